# Optimizing an MI355X kernel written in HIP

```python
import jax, jax.numpy as jnp
from jax import lax
import numpy as np

D_MODEL = 4096
BATCH = 2
SEQ = 8192
DEPTH = 1

GRID_W = 64
EPS = 1e-6
ROPE_BASE = 10000.0
N_BRANCHES = 2

MLA_HEADS = 16
MLA_Q_RANK = 768
MLA_KV_RANK = 512
MLA_NOPE_DIM = 128
MLA_ROPE_DIM = 64
MLA_QK_DIM = MLA_NOPE_DIM + MLA_ROPE_DIM
MLA_V_DIM = 128
MLA_WIDTH = MLA_HEADS * MLA_V_DIM
Q_BLOCK = 128

NA_HEADS = 16
NA_HEAD_DIM = 128
NA_WIDTH = NA_HEADS * NA_HEAD_DIM
NA_KH_MAX = 8
NA_KW = 16

PEER_HEADS = 8
PEER_N_KEYS = 128
PEER_N_EXPERTS = PEER_N_KEYS * PEER_N_KEYS
PEER_KEY_DIM = 256
PEER_HALF = PEER_KEY_DIM // 2
PEER_TOPK = 16
PEER_TOKEN_BLOCK = 64

IN_SIZES = (MLA_Q_RANK, MLA_KV_RANK, MLA_ROPE_DIM, NA_WIDTH, NA_WIDTH, NA_WIDTH)
D_IN = sum(IN_SIZES)
IN_OFFSETS = tuple(int(o) for o in np.cumsum(IN_SIZES)[:-1])

kernel_name = "hybrid_mla_natten_peer_block"


def rmsnorm(x, g):
    xf = x.astype(jnp.float32)
    xf = xf * lax.rsqrt(jnp.mean(xf * xf, axis=-1, keepdims=True) + EPS)
    return (xf * g.astype(jnp.float32)).astype(x.dtype)


def rope_1d(x, pos):
    half = x.shape[-1] // 2
    freqs = ROPE_BASE ** (-jnp.arange(half, dtype=jnp.float32) / half)
    ang = pos.astype(jnp.float32)[:, None] * freqs[None, :]
    ang = ang.reshape((ang.shape[0],) + (1,) * (x.ndim - 3) + (half,))
    cos = jnp.cos(ang).astype(x.dtype)
    sin = jnp.sin(ang).astype(x.dtype)
    x1, x2 = x[..., :half], x[..., half:]
    return jnp.concatenate([x1 * cos - x2 * sin, x1 * sin + x2 * cos], axis=-1)


def rope_2d(x, row, col):
    h = x.shape[-1] // 2
    return jnp.concatenate([rope_1d(x[..., :h], row), rope_1d(x[..., h:], col)], axis=-1)


def mla_branch(c_q, c_kv, k_rope, q_norm, w_uq, kv_norm, w_ukv, row, col):
    B, S, _ = c_q.shape
    q = (rmsnorm(c_q, q_norm) @ w_uq).reshape(B, S, MLA_HEADS, MLA_QK_DIM)
    q = jnp.concatenate([q[..., :MLA_NOPE_DIM], rope_2d(q[..., MLA_NOPE_DIM:], row, col)], axis=-1)
    kv = (rmsnorm(c_kv, kv_norm) @ w_ukv).reshape(B, S, MLA_HEADS, MLA_NOPE_DIM + MLA_V_DIM)
    k_nope, v = kv[..., :MLA_NOPE_DIM], kv[..., MLA_NOPE_DIM:]
    k_pe = rope_2d(k_rope, row, col)
    k = jnp.concatenate([k_nope, jnp.broadcast_to(k_pe[:, :, None, :], (B, S, MLA_HEADS, MLA_ROPE_DIM))], axis=-1)
    scale = MLA_QK_DIM ** -0.5
    n_blocks = S // Q_BLOCK
    qb = q.reshape(B, n_blocks, Q_BLOCK, MLA_HEADS, MLA_QK_DIM).transpose(1, 0, 2, 3, 4)

    def attend(q_blk):
        s = jnp.einsum('bqhd,bkhd->bhqk', q_blk, k).astype(jnp.float32) * scale
        p = jax.nn.softmax(s, axis=-1).astype(v.dtype)
        return jnp.einsum('bhqk,bkhd->bqhd', p, v)

    o = lax.map(attend, qb)
    return o.transpose(1, 0, 2, 3, 4).reshape(B, S, MLA_WIDTH)


def na_branch(q, k, v, rpb):
    B, S, _ = q.shape
    rows = S // GRID_W
    kh = min(NA_KH_MAX, rows)
    q = q.reshape(B, rows, GRID_W, NA_HEADS, NA_HEAD_DIM)
    k = k.reshape(B, rows, GRID_W, NA_HEADS, NA_HEAD_DIM)
    v = v.reshape(B, rows, GRID_W, NA_HEADS, NA_HEAD_DIM)
    cols = jnp.arange(GRID_W)
    col_start = jnp.clip(cols - NA_KW // 2, 0, GRID_W - NA_KW)
    col_idx = col_start[:, None] + jnp.arange(NA_KW)[None, :]
    dc = col_idx - cols[:, None]
    scale = NA_HEAD_DIM ** -0.5

    def row_attend(args):
        r, q_r = args
        rs = jnp.clip(r - kh // 2, 0, rows - kh)
        k_slab = lax.dynamic_slice_in_dim(k, rs, kh, axis=1)
        v_slab = lax.dynamic_slice_in_dim(v, rs, kh, axis=1)
        k_win = k_slab[:, :, col_idx]
        v_win = v_slab[:, :, col_idx]
        dr = rs + jnp.arange(kh) - r
        bias = rpb[:, dr[:, None, None] + (NA_KH_MAX - 1), dc[None, :, :] + (NA_KW - 1)]
        bias = bias.transpose(0, 2, 1, 3).astype(jnp.float32)
        s = jnp.einsum('bwhd,bkwjhd->bhwkj', q_r, k_win).astype(jnp.float32) * scale + bias[None]
        p = jax.nn.softmax(s.reshape(B, NA_HEADS, GRID_W, kh * NA_KW), axis=-1)
        p = p.reshape(B, NA_HEADS, GRID_W, kh, NA_KW).astype(v.dtype)
        return jnp.einsum('bhwkj,bkwjhd->bwhd', p, v_win)

    o = lax.map(row_attend, (jnp.arange(rows), q.transpose(1, 0, 2, 3, 4)))
    return o.transpose(1, 0, 2, 3, 4).reshape(B, S, NA_WIDTH)


def peer_ffn(h, w_query, subkeys, u, v):
    B, S, D = h.shape
    T = B * S
    ht = h.reshape(T, D)
    q = (ht @ w_query).reshape(T, PEER_HEADS, 2, PEER_HALF)
    s = jnp.einsum('thpc,hpnc->thpn', q, subkeys).astype(jnp.float32)
    top_s, top_i = lax.top_k(s, PEER_TOPK)
    cand_s = top_s[:, :, 0, :, None] + top_s[:, :, 1, None, :]
    cand_i = top_i[:, :, 0, :, None] * PEER_N_KEYS + top_i[:, :, 1, None, :]
    cand_s = cand_s.reshape(T, PEER_HEADS, PEER_TOPK * PEER_TOPK)
    cand_i = cand_i.reshape(T, PEER_HEADS, PEER_TOPK * PEER_TOPK)
    sel_s, pos = lax.top_k(cand_s, PEER_TOPK)
    experts = jnp.take_along_axis(cand_i, pos, axis=-1)
    gates = jax.nn.softmax(sel_s, axis=-1).astype(h.dtype)
    nb = T // PEER_TOKEN_BLOCK

    def block(args):
        x_b, e_b, g_b = args
        u_e = u[e_b]
        v_e = v[e_b]
        act = jax.nn.gelu(jnp.einsum('td,thkd->thk', x_b, u_e), approximate=False)
        return jnp.einsum('thk,thkd->td', g_b * act, v_e)

    out = lax.map(block, (ht.reshape(nb, PEER_TOKEN_BLOCK, D),
                          experts.reshape(nb, PEER_TOKEN_BLOCK, PEER_HEADS, PEER_TOPK),
                          gates.reshape(nb, PEER_TOKEN_BLOCK, PEER_HEADS, PEER_TOPK)))
    return out.reshape(B, S, D)


def setup_inputs(seed: int = 0) -> dict:
    key = jax.random.key(seed)
    ks = jax.random.split(key, 24)
    f = jnp.float32

    def nrm(k, shape, scale):
        return jax.random.normal(k, shape, f) * scale

    def gain(k, n):
        return 1.0 + 0.01 * jax.random.normal(k, (DEPTH, n), f)

    return {
        "x": jax.random.normal(ks[0], (BATCH, SEQ, D_MODEL), f),
        "attn_norm": gain(ks[1], D_MODEL),
        "w_in": nrm(ks[2], (DEPTH, D_MODEL, D_IN), D_MODEL ** -0.5),
        "q_norm": gain(ks[3], MLA_Q_RANK),
        "w_uq": nrm(ks[4], (DEPTH, MLA_Q_RANK, MLA_HEADS * MLA_QK_DIM), MLA_Q_RANK ** -0.5),
        "kv_norm": gain(ks[5], MLA_KV_RANK),
        "w_ukv": nrm(ks[6], (DEPTH, MLA_KV_RANK, MLA_HEADS * (MLA_NOPE_DIM + MLA_V_DIM)), MLA_KV_RANK ** -0.5),
        "w_branch_mla": nrm(ks[7], (DEPTH, MLA_WIDTH, D_MODEL), MLA_WIDTH ** -0.5),
        "na_rpb": nrm(ks[8], (DEPTH, NA_HEADS, 2 * NA_KH_MAX - 1, 2 * NA_KW - 1), 0.02),
        "w_branch_na": nrm(ks[9], (DEPTH, NA_WIDTH, D_MODEL), NA_WIDTH ** -0.5),
        "w_gate": nrm(ks[10], (DEPTH, D_MODEL, N_BRANCHES * D_MODEL), D_MODEL ** -0.5),
        "b_gate": nrm(ks[11], (DEPTH, N_BRANCHES * D_MODEL), 0.01),
        "w_out": nrm(ks[12], (DEPTH, D_MODEL, D_MODEL), D_MODEL ** -0.5),
        "ffn_norm": gain(ks[13], D_MODEL),
        "peer_w_query": nrm(ks[14], (DEPTH, D_MODEL, PEER_HEADS * PEER_KEY_DIM), D_MODEL ** -0.5),
        "peer_subkeys": nrm(ks[15], (DEPTH, PEER_HEADS, 2, PEER_N_KEYS, PEER_HALF), PEER_HALF ** -0.5),
        "peer_u": nrm(ks[16], (DEPTH, PEER_N_EXPERTS, D_MODEL), D_MODEL ** -0.5),
        "peer_v": nrm(ks[17], (DEPTH, PEER_N_EXPERTS, D_MODEL), PEER_HEADS ** -0.5),
        "final_norm": 1.0 + 0.01 * jax.random.normal(ks[18], (D_MODEL,), f),
    }


def reference(x, attn_norm, w_in, q_norm, w_uq, kv_norm, w_ukv, w_branch_mla, na_rpb, w_branch_na,
              w_gate, b_gate, w_out, ffn_norm, peer_w_query, peer_subkeys, peer_u, peer_v, final_norm):
    B, S, D = x.shape
    t = jnp.arange(S)
    row, col = t // GRID_W, t % GRID_W
    for l in range(DEPTH):
        h = rmsnorm(x, attn_norm[l])
        proj = h @ w_in[l]
        c_q, c_kv, k_rope, na_q, na_k, na_v = jnp.split(proj, IN_OFFSETS, axis=-1)
        y_a = mla_branch(c_q, c_kv, k_rope, q_norm[l], w_uq[l], kv_norm[l], w_ukv[l], row, col) @ w_branch_mla[l]
        y_b = na_branch(na_q, na_k, na_v, na_rpb[l]) @ w_branch_na[l]
        g = jax.nn.sigmoid(h @ w_gate[l] + b_gate[l]).reshape(B, S, N_BRANCHES, D)
        merged = g[:, :, 0, :] * y_a + g[:, :, 1, :] * y_b
        x = x + merged @ w_out[l]
        h2 = rmsnorm(x, ffn_norm[l])
        x = x + peer_ffn(h2, peer_w_query[l], peer_subkeys[l], peer_u[l], peer_v[l])
    return rmsnorm(x, final_norm)
```

```cpp
#include <hip/hip_runtime.h>
#include <hip/hip_bf16.h>
#include <cstdio>
#include <cstdint>

namespace pg8 {
#define PG8_LAS __attribute__((address_space(3)))
typedef unsigned short bf16_t;
typedef short bf16x8 __attribute__((ext_vector_type(8)));
typedef float f32x4 __attribute__((ext_vector_type(4)));
typedef float f32x2 __attribute__((ext_vector_type(2)));
typedef unsigned u32x4 __attribute__((ext_vector_type(4)));
typedef unsigned u32x2 __attribute__((ext_vector_type(2)));
constexpr int BM = 256, BK = 64, HALF = 128, HTB = HALF * BK * 2  , STAGE_BYTES = 8 * HTB, NXCD = 8, WGM = 8;

__host__ __device__ __forceinline__ int lds_byte(int r, int c) { const int st = (r >> 4) * 2 + (c >> 5), rr = r & 15, cc = c & 31, ob = rr * 64 + cc * 2; return st * 1024 + (ob ^ (((ob >> 9) & 1) << 5)); }
__host__ __device__ __forceinline__ void stage_rc(int b, int& R, int& C) { const int st = b / 1024, sb = b % 1024, swz = sb ^ (((sb >> 9) & 1) << 5); R = (st >> 1) * 16 + swz / 64; C = (st & 1) * 32 + (swz % 64) / 2; }
__host__ __device__ __forceinline__ int perm32(int rho) { const int n = rho >> 4, i = rho & 15; return 8 * (i >> 2) + 4 * n + (i & 3); }

struct Unit { int pm, pn; };
struct Gemm { const bf16_t* A; const bf16_t* Bt; int M, N, K, lda, ldb; };

struct StaticOrder {
    int nM, nN, nwg, G, c;
    __host__ __device__ void init(int M, int N, int G_, int c_) { nM = M / BM; nN = N / BM; nwg = nM * nN; G = G_; c = c_; }
    __host__ __device__ bool next(int i, Unit& u) const {
        const long L = (long)i * G + c; if (L >= nwg) return false;
        int wgid = (int)L; { const int q = nwg / NXCD, r = nwg % NXCD, xcd = wgid % NXCD, off = wgid / NXCD; wgid = (xcd < r ? xcd * (q + 1) : r * (q + 1) + (xcd - r) * q) + off; }
        const int nig = WGM * nN, gid = wgid / nig, fm = gid * WGM, gsz = (nM - fm) < WGM ? (nM - fm) : WGM;
        u.pm = fm + ((wgid % nig) % gsz); u.pn = (wgid % nig) / gsz; return true;
    }
    __device__ __forceinline__ void a_ready(const Unit&) const {}
    __device__ __forceinline__ void done(const Unit&) const {}
};

__device__ __forceinline__ unsigned cvt_pk_bf16(float lo, float hi) { unsigned r; asm volatile("v_cvt_pk_bf16_f32 %0, %1, %2" : "=v"(r) : "v"(lo), "v"(hi)); return r; }
__device__ __forceinline__ float bf_lo(unsigned w) { return __uint_as_float(w << 16); }
__device__ __forceinline__ float bf_hi(unsigned w) { return __uint_as_float(w & 0xffff0000u); }


template <class Epi, class Sched, bool ALIGN_EPI = true>
__device__ __forceinline__ void gemm_phase(PG8_LAS unsigned char* lds, const Gemm g, const Sched& S, const Epi& E) {
    const int tid = threadIdx.x, wid = __builtin_amdgcn_readfirstlane(tid >> 6), lane = tid & 63, wr = wid >> 2, wc = wid & 3, fr = lane & 15, fq = lane >> 4;
    const int K = g.K, nt = K / BK;
    unsigned voffA[2], voffB[2];
#pragma unroll
    for (int i = 0; i < 2; ++i) { int R, C; stage_rc(tid * 16 + i * 8192, R, C); const int Rb = Epi::PERM ? ((R & ~31) + perm32(R & 31)) : R;
        voffA[i] = (unsigned)(R * g.lda + C) * 2u; voffB[i] = (unsigned)(Rb * g.ldb + C) * 2u; }
    const size_t kstep = (size_t)(BK * 2);
    const size_t hstepA = (size_t)HALF * g.lda * 2, hstepB = (size_t)HALF * g.ldb * 2;
    const size_t tstepA = 2 * hstepA, tstepB = 2 * hstepB;
    const unsigned ldsw = (unsigned)wid * 1024u;
    const int aoff = lds_byte(wr * 64 + fr, fq * 8), boff = lds_byte(wc * 32 + fr, fq * 8);
#define PG8_SA(b, h) (((b) * 2 + (h)) * HTB)
#define PG8_SB(b, h) ((4 + (b) * 2 + (h)) * HTB)
#define PG8_STAGE(bufoff, gbase, voff) do { _Pragma("unroll") for (int _i = 0; _i < 2; ++_i) \
        __builtin_amdgcn_global_load_lds((const unsigned*)((const char*)(gbase) + (voff)[_i]), (PG8_LAS unsigned*)(lds + (bufoff) + ldsw + _i * 8192), 16, 0, 0); } while (0)
#define PG8_LDA(dst, b, h) do { _Pragma("unroll") for (int m = 0; m < 4; ++m) _Pragma("unroll") for (int k = 0; k < 2; ++k) dst[m][k] = *(const PG8_LAS bf16x8*)(lds + PG8_SA(b, h) + aoff + m * 2048 + k * 1024); } while (0)
#define PG8_LDB(dst, b, h) do { _Pragma("unroll") for (int n = 0; n < 2; ++n) _Pragma("unroll") for (int k = 0; k < 2; ++k) dst[n][k] = *(const PG8_LAS bf16x8*)(lds + PG8_SB(b, h) + boff + n * 2048 + k * 1024); } while (0)
#define PG8_MMA(ai, bj, At, Bt) do { __builtin_amdgcn_s_setprio(1); _Pragma("unroll") for (int m = 0; m < 4; ++m) _Pragma("unroll") for (int n = 0; n < 2; ++n) _Pragma("unroll") for (int k = 0; k < 2; ++k) \
        acc[ai][bj][m][n] = __builtin_amdgcn_mfma_f32_16x16x32_bf16(Bt[n][k], At[m][k], acc[ai][bj][m][n], 0, 0, 0); __builtin_amdgcn_s_setprio(0); } while (0)
#define PG8_WAIT_V(n) asm volatile("s_waitcnt vmcnt(" #n ")" ::: "memory")
#define PG8_WAIT_L(n) asm volatile("s_waitcnt lgkmcnt(" #n ")" ::: "memory")
#define PG8_BAR __builtin_amdgcn_s_barrier()
#define PG8_SCHED __builtin_amdgcn_sched_barrier(0)
    Unit cur, nxt; int ui = 0;
    if (!S.next(0, cur)) return;
    f32x4 acc[2][2][4][2];
#pragma unroll
    for (int a = 0; a < 2; ++a)
#pragma unroll
        for (int b = 0; b < 2; ++b)
#pragma unroll
            for (int m = 0; m < 4; ++m)
#pragma unroll
                for (int n = 0; n < 2; ++n) acc[a][b][m][n] = (f32x4){0.f, 0.f, 0.f, 0.f};
    bf16x8 At[4][2], B0[2][2], B1[2][2];
    const char* cA = (const char*)g.A + (size_t)cur.pm * tstepA; const char* cB = (const char*)g.Bt + (size_t)cur.pn * tstepB;
    S.a_ready(cur);
    PG8_STAGE(PG8_SB(0, 0), cB, voffB); PG8_STAGE(PG8_SB(0, 1), cB + hstepB, voffB); PG8_STAGE(PG8_SA(0, 0), cA, voffA); PG8_STAGE(PG8_SA(0, 1), cA + hstepA, voffA);
    if (wr == 1) PG8_BAR;
    PG8_WAIT_V(2); PG8_BAR;
    PG8_STAGE(PG8_SB(1, 0), cB + kstep, voffB); PG8_STAGE(PG8_SA(1, 0), cA + kstep, voffA); PG8_STAGE(PG8_SB(1, 1), cB + hstepB + kstep, voffB);
    PG8_WAIT_V(6); PG8_BAR;
    for (;;) {
        const bool has_next = S.next(ui + 1, nxt);
        const char* nA = has_next ? (const char*)g.A + (size_t)nxt.pm * tstepA : cA; const char* nB = has_next ? (const char*)g.Bt + (size_t)nxt.pn * tstepB : cB;
        for (int t = 0; t < nt; t += 2) {
            const bool last = (t == nt - 2);
            const char* a1 = cA + (size_t)(t + 1) * kstep;
            const char* a2 = last ? nA : cA + (size_t)(t + 2) * kstep; const char* b2 = last ? nB : cB + (size_t)(t + 2) * kstep;
            const char* a3 = a2 + kstep; const char* b3 = b2 + kstep;
            if (last && has_next) S.a_ready(nxt);
            PG8_LDB(B0, 0, 0); PG8_LDB(B1, 0, 1); PG8_SCHED; PG8_LDA(At, 0, 0); PG8_STAGE(PG8_SA(1, 1), a1 + hstepA, voffA);
            PG8_WAIT_V(8); PG8_WAIT_L(0); PG8_BAR; PG8_MMA(0, 0, At, B0); PG8_MMA(0, 1, At, B1); PG8_BAR; PG8_SCHED;
            PG8_LDA(At, 0, 1); PG8_STAGE(PG8_SB(0, 0), b2, voffB); PG8_STAGE(PG8_SB(0, 1), b2 + hstepB, voffB); PG8_STAGE(PG8_SA(0, 0), a2, voffA);
            PG8_WAIT_V(8); PG8_WAIT_L(0); PG8_BAR; PG8_MMA(1, 0, At, B0); PG8_MMA(1, 1, At, B1); PG8_BAR; PG8_SCHED;
            PG8_LDB(B0, 1, 0); PG8_LDB(B1, 1, 1); PG8_SCHED; PG8_LDA(At, 1, 0); PG8_STAGE(PG8_SA(0, 1), a2 + hstepA, voffA);
            PG8_WAIT_V(8); PG8_WAIT_L(0); PG8_BAR; PG8_MMA(0, 0, At, B0); PG8_MMA(0, 1, At, B1); PG8_BAR; PG8_SCHED;
            PG8_LDA(At, 1, 1); PG8_STAGE(PG8_SB(1, 0), b3, voffB); PG8_STAGE(PG8_SB(1, 1), b3 + hstepB, voffB); PG8_STAGE(PG8_SA(1, 0), a3, voffA);
            PG8_WAIT_V(8); PG8_WAIT_L(0); PG8_BAR; PG8_MMA(1, 0, At, B0); PG8_MMA(1, 1, At, B1); PG8_BAR; PG8_SCHED;
        }
        if constexpr (ALIGN_EPI) { if (wr == 0) PG8_BAR; }
        E(acc, cur, wr, wc, fr, fq); S.done(cur);
        if (!has_next) break;
#pragma unroll
        for (int a = 0; a < 2; ++a)
#pragma unroll
            for (int b = 0; b < 2; ++b)
#pragma unroll
                for (int m = 0; m < 4; ++m)
#pragma unroll
                    for (int n = 0; n < 2; ++n) acc[a][b][m][n] = (f32x4){0.f, 0.f, 0.f, 0.f};
        cur = nxt; cA = nA; cB = nB; ++ui;
        if constexpr (ALIGN_EPI) { if (wr == 1) PG8_BAR; }
    }
    PG8_WAIT_V(0);
    if constexpr (!ALIGN_EPI) { if (wr == 0) PG8_BAR; }
    PG8_BAR;
#undef PG8_SA
#undef PG8_SB
#undef PG8_STAGE
#undef PG8_LDA
#undef PG8_LDB
#undef PG8_MMA
#undef PG8_WAIT_V
#undef PG8_WAIT_L
#undef PG8_BAR
#undef PG8_SCHED
}

__device__ __forceinline__ float sigmoidf_fast(float x) { return __builtin_amdgcn_rcpf(1.0f + __builtin_amdgcn_exp2f(-1.4426950408889634f * x)); }

struct EpiIn {
    static constexpr bool PERM = true;
    unsigned char* wsb; size_t off_lat, off_na, na_stride, off_g; const float* bgate; float qscale;
    __device__ __forceinline__ void operator()(const f32x4 (&acc)[2][2][4][2], const Unit& u, int wr, int wc, int fr, int fq) const {
        const int row0 = u.pm * BM + wr * 64 + fr; const int pn = u.pn;
        size_t boff; int ldc, colt; float sc = 1.f; bool gate = false;
        if (pn < 6) { boff = off_lat; ldc = 1536; colt = pn * 256; }
        else if (pn < 30) { const int t = (pn - 6) >> 3; boff = off_na + (size_t)t * na_stride; ldc = 2048; colt = ((pn - 6) & 7) * 256; if (t == 0) sc = qscale; }
        else { boff = off_g; ldc = 8192; colt = (pn - 30) * 256; gate = true; }
        bf16_t* base = (bf16_t*)(wsb + boff);
        const int col0 = colt + wc * 32 + 8 * fq;
        f32x4 bv[2][2];
#pragma unroll
        for (int bj = 0; bj < 2; ++bj)
#pragma unroll
            for (int n = 0; n < 2; ++n) bv[bj][n] = gate ? *(const f32x4*)(bgate + col0 + bj * HALF + 4 * n) : (f32x4){0.f, 0.f, 0.f, 0.f};
#pragma unroll
        for (int ai = 0; ai < 2; ++ai)
#pragma unroll
            for (int m = 0; m < 4; ++m) { bf16_t* rowp = base + (size_t)(row0 + ai * HALF + m * 16) * ldc + col0;
#pragma unroll
                for (int bj = 0; bj < 2; ++bj) { f32x4 v0 = acc[ai][bj][m][0] + bv[bj][0], v1 = acc[ai][bj][m][1] + bv[bj][1];
                    if (gate) {
#pragma unroll
                        for (int i = 0; i < 4; ++i) { v0[i] = sigmoidf_fast(v0[i]); v1[i] = sigmoidf_fast(v1[i]); } }
                    else { v0 = v0 * sc; v1 = v1 * sc; }
                    u32x4 w; w.x = cvt_pk_bf16(v0[0], v0[1]); w.y = cvt_pk_bf16(v0[2], v0[3]); w.z = cvt_pk_bf16(v1[0], v1[1]); w.w = cvt_pk_bf16(v1[2], v1[3]);
                    *(u32x4*)(rowp + bj * HALF) = w; } }
    }
};

struct EpiQ {
    static constexpr bool PERM = false;
    bf16_t* Q; const float* rs; const float* rope; float qscale;
    __device__ __forceinline__ void operator()(const f32x4 (&acc)[2][2][4][2], const Unit& u, int wr, int wc, int fr, int fq) const {
#pragma unroll
        for (int ai = 0; ai < 2; ++ai)
#pragma unroll
            for (int m = 0; m < 4; ++m) {
                const int row = u.pm * BM + ai * HALF + wr * 64 + m * 16 + fr;
                const float rstd = rs[2 * row] * qscale;
                const int s = row & 8191, grow = s >> 6, gcol = s & 63;
#pragma unroll
                for (int bj = 0; bj < 2; ++bj) {
                    const int gg = 8 * u.pn + 4 * bj + wc, kind = gg % 6;
                    f32x4 v0 = acc[ai][bj][m][0] * rstd, v1 = acc[ai][bj][m][1] * rstd;
                    if (kind >= 4) {
                        const int pos = (kind == 4) ? grow : gcol;
                        const f32x4 t0 = *(const f32x4*)(rope + (size_t)(pos * 16 + 4 * fq) * 2), t1 = *(const f32x4*)(rope + (size_t)(pos * 16 + 4 * fq) * 2 + 4);
                        const float c0 = t0[0], s0 = t0[1], c1 = t0[2], s1 = t0[3], c2 = t1[0], s2 = t1[1], c3 = t1[2], s3 = t1[3];
                        f32x4 o0, o1;
                        o0[0] = v0[0] * c0 - v1[0] * s0; o1[0] = v0[0] * s0 + v1[0] * c0;
                        o0[1] = v0[1] * c1 - v1[1] * s1; o1[1] = v0[1] * s1 + v1[1] * c1;
                        o0[2] = v0[2] * c2 - v1[2] * s2; o1[2] = v0[2] * s2 + v1[2] * c2;
                        o0[3] = v0[3] * c3 - v1[3] * s3; o1[3] = v0[3] * s3 + v1[3] * c3;
                        v0 = o0; v1 = o1;
                    }
                    bf16_t* p = Q + (size_t)row * 3072 + u.pn * BM + bj * HALF + wc * 32 + 4 * fq;
                    u32x2 w0, w1; w0.x = cvt_pk_bf16(v0[0], v0[1]); w0.y = cvt_pk_bf16(v0[2], v0[3]); w1.x = cvt_pk_bf16(v1[0], v1[1]); w1.y = cvt_pk_bf16(v1[2], v1[3]);
                    *(u32x2*)p = w0; *(u32x2*)(p + 16) = w1;
                }
            }
    }
};

struct EpiKV {
    static constexpr bool PERM = true;
    bf16_t* Kn; bf16_t* Vm; const float* rs;
    __device__ __forceinline__ void operator()(const f32x4 (&acc)[2][2][4][2], const Unit& u, int wr, int wc, int fr, int fq) const {
        const int col0 = u.pn * HALF + wc * 32 + 8 * fq;
#pragma unroll
        for (int ai = 0; ai < 2; ++ai)
#pragma unroll
            for (int m = 0; m < 4; ++m) {
                const int row = u.pm * BM + ai * HALF + wr * 64 + m * 16 + fr;
                const float rstd = rs[2 * row + 1];
#pragma unroll
                for (int bj = 0; bj < 2; ++bj) { const f32x4 v0 = acc[ai][bj][m][0] * rstd, v1 = acc[ai][bj][m][1] * rstd;
                    u32x4 w; w.x = cvt_pk_bf16(v0[0], v0[1]); w.y = cvt_pk_bf16(v0[2], v0[3]); w.z = cvt_pk_bf16(v1[0], v1[1]); w.w = cvt_pk_bf16(v1[2], v1[3]);
                    *(u32x4*)((bj == 0 ? Kn : Vm) + (size_t)row * 2048 + col0) = w; }
            }
    }
};

template <bool FIRST> struct EpiGate {
    static constexpr bool PERM = true;
    const bf16_t* G; bf16_t* MRG;
    __device__ __forceinline__ void operator()(const f32x4 (&acc)[2][2][4][2], const Unit& u, int wr, int wc, int fr, int fq) const {
        const int col0 = u.pn * BM + wc * 32 + 8 * fq;
#pragma unroll
        for (int ai = 0; ai < 2; ++ai)
#pragma unroll
            for (int m = 0; m < 4; ++m) {
                const int row = u.pm * BM + ai * HALF + wr * 64 + m * 16 + fr;
#pragma unroll
                for (int bj = 0; bj < 2; ++bj) {
                    const int col = col0 + bj * HALF;
                    const u32x4 gw = *(const u32x4*)(G + (size_t)row * 8192 + (FIRST ? 0 : 4096) + col);
                    f32x4 v0 = acc[ai][bj][m][0], v1 = acc[ai][bj][m][1];
                    v0[0] *= bf_lo(gw.x); v0[1] *= bf_hi(gw.x); v0[2] *= bf_lo(gw.y); v0[3] *= bf_hi(gw.y);
                    v1[0] *= bf_lo(gw.z); v1[1] *= bf_hi(gw.z); v1[2] *= bf_lo(gw.w); v1[3] *= bf_hi(gw.w);
                    bf16_t* p = MRG + (size_t)row * 4096 + col;
                    if (!FIRST) { const u32x4 pw = *(const u32x4*)p;
                        v0[0] += bf_lo(pw.x); v0[1] += bf_hi(pw.x); v0[2] += bf_lo(pw.y); v0[3] += bf_hi(pw.y);
                        v1[0] += bf_lo(pw.z); v1[1] += bf_hi(pw.z); v1[2] += bf_lo(pw.w); v1[3] += bf_hi(pw.w); }
                    u32x4 w; w.x = cvt_pk_bf16(v0[0], v0[1]); w.y = cvt_pk_bf16(v0[2], v0[3]); w.z = cvt_pk_bf16(v1[0], v1[1]); w.w = cvt_pk_bf16(v1[2], v1[3]);
                    *(u32x4*)p = w;
                }
            }
    }
};

struct EpiF32 {
    static constexpr bool PERM = false;
    const float* base; float* out; int ldc;
    __device__ __forceinline__ void operator()(const f32x4 (&acc)[2][2][4][2], const Unit& u, int wr, int wc, int fr, int fq) const {
        const int col0 = u.pn * BM + wc * 32 + 4 * fq;
#pragma unroll
        for (int ai = 0; ai < 2; ++ai)
#pragma unroll
            for (int m = 0; m < 4; ++m) { const size_t off = (size_t)(u.pm * BM + ai * HALF + wr * 64 + m * 16 + fr) * ldc + col0;
#pragma unroll
                for (int bj = 0; bj < 2; ++bj)
#pragma unroll
                    for (int n = 0; n < 2; ++n) { f32x4 o = acc[ai][bj][m][n]; if (base) o = o + *(const f32x4*)(base + off + bj * HALF + n * 16); *(f32x4*)(out + off + bj * HALF + n * 16) = o; } }
    }
};
}

namespace att {
using bf16x8 = __attribute__((ext_vector_type(8))) short;
using s16x4  = __attribute__((ext_vector_type(4))) short;
using f32x16 = __attribute__((ext_vector_type(16))) float;
using u32x4  = __attribute__((ext_vector_type(4))) unsigned;
typedef unsigned short bf16_t;
constexpr int NW = 8, QBLK = 32, KVBLK = 64, SEQ = 8192, NHEAD = 16;
constexpr int SHM_V = KVBLK * 128 * 2, SHM_KN = KVBLK * 128 * 2, SHM_KR = KVBLK * 64 * 2;
constexpr int OFF_V = 0, OFF_KN = 2 * SHM_V, OFF_KR = OFF_KN + 2 * SHM_KN, OFF_WS = OFF_KR + 2 * SHM_KR, OFF_BIAS = OFF_WS + NW * 64 * 4, OFF_QR = OFF_BIAS + 2048, ATT_LDS_BYTES = OFF_QR + NW * 4096;
#define KSWZ(row, colB) ((row) * 256 + ((colB) ^ (((row) & 7) << 4)))
#define KRSWZ(row, chunk) ((row) * 128 + ((((chunk) ^ (((row) >> 1) & 7))) << 4))
#define ASBAR() __builtin_amdgcn_sched_barrier(0)
__device__ __forceinline__ int crow(int r, int hi) { return (r & 3) + 8 * (r >> 2) + 4 * hi; }
__device__ __forceinline__ unsigned cvtpk(float lo, float hi) { unsigned r; asm volatile("v_cvt_pk_bf16_f32 %0, %1, %2" : "=v"(r) : "v"(lo), "v"(hi)); return r; }
__device__ __forceinline__ bf16x8 ld8(const bf16_t* p) { return *reinterpret_cast<const bf16x8*>(p); }

constexpr float THR2 = 11.5f;
__device__ __forceinline__ void partialSM(f32x16& p0, f32x16& p1, float& m_reg, float& mn, float& alpha) {
  float pmax = p0[0];
#pragma unroll
  for (int r = 1; r < 16; ++r) pmax = fmaxf(pmax, p0[r]);
#pragma unroll
  for (int r = 0; r < 16; ++r) pmax = fmaxf(pmax, p1[r]);
  { auto rr = __builtin_amdgcn_permlane32_swap(__float_as_uint(pmax), __float_as_uint(pmax), false, false);
    pmax = fmaxf(__uint_as_float(rr[0]), __uint_as_float(rr[1])); }
  if (__builtin_expect(__all(pmax - m_reg <= THR2), 1)) { mn = m_reg; alpha = 1.f; }
  else { mn = fmaxf(m_reg, pmax); alpha = __builtin_amdgcn_exp2f(m_reg - mn); m_reg = mn; }
#pragma unroll
  for (int r = 0; r < 16; ++r) p0[r] = p0[r] - mn;
#pragma unroll
  for (int r = 0; r < 16; ++r) p1[r] = p1[r] - mn;
#pragma unroll
  for (int r = 0; r < 16; ++r) p0[r] = __builtin_amdgcn_exp2f(p0[r]);
}
__device__ __forceinline__ void finishSM(f32x16& p0, f32x16& p1, float alpha, float& l_reg, bf16x8& pa0, bf16x8& pa1, bf16x8& pa2, bf16x8& pa3) {
#pragma unroll
  for (int r = 0; r < 16; ++r) p1[r] = __builtin_amdgcn_exp2f(p1[r]);
  float ps = 0;
#pragma unroll
  for (int r = 0; r < 16; ++r) ps += p0[r];
#pragma unroll
  for (int r = 0; r < 16; ++r) ps += p1[r];
  { auto rr = __builtin_amdgcn_permlane32_swap(__float_as_uint(ps), __float_as_uint(ps), false, false);
    ps = __uint_as_float(rr[0]) + __uint_as_float(rr[1]); }
  l_reg = l_reg * alpha + ps;
#define PK4(P, BASE, OUT) do { unsigned a0 = cvtpk(P[BASE + 0], P[BASE + 1]), a1 = cvtpk(P[BASE + 2], P[BASE + 3]);   \
    unsigned b0 = cvtpk(P[BASE + 4], P[BASE + 5]), b1 = cvtpk(P[BASE + 6], P[BASE + 7]);                              \
    auto r0 = __builtin_amdgcn_permlane32_swap(a0, b0, false, false); auto r1 = __builtin_amdgcn_permlane32_swap(a1, b1, false, false); \
    u32x4 w = {r0[0], r1[0], r0[1], r1[1]}; OUT = *reinterpret_cast<bf16x8*>(&w); } while (0)
  PK4(p0, 0, pa0); PK4(p0, 8, pa1); PK4(p1, 0, pa2); PK4(p1, 8, pa3);
}
__device__ __forceinline__ int v_st(int k, int c) { const int kk = (k & ~0xC) | ((k & 4) << 1) | ((k & 8) >> 1); return ((kk >> 3) * 4 + (c >> 5)) * 512 + ((kk & 7) * 32 + (c & 31)) * 2; }
__device__ __forceinline__ int v_rd_base(int lane) { return ((lane & 3) << 3) | (((lane >> 2) & 3) << 6) | (((lane >> 4) & 1) << 5) | (((lane >> 5) & 1) << 8); }
constexpr int v_rd_off(int d0, int ks, int half) { return d0 * 512 + ks * 4096 + half * 2048; }
template <int OFF> __device__ __forceinline__ s16x4 tr_read(int vb) {
  s16x4 r; asm volatile("ds_read_b64_tr_b16 %0, %1 offset:%2" : "=&v"(r) : "v"(vb), "i"(OFF) : "memory"); return r;
}
template <int D0> __device__ __forceinline__ void pv_one(f32x16& od, int vb, bf16x8 pa0, bf16x8 pa1, bf16x8 pa2, bf16x8 pa3) {
  const s16x4 l0 = tr_read<v_rd_off(D0, 0, 0)>(vb), h0 = tr_read<v_rd_off(D0, 0, 1)>(vb), l1 = tr_read<v_rd_off(D0, 1, 0)>(vb), h1 = tr_read<v_rd_off(D0, 1, 1)>(vb);
  const s16x4 l2 = tr_read<v_rd_off(D0, 2, 0)>(vb), h2 = tr_read<v_rd_off(D0, 2, 1)>(vb), l3 = tr_read<v_rd_off(D0, 3, 0)>(vb), h3 = tr_read<v_rd_off(D0, 3, 1)>(vb);
  asm volatile("s_waitcnt lgkmcnt(0)" ::: "memory"); ASBAR();
#define PKV(L, H) (bf16x8){L[0], L[1], L[2], L[3], H[0], H[1], H[2], H[3]}
  od = __builtin_amdgcn_mfma_f32_32x32x16_bf16(pa0, PKV(l0, h0), od, 0, 0, 0);
  od = __builtin_amdgcn_mfma_f32_32x32x16_bf16(pa1, PKV(l1, h1), od, 0, 0, 0);
  od = __builtin_amdgcn_mfma_f32_32x32x16_bf16(pa2, PKV(l2, h2), od, 0, 0, 0);
  od = __builtin_amdgcn_mfma_f32_32x32x16_bf16(pa3, PKV(l3, h3), od, 0, 0, 0);
#undef PKV
}
__device__ __forceinline__ void pv_d0(f32x16* o, int vb, bf16x8 pa0, bf16x8 pa1, bf16x8 pa2, bf16x8 pa3) {
  pv_one<0>(o[0], vb, pa0, pa1, pa2, pa3); pv_one<1>(o[1], vb, pa0, pa1, pa2, pa3); pv_one<2>(o[2], vb, pa0, pa1, pa2, pa3); pv_one<3>(o[3], vb, pa0, pa1, pa2, pa3);
}
template <int NROPE> __device__ __forceinline__ void qkt(f32x16& p0, f32x16& p1, const char* Kn, const char* Kr, const bf16x8* qr, const char* qrl, int r32, int hi) {
  p0 = f32x16{}; p1 = f32x16{};
#pragma unroll
  for (int d0 = 0; d0 < 8; ++d0) { const int cb = (d0 * 16 + hi * 8) * 2;
    const bf16x8 b0 = *reinterpret_cast<const bf16x8*>(Kn + KSWZ(r32, cb));
    const bf16x8 b1 = *reinterpret_cast<const bf16x8*>(Kn + KSWZ(32 + r32, cb));
    p0 = __builtin_amdgcn_mfma_f32_32x32x16_bf16(b0, qr[d0], p0, 0, 0, 0);
    p1 = __builtin_amdgcn_mfma_f32_32x32x16_bf16(b1, qr[d0], p1, 0, 0, 0); }
#pragma unroll
  for (int d0 = 0; d0 < NROPE; ++d0) { const int ch = d0 * 2 + hi;
    const bf16x8 b0 = *reinterpret_cast<const bf16x8*>(Kr + KRSWZ(r32, ch));
    const bf16x8 b1 = *reinterpret_cast<const bf16x8*>(Kr + KRSWZ(32 + r32, ch));
    const bf16x8 qf = *reinterpret_cast<const bf16x8*>(qrl + d0 * 1024);
    p0 = __builtin_amdgcn_mfma_f32_32x32x16_bf16(b0, qf, p0, 0, 0, 0);
    p1 = __builtin_amdgcn_mfma_f32_32x32x16_bf16(b1, qf, p1, 0, 0, 0); }
}

__device__ __forceinline__ void mla_unit(int b, int h, int qb, const bf16_t* __restrict__ Q, const bf16_t* __restrict__ KN, const bf16_t* __restrict__ KR, const bf16_t* __restrict__ VM, bf16_t* __restrict__ O, char* lds) {
  int tid_ = threadIdx.x; asm volatile("" : "+v"(tid_));
  const int tid = tid_, wid = tid >> 6, lane = tid & 63, r32 = lane & 31, hi = lane >> 5;
  char* V_lds = lds + OFF_V; char* Kn_lds = lds + OFF_KN; char* Kr_lds = lds + OFF_KR;
  float* ws = (float*)(lds + OFF_WS) + wid * 64; float* li_l = ws; float* al_l = ws + 32;
  float m_reg = -1e30f, l_reg = 0; f32x16 o[4] = {}; bf16x8 qr[8];
  char* qrl = lds + OFF_QR + wid * 4096 + (hi * 32 + r32) * 16;
  const long rowbase = (long)b * SEQ;
  const bf16_t* Qw = Q + (rowbase + qb * 256 + wid * QBLK + r32) * 3072 + h * 192 + hi * 8;
#pragma unroll
  for (int d0 = 0; d0 < 8; ++d0) qr[d0] = ld8(Qw + d0 * 16);
  const bf16_t* Kh = KN + rowbase * 2048 + h * 128; const bf16_t* Vh = VM + rowbase * 2048 + h * 128; const bf16_t* Krb = KR + rowbase * 64;
  const int sr = tid >> 4, sc = (tid & 15) * 8, vst0 = v_st(sr, sc), vst1 = v_st(32 + sr, sc);
  const int krr = tid >> 3, krc = tid & 7;
  const int vb0 = (int)(uintptr_t)V_lds + v_rd_base(lane);
  struct { bf16x8 vs0, vs1, ks0, ks1, kr0; } sr_[1];
#define SLOAD(i, k0) do { sr_[i].vs0 = ld8(&Vh[(long)((k0) + sr) * 2048 + sc]); sr_[i].vs1 = ld8(&Vh[(long)((k0) + 32 + sr) * 2048 + sc]); \
    sr_[i].ks0 = ld8(&Kh[(long)((k0) + sr) * 2048 + sc]); sr_[i].ks1 = ld8(&Kh[(long)((k0) + 32 + sr) * 2048 + sc]); sr_[i].kr0 = ld8(&Krb[(long)((k0) + krr) * 64 + krc * 8]); } while (0)
#define SWRITE(bb, i) do { *(bf16x8*)(V_lds + (bb) * SHM_V + vst0) = sr_[i].vs0; *(bf16x8*)(V_lds + (bb) * SHM_V + vst1) = sr_[i].vs1; const int kc = sc * 2; \
    *(bf16x8*)(Kn_lds + (bb) * SHM_KN + KSWZ(sr, kc)) = sr_[i].ks0; *(bf16x8*)(Kn_lds + (bb) * SHM_KN + KSWZ(32 + sr, kc)) = sr_[i].ks1; \
    *(bf16x8*)(Kr_lds + (bb) * SHM_KR + KRSWZ(krr, krc)) = sr_[i].kr0; } while (0)
#define SWAIT() asm volatile("s_waitcnt vmcnt(0)" ::: "memory")
#define RESC(a) do { if (__any((a) < 1.f)) { if (hi == 0) al_l[r32] = (a); asm volatile("s_waitcnt lgkmcnt(0)" ::: "memory"); \
    _Pragma("unroll") for (int d = 0; d < 4; ++d) _Pragma("unroll") for (int r = 0; r < 16; ++r) o[d][r] *= al_l[crow(r, hi)]; } } while (0)
  f32x16 pA0, pA1, pB0, pB1; float mnA, mnB, alA, alB; bf16x8 pa0, pa1, pa2, pa3; const int NT = SEQ / KVBLK;
  constexpr int SE = 0, SO = 0;
  __syncthreads();
#pragma unroll
  for (int d0 = 0; d0 < 4; ++d0) *(bf16x8*)(qrl + d0 * 1024) = ld8(Qw + (8 + d0) * 16);
  SLOAD(SE, 0); asm volatile("s_waitcnt vmcnt(0)" ::: "memory"); SWRITE(0, SE); __syncthreads();
  qkt<4>(pA0, pA1, Kn_lds, Kr_lds, qr, qrl, r32, hi); partialSM(pA0, pA1, m_reg, mnA, alA);
  SLOAD(SO, KVBLK);
  SWAIT(); SWRITE(1, SO); __syncthreads();
  for (int j = 1; j + 1 < NT; j += 2) {
    ASBAR(); qkt<4>(pB0, pB1, Kn_lds + SHM_KN, Kr_lds + SHM_KR, qr, qrl, r32, hi);
    finishSM(pA0, pA1, alA, l_reg, pa0, pa1, pa2, pa3); ASBAR();
    SLOAD(SE, (j + 1) * KVBLK); ASBAR();
    pv_d0(o, vb0, pa0, pa1, pa2, pa3); partialSM(pB0, pB1, m_reg, mnB, alB);
    __syncthreads(); SWAIT(); SWRITE(0, SE);
    RESC(alB); __syncthreads();
    ASBAR(); qkt<4>(pA0, pA1, Kn_lds, Kr_lds, qr, qrl, r32, hi);
    finishSM(pB0, pB1, alB, l_reg, pa0, pa1, pa2, pa3); ASBAR();
    SLOAD(SO, (j + 2) * KVBLK); ASBAR();
    pv_d0(o, vb0 + SHM_V, pa0, pa1, pa2, pa3); partialSM(pA0, pA1, m_reg, mnA, alA);
    __syncthreads(); SWAIT(); SWRITE(1, SO);
    RESC(alA); __syncthreads();
  }
  ASBAR(); qkt<4>(pB0, pB1, Kn_lds + SHM_KN, Kr_lds + SHM_KR, qr, qrl, r32, hi);
  finishSM(pA0, pA1, alA, l_reg, pa0, pa1, pa2, pa3); ASBAR();
  pv_d0(o, vb0, pa0, pa1, pa2, pa3); partialSM(pB0, pB1, m_reg, mnB, alB);
  __syncthreads(); RESC(alB);
  finishSM(pB0, pB1, alB, l_reg, pa0, pa1, pa2, pa3); ASBAR();
  pv_d0(o, vb0 + SHM_V, pa0, pa1, pa2, pa3);
  if (hi == 0) li_l[r32] = l_reg; asm volatile("s_waitcnt lgkmcnt(0)" ::: "memory");
  float rli[16];
#pragma unroll
  for (int r = 0; r < 16; ++r) rli[r] = __builtin_amdgcn_rcpf(li_l[crow(r, hi)]);
  bf16_t* Ow = O + (rowbase + qb * 256 + wid * QBLK) * 2048 + h * 128;
#pragma unroll
  for (int r = 0; r < 16; ++r) { const int orow = crow(r, hi);
#pragma unroll
    for (int d0 = 0; d0 < 4; ++d0) Ow[(long)orow * 2048 + d0 * 32 + r32] = (bf16_t)(cvtpk(o[d0][r] * rli[r], 0.f) & 0xffffu); }
#undef SLOAD
#undef SWRITE
#undef SWAIT
#undef RESC
}

__device__ __forceinline__ void na_unit(int b, int h, int rg, const bf16_t* __restrict__ Q, const bf16_t* __restrict__ K, const bf16_t* __restrict__ V, const float* __restrict__ rpb, bf16_t* __restrict__ O, char* lds) {
  int tid_ = threadIdx.x; asm volatile("" : "+v"(tid_));
  const int tid = tid_, wid = tid >> 6, lane = tid & 63, r32 = lane & 31, hi = lane >> 5;
  char* V_lds = lds + OFF_V; char* Kn_lds = lds + OFF_KN;
  float* ws = (float*)(lds + OFF_WS) + wid * 64; float* li_l = ws; float* al_l = ws + 32;
  float* bias_l = (float*)(lds + OFF_BIAS);
  const int r0 = rg * 4, rq = r0 + (wid >> 1), cq = 32 * (wid & 1) + r32;
  const int rs_w = min(max(rq - 4, 0), 120), cs = min(max(cq - 8, 0), 48);
  const int kr_lo = min(max(r0 - 4, 0), 120), kr_hi = min(max(r0 + 3 - 4, 0), 120) + 7, NT = kr_hi - kr_lo + 1;
  const long rowbase = (long)b * SEQ;
  float m_reg = -1e30f, l_reg = 0; f32x16 o[4] = {}; bf16x8 qr[8];
  const bf16_t* Qw = Q + (rowbase + rq * 64 + cq) * 2048 + h * 128 + hi * 8;
#pragma unroll
  for (int d0 = 0; d0 < 8; ++d0) qr[d0] = ld8(Qw + d0 * 16);
  const bf16_t* Kh = K + rowbase * 2048 + h * 128; const bf16_t* Vh = V + rowbase * 2048 + h * 128;
  const int sr = tid >> 4, sc = (tid & 15) * 8, vst0 = v_st(sr, sc), vst1 = v_st(32 + sr, sc);
  const int vb0 = (int)(uintptr_t)V_lds + v_rd_base(lane);
  __syncthreads();
  if (tid < 465) bias_l[tid] = rpb[h * 465 + tid] * 1.4426950408889634f;
  bf16x8 vs0, vs1, ks0, ks1;
#define NLOAD(k0) do { vs0 = ld8(&Vh[(long)((k0) + sr) * 2048 + sc]); vs1 = ld8(&Vh[(long)((k0) + 32 + sr) * 2048 + sc]); \
    ks0 = ld8(&Kh[(long)((k0) + sr) * 2048 + sc]); ks1 = ld8(&Kh[(long)((k0) + 32 + sr) * 2048 + sc]); } while (0)
#define NWRITE(bb) do { *(bf16x8*)(V_lds + (bb) * SHM_V + vst0) = vs0; *(bf16x8*)(V_lds + (bb) * SHM_V + vst1) = vs1; const int kc = sc * 2; \
    *(bf16x8*)(Kn_lds + (bb) * SHM_KN + KSWZ(sr, kc)) = ks0; *(bf16x8*)(Kn_lds + (bb) * SHM_KN + KSWZ(32 + sr, kc)) = ks1; } while (0)
  NLOAD(kr_lo * 64);
  for (int i = 0; i < NT; ++i) {
    const int kr = kr_lo + i, bb = i & 1;
    NWRITE(bb);
    if (i + 1 < NT) NLOAD((kr + 1) * 64);
    __syncthreads();
    if (kr >= rs_w && kr < rs_w + 8) {
      f32x16 p0, p1;
      qkt<0>(p0, p1, Kn_lds + bb * SHM_KN, nullptr, qr, nullptr, r32, hi);
      const float* brow = bias_l + (kr - rq + 7) * 31 + 15 - cq;
      float pmax = -1e30f;
#pragma unroll
      for (int r = 0; r < 16; ++r) { const int k0 = crow(r, hi), k1 = 32 + k0;
        const bool v0 = (k0 >= cs) && (k0 < cs + 16), v1 = (k1 >= cs) && (k1 < cs + 16);
        const float b0 = brow[v0 ? k0 : cq], b1 = brow[v1 ? k1 : cq];
        p0[r] = v0 ? p0[r] + b0 : -1e30f; p1[r] = v1 ? p1[r] + b1 : -1e30f;
        pmax = fmaxf(pmax, fmaxf(p0[r], p1[r])); }
      { auto rr = __builtin_amdgcn_permlane32_swap(__float_as_uint(pmax), __float_as_uint(pmax), false, false);
        pmax = fmaxf(__uint_as_float(rr[0]), __uint_as_float(rr[1])); }
      const float mn = fmaxf(m_reg, pmax), alpha = __builtin_amdgcn_exp2f(m_reg - mn); m_reg = mn;
#pragma unroll
      for (int r = 0; r < 16; ++r) { p0[r] = __builtin_amdgcn_exp2f(p0[r] - mn); p1[r] = __builtin_amdgcn_exp2f(p1[r] - mn); }
      float ps = 0;
#pragma unroll
      for (int r = 0; r < 16; ++r) ps += p0[r] + p1[r];
      { auto rr = __builtin_amdgcn_permlane32_swap(__float_as_uint(ps), __float_as_uint(ps), false, false);
        ps = __uint_as_float(rr[0]) + __uint_as_float(rr[1]); }
      l_reg = l_reg * alpha + ps;
      if (hi == 0) al_l[r32] = alpha; asm volatile("s_waitcnt lgkmcnt(0)" ::: "memory");
#pragma unroll
      for (int d = 0; d < 4; ++d)
#pragma unroll
        for (int r = 0; r < 16; ++r) o[d][r] *= al_l[crow(r, hi)];
      bf16x8 pa0, pa1, pa2, pa3;
      PK4(p0, 0, pa0); PK4(p0, 8, pa1); PK4(p1, 0, pa2); PK4(p1, 8, pa3);
      pv_d0(o, vb0 + bb * SHM_V, pa0, pa1, pa2, pa3);
    }
  }
  if (hi == 0) li_l[r32] = l_reg; asm volatile("s_waitcnt lgkmcnt(0)" ::: "memory");
  float rli[16];
#pragma unroll
  for (int r = 0; r < 16; ++r) rli[r] = __builtin_amdgcn_rcpf(li_l[crow(r, hi)]);
  bf16_t* Ow = O + (rowbase + rq * 64 + 32 * (wid & 1)) * 2048 + h * 128;
#pragma unroll
  for (int r = 0; r < 16; ++r) { const int orow = crow(r, hi);
#pragma unroll
    for (int d0 = 0; d0 < 4; ++d0) Ow[(long)orow * 2048 + d0 * 32 + r32] = (bf16_t)(cvtpk(o[d0][r] * rli[r], 0.f) & 0xffffu); }
#undef NLOAD
#undef NWRITE
}
#undef PK4
}

namespace peer {
#define PLAS __attribute__((address_space(3)))
using bf16x8 = __attribute__((ext_vector_type(8))) short;
using bf16x2 = __attribute__((ext_vector_type(2))) __bf16;
using f32x16 = __attribute__((ext_vector_type(16))) float;
using f32x4  = __attribute__((ext_vector_type(4))) float;
using u32x4  = __attribute__((ext_vector_type(4))) unsigned;
typedef unsigned short bf16_t;
__device__ __forceinline__ int f2ord(float f) { const int u = __float_as_int(f); return u ^ ((u >> 31) & 0x7fffffff); }
__device__ __forceinline__ float ord2f(int s) { return __int_as_float(s ^ ((s >> 31) & 0x7fffffff)); }
__device__ __forceinline__ int crow(int r, int hi) { return (r & 3) + 8 * (r >> 2) + 4 * hi; }
__device__ __forceinline__ unsigned cvtpk(float lo, float hi) { unsigned r; asm volatile("v_cvt_pk_bf16_f32 %0, %1, %2" : "=v"(r) : "v"(lo), "v"(hi)); return r; }
__device__ __forceinline__ float bf_lo(unsigned w) { return __uint_as_float(w << 16); }
__device__ __forceinline__ float bf_hi(unsigned w) { return __uint_as_float(w & 0xffff0000u); }
__device__ __forceinline__ int swapmax(int m) { auto rr = __builtin_amdgcn_permlane32_swap((unsigned)m, (unsigned)m, false, false); const int a = (int)rr[0], b = (int)rr[1]; return a > b ? a : b; }

struct CandTab { int ci[50], cj[50]; };
constexpr CandTab make_cands() { CandTab t{}; int n = 0; for (int i = 0; i < 16; ++i) for (int j = 0; j < 16; ++j) if ((i + 1) * (j + 1) <= 16) { t.ci[n] = i; t.cj[n] = j; ++n; } return t; }
constexpr CandTab CT = make_cands();

constexpr int SEL_LDS_PER_WAVE = (2 * 16 + 16) * 64 * 4;

__device__ __forceinline__ void select32(int t0, const float* __restrict__ QP, const bf16_t* __restrict__ SUBH, const bf16_t* __restrict__ SUBL, int* __restrict__ IDX, float* __restrict__ GATE, PLAS int* wl, int lane_) {
  int lane = lane_; asm volatile("" : "+v"(lane));
  const int r32 = lane & 31, hi = lane >> 5;
  PLAS int* topl = wl; PLAS int* winl = wl + 2 * 16 * 64;
  const float* qrow = QP + (size_t)(t0 + r32) * 2048;
#pragma unroll 1
  for (int h = 0; h < 8; ++h) {
#pragma unroll 1
    for (int p = 0; p < 2; ++p) {
      bf16x8 qh[8], ql[8];
      const float* qp = qrow + h * 256 + p * 128 + hi * 8;
#pragma unroll
      for (int d0 = 0; d0 < 8; ++d0) {
        const f32x4 a = *(const f32x4*)(qp + d0 * 16), b = *(const f32x4*)(qp + d0 * 16 + 4);
        u32x4 wh, wlw;
        wh.x = cvtpk(a[0], a[1]); wh.y = cvtpk(a[2], a[3]); wh.z = cvtpk(b[0], b[1]); wh.w = cvtpk(b[2], b[3]);
        wlw.x = cvtpk(a[0] - bf_lo(wh.x), a[1] - bf_hi(wh.x)); wlw.y = cvtpk(a[2] - bf_lo(wh.y), a[3] - bf_hi(wh.y));
        wlw.z = cvtpk(b[0] - bf_lo(wh.z), b[1] - bf_hi(wh.z)); wlw.w = cvtpk(b[2] - bf_lo(wh.w), b[3] - bf_hi(wh.w));
        qh[d0] = *reinterpret_cast<bf16x8*>(&wh); ql[d0] = *reinterpret_cast<bf16x8*>(&wlw);
      }
      const size_t soff = ((size_t)(h * 2 + p) * 128 + r32) * 128 + hi * 8;
      int key[64];
#pragma unroll
      for (int kb = 0; kb < 4; ++kb) {
        f32x16 acc = f32x16{};
#pragma unroll
        for (int d0 = 0; d0 < 8; ++d0) {
          const bf16x8 ah = *reinterpret_cast<const bf16x8*>(SUBH + soff + (size_t)kb * 32 * 128 + d0 * 16);
          const bf16x8 al = *reinterpret_cast<const bf16x8*>(SUBL + soff + (size_t)kb * 32 * 128 + d0 * 16);
          acc = __builtin_amdgcn_mfma_f32_32x32x16_bf16(ah, qh[d0], acc, 0, 0, 0);
          acc = __builtin_amdgcn_mfma_f32_32x32x16_bf16(ah, ql[d0], acc, 0, 0, 0);
          acc = __builtin_amdgcn_mfma_f32_32x32x16_bf16(al, qh[d0], acc, 0, 0, 0);
        }
#pragma unroll
        for (int r = 0; r < 16; ++r) key[kb * 16 + r] = (f2ord(acc[r]) & ~127) | (kb * 32 + crow(r, hi));
      }
#pragma unroll 1
      for (int it = 0; it < 16; ++it) {
        int m = key[0];
#pragma unroll
        for (int i = 1; i < 64; ++i) m = key[i] > m ? key[i] : m;
        const int gm = swapmax(m);
        topl[(p * 16 + it) * 64 + lane] = gm;
#pragma unroll
        for (int i = 0; i < 64; ++i) key[i] = (key[i] == gm) ? (int)0x80000000 : key[i];
      }
    }
    int ck[25];
#pragma unroll
    for (int c = 0; c < 25; ++c) {
      const int i = hi ? CT.ci[2 * c + 1] : CT.ci[2 * c], j = hi ? CT.cj[2 * c + 1] : CT.cj[2 * c];
      const int k0 = topl[i * 64 + lane], k1 = topl[(16 + j) * 64 + lane];
      const float s = ord2f(k0 & ~127) + ord2f(k1 & ~127);
      ck[c] = (f2ord(s) & ~255) | (i << 4) | j;
    }
#pragma unroll 1
    for (int it = 0; it < 16; ++it) {
      int m = ck[0];
#pragma unroll
      for (int i = 1; i < 25; ++i) m = ck[i] > m ? ck[i] : m;
      const int gm = swapmax(m);
      winl[it * 64 + lane] = gm;
#pragma unroll
      for (int i = 0; i < 25; ++i) ck[i] = (ck[i] == gm) ? (int)0x80000000 : ck[i];
    }
    float e[16]; int wv[16]; float tot = 0.f;
    const float s0 = ord2f(winl[lane] & ~255);
#pragma unroll
    for (int k = 0; k < 16; ++k) { wv[k] = winl[k * 64 + lane]; e[k] = __builtin_amdgcn_exp2f((ord2f(wv[k] & ~255) - s0) * 1.4426950408889634f); tot += e[k]; }
    const float rtot = 1.0f / tot;
    const size_t ob = (size_t)(t0 + r32) * 128 + h * 16 + hi * 8;
#pragma unroll
    for (int k = 0; k < 8; ++k) {
      const int w = hi ? wv[8 + k] : wv[k]; const float ev = hi ? e[8 + k] : e[k];
      const int i = (w >> 4) & 15, j = w & 15;
      const int e0 = topl[i * 64 + lane] & 127, e1 = topl[(16 + j) * 64 + lane] & 127;
      IDX[ob + k] = e0 * 128 + e1; GATE[ob + k] = ev * rtot;
    }
  }
}

__device__ __forceinline__ float dot2(unsigned w, unsigned x, float acc) { return __builtin_amdgcn_fdot2_f32_bf16(__builtin_bit_cast(bf16x2, w), __builtin_bit_cast(bf16x2, x), acc, false); }
__device__ __forceinline__ float gelu_erf(float v) {
  const float av = fabsf(v), d = av * 0.2316418882f + 1.0f, t = __builtin_amdgcn_rcpf(d);
  float q = t * 0.5307027145f + (-0.7265760135f); q = q * t + 0.7107068705f; q = q * t + (-0.142248368f); q = q * t + 0.127414796f; q = q * t;
  const float e = __builtin_amdgcn_exp2f((v * v) * (-0.72134752044f));
  const float m = v * (q * e);
  return v < 0.f ? m : v - m;
}
__device__ __forceinline__ float wave_sum(float v) {
#pragma unroll
  for (int o = 1; o < 64; o <<= 1) v += __shfl_xor(v, o);
  return v;
}

__device__ __forceinline__ void expert_token(int t, const bf16_t* __restrict__ H2, const bf16_t* __restrict__ U, const bf16_t* __restrict__ V, const int* __restrict__ IDX, const float* __restrict__ GATE,
                                             float* X1OUT, const float* __restrict__ fnorm, int lane_) {
  int lane = lane_; asm volatile("" : "+v"(lane));
  const u32x4* hp = (const u32x4*)(H2 + (size_t)t * 4096) + lane;
  u32x4 hq[8];
#pragma unroll
  for (int k = 0; k < 8; ++k) hq[k] = hp[64 * k];
  const int e0 = IDX[(size_t)t * 128 + lane], e1 = IDX[(size_t)t * 128 + 64 + lane];
  const float g0 = GATE[(size_t)t * 128 + lane], g1 = GATE[(size_t)t * 128 + 64 + lane];
  float c0 = 0.f, c1 = 0.f;
  u32x4 ra[8], rb[8];
#define ELOAD(dst, tab, j) do { const int jj_ = (j); const int e_ = __builtin_amdgcn_readlane(jj_ < 64 ? e0 : e1, jj_ & 63); \
    const u32x4* rp_ = (const u32x4*)((tab) + (size_t)e_ * 4096) + lane; _Pragma("unroll") for (int k = 0; k < 8; ++k) dst[k] = rp_[64 * k]; asm volatile("" ::: "memory"); __builtin_amdgcn_sched_barrier(0); } while (0)
  ELOAD(ra, U, 0); ELOAD(rb, U, 1);
#pragma unroll 1
  for (int g = 0; g < 16; ++g) {
    float p[8];
#pragma unroll
    for (int i = 0; i < 8; ++i) {
      const int j = g * 8 + i;
      float a0 = 0.f, a1 = 0.f, a2 = 0.f, a3 = 0.f;
      if ((i & 1) == 0) {
#pragma unroll
        for (int k = 0; k < 8; ++k) { a0 = dot2(ra[k].x, hq[k].x, a0); a1 = dot2(ra[k].y, hq[k].y, a1); a2 = dot2(ra[k].z, hq[k].z, a2); a3 = dot2(ra[k].w, hq[k].w, a3); }
        ELOAD(ra, U, (j + 2) & 127);
      } else {
#pragma unroll
        for (int k = 0; k < 8; ++k) { a0 = dot2(rb[k].x, hq[k].x, a0); a1 = dot2(rb[k].y, hq[k].y, a1); a2 = dot2(rb[k].z, hq[k].z, a2); a3 = dot2(rb[k].w, hq[k].w, a3); }
        ELOAD(rb, U, (j + 2) & 127);
      }
      p[i] = (a0 + a1) + (a2 + a3);
    }
    float q4[4], q2[2], q1;
    { const bool up = (lane & 32) != 0;
#pragma unroll
      for (int i = 0; i < 4; ++i) { const float send = up ? p[i] : p[4 + i], keep = up ? p[4 + i] : p[i]; q4[i] = keep + __shfl_xor(send, 32); } }
    { const bool up = (lane & 16) != 0;
#pragma unroll
      for (int i = 0; i < 2; ++i) { const float send = up ? q4[i] : q4[2 + i], keep = up ? q4[2 + i] : q4[i]; q2[i] = keep + __shfl_xor(send, 16); } }
    { const bool up = (lane & 8) != 0; const float send = up ? q2[0] : q2[1], keep = up ? q2[1] : q2[0]; q1 = keep + __shfl_xor(send, 8); }
    q1 += __shfl_xor(q1, 4); q1 += __shfl_xor(q1, 2); q1 += __shfl_xor(q1, 1);
    const float got = __shfl(q1, 8 * (lane & 7));
    if ((lane >> 3) == (g & 7)) { if (g < 8) c0 = got; else c1 = got; }
  }
  c0 = g0 * gelu_erf(c0); c1 = g1 * gelu_erf(c1);
  ELOAD(ra, V, 0); ELOAD(rb, V, 1);
  float acc[64];
#pragma unroll
  for (int i = 0; i < 64; ++i) acc[i] = 0.f;
#define VROW(R, C) do { _Pragma("unroll") for (int k = 0; k < 8; ++k) { acc[8 * k + 0] += (C) * bf_lo(R[k].x); acc[8 * k + 1] += (C) * bf_hi(R[k].x); acc[8 * k + 2] += (C) * bf_lo(R[k].y); acc[8 * k + 3] += (C) * bf_hi(R[k].y); \
    acc[8 * k + 4] += (C) * bf_lo(R[k].z); acc[8 * k + 5] += (C) * bf_hi(R[k].z); acc[8 * k + 6] += (C) * bf_lo(R[k].w); acc[8 * k + 7] += (C) * bf_hi(R[k].w); } } while (0)
#pragma unroll 1
  for (int j = 0; j < 128; j += 2) {
    { const float c = __int_as_float(__builtin_amdgcn_readlane(__float_as_int(j < 64 ? c0 : c1), j & 63)); VROW(ra, c); __builtin_amdgcn_sched_barrier(0); ELOAD(ra, V, (j + 2) & 127); }
    { const float c = __int_as_float(__builtin_amdgcn_readlane(__float_as_int(j < 64 ? c0 : c1), (j + 1) & 63)); VROW(rb, c); __builtin_amdgcn_sched_barrier(0); ELOAD(rb, V, (j + 3) & 127); }
  }
#undef VROW
#undef ELOAD
  float* xr = X1OUT + (size_t)t * 4096 + 8 * lane; float ss = 0.f;
#ifdef PROBE_PEER_SCALE
#pragma unroll
  for (int i = 0; i < 64; ++i) acc[i] *= PROBE_PEER_SCALE;
#endif
#pragma unroll
  for (int k = 0; k < 8; ++k) { const f32x4 a = *(const f32x4*)(xr + 512 * k), b = *(const f32x4*)(xr + 512 * k + 4);
    acc[8 * k + 0] += a[0]; acc[8 * k + 1] += a[1]; acc[8 * k + 2] += a[2]; acc[8 * k + 3] += a[3]; acc[8 * k + 4] += b[0]; acc[8 * k + 5] += b[1]; acc[8 * k + 6] += b[2]; acc[8 * k + 7] += b[3]; }
#pragma unroll
  for (int i = 0; i < 64; ++i) ss += acc[i] * acc[i];
  const float rstd = 1.0f / sqrtf(wave_sum(ss) * (1.0f / 4096.0f) + 1e-6f);
  int fo_ = 8 * lane; asm volatile("" : "+v"(fo_)); const float* fn = fnorm + fo_;
#pragma unroll
  for (int k = 0; k < 8; ++k) { const f32x4 ga = *(const f32x4*)(fn + 512 * k), gb = *(const f32x4*)(fn + 512 * k + 4);
    f32x4 oa, ob; oa[0] = acc[8 * k + 0] * rstd * ga[0]; oa[1] = acc[8 * k + 1] * rstd * ga[1]; oa[2] = acc[8 * k + 2] * rstd * ga[2]; oa[3] = acc[8 * k + 3] * rstd * ga[3];
    ob[0] = acc[8 * k + 4] * rstd * gb[0]; ob[1] = acc[8 * k + 5] * rstd * gb[1]; ob[2] = acc[8 * k + 6] * rstd * gb[2]; ob[3] = acc[8 * k + 7] * rstd * gb[3];
    *(f32x4*)(xr + 512 * k) = oa; *(f32x4*)(xr + 512 * k + 4) = ob; }
}
#undef PLAS
}

constexpr int BATCH = 2, SEQ = 8192, DM = 4096, T = BATCH * SEQ;
constexpr int NCAT = 15872;
constexpr int NPH = 12;
#ifndef MK_CUTS
#define MK_CUTS 1
#endif
constexpr float EPS = 1e-6f;
constexpr float LOG2E = 1.4426950408889634f;
constexpr float MLA_QSCALE = 0.07216878364870322f * LOG2E;
constexpr float NA_QSCALE = 0.08838834764831845f * LOG2E;

constexpr size_t MiB = 1u << 20;
constexpr size_t WS_CTL = 0, CTL_ZERO_BYTES = 1 * MiB;
constexpr size_t WS_ROPE = 1 * MiB;
constexpr size_t WS_RS = 1 * MiB + 65536;
constexpr size_t WS_WCAT = 2 * MiB;
constexpr size_t WS_WUQ = WS_WCAT + 124 * MiB;
constexpr size_t WS_WUKV = WS_WUQ + 5 * MiB;
constexpr size_t WS_PA = WS_WUKV + 4 * MiB;
constexpr size_t WS_PB = WS_PA + 16 * MiB;
constexpr size_t WS_WOUT = WS_PB + 16 * MiB;
constexpr size_t WS_WQ = WS_WOUT + 32 * MiB;
constexpr size_t WS_SUBH = WS_WQ + 16 * MiB;
constexpr size_t WS_SUBL = WS_SUBH + 512 * 1024;
constexpr size_t WS_R1 = WS_SUBL + 512 * 1024;
constexpr size_t WS_LAT = WS_R1 + 128 * MiB;
constexpr size_t WS_R2 = WS_LAT + 48 * MiB;
constexpr size_t WS_R3 = WS_R2 + 192 * MiB;
constexpr size_t WS_R4 = WS_R3 + 256 * MiB;
constexpr size_t WS_KR = WS_R4 + 224 * MiB;
constexpr size_t WS_IDX = WS_KR + 2 * MiB;
constexpr size_t WS_GATE = WS_IDX + 8 * MiB;
constexpr size_t WS_END = WS_GATE + 8 * MiB;
constexpr int CW_TMO = 0, CW_BAR = 4096;

constexpr int RING_BYTES = 131072, LDSCTL_OFF = RING_BYTES, MISC_OFF = LDSCTL_OFF + 320, LDS_BYTES = 147456;
constexpr int NWAVES = 8;

#define GAS __attribute__((address_space(1)))
#define LAS __attribute__((address_space(3)))
typedef unsigned short bf16;
typedef unsigned v4u __attribute__((ext_vector_type(4)));
typedef float f32x4 __attribute__((ext_vector_type(4)));
typedef float f32x8 __attribute__((ext_vector_type(8)));
typedef GAS unsigned gu32;
#define RLX_AGENT __ATOMIC_RELAXED, __HIP_MEMORY_SCOPE_AGENT
#define LDS_WAIT() asm volatile("s_waitcnt lgkmcnt(0)" ::: "memory")
#define VM_WAIT() asm volatile("s_waitcnt vmcnt(0)" ::: "memory")
__device__ __forceinline__ unsigned pkbf(float lo, float hi) { unsigned r; asm volatile("v_cvt_pk_bf16_f32 %0, %1, %2" : "=v"(r) : "v"(lo), "v"(hi)); return r; }

#define XB_TMO      128
#define XB_XCNT(j)  (256  + 64 * (j))
#define XB_XSUB(j)  (1280 + 64 * (j))
#define XB_XGEN(j)  (2304 + 64 * (j))
#define XB_TOP      3328
#define XB_TOPGEN   3392
#define XCD_BAR_WORDS 3456
#define XB_SPIN_CAP (1u << 22)
__device__ __forceinline__ unsigned xb_ld(unsigned* p)              { return __hip_atomic_load(p, __ATOMIC_RELAXED, __HIP_MEMORY_SCOPE_AGENT); }
__device__ __forceinline__ unsigned xb_add(unsigned* p, unsigned v) { return __hip_atomic_fetch_add(p, v, __ATOMIC_RELAXED, __HIP_MEMORY_SCOPE_AGENT); }
__device__ __forceinline__ unsigned xb_xcc_id() { return (unsigned)__builtin_amdgcn_s_getreg((3 << 11) | 20) & 0xFu; }
#define XB_SPIN(cond, bar) do { unsigned _sp = 0; while (cond) { __builtin_amdgcn_s_sleep(1); \
    if ((++_sp & 255u) == 0u) { if (xb_ld(&(bar)[XB_TMO])) break; if (_sp > XB_SPIN_CAP) { atomicAdd(&(bar)[XB_TMO], 1u); break; } } } } while (0)
struct XcdBarrier { unsigned* bar; unsigned x; volatile LAS unsigned* st; };
__device__ __forceinline__ XcdBarrier xcd_barrier_post(unsigned* bar, volatile LAS unsigned* st) {
    XcdBarrier b; b.bar = bar; b.x = xb_xcc_id(); b.st = st;
    if (threadIdx.x == 0) (void)xb_add(&bar[XB_XCNT(b.x)], 1u);
    return b;
}
__device__ __forceinline__ void xcd_barrier_complete(unsigned* bar, unsigned x, unsigned& nloc, unsigned& nx) {
    const unsigned G = gridDim.x * gridDim.y * gridDim.z;
    unsigned sum, cnt, mine, sp = 0u;
    for (;;) {
        sum = 0u; cnt = 0u; mine = 0u;
#pragma unroll
        for (unsigned j = 0; j < 16; ++j) { const unsigned c = xb_ld(&bar[XB_XCNT(j)]); sum += c; cnt += (c > 0u) ? 1u : 0u; mine = (j == x) ? c : mine; }
        if (sum == G) break;
        __builtin_amdgcn_s_sleep(1);
        if ((++sp & 255u) == 0u) { if (xb_ld(&bar[XB_TMO])) break; if (sp > XB_SPIN_CAP) { atomicAdd(&bar[XB_TMO], 1u); break; } }
    }
    nloc = mine > 0u ? mine : 1u; nx = cnt > 0u ? cnt : 1u;
}
__device__ __forceinline__ void xcd_barrier(const XcdBarrier& b) {
    asm volatile("s_waitcnt vmcnt(0)" ::: "memory");
    __syncthreads();
    if (threadIdx.x == 0) {
        unsigned* bar = b.bar;
        __builtin_amdgcn_s_waitcnt(0);
        unsigned nloc = b.st[0], nx = b.st[1];
        if (nloc == 0u) { xcd_barrier_complete(bar, b.x, nloc, nx); b.st[0] = nloc; b.st[1] = nx; }
        const unsigned old = xb_add(&bar[XB_XSUB(b.x)], 1u);
        const unsigned gen = old / nloc;
        if (old + 1u == (gen + 1u) * nloc) {
            __builtin_amdgcn_fence(__ATOMIC_RELEASE, "agent");
            asm volatile("s_waitcnt vmcnt(0)" ::: "memory");
            const unsigned og = xb_add(&bar[XB_TOP], 1u);
            const unsigned tg = og / nx;
            if (og + 1u == (tg + 1u) * nx) xb_add(&bar[XB_TOPGEN], 1u);
            else XB_SPIN(xb_ld(&bar[XB_TOPGEN]) == tg, bar);
            __builtin_amdgcn_fence(__ATOMIC_ACQUIRE, "agent");
            xb_add(&bar[XB_XGEN(b.x)], 1u);
            asm volatile("s_waitcnt vmcnt(0)" ::: "memory");
        } else {
            XB_SPIN(xb_ld(&bar[XB_XGEN(b.x)]) == gen, bar);
            __builtin_amdgcn_fence(__ATOMIC_ACQUIRE, "agent");
            asm volatile("s_waitcnt vmcnt(0)" ::: "memory");
        }
    }
    __syncthreads();
}

__device__ __forceinline__ float wave_sum(float v) {
#pragma unroll
    for (int o = 1; o < 64; o <<= 1) v += __shfl_xor(v, o);
    return v;
}
__device__ __forceinline__ void transpose_item(const float* W, int N, bf16* WT, int ldt, int row_off, const float* gk, LAS float* scr, int kb, int nb, int lane) {
    const int k0 = 64 * kb, n0 = 32 * nb;
#pragma unroll 8
    for (int i = 0; i < 32; ++i) { const int kk = 2 * i + (lane >> 5); float w = W[(size_t)(k0 + kk) * N + n0 + (lane & 31)]; if (gk) w *= gk[k0 + kk]; scr[kk * 33 + (lane & 31)] = w; }
    LDS_WAIT(); asm volatile("" ::: "memory");
    const int c = lane & 7;
#pragma unroll
    for (int j = 0; j < 4; ++j) { const int n = (lane >> 3) + 8 * j; const LAS float* s = scr + (8 * c) * 33 + n;
        v4u o; o.x = pkbf(s[0 * 33], s[1 * 33]); o.y = pkbf(s[2 * 33], s[3 * 33]); o.z = pkbf(s[4 * 33], s[5 * 33]); o.w = pkbf(s[6 * 33], s[7 * 33]);
        *(GAS v4u*)(WT + (size_t)(row_off + n0 + n) * ldt + k0 + 8 * c) = o; }
    LDS_WAIT(); asm volatile("" ::: "memory");
}
__device__ __forceinline__ void rms_row_to_bf16(const float* xrow, const float* gain, bf16* orow, int lane) {
    const GAS f32x4* xr = (const GAS f32x4*)xrow + lane; const GAS f32x4* gr = (const GAS f32x4*)gain + lane;
    f32x4 v[16]; float s = 0.f;
#pragma unroll
    for (int j = 0; j < 16; ++j) { v[j] = xr[64 * j]; s += (v[j].x * v[j].x + v[j].y * v[j].y) + (v[j].z * v[j].z + v[j].w * v[j].w); }
    const float rstd = 1.f / sqrtf(wave_sum(s) * (1.f / DM) + EPS);
    GAS unsigned long long* o8 = (GAS unsigned long long*)orow + lane;
#pragma unroll
    for (int j = 0; j < 16; ++j) { const f32x4 g = gr[64 * j];
        o8[64 * j] = (unsigned long long)pkbf(v[j].x * rstd * g.x, v[j].y * rstd * g.y) | ((unsigned long long)pkbf(v[j].z * rstd * g.z, v[j].w * rstd * g.w) << 32); }
}

struct Args {
    const float* in[19]; float* out; unsigned char* ws; int ph_lo, ph_hi, use_bar, pad;
};

__global__ void __launch_bounds__(NWAVES * 64, 2) mk_fwd(Args args) {
    extern __shared__ __attribute__((aligned(16))) unsigned char lds[];
    LAS unsigned char* ldsl = (LAS unsigned char*)lds;
    volatile LAS unsigned* MISC = (volatile LAS unsigned*)(ldsl + MISC_OFF);
    const int tid = threadIdx.x, lane = tid & 63, wave = __builtin_amdgcn_readfirstlane(tid >> 6);
    const int G = gridDim.x, bx = blockIdx.x;
    const int vcu = (G % 8 == 0) ? (bx % 8) * (G / 8) + bx / 8 : bx;
    const int gw = vcu * NWAVES + wave, NGW = G * NWAVES;
    unsigned char* ws = args.ws;
    gu32* ctl = (gu32*)(ws + WS_CTL);
    const float* x = args.in[0]; const float* attn_norm = args.in[1]; const float* w_in = args.in[2]; const float* q_norm = args.in[3]; const float* w_uq = args.in[4];
    const float* kv_norm = args.in[5]; const float* w_ukv = args.in[6]; const float* w_bmla = args.in[7]; const float* na_rpb = args.in[8]; const float* w_bna = args.in[9];
    const float* w_gate = args.in[10]; const float* b_gate = args.in[11]; const float* w_out = args.in[12]; const float* ffn_norm = args.in[13]; const float* peer_wq = args.in[14];
    const float* peer_sub = args.in[15]; const float* peer_u = args.in[16]; const float* peer_v = args.in[17]; const float* final_norm = args.in[18];
    float* out = args.out;
    float* ROPE = (float*)(ws + WS_ROPE); float* RS = (float*)(ws + WS_RS);
    bf16* WCAT = (bf16*)(ws + WS_WCAT); bf16* WUQ = (bf16*)(ws + WS_WUQ); bf16* WUKV = (bf16*)(ws + WS_WUKV); bf16* PA = (bf16*)(ws + WS_PA); bf16* PB = (bf16*)(ws + WS_PB);
    bf16* WOUT = (bf16*)(ws + WS_WOUT); bf16* WQ = (bf16*)(ws + WS_WQ); bf16* SUBH = (bf16*)(ws + WS_SUBH); bf16* SUBL = (bf16*)(ws + WS_SUBL);
    bf16* XN = (bf16*)(ws + WS_R1); bf16* OA = (bf16*)(ws + WS_R1); bf16* OB = (bf16*)(ws + WS_R1 + 64 * MiB); bf16* H2 = (bf16*)(ws + WS_R1);
    bf16* LAT = (bf16*)(ws + WS_LAT);
    bf16* NAQ = (bf16*)(ws + WS_R2); bf16* NAK = (bf16*)(ws + WS_R2 + 64 * MiB); bf16* NAV = (bf16*)(ws + WS_R2 + 128 * MiB); bf16* MRG = (bf16*)(ws + WS_R2);
    bf16* GT = (bf16*)(ws + WS_R3); bf16* UB = (bf16*)(ws + WS_R3); bf16* VB = (bf16*)(ws + WS_R3 + 128 * MiB);
    bf16* QM = (bf16*)(ws + WS_R4); bf16* KN = (bf16*)(ws + WS_R4 + 96 * MiB); bf16* VM = (bf16*)(ws + WS_R4 + 160 * MiB); float* QP = (float*)(ws + WS_R4);
    bf16* KR = (bf16*)(ws + WS_KR); int* IDX = (int*)(ws + WS_IDX); float* GATE = (float*)(ws + WS_GATE);

    for (int u = tid; u < (LDS_BYTES - LDSCTL_OFF) / 4; u += NWAVES * 64) ((LAS unsigned*)(ldsl + LDSCTL_OFF))[u] = 0u;
    __syncthreads();
    XcdBarrier bar; bar.bar = (unsigned*)(ctl + CW_BAR); bar.x = 0; bar.st = nullptr;
    if (args.use_bar) bar = xcd_barrier_post((unsigned*)(ctl + CW_BAR), MISC + 8);
    const int lo = args.ph_lo, hi = args.ph_hi;
#ifndef MK_PHMASK
#define MK_PHMASK 0xFFF
#endif
#define IN(k) (((MK_PHMASK >> (k)) & 1) && lo <= (k) && (k) < hi)
#define SEAM(k) do { if (IN(k) && IN((k) + 1)) xcd_barrier(bar); } while (0)

    if (IN(0)) {
        LAS float* scr = (LAS float*)(ldsl + wave * 16384);
        constexpr int I0 = 64 * 234, I1 = 64 * 256, I2 = 12 * 96, I3 = 8 * 128, I4 = 32 * 128, I5 = 32 * 128, I6 = 64 * 128, I7 = 64 * 64;
        constexpr int NITEMS = I0 + I1 + I2 + I3 + I4 + I5 + I6 + I7;
        for (int it = gw; it < NITEMS; it += NGW) {
            int r = it;
            if (r < I0) { const int kb = r / 234, nb = r % 234; const int off = (nb >= 42) ? 192 : 0; transpose_item(w_in, 7488, WCAT, 4096, off, nullptr, scr, kb, nb, lane); continue; } r -= I0;
            if (r < I1) { transpose_item(w_gate, 8192, WCAT, 4096, 7680, nullptr, scr, r / 256, r % 256, lane); continue; } r -= I1;
            if (r < I2) { transpose_item(w_uq, 3072, WUQ, 768, 0, q_norm, scr, r / 96, r % 96, lane); continue; } r -= I2;
            if (r < I3) { transpose_item(w_ukv, 4096, WUKV, 512, 0, kv_norm, scr, r / 128, r % 128, lane); continue; } r -= I3;
            if (r < I4) { transpose_item(w_bmla, 4096, PA, 2048, 0, nullptr, scr, r / 128, r % 128, lane); continue; } r -= I4;
            if (r < I5) { transpose_item(w_bna, 4096, PB, 2048, 0, nullptr, scr, r / 128, r % 128, lane); continue; } r -= I5;
            if (r < I6) { transpose_item(w_out, 4096, WOUT, 4096, 0, nullptr, scr, r / 128, r % 128, lane); continue; } r -= I6;
            transpose_item(peer_wq, 2048, WQ, 4096, 0, nullptr, scr, r / 64, r % 64, lane);
        }
        for (int i = gw * 64 + lane; i < 192 * 4096 / 8; i += NGW * 64) ((GAS v4u*)(WCAT + (size_t)1344 * 4096))[i] = (v4u){0u, 0u, 0u, 0u};
        for (int i = gw * 64 + lane; i < 8 * 2 * 128 * 128 / 2; i += NGW * 64) { const float a = peer_sub[2 * i], b = peer_sub[2 * i + 1];
            const unsigned h = pkbf(a, b); const unsigned l = pkbf(a - __uint_as_float(h << 16), b - __uint_as_float(h & 0xffff0000u));
            ((GAS unsigned*)SUBH)[i] = h; ((GAS unsigned*)SUBL)[i] = l; }
        for (int i = gw * 64 + lane; i < 128 * 16; i += NGW * 64) { const int pos = i >> 4, j = i & 15; const float fr = powf(10000.0f, -(float)j / 16.0f); const float ang = (float)pos * fr;
            ROPE[2 * i] = cosf(ang); ROPE[2 * i + 1] = sinf(ang); }
        for (int m = gw; m < T; m += NGW) rms_row_to_bf16(x + (size_t)m * DM, attn_norm, XN + (size_t)m * DM, lane);
    }
    SEAM(0);
    if (IN(1)) {
        pg8::Gemm g{XN, WCAT, T, NCAT, DM, DM, DM}; pg8::StaticOrder S; S.init(T, NCAT, G, bx);
        pg8::EpiIn E{ws, WS_LAT, WS_R2, 64 * MiB, WS_R3, b_gate, NA_QSCALE};
        pg8::gemm_phase<pg8::EpiIn, pg8::StaticOrder>(ldsl, g, S, E);
    }
    SEAM(1);
    if (IN(2)) {
        for (int m = gw; m < T; m += NGW) {
            const bf16* row = LAT + (size_t)m * 1536;
            float sq = 0.f, skv = 0.f;
#pragma unroll
            for (int j = 0; j < 6; ++j) { const unsigned w = ((const GAS unsigned*)row)[lane + 64 * j]; const float a = __uint_as_float(w << 16), b = __uint_as_float(w & 0xffff0000u); sq += a * a + b * b; }
#pragma unroll
            for (int j = 0; j < 4; ++j) { const unsigned w = ((const GAS unsigned*)(row + 768))[lane + 64 * j]; const float a = __uint_as_float(w << 16), b = __uint_as_float(w & 0xffff0000u); skv += a * a + b * b; }
            sq = wave_sum(sq); skv = wave_sum(skv);
            if (lane == 0) { RS[2 * m] = 1.f / sqrtf(sq * (1.f / 768.f) + EPS); RS[2 * m + 1] = 1.f / sqrtf(skv * (1.f / 512.f) + EPS); }
            const float xk = __uint_as_float((unsigned)row[1280 + lane] << 16);
            const float xp = __shfl_xor(xk, 16);
            const int s = m & (SEQ - 1), pos = (lane < 32) ? (s >> 6) : (s & 63), j = lane & 15;
            const float c = ROPE[(pos * 16 + j) * 2], sn = ROPE[(pos * 16 + j) * 2 + 1];
            const float o = ((lane & 16) == 0) ? (xk * c - xp * sn) : (xp * sn + xk * c);
            KR[(size_t)m * 64 + lane] = (bf16)(pkbf(o, 0.f) & 0xffffu);
        }
    }
    SEAM(2);
    if (IN(3)) {
        { pg8::Gemm g{LAT, WUQ, T, 3072, 768, 1536, 768}; pg8::StaticOrder S; S.init(T, 3072, G, bx);
          pg8::EpiQ E{QM, RS, ROPE, MLA_QSCALE};
          pg8::gemm_phase<pg8::EpiQ, pg8::StaticOrder>(ldsl, g, S, E); }
        { pg8::Gemm g{LAT + 768, WUKV, T, 4096, 512, 1536, 512}; pg8::StaticOrder S; S.init(T, 4096, G, bx);
          pg8::EpiKV E{KN, VM, RS};
          pg8::gemm_phase<pg8::EpiKV, pg8::StaticOrder>(ldsl, g, S, E); }
    }
    SEAM(3);
    if (IN(4)) {
#ifndef NO_MLA
#pragma unroll 1
        for (int u = vcu; u < BATCH * 16 * 32; u += G) { const int bh = u >> 5, qb = u & 31; att::mla_unit(bh >> 4, bh & 15, qb, QM, KN, KR, VM, OA, (char*)lds); }
#endif
#ifndef NO_NA
#pragma unroll 1
        for (int u = vcu; u < BATCH * 16 * 32; u += G) { const int bh = u >> 5, rg = u & 31; att::na_unit(bh >> 4, bh & 15, rg, NAQ, NAK, NAV, na_rpb, OB, (char*)lds); }
#endif
        __syncthreads();
    }
    SEAM(4);
    if (IN(5)) {
        { pg8::Gemm g{OA, PA, T, DM, 2048, 2048, 2048}; pg8::StaticOrder S; S.init(T, DM, G, bx);
          pg8::EpiGate<true> E{GT, MRG};
          pg8::gemm_phase<pg8::EpiGate<true>, pg8::StaticOrder>(ldsl, g, S, E); }
    }
    SEAM(5);
    if (IN(6)) {
        { pg8::Gemm g{OB, PB, T, DM, 2048, 2048, 2048}; pg8::StaticOrder S; S.init(T, DM, G, bx);
          pg8::EpiGate<false> E{GT, MRG};
          pg8::gemm_phase<pg8::EpiGate<false>, pg8::StaticOrder>(ldsl, g, S, E); }
    }
    SEAM(6);
    if (IN(7)) {
        pg8::Gemm g{MRG, WOUT, T, DM, DM, DM, DM}; pg8::StaticOrder S; S.init(T, DM, G, bx);
        pg8::EpiF32 E{x, out, DM};
        pg8::gemm_phase<pg8::EpiF32, pg8::StaticOrder>(ldsl, g, S, E);
#ifdef PROBE_SKIP_ATTN
        VM_WAIT(); __syncthreads();
        for (size_t i = (size_t)gw * 64 + lane; i < (size_t)T * DM / 4; i += (size_t)NGW * 64) ((GAS f32x4*)out)[i] = ((const GAS f32x4*)x)[i];
#endif
    }
    SEAM(7);
    if (IN(8)) {
        for (int m = gw; m < T; m += NGW) rms_row_to_bf16(out + (size_t)m * DM, ffn_norm, H2 + (size_t)m * DM, lane);
        const size_t n8 = (size_t)16384 * 4096 / 8;
        for (size_t i = (size_t)gw * 64 + lane; i < 2 * n8; i += (size_t)NGW * 64) {
            const bool isu = i < n8; const size_t j = isu ? i : i - n8;
            const f32x8 v = *(const f32x8*)((isu ? peer_u : peer_v) + j * 8);
            v4u o; o.x = pkbf(v[0], v[1]); o.y = pkbf(v[2], v[3]); o.z = pkbf(v[4], v[5]); o.w = pkbf(v[6], v[7]);
            *(GAS v4u*)((isu ? UB : VB) + j * 8) = o;
        }
    }
    SEAM(8);
    if (IN(9)) {
        pg8::Gemm g{H2, WQ, T, 2048, DM, DM, DM}; pg8::StaticOrder S; S.init(T, 2048, G, bx);
        pg8::EpiF32 E{nullptr, QP, 2048};
        pg8::gemm_phase<pg8::EpiF32, pg8::StaticOrder>(ldsl, g, S, E);
    }
    SEAM(9);
    if (IN(10)) {
        LAS int* wl = (LAS int*)(ldsl + wave * peer::SEL_LDS_PER_WAVE);
        for (int grp = gw; grp < T / 32; grp += NGW) peer::select32(grp * 32, QP, SUBH, SUBL, IDX, GATE, wl, lane);
    }
    SEAM(10);
    if (IN(11)) {
#ifdef PROBE_SKIP_PEER
        for (int t = gw; t < T; t += NGW) { float* xr = out + (size_t)t * DM; f32x4 v[16]; float ss = 0.f;
            for (int j = 0; j < 16; ++j) { v[j] = ((const GAS f32x4*)xr)[lane + 64 * j]; ss += v[j].x * v[j].x + v[j].y * v[j].y + v[j].z * v[j].z + v[j].w * v[j].w; }
            const float rstd = 1.f / sqrtf(wave_sum(ss) * (1.f / DM) + EPS);
            for (int j = 0; j < 16; ++j) { const f32x4 g = ((const GAS f32x4*)final_norm)[lane + 64 * j]; ((GAS f32x4*)xr)[lane + 64 * j] = v[j] * rstd * g; } }
#else
        for (int t = gw; t < T; t += NGW) peer::expert_token(t, H2, UB, VB, IDX, GATE, out, final_norm, lane);
#endif
    }
#undef IN
#undef SEAM
}

extern "C" void kernel_launch(void* const* d_in, const int* in_sizes, int n_in, void* d_out, int out_size, void* d_ws, size_t ws_size, hipStream_t stream) {
    static int grid = 0;
    if (grid == 0) {
        if (n_in != 19 || out_size != T * DM || ws_size < WS_END) { fprintf(stderr, "kernel_launch: shape mismatch: n_in %d out %d ws %zu (need %zu)\n", n_in, out_size, ws_size, (size_t)WS_END); grid = -1; return; }
        int dev = 0, cus = 0, per_cu = 0;
        if (hipGetDevice(&dev) != hipSuccess || hipDeviceGetAttribute(&cus, hipDeviceAttributeMultiprocessorCount, dev) != hipSuccess) { grid = -1; return; }
        if (hipFuncSetAttribute((const void*)mk_fwd, hipFuncAttributeMaxDynamicSharedMemorySize, LDS_BYTES) != hipSuccess) { fprintf(stderr, "kernel_launch: hipFuncSetAttribute failed\n"); grid = -1; return; }
        if (hipOccupancyMaxActiveBlocksPerMultiprocessor(&per_cu, (const void*)mk_fwd, NWAVES * 64, LDS_BYTES) != hipSuccess || per_cu < 1) { fprintf(stderr, "kernel_launch: occupancy query says %d blocks per CU\n", per_cu); }
        (void)hipGetLastError();
        grid = cus;
    }
    if (grid < 0) return;
    if (hipMemsetAsync((char*)d_ws + WS_CTL, 0, CTL_ZERO_BYTES, stream) != hipSuccess) return;
    Args a{};
    for (int i = 0; i < 19; ++i) a.in[i] = (const float*)d_in[i];
    a.out = (float*)d_out; a.ws = (unsigned char*)d_ws; a.pad = 0;
    constexpr int NL = MK_CUTS;
    for (int li = 0; li < NL; ++li) {
        a.ph_lo = (NL == 1) ? 0 : li; a.ph_hi = (NL == 1) ? NPH : li + 1; a.use_bar = (NL == 1) ? 1 : 0;
        hipLaunchKernelGGL(mk_fwd, dim3(grid), dim3(NWAVES * 64), LDS_BYTES, stream, a);
    }
}
```

```cpp
#include <hip/hip_runtime.h>
#include <hip/hip_bf16.h>
#include <cstdio>
#include <cstdint>

namespace pg8 {
#define PG8_LAS __attribute__((address_space(3)))
typedef unsigned short bf16_t;
typedef short bf16x8 __attribute__((ext_vector_type(8)));
typedef float f32x4 __attribute__((ext_vector_type(4)));
typedef float f32x2 __attribute__((ext_vector_type(2)));
typedef unsigned u32x4 __attribute__((ext_vector_type(4)));
typedef unsigned u32x2 __attribute__((ext_vector_type(2)));
constexpr int BM = 256, BK = 64, HALF = 128, HTB = HALF * BK * 2  , STAGE_BYTES = 8 * HTB, NXCD = 8, WGM = 8;

__host__ __device__ __forceinline__ int lds_byte(int r, int c) { const int st = (r >> 4) * 2 + (c >> 5), rr = r & 15, cc = c & 31, ob = rr * 64 + cc * 2; return st * 1024 + (ob ^ (((ob >> 9) & 1) << 5)); }
__host__ __device__ __forceinline__ void stage_rc(int b, int& R, int& C) { const int st = b / 1024, sb = b % 1024, swz = sb ^ (((sb >> 9) & 1) << 5); R = (st >> 1) * 16 + swz / 64; C = (st & 1) * 32 + (swz % 64) / 2; }
__host__ __device__ __forceinline__ int perm32(int rho) { const int n = rho >> 4, i = rho & 15; return 8 * (i >> 2) + 4 * n + (i & 3); }

struct Unit { int pm, pn; };
struct Gemm { const bf16_t* A; const bf16_t* Bt; int M, N, K, lda, ldb; };

struct StaticOrder {
    int nM, nN, nwg, G, c;
    __host__ __device__ void init(int M, int N, int G_, int c_) { nM = M / BM; nN = N / BM; nwg = nM * nN; G = G_; c = c_; }
    __host__ __device__ bool next(int i, Unit& u) const {
        const long L = (long)i * G + c; if (L >= nwg) return false;
        int wgid = (int)L; { const int q = nwg / NXCD, r = nwg % NXCD, xcd = wgid % NXCD, off = wgid / NXCD; wgid = (xcd < r ? xcd * (q + 1) : r * (q + 1) + (xcd - r) * q) + off; }
        const int nig = WGM * nN, gid = wgid / nig, fm = gid * WGM, gsz = (nM - fm) < WGM ? (nM - fm) : WGM;
        u.pm = fm + ((wgid % nig) % gsz); u.pn = (wgid % nig) / gsz; return true;
    }
    __device__ __forceinline__ void a_ready(const Unit&) const {}
    __device__ __forceinline__ void done(const Unit&) const {}
};

__device__ __forceinline__ unsigned cvt_pk_bf16(float lo, float hi) { unsigned r; asm volatile("v_cvt_pk_bf16_f32 %0, %1, %2" : "=v"(r) : "v"(lo), "v"(hi)); return r; }
__device__ __forceinline__ float bf_lo(unsigned w) { return __uint_as_float(w << 16); }
__device__ __forceinline__ float bf_hi(unsigned w) { return __uint_as_float(w & 0xffff0000u); }


template <class Epi, class Sched, bool ALIGN_EPI = true>
__device__ __forceinline__ void gemm_phase(PG8_LAS unsigned char* lds, const Gemm g, const Sched& S, const Epi& E) {
    const int tid = threadIdx.x, wid = __builtin_amdgcn_readfirstlane(tid >> 6), lane = tid & 63, wr = wid >> 2, wc = wid & 3, fr = lane & 15, fq = lane >> 4;
    const int K = g.K, nt = K / BK;
    unsigned voffA[2], voffB[2];
#pragma unroll
    for (int i = 0; i < 2; ++i) { int R, C; stage_rc(tid * 16 + i * 8192, R, C); const int Rb = Epi::PERM ? ((R & ~31) + perm32(R & 31)) : R;
        voffA[i] = (unsigned)(R * g.lda + C) * 2u; voffB[i] = (unsigned)(Rb * g.ldb + C) * 2u; }
    const size_t kstep = (size_t)(BK * 2);
    const size_t hstepA = (size_t)HALF * g.lda * 2, hstepB = (size_t)HALF * g.ldb * 2;
    const size_t tstepA = 2 * hstepA, tstepB = 2 * hstepB;
    const unsigned ldsw = (unsigned)wid * 1024u;
    const int aoff = lds_byte(wr * 64 + fr, fq * 8), boff = lds_byte(wc * 32 + fr, fq * 8);
#define PG8_SA(b, h) (((b) * 2 + (h)) * HTB)
#define PG8_SB(b, h) ((4 + (b) * 2 + (h)) * HTB)
#define PG8_STAGE(bufoff, gbase, voff) do { _Pragma("unroll") for (int _i = 0; _i < 2; ++_i) \
        __builtin_amdgcn_global_load_lds((const unsigned*)((const char*)(gbase) + (voff)[_i]), (PG8_LAS unsigned*)(lds + (bufoff) + ldsw + _i * 8192), 16, 0, 0); } while (0)
#define PG8_LDA(dst, b, h) do { _Pragma("unroll") for (int m = 0; m < 4; ++m) _Pragma("unroll") for (int k = 0; k < 2; ++k) dst[m][k] = *(const PG8_LAS bf16x8*)(lds + PG8_SA(b, h) + aoff + m * 2048 + k * 1024); } while (0)
#define PG8_LDB(dst, b, h) do { _Pragma("unroll") for (int n = 0; n < 2; ++n) _Pragma("unroll") for (int k = 0; k < 2; ++k) dst[n][k] = *(const PG8_LAS bf16x8*)(lds + PG8_SB(b, h) + boff + n * 2048 + k * 1024); } while (0)
#define PG8_MMA(ai, bj, At, Bt) do { __builtin_amdgcn_s_setprio(1); _Pragma("unroll") for (int m = 0; m < 4; ++m) _Pragma("unroll") for (int n = 0; n < 2; ++n) _Pragma("unroll") for (int k = 0; k < 2; ++k) \
        acc[ai][bj][m][n] = __builtin_amdgcn_mfma_f32_16x16x32_bf16(Bt[n][k], At[m][k], acc[ai][bj][m][n], 0, 0, 0); __builtin_amdgcn_s_setprio(0); } while (0)
#define PG8_WAIT_V(n) asm volatile("s_waitcnt vmcnt(" #n ")" ::: "memory")
#define PG8_WAIT_L(n) asm volatile("s_waitcnt lgkmcnt(" #n ")" ::: "memory")
#define PG8_BAR __builtin_amdgcn_s_barrier()
#define PG8_SCHED __builtin_amdgcn_sched_barrier(0)
    Unit cur, nxt; int ui = 0;
    if (!S.next(0, cur)) return;
    f32x4 acc[2][2][4][2];
#pragma unroll
    for (int a = 0; a < 2; ++a)
#pragma unroll
        for (int b = 0; b < 2; ++b)
#pragma unroll
            for (int m = 0; m < 4; ++m)
#pragma unroll
                for (int n = 0; n < 2; ++n) acc[a][b][m][n] = (f32x4){0.f, 0.f, 0.f, 0.f};
    bf16x8 At[4][2], B0[2][2], B1[2][2];
    const char* cA = (const char*)g.A + (size_t)cur.pm * tstepA; const char* cB = (const char*)g.Bt + (size_t)cur.pn * tstepB;
    S.a_ready(cur);
    PG8_STAGE(PG8_SB(0, 0), cB, voffB); PG8_STAGE(PG8_SB(0, 1), cB + hstepB, voffB); PG8_STAGE(PG8_SA(0, 0), cA, voffA); PG8_STAGE(PG8_SA(0, 1), cA + hstepA, voffA);
    if (wr == 1) PG8_BAR;
    PG8_WAIT_V(2); PG8_BAR;
    PG8_STAGE(PG8_SB(1, 0), cB + kstep, voffB); PG8_STAGE(PG8_SA(1, 0), cA + kstep, voffA); PG8_STAGE(PG8_SB(1, 1), cB + hstepB + kstep, voffB);
    PG8_WAIT_V(6); PG8_BAR;
    for (;;) {
        const bool has_next = S.next(ui + 1, nxt);
        const char* nA = has_next ? (const char*)g.A + (size_t)nxt.pm * tstepA : cA; const char* nB = has_next ? (const char*)g.Bt + (size_t)nxt.pn * tstepB : cB;
        for (int t = 0; t < nt; t += 2) {
            const bool last = (t == nt - 2);
            const char* a1 = cA + (size_t)(t + 1) * kstep;
            const char* a2 = last ? nA : cA + (size_t)(t + 2) * kstep; const char* b2 = last ? nB : cB + (size_t)(t + 2) * kstep;
            const char* a3 = a2 + kstep; const char* b3 = b2 + kstep;
            if (last && has_next) S.a_ready(nxt);
            PG8_LDB(B0, 0, 0); PG8_LDB(B1, 0, 1); PG8_SCHED; PG8_LDA(At, 0, 0); PG8_STAGE(PG8_SA(1, 1), a1 + hstepA, voffA);
            PG8_WAIT_V(8); PG8_WAIT_L(0); PG8_BAR; PG8_MMA(0, 0, At, B0); PG8_MMA(0, 1, At, B1); PG8_BAR; PG8_SCHED;
            PG8_LDA(At, 0, 1); PG8_STAGE(PG8_SB(0, 0), b2, voffB); PG8_STAGE(PG8_SB(0, 1), b2 + hstepB, voffB); PG8_STAGE(PG8_SA(0, 0), a2, voffA);
            PG8_WAIT_V(8); PG8_WAIT_L(0); PG8_BAR; PG8_MMA(1, 0, At, B0); PG8_MMA(1, 1, At, B1); PG8_BAR; PG8_SCHED;
            PG8_LDB(B0, 1, 0); PG8_LDB(B1, 1, 1); PG8_SCHED; PG8_LDA(At, 1, 0); PG8_STAGE(PG8_SA(0, 1), a2 + hstepA, voffA);
            PG8_WAIT_V(8); PG8_WAIT_L(0); PG8_BAR; PG8_MMA(0, 0, At, B0); PG8_MMA(0, 1, At, B1); PG8_BAR; PG8_SCHED;
            PG8_LDA(At, 1, 1); PG8_STAGE(PG8_SB(1, 0), b3, voffB); PG8_STAGE(PG8_SB(1, 1), b3 + hstepB, voffB); PG8_STAGE(PG8_SA(1, 0), a3, voffA);
            PG8_WAIT_V(8); PG8_WAIT_L(0); PG8_BAR; PG8_MMA(1, 0, At, B0); PG8_MMA(1, 1, At, B1); PG8_BAR; PG8_SCHED;
        }
        if constexpr (ALIGN_EPI) { if (wr == 0) PG8_BAR; }
        E(acc, cur, wr, wc, fr, fq); S.done(cur);
        if (!has_next) break;
#pragma unroll
        for (int a = 0; a < 2; ++a)
#pragma unroll
            for (int b = 0; b < 2; ++b)
#pragma unroll
                for (int m = 0; m < 4; ++m)
#pragma unroll
                    for (int n = 0; n < 2; ++n) acc[a][b][m][n] = (f32x4){0.f, 0.f, 0.f, 0.f};
        cur = nxt; cA = nA; cB = nB; ++ui;
        if constexpr (ALIGN_EPI) { if (wr == 1) PG8_BAR; }
    }
    PG8_WAIT_V(0);
    if constexpr (!ALIGN_EPI) { if (wr == 0) PG8_BAR; }
    PG8_BAR;
#undef PG8_SA
#undef PG8_SB
#undef PG8_STAGE
#undef PG8_LDA
#undef PG8_LDB
#undef PG8_MMA
#undef PG8_WAIT_V
#undef PG8_WAIT_L
#undef PG8_BAR
#undef PG8_SCHED
}

__device__ __forceinline__ float sigmoidf_fast(float x) { return __builtin_amdgcn_rcpf(1.0f + __builtin_amdgcn_exp2f(-1.4426950408889634f * x)); }

struct EpiIn {
    static constexpr bool PERM = true;
    unsigned char* wsb; size_t off_lat, off_na, na_stride, off_g; const float* bgate; float qscale;
    __device__ __forceinline__ void operator()(const f32x4 (&acc)[2][2][4][2], const Unit& u, int wr, int wc, int fr, int fq) const {
        const int row0 = u.pm * BM + wr * 64 + fr; const int pn = u.pn;
        size_t boff; int ldc, colt; float sc = 1.f; bool gate = false;
        if (pn < 6) { boff = off_lat; ldc = 1536; colt = pn * 256; }
        else if (pn < 30) { const int t = (pn - 6) >> 3; boff = off_na + (size_t)t * na_stride; ldc = 2048; colt = ((pn - 6) & 7) * 256; if (t == 0) sc = qscale; }
        else { boff = off_g; ldc = 8192; colt = (pn - 30) * 256; gate = true; }
        bf16_t* base = (bf16_t*)(wsb + boff);
        const int col0 = colt + wc * 32 + 8 * fq;
        f32x4 bv[2][2];
#pragma unroll
        for (int bj = 0; bj < 2; ++bj)
#pragma unroll
            for (int n = 0; n < 2; ++n) bv[bj][n] = gate ? *(const f32x4*)(bgate + col0 + bj * HALF + 4 * n) : (f32x4){0.f, 0.f, 0.f, 0.f};
#pragma unroll
        for (int ai = 0; ai < 2; ++ai)
#pragma unroll
            for (int m = 0; m < 4; ++m) { bf16_t* rowp = base + (size_t)(row0 + ai * HALF + m * 16) * ldc + col0;
#pragma unroll
                for (int bj = 0; bj < 2; ++bj) { f32x4 v0 = acc[ai][bj][m][0] + bv[bj][0], v1 = acc[ai][bj][m][1] + bv[bj][1];
                    if (gate) {
#pragma unroll
                        for (int i = 0; i < 4; ++i) { v0[i] = sigmoidf_fast(v0[i]); v1[i] = sigmoidf_fast(v1[i]); } }
                    else { v0 = v0 * sc; v1 = v1 * sc; }
                    u32x4 w; w.x = cvt_pk_bf16(v0[0], v0[1]); w.y = cvt_pk_bf16(v0[2], v0[3]); w.z = cvt_pk_bf16(v1[0], v1[1]); w.w = cvt_pk_bf16(v1[2], v1[3]);
                    *(u32x4*)(rowp + bj * HALF) = w; } }
    }
};

struct EpiQ {
    static constexpr bool PERM = false;
    bf16_t* Q; const float* rs; const float* rope; float qscale;
    __device__ __forceinline__ void operator()(const f32x4 (&acc)[2][2][4][2], const Unit& u, int wr, int wc, int fr, int fq) const {
#pragma unroll
        for (int ai = 0; ai < 2; ++ai)
#pragma unroll
            for (int m = 0; m < 4; ++m) {
                const int row = u.pm * BM + ai * HALF + wr * 64 + m * 16 + fr;
                const float rstd = rs[2 * row] * qscale;
                const int s = row & 8191, grow = s >> 6, gcol = s & 63;
#pragma unroll
                for (int bj = 0; bj < 2; ++bj) {
                    const int gg = 8 * u.pn + 4 * bj + wc, kind = gg % 6;
                    f32x4 v0 = acc[ai][bj][m][0] * rstd, v1 = acc[ai][bj][m][1] * rstd;
                    if (kind >= 4) {
                        const int pos = (kind == 4) ? grow : gcol;
                        const f32x4 t0 = *(const f32x4*)(rope + (size_t)(pos * 16 + 4 * fq) * 2), t1 = *(const f32x4*)(rope + (size_t)(pos * 16 + 4 * fq) * 2 + 4);
                        const float c0 = t0[0], s0 = t0[1], c1 = t0[2], s1 = t0[3], c2 = t1[0], s2 = t1[1], c3 = t1[2], s3 = t1[3];
                        f32x4 o0, o1;
                        o0[0] = v0[0] * c0 - v1[0] * s0; o1[0] = v0[0] * s0 + v1[0] * c0;
                        o0[1] = v0[1] * c1 - v1[1] * s1; o1[1] = v0[1] * s1 + v1[1] * c1;
                        o0[2] = v0[2] * c2 - v1[2] * s2; o1[2] = v0[2] * s2 + v1[2] * c2;
                        o0[3] = v0[3] * c3 - v1[3] * s3; o1[3] = v0[3] * s3 + v1[3] * c3;
                        v0 = o0; v1 = o1;
                    }
                    bf16_t* p = Q + (size_t)row * 3072 + u.pn * BM + bj * HALF + wc * 32 + 4 * fq;
                    u32x2 w0, w1; w0.x = cvt_pk_bf16(v0[0], v0[1]); w0.y = cvt_pk_bf16(v0[2], v0[3]); w1.x = cvt_pk_bf16(v1[0], v1[1]); w1.y = cvt_pk_bf16(v1[2], v1[3]);
                    *(u32x2*)p = w0; *(u32x2*)(p + 16) = w1;
                }
            }
    }
};

struct EpiKV {
    static constexpr bool PERM = true;
    bf16_t* Kn; bf16_t* Vm; const float* rs;
    __device__ __forceinline__ void operator()(const f32x4 (&acc)[2][2][4][2], const Unit& u, int wr, int wc, int fr, int fq) const {
        const int col0 = u.pn * HALF + wc * 32 + 8 * fq;
#pragma unroll
        for (int ai = 0; ai < 2; ++ai)
#pragma unroll
            for (int m = 0; m < 4; ++m) {
                const int row = u.pm * BM + ai * HALF + wr * 64 + m * 16 + fr;
                const float rstd = rs[2 * row + 1];
#pragma unroll
                for (int bj = 0; bj < 2; ++bj) { const f32x4 v0 = acc[ai][bj][m][0] * rstd, v1 = acc[ai][bj][m][1] * rstd;
                    u32x4 w; w.x = cvt_pk_bf16(v0[0], v0[1]); w.y = cvt_pk_bf16(v0[2], v0[3]); w.z = cvt_pk_bf16(v1[0], v1[1]); w.w = cvt_pk_bf16(v1[2], v1[3]);
                    *(u32x4*)((bj == 0 ? Kn : Vm) + (size_t)row * 2048 + col0) = w; }
            }
    }
};

template <bool FIRST> struct EpiGate {
    static constexpr bool PERM = true;
    const bf16_t* G; bf16_t* MRG;
    __device__ __forceinline__ void operator()(const f32x4 (&acc)[2][2][4][2], const Unit& u, int wr, int wc, int fr, int fq) const {
        const int col0 = u.pn * BM + wc * 32 + 8 * fq;
#pragma unroll
        for (int ai = 0; ai < 2; ++ai)
#pragma unroll
            for (int m = 0; m < 4; ++m) {
                const int row = u.pm * BM + ai * HALF + wr * 64 + m * 16 + fr;
#pragma unroll
                for (int bj = 0; bj < 2; ++bj) {
                    const int col = col0 + bj * HALF;
                    const u32x4 gw = *(const u32x4*)(G + (size_t)row * 8192 + (FIRST ? 0 : 4096) + col);
                    f32x4 v0 = acc[ai][bj][m][0], v1 = acc[ai][bj][m][1];
                    v0[0] *= bf_lo(gw.x); v0[1] *= bf_hi(gw.x); v0[2] *= bf_lo(gw.y); v0[3] *= bf_hi(gw.y);
                    v1[0] *= bf_lo(gw.z); v1[1] *= bf_hi(gw.z); v1[2] *= bf_lo(gw.w); v1[3] *= bf_hi(gw.w);
                    bf16_t* p = MRG + (size_t)row * 4096 + col;
                    if (!FIRST) { const u32x4 pw = *(const u32x4*)p;
                        v0[0] += bf_lo(pw.x); v0[1] += bf_hi(pw.x); v0[2] += bf_lo(pw.y); v0[3] += bf_hi(pw.y);
                        v1[0] += bf_lo(pw.z); v1[1] += bf_hi(pw.z); v1[2] += bf_lo(pw.w); v1[3] += bf_hi(pw.w); }
                    u32x4 w; w.x = cvt_pk_bf16(v0[0], v0[1]); w.y = cvt_pk_bf16(v0[2], v0[3]); w.z = cvt_pk_bf16(v1[0], v1[1]); w.w = cvt_pk_bf16(v1[2], v1[3]);
                    *(u32x4*)p = w;
                }
            }
    }
};

struct EpiF32 {
    static constexpr bool PERM = false;
    const float* base; float* out; int ldc;
    __device__ __forceinline__ void operator()(const f32x4 (&acc)[2][2][4][2], const Unit& u, int wr, int wc, int fr, int fq) const {
        const int col0 = u.pn * BM + wc * 32 + 4 * fq;
#pragma unroll
        for (int ai = 0; ai < 2; ++ai)
#pragma unroll
            for (int m = 0; m < 4; ++m) { const size_t off = (size_t)(u.pm * BM + ai * HALF + wr * 64 + m * 16 + fr) * ldc + col0;
#pragma unroll
                for (int bj = 0; bj < 2; ++bj)
#pragma unroll
                    for (int n = 0; n < 2; ++n) { f32x4 o = acc[ai][bj][m][n]; if (base) o = o + *(const f32x4*)(base + off + bj * HALF + n * 16); *(f32x4*)(out + off + bj * HALF + n * 16) = o; } }
    }
};
}

namespace att {
using bf16x8 = __attribute__((ext_vector_type(8))) short;
using s16x4  = __attribute__((ext_vector_type(4))) short;
using f32x16 = __attribute__((ext_vector_type(16))) float;
using u32x4  = __attribute__((ext_vector_type(4))) unsigned;
typedef unsigned short bf16_t;
constexpr int NW = 8, QBLK = 32, KVBLK = 64, SEQ = 8192, NHEAD = 16;
constexpr int SHM_V = KVBLK * 128 * 2, SHM_KN = KVBLK * 128 * 2, SHM_KR = KVBLK * 64 * 2;
constexpr int OFF_V = 0, OFF_KN = 2 * SHM_V, OFF_KR = OFF_KN + 2 * SHM_KN, OFF_WS = OFF_KR + 2 * SHM_KR, OFF_BIAS = OFF_WS + NW * 64 * 4, OFF_QR = OFF_BIAS + 2048, ATT_LDS_BYTES = OFF_QR + NW * 4096;
#define KSWZ(row, colB) ((row) * 256 + ((colB) ^ (((row) & 7) << 4)))
#define KRSWZ(row, chunk) ((row) * 128 + ((((chunk) ^ (((row) >> 1) & 7))) << 4))
#define ASBAR() __builtin_amdgcn_sched_barrier(0)
__device__ __forceinline__ int crow(int r, int hi) { return (r & 3) + 8 * (r >> 2) + 4 * hi; }
__device__ __forceinline__ unsigned cvtpk(float lo, float hi) { unsigned r; asm volatile("v_cvt_pk_bf16_f32 %0, %1, %2" : "=v"(r) : "v"(lo), "v"(hi)); return r; }
__device__ __forceinline__ bf16x8 ld8(const bf16_t* p) { return *reinterpret_cast<const bf16x8*>(p); }

constexpr float THR2 = 11.5f;
__device__ __forceinline__ void partialSM(f32x16& p0, f32x16& p1, float& m_reg, float& mn, float& alpha) {
  float pmax = p0[0];
#pragma unroll
  for (int r = 1; r < 16; ++r) pmax = fmaxf(pmax, p0[r]);
#pragma unroll
  for (int r = 0; r < 16; ++r) pmax = fmaxf(pmax, p1[r]);
  { auto rr = __builtin_amdgcn_permlane32_swap(__float_as_uint(pmax), __float_as_uint(pmax), false, false);
    pmax = fmaxf(__uint_as_float(rr[0]), __uint_as_float(rr[1])); }
  if (__builtin_expect(__all(pmax - m_reg <= THR2), 1)) { mn = m_reg; alpha = 1.f; }
  else { mn = fmaxf(m_reg, pmax); alpha = __builtin_amdgcn_exp2f(m_reg - mn); m_reg = mn; }
#pragma unroll
  for (int r = 0; r < 16; ++r) p0[r] = p0[r] - mn;
#pragma unroll
  for (int r = 0; r < 16; ++r) p1[r] = p1[r] - mn;
#pragma unroll
  for (int r = 0; r < 16; ++r) p0[r] = __builtin_amdgcn_exp2f(p0[r]);
}
__device__ __forceinline__ void finishSM(f32x16& p0, f32x16& p1, float alpha, float& l_reg, bf16x8& pa0, bf16x8& pa1, bf16x8& pa2, bf16x8& pa3) {
#pragma unroll
  for (int r = 0; r < 16; ++r) p1[r] = __builtin_amdgcn_exp2f(p1[r]);
  float ps = 0;
#pragma unroll
  for (int r = 0; r < 16; ++r) ps += p0[r];
#pragma unroll
  for (int r = 0; r < 16; ++r) ps += p1[r];
  { auto rr = __builtin_amdgcn_permlane32_swap(__float_as_uint(ps), __float_as_uint(ps), false, false);
    ps = __uint_as_float(rr[0]) + __uint_as_float(rr[1]); }
  l_reg = l_reg * alpha + ps;
#define PK4(P, BASE, OUT) do { unsigned a0 = cvtpk(P[BASE + 0], P[BASE + 1]), a1 = cvtpk(P[BASE + 2], P[BASE + 3]);   \
    unsigned b0 = cvtpk(P[BASE + 4], P[BASE + 5]), b1 = cvtpk(P[BASE + 6], P[BASE + 7]);                              \
    auto r0 = __builtin_amdgcn_permlane32_swap(a0, b0, false, false); auto r1 = __builtin_amdgcn_permlane32_swap(a1, b1, false, false); \
    u32x4 w = {r0[0], r1[0], r0[1], r1[1]}; OUT = *reinterpret_cast<bf16x8*>(&w); } while (0)
  PK4(p0, 0, pa0); PK4(p0, 8, pa1); PK4(p1, 0, pa2); PK4(p1, 8, pa3);
}
__device__ __forceinline__ int v_st(int k, int c) { const int kk = (k & ~0xC) | ((k & 4) << 1) | ((k & 8) >> 1); return ((kk >> 3) * 4 + (c >> 5)) * 512 + ((kk & 7) * 32 + (c & 31)) * 2; }
__device__ __forceinline__ int v_rd_base(int lane) { return ((lane & 3) << 3) | (((lane >> 2) & 3) << 6) | (((lane >> 4) & 1) << 5) | (((lane >> 5) & 1) << 8); }
constexpr int v_rd_off(int d0, int ks, int half) { return d0 * 512 + ks * 4096 + half * 2048; }
template <int OFF> __device__ __forceinline__ s16x4 tr_read(int vb) {
  s16x4 r; asm volatile("ds_read_b64_tr_b16 %0, %1 offset:%2" : "=&v"(r) : "v"(vb), "i"(OFF) : "memory"); return r;
}
template <int D0> __device__ __forceinline__ void pv_one(f32x16& od, int vb, bf16x8 pa0, bf16x8 pa1, bf16x8 pa2, bf16x8 pa3) {
  const s16x4 l0 = tr_read<v_rd_off(D0, 0, 0)>(vb), h0 = tr_read<v_rd_off(D0, 0, 1)>(vb), l1 = tr_read<v_rd_off(D0, 1, 0)>(vb), h1 = tr_read<v_rd_off(D0, 1, 1)>(vb);
  const s16x4 l2 = tr_read<v_rd_off(D0, 2, 0)>(vb), h2 = tr_read<v_rd_off(D0, 2, 1)>(vb), l3 = tr_read<v_rd_off(D0, 3, 0)>(vb), h3 = tr_read<v_rd_off(D0, 3, 1)>(vb);
  asm volatile("s_waitcnt lgkmcnt(0)" ::: "memory"); ASBAR();
#define PKV(L, H) (bf16x8){L[0], L[1], L[2], L[3], H[0], H[1], H[2], H[3]}
  od = __builtin_amdgcn_mfma_f32_32x32x16_bf16(pa0, PKV(l0, h0), od, 0, 0, 0);
  od = __builtin_amdgcn_mfma_f32_32x32x16_bf16(pa1, PKV(l1, h1), od, 0, 0, 0);
  od = __builtin_amdgcn_mfma_f32_32x32x16_bf16(pa2, PKV(l2, h2), od, 0, 0, 0);
  od = __builtin_amdgcn_mfma_f32_32x32x16_bf16(pa3, PKV(l3, h3), od, 0, 0, 0);
#undef PKV
}
__device__ __forceinline__ void pv_d0(f32x16* o, int vb, bf16x8 pa0, bf16x8 pa1, bf16x8 pa2, bf16x8 pa3) {
  pv_one<0>(o[0], vb, pa0, pa1, pa2, pa3); pv_one<1>(o[1], vb, pa0, pa1, pa2, pa3); pv_one<2>(o[2], vb, pa0, pa1, pa2, pa3); pv_one<3>(o[3], vb, pa0, pa1, pa2, pa3);
}
template <int NROPE> __device__ __forceinline__ void qkt(f32x16& p0, f32x16& p1, const char* Kn, const char* Kr, const bf16x8* qr, const char* qrl, int r32, int hi) {
  p0 = f32x16{}; p1 = f32x16{};
#pragma unroll
  for (int d0 = 0; d0 < 8; ++d0) { const int cb = (d0 * 16 + hi * 8) * 2;
    const bf16x8 b0 = *reinterpret_cast<const bf16x8*>(Kn + KSWZ(r32, cb));
    const bf16x8 b1 = *reinterpret_cast<const bf16x8*>(Kn + KSWZ(32 + r32, cb));
    p0 = __builtin_amdgcn_mfma_f32_32x32x16_bf16(b0, qr[d0], p0, 0, 0, 0);
    p1 = __builtin_amdgcn_mfma_f32_32x32x16_bf16(b1, qr[d0], p1, 0, 0, 0); }
#pragma unroll
  for (int d0 = 0; d0 < NROPE; ++d0) { const int ch = d0 * 2 + hi;
    const bf16x8 b0 = *reinterpret_cast<const bf16x8*>(Kr + KRSWZ(r32, ch));
    const bf16x8 b1 = *reinterpret_cast<const bf16x8*>(Kr + KRSWZ(32 + r32, ch));
    const bf16x8 qf = *reinterpret_cast<const bf16x8*>(qrl + d0 * 1024);
    p0 = __builtin_amdgcn_mfma_f32_32x32x16_bf16(b0, qf, p0, 0, 0, 0);
    p1 = __builtin_amdgcn_mfma_f32_32x32x16_bf16(b1, qf, p1, 0, 0, 0); }
}

__device__ __forceinline__ void mla_unit(int b, int h, int qb, const bf16_t* __restrict__ Q, const bf16_t* __restrict__ KN, const bf16_t* __restrict__ KR, const bf16_t* __restrict__ VM, bf16_t* __restrict__ O, char* lds) {
  int tid_ = threadIdx.x; asm volatile("" : "+v"(tid_));
  const int tid = tid_, wid = tid >> 6, lane = tid & 63, r32 = lane & 31, hi = lane >> 5;
  char* V_lds = lds + OFF_V; char* Kn_lds = lds + OFF_KN; char* Kr_lds = lds + OFF_KR;
  float* ws = (float*)(lds + OFF_WS) + wid * 64; float* li_l = ws; float* al_l = ws + 32;
  float m_reg = -1e30f, l_reg = 0; f32x16 o[4] = {}; bf16x8 qr[8];
  char* qrl = lds + OFF_QR + wid * 4096 + (hi * 32 + r32) * 16;
  const long rowbase = (long)b * SEQ;
  const bf16_t* Qw = Q + (rowbase + qb * 256 + wid * QBLK + r32) * 3072 + h * 192 + hi * 8;
#pragma unroll
  for (int d0 = 0; d0 < 8; ++d0) qr[d0] = ld8(Qw + d0 * 16);
  const bf16_t* Kh = KN + rowbase * 2048 + h * 128; const bf16_t* Vh = VM + rowbase * 2048 + h * 128; const bf16_t* Krb = KR + rowbase * 64;
  const int sr = tid >> 4, sc = (tid & 15) * 8, vst0 = v_st(sr, sc), vst1 = v_st(32 + sr, sc);
  const int krr = tid >> 3, krc = tid & 7;
  const int vb0 = (int)(uintptr_t)V_lds + v_rd_base(lane);
  struct { bf16x8 vs0, vs1, ks0, ks1, kr0; } sr_[1];
#define SLOAD(i, k0) do { sr_[i].vs0 = ld8(&Vh[(long)((k0) + sr) * 2048 + sc]); sr_[i].vs1 = ld8(&Vh[(long)((k0) + 32 + sr) * 2048 + sc]); \
    sr_[i].ks0 = ld8(&Kh[(long)((k0) + sr) * 2048 + sc]); sr_[i].ks1 = ld8(&Kh[(long)((k0) + 32 + sr) * 2048 + sc]); sr_[i].kr0 = ld8(&Krb[(long)((k0) + krr) * 64 + krc * 8]); } while (0)
#define SWRITE(bb, i) do { *(bf16x8*)(V_lds + (bb) * SHM_V + vst0) = sr_[i].vs0; *(bf16x8*)(V_lds + (bb) * SHM_V + vst1) = sr_[i].vs1; const int kc = sc * 2; \
    *(bf16x8*)(Kn_lds + (bb) * SHM_KN + KSWZ(sr, kc)) = sr_[i].ks0; *(bf16x8*)(Kn_lds + (bb) * SHM_KN + KSWZ(32 + sr, kc)) = sr_[i].ks1; \
    *(bf16x8*)(Kr_lds + (bb) * SHM_KR + KRSWZ(krr, krc)) = sr_[i].kr0; } while (0)
#define SWAIT() asm volatile("s_waitcnt vmcnt(0)" ::: "memory")
#define RESC(a) do { if (__any((a) < 1.f)) { if (hi == 0) al_l[r32] = (a); asm volatile("s_waitcnt lgkmcnt(0)" ::: "memory"); \
    _Pragma("unroll") for (int d = 0; d < 4; ++d) _Pragma("unroll") for (int r = 0; r < 16; ++r) o[d][r] *= al_l[crow(r, hi)]; } } while (0)
  f32x16 pA0, pA1, pB0, pB1; float mnA, mnB, alA, alB; bf16x8 pa0, pa1, pa2, pa3; const int NT = SEQ / KVBLK;
  constexpr int SE = 0, SO = 0;
  __syncthreads();
#pragma unroll
  for (int d0 = 0; d0 < 4; ++d0) *(bf16x8*)(qrl + d0 * 1024) = ld8(Qw + (8 + d0) * 16);
  SLOAD(SE, 0); asm volatile("s_waitcnt vmcnt(0)" ::: "memory"); SWRITE(0, SE); __syncthreads();
  qkt<4>(pA0, pA1, Kn_lds, Kr_lds, qr, qrl, r32, hi); partialSM(pA0, pA1, m_reg, mnA, alA);
  SLOAD(SO, KVBLK);
  SWAIT(); SWRITE(1, SO); __syncthreads();
  for (int j = 1; j + 1 < NT; j += 2) {
    ASBAR(); qkt<4>(pB0, pB1, Kn_lds + SHM_KN, Kr_lds + SHM_KR, qr, qrl, r32, hi);
    finishSM(pA0, pA1, alA, l_reg, pa0, pa1, pa2, pa3); ASBAR();
    SLOAD(SE, (j + 1) * KVBLK); ASBAR();
    pv_d0(o, vb0, pa0, pa1, pa2, pa3); partialSM(pB0, pB1, m_reg, mnB, alB);
    __syncthreads(); SWAIT(); SWRITE(0, SE);
    RESC(alB); __syncthreads();
    ASBAR(); qkt<4>(pA0, pA1, Kn_lds, Kr_lds, qr, qrl, r32, hi);
    finishSM(pB0, pB1, alB, l_reg, pa0, pa1, pa2, pa3); ASBAR();
    SLOAD(SO, (j + 2) * KVBLK); ASBAR();
    pv_d0(o, vb0 + SHM_V, pa0, pa1, pa2, pa3); partialSM(pA0, pA1, m_reg, mnA, alA);
    __syncthreads(); SWAIT(); SWRITE(1, SO);
    RESC(alA); __syncthreads();
  }
  ASBAR(); qkt<4>(pB0, pB1, Kn_lds + SHM_KN, Kr_lds + SHM_KR, qr, qrl, r32, hi);
  finishSM(pA0, pA1, alA, l_reg, pa0, pa1, pa2, pa3); ASBAR();
  pv_d0(o, vb0, pa0, pa1, pa2, pa3); partialSM(pB0, pB1, m_reg, mnB, alB);
  __syncthreads(); RESC(alB);
  finishSM(pB0, pB1, alB, l_reg, pa0, pa1, pa2, pa3); ASBAR();
  pv_d0(o, vb0 + SHM_V, pa0, pa1, pa2, pa3);
  if (hi == 0) li_l[r32] = l_reg; asm volatile("s_waitcnt lgkmcnt(0)" ::: "memory");
  float rli[16];
#pragma unroll
  for (int r = 0; r < 16; ++r) rli[r] = __builtin_amdgcn_rcpf(li_l[crow(r, hi)]);
  bf16_t* Ow = O + (rowbase + qb * 256 + wid * QBLK) * 2048 + h * 128;
#pragma unroll
  for (int r = 0; r < 16; ++r) { const int orow = crow(r, hi);
#pragma unroll
    for (int d0 = 0; d0 < 4; ++d0) Ow[(long)orow * 2048 + d0 * 32 + r32] = (bf16_t)(cvtpk(o[d0][r] * rli[r], 0.f) & 0xffffu); }
#undef SLOAD
#undef SWRITE
#undef SWAIT
#undef RESC
}

__device__ __forceinline__ void na_unit(int b, int h, int rg, const bf16_t* __restrict__ Q, const bf16_t* __restrict__ K, const bf16_t* __restrict__ V, const float* __restrict__ rpb, bf16_t* __restrict__ O, char* lds) {
  int tid_ = threadIdx.x; asm volatile("" : "+v"(tid_));
  const int tid = tid_, wid = tid >> 6, lane = tid & 63, r32 = lane & 31, hi = lane >> 5;
  char* V_lds = lds + OFF_V; char* Kn_lds = lds + OFF_KN;
  float* ws = (float*)(lds + OFF_WS) + wid * 64; float* li_l = ws; float* al_l = ws + 32;
  float* bias_l = (float*)(lds + OFF_BIAS);
  const int r0 = rg * 4, rq = r0 + (wid >> 1), cq = 32 * (wid & 1) + r32;
  const int rs_w = min(max(rq - 4, 0), 120), cs = min(max(cq - 8, 0), 48);
  const int kr_lo = min(max(r0 - 4, 0), 120), kr_hi = min(max(r0 + 3 - 4, 0), 120) + 7, NT = kr_hi - kr_lo + 1;
  const long rowbase = (long)b * SEQ;
  float m_reg = -1e30f, l_reg = 0; f32x16 o[4] = {}; bf16x8 qr[8];
  const bf16_t* Qw = Q + (rowbase + rq * 64 + cq) * 2048 + h * 128 + hi * 8;
#pragma unroll
  for (int d0 = 0; d0 < 8; ++d0) qr[d0] = ld8(Qw + d0 * 16);
  const bf16_t* Kh = K + rowbase * 2048 + h * 128; const bf16_t* Vh = V + rowbase * 2048 + h * 128;
  const int sr = tid >> 4, sc = (tid & 15) * 8, vst0 = v_st(sr, sc), vst1 = v_st(32 + sr, sc);
  const int vb0 = (int)(uintptr_t)V_lds + v_rd_base(lane);
  __syncthreads();
  if (tid < 465) bias_l[tid] = rpb[h * 465 + tid] * 1.4426950408889634f;
  bf16x8 vs0, vs1, ks0, ks1;
#define NLOAD(k0) do { vs0 = ld8(&Vh[(long)((k0) + sr) * 2048 + sc]); vs1 = ld8(&Vh[(long)((k0) + 32 + sr) * 2048 + sc]); \
    ks0 = ld8(&Kh[(long)((k0) + sr) * 2048 + sc]); ks1 = ld8(&Kh[(long)((k0) + 32 + sr) * 2048 + sc]); } while (0)
#define NWRITE(bb) do { *(bf16x8*)(V_lds + (bb) * SHM_V + vst0) = vs0; *(bf16x8*)(V_lds + (bb) * SHM_V + vst1) = vs1; const int kc = sc * 2; \
    *(bf16x8*)(Kn_lds + (bb) * SHM_KN + KSWZ(sr, kc)) = ks0; *(bf16x8*)(Kn_lds + (bb) * SHM_KN + KSWZ(32 + sr, kc)) = ks1; } while (0)
  NLOAD(kr_lo * 64);
  for (int i = 0; i < NT; ++i) {
    const int kr = kr_lo + i, bb = i & 1;
    NWRITE(bb);
    if (i + 1 < NT) NLOAD((kr + 1) * 64);
    __syncthreads();
    if (kr >= rs_w && kr < rs_w + 8) {
      f32x16 p0, p1;
      qkt<0>(p0, p1, Kn_lds + bb * SHM_KN, nullptr, qr, nullptr, r32, hi);
      const float* brow = bias_l + (kr - rq + 7) * 31 + 15 - cq;
      float pmax = -1e30f;
#pragma unroll
      for (int r = 0; r < 16; ++r) { const int k0 = crow(r, hi), k1 = 32 + k0;
        const bool v0 = (k0 >= cs) && (k0 < cs + 16), v1 = (k1 >= cs) && (k1 < cs + 16);
        const float b0 = brow[v0 ? k0 : cq], b1 = brow[v1 ? k1 : cq];
        p0[r] = v0 ? p0[r] + b0 : -1e30f; p1[r] = v1 ? p1[r] + b1 : -1e30f;
        pmax = fmaxf(pmax, fmaxf(p0[r], p1[r])); }
      { auto rr = __builtin_amdgcn_permlane32_swap(__float_as_uint(pmax), __float_as_uint(pmax), false, false);
        pmax = fmaxf(__uint_as_float(rr[0]), __uint_as_float(rr[1])); }
      const float mn = fmaxf(m_reg, pmax), alpha = __builtin_amdgcn_exp2f(m_reg - mn); m_reg = mn;
#pragma unroll
      for (int r = 0; r < 16; ++r) { p0[r] = __builtin_amdgcn_exp2f(p0[r] - mn); p1[r] = __builtin_amdgcn_exp2f(p1[r] - mn); }
      float ps = 0;
#pragma unroll
      for (int r = 0; r < 16; ++r) ps += p0[r] + p1[r];
      { auto rr = __builtin_amdgcn_permlane32_swap(__float_as_uint(ps), __float_as_uint(ps), false, false);
        ps = __uint_as_float(rr[0]) + __uint_as_float(rr[1]); }
      l_reg = l_reg * alpha + ps;
      if (hi == 0) al_l[r32] = alpha; asm volatile("s_waitcnt lgkmcnt(0)" ::: "memory");
#pragma unroll
      for (int d = 0; d < 4; ++d)
#pragma unroll
        for (int r = 0; r < 16; ++r) o[d][r] *= al_l[crow(r, hi)];
      bf16x8 pa0, pa1, pa2, pa3;
      PK4(p0, 0, pa0); PK4(p0, 8, pa1); PK4(p1, 0, pa2); PK4(p1, 8, pa3);
      pv_d0(o, vb0 + bb * SHM_V, pa0, pa1, pa2, pa3);
    }
  }
  if (hi == 0) li_l[r32] = l_reg; asm volatile("s_waitcnt lgkmcnt(0)" ::: "memory");
  float rli[16];
#pragma unroll
  for (int r = 0; r < 16; ++r) rli[r] = __builtin_amdgcn_rcpf(li_l[crow(r, hi)]);
  bf16_t* Ow = O + (rowbase + rq * 64 + 32 * (wid & 1)) * 2048 + h * 128;
#pragma unroll
  for (int r = 0; r < 16; ++r) { const int orow = crow(r, hi);
#pragma unroll
    for (int d0 = 0; d0 < 4; ++d0) Ow[(long)orow * 2048 + d0 * 32 + r32] = (bf16_t)(cvtpk(o[d0][r] * rli[r], 0.f) & 0xffffu); }
#undef NLOAD
#undef NWRITE
}
#undef PK4
}

namespace peer {
#define PLAS __attribute__((address_space(3)))
using bf16x8 = __attribute__((ext_vector_type(8))) short;
using bf16x2 = __attribute__((ext_vector_type(2))) __bf16;
using f32x16 = __attribute__((ext_vector_type(16))) float;
using f32x4  = __attribute__((ext_vector_type(4))) float;
using u32x4  = __attribute__((ext_vector_type(4))) unsigned;
typedef unsigned short bf16_t;
__device__ __forceinline__ int f2ord(float f) { const int u = __float_as_int(f); return u ^ ((u >> 31) & 0x7fffffff); }
__device__ __forceinline__ float ord2f(int s) { return __int_as_float(s ^ ((s >> 31) & 0x7fffffff)); }
__device__ __forceinline__ int crow(int r, int hi) { return (r & 3) + 8 * (r >> 2) + 4 * hi; }
__device__ __forceinline__ unsigned cvtpk(float lo, float hi) { unsigned r; asm volatile("v_cvt_pk_bf16_f32 %0, %1, %2" : "=v"(r) : "v"(lo), "v"(hi)); return r; }
__device__ __forceinline__ float bf_lo(unsigned w) { return __uint_as_float(w << 16); }
__device__ __forceinline__ float bf_hi(unsigned w) { return __uint_as_float(w & 0xffff0000u); }
__device__ __forceinline__ int swapmax(int m) { auto rr = __builtin_amdgcn_permlane32_swap((unsigned)m, (unsigned)m, false, false); const int a = (int)rr[0], b = (int)rr[1]; return a > b ? a : b; }

struct CandTab { int ci[50], cj[50]; };
constexpr CandTab make_cands() { CandTab t{}; int n = 0; for (int i = 0; i < 16; ++i) for (int j = 0; j < 16; ++j) if ((i + 1) * (j + 1) <= 16) { t.ci[n] = i; t.cj[n] = j; ++n; } return t; }
constexpr CandTab CT = make_cands();

constexpr int SEL_LDS_PER_WAVE = (2 * 16 + 16) * 64 * 4;

__device__ __forceinline__ void select32(int t0, const float* __restrict__ QP, const bf16_t* __restrict__ SUBH, const bf16_t* __restrict__ SUBL, int* __restrict__ IDX, float* __restrict__ GATE, PLAS int* wl, int lane_) {
  int lane = lane_; asm volatile("" : "+v"(lane));
  const int r32 = lane & 31, hi = lane >> 5;
  PLAS int* topl = wl; PLAS int* winl = wl + 2 * 16 * 64;
  const float* qrow = QP + (size_t)(t0 + r32) * 2048;
#pragma unroll 1
  for (int h = 0; h < 8; ++h) {
#pragma unroll 1
    for (int p = 0; p < 2; ++p) {
      bf16x8 qh[8], ql[8];
      const float* qp = qrow + h * 256 + p * 128 + hi * 8;
#pragma unroll
      for (int d0 = 0; d0 < 8; ++d0) {
        const f32x4 a = *(const f32x4*)(qp + d0 * 16), b = *(const f32x4*)(qp + d0 * 16 + 4);
        u32x4 wh, wlw;
        wh.x = cvtpk(a[0], a[1]); wh.y = cvtpk(a[2], a[3]); wh.z = cvtpk(b[0], b[1]); wh.w = cvtpk(b[2], b[3]);
        wlw.x = cvtpk(a[0] - bf_lo(wh.x), a[1] - bf_hi(wh.x)); wlw.y = cvtpk(a[2] - bf_lo(wh.y), a[3] - bf_hi(wh.y));
        wlw.z = cvtpk(b[0] - bf_lo(wh.z), b[1] - bf_hi(wh.z)); wlw.w = cvtpk(b[2] - bf_lo(wh.w), b[3] - bf_hi(wh.w));
        qh[d0] = *reinterpret_cast<bf16x8*>(&wh); ql[d0] = *reinterpret_cast<bf16x8*>(&wlw);
      }
      const size_t soff = ((size_t)(h * 2 + p) * 128 + r32) * 128 + hi * 8;
      int key[64];
#pragma unroll
      for (int kb = 0; kb < 4; ++kb) {
        f32x16 acc = f32x16{};
#pragma unroll
        for (int d0 = 0; d0 < 8; ++d0) {
          const bf16x8 ah = *reinterpret_cast<const bf16x8*>(SUBH + soff + (size_t)kb * 32 * 128 + d0 * 16);
          const bf16x8 al = *reinterpret_cast<const bf16x8*>(SUBL + soff + (size_t)kb * 32 * 128 + d0 * 16);
          acc = __builtin_amdgcn_mfma_f32_32x32x16_bf16(ah, qh[d0], acc, 0, 0, 0);
          acc = __builtin_amdgcn_mfma_f32_32x32x16_bf16(ah, ql[d0], acc, 0, 0, 0);
          acc = __builtin_amdgcn_mfma_f32_32x32x16_bf16(al, qh[d0], acc, 0, 0, 0);
        }
#pragma unroll
        for (int r = 0; r < 16; ++r) key[kb * 16 + r] = (f2ord(acc[r]) & ~127) | (kb * 32 + crow(r, hi));
      }
#pragma unroll 1
      for (int it = 0; it < 16; ++it) {
        int m = key[0];
#pragma unroll
        for (int i = 1; i < 64; ++i) m = key[i] > m ? key[i] : m;
        const int gm = swapmax(m);
        topl[(p * 16 + it) * 64 + lane] = gm;
#pragma unroll
        for (int i = 0; i < 64; ++i) key[i] = (key[i] == gm) ? (int)0x80000000 : key[i];
      }
    }
    int ck[25];
#pragma unroll
    for (int c = 0; c < 25; ++c) {
      const int i = hi ? CT.ci[2 * c + 1] : CT.ci[2 * c], j = hi ? CT.cj[2 * c + 1] : CT.cj[2 * c];
      const int k0 = topl[i * 64 + lane], k1 = topl[(16 + j) * 64 + lane];
      const float s = ord2f(k0 & ~127) + ord2f(k1 & ~127);
      ck[c] = (f2ord(s) & ~255) | (i << 4) | j;
    }
#pragma unroll 1
    for (int it = 0; it < 16; ++it) {
      int m = ck[0];
#pragma unroll
      for (int i = 1; i < 25; ++i) m = ck[i] > m ? ck[i] : m;
      const int gm = swapmax(m);
      winl[it * 64 + lane] = gm;
#pragma unroll
      for (int i = 0; i < 25; ++i) ck[i] = (ck[i] == gm) ? (int)0x80000000 : ck[i];
    }
    float e[16]; int wv[16]; float tot = 0.f;
    const float s0 = ord2f(winl[lane] & ~255);
#pragma unroll
    for (int k = 0; k < 16; ++k) { wv[k] = winl[k * 64 + lane]; e[k] = __builtin_amdgcn_exp2f((ord2f(wv[k] & ~255) - s0) * 1.4426950408889634f); tot += e[k]; }
    const float rtot = 1.0f / tot;
    const size_t ob = (size_t)(t0 + r32) * 128 + h * 16 + hi * 8;
#pragma unroll
    for (int k = 0; k < 8; ++k) {
      const int w = hi ? wv[8 + k] : wv[k]; const float ev = hi ? e[8 + k] : e[k];
      const int i = (w >> 4) & 15, j = w & 15;
      const int e0 = topl[i * 64 + lane] & 127, e1 = topl[(16 + j) * 64 + lane] & 127;
      IDX[ob + k] = e0 * 128 + e1; GATE[ob + k] = ev * rtot;
    }
  }
}

__device__ __forceinline__ float dot2(unsigned w, unsigned x, float acc) { return __builtin_amdgcn_fdot2_f32_bf16(__builtin_bit_cast(bf16x2, w), __builtin_bit_cast(bf16x2, x), acc, false); }
__device__ __forceinline__ float gelu_erf(float v) {
  const float av = fabsf(v), d = av * 0.2316418882f + 1.0f, t = __builtin_amdgcn_rcpf(d);
  float q = t * 0.5307027145f + (-0.7265760135f); q = q * t + 0.7107068705f; q = q * t + (-0.142248368f); q = q * t + 0.127414796f; q = q * t;
  const float e = __builtin_amdgcn_exp2f((v * v) * (-0.72134752044f));
  const float m = v * (q * e);
  return v < 0.f ? m : v - m;
}
__device__ __forceinline__ float wave_sum(float v) {
#pragma unroll
  for (int o = 1; o < 64; o <<= 1) v += __shfl_xor(v, o);
  return v;
}

typedef float f32x2 __attribute__((ext_vector_type(2)));
constexpr float USCALE = 64.0f, VSCALE = 4.0f;
__device__ __forceinline__ f32x2 fp8x2(unsigned w, bool hiword) { return hiword ? __builtin_amdgcn_cvt_pk_f32_fp8((int)w, true) : __builtin_amdgcn_cvt_pk_f32_fp8((int)w, false); }
template <bool STORE> __device__ __forceinline__ void expert_token(int t, const bf16_t* __restrict__ H2, const unsigned char* __restrict__ U8, const unsigned char* __restrict__ V8, const int* __restrict__ IDX, const float* __restrict__ GATE,
                                             float* X1OUT, const float* __restrict__ fnorm, int lane_) {
  int lane = lane_; asm volatile("" : "+v"(lane));
  f32x2 hf[4][8];
  { const u32x4* hp = (const u32x4*)(H2 + (size_t)t * 4096) + 2 * lane;
#pragma unroll
    for (int k = 0; k < 4; ++k) { const u32x4 a = hp[128 * k], b = hp[128 * k + 1];
      hf[k][0] = (f32x2){bf_lo(a.x), bf_hi(a.x)}; hf[k][1] = (f32x2){bf_lo(a.y), bf_hi(a.y)}; hf[k][2] = (f32x2){bf_lo(a.z), bf_hi(a.z)}; hf[k][3] = (f32x2){bf_lo(a.w), bf_hi(a.w)};
      hf[k][4] = (f32x2){bf_lo(b.x), bf_hi(b.x)}; hf[k][5] = (f32x2){bf_lo(b.y), bf_hi(b.y)}; hf[k][6] = (f32x2){bf_lo(b.z), bf_hi(b.z)}; hf[k][7] = (f32x2){bf_lo(b.w), bf_hi(b.w)}; } }
  const int e0 = IDX[(size_t)t * 128 + lane], e1 = IDX[(size_t)t * 128 + 64 + lane];
  const float g0 = GATE[(size_t)t * 128 + lane], g1 = GATE[(size_t)t * 128 + 64 + lane];
  float c0 = 0.f, c1 = 0.f;
  u32x4 r0[4], r1[4], r2[4], r3[4];
#define ELOAD(dst, jj) do { const int jx_ = (jj); if (jx_ < 256) { const int sl_ = jx_ & 127; const int e_ = __builtin_amdgcn_readlane(sl_ < 64 ? e0 : e1, sl_ & 63); \
    const u32x4* rp_ = (const u32x4*)((jx_ < 128 ? U8 : V8) + (size_t)e_ * 4096) + lane; _Pragma("unroll") for (int k = 0; k < 4; ++k) dst[k] = rp_[64 * k]; } \
    asm volatile("" ::: "memory"); __builtin_amdgcn_sched_barrier(0); } while (0)
#define UDOT(R, OUT) do { f32x2 a0_ = {0.f, 0.f}, a1_ = {0.f, 0.f}, a2_ = {0.f, 0.f}, a3_ = {0.f, 0.f}; \
    _Pragma("unroll") for (int k = 0; k < 4; ++k) { \
      a0_ += fp8x2(R[k].x, false) * hf[k][0]; a1_ += fp8x2(R[k].x, true) * hf[k][1]; a2_ += fp8x2(R[k].y, false) * hf[k][2]; a3_ += fp8x2(R[k].y, true) * hf[k][3]; \
      a0_ += fp8x2(R[k].z, false) * hf[k][4]; a1_ += fp8x2(R[k].z, true) * hf[k][5]; a2_ += fp8x2(R[k].w, false) * hf[k][6]; a3_ += fp8x2(R[k].w, true) * hf[k][7]; } \
    a0_ += a1_; a2_ += a3_; a0_ += a2_; OUT = a0_.x + a0_.y; } while (0)
  ELOAD(r0, 0); ELOAD(r1, 1); ELOAD(r2, 2); ELOAD(r3, 3);
#pragma unroll 1
  for (int g = 0; g < 16; ++g) {
    float p[8];
    const int j = g * 8;
    UDOT(r0, p[0]); ELOAD(r0, j + 4); UDOT(r1, p[1]); ELOAD(r1, j + 5); UDOT(r2, p[2]); ELOAD(r2, j + 6); UDOT(r3, p[3]); ELOAD(r3, j + 7);
    UDOT(r0, p[4]); ELOAD(r0, j + 8); UDOT(r1, p[5]); ELOAD(r1, j + 9); UDOT(r2, p[6]); ELOAD(r2, j + 10); UDOT(r3, p[7]); ELOAD(r3, j + 11);
    float q4[4], q2[2], q1;
    { const bool up = (lane & 32) != 0;
#pragma unroll
      for (int i = 0; i < 4; ++i) { const float send = up ? p[i] : p[4 + i], keep = up ? p[4 + i] : p[i]; q4[i] = keep + __shfl_xor(send, 32); } }
    { const bool up = (lane & 16) != 0;
#pragma unroll
      for (int i = 0; i < 2; ++i) { const float send = up ? q4[i] : q4[2 + i], keep = up ? q4[2 + i] : q4[i]; q2[i] = keep + __shfl_xor(send, 16); } }
    { const bool up = (lane & 8) != 0; const float send = up ? q2[0] : q2[1], keep = up ? q2[1] : q2[0]; q1 = keep + __shfl_xor(send, 8); }
    q1 += __shfl_xor(q1, 4); q1 += __shfl_xor(q1, 2); q1 += __shfl_xor(q1, 1);
    const float got = __shfl(q1, 8 * (lane & 7));
    if ((lane >> 3) == (g & 7)) { if (g < 8) c0 = got; else c1 = got; }
  }
#undef UDOT
  c0 = g0 * gelu_erf(c0 * (1.0f / USCALE)) * (1.0f / VSCALE); c1 = g1 * gelu_erf(c1 * (1.0f / USCALE)) * (1.0f / VSCALE);
  f32x2 acc[4][8];
#pragma unroll
  for (int k = 0; k < 4; ++k)
#pragma unroll
    for (int i = 0; i < 8; ++i) acc[k][i] = (f32x2){0.f, 0.f};
#define VROW(R, C) do { const f32x2 cc_ = {(C), (C)}; _Pragma("unroll") for (int k = 0; k < 4; ++k) { \
      acc[k][0] += cc_ * fp8x2(R[k].x, false); acc[k][1] += cc_ * fp8x2(R[k].x, true); acc[k][2] += cc_ * fp8x2(R[k].y, false); acc[k][3] += cc_ * fp8x2(R[k].y, true); \
      acc[k][4] += cc_ * fp8x2(R[k].z, false); acc[k][5] += cc_ * fp8x2(R[k].z, true); acc[k][6] += cc_ * fp8x2(R[k].w, false); acc[k][7] += cc_ * fp8x2(R[k].w, true); } } while (0)
#define CJ(j) __int_as_float(__builtin_amdgcn_readlane(__float_as_int((j) < 64 ? c0 : c1), (j) & 63))
#pragma unroll 1
  for (int j = 0; j < 128; j += 4) {
    { const float c = CJ(j); VROW(r0, c); __builtin_amdgcn_sched_barrier(0); ELOAD(r0, 128 + j + 4); }
    { const float c = CJ(j + 1); VROW(r1, c); __builtin_amdgcn_sched_barrier(0); ELOAD(r1, 128 + j + 5); }
    { const float c = CJ(j + 2); VROW(r2, c); __builtin_amdgcn_sched_barrier(0); ELOAD(r2, 128 + j + 6); }
    { const float c = CJ(j + 3); VROW(r3, c); __builtin_amdgcn_sched_barrier(0); ELOAD(r3, 128 + j + 7); }
  }
#undef VROW
#undef CJ
#undef ELOAD
  int xo_ = 16 * lane; asm volatile("" : "+v"(xo_));
  float* xr = X1OUT + (size_t)t * 4096 + xo_; float ss = 0.f;
#ifdef PROBE_PEER_SCALE
#pragma unroll
  for (int k = 0; k < 4; ++k)
#pragma unroll
    for (int i = 0; i < 8; ++i) acc[k][i] *= PROBE_PEER_SCALE;
#endif
#pragma unroll
  for (int k = 0; k < 4; ++k)
#pragma unroll
    for (int q = 0; q < 4; ++q) { const f32x4 a = *(const f32x4*)(xr + 1024 * k + 4 * q);
      acc[k][2 * q] += (f32x2){a[0], a[1]}; acc[k][2 * q + 1] += (f32x2){a[2], a[3]};
      ss += acc[k][2 * q].x * acc[k][2 * q].x + acc[k][2 * q].y * acc[k][2 * q].y + acc[k][2 * q + 1].x * acc[k][2 * q + 1].x + acc[k][2 * q + 1].y * acc[k][2 * q + 1].y; }
  const float rstd = 1.0f / sqrtf(wave_sum(ss) * (1.0f / 4096.0f) + 1e-6f);
  const float* fn = fnorm + xo_;
#pragma unroll
  for (int k = 0; k < 4; ++k)
#pragma unroll
    for (int q = 0; q < 4; ++q) { const f32x4 g = *(const f32x4*)(fn + 1024 * k + 4 * q);
      f32x4 o; o[0] = acc[k][2 * q].x * rstd * g[0]; o[1] = acc[k][2 * q].y * rstd * g[1]; o[2] = acc[k][2 * q + 1].x * rstd * g[2]; o[3] = acc[k][2 * q + 1].y * rstd * g[3];
      if constexpr (STORE) { *(f32x4*)(xr + 1024 * k + 4 * q) = o; } else { asm volatile("" :: "v"(o)); } }
}
#undef PLAS
}

constexpr int BATCH = 2, SEQ = 8192, DM = 4096, T = BATCH * SEQ;
constexpr int NCAT = 15872;
constexpr int NPH = 12;
#ifndef MK_CUTS
#define MK_CUTS 1
#endif
constexpr float EPS = 1e-6f;
constexpr float LOG2E = 1.4426950408889634f;
constexpr float MLA_QSCALE = 0.07216878364870322f * LOG2E;
constexpr float NA_QSCALE = 0.08838834764831845f * LOG2E;

constexpr size_t MiB = 1u << 20;
constexpr size_t WS_CTL = 0, CTL_ZERO_BYTES = 1 * MiB;
constexpr size_t WS_ROPE = 1 * MiB;
constexpr size_t WS_RS = 1 * MiB + 65536;
constexpr size_t WS_WCAT = 2 * MiB;
constexpr size_t WS_WUQ = WS_WCAT + 124 * MiB;
constexpr size_t WS_WUKV = WS_WUQ + 5 * MiB;
constexpr size_t WS_PA = WS_WUKV + 4 * MiB;
constexpr size_t WS_PB = WS_PA + 16 * MiB;
constexpr size_t WS_WOUT = WS_PB + 16 * MiB;
constexpr size_t WS_WQ = WS_WOUT + 32 * MiB;
constexpr size_t WS_SUBH = WS_WQ + 16 * MiB;
constexpr size_t WS_SUBL = WS_SUBH + 512 * 1024;
constexpr size_t WS_R1 = WS_SUBL + 512 * 1024;
constexpr size_t WS_LAT = WS_R1 + 128 * MiB;
constexpr size_t WS_R2 = WS_LAT + 48 * MiB;
constexpr size_t WS_R3 = WS_R2 + 192 * MiB;
constexpr size_t WS_R4 = WS_R3 + 256 * MiB;
constexpr size_t WS_KR = WS_R4 + 224 * MiB;
constexpr size_t WS_IDX = WS_KR + 2 * MiB;
constexpr size_t WS_GATE = WS_IDX + 8 * MiB;
constexpr size_t WS_END = WS_GATE + 8 * MiB;
constexpr int CW_TMO = 0, CW_BAR = 4096;

constexpr int RING_BYTES = 131072, LDSCTL_OFF = RING_BYTES, MISC_OFF = LDSCTL_OFF + 320, LDS_BYTES = 147456;
constexpr int NWAVES = 8;

#define GAS __attribute__((address_space(1)))
#define LAS __attribute__((address_space(3)))
typedef unsigned short bf16;
typedef unsigned v4u __attribute__((ext_vector_type(4)));
typedef float f32x4 __attribute__((ext_vector_type(4)));
typedef float f32x8 __attribute__((ext_vector_type(8)));
typedef GAS unsigned gu32;
#define RLX_AGENT __ATOMIC_RELAXED, __HIP_MEMORY_SCOPE_AGENT
#define LDS_WAIT() asm volatile("s_waitcnt lgkmcnt(0)" ::: "memory")
#define VM_WAIT() asm volatile("s_waitcnt vmcnt(0)" ::: "memory")
__device__ __forceinline__ unsigned pkbf(float lo, float hi) { unsigned r; asm volatile("v_cvt_pk_bf16_f32 %0, %1, %2" : "=v"(r) : "v"(lo), "v"(hi)); return r; }

#define XB_TMO      128
#define XB_XCNT(j)  (256  + 64 * (j))
#define XB_XSUB(j)  (1280 + 64 * (j))
#define XB_XGEN(j)  (2304 + 64 * (j))
#define XB_TOP      3328
#define XB_TOPGEN   3392
#define XCD_BAR_WORDS 3456
#define XB_SPIN_CAP (1u << 22)
__device__ __forceinline__ unsigned xb_ld(unsigned* p)              { return __hip_atomic_load(p, __ATOMIC_RELAXED, __HIP_MEMORY_SCOPE_AGENT); }
__device__ __forceinline__ unsigned xb_add(unsigned* p, unsigned v) { return __hip_atomic_fetch_add(p, v, __ATOMIC_RELAXED, __HIP_MEMORY_SCOPE_AGENT); }
__device__ __forceinline__ unsigned xb_xcc_id() { return (unsigned)__builtin_amdgcn_s_getreg((3 << 11) | 20) & 0xFu; }
#define XB_SPIN(cond, bar) do { unsigned _sp = 0; while (cond) { __builtin_amdgcn_s_sleep(1); \
    if ((++_sp & 255u) == 0u) { if (xb_ld(&(bar)[XB_TMO])) break; if (_sp > XB_SPIN_CAP) { atomicAdd(&(bar)[XB_TMO], 1u); break; } } } } while (0)
struct XcdBarrier { unsigned* bar; unsigned x; volatile LAS unsigned* st; };
__device__ __forceinline__ XcdBarrier xcd_barrier_post(unsigned* bar, volatile LAS unsigned* st) {
    XcdBarrier b; b.bar = bar; b.x = xb_xcc_id(); b.st = st;
    if (threadIdx.x == 0) (void)xb_add(&bar[XB_XCNT(b.x)], 1u);
    return b;
}
__device__ __forceinline__ void xcd_barrier_complete(unsigned* bar, unsigned x, unsigned& nloc, unsigned& nx) {
    const unsigned G = gridDim.x * gridDim.y * gridDim.z;
    unsigned sum, cnt, mine, sp = 0u;
    for (;;) {
        sum = 0u; cnt = 0u; mine = 0u;
#pragma unroll
        for (unsigned j = 0; j < 16; ++j) { const unsigned c = xb_ld(&bar[XB_XCNT(j)]); sum += c; cnt += (c > 0u) ? 1u : 0u; mine = (j == x) ? c : mine; }
        if (sum == G) break;
        __builtin_amdgcn_s_sleep(1);
        if ((++sp & 255u) == 0u) { if (xb_ld(&bar[XB_TMO])) break; if (sp > XB_SPIN_CAP) { atomicAdd(&bar[XB_TMO], 1u); break; } }
    }
    nloc = mine > 0u ? mine : 1u; nx = cnt > 0u ? cnt : 1u;
}
__device__ __forceinline__ void xcd_barrier(const XcdBarrier& b) {
    asm volatile("s_waitcnt vmcnt(0)" ::: "memory");
    __syncthreads();
    if (threadIdx.x == 0) {
        unsigned* bar = b.bar;
        __builtin_amdgcn_s_waitcnt(0);
        unsigned nloc = b.st[0], nx = b.st[1];
        if (nloc == 0u) { xcd_barrier_complete(bar, b.x, nloc, nx); b.st[0] = nloc; b.st[1] = nx; }
        const unsigned old = xb_add(&bar[XB_XSUB(b.x)], 1u);
        const unsigned gen = old / nloc;
        if (old + 1u == (gen + 1u) * nloc) {
            __builtin_amdgcn_fence(__ATOMIC_RELEASE, "agent");
            asm volatile("s_waitcnt vmcnt(0)" ::: "memory");
            const unsigned og = xb_add(&bar[XB_TOP], 1u);
            const unsigned tg = og / nx;
            if (og + 1u == (tg + 1u) * nx) xb_add(&bar[XB_TOPGEN], 1u);
            else XB_SPIN(xb_ld(&bar[XB_TOPGEN]) == tg, bar);
            __builtin_amdgcn_fence(__ATOMIC_ACQUIRE, "agent");
            xb_add(&bar[XB_XGEN(b.x)], 1u);
            asm volatile("s_waitcnt vmcnt(0)" ::: "memory");
        } else {
            XB_SPIN(xb_ld(&bar[XB_XGEN(b.x)]) == gen, bar);
            __builtin_amdgcn_fence(__ATOMIC_ACQUIRE, "agent");
            asm volatile("s_waitcnt vmcnt(0)" ::: "memory");
        }
    }
    __syncthreads();
}

__device__ __forceinline__ float wave_sum(float v) {
#pragma unroll
    for (int o = 1; o < 64; o <<= 1) v += __shfl_xor(v, o);
    return v;
}
__device__ __forceinline__ void transpose_item(const float* W, int N, bf16* WT, int ldt, int row_off, const float* gk, LAS float* scr, int kb, int nb, int lane) {
    const int k0 = 64 * kb, n0 = 32 * nb;
#pragma unroll 8
    for (int i = 0; i < 32; ++i) { const int kk = 2 * i + (lane >> 5); float w = W[(size_t)(k0 + kk) * N + n0 + (lane & 31)]; if (gk) w *= gk[k0 + kk]; scr[kk * 33 + (lane & 31)] = w; }
    LDS_WAIT(); asm volatile("" ::: "memory");
    const int c = lane & 7;
#pragma unroll
    for (int j = 0; j < 4; ++j) { const int n = (lane >> 3) + 8 * j; const LAS float* s = scr + (8 * c) * 33 + n;
        v4u o; o.x = pkbf(s[0 * 33], s[1 * 33]); o.y = pkbf(s[2 * 33], s[3 * 33]); o.z = pkbf(s[4 * 33], s[5 * 33]); o.w = pkbf(s[6 * 33], s[7 * 33]);
        *(GAS v4u*)(WT + (size_t)(row_off + n0 + n) * ldt + k0 + 8 * c) = o; }
    LDS_WAIT(); asm volatile("" ::: "memory");
}
__device__ __forceinline__ void rms_row_to_bf16(const float* xrow, const float* gain, bf16* orow, int lane) {
    const GAS f32x4* xr = (const GAS f32x4*)xrow + lane; const GAS f32x4* gr = (const GAS f32x4*)gain + lane;
    f32x4 v[16]; float s = 0.f;
#pragma unroll
    for (int j = 0; j < 16; ++j) { v[j] = xr[64 * j]; s += (v[j].x * v[j].x + v[j].y * v[j].y) + (v[j].z * v[j].z + v[j].w * v[j].w); }
    const float rstd = 1.f / sqrtf(wave_sum(s) * (1.f / DM) + EPS);
    GAS unsigned long long* o8 = (GAS unsigned long long*)orow + lane;
#pragma unroll
    for (int j = 0; j < 16; ++j) { const f32x4 g = gr[64 * j];
        o8[64 * j] = (unsigned long long)pkbf(v[j].x * rstd * g.x, v[j].y * rstd * g.y) | ((unsigned long long)pkbf(v[j].z * rstd * g.z, v[j].w * rstd * g.w) << 32); }
}

struct Args {
    const float* in[19]; float* out; unsigned char* ws; int ph_lo, ph_hi, use_bar, pad;
};

__global__ void __launch_bounds__(NWAVES * 64, 2) mk_fwd(Args args) {
    extern __shared__ __attribute__((aligned(16))) unsigned char lds[];
    LAS unsigned char* ldsl = (LAS unsigned char*)lds;
    volatile LAS unsigned* MISC = (volatile LAS unsigned*)(ldsl + MISC_OFF);
    const int tid = threadIdx.x, lane = tid & 63, wave = __builtin_amdgcn_readfirstlane(tid >> 6);
    const int G = gridDim.x, bx = blockIdx.x;
    const int vcu = (G % 8 == 0) ? (bx % 8) * (G / 8) + bx / 8 : bx;
    const int gw = vcu * NWAVES + wave, NGW = G * NWAVES;
    unsigned char* ws = args.ws;
    gu32* ctl = (gu32*)(ws + WS_CTL);
    const float* x = args.in[0]; const float* attn_norm = args.in[1]; const float* w_in = args.in[2]; const float* q_norm = args.in[3]; const float* w_uq = args.in[4];
    const float* kv_norm = args.in[5]; const float* w_ukv = args.in[6]; const float* w_bmla = args.in[7]; const float* na_rpb = args.in[8]; const float* w_bna = args.in[9];
    const float* w_gate = args.in[10]; const float* b_gate = args.in[11]; const float* w_out = args.in[12]; const float* ffn_norm = args.in[13]; const float* peer_wq = args.in[14];
    const float* peer_sub = args.in[15]; const float* peer_u = args.in[16]; const float* peer_v = args.in[17]; const float* final_norm = args.in[18];
    float* out = args.out;
    float* ROPE = (float*)(ws + WS_ROPE); float* RS = (float*)(ws + WS_RS);
    bf16* WCAT = (bf16*)(ws + WS_WCAT); bf16* WUQ = (bf16*)(ws + WS_WUQ); bf16* WUKV = (bf16*)(ws + WS_WUKV); bf16* PA = (bf16*)(ws + WS_PA); bf16* PB = (bf16*)(ws + WS_PB);
    bf16* WOUT = (bf16*)(ws + WS_WOUT); bf16* WQ = (bf16*)(ws + WS_WQ); bf16* SUBH = (bf16*)(ws + WS_SUBH); bf16* SUBL = (bf16*)(ws + WS_SUBL);
    bf16* XN = (bf16*)(ws + WS_R1); bf16* OA = (bf16*)(ws + WS_R1); bf16* OB = (bf16*)(ws + WS_R1 + 64 * MiB); bf16* H2 = (bf16*)(ws + WS_R1);
    bf16* LAT = (bf16*)(ws + WS_LAT);
    bf16* NAQ = (bf16*)(ws + WS_R2); bf16* NAK = (bf16*)(ws + WS_R2 + 64 * MiB); bf16* NAV = (bf16*)(ws + WS_R2 + 128 * MiB); bf16* MRG = (bf16*)(ws + WS_R2);
    bf16* GT = (bf16*)(ws + WS_R3); unsigned char* U8 = ws + WS_R3; unsigned char* V8 = ws + WS_R3 + 64 * MiB;
    bf16* QM = (bf16*)(ws + WS_R4); bf16* KN = (bf16*)(ws + WS_R4 + 96 * MiB); bf16* VM = (bf16*)(ws + WS_R4 + 160 * MiB); float* QP = (float*)(ws + WS_R4);
    bf16* KR = (bf16*)(ws + WS_KR); int* IDX = (int*)(ws + WS_IDX); float* GATE = (float*)(ws + WS_GATE);

    for (int u = tid; u < (LDS_BYTES - LDSCTL_OFF) / 4; u += NWAVES * 64) ((LAS unsigned*)(ldsl + LDSCTL_OFF))[u] = 0u;
    __syncthreads();
    XcdBarrier bar; bar.bar = (unsigned*)(ctl + CW_BAR); bar.x = 0; bar.st = nullptr;
    if (args.use_bar) bar = xcd_barrier_post((unsigned*)(ctl + CW_BAR), MISC + 8);
    const int lo = args.ph_lo, hi = args.ph_hi;
#ifndef MK_PHMASK
#define MK_PHMASK 0xFFF
#endif
#define IN(k) (((MK_PHMASK >> (k)) & 1) && lo <= (k) && (k) < hi)
#ifndef MK_DUP
#define MK_DUP -1
#endif
#define REPS(k) ((MK_DUP == (k)) ? 2 : 1)
#define SEAM(k) do { if (IN(k) && IN((k) + 1)) xcd_barrier(bar); } while (0)

    for (int rep_ = 0; rep_ < REPS(0); ++rep_) if (IN(0)) {
        LAS float* scr = (LAS float*)(ldsl + wave * 16384);
        constexpr int I0 = 64 * 234, I1 = 64 * 256, I2 = 12 * 96, I3 = 8 * 128, I4 = 32 * 128, I5 = 32 * 128, I6 = 64 * 128, I7 = 64 * 64;
        constexpr int NITEMS = I0 + I1 + I2 + I3 + I4 + I5 + I6 + I7;
        for (int it = gw; it < NITEMS; it += NGW) {
            int r = it;
            if (r < I0) { const int kb = r / 234, nb = r % 234; const int off = (nb >= 42) ? 192 : 0; transpose_item(w_in, 7488, WCAT, 4096, off, nullptr, scr, kb, nb, lane); continue; } r -= I0;
            if (r < I1) { transpose_item(w_gate, 8192, WCAT, 4096, 7680, nullptr, scr, r / 256, r % 256, lane); continue; } r -= I1;
            if (r < I2) { transpose_item(w_uq, 3072, WUQ, 768, 0, q_norm, scr, r / 96, r % 96, lane); continue; } r -= I2;
            if (r < I3) { transpose_item(w_ukv, 4096, WUKV, 512, 0, kv_norm, scr, r / 128, r % 128, lane); continue; } r -= I3;
            if (r < I4) { transpose_item(w_bmla, 4096, PA, 2048, 0, nullptr, scr, r / 128, r % 128, lane); continue; } r -= I4;
            if (r < I5) { transpose_item(w_bna, 4096, PB, 2048, 0, nullptr, scr, r / 128, r % 128, lane); continue; } r -= I5;
            if (r < I6) { transpose_item(w_out, 4096, WOUT, 4096, 0, nullptr, scr, r / 128, r % 128, lane); continue; } r -= I6;
            transpose_item(peer_wq, 2048, WQ, 4096, 0, nullptr, scr, r / 64, r % 64, lane);
        }
        for (int i = gw * 64 + lane; i < 192 * 4096 / 8; i += NGW * 64) ((GAS v4u*)(WCAT + (size_t)1344 * 4096))[i] = (v4u){0u, 0u, 0u, 0u};
        for (int i = gw * 64 + lane; i < 8 * 2 * 128 * 128 / 2; i += NGW * 64) { const float a = peer_sub[2 * i], b = peer_sub[2 * i + 1];
            const unsigned h = pkbf(a, b); const unsigned l = pkbf(a - __uint_as_float(h << 16), b - __uint_as_float(h & 0xffff0000u));
            ((GAS unsigned*)SUBH)[i] = h; ((GAS unsigned*)SUBL)[i] = l; }
        for (int i = gw * 64 + lane; i < 128 * 16; i += NGW * 64) { const int pos = i >> 4, j = i & 15; const float fr = powf(10000.0f, -(float)j / 16.0f); const float ang = (float)pos * fr;
            ROPE[2 * i] = cosf(ang); ROPE[2 * i + 1] = sinf(ang); }
        for (int m = gw; m < T; m += NGW) rms_row_to_bf16(x + (size_t)m * DM, attn_norm, XN + (size_t)m * DM, lane);
    }
    SEAM(0);
    for (int rep_ = 0; rep_ < REPS(1); ++rep_) if (IN(1)) {
        pg8::Gemm g{XN, WCAT, T, NCAT, DM, DM, DM}; pg8::StaticOrder S; S.init(T, NCAT, G, bx);
        pg8::EpiIn E{ws, WS_LAT, WS_R2, 64 * MiB, WS_R3, b_gate, NA_QSCALE};
        pg8::gemm_phase<pg8::EpiIn, pg8::StaticOrder>(ldsl, g, S, E);
    }
    SEAM(1);
    for (int rep_ = 0; rep_ < REPS(2); ++rep_) if (IN(2)) {
        for (int m = gw; m < T; m += NGW) {
            const bf16* row = LAT + (size_t)m * 1536;
            float sq = 0.f, skv = 0.f;
#pragma unroll
            for (int j = 0; j < 6; ++j) { const unsigned w = ((const GAS unsigned*)row)[lane + 64 * j]; const float a = __uint_as_float(w << 16), b = __uint_as_float(w & 0xffff0000u); sq += a * a + b * b; }
#pragma unroll
            for (int j = 0; j < 4; ++j) { const unsigned w = ((const GAS unsigned*)(row + 768))[lane + 64 * j]; const float a = __uint_as_float(w << 16), b = __uint_as_float(w & 0xffff0000u); skv += a * a + b * b; }
            sq = wave_sum(sq); skv = wave_sum(skv);
            if (lane == 0) { RS[2 * m] = 1.f / sqrtf(sq * (1.f / 768.f) + EPS); RS[2 * m + 1] = 1.f / sqrtf(skv * (1.f / 512.f) + EPS); }
            const float xk = __uint_as_float((unsigned)row[1280 + lane] << 16);
            const float xp = __shfl_xor(xk, 16);
            const int s = m & (SEQ - 1), pos = (lane < 32) ? (s >> 6) : (s & 63), j = lane & 15;
            const float c = ROPE[(pos * 16 + j) * 2], sn = ROPE[(pos * 16 + j) * 2 + 1];
            const float o = ((lane & 16) == 0) ? (xk * c - xp * sn) : (xp * sn + xk * c);
            KR[(size_t)m * 64 + lane] = (bf16)(pkbf(o, 0.f) & 0xffffu);
        }
    }
    SEAM(2);
    for (int rep_ = 0; rep_ < REPS(3); ++rep_) if (IN(3)) {
        { pg8::Gemm g{LAT, WUQ, T, 3072, 768, 1536, 768}; pg8::StaticOrder S; S.init(T, 3072, G, bx);
          pg8::EpiQ E{QM, RS, ROPE, MLA_QSCALE};
          pg8::gemm_phase<pg8::EpiQ, pg8::StaticOrder>(ldsl, g, S, E); }
        { pg8::Gemm g{LAT + 768, WUKV, T, 4096, 512, 1536, 512}; pg8::StaticOrder S; S.init(T, 4096, G, bx);
          pg8::EpiKV E{KN, VM, RS};
          pg8::gemm_phase<pg8::EpiKV, pg8::StaticOrder>(ldsl, g, S, E); }
    }
    SEAM(3);
    for (int rep_ = 0; rep_ < REPS(4); ++rep_) if (IN(4)) {
#ifndef NO_MLA
#pragma unroll 1
        for (int u = vcu; u < BATCH * 16 * 32; u += G) { const int bh = u >> 5, qb = u & 31; att::mla_unit(bh >> 4, bh & 15, qb, QM, KN, KR, VM, OA, (char*)lds); }
#endif
#ifndef NO_NA
#pragma unroll 1
        for (int u = vcu; u < BATCH * 16 * 32; u += G) { const int bh = u >> 5, rg = u & 31; att::na_unit(bh >> 4, bh & 15, rg, NAQ, NAK, NAV, na_rpb, OB, (char*)lds); }
#endif
        __syncthreads();
    }
    SEAM(4);
    for (int rep_ = 0; rep_ < REPS(5); ++rep_) if (IN(5)) {
        { pg8::Gemm g{OA, PA, T, DM, 2048, 2048, 2048}; pg8::StaticOrder S; S.init(T, DM, G, bx);
          pg8::EpiGate<true> E{GT, MRG};
          pg8::gemm_phase<pg8::EpiGate<true>, pg8::StaticOrder>(ldsl, g, S, E); }
    }
    SEAM(5);
    for (int rep_ = 0; rep_ < REPS(6); ++rep_) if (IN(6)) {
        { pg8::Gemm g{OB, PB, T, DM, 2048, 2048, 2048}; pg8::StaticOrder S; S.init(T, DM, G, bx);
          pg8::EpiGate<false> E{GT, MRG};
          pg8::gemm_phase<pg8::EpiGate<false>, pg8::StaticOrder>(ldsl, g, S, E); }
    }
    SEAM(6);
    for (int rep_ = 0; rep_ < REPS(7); ++rep_) if (IN(7)) {
        pg8::Gemm g{MRG, WOUT, T, DM, DM, DM, DM}; pg8::StaticOrder S; S.init(T, DM, G, bx);
        pg8::EpiF32 E{x, out, DM};
        pg8::gemm_phase<pg8::EpiF32, pg8::StaticOrder>(ldsl, g, S, E);
#ifdef PROBE_SKIP_ATTN
        VM_WAIT(); __syncthreads();
        for (size_t i = (size_t)gw * 64 + lane; i < (size_t)T * DM / 4; i += (size_t)NGW * 64) ((GAS f32x4*)out)[i] = ((const GAS f32x4*)x)[i];
#endif
    }
    SEAM(7);
    for (int rep_ = 0; rep_ < REPS(8); ++rep_) if (IN(8)) {
        for (int m = gw; m < T; m += NGW) rms_row_to_bf16(out + (size_t)m * DM, ffn_norm, H2 + (size_t)m * DM, lane);
        const size_t n16 = (size_t)16384 * 4096 / 16;
        for (size_t i = (size_t)gw * 64 + lane; i < 2 * n16; i += (size_t)NGW * 64) {
            const bool isu = i < n16; const size_t j = isu ? i : i - n16; const float sc = isu ? peer::USCALE : peer::VSCALE;
            const GAS f32x4* src = (const GAS f32x4*)((isu ? peer_u : peer_v) + j * 16);
            const f32x4 a = src[0] * sc, b = src[1] * sc, c = src[2] * sc, d = src[3] * sc;
            v4u o; int w;
            w = __builtin_amdgcn_cvt_pk_fp8_f32(a[0], a[1], 0, false); w = __builtin_amdgcn_cvt_pk_fp8_f32(a[2], a[3], w, true); o.x = (unsigned)w;
            w = __builtin_amdgcn_cvt_pk_fp8_f32(b[0], b[1], 0, false); w = __builtin_amdgcn_cvt_pk_fp8_f32(b[2], b[3], w, true); o.y = (unsigned)w;
            w = __builtin_amdgcn_cvt_pk_fp8_f32(c[0], c[1], 0, false); w = __builtin_amdgcn_cvt_pk_fp8_f32(c[2], c[3], w, true); o.z = (unsigned)w;
            w = __builtin_amdgcn_cvt_pk_fp8_f32(d[0], d[1], 0, false); w = __builtin_amdgcn_cvt_pk_fp8_f32(d[2], d[3], w, true); o.w = (unsigned)w;
            *(GAS v4u*)((isu ? U8 : V8) + j * 16) = o;
        }
    }
    SEAM(8);
    for (int rep_ = 0; rep_ < REPS(9); ++rep_) if (IN(9)) {
        pg8::Gemm g{H2, WQ, T, 2048, DM, DM, DM}; pg8::StaticOrder S; S.init(T, 2048, G, bx);
        pg8::EpiF32 E{nullptr, QP, 2048};
        pg8::gemm_phase<pg8::EpiF32, pg8::StaticOrder>(ldsl, g, S, E);
    }
    SEAM(9);
    for (int rep_ = 0; rep_ < REPS(10); ++rep_) if (IN(10)) {
        LAS int* wl = (LAS int*)(ldsl + wave * peer::SEL_LDS_PER_WAVE);
        for (int grp = gw; grp < T / 32; grp += NGW) peer::select32(grp * 32, QP, SUBH, SUBL, IDX, GATE, wl, lane);
    }
    SEAM(10);
    for (int rep_ = 0; rep_ < REPS(11); ++rep_) if (IN(11)) {
#ifdef PROBE_SKIP_PEER
        for (int t = gw; t < T; t += NGW) { float* xr = out + (size_t)t * DM; f32x4 v[16]; float ss = 0.f;
            for (int j = 0; j < 16; ++j) { v[j] = ((const GAS f32x4*)xr)[lane + 64 * j]; ss += v[j].x * v[j].x + v[j].y * v[j].y + v[j].z * v[j].z + v[j].w * v[j].w; }
            const float rstd = 1.f / sqrtf(wave_sum(ss) * (1.f / DM) + EPS);
            for (int j = 0; j < 16; ++j) { const f32x4 g = ((const GAS f32x4*)final_norm)[lane + 64 * j]; ((GAS f32x4*)xr)[lane + 64 * j] = v[j] * rstd * g; } }
#else
        if (MK_DUP == 11 && rep_ == 0) { for (int t = gw; t < T; t += NGW) peer::expert_token<false>(t, H2, U8, V8, IDX, GATE, out, final_norm, lane); }
        else { for (int t = gw; t < T; t += NGW) peer::expert_token<true>(t, H2, U8, V8, IDX, GATE, out, final_norm, lane); }
#endif
    }
#undef IN
#undef SEAM
}

extern "C" void kernel_launch(void* const* d_in, const int* in_sizes, int n_in, void* d_out, int out_size, void* d_ws, size_t ws_size, hipStream_t stream) {
    static int grid = 0;
    if (grid == 0) {
        if (n_in != 19 || out_size != T * DM || ws_size < WS_END) { fprintf(stderr, "kernel_launch: shape mismatch: n_in %d out %d ws %zu (need %zu)\n", n_in, out_size, ws_size, (size_t)WS_END); grid = -1; return; }
        int dev = 0, cus = 0, per_cu = 0;
        if (hipGetDevice(&dev) != hipSuccess || hipDeviceGetAttribute(&cus, hipDeviceAttributeMultiprocessorCount, dev) != hipSuccess) { grid = -1; return; }
        if (hipFuncSetAttribute((const void*)mk_fwd, hipFuncAttributeMaxDynamicSharedMemorySize, LDS_BYTES) != hipSuccess) { fprintf(stderr, "kernel_launch: hipFuncSetAttribute failed\n"); grid = -1; return; }
        if (hipOccupancyMaxActiveBlocksPerMultiprocessor(&per_cu, (const void*)mk_fwd, NWAVES * 64, LDS_BYTES) != hipSuccess || per_cu < 1) { fprintf(stderr, "kernel_launch: occupancy query says %d blocks per CU\n", per_cu); }
        (void)hipGetLastError();
        grid = cus;
    }
    if (grid < 0) return;
    if (hipMemsetAsync((char*)d_ws + WS_CTL, 0, CTL_ZERO_BYTES, stream) != hipSuccess) return;
    Args a{};
    for (int i = 0; i < 19; ++i) a.in[i] = (const float*)d_in[i];
    a.out = (float*)d_out; a.ws = (unsigned char*)d_ws; a.pad = 0;
    constexpr int NL = MK_CUTS;
    for (int li = 0; li < NL; ++li) {
        a.ph_lo = (NL == 1) ? 0 : li; a.ph_hi = (NL == 1) ? NPH : li + 1; a.use_bar = (NL == 1) ? 1 : 0;
        hipLaunchKernelGGL(mk_fwd, dim3(grid), dim3(NWAVES * 64), LDS_BYTES, stream, a);
    }
}
```

```cpp
#include <hip/hip_runtime.h>
#include <hip/hip_bf16.h>
#include <cstdio>
#include <cstdint>

namespace pg8 {
#define PG8_LAS __attribute__((address_space(3)))
typedef unsigned short bf16_t;
typedef short bf16x8 __attribute__((ext_vector_type(8)));
typedef float f32x4 __attribute__((ext_vector_type(4)));
typedef float f32x2 __attribute__((ext_vector_type(2)));
typedef unsigned u32x4 __attribute__((ext_vector_type(4)));
typedef unsigned u32x2 __attribute__((ext_vector_type(2)));
constexpr int BM = 256, BK = 64, HALF = 128, HTB = HALF * BK * 2  , STAGE_BYTES = 8 * HTB, NXCD = 8, WGM = 8;

__host__ __device__ __forceinline__ int lds_byte(int r, int c) { const int st = (r >> 4) * 2 + (c >> 5), rr = r & 15, cc = c & 31, ob = rr * 64 + cc * 2; return st * 1024 + (ob ^ (((ob >> 9) & 1) << 5)); }
__host__ __device__ __forceinline__ void stage_rc(int b, int& R, int& C) { const int st = b / 1024, sb = b % 1024, swz = sb ^ (((sb >> 9) & 1) << 5); R = (st >> 1) * 16 + swz / 64; C = (st & 1) * 32 + (swz % 64) / 2; }
__host__ __device__ __forceinline__ int perm32(int rho) { const int n = rho >> 4, i = rho & 15; return 8 * (i >> 2) + 4 * n + (i & 3); }

struct Unit { int pm, pn; };
struct Gemm { const bf16_t* A; const bf16_t* Bt; int M, N, K, lda, ldb; };

struct StaticOrder {
    int nM, nN, nwg, G, c;
    __host__ __device__ void init(int M, int N, int G_, int c_) { nM = M / BM; nN = N / BM; nwg = nM * nN; G = G_; c = c_; }
    __host__ __device__ bool next(int i, Unit& u) const {
        const long L = (long)i * G + c; if (L >= nwg) return false;
        int wgid = (int)L; { const int q = nwg / NXCD, r = nwg % NXCD, xcd = wgid % NXCD, off = wgid / NXCD; wgid = (xcd < r ? xcd * (q + 1) : r * (q + 1) + (xcd - r) * q) + off; }
        const int nig = WGM * nN, gid = wgid / nig, fm = gid * WGM, gsz = (nM - fm) < WGM ? (nM - fm) : WGM;
        u.pm = fm + ((wgid % nig) % gsz); u.pn = (wgid % nig) / gsz; return true;
    }
    __device__ __forceinline__ void a_ready(const Unit&) const {}
    __device__ __forceinline__ void done(const Unit&) const {}
};

__device__ __forceinline__ unsigned cvt_pk_bf16(float lo, float hi) { unsigned r; asm volatile("v_cvt_pk_bf16_f32 %0, %1, %2" : "=v"(r) : "v"(lo), "v"(hi)); return r; }
__device__ __forceinline__ float bf_lo(unsigned w) { return __uint_as_float(w << 16); }
__device__ __forceinline__ float bf_hi(unsigned w) { return __uint_as_float(w & 0xffff0000u); }


template <class Epi, class Sched, bool ALIGN_EPI = true>
__device__ __forceinline__ void gemm_phase(PG8_LAS unsigned char* lds, const Gemm g, const Sched& S, const Epi& E) {
    const int tid = threadIdx.x, wid = __builtin_amdgcn_readfirstlane(tid >> 6), lane = tid & 63, wr = wid >> 2, wc = wid & 3, fr = lane & 15, fq = lane >> 4;
    const int K = g.K, nt = K / BK;
    unsigned voffA[2], voffB[2];
#pragma unroll
    for (int i = 0; i < 2; ++i) { int R, C; stage_rc(tid * 16 + i * 8192, R, C); const int Rb = Epi::PERM ? ((R & ~31) + perm32(R & 31)) : R;
        voffA[i] = (unsigned)(R * g.lda + C) * 2u; voffB[i] = (unsigned)(Rb * g.ldb + C) * 2u; }
    const size_t kstep = (size_t)(BK * 2);
    const size_t hstepA = (size_t)HALF * g.lda * 2, hstepB = (size_t)HALF * g.ldb * 2;
    const size_t tstepA = 2 * hstepA, tstepB = 2 * hstepB;
    const unsigned ldsw = (unsigned)wid * 1024u;
    const int aoff = lds_byte(wr * 64 + fr, fq * 8), boff = lds_byte(wc * 32 + fr, fq * 8);
#define PG8_SA(b, h) (((b) * 2 + (h)) * HTB)
#define PG8_SB(b, h) ((4 + (b) * 2 + (h)) * HTB)
#define PG8_STAGE(bufoff, gbase, voff) do { _Pragma("unroll") for (int _i = 0; _i < 2; ++_i) \
        __builtin_amdgcn_global_load_lds((const unsigned*)((const char*)(gbase) + (voff)[_i]), (PG8_LAS unsigned*)(lds + (bufoff) + ldsw + _i * 8192), 16, 0, 0); } while (0)
#define PG8_LDA(dst, b, h) do { _Pragma("unroll") for (int m = 0; m < 4; ++m) _Pragma("unroll") for (int k = 0; k < 2; ++k) dst[m][k] = *(const PG8_LAS bf16x8*)(lds + PG8_SA(b, h) + aoff + m * 2048 + k * 1024); } while (0)
#define PG8_LDB(dst, b, h) do { _Pragma("unroll") for (int n = 0; n < 2; ++n) _Pragma("unroll") for (int k = 0; k < 2; ++k) dst[n][k] = *(const PG8_LAS bf16x8*)(lds + PG8_SB(b, h) + boff + n * 2048 + k * 1024); } while (0)
#define PG8_MMA(ai, bj, At, Bt) do { __builtin_amdgcn_s_setprio(1); _Pragma("unroll") for (int m = 0; m < 4; ++m) _Pragma("unroll") for (int n = 0; n < 2; ++n) _Pragma("unroll") for (int k = 0; k < 2; ++k) \
        acc[ai][bj][m][n] = __builtin_amdgcn_mfma_f32_16x16x32_bf16(Bt[n][k], At[m][k], acc[ai][bj][m][n], 0, 0, 0); __builtin_amdgcn_s_setprio(0); } while (0)
#define PG8_WAIT_V(n) asm volatile("s_waitcnt vmcnt(" #n ")" ::: "memory")
#define PG8_WAIT_L(n) asm volatile("s_waitcnt lgkmcnt(" #n ")" ::: "memory")
#define PG8_BAR __builtin_amdgcn_s_barrier()
#define PG8_SCHED __builtin_amdgcn_sched_barrier(0)
    Unit cur, nxt; int ui = 0;
    if (!S.next(0, cur)) return;
    f32x4 acc[2][2][4][2];
#pragma unroll
    for (int a = 0; a < 2; ++a)
#pragma unroll
        for (int b = 0; b < 2; ++b)
#pragma unroll
            for (int m = 0; m < 4; ++m)
#pragma unroll
                for (int n = 0; n < 2; ++n) acc[a][b][m][n] = (f32x4){0.f, 0.f, 0.f, 0.f};
    bf16x8 At[4][2], B0[2][2], B1[2][2];
    const char* cA = (const char*)g.A + (size_t)cur.pm * tstepA; const char* cB = (const char*)g.Bt + (size_t)cur.pn * tstepB;
    S.a_ready(cur);
    PG8_STAGE(PG8_SB(0, 0), cB, voffB); PG8_STAGE(PG8_SB(0, 1), cB + hstepB, voffB); PG8_STAGE(PG8_SA(0, 0), cA, voffA); PG8_STAGE(PG8_SA(0, 1), cA + hstepA, voffA);
    if (wr == 1) PG8_BAR;
    PG8_WAIT_V(2); PG8_BAR;
    PG8_STAGE(PG8_SB(1, 0), cB + kstep, voffB); PG8_STAGE(PG8_SA(1, 0), cA + kstep, voffA); PG8_STAGE(PG8_SB(1, 1), cB + hstepB + kstep, voffB);
    PG8_WAIT_V(6); PG8_BAR;
    for (;;) {
        const bool has_next = S.next(ui + 1, nxt);
        const char* nA = has_next ? (const char*)g.A + (size_t)nxt.pm * tstepA : cA; const char* nB = has_next ? (const char*)g.Bt + (size_t)nxt.pn * tstepB : cB;
        for (int t = 0; t < nt; t += 2) {
            const bool last = (t == nt - 2);
            const char* a1 = cA + (size_t)(t + 1) * kstep;
            const char* a2 = last ? nA : cA + (size_t)(t + 2) * kstep; const char* b2 = last ? nB : cB + (size_t)(t + 2) * kstep;
            const char* a3 = a2 + kstep; const char* b3 = b2 + kstep;
            if (last && has_next) S.a_ready(nxt);
            PG8_LDB(B0, 0, 0); PG8_LDB(B1, 0, 1); PG8_SCHED; PG8_LDA(At, 0, 0); PG8_STAGE(PG8_SA(1, 1), a1 + hstepA, voffA);
            PG8_WAIT_V(8); PG8_WAIT_L(0); PG8_BAR; PG8_MMA(0, 0, At, B0); PG8_MMA(0, 1, At, B1); PG8_BAR; PG8_SCHED;
            PG8_LDA(At, 0, 1); PG8_STAGE(PG8_SB(0, 0), b2, voffB); PG8_STAGE(PG8_SB(0, 1), b2 + hstepB, voffB); PG8_STAGE(PG8_SA(0, 0), a2, voffA);
            PG8_WAIT_V(8); PG8_WAIT_L(0); PG8_BAR; PG8_MMA(1, 0, At, B0); PG8_MMA(1, 1, At, B1); PG8_BAR; PG8_SCHED;
            PG8_LDB(B0, 1, 0); PG8_LDB(B1, 1, 1); PG8_SCHED; PG8_LDA(At, 1, 0); PG8_STAGE(PG8_SA(0, 1), a2 + hstepA, voffA);
            PG8_WAIT_V(8); PG8_WAIT_L(0); PG8_BAR; PG8_MMA(0, 0, At, B0); PG8_MMA(0, 1, At, B1); PG8_BAR; PG8_SCHED;
            PG8_LDA(At, 1, 1); PG8_STAGE(PG8_SB(1, 0), b3, voffB); PG8_STAGE(PG8_SB(1, 1), b3 + hstepB, voffB); PG8_STAGE(PG8_SA(1, 0), a3, voffA);
            PG8_WAIT_V(8); PG8_WAIT_L(0); PG8_BAR; PG8_MMA(1, 0, At, B0); PG8_MMA(1, 1, At, B1); PG8_BAR; PG8_SCHED;
        }
        if constexpr (ALIGN_EPI) { if (wr == 0) PG8_BAR; }
        E(acc, cur, wr, wc, fr, fq); S.done(cur);
        if (!has_next) break;
#pragma unroll
        for (int a = 0; a < 2; ++a)
#pragma unroll
            for (int b = 0; b < 2; ++b)
#pragma unroll
                for (int m = 0; m < 4; ++m)
#pragma unroll
                    for (int n = 0; n < 2; ++n) acc[a][b][m][n] = (f32x4){0.f, 0.f, 0.f, 0.f};
        cur = nxt; cA = nA; cB = nB; ++ui;
        if constexpr (ALIGN_EPI) { if (wr == 1) PG8_BAR; }
    }
    PG8_WAIT_V(0);
    if constexpr (!ALIGN_EPI) { if (wr == 0) PG8_BAR; }
    PG8_BAR;
#undef PG8_SA
#undef PG8_SB
#undef PG8_STAGE
#undef PG8_LDA
#undef PG8_LDB
#undef PG8_MMA
#undef PG8_WAIT_V
#undef PG8_WAIT_L
#undef PG8_BAR
#undef PG8_SCHED
}

__device__ __forceinline__ float sigmoidf_fast(float x) { return __builtin_amdgcn_rcpf(1.0f + __builtin_amdgcn_exp2f(-1.4426950408889634f * x)); }

struct EpiIn {
    static constexpr bool PERM = true;
    unsigned char* wsb; size_t off_lat, off_na, na_stride, off_g; const float* bgate; float qscale;
    __device__ __forceinline__ void operator()(const f32x4 (&acc)[2][2][4][2], const Unit& u, int wr, int wc, int fr, int fq) const {
        const int row0 = u.pm * BM + wr * 64 + fr; const int pn = u.pn;
        size_t boff; int ldc, colt; float sc = 1.f; bool gate = false;
        if (pn < 6) { boff = off_lat; ldc = 1536; colt = pn * 256; }
        else if (pn < 30) { const int t = (pn - 6) >> 3; boff = off_na + (size_t)t * na_stride; ldc = 2048; colt = ((pn - 6) & 7) * 256; if (t == 0) sc = qscale; }
        else { boff = off_g; ldc = 8192; colt = (pn - 30) * 256; gate = true; }
        bf16_t* base = (bf16_t*)(wsb + boff);
        const int col0 = colt + wc * 32 + 8 * fq;
        f32x4 bv[2][2];
#pragma unroll
        for (int bj = 0; bj < 2; ++bj)
#pragma unroll
            for (int n = 0; n < 2; ++n) bv[bj][n] = gate ? *(const f32x4*)(bgate + col0 + bj * HALF + 4 * n) : (f32x4){0.f, 0.f, 0.f, 0.f};
#pragma unroll
        for (int ai = 0; ai < 2; ++ai)
#pragma unroll
            for (int m = 0; m < 4; ++m) { bf16_t* rowp = base + (size_t)(row0 + ai * HALF + m * 16) * ldc + col0;
#pragma unroll
                for (int bj = 0; bj < 2; ++bj) { f32x4 v0 = acc[ai][bj][m][0] + bv[bj][0], v1 = acc[ai][bj][m][1] + bv[bj][1];
                    if (gate) {
#pragma unroll
                        for (int i = 0; i < 4; ++i) { v0[i] = sigmoidf_fast(v0[i]); v1[i] = sigmoidf_fast(v1[i]); } }
                    else { v0 = v0 * sc; v1 = v1 * sc; }
                    u32x4 w; w.x = cvt_pk_bf16(v0[0], v0[1]); w.y = cvt_pk_bf16(v0[2], v0[3]); w.z = cvt_pk_bf16(v1[0], v1[1]); w.w = cvt_pk_bf16(v1[2], v1[3]);
                    *(u32x4*)(rowp + bj * HALF) = w; } }
    }
};

struct EpiQ {
    static constexpr bool PERM = false;
    bf16_t* Q; const float* rs; const float* rope; float qscale;
    __device__ __forceinline__ void operator()(const f32x4 (&acc)[2][2][4][2], const Unit& u, int wr, int wc, int fr, int fq) const {
#pragma unroll
        for (int ai = 0; ai < 2; ++ai)
#pragma unroll
            for (int m = 0; m < 4; ++m) {
                const int row = u.pm * BM + ai * HALF + wr * 64 + m * 16 + fr;
                const float rstd = rs[2 * row] * qscale;
                const int s = row & 8191, grow = s >> 6, gcol = s & 63;
#pragma unroll
                for (int bj = 0; bj < 2; ++bj) {
                    const int gg = 8 * u.pn + 4 * bj + wc, kind = gg % 6;
                    f32x4 v0 = acc[ai][bj][m][0] * rstd, v1 = acc[ai][bj][m][1] * rstd;
                    if (kind >= 4) {
                        const int pos = (kind == 4) ? grow : gcol;
                        const f32x4 t0 = *(const f32x4*)(rope + (size_t)(pos * 16 + 4 * fq) * 2), t1 = *(const f32x4*)(rope + (size_t)(pos * 16 + 4 * fq) * 2 + 4);
                        const float c0 = t0[0], s0 = t0[1], c1 = t0[2], s1 = t0[3], c2 = t1[0], s2 = t1[1], c3 = t1[2], s3 = t1[3];
                        f32x4 o0, o1;
                        o0[0] = v0[0] * c0 - v1[0] * s0; o1[0] = v0[0] * s0 + v1[0] * c0;
                        o0[1] = v0[1] * c1 - v1[1] * s1; o1[1] = v0[1] * s1 + v1[1] * c1;
                        o0[2] = v0[2] * c2 - v1[2] * s2; o1[2] = v0[2] * s2 + v1[2] * c2;
                        o0[3] = v0[3] * c3 - v1[3] * s3; o1[3] = v0[3] * s3 + v1[3] * c3;
                        v0 = o0; v1 = o1;
                    }
                    bf16_t* p = Q + (size_t)row * 3072 + u.pn * BM + bj * HALF + wc * 32 + 4 * fq;
                    u32x2 w0, w1; w0.x = cvt_pk_bf16(v0[0], v0[1]); w0.y = cvt_pk_bf16(v0[2], v0[3]); w1.x = cvt_pk_bf16(v1[0], v1[1]); w1.y = cvt_pk_bf16(v1[2], v1[3]);
                    *(u32x2*)p = w0; *(u32x2*)(p + 16) = w1;
                }
            }
    }
};

struct EpiKV {
    static constexpr bool PERM = true;
    bf16_t* Kn; bf16_t* Vm; const float* rs;
    __device__ __forceinline__ void operator()(const f32x4 (&acc)[2][2][4][2], const Unit& u, int wr, int wc, int fr, int fq) const {
        const int col0 = u.pn * HALF + wc * 32 + 8 * fq;
#pragma unroll
        for (int ai = 0; ai < 2; ++ai)
#pragma unroll
            for (int m = 0; m < 4; ++m) {
                const int row = u.pm * BM + ai * HALF + wr * 64 + m * 16 + fr;
                const float rstd = rs[2 * row + 1];
#pragma unroll
                for (int bj = 0; bj < 2; ++bj) { const f32x4 v0 = acc[ai][bj][m][0] * rstd, v1 = acc[ai][bj][m][1] * rstd;
                    u32x4 w; w.x = cvt_pk_bf16(v0[0], v0[1]); w.y = cvt_pk_bf16(v0[2], v0[3]); w.z = cvt_pk_bf16(v1[0], v1[1]); w.w = cvt_pk_bf16(v1[2], v1[3]);
                    *(u32x4*)((bj == 0 ? Kn : Vm) + (size_t)row * 2048 + col0) = w; }
            }
    }
};

template <bool FIRST> struct EpiGate {
    static constexpr bool PERM = true;
    const bf16_t* G; bf16_t* MRG;
    __device__ __forceinline__ void operator()(const f32x4 (&acc)[2][2][4][2], const Unit& u, int wr, int wc, int fr, int fq) const {
        const int col0 = u.pn * BM + wc * 32 + 8 * fq;
#pragma unroll
        for (int ai = 0; ai < 2; ++ai)
#pragma unroll
            for (int m = 0; m < 4; ++m) {
                const int row = u.pm * BM + ai * HALF + wr * 64 + m * 16 + fr;
#pragma unroll
                for (int bj = 0; bj < 2; ++bj) {
                    const int col = col0 + bj * HALF;
                    const u32x4 gw = *(const u32x4*)(G + (size_t)row * 8192 + (FIRST ? 0 : 4096) + col);
                    f32x4 v0 = acc[ai][bj][m][0], v1 = acc[ai][bj][m][1];
                    v0[0] *= bf_lo(gw.x); v0[1] *= bf_hi(gw.x); v0[2] *= bf_lo(gw.y); v0[3] *= bf_hi(gw.y);
                    v1[0] *= bf_lo(gw.z); v1[1] *= bf_hi(gw.z); v1[2] *= bf_lo(gw.w); v1[3] *= bf_hi(gw.w);
                    bf16_t* p = MRG + (size_t)row * 4096 + col;
                    if (!FIRST) { const u32x4 pw = *(const u32x4*)p;
                        v0[0] += bf_lo(pw.x); v0[1] += bf_hi(pw.x); v0[2] += bf_lo(pw.y); v0[3] += bf_hi(pw.y);
                        v1[0] += bf_lo(pw.z); v1[1] += bf_hi(pw.z); v1[2] += bf_lo(pw.w); v1[3] += bf_hi(pw.w); }
                    u32x4 w; w.x = cvt_pk_bf16(v0[0], v0[1]); w.y = cvt_pk_bf16(v0[2], v0[3]); w.z = cvt_pk_bf16(v1[0], v1[1]); w.w = cvt_pk_bf16(v1[2], v1[3]);
                    *(u32x4*)p = w;
                }
            }
    }
};

struct EpiF32 {
    static constexpr bool PERM = false;
    const float* base; float* out; int ldc;
    __device__ __forceinline__ void operator()(const f32x4 (&acc)[2][2][4][2], const Unit& u, int wr, int wc, int fr, int fq) const {
        const int col0 = u.pn * BM + wc * 32 + 4 * fq;
#pragma unroll
        for (int ai = 0; ai < 2; ++ai)
#pragma unroll
            for (int m = 0; m < 4; ++m) { const size_t off = (size_t)(u.pm * BM + ai * HALF + wr * 64 + m * 16 + fr) * ldc + col0;
#pragma unroll
                for (int bj = 0; bj < 2; ++bj)
#pragma unroll
                    for (int n = 0; n < 2; ++n) { f32x4 o = acc[ai][bj][m][n]; if (base) o = o + *(const f32x4*)(base + off + bj * HALF + n * 16); *(f32x4*)(out + off + bj * HALF + n * 16) = o; } }
    }
};
}

namespace att {
using bf16x8 = __attribute__((ext_vector_type(8))) short;
using s16x4  = __attribute__((ext_vector_type(4))) short;
using f32x16 = __attribute__((ext_vector_type(16))) float;
using u32x4  = __attribute__((ext_vector_type(4))) unsigned;
typedef unsigned short bf16_t;
constexpr int NW = 8, QBLK = 32, KVBLK = 64, SEQ = 8192, NHEAD = 16;
constexpr int SHM_V = KVBLK * 128 * 2, SHM_KN = KVBLK * 128 * 2, SHM_KR = KVBLK * 64 * 2;
constexpr int OFF_V = 0, OFF_KN = 2 * SHM_V, OFF_KR = OFF_KN + 2 * SHM_KN, OFF_WS = OFF_KR + 2 * SHM_KR, OFF_BIAS = OFF_WS + NW * 64 * 4, OFF_QR = OFF_BIAS + 2048, ATT_LDS_BYTES = OFF_QR + NW * 4096;
#define KSWZ(row, colB) ((row) * 256 + ((colB) ^ (((row) & 7) << 4)))
#define KRSWZ(row, chunk) ((row) * 128 + ((((chunk) ^ (((row) >> 1) & 7))) << 4))
#define ASBAR() __builtin_amdgcn_sched_barrier(0)
__device__ __forceinline__ int crow(int r, int hi) { return (r & 3) + 8 * (r >> 2) + 4 * hi; }
__device__ __forceinline__ unsigned cvtpk(float lo, float hi) { unsigned r; asm volatile("v_cvt_pk_bf16_f32 %0, %1, %2" : "=v"(r) : "v"(lo), "v"(hi)); return r; }
__device__ __forceinline__ bf16x8 ld8(const bf16_t* p) { return *reinterpret_cast<const bf16x8*>(p); }

constexpr float THR2 = 11.5f;
__device__ __forceinline__ void partialSM(f32x16& p0, f32x16& p1, float& m_reg, float& mn, float& alpha) {
  float pmax = p0[0];
#pragma unroll
  for (int r = 1; r < 16; ++r) pmax = fmaxf(pmax, p0[r]);
#pragma unroll
  for (int r = 0; r < 16; ++r) pmax = fmaxf(pmax, p1[r]);
  { auto rr = __builtin_amdgcn_permlane32_swap(__float_as_uint(pmax), __float_as_uint(pmax), false, false);
    pmax = fmaxf(__uint_as_float(rr[0]), __uint_as_float(rr[1])); }
  if (__builtin_expect(__all(pmax - m_reg <= THR2), 1)) { mn = m_reg; alpha = 1.f; }
  else { mn = fmaxf(m_reg, pmax); alpha = __builtin_amdgcn_exp2f(m_reg - mn); m_reg = mn; }
#pragma unroll
  for (int r = 0; r < 16; ++r) p0[r] = p0[r] - mn;
#pragma unroll
  for (int r = 0; r < 16; ++r) p1[r] = p1[r] - mn;
#pragma unroll
  for (int r = 0; r < 16; ++r) p0[r] = __builtin_amdgcn_exp2f(p0[r]);
}
__device__ __forceinline__ void finishSM(f32x16& p0, f32x16& p1, float alpha, float& l_reg, bf16x8& pa0, bf16x8& pa1, bf16x8& pa2, bf16x8& pa3) {
#pragma unroll
  for (int r = 0; r < 16; ++r) p1[r] = __builtin_amdgcn_exp2f(p1[r]);
  float ps = 0;
#pragma unroll
  for (int r = 0; r < 16; ++r) ps += p0[r];
#pragma unroll
  for (int r = 0; r < 16; ++r) ps += p1[r];
  { auto rr = __builtin_amdgcn_permlane32_swap(__float_as_uint(ps), __float_as_uint(ps), false, false);
    ps = __uint_as_float(rr[0]) + __uint_as_float(rr[1]); }
  l_reg = l_reg * alpha + ps;
#define PK4(P, BASE, OUT) do { unsigned a0 = cvtpk(P[BASE + 0], P[BASE + 1]), a1 = cvtpk(P[BASE + 2], P[BASE + 3]);   \
    unsigned b0 = cvtpk(P[BASE + 4], P[BASE + 5]), b1 = cvtpk(P[BASE + 6], P[BASE + 7]);                              \
    auto r0 = __builtin_amdgcn_permlane32_swap(a0, b0, false, false); auto r1 = __builtin_amdgcn_permlane32_swap(a1, b1, false, false); \
    u32x4 w = {r0[0], r1[0], r0[1], r1[1]}; OUT = *reinterpret_cast<bf16x8*>(&w); } while (0)
  PK4(p0, 0, pa0); PK4(p0, 8, pa1); PK4(p1, 0, pa2); PK4(p1, 8, pa3);
}
__device__ __forceinline__ int v_st(int k, int c) { const int kk = (k & ~0xC) | ((k & 4) << 1) | ((k & 8) >> 1); return ((kk >> 3) * 4 + (c >> 5)) * 512 + ((kk & 7) * 32 + (c & 31)) * 2; }
__device__ __forceinline__ int v_rd_base(int lane) { return ((lane & 3) << 3) | (((lane >> 2) & 3) << 6) | (((lane >> 4) & 1) << 5) | (((lane >> 5) & 1) << 8); }
constexpr int v_rd_off(int d0, int ks, int half) { return d0 * 512 + ks * 4096 + half * 2048; }
template <int OFF> __device__ __forceinline__ s16x4 tr_read(int vb) {
  s16x4 r; asm volatile("ds_read_b64_tr_b16 %0, %1 offset:%2" : "=&v"(r) : "v"(vb), "i"(OFF) : "memory"); return r;
}
template <int D0> __device__ __forceinline__ void pv_one(f32x16& od, int vb, bf16x8 pa0, bf16x8 pa1, bf16x8 pa2, bf16x8 pa3) {
  const s16x4 l0 = tr_read<v_rd_off(D0, 0, 0)>(vb), h0 = tr_read<v_rd_off(D0, 0, 1)>(vb), l1 = tr_read<v_rd_off(D0, 1, 0)>(vb), h1 = tr_read<v_rd_off(D0, 1, 1)>(vb);
  const s16x4 l2 = tr_read<v_rd_off(D0, 2, 0)>(vb), h2 = tr_read<v_rd_off(D0, 2, 1)>(vb), l3 = tr_read<v_rd_off(D0, 3, 0)>(vb), h3 = tr_read<v_rd_off(D0, 3, 1)>(vb);
  asm volatile("s_waitcnt lgkmcnt(0)" ::: "memory"); ASBAR();
#define PKV(L, H) (bf16x8){L[0], L[1], L[2], L[3], H[0], H[1], H[2], H[3]}
  od = __builtin_amdgcn_mfma_f32_32x32x16_bf16(pa0, PKV(l0, h0), od, 0, 0, 0);
  od = __builtin_amdgcn_mfma_f32_32x32x16_bf16(pa1, PKV(l1, h1), od, 0, 0, 0);
  od = __builtin_amdgcn_mfma_f32_32x32x16_bf16(pa2, PKV(l2, h2), od, 0, 0, 0);
  od = __builtin_amdgcn_mfma_f32_32x32x16_bf16(pa3, PKV(l3, h3), od, 0, 0, 0);
#undef PKV
}
__device__ __forceinline__ void pv_d0(f32x16* o, int vb, bf16x8 pa0, bf16x8 pa1, bf16x8 pa2, bf16x8 pa3) {
  pv_one<0>(o[0], vb, pa0, pa1, pa2, pa3); pv_one<1>(o[1], vb, pa0, pa1, pa2, pa3); pv_one<2>(o[2], vb, pa0, pa1, pa2, pa3); pv_one<3>(o[3], vb, pa0, pa1, pa2, pa3);
}
template <int NROPE> __device__ __forceinline__ void qkt(f32x16& p0, f32x16& p1, const char* Kn, const char* Kr, const bf16x8* qr, const char* qrl, int r32, int hi) {
  p0 = f32x16{}; p1 = f32x16{};
#pragma unroll
  for (int d0 = 0; d0 < 8; ++d0) { const int cb = (d0 * 16 + hi * 8) * 2;
    const bf16x8 b0 = *reinterpret_cast<const bf16x8*>(Kn + KSWZ(r32, cb));
    const bf16x8 b1 = *reinterpret_cast<const bf16x8*>(Kn + KSWZ(32 + r32, cb));
    p0 = __builtin_amdgcn_mfma_f32_32x32x16_bf16(b0, qr[d0], p0, 0, 0, 0);
    p1 = __builtin_amdgcn_mfma_f32_32x32x16_bf16(b1, qr[d0], p1, 0, 0, 0); }
#pragma unroll
  for (int d0 = 0; d0 < NROPE; ++d0) { const int ch = d0 * 2 + hi;
    const bf16x8 b0 = *reinterpret_cast<const bf16x8*>(Kr + KRSWZ(r32, ch));
    const bf16x8 b1 = *reinterpret_cast<const bf16x8*>(Kr + KRSWZ(32 + r32, ch));
    const bf16x8 qf = *reinterpret_cast<const bf16x8*>(qrl + d0 * 1024);
    p0 = __builtin_amdgcn_mfma_f32_32x32x16_bf16(b0, qf, p0, 0, 0, 0);
    p1 = __builtin_amdgcn_mfma_f32_32x32x16_bf16(b1, qf, p1, 0, 0, 0); }
}

__device__ __forceinline__ void mla_unit(int b, int h, int qb, const bf16_t* __restrict__ Q, const bf16_t* __restrict__ KN, const bf16_t* __restrict__ KR, const bf16_t* __restrict__ VM, bf16_t* __restrict__ O, char* lds) {
  int tid_ = threadIdx.x; asm volatile("" : "+v"(tid_));
  const int tid = tid_, wid = tid >> 6, lane = tid & 63, r32 = lane & 31, hi = lane >> 5;
  char* V_lds = lds + OFF_V; char* Kn_lds = lds + OFF_KN; char* Kr_lds = lds + OFF_KR;
  float* ws = (float*)(lds + OFF_WS) + wid * 64; float* li_l = ws; float* al_l = ws + 32;
  float m_reg = -1e30f, l_reg = 0; f32x16 o[4] = {}; bf16x8 qr[8];
  char* qrl = lds + OFF_QR + wid * 4096 + (hi * 32 + r32) * 16;
  const long rowbase = (long)b * SEQ;
  const bf16_t* Qw = Q + (rowbase + qb * 256 + wid * QBLK + r32) * 3072 + h * 192 + hi * 8;
#pragma unroll
  for (int d0 = 0; d0 < 8; ++d0) qr[d0] = ld8(Qw + d0 * 16);
  const bf16_t* Kh = KN + rowbase * 2048 + h * 128; const bf16_t* Vh = VM + rowbase * 2048 + h * 128; const bf16_t* Krb = KR + rowbase * 64;
  const int sr = tid >> 4, sc = (tid & 15) * 8, vst0 = v_st(sr, sc), vst1 = v_st(32 + sr, sc);
  const int krr = tid >> 3, krc = tid & 7;
  const int vb0 = (int)(uintptr_t)V_lds + v_rd_base(lane);
  struct { bf16x8 vs0, vs1, ks0, ks1, kr0; } sr_[1];
#define SLOAD(i, k0) do { sr_[i].vs0 = ld8(&Vh[(long)((k0) + sr) * 2048 + sc]); sr_[i].vs1 = ld8(&Vh[(long)((k0) + 32 + sr) * 2048 + sc]); \
    sr_[i].ks0 = ld8(&Kh[(long)((k0) + sr) * 2048 + sc]); sr_[i].ks1 = ld8(&Kh[(long)((k0) + 32 + sr) * 2048 + sc]); sr_[i].kr0 = ld8(&Krb[(long)((k0) + krr) * 64 + krc * 8]); } while (0)
#define SWRITE(bb, i) do { *(bf16x8*)(V_lds + (bb) * SHM_V + vst0) = sr_[i].vs0; *(bf16x8*)(V_lds + (bb) * SHM_V + vst1) = sr_[i].vs1; const int kc = sc * 2; \
    *(bf16x8*)(Kn_lds + (bb) * SHM_KN + KSWZ(sr, kc)) = sr_[i].ks0; *(bf16x8*)(Kn_lds + (bb) * SHM_KN + KSWZ(32 + sr, kc)) = sr_[i].ks1; \
    *(bf16x8*)(Kr_lds + (bb) * SHM_KR + KRSWZ(krr, krc)) = sr_[i].kr0; } while (0)
#define SWAIT() asm volatile("s_waitcnt vmcnt(0)" ::: "memory")
#define RESC(a) do { if (__any((a) < 1.f)) { if (hi == 0) al_l[r32] = (a); asm volatile("s_waitcnt lgkmcnt(0)" ::: "memory"); \
    _Pragma("unroll") for (int d = 0; d < 4; ++d) _Pragma("unroll") for (int r = 0; r < 16; ++r) o[d][r] *= al_l[crow(r, hi)]; } } while (0)
  f32x16 pA0, pA1, pB0, pB1; float mnA, mnB, alA, alB; bf16x8 pa0, pa1, pa2, pa3; const int NT = SEQ / KVBLK;
  constexpr int SE = 0, SO = 0;
  __syncthreads();
#pragma unroll
  for (int d0 = 0; d0 < 4; ++d0) *(bf16x8*)(qrl + d0 * 1024) = ld8(Qw + (8 + d0) * 16);
  SLOAD(SE, 0); asm volatile("s_waitcnt vmcnt(0)" ::: "memory"); SWRITE(0, SE); __syncthreads();
  qkt<4>(pA0, pA1, Kn_lds, Kr_lds, qr, qrl, r32, hi); partialSM(pA0, pA1, m_reg, mnA, alA);
  SLOAD(SO, KVBLK);
  SWAIT(); SWRITE(1, SO); __syncthreads();
  for (int j = 1; j + 1 < NT; j += 2) {
    ASBAR(); qkt<4>(pB0, pB1, Kn_lds + SHM_KN, Kr_lds + SHM_KR, qr, qrl, r32, hi);
    finishSM(pA0, pA1, alA, l_reg, pa0, pa1, pa2, pa3); ASBAR();
    SLOAD(SE, (j + 1) * KVBLK); ASBAR();
    pv_d0(o, vb0, pa0, pa1, pa2, pa3); partialSM(pB0, pB1, m_reg, mnB, alB);
    __syncthreads(); SWAIT(); SWRITE(0, SE);
    RESC(alB); __syncthreads();
    ASBAR(); qkt<4>(pA0, pA1, Kn_lds, Kr_lds, qr, qrl, r32, hi);
    finishSM(pB0, pB1, alB, l_reg, pa0, pa1, pa2, pa3); ASBAR();
    SLOAD(SO, (j + 2) * KVBLK); ASBAR();
    pv_d0(o, vb0 + SHM_V, pa0, pa1, pa2, pa3); partialSM(pA0, pA1, m_reg, mnA, alA);
    __syncthreads(); SWAIT(); SWRITE(1, SO);
    RESC(alA); __syncthreads();
  }
  ASBAR(); qkt<4>(pB0, pB1, Kn_lds + SHM_KN, Kr_lds + SHM_KR, qr, qrl, r32, hi);
  finishSM(pA0, pA1, alA, l_reg, pa0, pa1, pa2, pa3); ASBAR();
  pv_d0(o, vb0, pa0, pa1, pa2, pa3); partialSM(pB0, pB1, m_reg, mnB, alB);
  __syncthreads(); RESC(alB);
  finishSM(pB0, pB1, alB, l_reg, pa0, pa1, pa2, pa3); ASBAR();
  pv_d0(o, vb0 + SHM_V, pa0, pa1, pa2, pa3);
  if (hi == 0) li_l[r32] = l_reg; asm volatile("s_waitcnt lgkmcnt(0)" ::: "memory");
  float rli[16];
#pragma unroll
  for (int r = 0; r < 16; ++r) rli[r] = __builtin_amdgcn_rcpf(li_l[crow(r, hi)]);
  bf16_t* Ow = O + (rowbase + qb * 256 + wid * QBLK) * 2048 + h * 128;
#pragma unroll
  for (int r = 0; r < 16; ++r) { const int orow = crow(r, hi);
#pragma unroll
    for (int d0 = 0; d0 < 4; ++d0) Ow[(long)orow * 2048 + d0 * 32 + r32] = (bf16_t)(cvtpk(o[d0][r] * rli[r], 0.f) & 0xffffu); }
#undef SLOAD
#undef SWRITE
#undef SWAIT
#undef RESC
}

__device__ __forceinline__ void na_unit(int b, int h, int rg, const bf16_t* __restrict__ Q, const bf16_t* __restrict__ K, const bf16_t* __restrict__ V, const float* __restrict__ rpb, bf16_t* __restrict__ O, char* lds) {
  int tid_ = threadIdx.x; asm volatile("" : "+v"(tid_));
  const int tid = tid_, wid = tid >> 6, lane = tid & 63, r32 = lane & 31, hi = lane >> 5;
  char* V_lds = lds + OFF_V; char* Kn_lds = lds + OFF_KN;
  float* ws = (float*)(lds + OFF_WS) + wid * 64; float* li_l = ws; float* al_l = ws + 32;
  float* bias_l = (float*)(lds + OFF_BIAS);
  const int r0 = rg * 4, rq = r0 + (wid >> 1), cq = 32 * (wid & 1) + r32;
  const int rs_w = min(max(rq - 4, 0), 120), cs = min(max(cq - 8, 0), 48);
  const int kr_lo = min(max(r0 - 4, 0), 120), kr_hi = min(max(r0 + 3 - 4, 0), 120) + 7, NT = kr_hi - kr_lo + 1;
  const long rowbase = (long)b * SEQ;
  float m_reg = -1e30f, l_reg = 0; f32x16 o[4] = {}; bf16x8 qr[8];
  const bf16_t* Qw = Q + (rowbase + rq * 64 + cq) * 2048 + h * 128 + hi * 8;
#pragma unroll
  for (int d0 = 0; d0 < 8; ++d0) qr[d0] = ld8(Qw + d0 * 16);
  const bf16_t* Kh = K + rowbase * 2048 + h * 128; const bf16_t* Vh = V + rowbase * 2048 + h * 128;
  const int sr = tid >> 4, sc = (tid & 15) * 8, vst0 = v_st(sr, sc), vst1 = v_st(32 + sr, sc);
  const int vb0 = (int)(uintptr_t)V_lds + v_rd_base(lane);
  __syncthreads();
  if (tid < 465) bias_l[tid] = rpb[h * 465 + tid] * 1.4426950408889634f;
  bf16x8 vs0, vs1, ks0, ks1;
#define NLOAD(k0) do { vs0 = ld8(&Vh[(long)((k0) + sr) * 2048 + sc]); vs1 = ld8(&Vh[(long)((k0) + 32 + sr) * 2048 + sc]); \
    ks0 = ld8(&Kh[(long)((k0) + sr) * 2048 + sc]); ks1 = ld8(&Kh[(long)((k0) + 32 + sr) * 2048 + sc]); } while (0)
#define NWRITE(bb) do { *(bf16x8*)(V_lds + (bb) * SHM_V + vst0) = vs0; *(bf16x8*)(V_lds + (bb) * SHM_V + vst1) = vs1; const int kc = sc * 2; \
    *(bf16x8*)(Kn_lds + (bb) * SHM_KN + KSWZ(sr, kc)) = ks0; *(bf16x8*)(Kn_lds + (bb) * SHM_KN + KSWZ(32 + sr, kc)) = ks1; } while (0)
  NLOAD(kr_lo * 64);
  for (int i = 0; i < NT; ++i) {
    const int kr = kr_lo + i, bb = i & 1;
    NWRITE(bb);
    if (i + 1 < NT) NLOAD((kr + 1) * 64);
    __syncthreads();
    if (kr >= rs_w && kr < rs_w + 8) {
      f32x16 p0, p1;
      qkt<0>(p0, p1, Kn_lds + bb * SHM_KN, nullptr, qr, nullptr, r32, hi);
      const float* brow = bias_l + (kr - rq + 7) * 31 + 15 - cq;
      float pmax = -1e30f;
#pragma unroll
      for (int r = 0; r < 16; ++r) { const int k0 = crow(r, hi), k1 = 32 + k0;
        const bool v0 = (k0 >= cs) && (k0 < cs + 16), v1 = (k1 >= cs) && (k1 < cs + 16);
        const float b0 = brow[v0 ? k0 : cq], b1 = brow[v1 ? k1 : cq];
        p0[r] = v0 ? p0[r] + b0 : -1e30f; p1[r] = v1 ? p1[r] + b1 : -1e30f;
        pmax = fmaxf(pmax, fmaxf(p0[r], p1[r])); }
      { auto rr = __builtin_amdgcn_permlane32_swap(__float_as_uint(pmax), __float_as_uint(pmax), false, false);
        pmax = fmaxf(__uint_as_float(rr[0]), __uint_as_float(rr[1])); }
      const float mn = fmaxf(m_reg, pmax), alpha = __builtin_amdgcn_exp2f(m_reg - mn); m_reg = mn;
#pragma unroll
      for (int r = 0; r < 16; ++r) { p0[r] = __builtin_amdgcn_exp2f(p0[r] - mn); p1[r] = __builtin_amdgcn_exp2f(p1[r] - mn); }
      float ps = 0;
#pragma unroll
      for (int r = 0; r < 16; ++r) ps += p0[r] + p1[r];
      { auto rr = __builtin_amdgcn_permlane32_swap(__float_as_uint(ps), __float_as_uint(ps), false, false);
        ps = __uint_as_float(rr[0]) + __uint_as_float(rr[1]); }
      l_reg = l_reg * alpha + ps;
      if (hi == 0) al_l[r32] = alpha; asm volatile("s_waitcnt lgkmcnt(0)" ::: "memory");
#pragma unroll
      for (int d = 0; d < 4; ++d)
#pragma unroll
        for (int r = 0; r < 16; ++r) o[d][r] *= al_l[crow(r, hi)];
      bf16x8 pa0, pa1, pa2, pa3;
      PK4(p0, 0, pa0); PK4(p0, 8, pa1); PK4(p1, 0, pa2); PK4(p1, 8, pa3);
      pv_d0(o, vb0 + bb * SHM_V, pa0, pa1, pa2, pa3);
    }
  }
  if (hi == 0) li_l[r32] = l_reg; asm volatile("s_waitcnt lgkmcnt(0)" ::: "memory");
  float rli[16];
#pragma unroll
  for (int r = 0; r < 16; ++r) rli[r] = __builtin_amdgcn_rcpf(li_l[crow(r, hi)]);
  bf16_t* Ow = O + (rowbase + rq * 64 + 32 * (wid & 1)) * 2048 + h * 128;
#pragma unroll
  for (int r = 0; r < 16; ++r) { const int orow = crow(r, hi);
#pragma unroll
    for (int d0 = 0; d0 < 4; ++d0) Ow[(long)orow * 2048 + d0 * 32 + r32] = (bf16_t)(cvtpk(o[d0][r] * rli[r], 0.f) & 0xffffu); }
#undef NLOAD
#undef NWRITE
}
#undef PK4
}

namespace peer {
#define PLAS __attribute__((address_space(3)))
using bf16x8 = __attribute__((ext_vector_type(8))) short;
using bf16x2 = __attribute__((ext_vector_type(2))) __bf16;
using f32x16 = __attribute__((ext_vector_type(16))) float;
using f32x4  = __attribute__((ext_vector_type(4))) float;
using u32x4  = __attribute__((ext_vector_type(4))) unsigned;
typedef unsigned short bf16_t;
__device__ __forceinline__ int f2ord(float f) { const int u = __float_as_int(f); return u ^ ((u >> 31) & 0x7fffffff); }
__device__ __forceinline__ float ord2f(int s) { return __int_as_float(s ^ ((s >> 31) & 0x7fffffff)); }
__device__ __forceinline__ int crow(int r, int hi) { return (r & 3) + 8 * (r >> 2) + 4 * hi; }
__device__ __forceinline__ unsigned cvtpk(float lo, float hi) { unsigned r; asm volatile("v_cvt_pk_bf16_f32 %0, %1, %2" : "=v"(r) : "v"(lo), "v"(hi)); return r; }
__device__ __forceinline__ float bf_lo(unsigned w) { return __uint_as_float(w << 16); }
__device__ __forceinline__ float bf_hi(unsigned w) { return __uint_as_float(w & 0xffff0000u); }
__device__ __forceinline__ int swapmax(int m) { auto rr = __builtin_amdgcn_permlane32_swap((unsigned)m, (unsigned)m, false, false); const int a = (int)rr[0], b = (int)rr[1]; return a > b ? a : b; }

struct CandTab { int ci[50], cj[50]; };
constexpr CandTab make_cands() { CandTab t{}; int n = 0; for (int i = 0; i < 16; ++i) for (int j = 0; j < 16; ++j) if ((i + 1) * (j + 1) <= 16) { t.ci[n] = i; t.cj[n] = j; ++n; } return t; }
constexpr CandTab CT = make_cands();

constexpr int SEL_LDS_PER_WAVE = (2 * 16 + 16) * 64 * 4;

__device__ __forceinline__ void select32(int t0, int h, const float* __restrict__ QP, const bf16_t* __restrict__ SUBH, const bf16_t* __restrict__ SUBL, int* __restrict__ IDX, float* __restrict__ GATE, PLAS int* wl, int lane_) {
  int lane = lane_; asm volatile("" : "+v"(lane));
  const int r32 = lane & 31, hi = lane >> 5;
  PLAS int* topl = wl; PLAS int* winl = wl + 2 * 16 * 64;
  const float* qrow = QP + (size_t)(t0 + r32) * 2048;
  {
#pragma unroll 1
    for (int p = 0; p < 2; ++p) {
      bf16x8 qh[8], ql[8];
      const float* qp = qrow + h * 256 + p * 128 + hi * 8;
#pragma unroll
      for (int d0 = 0; d0 < 8; ++d0) {
        const f32x4 a = *(const f32x4*)(qp + d0 * 16), b = *(const f32x4*)(qp + d0 * 16 + 4);
        u32x4 wh, wlw;
        wh.x = cvtpk(a[0], a[1]); wh.y = cvtpk(a[2], a[3]); wh.z = cvtpk(b[0], b[1]); wh.w = cvtpk(b[2], b[3]);
        wlw.x = cvtpk(a[0] - bf_lo(wh.x), a[1] - bf_hi(wh.x)); wlw.y = cvtpk(a[2] - bf_lo(wh.y), a[3] - bf_hi(wh.y));
        wlw.z = cvtpk(b[0] - bf_lo(wh.z), b[1] - bf_hi(wh.z)); wlw.w = cvtpk(b[2] - bf_lo(wh.w), b[3] - bf_hi(wh.w));
        qh[d0] = *reinterpret_cast<bf16x8*>(&wh); ql[d0] = *reinterpret_cast<bf16x8*>(&wlw);
      }
      const size_t soff = ((size_t)(h * 2 + p) * 128 + r32) * 128 + hi * 8;
      int key[64];
#pragma unroll
      for (int kb = 0; kb < 4; ++kb) {
        f32x16 acc = f32x16{};
#pragma unroll
        for (int d0 = 0; d0 < 8; ++d0) {
          const bf16x8 ah = *reinterpret_cast<const bf16x8*>(SUBH + soff + (size_t)kb * 32 * 128 + d0 * 16);
          const bf16x8 al = *reinterpret_cast<const bf16x8*>(SUBL + soff + (size_t)kb * 32 * 128 + d0 * 16);
          acc = __builtin_amdgcn_mfma_f32_32x32x16_bf16(ah, qh[d0], acc, 0, 0, 0);
          acc = __builtin_amdgcn_mfma_f32_32x32x16_bf16(ah, ql[d0], acc, 0, 0, 0);
          acc = __builtin_amdgcn_mfma_f32_32x32x16_bf16(al, qh[d0], acc, 0, 0, 0);
        }
#pragma unroll
        for (int r = 0; r < 16; ++r) key[kb * 16 + r] = (f2ord(acc[r]) & ~127) | (kb * 32 + crow(r, hi));
      }
#pragma unroll 1
      for (int it = 0; it < 16; ++it) {
        int m = key[0];
#pragma unroll
        for (int i = 1; i < 64; ++i) m = key[i] > m ? key[i] : m;
        const int gm = swapmax(m);
        topl[(p * 16 + it) * 64 + lane] = gm;
#pragma unroll
        for (int i = 0; i < 64; ++i) key[i] = (key[i] == gm) ? (int)0x80000000 : key[i];
      }
    }
    int ck[25];
#pragma unroll
    for (int c = 0; c < 25; ++c) {
      const int i = hi ? CT.ci[2 * c + 1] : CT.ci[2 * c], j = hi ? CT.cj[2 * c + 1] : CT.cj[2 * c];
      const int k0 = topl[i * 64 + lane], k1 = topl[(16 + j) * 64 + lane];
      const float s = ord2f(k0 & ~127) + ord2f(k1 & ~127);
      ck[c] = (f2ord(s) & ~255) | (i << 4) | j;
    }
#pragma unroll 1
    for (int it = 0; it < 16; ++it) {
      int m = ck[0];
#pragma unroll
      for (int i = 1; i < 25; ++i) m = ck[i] > m ? ck[i] : m;
      const int gm = swapmax(m);
      winl[it * 64 + lane] = gm;
#pragma unroll
      for (int i = 0; i < 25; ++i) ck[i] = (ck[i] == gm) ? (int)0x80000000 : ck[i];
    }
    float e[16]; int wv[16]; float tot = 0.f;
    const float s0 = ord2f(winl[lane] & ~255);
#pragma unroll
    for (int k = 0; k < 16; ++k) { wv[k] = winl[k * 64 + lane]; e[k] = __builtin_amdgcn_exp2f((ord2f(wv[k] & ~255) - s0) * 1.4426950408889634f); tot += e[k]; }
    const float rtot = 1.0f / tot;
    int l2_ = lane_; asm volatile("" : "+v"(l2_));
    const size_t ob = (size_t)(t0 + (l2_ & 31)) * 128 + h * 16 + (l2_ >> 5) * 8;
#pragma unroll
    for (int k = 0; k < 8; ++k) {
      const int w = hi ? wv[8 + k] : wv[k]; const float ev = hi ? e[8 + k] : e[k];
      const int i = (w >> 4) & 15, j = w & 15;
      const int e0 = topl[i * 64 + lane] & 127, e1 = topl[(16 + j) * 64 + lane] & 127;
      IDX[ob + k] = e0 * 128 + e1; GATE[ob + k] = ev * rtot;
    }
  }
}

__device__ __forceinline__ float dot2(unsigned w, unsigned x, float acc) { return __builtin_amdgcn_fdot2_f32_bf16(__builtin_bit_cast(bf16x2, w), __builtin_bit_cast(bf16x2, x), acc, false); }
__device__ __forceinline__ float gelu_erf(float v) {
  const float av = fabsf(v), d = av * 0.2316418882f + 1.0f, t = __builtin_amdgcn_rcpf(d);
  float q = t * 0.5307027145f + (-0.7265760135f); q = q * t + 0.7107068705f; q = q * t + (-0.142248368f); q = q * t + 0.127414796f; q = q * t;
  const float e = __builtin_amdgcn_exp2f((v * v) * (-0.72134752044f));
  const float m = v * (q * e);
  return v < 0.f ? m : v - m;
}
__device__ __forceinline__ float wave_sum(float v) {
#pragma unroll
  for (int o = 1; o < 64; o <<= 1) v += __shfl_xor(v, o);
  return v;
}

typedef float f32x2 __attribute__((ext_vector_type(2)));
constexpr float USCALE = 64.0f, VSCALE = 4.0f;
__device__ __forceinline__ f32x2 fp8x2(unsigned w, bool hiword) { return hiword ? __builtin_amdgcn_cvt_pk_f32_fp8((int)w, true) : __builtin_amdgcn_cvt_pk_f32_fp8((int)w, false); }
template <bool STORE> __device__ __forceinline__ void expert_token(int t, const bf16_t* __restrict__ H2, const unsigned char* __restrict__ U8, const unsigned char* __restrict__ V8, const int* __restrict__ IDX, const float* __restrict__ GATE,
                                             float* X1OUT, const float* __restrict__ fnorm, int lane_) {
  int lane = lane_; asm volatile("" : "+v"(lane));
  f32x2 hf[4][8];
  { const u32x4* hp = (const u32x4*)(H2 + (size_t)t * 4096) + 2 * lane;
#pragma unroll
    for (int k = 0; k < 4; ++k) { const u32x4 a = hp[128 * k], b = hp[128 * k + 1];
      hf[k][0] = (f32x2){bf_lo(a.x), bf_hi(a.x)}; hf[k][1] = (f32x2){bf_lo(a.y), bf_hi(a.y)}; hf[k][2] = (f32x2){bf_lo(a.z), bf_hi(a.z)}; hf[k][3] = (f32x2){bf_lo(a.w), bf_hi(a.w)};
      hf[k][4] = (f32x2){bf_lo(b.x), bf_hi(b.x)}; hf[k][5] = (f32x2){bf_lo(b.y), bf_hi(b.y)}; hf[k][6] = (f32x2){bf_lo(b.z), bf_hi(b.z)}; hf[k][7] = (f32x2){bf_lo(b.w), bf_hi(b.w)}; } }
  const int e0 = IDX[(size_t)t * 128 + lane], e1 = IDX[(size_t)t * 128 + 64 + lane];
  const float g0 = GATE[(size_t)t * 128 + lane], g1 = GATE[(size_t)t * 128 + 64 + lane];
  float c0 = 0.f, c1 = 0.f;
  u32x4 r0[4], r1[4], r2[4], r3[4];
#define ELOAD(dst, jj) do { const int jx_ = (jj); if (jx_ < 256) { const int sl_ = jx_ & 127; const int e_ = __builtin_amdgcn_readlane(sl_ < 64 ? e0 : e1, sl_ & 63); \
    const u32x4* rp_ = (const u32x4*)((jx_ < 128 ? U8 : V8) + (size_t)e_ * 4096) + lane; _Pragma("unroll") for (int k = 0; k < 4; ++k) dst[k] = rp_[64 * k]; } \
    asm volatile("" ::: "memory"); __builtin_amdgcn_sched_barrier(0); } while (0)
#define UDOT(R, OUT) do { f32x2 a0_ = {0.f, 0.f}, a1_ = {0.f, 0.f}, a2_ = {0.f, 0.f}, a3_ = {0.f, 0.f}; \
    _Pragma("unroll") for (int k = 0; k < 4; ++k) { \
      a0_ += fp8x2(R[k].x, false) * hf[k][0]; a1_ += fp8x2(R[k].x, true) * hf[k][1]; a2_ += fp8x2(R[k].y, false) * hf[k][2]; a3_ += fp8x2(R[k].y, true) * hf[k][3]; \
      a0_ += fp8x2(R[k].z, false) * hf[k][4]; a1_ += fp8x2(R[k].z, true) * hf[k][5]; a2_ += fp8x2(R[k].w, false) * hf[k][6]; a3_ += fp8x2(R[k].w, true) * hf[k][7]; } \
    a0_ += a1_; a2_ += a3_; a0_ += a2_; OUT = a0_.x + a0_.y; } while (0)
  ELOAD(r0, 0); ELOAD(r1, 1); ELOAD(r2, 2); ELOAD(r3, 3);
#pragma unroll 1
  for (int g = 0; g < 16; ++g) {
    float p[8];
    const int j = g * 8;
    UDOT(r0, p[0]); ELOAD(r0, j + 4); UDOT(r1, p[1]); ELOAD(r1, j + 5); UDOT(r2, p[2]); ELOAD(r2, j + 6); UDOT(r3, p[3]); ELOAD(r3, j + 7);
    UDOT(r0, p[4]); ELOAD(r0, j + 8); UDOT(r1, p[5]); ELOAD(r1, j + 9); UDOT(r2, p[6]); ELOAD(r2, j + 10); UDOT(r3, p[7]); ELOAD(r3, j + 11);
    float q4[4], q2[2], q1;
    { const bool up = (lane & 32) != 0;
#pragma unroll
      for (int i = 0; i < 4; ++i) { const float send = up ? p[i] : p[4 + i], keep = up ? p[4 + i] : p[i]; q4[i] = keep + __shfl_xor(send, 32); } }
    { const bool up = (lane & 16) != 0;
#pragma unroll
      for (int i = 0; i < 2; ++i) { const float send = up ? q4[i] : q4[2 + i], keep = up ? q4[2 + i] : q4[i]; q2[i] = keep + __shfl_xor(send, 16); } }
    { const bool up = (lane & 8) != 0; const float send = up ? q2[0] : q2[1], keep = up ? q2[1] : q2[0]; q1 = keep + __shfl_xor(send, 8); }
    q1 += __shfl_xor(q1, 4); q1 += __shfl_xor(q1, 2); q1 += __shfl_xor(q1, 1);
    const float got = __shfl(q1, 8 * (lane & 7));
    if ((lane >> 3) == (g & 7)) { if (g < 8) c0 = got; else c1 = got; }
  }
#undef UDOT
  c0 = g0 * gelu_erf(c0 * (1.0f / USCALE)) * (1.0f / VSCALE); c1 = g1 * gelu_erf(c1 * (1.0f / USCALE)) * (1.0f / VSCALE);
  f32x2 acc[4][8];
#pragma unroll
  for (int k = 0; k < 4; ++k)
#pragma unroll
    for (int i = 0; i < 8; ++i) acc[k][i] = (f32x2){0.f, 0.f};
#define VROW(R, C) do { const f32x2 cc_ = {(C), (C)}; _Pragma("unroll") for (int k = 0; k < 4; ++k) { \
      acc[k][0] += cc_ * fp8x2(R[k].x, false); acc[k][1] += cc_ * fp8x2(R[k].x, true); acc[k][2] += cc_ * fp8x2(R[k].y, false); acc[k][3] += cc_ * fp8x2(R[k].y, true); \
      acc[k][4] += cc_ * fp8x2(R[k].z, false); acc[k][5] += cc_ * fp8x2(R[k].z, true); acc[k][6] += cc_ * fp8x2(R[k].w, false); acc[k][7] += cc_ * fp8x2(R[k].w, true); } } while (0)
#define CJ(j) __int_as_float(__builtin_amdgcn_readlane(__float_as_int((j) < 64 ? c0 : c1), (j) & 63))
#pragma unroll 1
  for (int j = 0; j < 128; j += 4) {
    { const float c = CJ(j); VROW(r0, c); __builtin_amdgcn_sched_barrier(0); ELOAD(r0, 128 + j + 4); }
    { const float c = CJ(j + 1); VROW(r1, c); __builtin_amdgcn_sched_barrier(0); ELOAD(r1, 128 + j + 5); }
    { const float c = CJ(j + 2); VROW(r2, c); __builtin_amdgcn_sched_barrier(0); ELOAD(r2, 128 + j + 6); }
    { const float c = CJ(j + 3); VROW(r3, c); __builtin_amdgcn_sched_barrier(0); ELOAD(r3, 128 + j + 7); }
  }
#undef VROW
#undef CJ
#undef ELOAD
  int xo_ = 16 * lane; asm volatile("" : "+v"(xo_));
  float* xr = X1OUT + (size_t)t * 4096 + xo_; float ss = 0.f;
#ifdef PROBE_PEER_SCALE
#pragma unroll
  for (int k = 0; k < 4; ++k)
#pragma unroll
    for (int i = 0; i < 8; ++i) acc[k][i] *= PROBE_PEER_SCALE;
#endif
#pragma unroll
  for (int k = 0; k < 4; ++k)
#pragma unroll
    for (int q = 0; q < 4; ++q) { const f32x4 a = *(const f32x4*)(xr + 1024 * k + 4 * q);
      acc[k][2 * q] += (f32x2){a[0], a[1]}; acc[k][2 * q + 1] += (f32x2){a[2], a[3]};
      ss += acc[k][2 * q].x * acc[k][2 * q].x + acc[k][2 * q].y * acc[k][2 * q].y + acc[k][2 * q + 1].x * acc[k][2 * q + 1].x + acc[k][2 * q + 1].y * acc[k][2 * q + 1].y; }
  const float rstd = 1.0f / sqrtf(wave_sum(ss) * (1.0f / 4096.0f) + 1e-6f);
  const float* fn = fnorm + xo_;
#pragma unroll
  for (int k = 0; k < 4; ++k)
#pragma unroll
    for (int q = 0; q < 4; ++q) { const f32x4 g = *(const f32x4*)(fn + 1024 * k + 4 * q);
      f32x4 o; o[0] = acc[k][2 * q].x * rstd * g[0]; o[1] = acc[k][2 * q].y * rstd * g[1]; o[2] = acc[k][2 * q + 1].x * rstd * g[2]; o[3] = acc[k][2 * q + 1].y * rstd * g[3];
      if constexpr (STORE) { *(f32x4*)(xr + 1024 * k + 4 * q) = o; } else { asm volatile("" :: "v"(o)); } }
}
#undef PLAS
}

constexpr int BATCH = 2, SEQ = 8192, DM = 4096, T = BATCH * SEQ;
constexpr int NCAT = 15872;
constexpr int NPH = 12;
#ifndef MK_CUTS
#define MK_CUTS 1
#endif
constexpr float EPS = 1e-6f;
constexpr float LOG2E = 1.4426950408889634f;
constexpr float MLA_QSCALE = 0.07216878364870322f * LOG2E;
constexpr float NA_QSCALE = 0.08838834764831845f * LOG2E;

constexpr size_t MiB = 1u << 20;
constexpr size_t WS_CTL = 0, CTL_ZERO_BYTES = 1 * MiB;
constexpr size_t WS_ROPE = 1 * MiB;
constexpr size_t WS_RS = 1 * MiB + 65536;
constexpr size_t WS_WCAT = 2 * MiB;
constexpr size_t WS_WUQ = WS_WCAT + 124 * MiB;
constexpr size_t WS_WUKV = WS_WUQ + 5 * MiB;
constexpr size_t WS_PA = WS_WUKV + 4 * MiB;
constexpr size_t WS_PB = WS_PA + 16 * MiB;
constexpr size_t WS_WOUT = WS_PB + 16 * MiB;
constexpr size_t WS_WQ = WS_WOUT + 32 * MiB;
constexpr size_t WS_SUBH = WS_WQ + 16 * MiB;
constexpr size_t WS_SUBL = WS_SUBH + 512 * 1024;
constexpr size_t WS_R1 = WS_SUBL + 512 * 1024;
constexpr size_t WS_LAT = WS_R1 + 128 * MiB;
constexpr size_t WS_R2 = WS_LAT + 48 * MiB;
constexpr size_t WS_R3 = WS_R2 + 192 * MiB;
constexpr size_t WS_R4 = WS_R3 + 256 * MiB;
constexpr size_t WS_KR = WS_R4 + 224 * MiB;
constexpr size_t WS_IDX = WS_KR + 2 * MiB;
constexpr size_t WS_GATE = WS_IDX + 8 * MiB;
constexpr size_t WS_END = WS_GATE + 8 * MiB;
constexpr int CW_TMO = 0, CW_BAR = 4096;

constexpr int RING_BYTES = 131072, LDSCTL_OFF = RING_BYTES, MISC_OFF = LDSCTL_OFF + 320, LDS_BYTES = 147456;
constexpr int NWAVES = 8;

#define GAS __attribute__((address_space(1)))
#define LAS __attribute__((address_space(3)))
typedef unsigned short bf16;
typedef unsigned v4u __attribute__((ext_vector_type(4)));
typedef float f32x4 __attribute__((ext_vector_type(4)));
typedef float f32x8 __attribute__((ext_vector_type(8)));
typedef GAS unsigned gu32;
#define RLX_AGENT __ATOMIC_RELAXED, __HIP_MEMORY_SCOPE_AGENT
#define LDS_WAIT() asm volatile("s_waitcnt lgkmcnt(0)" ::: "memory")
#define VM_WAIT() asm volatile("s_waitcnt vmcnt(0)" ::: "memory")
__device__ __forceinline__ unsigned pkbf(float lo, float hi) { unsigned r; asm volatile("v_cvt_pk_bf16_f32 %0, %1, %2" : "=v"(r) : "v"(lo), "v"(hi)); return r; }

#define XB_TMO      128
#define XB_XCNT(j)  (256  + 64 * (j))
#define XB_XSUB(j)  (1280 + 64 * (j))
#define XB_XGEN(j)  (2304 + 64 * (j))
#define XB_TOP      3328
#define XB_TOPGEN   3392
#define XCD_BAR_WORDS 3456
#define XB_SPIN_CAP (1u << 22)
__device__ __forceinline__ unsigned xb_ld(unsigned* p)              { return __hip_atomic_load(p, __ATOMIC_RELAXED, __HIP_MEMORY_SCOPE_AGENT); }
__device__ __forceinline__ unsigned xb_add(unsigned* p, unsigned v) { return __hip_atomic_fetch_add(p, v, __ATOMIC_RELAXED, __HIP_MEMORY_SCOPE_AGENT); }
__device__ __forceinline__ unsigned xb_xcc_id() { return (unsigned)__builtin_amdgcn_s_getreg((3 << 11) | 20) & 0xFu; }
#define XB_SPIN(cond, bar) do { unsigned _sp = 0; while (cond) { __builtin_amdgcn_s_sleep(1); \
    if ((++_sp & 255u) == 0u) { if (xb_ld(&(bar)[XB_TMO])) break; if (_sp > XB_SPIN_CAP) { atomicAdd(&(bar)[XB_TMO], 1u); break; } } } } while (0)
struct XcdBarrier { unsigned* bar; unsigned x; volatile LAS unsigned* st; };
__device__ __forceinline__ XcdBarrier xcd_barrier_post(unsigned* bar, volatile LAS unsigned* st) {
    XcdBarrier b; b.bar = bar; b.x = xb_xcc_id(); b.st = st;
    if (threadIdx.x == 0) (void)xb_add(&bar[XB_XCNT(b.x)], 1u);
    return b;
}
__device__ __forceinline__ void xcd_barrier_complete(unsigned* bar, unsigned x, unsigned& nloc, unsigned& nx) {
    const unsigned G = gridDim.x * gridDim.y * gridDim.z;
    unsigned sum, cnt, mine, sp = 0u;
    for (;;) {
        sum = 0u; cnt = 0u; mine = 0u;
#pragma unroll
        for (unsigned j = 0; j < 16; ++j) { const unsigned c = xb_ld(&bar[XB_XCNT(j)]); sum += c; cnt += (c > 0u) ? 1u : 0u; mine = (j == x) ? c : mine; }
        if (sum == G) break;
        __builtin_amdgcn_s_sleep(1);
        if ((++sp & 255u) == 0u) { if (xb_ld(&bar[XB_TMO])) break; if (sp > XB_SPIN_CAP) { atomicAdd(&bar[XB_TMO], 1u); break; } }
    }
    nloc = mine > 0u ? mine : 1u; nx = cnt > 0u ? cnt : 1u;
}
__device__ __forceinline__ void xcd_barrier(const XcdBarrier& b) {
    asm volatile("s_waitcnt vmcnt(0)" ::: "memory");
    __syncthreads();
    if (threadIdx.x == 0) {
        unsigned* bar = b.bar;
        __builtin_amdgcn_s_waitcnt(0);
        unsigned nloc = b.st[0], nx = b.st[1];
        if (nloc == 0u) { xcd_barrier_complete(bar, b.x, nloc, nx); b.st[0] = nloc; b.st[1] = nx; }
        const unsigned old = xb_add(&bar[XB_XSUB(b.x)], 1u);
        const unsigned gen = old / nloc;
        if (old + 1u == (gen + 1u) * nloc) {
            __builtin_amdgcn_fence(__ATOMIC_RELEASE, "agent");
            asm volatile("s_waitcnt vmcnt(0)" ::: "memory");
            const unsigned og = xb_add(&bar[XB_TOP], 1u);
            const unsigned tg = og / nx;
            if (og + 1u == (tg + 1u) * nx) xb_add(&bar[XB_TOPGEN], 1u);
            else XB_SPIN(xb_ld(&bar[XB_TOPGEN]) == tg, bar);
            __builtin_amdgcn_fence(__ATOMIC_ACQUIRE, "agent");
            xb_add(&bar[XB_XGEN(b.x)], 1u);
            asm volatile("s_waitcnt vmcnt(0)" ::: "memory");
        } else {
            XB_SPIN(xb_ld(&bar[XB_XGEN(b.x)]) == gen, bar);
            __builtin_amdgcn_fence(__ATOMIC_ACQUIRE, "agent");
            asm volatile("s_waitcnt vmcnt(0)" ::: "memory");
        }
    }
    __syncthreads();
}

__device__ __forceinline__ float wave_sum(float v) {
#pragma unroll
    for (int o = 1; o < 64; o <<= 1) v += __shfl_xor(v, o);
    return v;
}
__device__ __forceinline__ void transpose_item(const float* W, int N, bf16* WT, int ldt, int row_off, const float* gk, LAS float* scr, int kb, int nb, int lane) {
    const int k0 = 64 * kb, n0 = 32 * nb;
#pragma unroll 8
    for (int i = 0; i < 32; ++i) { const int kk = 2 * i + (lane >> 5); float w = W[(size_t)(k0 + kk) * N + n0 + (lane & 31)]; if (gk) w *= gk[k0 + kk]; scr[kk * 33 + (lane & 31)] = w; }
    LDS_WAIT(); asm volatile("" ::: "memory");
    const int c = lane & 7;
#pragma unroll
    for (int j = 0; j < 4; ++j) { const int n = (lane >> 3) + 8 * j; const LAS float* s = scr + (8 * c) * 33 + n;
        v4u o; o.x = pkbf(s[0 * 33], s[1 * 33]); o.y = pkbf(s[2 * 33], s[3 * 33]); o.z = pkbf(s[4 * 33], s[5 * 33]); o.w = pkbf(s[6 * 33], s[7 * 33]);
        *(GAS v4u*)(WT + (size_t)(row_off + n0 + n) * ldt + k0 + 8 * c) = o; }
    LDS_WAIT(); asm volatile("" ::: "memory");
}
__device__ __forceinline__ void rms_row_to_bf16(const float* xrow, const float* gain, bf16* orow, int lane) {
    const GAS f32x4* xr = (const GAS f32x4*)xrow + lane; const GAS f32x4* gr = (const GAS f32x4*)gain + lane;
    f32x4 v[16]; float s = 0.f;
#pragma unroll
    for (int j = 0; j < 16; ++j) { v[j] = xr[64 * j]; s += (v[j].x * v[j].x + v[j].y * v[j].y) + (v[j].z * v[j].z + v[j].w * v[j].w); }
    const float rstd = 1.f / sqrtf(wave_sum(s) * (1.f / DM) + EPS);
    GAS unsigned long long* o8 = (GAS unsigned long long*)orow + lane;
#pragma unroll
    for (int j = 0; j < 16; ++j) { const f32x4 g = gr[64 * j];
        o8[64 * j] = (unsigned long long)pkbf(v[j].x * rstd * g.x, v[j].y * rstd * g.y) | ((unsigned long long)pkbf(v[j].z * rstd * g.z, v[j].w * rstd * g.w) << 32); }
}

struct Args {
    const float* in[19]; float* out; unsigned char* ws; int ph_lo, ph_hi, use_bar, pad;
};

__global__ void __launch_bounds__(NWAVES * 64, 2) mk_fwd(Args args) {
    extern __shared__ __attribute__((aligned(16))) unsigned char lds[];
    LAS unsigned char* ldsl = (LAS unsigned char*)lds;
    volatile LAS unsigned* MISC = (volatile LAS unsigned*)(ldsl + MISC_OFF);
    const int tid = threadIdx.x, lane = tid & 63, wave = __builtin_amdgcn_readfirstlane(tid >> 6);
    const int G = gridDim.x, bx = blockIdx.x;
    const int vcu = (G % 8 == 0) ? (bx % 8) * (G / 8) + bx / 8 : bx;
    const int gw = vcu * NWAVES + wave, NGW = G * NWAVES;
    unsigned char* ws = args.ws;
    gu32* ctl = (gu32*)(ws + WS_CTL);
    const float* x = args.in[0]; const float* attn_norm = args.in[1]; const float* w_in = args.in[2]; const float* q_norm = args.in[3]; const float* w_uq = args.in[4];
    const float* kv_norm = args.in[5]; const float* w_ukv = args.in[6]; const float* w_bmla = args.in[7]; const float* na_rpb = args.in[8]; const float* w_bna = args.in[9];
    const float* w_gate = args.in[10]; const float* b_gate = args.in[11]; const float* w_out = args.in[12]; const float* ffn_norm = args.in[13]; const float* peer_wq = args.in[14];
    const float* peer_sub = args.in[15]; const float* peer_u = args.in[16]; const float* peer_v = args.in[17]; const float* final_norm = args.in[18];
    float* out = args.out;
    float* ROPE = (float*)(ws + WS_ROPE); float* RS = (float*)(ws + WS_RS);
    bf16* WCAT = (bf16*)(ws + WS_WCAT); bf16* WUQ = (bf16*)(ws + WS_WUQ); bf16* WUKV = (bf16*)(ws + WS_WUKV); bf16* PA = (bf16*)(ws + WS_PA); bf16* PB = (bf16*)(ws + WS_PB);
    bf16* WOUT = (bf16*)(ws + WS_WOUT); bf16* WQ = (bf16*)(ws + WS_WQ); bf16* SUBH = (bf16*)(ws + WS_SUBH); bf16* SUBL = (bf16*)(ws + WS_SUBL);
    bf16* XN = (bf16*)(ws + WS_R1); bf16* OA = (bf16*)(ws + WS_R1); bf16* OB = (bf16*)(ws + WS_R1 + 64 * MiB); bf16* H2 = (bf16*)(ws + WS_R1);
    bf16* LAT = (bf16*)(ws + WS_LAT);
    bf16* NAQ = (bf16*)(ws + WS_R2); bf16* NAK = (bf16*)(ws + WS_R2 + 64 * MiB); bf16* NAV = (bf16*)(ws + WS_R2 + 128 * MiB); bf16* MRG = (bf16*)(ws + WS_R2);
    bf16* GT = (bf16*)(ws + WS_R3); unsigned char* U8 = ws + WS_R3; unsigned char* V8 = ws + WS_R3 + 64 * MiB;
    bf16* QM = (bf16*)(ws + WS_R4); bf16* KN = (bf16*)(ws + WS_R4 + 96 * MiB); bf16* VM = (bf16*)(ws + WS_R4 + 160 * MiB); float* QP = (float*)(ws + WS_R4);
    bf16* KR = (bf16*)(ws + WS_KR); int* IDX = (int*)(ws + WS_IDX); float* GATE = (float*)(ws + WS_GATE);

    for (int u = tid; u < (LDS_BYTES - LDSCTL_OFF) / 4; u += NWAVES * 64) ((LAS unsigned*)(ldsl + LDSCTL_OFF))[u] = 0u;
    __syncthreads();
    XcdBarrier bar; bar.bar = (unsigned*)(ctl + CW_BAR); bar.x = 0; bar.st = nullptr;
    if (args.use_bar) bar = xcd_barrier_post((unsigned*)(ctl + CW_BAR), MISC + 8);
    const int lo = args.ph_lo, hi = args.ph_hi;
#ifndef MK_PHMASK
#define MK_PHMASK 0xFFF
#endif
#define IN(k) (((MK_PHMASK >> (k)) & 1) && lo <= (k) && (k) < hi)
#ifndef MK_DUP
#define MK_DUP -1
#endif
#define REPS(k) ((MK_DUP == (k)) ? 2 : 1)
#define SEAM(k) do { if (IN(k) && IN((k) + 1)) xcd_barrier(bar); } while (0)

    for (int rep_ = 0; rep_ < REPS(0); ++rep_) if (IN(0)) {
        LAS float* scr = (LAS float*)(ldsl + wave * 16384);
        constexpr int I0 = 64 * 234, I1 = 64 * 256, I2 = 12 * 96, I3 = 8 * 128, I4 = 32 * 128, I5 = 32 * 128, I6 = 64 * 128, I7 = 64 * 64;
        constexpr int NITEMS = I0 + I1 + I2 + I3 + I4 + I5 + I6 + I7;
        for (int it = gw; it < NITEMS; it += NGW) {
            int r = it;
            if (r < I0) { const int kb = r / 234, nb = r % 234; const int off = (nb >= 42) ? 192 : 0; transpose_item(w_in, 7488, WCAT, 4096, off, nullptr, scr, kb, nb, lane); continue; } r -= I0;
            if (r < I1) { transpose_item(w_gate, 8192, WCAT, 4096, 7680, nullptr, scr, r / 256, r % 256, lane); continue; } r -= I1;
            if (r < I2) { transpose_item(w_uq, 3072, WUQ, 768, 0, q_norm, scr, r / 96, r % 96, lane); continue; } r -= I2;
            if (r < I3) { transpose_item(w_ukv, 4096, WUKV, 512, 0, kv_norm, scr, r / 128, r % 128, lane); continue; } r -= I3;
            if (r < I4) { transpose_item(w_bmla, 4096, PA, 2048, 0, nullptr, scr, r / 128, r % 128, lane); continue; } r -= I4;
            if (r < I5) { transpose_item(w_bna, 4096, PB, 2048, 0, nullptr, scr, r / 128, r % 128, lane); continue; } r -= I5;
            if (r < I6) { transpose_item(w_out, 4096, WOUT, 4096, 0, nullptr, scr, r / 128, r % 128, lane); continue; } r -= I6;
            transpose_item(peer_wq, 2048, WQ, 4096, 0, nullptr, scr, r / 64, r % 64, lane);
        }
        for (int i = gw * 64 + lane; i < 192 * 4096 / 8; i += NGW * 64) ((GAS v4u*)(WCAT + (size_t)1344 * 4096))[i] = (v4u){0u, 0u, 0u, 0u};
        for (int i = gw * 64 + lane; i < 8 * 2 * 128 * 128 / 2; i += NGW * 64) { const float a = peer_sub[2 * i], b = peer_sub[2 * i + 1];
            const unsigned h = pkbf(a, b); const unsigned l = pkbf(a - __uint_as_float(h << 16), b - __uint_as_float(h & 0xffff0000u));
            ((GAS unsigned*)SUBH)[i] = h; ((GAS unsigned*)SUBL)[i] = l; }
        for (int i = gw * 64 + lane; i < 128 * 16; i += NGW * 64) { const int pos = i >> 4, j = i & 15; const float fr = powf(10000.0f, -(float)j / 16.0f); const float ang = (float)pos * fr;
            ROPE[2 * i] = cosf(ang); ROPE[2 * i + 1] = sinf(ang); }
        for (int m = gw; m < T; m += NGW) rms_row_to_bf16(x + (size_t)m * DM, attn_norm, XN + (size_t)m * DM, lane);
    }
    SEAM(0);
    for (int rep_ = 0; rep_ < REPS(1); ++rep_) if (IN(1)) {
        pg8::Gemm g{XN, WCAT, T, NCAT, DM, DM, DM}; pg8::StaticOrder S; S.init(T, NCAT, G, bx);
        pg8::EpiIn E{ws, WS_LAT, WS_R2, 64 * MiB, WS_R3, b_gate, NA_QSCALE};
        pg8::gemm_phase<pg8::EpiIn, pg8::StaticOrder>(ldsl, g, S, E);
    }
    SEAM(1);
    for (int rep_ = 0; rep_ < REPS(2); ++rep_) if (IN(2)) {
        for (int m = gw; m < T; m += NGW) {
            const bf16* row = LAT + (size_t)m * 1536;
            float sq = 0.f, skv = 0.f;
#pragma unroll
            for (int j = 0; j < 6; ++j) { const unsigned w = ((const GAS unsigned*)row)[lane + 64 * j]; const float a = __uint_as_float(w << 16), b = __uint_as_float(w & 0xffff0000u); sq += a * a + b * b; }
#pragma unroll
            for (int j = 0; j < 4; ++j) { const unsigned w = ((const GAS unsigned*)(row + 768))[lane + 64 * j]; const float a = __uint_as_float(w << 16), b = __uint_as_float(w & 0xffff0000u); skv += a * a + b * b; }
            sq = wave_sum(sq); skv = wave_sum(skv);
            if (lane == 0) { RS[2 * m] = 1.f / sqrtf(sq * (1.f / 768.f) + EPS); RS[2 * m + 1] = 1.f / sqrtf(skv * (1.f / 512.f) + EPS); }
            const float xk = __uint_as_float((unsigned)row[1280 + lane] << 16);
            const float xp = __shfl_xor(xk, 16);
            const int s = m & (SEQ - 1), pos = (lane < 32) ? (s >> 6) : (s & 63), j = lane & 15;
            const float c = ROPE[(pos * 16 + j) * 2], sn = ROPE[(pos * 16 + j) * 2 + 1];
            const float o = ((lane & 16) == 0) ? (xk * c - xp * sn) : (xp * sn + xk * c);
            KR[(size_t)m * 64 + lane] = (bf16)(pkbf(o, 0.f) & 0xffffu);
        }
    }
    SEAM(2);
    for (int rep_ = 0; rep_ < REPS(3); ++rep_) if (IN(3)) {
        { pg8::Gemm g{LAT, WUQ, T, 3072, 768, 1536, 768}; pg8::StaticOrder S; S.init(T, 3072, G, bx);
          pg8::EpiQ E{QM, RS, ROPE, MLA_QSCALE};
          pg8::gemm_phase<pg8::EpiQ, pg8::StaticOrder>(ldsl, g, S, E); }
        { pg8::Gemm g{LAT + 768, WUKV, T, 4096, 512, 1536, 512}; pg8::StaticOrder S; S.init(T, 4096, G, bx);
          pg8::EpiKV E{KN, VM, RS};
          pg8::gemm_phase<pg8::EpiKV, pg8::StaticOrder>(ldsl, g, S, E); }
    }
    SEAM(3);
    for (int rep_ = 0; rep_ < REPS(4); ++rep_) if (IN(4)) {
#ifndef NO_MLA
#pragma unroll 1
        for (int u = vcu; u < BATCH * 16 * 32; u += G) { const int bh = u >> 5, qb = u & 31; att::mla_unit(bh >> 4, bh & 15, qb, QM, KN, KR, VM, OA, (char*)lds); }
#endif
#ifndef NO_NA
#pragma unroll 1
        for (int u = vcu; u < BATCH * 16 * 32; u += G) { const int bh = u >> 5, rg = u & 31; att::na_unit(bh >> 4, bh & 15, rg, NAQ, NAK, NAV, na_rpb, OB, (char*)lds); }
#endif
        __syncthreads();
    }
    SEAM(4);
    for (int rep_ = 0; rep_ < REPS(5); ++rep_) if (IN(5)) {
        { pg8::Gemm g{OA, PA, T, DM, 2048, 2048, 2048}; pg8::StaticOrder S; S.init(T, DM, G, bx);
          pg8::EpiGate<true> E{GT, MRG};
          pg8::gemm_phase<pg8::EpiGate<true>, pg8::StaticOrder>(ldsl, g, S, E); }
    }
    SEAM(5);
    for (int rep_ = 0; rep_ < REPS(6); ++rep_) if (IN(6)) {
        { pg8::Gemm g{OB, PB, T, DM, 2048, 2048, 2048}; pg8::StaticOrder S; S.init(T, DM, G, bx);
          pg8::EpiGate<false> E{GT, MRG};
          pg8::gemm_phase<pg8::EpiGate<false>, pg8::StaticOrder>(ldsl, g, S, E); }
    }
    SEAM(6);
    for (int rep_ = 0; rep_ < REPS(7); ++rep_) if (IN(7)) {
        pg8::Gemm g{MRG, WOUT, T, DM, DM, DM, DM}; pg8::StaticOrder S; S.init(T, DM, G, bx);
        pg8::EpiF32 E{x, out, DM};
        pg8::gemm_phase<pg8::EpiF32, pg8::StaticOrder>(ldsl, g, S, E);
#ifdef PROBE_SKIP_ATTN
        VM_WAIT(); __syncthreads();
        for (size_t i = (size_t)gw * 64 + lane; i < (size_t)T * DM / 4; i += (size_t)NGW * 64) ((GAS f32x4*)out)[i] = ((const GAS f32x4*)x)[i];
#endif
    }
    SEAM(7);
    for (int rep_ = 0; rep_ < REPS(8); ++rep_) if (IN(8)) {
        for (int m = gw; m < T; m += NGW) rms_row_to_bf16(out + (size_t)m * DM, ffn_norm, H2 + (size_t)m * DM, lane);
        const size_t n16 = (size_t)16384 * 4096 / 16;
        for (size_t i = (size_t)gw * 64 + lane; i < 2 * n16; i += (size_t)NGW * 64) {
            const bool isu = i < n16; const size_t j = isu ? i : i - n16; const float sc = isu ? peer::USCALE : peer::VSCALE;
            const GAS f32x4* src = (const GAS f32x4*)((isu ? peer_u : peer_v) + j * 16);
            const f32x4 a = src[0] * sc, b = src[1] * sc, c = src[2] * sc, d = src[3] * sc;
            v4u o; int w;
            w = __builtin_amdgcn_cvt_pk_fp8_f32(a[0], a[1], 0, false); w = __builtin_amdgcn_cvt_pk_fp8_f32(a[2], a[3], w, true); o.x = (unsigned)w;
            w = __builtin_amdgcn_cvt_pk_fp8_f32(b[0], b[1], 0, false); w = __builtin_amdgcn_cvt_pk_fp8_f32(b[2], b[3], w, true); o.y = (unsigned)w;
            w = __builtin_amdgcn_cvt_pk_fp8_f32(c[0], c[1], 0, false); w = __builtin_amdgcn_cvt_pk_fp8_f32(c[2], c[3], w, true); o.z = (unsigned)w;
            w = __builtin_amdgcn_cvt_pk_fp8_f32(d[0], d[1], 0, false); w = __builtin_amdgcn_cvt_pk_fp8_f32(d[2], d[3], w, true); o.w = (unsigned)w;
            *(GAS v4u*)((isu ? U8 : V8) + j * 16) = o;
        }
    }
    SEAM(8);
    for (int rep_ = 0; rep_ < REPS(9); ++rep_) if (IN(9)) {
        pg8::Gemm g{H2, WQ, T, 2048, DM, DM, DM}; pg8::StaticOrder S; S.init(T, 2048, G, bx);
        pg8::EpiF32 E{nullptr, QP, 2048};
        pg8::gemm_phase<pg8::EpiF32, pg8::StaticOrder>(ldsl, g, S, E);
    }
    SEAM(9);
    for (int rep_ = 0; rep_ < REPS(10); ++rep_) if (IN(10)) {
        LAS int* wl = (LAS int*)(ldsl + wave * peer::SEL_LDS_PER_WAVE);
        for (int it = gw; it < (T / 32) * 8; it += NGW) peer::select32((it >> 3) * 32, it & 7, QP, SUBH, SUBL, IDX, GATE, wl, lane);
    }
    SEAM(10);
    for (int rep_ = 0; rep_ < REPS(11); ++rep_) if (IN(11)) {
#ifdef PROBE_SKIP_PEER
        for (int t = gw; t < T; t += NGW) { float* xr = out + (size_t)t * DM; f32x4 v[16]; float ss = 0.f;
            for (int j = 0; j < 16; ++j) { v[j] = ((const GAS f32x4*)xr)[lane + 64 * j]; ss += v[j].x * v[j].x + v[j].y * v[j].y + v[j].z * v[j].z + v[j].w * v[j].w; }
            const float rstd = 1.f / sqrtf(wave_sum(ss) * (1.f / DM) + EPS);
            for (int j = 0; j < 16; ++j) { const f32x4 g = ((const GAS f32x4*)final_norm)[lane + 64 * j]; ((GAS f32x4*)xr)[lane + 64 * j] = v[j] * rstd * g; } }
#else
        if (MK_DUP == 11 && rep_ == 0) { for (int t = gw; t < T; t += NGW) peer::expert_token<false>(t, H2, U8, V8, IDX, GATE, out, final_norm, lane); }
        else { for (int t = gw; t < T; t += NGW) peer::expert_token<true>(t, H2, U8, V8, IDX, GATE, out, final_norm, lane); }
#endif
    }
#undef IN
#undef SEAM
}

extern "C" void kernel_launch(void* const* d_in, const int* in_sizes, int n_in, void* d_out, int out_size, void* d_ws, size_t ws_size, hipStream_t stream) {
    static int grid = 0;
    if (grid == 0) {
        if (n_in != 19 || out_size != T * DM || ws_size < WS_END) { fprintf(stderr, "kernel_launch: shape mismatch: n_in %d out %d ws %zu (need %zu)\n", n_in, out_size, ws_size, (size_t)WS_END); grid = -1; return; }
        int dev = 0, cus = 0, per_cu = 0;
        if (hipGetDevice(&dev) != hipSuccess || hipDeviceGetAttribute(&cus, hipDeviceAttributeMultiprocessorCount, dev) != hipSuccess) { grid = -1; return; }
        if (hipFuncSetAttribute((const void*)mk_fwd, hipFuncAttributeMaxDynamicSharedMemorySize, LDS_BYTES) != hipSuccess) { fprintf(stderr, "kernel_launch: hipFuncSetAttribute failed\n"); grid = -1; return; }
        if (hipOccupancyMaxActiveBlocksPerMultiprocessor(&per_cu, (const void*)mk_fwd, NWAVES * 64, LDS_BYTES) != hipSuccess || per_cu < 1) { fprintf(stderr, "kernel_launch: occupancy query says %d blocks per CU\n", per_cu); }
        (void)hipGetLastError();
        grid = cus;
    }
    if (grid < 0) return;
    if (hipMemsetAsync((char*)d_ws + WS_CTL, 0, CTL_ZERO_BYTES, stream) != hipSuccess) return;
    Args a{};
    for (int i = 0; i < 19; ++i) a.in[i] = (const float*)d_in[i];
    a.out = (float*)d_out; a.ws = (unsigned char*)d_ws; a.pad = 0;
    constexpr int NL = MK_CUTS;
    for (int li = 0; li < NL; ++li) {
        a.ph_lo = (NL == 1) ? 0 : li; a.ph_hi = (NL == 1) ? NPH : li + 1; a.use_bar = (NL == 1) ? 1 : 0;
        hipLaunchKernelGGL(mk_fwd, dim3(grid), dim3(NWAVES * 64), LDS_BYTES, stream, a);
    }
}
```

```cpp
#include <hip/hip_runtime.h>
#include <hip/hip_bf16.h>
#include <cstdio>
#include <cstdint>

namespace pg8 {
#define PG8_LAS __attribute__((address_space(3)))
typedef unsigned short bf16_t;
typedef short bf16x8 __attribute__((ext_vector_type(8)));
typedef float f32x4 __attribute__((ext_vector_type(4)));
typedef float f32x2 __attribute__((ext_vector_type(2)));
typedef unsigned u32x4 __attribute__((ext_vector_type(4)));
typedef unsigned u32x2 __attribute__((ext_vector_type(2)));
constexpr int BM = 256, BK = 64, HALF = 128, HTB = HALF * BK * 2  , STAGE_BYTES = 8 * HTB, NXCD = 8, WGM = 8;

__host__ __device__ __forceinline__ int lds_byte(int r, int c) { const int st = (r >> 4) * 2 + (c >> 5), rr = r & 15, cc = c & 31, ob = rr * 64 + cc * 2; return st * 1024 + (ob ^ (((ob >> 9) & 1) << 5)); }
__host__ __device__ __forceinline__ void stage_rc(int b, int& R, int& C) { const int st = b / 1024, sb = b % 1024, swz = sb ^ (((sb >> 9) & 1) << 5); R = (st >> 1) * 16 + swz / 64; C = (st & 1) * 32 + (swz % 64) / 2; }
__host__ __device__ __forceinline__ int perm32(int rho) { const int n = rho >> 4, i = rho & 15; return 8 * (i >> 2) + 4 * n + (i & 3); }

struct Unit { int pm, pn; };
struct Gemm { const bf16_t* A; const bf16_t* Bt; int M, N, K, lda, ldb; };

struct StaticOrder {
    int nM, nN, nwg, G, c;
    __host__ __device__ void init(int M, int N, int G_, int c_) { nM = M / BM; nN = N / BM; nwg = nM * nN; G = G_; c = c_; }
    __host__ __device__ bool next(int i, Unit& u) const {
        const long L = (long)i * G + c; if (L >= nwg) return false;
        int wgid = (int)L; { const int q = nwg / NXCD, r = nwg % NXCD, xcd = wgid % NXCD, off = wgid / NXCD; wgid = (xcd < r ? xcd * (q + 1) : r * (q + 1) + (xcd - r) * q) + off; }
        const int nig = WGM * nN, gid = wgid / nig, fm = gid * WGM, gsz = (nM - fm) < WGM ? (nM - fm) : WGM;
        u.pm = fm + ((wgid % nig) % gsz); u.pn = (wgid % nig) / gsz; return true;
    }
    __device__ __forceinline__ void a_ready(const Unit&) const {}
    __device__ __forceinline__ void done(const Unit&) const {}
};

__device__ __forceinline__ unsigned cvt_pk_bf16(float lo, float hi) { unsigned r; asm volatile("v_cvt_pk_bf16_f32 %0, %1, %2" : "=v"(r) : "v"(lo), "v"(hi)); return r; }
__device__ __forceinline__ float bf_lo(unsigned w) { return __uint_as_float(w << 16); }
__device__ __forceinline__ float bf_hi(unsigned w) { return __uint_as_float(w & 0xffff0000u); }


typedef int v8i __attribute__((ext_vector_type(8)));
typedef int v4i __attribute__((ext_vector_type(4)));
typedef v8i v8i_a16 __attribute__((aligned(16)));
template <class Epi, class Sched, bool ALIGN_EPI = true, bool FP8 = false>
__device__ __forceinline__ void gemm_phase(PG8_LAS unsigned char* lds, const Gemm g, const Sched& S, const Epi& E) {
    int tid_ = threadIdx.x; asm volatile("" : "+v"(tid_));
    const int tid = tid_, wid = __builtin_amdgcn_readfirstlane(tid >> 6), lane = tid & 63, wr = wid >> 2, wc = wid & 3, fr = lane & 15, fq = lane >> 4;
    const int K = g.K, nt = FP8 ? K / 128 : K / BK;
    unsigned voffA[2], voffB[2];
#pragma unroll
    for (int i = 0; i < 2; ++i) { int R, C; stage_rc(tid * 16 + i * 8192, R, C); const int Rb = Epi::PERM ? ((R & ~31) + perm32(R & 31)) : R;
        voffA[i] = FP8 ? (unsigned)(R * g.lda + 2 * C) : (unsigned)(R * g.lda + C) * 2u; voffB[i] = FP8 ? (unsigned)(Rb * g.ldb + 2 * C) : (unsigned)(Rb * g.ldb + C) * 2u; }
    const size_t kstep = (size_t)(BK * 2);
    const size_t hstepA = (size_t)HALF * g.lda * (FP8 ? 1 : 2), hstepB = (size_t)HALF * g.ldb * (FP8 ? 1 : 2);
    const size_t tstepA = 2 * hstepA, tstepB = 2 * hstepB;
    const unsigned ldsw = (unsigned)wid * 1024u;
    const int aoff = lds_byte(wr * 64 + fr, FP8 ? fq * 16 : fq * 8), boff = lds_byte(wc * 32 + fr, FP8 ? fq * 16 : fq * 8);
#define PG8_SA(b, h) (((b) * 2 + (h)) * HTB)
#define PG8_SB(b, h) ((4 + (b) * 2 + (h)) * HTB)
#define PG8_STAGE(bufoff, gbase, voff) do { _Pragma("unroll") for (int _i = 0; _i < 2; ++_i) \
        __builtin_amdgcn_global_load_lds((const unsigned*)((const char*)(gbase) + (voff)[_i]), (PG8_LAS unsigned*)(lds + (bufoff) + ldsw + _i * 8192), 16, 0, 0); } while (0)
#define PG8_LDA(dst, b, h) do { if constexpr (FP8) { _Pragma("unroll") for (int m = 0; m < 4; ++m) { const bf16x8 lo_ = *(const PG8_LAS bf16x8*)(lds + PG8_SA(b, h) + aoff + m * 2048), hi_ = *(const PG8_LAS bf16x8*)(lds + PG8_SA(b, h) + aoff + m * 2048 + 16); \
            dst##8[m] = __builtin_shufflevector(__builtin_bit_cast(v4i, lo_), __builtin_bit_cast(v4i, hi_), 0, 1, 2, 3, 4, 5, 6, 7); } } \
        else { _Pragma("unroll") for (int m = 0; m < 4; ++m) _Pragma("unroll") for (int k = 0; k < 2; ++k) dst[m][k] = *(const PG8_LAS bf16x8*)(lds + PG8_SA(b, h) + aoff + m * 2048 + k * 1024); } } while (0)
#define PG8_LDB(dst, b, h) do { if constexpr (FP8) { _Pragma("unroll") for (int n = 0; n < 2; ++n) { const bf16x8 lo_ = *(const PG8_LAS bf16x8*)(lds + PG8_SB(b, h) + boff + n * 2048), hi_ = *(const PG8_LAS bf16x8*)(lds + PG8_SB(b, h) + boff + n * 2048 + 16); \
            dst##8[n] = __builtin_shufflevector(__builtin_bit_cast(v4i, lo_), __builtin_bit_cast(v4i, hi_), 0, 1, 2, 3, 4, 5, 6, 7); } } \
        else { _Pragma("unroll") for (int n = 0; n < 2; ++n) _Pragma("unroll") for (int k = 0; k < 2; ++k) dst[n][k] = *(const PG8_LAS bf16x8*)(lds + PG8_SB(b, h) + boff + n * 2048 + k * 1024); } } while (0)
#define PG8_V8(F) __builtin_shufflevector(__builtin_bit_cast(v4i, (F)[0]), __builtin_bit_cast(v4i, (F)[1]), 0, 1, 2, 3, 4, 5, 6, 7)
#define PG8_MMA(ai, bj, At, Bt) do { __builtin_amdgcn_s_setprio(1); _Pragma("unroll") for (int m = 0; m < 4; ++m) _Pragma("unroll") for (int n = 0; n < 2; ++n) { \
        if constexpr (FP8) asm volatile("v_mfma_f32_16x16x128_f8f6f4 %0, %1, %2, %0" : "+v"(acc[ai][bj][m][n]) : "v"(Bt##8[n]), "v"(At##8[m])); \
        else { _Pragma("unroll") for (int k = 0; k < 2; ++k) acc[ai][bj][m][n] = __builtin_amdgcn_mfma_f32_16x16x32_bf16(Bt[n][k], At[m][k], acc[ai][bj][m][n], 0, 0, 0); } } \
        __builtin_amdgcn_s_setprio(0); } while (0)
#define PG8_WAIT_V(n) asm volatile("s_waitcnt vmcnt(" #n ")" ::: "memory")
#define PG8_WAIT_L(n) asm volatile("s_waitcnt lgkmcnt(" #n ")" ::: "memory")
#define PG8_BAR __builtin_amdgcn_s_barrier()
#define PG8_SCHED __builtin_amdgcn_sched_barrier(0)
    Unit cur, nxt; int ui = 0;
    if (!S.next(0, cur)) return;
    f32x4 acc[2][2][4][2];
#pragma unroll
    for (int a = 0; a < 2; ++a)
#pragma unroll
        for (int b = 0; b < 2; ++b)
#pragma unroll
            for (int m = 0; m < 4; ++m)
#pragma unroll
                for (int n = 0; n < 2; ++n) acc[a][b][m][n] = (f32x4){0.f, 0.f, 0.f, 0.f};
    bf16x8 At[4][2], B0[2][2], B1[2][2]; v8i At8[4], B08[2], B18[2];
    const char* cA = (const char*)g.A + (size_t)cur.pm * tstepA; const char* cB = (const char*)g.Bt + (size_t)cur.pn * tstepB;
    S.a_ready(cur);
    PG8_STAGE(PG8_SB(0, 0), cB, voffB); PG8_STAGE(PG8_SB(0, 1), cB + hstepB, voffB); PG8_STAGE(PG8_SA(0, 0), cA, voffA); PG8_STAGE(PG8_SA(0, 1), cA + hstepA, voffA);
    if (wr == 1) PG8_BAR;
    PG8_WAIT_V(2); PG8_BAR;
    PG8_STAGE(PG8_SB(1, 0), cB + kstep, voffB); PG8_STAGE(PG8_SA(1, 0), cA + kstep, voffA); PG8_STAGE(PG8_SB(1, 1), cB + hstepB + kstep, voffB);
    PG8_WAIT_V(6); PG8_BAR;
    for (;;) {
        const bool has_next = S.next(ui + 1, nxt);
        const char* nA = has_next ? (const char*)g.A + (size_t)nxt.pm * tstepA : cA; const char* nB = has_next ? (const char*)g.Bt + (size_t)nxt.pn * tstepB : cB;
        for (int t = 0; t < nt; t += 2) {
            const bool last = (t == nt - 2);
            const char* a1 = cA + (size_t)(t + 1) * kstep;
            const char* a2 = last ? nA : cA + (size_t)(t + 2) * kstep; const char* b2 = last ? nB : cB + (size_t)(t + 2) * kstep;
            const char* a3 = a2 + kstep; const char* b3 = b2 + kstep;
            if (last && has_next) S.a_ready(nxt);
            PG8_LDB(B0, 0, 0); PG8_LDB(B1, 0, 1); PG8_SCHED; PG8_LDA(At, 0, 0); PG8_STAGE(PG8_SA(1, 1), a1 + hstepA, voffA);
            PG8_WAIT_V(8); PG8_WAIT_L(0); PG8_BAR; PG8_MMA(0, 0, At, B0); PG8_MMA(0, 1, At, B1); PG8_BAR; PG8_SCHED;
            PG8_LDA(At, 0, 1); PG8_STAGE(PG8_SB(0, 0), b2, voffB); PG8_STAGE(PG8_SB(0, 1), b2 + hstepB, voffB); PG8_STAGE(PG8_SA(0, 0), a2, voffA);
            PG8_WAIT_V(8); PG8_WAIT_L(0); PG8_BAR; PG8_MMA(1, 0, At, B0); PG8_MMA(1, 1, At, B1); PG8_BAR; PG8_SCHED;
            PG8_LDB(B0, 1, 0); PG8_LDB(B1, 1, 1); PG8_SCHED; PG8_LDA(At, 1, 0); PG8_STAGE(PG8_SA(0, 1), a2 + hstepA, voffA);
            PG8_WAIT_V(8); PG8_WAIT_L(0); PG8_BAR; PG8_MMA(0, 0, At, B0); PG8_MMA(0, 1, At, B1); PG8_BAR; PG8_SCHED;
            PG8_LDA(At, 1, 1); PG8_STAGE(PG8_SB(1, 0), b3, voffB); PG8_STAGE(PG8_SB(1, 1), b3 + hstepB, voffB); PG8_STAGE(PG8_SA(1, 0), a3, voffA);
            PG8_WAIT_V(8); PG8_WAIT_L(0); PG8_BAR; PG8_MMA(1, 0, At, B0); PG8_MMA(1, 1, At, B1); PG8_BAR; PG8_SCHED;
        }
        if constexpr (ALIGN_EPI) { if (wr == 0) PG8_BAR; }
        if constexpr (FP8) asm volatile("s_nop 15\n\ts_nop 7" ::: "memory");
        { int l_ = threadIdx.x; asm volatile("" : "+v"(l_));
          E(acc, cur, wr, wc, l_ & 15, (l_ >> 4) & 3); } S.done(cur);
        if (!has_next) break;
#pragma unroll
        for (int a = 0; a < 2; ++a)
#pragma unroll
            for (int b = 0; b < 2; ++b)
#pragma unroll
                for (int m = 0; m < 4; ++m)
#pragma unroll
                    for (int n = 0; n < 2; ++n) acc[a][b][m][n] = (f32x4){0.f, 0.f, 0.f, 0.f};
        cur = nxt; cA = nA; cB = nB; ++ui;
        if constexpr (ALIGN_EPI) { if (wr == 1) PG8_BAR; }
    }
    PG8_WAIT_V(0);
    if constexpr (!ALIGN_EPI) { if (wr == 0) PG8_BAR; }
    PG8_BAR;
#undef PG8_SA
#undef PG8_SB
#undef PG8_STAGE
#undef PG8_LDA
#undef PG8_LDB
#undef PG8_MMA
#undef PG8_V8
#undef PG8_WAIT_V
#undef PG8_WAIT_L
#undef PG8_BAR
#undef PG8_SCHED
}

__device__ __forceinline__ unsigned pk4_fp8(float a, float b, float c, float d) { int w = __builtin_amdgcn_cvt_pk_fp8_f32(a, b, 0, false); w = __builtin_amdgcn_cvt_pk_fp8_f32(c, d, w, true); return (unsigned)w; }
__device__ __forceinline__ float sigmoidf_fast(float x) { return __builtin_amdgcn_rcpf(1.0f + __builtin_amdgcn_exp2f(-1.4426950408889634f * x)); }

struct EpiIn {
    static constexpr bool PERM = true;
    unsigned char* wsb; size_t off_lat, off_na, na_stride, off_g; const float* bgate; float qscale; float ascale;
    __device__ __forceinline__ void operator()(const f32x4 (&acc)[2][2][4][2], const Unit& u, int wr, int wc, int fr, int fq) const {
        const int row0 = u.pm * BM + wr * 64 + fr; const int pn = u.pn;
        size_t boff; int ldc, colt; float sc = 1.f; bool gate = false;
        if (pn < 6) { boff = off_lat; ldc = 1536; colt = pn * 256; }
        else if (pn < 30) { const int t = (pn - 6) >> 3; boff = off_na + (size_t)t * na_stride; ldc = 2048; colt = ((pn - 6) & 7) * 256; if (t == 0) sc = qscale; }
        else { boff = off_g; ldc = 8192; colt = (pn - 30) * 256; gate = true; }
        bf16_t* base = (bf16_t*)(wsb + boff);
        const int col0 = colt + wc * 32 + 8 * fq;
        f32x4 bv[2][2];
#pragma unroll
        for (int bj = 0; bj < 2; ++bj)
#pragma unroll
            for (int n = 0; n < 2; ++n) bv[bj][n] = gate ? *(const f32x4*)(bgate + col0 + bj * HALF + 4 * n) : (f32x4){0.f, 0.f, 0.f, 0.f};
#pragma unroll
        for (int ai = 0; ai < 2; ++ai)
#pragma unroll
            for (int m = 0; m < 4; ++m) { bf16_t* rowp = base + (size_t)(row0 + ai * HALF + m * 16) * ldc + col0;
#pragma unroll
                for (int bj = 0; bj < 2; ++bj) { f32x4 v0 = acc[ai][bj][m][0] * ascale + bv[bj][0], v1 = acc[ai][bj][m][1] * ascale + bv[bj][1];
                    if (gate) {
#pragma unroll
                        for (int i = 0; i < 4; ++i) { v0[i] = sigmoidf_fast(v0[i]); v1[i] = sigmoidf_fast(v1[i]); } }
                    else { v0 = v0 * sc; v1 = v1 * sc; }
                    u32x4 w; w.x = cvt_pk_bf16(v0[0], v0[1]); w.y = cvt_pk_bf16(v0[2], v0[3]); w.z = cvt_pk_bf16(v1[0], v1[1]); w.w = cvt_pk_bf16(v1[2], v1[3]);
                    *(u32x4*)(rowp + bj * HALF) = w; } }
    }
};

struct EpiQ {
    static constexpr bool PERM = false;
    bf16_t* Q; const float* rs; const float* rope; float qscale;
    __device__ __forceinline__ void operator()(const f32x4 (&acc)[2][2][4][2], const Unit& u, int wr, int wc, int fr, int fq) const {
#pragma unroll
        for (int ai = 0; ai < 2; ++ai)
#pragma unroll
            for (int m = 0; m < 4; ++m) {
                const int row = u.pm * BM + ai * HALF + wr * 64 + m * 16 + fr;
                const float rstd = rs[2 * row] * qscale;
                const int s = row & 8191, grow = s >> 6, gcol = s & 63;
#pragma unroll
                for (int bj = 0; bj < 2; ++bj) {
                    const int gg = 8 * u.pn + 4 * bj + wc, kind = gg % 6;
                    f32x4 v0 = acc[ai][bj][m][0] * rstd, v1 = acc[ai][bj][m][1] * rstd;
                    if (kind >= 4) {
                        const int pos = (kind == 4) ? grow : gcol;
                        const f32x4 t0 = *(const f32x4*)(rope + (size_t)(pos * 16 + 4 * fq) * 2), t1 = *(const f32x4*)(rope + (size_t)(pos * 16 + 4 * fq) * 2 + 4);
                        const float c0 = t0[0], s0 = t0[1], c1 = t0[2], s1 = t0[3], c2 = t1[0], s2 = t1[1], c3 = t1[2], s3 = t1[3];
                        f32x4 o0, o1;
                        o0[0] = v0[0] * c0 - v1[0] * s0; o1[0] = v0[0] * s0 + v1[0] * c0;
                        o0[1] = v0[1] * c1 - v1[1] * s1; o1[1] = v0[1] * s1 + v1[1] * c1;
                        o0[2] = v0[2] * c2 - v1[2] * s2; o1[2] = v0[2] * s2 + v1[2] * c2;
                        o0[3] = v0[3] * c3 - v1[3] * s3; o1[3] = v0[3] * s3 + v1[3] * c3;
                        v0 = o0; v1 = o1;
                    }
                    bf16_t* p = Q + (size_t)row * 3072 + u.pn * BM + bj * HALF + wc * 32 + 4 * fq;
                    u32x2 w0, w1; w0.x = cvt_pk_bf16(v0[0], v0[1]); w0.y = cvt_pk_bf16(v0[2], v0[3]); w1.x = cvt_pk_bf16(v1[0], v1[1]); w1.y = cvt_pk_bf16(v1[2], v1[3]);
                    *(u32x2*)p = w0; *(u32x2*)(p + 16) = w1;
                }
            }
    }
};

struct EpiKV {
    static constexpr bool PERM = true;
    bf16_t* Kn; bf16_t* Vm; const float* rs;
    __device__ __forceinline__ void operator()(const f32x4 (&acc)[2][2][4][2], const Unit& u, int wr, int wc, int fr, int fq) const {
        const int col0 = u.pn * HALF + wc * 32 + 8 * fq;
#pragma unroll
        for (int ai = 0; ai < 2; ++ai)
#pragma unroll
            for (int m = 0; m < 4; ++m) {
                const int row = u.pm * BM + ai * HALF + wr * 64 + m * 16 + fr;
                const float rstd = rs[2 * row + 1];
#pragma unroll
                for (int bj = 0; bj < 2; ++bj) { const f32x4 v0 = acc[ai][bj][m][0] * rstd, v1 = acc[ai][bj][m][1] * rstd;
                    u32x4 w; w.x = cvt_pk_bf16(v0[0], v0[1]); w.y = cvt_pk_bf16(v0[2], v0[3]); w.z = cvt_pk_bf16(v1[0], v1[1]); w.w = cvt_pk_bf16(v1[2], v1[3]);
                    *(u32x4*)((bj == 0 ? Kn : Vm) + (size_t)row * 2048 + col0) = w; }
            }
    }
};

template <bool FIRST> struct EpiGate {
    static constexpr bool PERM = true;
    const bf16_t* G; bf16_t* MRG; unsigned char* M8; float ascale, oscale;
    __device__ __forceinline__ void operator()(const f32x4 (&acc)[2][2][4][2], const Unit& u, int wr, int wc, int fr, int fq) const {
        const int col0 = u.pn * BM + wc * 32 + 8 * fq;
#pragma unroll
        for (int ai = 0; ai < 2; ++ai)
#pragma unroll
            for (int m = 0; m < 4; ++m) {
                const int row = u.pm * BM + ai * HALF + wr * 64 + m * 16 + fr;
#pragma unroll
                for (int bj = 0; bj < 2; ++bj) {
                    const int col = col0 + bj * HALF;
                    const u32x4 gw = *(const u32x4*)(G + (size_t)row * 8192 + (FIRST ? 0 : 4096) + col);
                    f32x4 v0 = acc[ai][bj][m][0] * ascale, v1 = acc[ai][bj][m][1] * ascale;
                    v0[0] *= bf_lo(gw.x); v0[1] *= bf_hi(gw.x); v0[2] *= bf_lo(gw.y); v0[3] *= bf_hi(gw.y);
                    v1[0] *= bf_lo(gw.z); v1[1] *= bf_hi(gw.z); v1[2] *= bf_lo(gw.w); v1[3] *= bf_hi(gw.w);
                    bf16_t* p = MRG + (size_t)row * 4096 + col;
                    if (!FIRST) { const u32x4 pw = *(const u32x4*)p;
                        v0[0] += bf_lo(pw.x); v0[1] += bf_hi(pw.x); v0[2] += bf_lo(pw.y); v0[3] += bf_hi(pw.y);
                        v1[0] += bf_lo(pw.z); v1[1] += bf_hi(pw.z); v1[2] += bf_lo(pw.w); v1[3] += bf_hi(pw.w); }
                    if constexpr (FIRST) { u32x4 w; w.x = cvt_pk_bf16(v0[0], v0[1]); w.y = cvt_pk_bf16(v0[2], v0[3]); w.z = cvt_pk_bf16(v1[0], v1[1]); w.w = cvt_pk_bf16(v1[2], v1[3]);
                        *(u32x4*)p = w; }
                    else { v0 = v0 * oscale; v1 = v1 * oscale; u32x2 w; w.x = pk4_fp8(v0[0], v0[1], v0[2], v0[3]); w.y = pk4_fp8(v1[0], v1[1], v1[2], v1[3]);
                        *(u32x2*)(M8 + (size_t)row * 4096 + col) = w; }
                }
            }
    }
};

struct EpiF32 {
    static constexpr bool PERM = false;
    const float* base; float* out; int ldc; float ascale;
    __device__ __forceinline__ void operator()(const f32x4 (&acc)[2][2][4][2], const Unit& u, int wr, int wc, int fr, int fq) const {
        const int col0 = u.pn * BM + wc * 32 + 4 * fq;
#pragma unroll
        for (int ai = 0; ai < 2; ++ai)
#pragma unroll
            for (int m = 0; m < 4; ++m) { const size_t off = (size_t)(u.pm * BM + ai * HALF + wr * 64 + m * 16 + fr) * ldc + col0;
#pragma unroll
                for (int bj = 0; bj < 2; ++bj)
#pragma unroll
                    for (int n = 0; n < 2; ++n) { f32x4 o = acc[ai][bj][m][n] * ascale; if (base) o = o + *(const f32x4*)(base + off + bj * HALF + n * 16); *(f32x4*)(out + off + bj * HALF + n * 16) = o; } }
    }
};
}

namespace att {
using bf16x8 = __attribute__((ext_vector_type(8))) short;
using s16x4  = __attribute__((ext_vector_type(4))) short;
using f32x16 = __attribute__((ext_vector_type(16))) float;
using u32x4  = __attribute__((ext_vector_type(4))) unsigned;
typedef unsigned short bf16_t;
constexpr int NW = 8, QBLK = 32, KVBLK = 64, SEQ = 8192, NHEAD = 16;
constexpr int SHM_V = KVBLK * 128 * 2, SHM_KN = KVBLK * 128 * 2, SHM_KR = KVBLK * 64 * 2;
constexpr int OFF_V = 0, OFF_KN = 2 * SHM_V, OFF_KR = OFF_KN + 2 * SHM_KN, OFF_WS = OFF_KR + 2 * SHM_KR, OFF_BIAS = OFF_WS + NW * 64 * 4, OFF_QR = OFF_BIAS + 2048, ATT_LDS_BYTES = OFF_QR + NW * 4096;
#define KSWZ(row, colB) ((row) * 256 + ((colB) ^ (((row) & 7) << 4)))
#define KRSWZ(row, chunk) ((row) * 128 + ((((chunk) ^ (((row) >> 1) & 7))) << 4))
#define ASBAR() __builtin_amdgcn_sched_barrier(0)
__device__ __forceinline__ int crow(int r, int hi) { return (r & 3) + 8 * (r >> 2) + 4 * hi; }
__device__ __forceinline__ unsigned cvtpk(float lo, float hi) { unsigned r; asm volatile("v_cvt_pk_bf16_f32 %0, %1, %2" : "=v"(r) : "v"(lo), "v"(hi)); return r; }
__device__ __forceinline__ bf16x8 ld8(const bf16_t* p) { return *reinterpret_cast<const bf16x8*>(p); }

constexpr float THR2 = 11.5f;
__device__ __forceinline__ void partialSM(f32x16& p0, f32x16& p1, float& m_reg, float& mn, float& alpha) {
  float pmax = p0[0];
#pragma unroll
  for (int r = 1; r < 16; ++r) pmax = fmaxf(pmax, p0[r]);
#pragma unroll
  for (int r = 0; r < 16; ++r) pmax = fmaxf(pmax, p1[r]);
  { auto rr = __builtin_amdgcn_permlane32_swap(__float_as_uint(pmax), __float_as_uint(pmax), false, false);
    pmax = fmaxf(__uint_as_float(rr[0]), __uint_as_float(rr[1])); }
  if (__builtin_expect(__all(pmax - m_reg <= THR2), 1)) { mn = m_reg; alpha = 1.f; }
  else { mn = fmaxf(m_reg, pmax); alpha = __builtin_amdgcn_exp2f(m_reg - mn); m_reg = mn; }
#pragma unroll
  for (int r = 0; r < 16; ++r) p0[r] = p0[r] - mn;
#pragma unroll
  for (int r = 0; r < 16; ++r) p1[r] = p1[r] - mn;
#pragma unroll
  for (int r = 0; r < 16; ++r) p0[r] = __builtin_amdgcn_exp2f(p0[r]);
}
__device__ __forceinline__ void finishSM(f32x16& p0, f32x16& p1, float alpha, float& l_reg, bf16x8& pa0, bf16x8& pa1, bf16x8& pa2, bf16x8& pa3) {
#pragma unroll
  for (int r = 0; r < 16; ++r) p1[r] = __builtin_amdgcn_exp2f(p1[r]);
  float ps = 0;
#pragma unroll
  for (int r = 0; r < 16; ++r) ps += p0[r];
#pragma unroll
  for (int r = 0; r < 16; ++r) ps += p1[r];
  { auto rr = __builtin_amdgcn_permlane32_swap(__float_as_uint(ps), __float_as_uint(ps), false, false);
    ps = __uint_as_float(rr[0]) + __uint_as_float(rr[1]); }
  l_reg = l_reg * alpha + ps;
#define PK4(P, BASE, OUT) do { unsigned a0 = cvtpk(P[BASE + 0], P[BASE + 1]), a1 = cvtpk(P[BASE + 2], P[BASE + 3]);   \
    unsigned b0 = cvtpk(P[BASE + 4], P[BASE + 5]), b1 = cvtpk(P[BASE + 6], P[BASE + 7]);                              \
    auto r0 = __builtin_amdgcn_permlane32_swap(a0, b0, false, false); auto r1 = __builtin_amdgcn_permlane32_swap(a1, b1, false, false); \
    u32x4 w = {r0[0], r1[0], r0[1], r1[1]}; OUT = *reinterpret_cast<bf16x8*>(&w); } while (0)
  PK4(p0, 0, pa0); PK4(p0, 8, pa1); PK4(p1, 0, pa2); PK4(p1, 8, pa3);
}
__device__ __forceinline__ int v_st(int k, int c) { const int kk = (k & ~0xC) | ((k & 4) << 1) | ((k & 8) >> 1); return ((kk >> 3) * 4 + (c >> 5)) * 512 + ((kk & 7) * 32 + (c & 31)) * 2; }
__device__ __forceinline__ int v_rd_base(int lane) { return ((lane & 3) << 3) | (((lane >> 2) & 3) << 6) | (((lane >> 4) & 1) << 5) | (((lane >> 5) & 1) << 8); }
constexpr int v_rd_off(int d0, int ks, int half) { return d0 * 512 + ks * 4096 + half * 2048; }
template <int OFF> __device__ __forceinline__ s16x4 tr_read(int vb) {
  s16x4 r; asm volatile("ds_read_b64_tr_b16 %0, %1 offset:%2" : "=&v"(r) : "v"(vb), "i"(OFF) : "memory"); return r;
}
template <int D0> __device__ __forceinline__ void pv_one(f32x16& od, int vb, bf16x8 pa0, bf16x8 pa1, bf16x8 pa2, bf16x8 pa3) {
  const s16x4 l0 = tr_read<v_rd_off(D0, 0, 0)>(vb), h0 = tr_read<v_rd_off(D0, 0, 1)>(vb), l1 = tr_read<v_rd_off(D0, 1, 0)>(vb), h1 = tr_read<v_rd_off(D0, 1, 1)>(vb);
  const s16x4 l2 = tr_read<v_rd_off(D0, 2, 0)>(vb), h2 = tr_read<v_rd_off(D0, 2, 1)>(vb), l3 = tr_read<v_rd_off(D0, 3, 0)>(vb), h3 = tr_read<v_rd_off(D0, 3, 1)>(vb);
  asm volatile("s_waitcnt lgkmcnt(0)" ::: "memory"); ASBAR();
#define PKV(L, H) (bf16x8){L[0], L[1], L[2], L[3], H[0], H[1], H[2], H[3]}
  od = __builtin_amdgcn_mfma_f32_32x32x16_bf16(pa0, PKV(l0, h0), od, 0, 0, 0);
  od = __builtin_amdgcn_mfma_f32_32x32x16_bf16(pa1, PKV(l1, h1), od, 0, 0, 0);
  od = __builtin_amdgcn_mfma_f32_32x32x16_bf16(pa2, PKV(l2, h2), od, 0, 0, 0);
  od = __builtin_amdgcn_mfma_f32_32x32x16_bf16(pa3, PKV(l3, h3), od, 0, 0, 0);
#undef PKV
}
__device__ __forceinline__ void pv_d0(f32x16* o, int vb, bf16x8 pa0, bf16x8 pa1, bf16x8 pa2, bf16x8 pa3) {
  pv_one<0>(o[0], vb, pa0, pa1, pa2, pa3); pv_one<1>(o[1], vb, pa0, pa1, pa2, pa3); pv_one<2>(o[2], vb, pa0, pa1, pa2, pa3); pv_one<3>(o[3], vb, pa0, pa1, pa2, pa3);
}
template <int NROPE> __device__ __forceinline__ void qkt(f32x16& p0, f32x16& p1, const char* Kn, const char* Kr, const bf16x8* qr, const char* qrl, int r32, int hi) {
  p0 = f32x16{}; p1 = f32x16{};
#pragma unroll
  for (int d0 = 0; d0 < 8; ++d0) { const int cb = (d0 * 16 + hi * 8) * 2;
    const bf16x8 b0 = *reinterpret_cast<const bf16x8*>(Kn + KSWZ(r32, cb));
    const bf16x8 b1 = *reinterpret_cast<const bf16x8*>(Kn + KSWZ(32 + r32, cb));
    p0 = __builtin_amdgcn_mfma_f32_32x32x16_bf16(b0, qr[d0], p0, 0, 0, 0);
    p1 = __builtin_amdgcn_mfma_f32_32x32x16_bf16(b1, qr[d0], p1, 0, 0, 0); }
#pragma unroll
  for (int d0 = 0; d0 < NROPE; ++d0) { const int ch = d0 * 2 + hi;
    const bf16x8 b0 = *reinterpret_cast<const bf16x8*>(Kr + KRSWZ(r32, ch));
    const bf16x8 b1 = *reinterpret_cast<const bf16x8*>(Kr + KRSWZ(32 + r32, ch));
    const bf16x8 qf = *reinterpret_cast<const bf16x8*>(qrl + d0 * 1024);
    p0 = __builtin_amdgcn_mfma_f32_32x32x16_bf16(b0, qf, p0, 0, 0, 0);
    p1 = __builtin_amdgcn_mfma_f32_32x32x16_bf16(b1, qf, p1, 0, 0, 0); }
}

__device__ __forceinline__ void mla_unit(int b, int h, int qb, const bf16_t* __restrict__ Q, const bf16_t* __restrict__ KN, const bf16_t* __restrict__ KR, const bf16_t* __restrict__ VM, unsigned char* __restrict__ O, float oscale, char* lds) {
  int tid_ = threadIdx.x; asm volatile("" : "+v"(tid_));
  const int tid = tid_, wid = tid >> 6, lane = tid & 63, r32 = lane & 31, hi = lane >> 5;
  char* V_lds = lds + OFF_V; char* Kn_lds = lds + OFF_KN; char* Kr_lds = lds + OFF_KR;
  float* ws = (float*)(lds + OFF_WS) + wid * 64; float* li_l = ws; float* al_l = ws + 32;
  float m_reg = -1e30f, l_reg = 0; f32x16 o[4] = {}; bf16x8 qr[8];
  char* qrl = lds + OFF_QR + wid * 4096 + (hi * 32 + r32) * 16;
  const long rowbase = (long)b * SEQ;
  const bf16_t* Qw = Q + (rowbase + qb * 256 + wid * QBLK + r32) * 3072 + h * 192 + hi * 8;
#pragma unroll
  for (int d0 = 0; d0 < 8; ++d0) qr[d0] = ld8(Qw + d0 * 16);
  const bf16_t* Kh = KN + rowbase * 2048 + h * 128; const bf16_t* Vh = VM + rowbase * 2048 + h * 128; const bf16_t* Krb = KR + rowbase * 64;
  const int sr = tid >> 4, sc = (tid & 15) * 8, vst0 = v_st(sr, sc), vst1 = v_st(32 + sr, sc);
  const int krr = tid >> 3, krc = tid & 7;
  const int vb0 = (int)(uintptr_t)V_lds + v_rd_base(lane);
  struct { bf16x8 vs0, vs1, ks0, ks1, kr0; } sr_[1];
#define SLOAD(i, k0) do { sr_[i].vs0 = ld8(&Vh[(long)((k0) + sr) * 2048 + sc]); sr_[i].vs1 = ld8(&Vh[(long)((k0) + 32 + sr) * 2048 + sc]); \
    sr_[i].ks0 = ld8(&Kh[(long)((k0) + sr) * 2048 + sc]); sr_[i].ks1 = ld8(&Kh[(long)((k0) + 32 + sr) * 2048 + sc]); sr_[i].kr0 = ld8(&Krb[(long)((k0) + krr) * 64 + krc * 8]); } while (0)
#define SWRITE(bb, i) do { *(bf16x8*)(V_lds + (bb) * SHM_V + vst0) = sr_[i].vs0; *(bf16x8*)(V_lds + (bb) * SHM_V + vst1) = sr_[i].vs1; const int kc = sc * 2; \
    *(bf16x8*)(Kn_lds + (bb) * SHM_KN + KSWZ(sr, kc)) = sr_[i].ks0; *(bf16x8*)(Kn_lds + (bb) * SHM_KN + KSWZ(32 + sr, kc)) = sr_[i].ks1; \
    *(bf16x8*)(Kr_lds + (bb) * SHM_KR + KRSWZ(krr, krc)) = sr_[i].kr0; } while (0)
#define SWAIT() asm volatile("s_waitcnt vmcnt(0)" ::: "memory")
#define RESC(a) do { if (__any((a) < 1.f)) { if (hi == 0) al_l[r32] = (a); asm volatile("s_waitcnt lgkmcnt(0)" ::: "memory"); \
    _Pragma("unroll") for (int d = 0; d < 4; ++d) _Pragma("unroll") for (int r = 0; r < 16; ++r) o[d][r] *= al_l[crow(r, hi)]; } } while (0)
  f32x16 pA0, pA1, pB0, pB1; float mnA, mnB, alA, alB; bf16x8 pa0, pa1, pa2, pa3; const int NT = SEQ / KVBLK;
  constexpr int SE = 0, SO = 0;
  __syncthreads();
#pragma unroll
  for (int d0 = 0; d0 < 4; ++d0) *(bf16x8*)(qrl + d0 * 1024) = ld8(Qw + (8 + d0) * 16);
  SLOAD(SE, 0); asm volatile("s_waitcnt vmcnt(0)" ::: "memory"); SWRITE(0, SE); __syncthreads();
  qkt<4>(pA0, pA1, Kn_lds, Kr_lds, qr, qrl, r32, hi); partialSM(pA0, pA1, m_reg, mnA, alA);
  SLOAD(SO, KVBLK);
  SWAIT(); SWRITE(1, SO); __syncthreads();
  for (int j = 1; j + 1 < NT; j += 2) {
    ASBAR(); qkt<4>(pB0, pB1, Kn_lds + SHM_KN, Kr_lds + SHM_KR, qr, qrl, r32, hi);
    finishSM(pA0, pA1, alA, l_reg, pa0, pa1, pa2, pa3); ASBAR();
    SLOAD(SE, (j + 1) * KVBLK); ASBAR();
    pv_d0(o, vb0, pa0, pa1, pa2, pa3); partialSM(pB0, pB1, m_reg, mnB, alB);
    __syncthreads(); SWAIT(); SWRITE(0, SE);
    RESC(alB); __syncthreads();
    ASBAR(); qkt<4>(pA0, pA1, Kn_lds, Kr_lds, qr, qrl, r32, hi);
    finishSM(pB0, pB1, alB, l_reg, pa0, pa1, pa2, pa3); ASBAR();
    SLOAD(SO, (j + 2) * KVBLK); ASBAR();
    pv_d0(o, vb0 + SHM_V, pa0, pa1, pa2, pa3); partialSM(pA0, pA1, m_reg, mnA, alA);
    __syncthreads(); SWAIT(); SWRITE(1, SO);
    RESC(alA); __syncthreads();
  }
  ASBAR(); qkt<4>(pB0, pB1, Kn_lds + SHM_KN, Kr_lds + SHM_KR, qr, qrl, r32, hi);
  finishSM(pA0, pA1, alA, l_reg, pa0, pa1, pa2, pa3); ASBAR();
  pv_d0(o, vb0, pa0, pa1, pa2, pa3); partialSM(pB0, pB1, m_reg, mnB, alB);
  __syncthreads(); RESC(alB);
  finishSM(pB0, pB1, alB, l_reg, pa0, pa1, pa2, pa3); ASBAR();
  pv_d0(o, vb0 + SHM_V, pa0, pa1, pa2, pa3);
  if (hi == 0) li_l[r32] = l_reg; asm volatile("s_waitcnt lgkmcnt(0)" ::: "memory");
  float rli[16];
#pragma unroll
  for (int r = 0; r < 16; ++r) rli[r] = __builtin_amdgcn_rcpf(li_l[crow(r, hi)]) * oscale;
  unsigned char* Ow = O + (rowbase + qb * 256 + wid * QBLK) * 2048 + h * 128;
#pragma unroll
  for (int r = 0; r < 16; ++r) { const int orow = crow(r, hi);
#pragma unroll
    for (int d0 = 0; d0 < 4; ++d0) Ow[(long)orow * 2048 + d0 * 32 + r32] = (unsigned char)(__builtin_amdgcn_cvt_pk_fp8_f32(o[d0][r] * rli[r], 0.f, 0, false) & 0xff); }
#undef SLOAD
#undef SWRITE
#undef SWAIT
#undef RESC
}

__device__ __forceinline__ void na_unit(int b, int h, int rg, const bf16_t* __restrict__ Q, const bf16_t* __restrict__ K, const bf16_t* __restrict__ V, const float* __restrict__ rpb, unsigned char* __restrict__ O, float oscale, char* lds) {
  int tid_ = threadIdx.x; asm volatile("" : "+v"(tid_));
  const int tid = tid_, wid = tid >> 6, lane = tid & 63, r32 = lane & 31, hi = lane >> 5;
  char* V_lds = lds + OFF_V; char* Kn_lds = lds + OFF_KN;
  float* ws = (float*)(lds + OFF_WS) + wid * 64; float* li_l = ws; float* al_l = ws + 32;
  float* bias_l = (float*)(lds + OFF_BIAS);
  const int r0 = rg * 4, rq = r0 + (wid >> 1), cq = 32 * (wid & 1) + r32;
  const int rs_w = min(max(rq - 4, 0), 120), cs = min(max(cq - 8, 0), 48);
  const int kr_lo = min(max(r0 - 4, 0), 120), kr_hi = min(max(r0 + 3 - 4, 0), 120) + 7, NT = kr_hi - kr_lo + 1;
  const long rowbase = (long)b * SEQ;
  float m_reg = -1e30f, l_reg = 0; f32x16 o[4] = {}; bf16x8 qr[8];
  const bf16_t* Qw = Q + (rowbase + rq * 64 + cq) * 2048 + h * 128 + hi * 8;
#pragma unroll
  for (int d0 = 0; d0 < 8; ++d0) qr[d0] = ld8(Qw + d0 * 16);
  const bf16_t* Kh = K + rowbase * 2048 + h * 128; const bf16_t* Vh = V + rowbase * 2048 + h * 128;
  const int sr = tid >> 4, sc = (tid & 15) * 8, vst0 = v_st(sr, sc), vst1 = v_st(32 + sr, sc);
  const int vb0 = (int)(uintptr_t)V_lds + v_rd_base(lane);
  __syncthreads();
  if (tid < 465) bias_l[tid] = rpb[h * 465 + tid] * 1.4426950408889634f;
  bf16x8 vs0, vs1, ks0, ks1;
#define NLOAD(k0) do { vs0 = ld8(&Vh[(long)((k0) + sr) * 2048 + sc]); vs1 = ld8(&Vh[(long)((k0) + 32 + sr) * 2048 + sc]); \
    ks0 = ld8(&Kh[(long)((k0) + sr) * 2048 + sc]); ks1 = ld8(&Kh[(long)((k0) + 32 + sr) * 2048 + sc]); } while (0)
#define NWRITE(bb) do { *(bf16x8*)(V_lds + (bb) * SHM_V + vst0) = vs0; *(bf16x8*)(V_lds + (bb) * SHM_V + vst1) = vs1; const int kc = sc * 2; \
    *(bf16x8*)(Kn_lds + (bb) * SHM_KN + KSWZ(sr, kc)) = ks0; *(bf16x8*)(Kn_lds + (bb) * SHM_KN + KSWZ(32 + sr, kc)) = ks1; } while (0)
  NLOAD(kr_lo * 64);
  for (int i = 0; i < NT; ++i) {
    const int kr = kr_lo + i, bb = i & 1;
    NWRITE(bb);
    if (i + 1 < NT) NLOAD((kr + 1) * 64);
    __syncthreads();
    if (kr >= rs_w && kr < rs_w + 8) {
      f32x16 p0, p1;
      qkt<0>(p0, p1, Kn_lds + bb * SHM_KN, nullptr, qr, nullptr, r32, hi);
      const float* brow = bias_l + (kr - rq + 7) * 31 + 15 - cq;
      float pmax = -1e30f;
#pragma unroll
      for (int r = 0; r < 16; ++r) { const int k0 = crow(r, hi), k1 = 32 + k0;
        const bool v0 = (k0 >= cs) && (k0 < cs + 16), v1 = (k1 >= cs) && (k1 < cs + 16);
        const float b0 = brow[v0 ? k0 : cq], b1 = brow[v1 ? k1 : cq];
        p0[r] = v0 ? p0[r] + b0 : -1e30f; p1[r] = v1 ? p1[r] + b1 : -1e30f;
        pmax = fmaxf(pmax, fmaxf(p0[r], p1[r])); }
      { auto rr = __builtin_amdgcn_permlane32_swap(__float_as_uint(pmax), __float_as_uint(pmax), false, false);
        pmax = fmaxf(__uint_as_float(rr[0]), __uint_as_float(rr[1])); }
      const float mn = fmaxf(m_reg, pmax), alpha = __builtin_amdgcn_exp2f(m_reg - mn); m_reg = mn;
#pragma unroll
      for (int r = 0; r < 16; ++r) { p0[r] = __builtin_amdgcn_exp2f(p0[r] - mn); p1[r] = __builtin_amdgcn_exp2f(p1[r] - mn); }
      float ps = 0;
#pragma unroll
      for (int r = 0; r < 16; ++r) ps += p0[r] + p1[r];
      { auto rr = __builtin_amdgcn_permlane32_swap(__float_as_uint(ps), __float_as_uint(ps), false, false);
        ps = __uint_as_float(rr[0]) + __uint_as_float(rr[1]); }
      l_reg = l_reg * alpha + ps;
      if (hi == 0) al_l[r32] = alpha; asm volatile("s_waitcnt lgkmcnt(0)" ::: "memory");
#pragma unroll
      for (int d = 0; d < 4; ++d)
#pragma unroll
        for (int r = 0; r < 16; ++r) o[d][r] *= al_l[crow(r, hi)];
      bf16x8 pa0, pa1, pa2, pa3;
      PK4(p0, 0, pa0); PK4(p0, 8, pa1); PK4(p1, 0, pa2); PK4(p1, 8, pa3);
      pv_d0(o, vb0 + bb * SHM_V, pa0, pa1, pa2, pa3);
    }
  }
  if (hi == 0) li_l[r32] = l_reg; asm volatile("s_waitcnt lgkmcnt(0)" ::: "memory");
  float rli[16];
#pragma unroll
  for (int r = 0; r < 16; ++r) rli[r] = __builtin_amdgcn_rcpf(li_l[crow(r, hi)]) * oscale;
  unsigned char* Ow = O + (rowbase + rq * 64 + 32 * (wid & 1)) * 2048 + h * 128;
#pragma unroll
  for (int r = 0; r < 16; ++r) { const int orow = crow(r, hi);
#pragma unroll
    for (int d0 = 0; d0 < 4; ++d0) Ow[(long)orow * 2048 + d0 * 32 + r32] = (unsigned char)(__builtin_amdgcn_cvt_pk_fp8_f32(o[d0][r] * rli[r], 0.f, 0, false) & 0xff); }
#undef NLOAD
#undef NWRITE
}
#undef PK4
}

namespace peer {
#define PLAS __attribute__((address_space(3)))
using bf16x8 = __attribute__((ext_vector_type(8))) short;
using bf16x2 = __attribute__((ext_vector_type(2))) __bf16;
using f32x16 = __attribute__((ext_vector_type(16))) float;
using f32x4  = __attribute__((ext_vector_type(4))) float;
using u32x4  = __attribute__((ext_vector_type(4))) unsigned;
typedef unsigned short bf16_t;
__device__ __forceinline__ int f2ord(float f) { const int u = __float_as_int(f); return u ^ ((u >> 31) & 0x7fffffff); }
__device__ __forceinline__ float ord2f(int s) { return __int_as_float(s ^ ((s >> 31) & 0x7fffffff)); }
__device__ __forceinline__ int crow(int r, int hi) { return (r & 3) + 8 * (r >> 2) + 4 * hi; }
__device__ __forceinline__ unsigned cvtpk(float lo, float hi) { unsigned r; asm volatile("v_cvt_pk_bf16_f32 %0, %1, %2" : "=v"(r) : "v"(lo), "v"(hi)); return r; }
__device__ __forceinline__ float bf_lo(unsigned w) { return __uint_as_float(w << 16); }
__device__ __forceinline__ float bf_hi(unsigned w) { return __uint_as_float(w & 0xffff0000u); }
__device__ __forceinline__ int swapmax(int m) { auto rr = __builtin_amdgcn_permlane32_swap((unsigned)m, (unsigned)m, false, false); const int a = (int)rr[0], b = (int)rr[1]; return a > b ? a : b; }

struct CandTab { int ci[50], cj[50]; };
constexpr CandTab make_cands() { CandTab t{}; int n = 0; for (int i = 0; i < 16; ++i) for (int j = 0; j < 16; ++j) if ((i + 1) * (j + 1) <= 16) { t.ci[n] = i; t.cj[n] = j; ++n; } return t; }
constexpr CandTab CT = make_cands();

constexpr int SEL_LDS_PER_WAVE = (2 * 16 + 16) * 64 * 4;

__device__ __forceinline__ void select32(int t0, int h, const float* __restrict__ QP, const bf16_t* __restrict__ SUBH, const bf16_t* __restrict__ SUBL, int* __restrict__ IDX, float* __restrict__ GATE, PLAS int* wl, int lane_) {
  int lane = lane_; asm volatile("" : "+v"(lane));
  const int r32 = lane & 31, hi = lane >> 5;
  PLAS int* topl = wl; PLAS int* winl = wl + 2 * 16 * 64;
  const float* qrow = QP + (size_t)(t0 + r32) * 2048;
  {
#pragma unroll 1
    for (int p = 0; p < 2; ++p) {
      bf16x8 qh[8], ql[8];
      const float* qp = qrow + h * 256 + p * 128 + hi * 8;
#pragma unroll
      for (int d0 = 0; d0 < 8; ++d0) {
        const f32x4 a = *(const f32x4*)(qp + d0 * 16), b = *(const f32x4*)(qp + d0 * 16 + 4);
        u32x4 wh, wlw;
        wh.x = cvtpk(a[0], a[1]); wh.y = cvtpk(a[2], a[3]); wh.z = cvtpk(b[0], b[1]); wh.w = cvtpk(b[2], b[3]);
        wlw.x = cvtpk(a[0] - bf_lo(wh.x), a[1] - bf_hi(wh.x)); wlw.y = cvtpk(a[2] - bf_lo(wh.y), a[3] - bf_hi(wh.y));
        wlw.z = cvtpk(b[0] - bf_lo(wh.z), b[1] - bf_hi(wh.z)); wlw.w = cvtpk(b[2] - bf_lo(wh.w), b[3] - bf_hi(wh.w));
        qh[d0] = *reinterpret_cast<bf16x8*>(&wh); ql[d0] = *reinterpret_cast<bf16x8*>(&wlw);
      }
      const size_t soff = ((size_t)(h * 2 + p) * 128 + r32) * 128 + hi * 8;
      int key[64];
#pragma unroll
      for (int kb = 0; kb < 4; ++kb) {
        f32x16 acc = f32x16{};
#pragma unroll
        for (int d0 = 0; d0 < 8; ++d0) {
          const bf16x8 ah = *reinterpret_cast<const bf16x8*>(SUBH + soff + (size_t)kb * 32 * 128 + d0 * 16);
          const bf16x8 al = *reinterpret_cast<const bf16x8*>(SUBL + soff + (size_t)kb * 32 * 128 + d0 * 16);
          acc = __builtin_amdgcn_mfma_f32_32x32x16_bf16(ah, qh[d0], acc, 0, 0, 0);
          acc = __builtin_amdgcn_mfma_f32_32x32x16_bf16(ah, ql[d0], acc, 0, 0, 0);
          acc = __builtin_amdgcn_mfma_f32_32x32x16_bf16(al, qh[d0], acc, 0, 0, 0);
        }
#pragma unroll
        for (int r = 0; r < 16; ++r) key[kb * 16 + r] = (f2ord(acc[r]) & ~127) | (kb * 32 + crow(r, hi));
      }
#pragma unroll 1
      for (int it = 0; it < 16; ++it) {
        int m = key[0];
#pragma unroll
        for (int i = 1; i < 64; ++i) m = key[i] > m ? key[i] : m;
        const int gm = swapmax(m);
        topl[(p * 16 + it) * 64 + lane] = gm;
#pragma unroll
        for (int i = 0; i < 64; ++i) key[i] = (key[i] == gm) ? (int)0x80000000 : key[i];
      }
    }
    int ck[25];
#pragma unroll
    for (int c = 0; c < 25; ++c) {
      const int i = hi ? CT.ci[2 * c + 1] : CT.ci[2 * c], j = hi ? CT.cj[2 * c + 1] : CT.cj[2 * c];
      const int k0 = topl[i * 64 + lane], k1 = topl[(16 + j) * 64 + lane];
      const float s = ord2f(k0 & ~127) + ord2f(k1 & ~127);
      ck[c] = (f2ord(s) & ~255) | (i << 4) | j;
    }
#pragma unroll 1
    for (int it = 0; it < 16; ++it) {
      int m = ck[0];
#pragma unroll
      for (int i = 1; i < 25; ++i) m = ck[i] > m ? ck[i] : m;
      const int gm = swapmax(m);
      winl[it * 64 + lane] = gm;
#pragma unroll
      for (int i = 0; i < 25; ++i) ck[i] = (ck[i] == gm) ? (int)0x80000000 : ck[i];
    }
    float e[16]; int wv[16]; float tot = 0.f;
    const float s0 = ord2f(winl[lane] & ~255);
#pragma unroll
    for (int k = 0; k < 16; ++k) { wv[k] = winl[k * 64 + lane]; e[k] = __builtin_amdgcn_exp2f((ord2f(wv[k] & ~255) - s0) * 1.4426950408889634f); tot += e[k]; }
    const float rtot = 1.0f / tot;
    int l2_ = lane_; asm volatile("" : "+v"(l2_));
    const size_t ob = (size_t)(t0 + (l2_ & 31)) * 128 + h * 16 + (l2_ >> 5) * 8;
#pragma unroll
    for (int k = 0; k < 8; ++k) {
      const int w = hi ? wv[8 + k] : wv[k]; const float ev = hi ? e[8 + k] : e[k];
      const int i = (w >> 4) & 15, j = w & 15;
      const int e0 = topl[i * 64 + lane] & 127, e1 = topl[(16 + j) * 64 + lane] & 127;
      IDX[ob + k] = e0 * 128 + e1; GATE[ob + k] = ev * rtot;
    }
  }
}

__device__ __forceinline__ float dot2(unsigned w, unsigned x, float acc) { return __builtin_amdgcn_fdot2_f32_bf16(__builtin_bit_cast(bf16x2, w), __builtin_bit_cast(bf16x2, x), acc, false); }
__device__ __forceinline__ float gelu_erf(float v) {
  const float av = fabsf(v), d = av * 0.2316418882f + 1.0f, t = __builtin_amdgcn_rcpf(d);
  float q = t * 0.5307027145f + (-0.7265760135f); q = q * t + 0.7107068705f; q = q * t + (-0.142248368f); q = q * t + 0.127414796f; q = q * t;
  const float e = __builtin_amdgcn_exp2f((v * v) * (-0.72134752044f));
  const float m = v * (q * e);
  return v < 0.f ? m : v - m;
}
__device__ __forceinline__ float wave_sum(float v) {
#pragma unroll
  for (int o = 1; o < 64; o <<= 1) v += __shfl_xor(v, o);
  return v;
}

typedef float f32x2 __attribute__((ext_vector_type(2)));
constexpr float USCALE = 64.0f, VSCALE = 4.0f;
__device__ __forceinline__ f32x2 fp8x2(unsigned w, bool hiword) { return hiword ? __builtin_amdgcn_cvt_pk_f32_fp8((int)w, true) : __builtin_amdgcn_cvt_pk_f32_fp8((int)w, false); }
template <bool STORE, bool FAKE = false> __device__ __forceinline__ void expert_token(int t, const bf16_t* __restrict__ H2, const unsigned char* __restrict__ U8, const unsigned char* __restrict__ V8, const int* __restrict__ IDX, const float* __restrict__ GATE,
                                             float* X1OUT, const float* __restrict__ fnorm, int lane_) {
  int lane = lane_; asm volatile("" : "+v"(lane));
  f32x2 hf[4][8];
  { const u32x4* hp = (const u32x4*)(H2 + (size_t)t * 4096) + 2 * lane;
#pragma unroll
    for (int k = 0; k < 4; ++k) { const u32x4 a = hp[128 * k], b = hp[128 * k + 1];
      hf[k][0] = (f32x2){bf_lo(a.x), bf_hi(a.x)}; hf[k][1] = (f32x2){bf_lo(a.y), bf_hi(a.y)}; hf[k][2] = (f32x2){bf_lo(a.z), bf_hi(a.z)}; hf[k][3] = (f32x2){bf_lo(a.w), bf_hi(a.w)};
      hf[k][4] = (f32x2){bf_lo(b.x), bf_hi(b.x)}; hf[k][5] = (f32x2){bf_lo(b.y), bf_hi(b.y)}; hf[k][6] = (f32x2){bf_lo(b.z), bf_hi(b.z)}; hf[k][7] = (f32x2){bf_lo(b.w), bf_hi(b.w)}; } }
  const int e0 = FAKE ? lane : IDX[(size_t)t * 128 + lane], e1 = FAKE ? lane + 64 : IDX[(size_t)t * 128 + 64 + lane];
  const float g0 = GATE[(size_t)t * 128 + lane], g1 = GATE[(size_t)t * 128 + 64 + lane];
  float c0 = 0.f, c1 = 0.f;
  u32x4 r0[4], r1[4], r2[4], r3[4];
#define ELOAD(dst, jj) do { const int jx_ = (jj); if (jx_ < 256) { const int sl_ = jx_ & 127; const int e_ = __builtin_amdgcn_readlane(sl_ < 64 ? e0 : e1, sl_ & 63); \
    const u32x4* rp_ = (const u32x4*)((jx_ < 128 ? U8 : V8) + (size_t)e_ * 4096) + lane; _Pragma("unroll") for (int k = 0; k < 4; ++k) dst[k] = rp_[64 * k]; } \
    asm volatile("" ::: "memory"); __builtin_amdgcn_sched_barrier(0); } while (0)
#define UDOT(R, OUT) do { f32x2 a0_ = {0.f, 0.f}, a1_ = {0.f, 0.f}, a2_ = {0.f, 0.f}, a3_ = {0.f, 0.f}; \
    _Pragma("unroll") for (int k = 0; k < 4; ++k) { \
      a0_ += fp8x2(R[k].x, false) * hf[k][0]; a1_ += fp8x2(R[k].x, true) * hf[k][1]; a2_ += fp8x2(R[k].y, false) * hf[k][2]; a3_ += fp8x2(R[k].y, true) * hf[k][3]; \
      a0_ += fp8x2(R[k].z, false) * hf[k][4]; a1_ += fp8x2(R[k].z, true) * hf[k][5]; a2_ += fp8x2(R[k].w, false) * hf[k][6]; a3_ += fp8x2(R[k].w, true) * hf[k][7]; } \
    a0_ += a1_; a2_ += a3_; a0_ += a2_; OUT = a0_.x + a0_.y; } while (0)
  ELOAD(r0, 0); ELOAD(r1, 1); ELOAD(r2, 2); ELOAD(r3, 3);
#pragma unroll 1
  for (int g = 0; g < 16; ++g) {
    float p[8];
    const int j = g * 8;
    UDOT(r0, p[0]); ELOAD(r0, j + 4); UDOT(r1, p[1]); ELOAD(r1, j + 5); UDOT(r2, p[2]); ELOAD(r2, j + 6); UDOT(r3, p[3]); ELOAD(r3, j + 7);
    UDOT(r0, p[4]); ELOAD(r0, j + 8); UDOT(r1, p[5]); ELOAD(r1, j + 9); UDOT(r2, p[6]); ELOAD(r2, j + 10); UDOT(r3, p[7]); ELOAD(r3, j + 11);
    float q4[4], q2[2], q1;
    { const bool up = (lane & 32) != 0;
#pragma unroll
      for (int i = 0; i < 4; ++i) { const float send = up ? p[i] : p[4 + i], keep = up ? p[4 + i] : p[i]; q4[i] = keep + __shfl_xor(send, 32); } }
    { const bool up = (lane & 16) != 0;
#pragma unroll
      for (int i = 0; i < 2; ++i) { const float send = up ? q4[i] : q4[2 + i], keep = up ? q4[2 + i] : q4[i]; q2[i] = keep + __shfl_xor(send, 16); } }
    { const bool up = (lane & 8) != 0; const float send = up ? q2[0] : q2[1], keep = up ? q2[1] : q2[0]; q1 = keep + __shfl_xor(send, 8); }
    q1 += __shfl_xor(q1, 4); q1 += __shfl_xor(q1, 2); q1 += __shfl_xor(q1, 1);
    const float got = __shfl(q1, 8 * (lane & 7));
    if ((lane >> 3) == (g & 7)) { if (g < 8) c0 = got; else c1 = got; }
  }
#undef UDOT
  c0 = g0 * gelu_erf(c0 * (1.0f / USCALE)) * (1.0f / VSCALE); c1 = g1 * gelu_erf(c1 * (1.0f / USCALE)) * (1.0f / VSCALE);
  f32x2 acc[4][8];
#pragma unroll
  for (int k = 0; k < 4; ++k)
#pragma unroll
    for (int i = 0; i < 8; ++i) acc[k][i] = (f32x2){0.f, 0.f};
#define VROW(R, C) do { const f32x2 cc_ = {(C), (C)}; _Pragma("unroll") for (int k = 0; k < 4; ++k) { \
      acc[k][0] += cc_ * fp8x2(R[k].x, false); acc[k][1] += cc_ * fp8x2(R[k].x, true); acc[k][2] += cc_ * fp8x2(R[k].y, false); acc[k][3] += cc_ * fp8x2(R[k].y, true); \
      acc[k][4] += cc_ * fp8x2(R[k].z, false); acc[k][5] += cc_ * fp8x2(R[k].z, true); acc[k][6] += cc_ * fp8x2(R[k].w, false); acc[k][7] += cc_ * fp8x2(R[k].w, true); } } while (0)
#define CJ(j) __int_as_float(__builtin_amdgcn_readlane(__float_as_int((j) < 64 ? c0 : c1), (j) & 63))
#pragma unroll 1
  for (int j = 0; j < 128; j += 4) {
    { const float c = CJ(j); VROW(r0, c); __builtin_amdgcn_sched_barrier(0); ELOAD(r0, 128 + j + 4); }
    { const float c = CJ(j + 1); VROW(r1, c); __builtin_amdgcn_sched_barrier(0); ELOAD(r1, 128 + j + 5); }
    { const float c = CJ(j + 2); VROW(r2, c); __builtin_amdgcn_sched_barrier(0); ELOAD(r2, 128 + j + 6); }
    { const float c = CJ(j + 3); VROW(r3, c); __builtin_amdgcn_sched_barrier(0); ELOAD(r3, 128 + j + 7); }
  }
#undef VROW
#undef CJ
#undef ELOAD
  int xo_ = 16 * lane; asm volatile("" : "+v"(xo_));
  float* xr = X1OUT + (size_t)t * 4096 + xo_; float ss = 0.f;
#ifdef PROBE_PEER_SCALE
#pragma unroll
  for (int k = 0; k < 4; ++k)
#pragma unroll
    for (int i = 0; i < 8; ++i) acc[k][i] *= PROBE_PEER_SCALE;
#endif
#pragma unroll
  for (int k = 0; k < 4; ++k)
#pragma unroll
    for (int q = 0; q < 4; ++q) { const f32x4 a = *(const f32x4*)(xr + 1024 * k + 4 * q);
      acc[k][2 * q] += (f32x2){a[0], a[1]}; acc[k][2 * q + 1] += (f32x2){a[2], a[3]};
      ss += acc[k][2 * q].x * acc[k][2 * q].x + acc[k][2 * q].y * acc[k][2 * q].y + acc[k][2 * q + 1].x * acc[k][2 * q + 1].x + acc[k][2 * q + 1].y * acc[k][2 * q + 1].y; }
  const float rstd = 1.0f / sqrtf(wave_sum(ss) * (1.0f / 4096.0f) + 1e-6f);
  const float* fn = fnorm + xo_;
#pragma unroll
  for (int k = 0; k < 4; ++k)
#pragma unroll
    for (int q = 0; q < 4; ++q) { const f32x4 g = *(const f32x4*)(fn + 1024 * k + 4 * q);
      f32x4 o; o[0] = acc[k][2 * q].x * rstd * g[0]; o[1] = acc[k][2 * q].y * rstd * g[1]; o[2] = acc[k][2 * q + 1].x * rstd * g[2]; o[3] = acc[k][2 * q + 1].y * rstd * g[3];
      if constexpr (STORE) { *(f32x4*)(xr + 1024 * k + 4 * q) = o; } else { asm volatile("" :: "v"(o)); } }
}
#undef PLAS
}

constexpr int BATCH = 2, SEQ = 8192, DM = 4096, T = BATCH * SEQ;
constexpr int NCAT = 15872;
constexpr int NPH = 12;
#ifndef MK_CUTS
#define MK_CUTS 1
#endif
constexpr float EPS = 1e-6f;
constexpr float LOG2E = 1.4426950408889634f;
constexpr float MLA_QSCALE = 0.07216878364870322f * LOG2E;
constexpr float S_WIN = 64.f, S_PAB = 32.f, S_WOUT = 64.f, S_OA = 64.f, S_OB = 16.f, S_MRG = 16.f;
constexpr float NA_QSCALE = 0.08838834764831845f * LOG2E;

constexpr size_t MiB = 1u << 20;
constexpr size_t WS_CTL = 0, CTL_ZERO_BYTES = 1 * MiB;
constexpr size_t WS_ROPE = 1 * MiB;
constexpr size_t WS_RS = 1 * MiB + 65536;
constexpr size_t WS_WCAT = 2 * MiB;
constexpr size_t WS_WUQ = WS_WCAT + 124 * MiB;
constexpr size_t WS_WUKV = WS_WUQ + 5 * MiB;
constexpr size_t WS_PA = WS_WUKV + 4 * MiB;
constexpr size_t WS_PB = WS_PA + 16 * MiB;
constexpr size_t WS_WOUT = WS_PB + 16 * MiB;
constexpr size_t WS_WQ = WS_WOUT + 32 * MiB;
constexpr size_t WS_SUBH = WS_WQ + 16 * MiB;
constexpr size_t WS_SUBL = WS_SUBH + 512 * 1024;
constexpr size_t WS_R1 = WS_SUBL + 512 * 1024;
constexpr size_t WS_LAT = WS_R1 + 128 * MiB;
constexpr size_t WS_R2 = WS_LAT + 48 * MiB;
constexpr size_t WS_R3 = WS_R2 + 192 * MiB;
constexpr size_t WS_R4 = WS_R3 + 256 * MiB;
constexpr size_t WS_KR = WS_R4 + 224 * MiB;
constexpr size_t WS_IDX = WS_KR + 2 * MiB;
constexpr size_t WS_GATE = WS_IDX + 8 * MiB;
constexpr size_t WS_END = WS_GATE + 8 * MiB;
constexpr int CW_TMO = 0, CW_BAR = 4096;

constexpr int RING_BYTES = 131072, LDSCTL_OFF = RING_BYTES, MISC_OFF = LDSCTL_OFF + 320, LDS_BYTES = 147456;
constexpr int NWAVES = 8;

#define GAS __attribute__((address_space(1)))
#define LAS __attribute__((address_space(3)))
typedef unsigned short bf16;
typedef unsigned v4u __attribute__((ext_vector_type(4)));
typedef float f32x4 __attribute__((ext_vector_type(4)));
typedef float f32x8 __attribute__((ext_vector_type(8)));
typedef GAS unsigned gu32;
#define RLX_AGENT __ATOMIC_RELAXED, __HIP_MEMORY_SCOPE_AGENT
#define LDS_WAIT() asm volatile("s_waitcnt lgkmcnt(0)" ::: "memory")
#define VM_WAIT() asm volatile("s_waitcnt vmcnt(0)" ::: "memory")
__device__ __forceinline__ unsigned pkbf(float lo, float hi) { unsigned r; asm volatile("v_cvt_pk_bf16_f32 %0, %1, %2" : "=v"(r) : "v"(lo), "v"(hi)); return r; }

#define XB_TMO      128
#define XB_XCNT(j)  (256  + 64 * (j))
#define XB_XSUB(j)  (1280 + 64 * (j))
#define XB_XGEN(j)  (2304 + 64 * (j))
#define XB_TOP      3328
#define XB_TOPGEN   3392
#define XCD_BAR_WORDS 3456
#define XB_SPIN_CAP (1u << 22)
__device__ __forceinline__ unsigned xb_ld(unsigned* p)              { return __hip_atomic_load(p, __ATOMIC_RELAXED, __HIP_MEMORY_SCOPE_AGENT); }
__device__ __forceinline__ unsigned xb_add(unsigned* p, unsigned v) { return __hip_atomic_fetch_add(p, v, __ATOMIC_RELAXED, __HIP_MEMORY_SCOPE_AGENT); }
__device__ __forceinline__ unsigned xb_xcc_id() { return (unsigned)__builtin_amdgcn_s_getreg((3 << 11) | 20) & 0xFu; }
#define XB_SPIN(cond, bar) do { unsigned _sp = 0; while (cond) { __builtin_amdgcn_s_sleep(1); \
    if ((++_sp & 255u) == 0u) { if (xb_ld(&(bar)[XB_TMO])) break; if (_sp > XB_SPIN_CAP) { atomicAdd(&(bar)[XB_TMO], 1u); break; } } } } while (0)
struct XcdBarrier { unsigned* bar; unsigned x; volatile LAS unsigned* st; };
__device__ __forceinline__ XcdBarrier xcd_barrier_post(unsigned* bar, volatile LAS unsigned* st) {
    XcdBarrier b; b.bar = bar; b.x = xb_xcc_id(); b.st = st;
    if (threadIdx.x == 0) (void)xb_add(&bar[XB_XCNT(b.x)], 1u);
    return b;
}
__device__ __forceinline__ void xcd_barrier_complete(unsigned* bar, unsigned x, unsigned& nloc, unsigned& nx) {
    const unsigned G = gridDim.x * gridDim.y * gridDim.z;
    unsigned sum, cnt, mine, sp = 0u;
    for (;;) {
        sum = 0u; cnt = 0u; mine = 0u;
#pragma unroll
        for (unsigned j = 0; j < 16; ++j) { const unsigned c = xb_ld(&bar[XB_XCNT(j)]); sum += c; cnt += (c > 0u) ? 1u : 0u; mine = (j == x) ? c : mine; }
        if (sum == G) break;
        __builtin_amdgcn_s_sleep(1);
        if ((++sp & 255u) == 0u) { if (xb_ld(&bar[XB_TMO])) break; if (sp > XB_SPIN_CAP) { atomicAdd(&bar[XB_TMO], 1u); break; } }
    }
    nloc = mine > 0u ? mine : 1u; nx = cnt > 0u ? cnt : 1u;
}
__device__ __forceinline__ void xcd_barrier(const XcdBarrier& b) {
    asm volatile("s_waitcnt vmcnt(0)" ::: "memory");
    __syncthreads();
    if (threadIdx.x == 0) {
        unsigned* bar = b.bar;
        __builtin_amdgcn_s_waitcnt(0);
        unsigned nloc = b.st[0], nx = b.st[1];
        if (nloc == 0u) { xcd_barrier_complete(bar, b.x, nloc, nx); b.st[0] = nloc; b.st[1] = nx; }
        const unsigned old = xb_add(&bar[XB_XSUB(b.x)], 1u);
        const unsigned gen = old / nloc;
        if (old + 1u == (gen + 1u) * nloc) {
            __builtin_amdgcn_fence(__ATOMIC_RELEASE, "agent");
            asm volatile("s_waitcnt vmcnt(0)" ::: "memory");
            const unsigned og = xb_add(&bar[XB_TOP], 1u);
            const unsigned tg = og / nx;
            if (og + 1u == (tg + 1u) * nx) xb_add(&bar[XB_TOPGEN], 1u);
            else XB_SPIN(xb_ld(&bar[XB_TOPGEN]) == tg, bar);
            __builtin_amdgcn_fence(__ATOMIC_ACQUIRE, "agent");
            xb_add(&bar[XB_XGEN(b.x)], 1u);
            asm volatile("s_waitcnt vmcnt(0)" ::: "memory");
        } else {
            XB_SPIN(xb_ld(&bar[XB_XGEN(b.x)]) == gen, bar);
            __builtin_amdgcn_fence(__ATOMIC_ACQUIRE, "agent");
            asm volatile("s_waitcnt vmcnt(0)" ::: "memory");
        }
    }
    __syncthreads();
}

__device__ __forceinline__ float wave_sum(float v) {
#pragma unroll
    for (int o = 1; o < 64; o <<= 1) v += __shfl_xor(v, o);
    return v;
}
__device__ __forceinline__ void transpose_item(const float* W, int N, bf16* WT, int ldt, int row_off, const float* gk, LAS float* scr, int kb, int nb, int lane) {
    const int k0 = 64 * kb, n0 = 32 * nb;
#pragma unroll 8
    for (int i = 0; i < 32; ++i) { const int kk = 2 * i + (lane >> 5); float w = W[(size_t)(k0 + kk) * N + n0 + (lane & 31)]; if (gk) w *= gk[k0 + kk]; scr[kk * 33 + (lane & 31)] = w; }
    LDS_WAIT(); asm volatile("" ::: "memory");
    const int c = lane & 7;
#pragma unroll
    for (int j = 0; j < 4; ++j) { const int n = (lane >> 3) + 8 * j; const LAS float* s = scr + (8 * c) * 33 + n;
        v4u o; o.x = pkbf(s[0 * 33], s[1 * 33]); o.y = pkbf(s[2 * 33], s[3 * 33]); o.z = pkbf(s[4 * 33], s[5 * 33]); o.w = pkbf(s[6 * 33], s[7 * 33]);
        *(GAS v4u*)(WT + (size_t)(row_off + n0 + n) * ldt + k0 + 8 * c) = o; }
    LDS_WAIT(); asm volatile("" ::: "memory");
}
__device__ __forceinline__ void rms_row_to_bf16(const float* xrow, const float* gain, bf16* orow, int lane) {
    const GAS f32x4* xr = (const GAS f32x4*)xrow + lane; const GAS f32x4* gr = (const GAS f32x4*)gain + lane;
    f32x4 v[16]; float s = 0.f;
#pragma unroll
    for (int j = 0; j < 16; ++j) { v[j] = xr[64 * j]; s += (v[j].x * v[j].x + v[j].y * v[j].y) + (v[j].z * v[j].z + v[j].w * v[j].w); }
    const float rstd = 1.f / sqrtf(wave_sum(s) * (1.f / DM) + EPS);
    GAS unsigned long long* o8 = (GAS unsigned long long*)orow + lane;
#pragma unroll
    for (int j = 0; j < 16; ++j) { const f32x4 g = gr[64 * j];
        o8[64 * j] = (unsigned long long)pkbf(v[j].x * rstd * g.x, v[j].y * rstd * g.y) | ((unsigned long long)pkbf(v[j].z * rstd * g.z, v[j].w * rstd * g.w) << 32); }
}

__device__ __forceinline__ unsigned pk4f8(float a, float b, float c, float d) { int w = __builtin_amdgcn_cvt_pk_fp8_f32(a, b, 0, false); w = __builtin_amdgcn_cvt_pk_fp8_f32(c, d, w, true); return (unsigned)w; }
__device__ __forceinline__ void transpose_item8(const float* W, int N, unsigned char* WT, int ldt, int row_off, float scale, LAS float* scr, int kb, int nb, int lane) {
    const int k0 = 64 * kb, n0 = 32 * nb;
#pragma unroll 8
    for (int i = 0; i < 32; ++i) { const int kk = 2 * i + (lane >> 5); scr[kk * 33 + (lane & 31)] = W[(size_t)(k0 + kk) * N + n0 + (lane & 31)] * scale; }
    LDS_WAIT(); asm volatile("" ::: "memory");
    const int n = lane >> 1, kh = (lane & 1) * 32; const LAS float* s = scr + kh * 33 + n;
#pragma unroll
    for (int j = 0; j < 2; ++j) { v4u o;
        o.x = pk4f8(s[(16 * j + 0) * 33], s[(16 * j + 1) * 33], s[(16 * j + 2) * 33], s[(16 * j + 3) * 33]); o.y = pk4f8(s[(16 * j + 4) * 33], s[(16 * j + 5) * 33], s[(16 * j + 6) * 33], s[(16 * j + 7) * 33]);
        o.z = pk4f8(s[(16 * j + 8) * 33], s[(16 * j + 9) * 33], s[(16 * j + 10) * 33], s[(16 * j + 11) * 33]); o.w = pk4f8(s[(16 * j + 12) * 33], s[(16 * j + 13) * 33], s[(16 * j + 14) * 33], s[(16 * j + 15) * 33]);
        *(GAS v4u*)(WT + (size_t)(row_off + n0 + n) * ldt + k0 + kh + 16 * j) = o; }
    LDS_WAIT(); asm volatile("" ::: "memory");
}
__device__ __forceinline__ void rms_row_to_fp8(const float* xrow, const float* gain, unsigned char* orow, int lane) {
    const GAS f32x4* xr = (const GAS f32x4*)xrow + lane; const GAS f32x4* gr = (const GAS f32x4*)gain + lane;
    f32x4 v[16]; float s = 0.f;
#pragma unroll
    for (int j = 0; j < 16; ++j) { v[j] = xr[64 * j]; s += (v[j].x * v[j].x + v[j].y * v[j].y) + (v[j].z * v[j].z + v[j].w * v[j].w); }
    const float rstd = 1.f / sqrtf(wave_sum(s) * (1.f / DM) + EPS);
    GAS unsigned* o4 = (GAS unsigned*)orow + lane;
#pragma unroll
    for (int j = 0; j < 16; ++j) { const f32x4 g = gr[64 * j]; o4[64 * j] = pk4f8(v[j].x * rstd * g.x, v[j].y * rstd * g.y, v[j].z * rstd * g.z, v[j].w * rstd * g.w); }
}

struct Args {
    const float* in[19]; float* out; unsigned char* ws; int ph_lo, ph_hi, use_bar, pad;
};

__global__ void __launch_bounds__(NWAVES * 64, 2) mk_fwd(Args args) {
    extern __shared__ __attribute__((aligned(16))) unsigned char lds[];
    LAS unsigned char* ldsl = (LAS unsigned char*)lds;
    volatile LAS unsigned* MISC = (volatile LAS unsigned*)(ldsl + MISC_OFF);
    const int tid = threadIdx.x, lane = tid & 63, wave = __builtin_amdgcn_readfirstlane(tid >> 6);
    const int G = gridDim.x, bx = blockIdx.x;
    const int vcu = (G % 8 == 0) ? (bx % 8) * (G / 8) + bx / 8 : bx;
    const int gw = vcu * NWAVES + wave, NGW = G * NWAVES;
    unsigned char* ws = args.ws;
    gu32* ctl = (gu32*)(ws + WS_CTL);
    const float* x = args.in[0]; const float* attn_norm = args.in[1]; const float* w_in = args.in[2]; const float* q_norm = args.in[3]; const float* w_uq = args.in[4];
    const float* kv_norm = args.in[5]; const float* w_ukv = args.in[6]; const float* w_bmla = args.in[7]; const float* na_rpb = args.in[8]; const float* w_bna = args.in[9];
    const float* w_gate = args.in[10]; const float* b_gate = args.in[11]; const float* w_out = args.in[12]; const float* ffn_norm = args.in[13]; const float* peer_wq = args.in[14];
    const float* peer_sub = args.in[15]; const float* peer_u = args.in[16]; const float* peer_v = args.in[17]; const float* final_norm = args.in[18];
    float* out = args.out;
    float* ROPE = (float*)(ws + WS_ROPE); float* RS = (float*)(ws + WS_RS);
    bf16* WCAT = (bf16*)(ws + WS_WCAT); bf16* WUQ = (bf16*)(ws + WS_WUQ); bf16* WUKV = (bf16*)(ws + WS_WUKV); bf16* PA = (bf16*)(ws + WS_PA); bf16* PB = (bf16*)(ws + WS_PB);
    bf16* WOUT = (bf16*)(ws + WS_WOUT); bf16* WQ = (bf16*)(ws + WS_WQ); bf16* SUBH = (bf16*)(ws + WS_SUBH); bf16* SUBL = (bf16*)(ws + WS_SUBL);
    unsigned char* XN8 = ws + WS_R1; unsigned char* OA8 = ws + WS_R1; unsigned char* OB8 = ws + WS_R1 + 32 * MiB; bf16* H2 = (bf16*)(ws + WS_R1);
    bf16* LAT = (bf16*)(ws + WS_LAT);
    bf16* NAQ = (bf16*)(ws + WS_R2); bf16* NAK = (bf16*)(ws + WS_R2 + 64 * MiB); bf16* NAV = (bf16*)(ws + WS_R2 + 128 * MiB); bf16* MRG = (bf16*)(ws + WS_R2); unsigned char* MRG8 = ws + WS_R2 + 128 * MiB;
    bf16* GT = (bf16*)(ws + WS_R3); unsigned char* U8 = ws + WS_R3; unsigned char* V8 = ws + WS_R3 + 64 * MiB;
    bf16* QM = (bf16*)(ws + WS_R4); bf16* KN = (bf16*)(ws + WS_R4 + 96 * MiB); bf16* VM = (bf16*)(ws + WS_R4 + 160 * MiB); float* QP = (float*)(ws + WS_R4);
    bf16* KR = (bf16*)(ws + WS_KR); int* IDX = (int*)(ws + WS_IDX); float* GATE = (float*)(ws + WS_GATE);

    for (int u = tid; u < (LDS_BYTES - LDSCTL_OFF) / 4; u += NWAVES * 64) ((LAS unsigned*)(ldsl + LDSCTL_OFF))[u] = 0u;
    __syncthreads();
    XcdBarrier bar; bar.bar = (unsigned*)(ctl + CW_BAR); bar.x = 0; bar.st = nullptr;
    if (args.use_bar) bar = xcd_barrier_post((unsigned*)(ctl + CW_BAR), MISC + 8);
    const int lo = args.ph_lo, hi = args.ph_hi;
#ifndef MK_PHMASK
#define MK_PHMASK 0xFFF
#endif
#define IN(k) (((MK_PHMASK >> (k)) & 1) && lo <= (k) && (k) < hi)
#ifndef MK_FAKE
#define MK_FAKE false
#endif
#ifndef MK_DUP
#define MK_DUP -1
#endif
#define REPS(k) ((MK_DUP == (k)) ? 2 : 1)
#define SEAM(k) do { if (IN(k) && IN((k) + 1)) xcd_barrier(bar); } while (0)

    for (int rep_ = 0; rep_ < REPS(0); ++rep_) if (IN(0)) {
        LAS float* scr = (LAS float*)(ldsl + wave * 16384);
        constexpr int I0 = 64 * 234, I1 = 64 * 256, I2 = 12 * 96, I3 = 8 * 128, I4 = 32 * 128, I5 = 32 * 128, I6 = 64 * 128, I7 = 64 * 64;
        constexpr int NITEMS = I0 + I1 + I2 + I3 + I4 + I5 + I6 + I7;
        for (int it = gw; it < NITEMS; it += NGW) {
            int r = it;
            if (r < I0) { const int kb = r / 234, nb = r % 234; const int off = (nb >= 42) ? 192 : 0; transpose_item8(w_in, 7488, (unsigned char*)WCAT, 4096, off, S_WIN, scr, kb, nb, lane); continue; } r -= I0;
            if (r < I1) { transpose_item8(w_gate, 8192, (unsigned char*)WCAT, 4096, 7680, S_WIN, scr, r / 256, r % 256, lane); continue; } r -= I1;
            if (r < I2) { transpose_item(w_uq, 3072, WUQ, 768, 0, q_norm, scr, r / 96, r % 96, lane); continue; } r -= I2;
            if (r < I3) { transpose_item(w_ukv, 4096, WUKV, 512, 0, kv_norm, scr, r / 128, r % 128, lane); continue; } r -= I3;
            if (r < I4) { transpose_item8(w_bmla, 4096, (unsigned char*)PA, 2048, 0, S_PAB, scr, r / 128, r % 128, lane); continue; } r -= I4;
            if (r < I5) { transpose_item8(w_bna, 4096, (unsigned char*)PB, 2048, 0, S_PAB, scr, r / 128, r % 128, lane); continue; } r -= I5;
            if (r < I6) { transpose_item8(w_out, 4096, (unsigned char*)WOUT, 4096, 0, S_WOUT, scr, r / 128, r % 128, lane); continue; } r -= I6;
            transpose_item(peer_wq, 2048, WQ, 4096, 0, nullptr, scr, r / 64, r % 64, lane);
        }
        for (int i = gw * 64 + lane; i < 192 * 4096 / 16; i += NGW * 64) ((GAS v4u*)((unsigned char*)WCAT + (size_t)1344 * 4096))[i] = (v4u){0u, 0u, 0u, 0u};
        for (int i = gw * 64 + lane; i < 8 * 2 * 128 * 128 / 2; i += NGW * 64) { const float a = peer_sub[2 * i], b = peer_sub[2 * i + 1];
            const unsigned h = pkbf(a, b); const unsigned l = pkbf(a - __uint_as_float(h << 16), b - __uint_as_float(h & 0xffff0000u));
            ((GAS unsigned*)SUBH)[i] = h; ((GAS unsigned*)SUBL)[i] = l; }
        for (int i = gw * 64 + lane; i < 128 * 16; i += NGW * 64) { const int pos = i >> 4, j = i & 15; const float fr = powf(10000.0f, -(float)j / 16.0f); const float ang = (float)pos * fr;
            ROPE[2 * i] = cosf(ang); ROPE[2 * i + 1] = sinf(ang); }
        for (int m = gw; m < T; m += NGW) rms_row_to_fp8(x + (size_t)m * DM, attn_norm, XN8 + (size_t)m * DM, lane);
    }
    SEAM(0);
    for (int rep_ = 0; rep_ < REPS(1); ++rep_) if (IN(1)) {
        pg8::Gemm g{(const bf16*)XN8, WCAT, T, NCAT, DM, DM, DM}; pg8::StaticOrder S; S.init(T, NCAT, G, bx);
        pg8::EpiIn E{ws, WS_LAT, WS_R2, 64 * MiB, WS_R3, b_gate, NA_QSCALE, 1.0f / S_WIN};
        pg8::gemm_phase<pg8::EpiIn, pg8::StaticOrder, true, true>(ldsl, g, S, E);
    }
    SEAM(1);
    for (int rep_ = 0; rep_ < REPS(2); ++rep_) if (IN(2)) {
        for (int m = gw; m < T; m += NGW) {
            const bf16* row = LAT + (size_t)m * 1536;
            float sq = 0.f, skv = 0.f;
#pragma unroll
            for (int j = 0; j < 6; ++j) { const unsigned w = ((const GAS unsigned*)row)[lane + 64 * j]; const float a = __uint_as_float(w << 16), b = __uint_as_float(w & 0xffff0000u); sq += a * a + b * b; }
#pragma unroll
            for (int j = 0; j < 4; ++j) { const unsigned w = ((const GAS unsigned*)(row + 768))[lane + 64 * j]; const float a = __uint_as_float(w << 16), b = __uint_as_float(w & 0xffff0000u); skv += a * a + b * b; }
            sq = wave_sum(sq); skv = wave_sum(skv);
            if (lane == 0) { RS[2 * m] = 1.f / sqrtf(sq * (1.f / 768.f) + EPS); RS[2 * m + 1] = 1.f / sqrtf(skv * (1.f / 512.f) + EPS); }
            const float xk = __uint_as_float((unsigned)row[1280 + lane] << 16);
            const float xp = __shfl_xor(xk, 16);
            const int s = m & (SEQ - 1), pos = (lane < 32) ? (s >> 6) : (s & 63), j = lane & 15;
            const float c = ROPE[(pos * 16 + j) * 2], sn = ROPE[(pos * 16 + j) * 2 + 1];
            const float o = ((lane & 16) == 0) ? (xk * c - xp * sn) : (xp * sn + xk * c);
            KR[(size_t)m * 64 + lane] = (bf16)(pkbf(o, 0.f) & 0xffffu);
        }
    }
    SEAM(2);
    for (int rep_ = 0; rep_ < REPS(3); ++rep_) if (IN(3)) {
        { pg8::Gemm g{LAT, WUQ, T, 3072, 768, 1536, 768}; pg8::StaticOrder S; S.init(T, 3072, G, bx);
          pg8::EpiQ E{QM, RS, ROPE, MLA_QSCALE};
          pg8::gemm_phase<pg8::EpiQ, pg8::StaticOrder>(ldsl, g, S, E); }
        { pg8::Gemm g{LAT + 768, WUKV, T, 4096, 512, 1536, 512}; pg8::StaticOrder S; S.init(T, 4096, G, bx);
          pg8::EpiKV E{KN, VM, RS};
          pg8::gemm_phase<pg8::EpiKV, pg8::StaticOrder>(ldsl, g, S, E); }
    }
    SEAM(3);
    for (int rep_ = 0; rep_ < REPS(4); ++rep_) if (IN(4)) {
#ifndef NO_MLA
#pragma unroll 1
        for (int u = vcu; u < BATCH * 16 * 32; u += G) { const int bh = u >> 5, qb = u & 31; att::mla_unit(bh >> 4, bh & 15, qb, QM, KN, KR, VM, OA8, S_OA, (char*)lds); }
#endif
#ifndef NO_NA
#pragma unroll 1
        for (int u = vcu; u < BATCH * 16 * 32; u += G) { const int bh = u >> 5, rg = u & 31; att::na_unit(bh >> 4, bh & 15, rg, NAQ, NAK, NAV, na_rpb, OB8, S_OB, (char*)lds); }
#endif
        __syncthreads();
    }
    SEAM(4);
    for (int rep_ = 0; rep_ < REPS(5); ++rep_) if (IN(5)) {
        { pg8::Gemm g{(const bf16*)OA8, PA, T, DM, 2048, 2048, 2048}; pg8::StaticOrder S; S.init(T, DM, G, bx);
          pg8::EpiGate<true> E{GT, MRG, nullptr, 1.0f / (S_OA * S_PAB), 0.f};
          pg8::gemm_phase<pg8::EpiGate<true>, pg8::StaticOrder, true, true>(ldsl, g, S, E); }
    }
    SEAM(5);
    for (int rep_ = 0; rep_ < REPS(6); ++rep_) if (IN(6)) {
        { pg8::Gemm g{(const bf16*)OB8, PB, T, DM, 2048, 2048, 2048}; pg8::StaticOrder S; S.init(T, DM, G, bx);
          pg8::EpiGate<false> E{GT, MRG, MRG8, 1.0f / (S_OB * S_PAB), S_MRG};
          pg8::gemm_phase<pg8::EpiGate<false>, pg8::StaticOrder, true, true>(ldsl, g, S, E); }
    }
    SEAM(6);
    for (int rep_ = 0; rep_ < REPS(7); ++rep_) if (IN(7)) {
        pg8::Gemm g{(const bf16*)MRG8, WOUT, T, DM, DM, DM, DM}; pg8::StaticOrder S; S.init(T, DM, G, bx);
        pg8::EpiF32 E{x, out, DM, 1.0f / (S_MRG * S_WOUT)};
        pg8::gemm_phase<pg8::EpiF32, pg8::StaticOrder, true, true>(ldsl, g, S, E);
#ifdef PROBE_SKIP_ATTN
        VM_WAIT(); __syncthreads();
        for (size_t i = (size_t)gw * 64 + lane; i < (size_t)T * DM / 4; i += (size_t)NGW * 64) ((GAS f32x4*)out)[i] = ((const GAS f32x4*)x)[i];
#endif
    }
    SEAM(7);
    for (int rep_ = 0; rep_ < REPS(8); ++rep_) if (IN(8)) {
        for (int m = gw; m < T; m += NGW) rms_row_to_bf16(out + (size_t)m * DM, ffn_norm, H2 + (size_t)m * DM, lane);
        const size_t n16 = (size_t)16384 * 4096 / 16;
        for (size_t i = (size_t)gw * 64 + lane; i < 2 * n16; i += (size_t)NGW * 64) {
            const bool isu = i < n16; const size_t j = isu ? i : i - n16; const float sc = isu ? peer::USCALE : peer::VSCALE;
            const GAS f32x4* src = (const GAS f32x4*)((isu ? peer_u : peer_v) + j * 16);
            const f32x4 a = src[0] * sc, b = src[1] * sc, c = src[2] * sc, d = src[3] * sc;
            v4u o; int w;
            w = __builtin_amdgcn_cvt_pk_fp8_f32(a[0], a[1], 0, false); w = __builtin_amdgcn_cvt_pk_fp8_f32(a[2], a[3], w, true); o.x = (unsigned)w;
            w = __builtin_amdgcn_cvt_pk_fp8_f32(b[0], b[1], 0, false); w = __builtin_amdgcn_cvt_pk_fp8_f32(b[2], b[3], w, true); o.y = (unsigned)w;
            w = __builtin_amdgcn_cvt_pk_fp8_f32(c[0], c[1], 0, false); w = __builtin_amdgcn_cvt_pk_fp8_f32(c[2], c[3], w, true); o.z = (unsigned)w;
            w = __builtin_amdgcn_cvt_pk_fp8_f32(d[0], d[1], 0, false); w = __builtin_amdgcn_cvt_pk_fp8_f32(d[2], d[3], w, true); o.w = (unsigned)w;
            *(GAS v4u*)((isu ? U8 : V8) + j * 16) = o;
        }
    }
    SEAM(8);
    for (int rep_ = 0; rep_ < REPS(9); ++rep_) if (IN(9)) {
        pg8::Gemm g{H2, WQ, T, 2048, DM, DM, DM}; pg8::StaticOrder S; S.init(T, 2048, G, bx);
        pg8::EpiF32 E{nullptr, QP, 2048, 1.0f};
        pg8::gemm_phase<pg8::EpiF32, pg8::StaticOrder>(ldsl, g, S, E);
    }
    SEAM(9);
    for (int rep_ = 0; rep_ < REPS(10); ++rep_) if (IN(10)) {
        LAS int* wl = (LAS int*)(ldsl + wave * peer::SEL_LDS_PER_WAVE);
        for (int it = gw; it < (T / 32) * 8; it += NGW) peer::select32((it >> 3) * 32, it & 7, QP, SUBH, SUBL, IDX, GATE, wl, lane);
    }
    SEAM(10);
    for (int rep_ = 0; rep_ < REPS(11); ++rep_) if (IN(11)) {
#ifdef PROBE_SKIP_PEER
        for (int t = gw; t < T; t += NGW) { float* xr = out + (size_t)t * DM; f32x4 v[16]; float ss = 0.f;
            for (int j = 0; j < 16; ++j) { v[j] = ((const GAS f32x4*)xr)[lane + 64 * j]; ss += v[j].x * v[j].x + v[j].y * v[j].y + v[j].z * v[j].z + v[j].w * v[j].w; }
            const float rstd = 1.f / sqrtf(wave_sum(ss) * (1.f / DM) + EPS);
            for (int j = 0; j < 16; ++j) { const f32x4 g = ((const GAS f32x4*)final_norm)[lane + 64 * j]; ((GAS f32x4*)xr)[lane + 64 * j] = v[j] * rstd * g; } }
#else
        if (MK_DUP == 11 && rep_ == 0) { for (int t = gw; t < T; t += NGW) peer::expert_token<false, MK_FAKE>(t, H2, U8, V8, IDX, GATE, out, final_norm, lane); }
        else { for (int t = gw; t < T; t += NGW) peer::expert_token<true>(t, H2, U8, V8, IDX, GATE, out, final_norm, lane); }
#endif
    }
#undef IN
#undef SEAM
}

extern "C" void kernel_launch(void* const* d_in, const int* in_sizes, int n_in, void* d_out, int out_size, void* d_ws, size_t ws_size, hipStream_t stream) {
    static int grid = 0;
    if (grid == 0) {
        if (n_in != 19 || out_size != T * DM || ws_size < WS_END) { fprintf(stderr, "kernel_launch: shape mismatch: n_in %d out %d ws %zu (need %zu)\n", n_in, out_size, ws_size, (size_t)WS_END); grid = -1; return; }
        int dev = 0, cus = 0, per_cu = 0;
        if (hipGetDevice(&dev) != hipSuccess || hipDeviceGetAttribute(&cus, hipDeviceAttributeMultiprocessorCount, dev) != hipSuccess) { grid = -1; return; }
        if (hipFuncSetAttribute((const void*)mk_fwd, hipFuncAttributeMaxDynamicSharedMemorySize, LDS_BYTES) != hipSuccess) { fprintf(stderr, "kernel_launch: hipFuncSetAttribute failed\n"); grid = -1; return; }
        if (hipOccupancyMaxActiveBlocksPerMultiprocessor(&per_cu, (const void*)mk_fwd, NWAVES * 64, LDS_BYTES) != hipSuccess || per_cu < 1) { fprintf(stderr, "kernel_launch: occupancy query says %d blocks per CU\n", per_cu); }
        (void)hipGetLastError();
        grid = cus;
    }
    if (grid < 0) return;
    if (hipMemsetAsync((char*)d_ws + WS_CTL, 0, CTL_ZERO_BYTES, stream) != hipSuccess) return;
    Args a{};
    for (int i = 0; i < 19; ++i) a.in[i] = (const float*)d_in[i];
    a.out = (float*)d_out; a.ws = (unsigned char*)d_ws; a.pad = 0;
    constexpr int NL = MK_CUTS;
    for (int li = 0; li < NL; ++li) {
        a.ph_lo = (NL == 1) ? 0 : li; a.ph_hi = (NL == 1) ? NPH : li + 1; a.use_bar = (NL == 1) ? 1 : 0;
        hipLaunchKernelGGL(mk_fwd, dim3(grid), dim3(NWAVES * 64), LDS_BYTES, stream, a);
    }
}
```

```cpp
#include <hip/hip_runtime.h>
#include <hip/hip_bf16.h>
#include <cstdio>
#include <cstdint>

namespace pg8 {
#define PG8_LAS __attribute__((address_space(3)))
typedef unsigned short bf16_t;
typedef short bf16x8 __attribute__((ext_vector_type(8)));
typedef float f32x4 __attribute__((ext_vector_type(4)));
typedef float f32x2 __attribute__((ext_vector_type(2)));
typedef unsigned u32x4 __attribute__((ext_vector_type(4)));
typedef unsigned u32x2 __attribute__((ext_vector_type(2)));
constexpr int BM = 256, BK = 64, HALF = 128, HTB = HALF * BK * 2  , STAGE_BYTES = 8 * HTB, NXCD = 8, WGM = 8;

__host__ __device__ __forceinline__ int lds_byte(int r, int c) { const int st = (r >> 4) * 2 + (c >> 5), rr = r & 15, cc = c & 31, ob = rr * 64 + cc * 2; return st * 1024 + (ob ^ (((ob >> 9) & 1) << 5)); }
__host__ __device__ __forceinline__ void stage_rc(int b, int& R, int& C) { const int st = b / 1024, sb = b % 1024, swz = sb ^ (((sb >> 9) & 1) << 5); R = (st >> 1) * 16 + swz / 64; C = (st & 1) * 32 + (swz % 64) / 2; }
__host__ __device__ __forceinline__ int perm32(int rho) { const int n = rho >> 4, i = rho & 15; return 8 * (i >> 2) + 4 * n + (i & 3); }

struct Unit { int pm, pn; };
struct Gemm { const bf16_t* A; const bf16_t* Bt; int M, N, K, lda, ldb; };

struct StaticOrder {
    int nM, nN, nwg, G, c;
    __host__ __device__ void init(int M, int N, int G_, int c_) { nM = M / BM; nN = N / BM; nwg = nM * nN; G = G_; c = c_; }
    __host__ __device__ bool next(int i, Unit& u) const {
        const long L = (long)i * G + c; if (L >= nwg) return false;
        int wgid = (int)L; { const int q = nwg / NXCD, r = nwg % NXCD, xcd = wgid % NXCD, off = wgid / NXCD; wgid = (xcd < r ? xcd * (q + 1) : r * (q + 1) + (xcd - r) * q) + off; }
        const int nig = WGM * nN, gid = wgid / nig, fm = gid * WGM, gsz = (nM - fm) < WGM ? (nM - fm) : WGM;
        u.pm = fm + ((wgid % nig) % gsz); u.pn = (wgid % nig) / gsz; return true;
    }
    __device__ __forceinline__ void a_ready(const Unit&) const {}
    __device__ __forceinline__ void done(const Unit&) const {}
};

__device__ __forceinline__ unsigned cvt_pk_bf16(float lo, float hi) { unsigned r; asm volatile("v_cvt_pk_bf16_f32 %0, %1, %2" : "=v"(r) : "v"(lo), "v"(hi)); return r; }
__device__ __forceinline__ float bf_lo(unsigned w) { return __uint_as_float(w << 16); }
__device__ __forceinline__ float bf_hi(unsigned w) { return __uint_as_float(w & 0xffff0000u); }


typedef int v8i __attribute__((ext_vector_type(8)));
typedef int v4i __attribute__((ext_vector_type(4)));
typedef v8i v8i_a16 __attribute__((aligned(16)));
template <class Epi, class Sched, bool ALIGN_EPI = true, bool FP8 = false>
__device__ __forceinline__ void gemm_phase(PG8_LAS unsigned char* lds, const Gemm g, const Sched& S, const Epi& E) {
    int tid_ = threadIdx.x; asm volatile("" : "+v"(tid_));
    const int tid = tid_, wid = __builtin_amdgcn_readfirstlane(tid >> 6), lane = tid & 63, wr = wid >> 2, wc = wid & 3, fr = lane & 15, fq = lane >> 4;
    const int K = g.K, nt = FP8 ? K / 128 : K / BK;
    unsigned voffA[2], voffB[2];
#pragma unroll
    for (int i = 0; i < 2; ++i) { int R, C; stage_rc(tid * 16 + i * 8192, R, C); const int Rb = Epi::PERM ? ((R & ~31) + perm32(R & 31)) : R;
        voffA[i] = FP8 ? (unsigned)(R * g.lda + 2 * C) : (unsigned)(R * g.lda + C) * 2u; voffB[i] = FP8 ? (unsigned)(Rb * g.ldb + 2 * C) : (unsigned)(Rb * g.ldb + C) * 2u; }
    const size_t kstep = (size_t)(BK * 2);
    const size_t hstepA = (size_t)HALF * g.lda * (FP8 ? 1 : 2), hstepB = (size_t)HALF * g.ldb * (FP8 ? 1 : 2);
    const size_t tstepA = 2 * hstepA, tstepB = 2 * hstepB;
    const unsigned ldsw = (unsigned)wid * 1024u;
    const int aoff = lds_byte(wr * 64 + fr, FP8 ? fq * 16 : fq * 8), boff = lds_byte(wc * 32 + fr, FP8 ? fq * 16 : fq * 8);
#define PG8_SA(b, h) (((b) * 2 + (h)) * HTB)
#define PG8_SB(b, h) ((4 + (b) * 2 + (h)) * HTB)
#define PG8_STAGE(bufoff, gbase, voff) do { _Pragma("unroll") for (int _i = 0; _i < 2; ++_i) \
        __builtin_amdgcn_global_load_lds((const unsigned*)((const char*)(gbase) + (voff)[_i]), (PG8_LAS unsigned*)(lds + (bufoff) + ldsw + _i * 8192), 16, 0, 0); } while (0)
#define PG8_LDA(dst, b, h) do { if constexpr (FP8) { _Pragma("unroll") for (int m = 0; m < 4; ++m) { const bf16x8 lo_ = *(const PG8_LAS bf16x8*)(lds + PG8_SA(b, h) + aoff + m * 2048), hi_ = *(const PG8_LAS bf16x8*)(lds + PG8_SA(b, h) + aoff + m * 2048 + 16); \
            dst##8[m] = __builtin_shufflevector(__builtin_bit_cast(v4i, lo_), __builtin_bit_cast(v4i, hi_), 0, 1, 2, 3, 4, 5, 6, 7); } } \
        else { _Pragma("unroll") for (int m = 0; m < 4; ++m) _Pragma("unroll") for (int k = 0; k < 2; ++k) dst[m][k] = *(const PG8_LAS bf16x8*)(lds + PG8_SA(b, h) + aoff + m * 2048 + k * 1024); } } while (0)
#define PG8_LDB(dst, b, h) do { if constexpr (FP8) { _Pragma("unroll") for (int n = 0; n < 2; ++n) { const bf16x8 lo_ = *(const PG8_LAS bf16x8*)(lds + PG8_SB(b, h) + boff + n * 2048), hi_ = *(const PG8_LAS bf16x8*)(lds + PG8_SB(b, h) + boff + n * 2048 + 16); \
            dst##8[n] = __builtin_shufflevector(__builtin_bit_cast(v4i, lo_), __builtin_bit_cast(v4i, hi_), 0, 1, 2, 3, 4, 5, 6, 7); } } \
        else { _Pragma("unroll") for (int n = 0; n < 2; ++n) _Pragma("unroll") for (int k = 0; k < 2; ++k) dst[n][k] = *(const PG8_LAS bf16x8*)(lds + PG8_SB(b, h) + boff + n * 2048 + k * 1024); } } while (0)
#define PG8_V8(F) __builtin_shufflevector(__builtin_bit_cast(v4i, (F)[0]), __builtin_bit_cast(v4i, (F)[1]), 0, 1, 2, 3, 4, 5, 6, 7)
#define PG8_MMA(ai, bj, At, Bt) do { __builtin_amdgcn_s_setprio(1); _Pragma("unroll") for (int m = 0; m < 4; ++m) _Pragma("unroll") for (int n = 0; n < 2; ++n) { \
        if constexpr (FP8) asm volatile("v_mfma_f32_16x16x128_f8f6f4 %0, %1, %2, %0" : "+v"(acc[ai][bj][m][n]) : "v"(Bt##8[n]), "v"(At##8[m])); \
        else { _Pragma("unroll") for (int k = 0; k < 2; ++k) acc[ai][bj][m][n] = __builtin_amdgcn_mfma_f32_16x16x32_bf16(Bt[n][k], At[m][k], acc[ai][bj][m][n], 0, 0, 0); } } \
        __builtin_amdgcn_s_setprio(0); } while (0)
#define PG8_WAIT_V(n) asm volatile("s_waitcnt vmcnt(" #n ")" ::: "memory")
#define PG8_WAIT_L(n) asm volatile("s_waitcnt lgkmcnt(" #n ")" ::: "memory")
#define PG8_BAR __builtin_amdgcn_s_barrier()
#define PG8_SCHED __builtin_amdgcn_sched_barrier(0)
    Unit cur, nxt; int ui = 0;
    if (!S.next(0, cur)) return;
    f32x4 acc[2][2][4][2];
#pragma unroll
    for (int a = 0; a < 2; ++a)
#pragma unroll
        for (int b = 0; b < 2; ++b)
#pragma unroll
            for (int m = 0; m < 4; ++m)
#pragma unroll
                for (int n = 0; n < 2; ++n) acc[a][b][m][n] = (f32x4){0.f, 0.f, 0.f, 0.f};
    bf16x8 At[4][2], B0[2][2], B1[2][2]; v8i At8[4], B08[2], B18[2];
    const char* cA = (const char*)g.A + (size_t)cur.pm * tstepA; const char* cB = (const char*)g.Bt + (size_t)cur.pn * tstepB;
    S.a_ready(cur);
    PG8_STAGE(PG8_SB(0, 0), cB, voffB); PG8_STAGE(PG8_SB(0, 1), cB + hstepB, voffB); PG8_STAGE(PG8_SA(0, 0), cA, voffA); PG8_STAGE(PG8_SA(0, 1), cA + hstepA, voffA);
    if (wr == 1) PG8_BAR;
    PG8_WAIT_V(2); PG8_BAR;
    PG8_STAGE(PG8_SB(1, 0), cB + kstep, voffB); PG8_STAGE(PG8_SA(1, 0), cA + kstep, voffA); PG8_STAGE(PG8_SB(1, 1), cB + hstepB + kstep, voffB);
    PG8_WAIT_V(6); PG8_BAR;
    for (;;) {
        const bool has_next = S.next(ui + 1, nxt);
        const char* nA = has_next ? (const char*)g.A + (size_t)nxt.pm * tstepA : cA; const char* nB = has_next ? (const char*)g.Bt + (size_t)nxt.pn * tstepB : cB;
        for (int t = 0; t < nt; t += 2) {
            const bool last = (t == nt - 2);
            const char* a1 = cA + (size_t)(t + 1) * kstep;
            const char* a2 = last ? nA : cA + (size_t)(t + 2) * kstep; const char* b2 = last ? nB : cB + (size_t)(t + 2) * kstep;
            const char* a3 = a2 + kstep; const char* b3 = b2 + kstep;
            if (last && has_next) S.a_ready(nxt);
            PG8_LDB(B0, 0, 0); PG8_LDB(B1, 0, 1); PG8_SCHED; PG8_LDA(At, 0, 0); PG8_STAGE(PG8_SA(1, 1), a1 + hstepA, voffA);
            PG8_WAIT_V(8); PG8_WAIT_L(0); PG8_BAR; PG8_MMA(0, 0, At, B0); PG8_MMA(0, 1, At, B1); PG8_BAR; PG8_SCHED;
            PG8_LDA(At, 0, 1); PG8_STAGE(PG8_SB(0, 0), b2, voffB); PG8_STAGE(PG8_SB(0, 1), b2 + hstepB, voffB); PG8_STAGE(PG8_SA(0, 0), a2, voffA);
            PG8_WAIT_V(8); PG8_WAIT_L(0); PG8_BAR; PG8_MMA(1, 0, At, B0); PG8_MMA(1, 1, At, B1); PG8_BAR; PG8_SCHED;
            PG8_LDB(B0, 1, 0); PG8_LDB(B1, 1, 1); PG8_SCHED; PG8_LDA(At, 1, 0); PG8_STAGE(PG8_SA(0, 1), a2 + hstepA, voffA);
            PG8_WAIT_V(8); PG8_WAIT_L(0); PG8_BAR; PG8_MMA(0, 0, At, B0); PG8_MMA(0, 1, At, B1); PG8_BAR; PG8_SCHED;
            PG8_LDA(At, 1, 1); PG8_STAGE(PG8_SB(1, 0), b3, voffB); PG8_STAGE(PG8_SB(1, 1), b3 + hstepB, voffB); PG8_STAGE(PG8_SA(1, 0), a3, voffA);
            PG8_WAIT_V(8); PG8_WAIT_L(0); PG8_BAR; PG8_MMA(1, 0, At, B0); PG8_MMA(1, 1, At, B1); PG8_BAR; PG8_SCHED;
        }
        if constexpr (ALIGN_EPI) { if (wr == 0) PG8_BAR; }
        if constexpr (FP8) asm volatile("s_nop 15\n\ts_nop 7" ::: "memory");
        { int l_ = threadIdx.x; asm volatile("" : "+v"(l_));
          E(acc, cur, wr, wc, l_ & 15, (l_ >> 4) & 3); } S.done(cur);
        if (!has_next) break;
#pragma unroll
        for (int a = 0; a < 2; ++a)
#pragma unroll
            for (int b = 0; b < 2; ++b)
#pragma unroll
                for (int m = 0; m < 4; ++m)
#pragma unroll
                    for (int n = 0; n < 2; ++n) acc[a][b][m][n] = (f32x4){0.f, 0.f, 0.f, 0.f};
        cur = nxt; cA = nA; cB = nB; ++ui;
        if constexpr (ALIGN_EPI) { if (wr == 1) PG8_BAR; }
    }
    PG8_WAIT_V(0);
    if constexpr (!ALIGN_EPI) { if (wr == 0) PG8_BAR; }
    PG8_BAR;
#undef PG8_SA
#undef PG8_SB
#undef PG8_STAGE
#undef PG8_LDA
#undef PG8_LDB
#undef PG8_MMA
#undef PG8_V8
#undef PG8_WAIT_V
#undef PG8_WAIT_L
#undef PG8_BAR
#undef PG8_SCHED
}

__device__ __forceinline__ unsigned pk4_fp8(float a, float b, float c, float d) { int w = __builtin_amdgcn_cvt_pk_fp8_f32(a, b, 0, false); w = __builtin_amdgcn_cvt_pk_fp8_f32(c, d, w, true); return (unsigned)w; }
__device__ __forceinline__ float sigmoidf_fast(float x) { return __builtin_amdgcn_rcpf(1.0f + __builtin_amdgcn_exp2f(-1.4426950408889634f * x)); }

struct EpiIn {
    static constexpr bool PERM = true;
    unsigned char* wsb; size_t off_lat, off_na, na_stride, off_g; const float* bgate; float qscale; float ascale;
    __device__ __forceinline__ void operator()(const f32x4 (&acc)[2][2][4][2], const Unit& u, int wr, int wc, int fr, int fq) const {
        const int row0 = u.pm * BM + wr * 64 + fr; const int pn = u.pn;
        size_t boff; int ldc, colt; float sc = 1.f; bool gate = false;
        if (pn < 6) { boff = off_lat; ldc = 1536; colt = pn * 256; }
        else if (pn < 30) { const int t = (pn - 6) >> 3; boff = off_na + (size_t)t * na_stride; ldc = 2048; colt = ((pn - 6) & 7) * 256; if (t == 0) sc = qscale; }
        else { boff = off_g; ldc = 8192; colt = (pn - 30) * 256; gate = true; }
        bf16_t* base = (bf16_t*)(wsb + boff);
        const int col0 = colt + wc * 32 + 8 * fq;
        f32x4 bv[2][2];
#pragma unroll
        for (int bj = 0; bj < 2; ++bj)
#pragma unroll
            for (int n = 0; n < 2; ++n) bv[bj][n] = gate ? *(const f32x4*)(bgate + col0 + bj * HALF + 4 * n) : (f32x4){0.f, 0.f, 0.f, 0.f};
#pragma unroll
        for (int ai = 0; ai < 2; ++ai)
#pragma unroll
            for (int m = 0; m < 4; ++m) { bf16_t* rowp = base + (size_t)(row0 + ai * HALF + m * 16) * ldc + col0;
#pragma unroll
                for (int bj = 0; bj < 2; ++bj) { f32x4 v0 = acc[ai][bj][m][0] * ascale + bv[bj][0], v1 = acc[ai][bj][m][1] * ascale + bv[bj][1];
                    if (gate) {
#pragma unroll
                        for (int i = 0; i < 4; ++i) { v0[i] = sigmoidf_fast(v0[i]); v1[i] = sigmoidf_fast(v1[i]); } }
                    else { v0 = v0 * sc; v1 = v1 * sc; }
                    u32x4 w; w.x = cvt_pk_bf16(v0[0], v0[1]); w.y = cvt_pk_bf16(v0[2], v0[3]); w.z = cvt_pk_bf16(v1[0], v1[1]); w.w = cvt_pk_bf16(v1[2], v1[3]);
                    *(u32x4*)(rowp + bj * HALF) = w; } }
    }
};

struct EpiQ {
    static constexpr bool PERM = false;
    bf16_t* Q; const float* rs; const float* rope; float qscale;
    __device__ __forceinline__ void operator()(const f32x4 (&acc)[2][2][4][2], const Unit& u, int wr, int wc, int fr, int fq) const {
#pragma unroll
        for (int ai = 0; ai < 2; ++ai)
#pragma unroll
            for (int m = 0; m < 4; ++m) {
                const int row = u.pm * BM + ai * HALF + wr * 64 + m * 16 + fr;
                const float rstd = rs[2 * row] * qscale;
                const int s = row & 8191, grow = s >> 6, gcol = s & 63;
#pragma unroll
                for (int bj = 0; bj < 2; ++bj) {
                    const int gg = 8 * u.pn + 4 * bj + wc, kind = gg % 6;
                    f32x4 v0 = acc[ai][bj][m][0] * rstd, v1 = acc[ai][bj][m][1] * rstd;
                    if (kind >= 4) {
                        const int pos = (kind == 4) ? grow : gcol;
                        const f32x4 t0 = *(const f32x4*)(rope + (size_t)(pos * 16 + 4 * fq) * 2), t1 = *(const f32x4*)(rope + (size_t)(pos * 16 + 4 * fq) * 2 + 4);
                        const float c0 = t0[0], s0 = t0[1], c1 = t0[2], s1 = t0[3], c2 = t1[0], s2 = t1[1], c3 = t1[2], s3 = t1[3];
                        f32x4 o0, o1;
                        o0[0] = v0[0] * c0 - v1[0] * s0; o1[0] = v0[0] * s0 + v1[0] * c0;
                        o0[1] = v0[1] * c1 - v1[1] * s1; o1[1] = v0[1] * s1 + v1[1] * c1;
                        o0[2] = v0[2] * c2 - v1[2] * s2; o1[2] = v0[2] * s2 + v1[2] * c2;
                        o0[3] = v0[3] * c3 - v1[3] * s3; o1[3] = v0[3] * s3 + v1[3] * c3;
                        v0 = o0; v1 = o1;
                    }
                    bf16_t* p = Q + (size_t)row * 3072 + u.pn * BM + bj * HALF + wc * 32 + 4 * fq;
                    u32x2 w0, w1; w0.x = cvt_pk_bf16(v0[0], v0[1]); w0.y = cvt_pk_bf16(v0[2], v0[3]); w1.x = cvt_pk_bf16(v1[0], v1[1]); w1.y = cvt_pk_bf16(v1[2], v1[3]);
                    *(u32x2*)p = w0; *(u32x2*)(p + 16) = w1;
                }
            }
    }
};

struct EpiKV {
    static constexpr bool PERM = true;
    bf16_t* Kn; bf16_t* Vm; const float* rs;
    __device__ __forceinline__ void operator()(const f32x4 (&acc)[2][2][4][2], const Unit& u, int wr, int wc, int fr, int fq) const {
        const int col0 = u.pn * HALF + wc * 32 + 8 * fq;
#pragma unroll
        for (int ai = 0; ai < 2; ++ai)
#pragma unroll
            for (int m = 0; m < 4; ++m) {
                const int row = u.pm * BM + ai * HALF + wr * 64 + m * 16 + fr;
                const float rstd = rs[2 * row + 1];
#pragma unroll
                for (int bj = 0; bj < 2; ++bj) { const f32x4 v0 = acc[ai][bj][m][0] * rstd, v1 = acc[ai][bj][m][1] * rstd;
                    u32x4 w; w.x = cvt_pk_bf16(v0[0], v0[1]); w.y = cvt_pk_bf16(v0[2], v0[3]); w.z = cvt_pk_bf16(v1[0], v1[1]); w.w = cvt_pk_bf16(v1[2], v1[3]);
                    *(u32x4*)((bj == 0 ? Kn : Vm) + (size_t)row * 2048 + col0) = w; }
            }
    }
};

template <bool FIRST> struct EpiGate {
    static constexpr bool PERM = true;
    const bf16_t* G; bf16_t* MRG; unsigned char* M8; float ascale, oscale;
    __device__ __forceinline__ void operator()(const f32x4 (&acc)[2][2][4][2], const Unit& u, int wr, int wc, int fr, int fq) const {
        const int col0 = u.pn * BM + wc * 32 + 8 * fq;
#pragma unroll
        for (int ai = 0; ai < 2; ++ai)
#pragma unroll
            for (int m = 0; m < 4; ++m) {
                const int row = u.pm * BM + ai * HALF + wr * 64 + m * 16 + fr;
#pragma unroll
                for (int bj = 0; bj < 2; ++bj) {
                    const int col = col0 + bj * HALF;
                    const u32x4 gw = *(const u32x4*)(G + (size_t)row * 8192 + (FIRST ? 0 : 4096) + col);
                    f32x4 v0 = acc[ai][bj][m][0] * ascale, v1 = acc[ai][bj][m][1] * ascale;
                    v0[0] *= bf_lo(gw.x); v0[1] *= bf_hi(gw.x); v0[2] *= bf_lo(gw.y); v0[3] *= bf_hi(gw.y);
                    v1[0] *= bf_lo(gw.z); v1[1] *= bf_hi(gw.z); v1[2] *= bf_lo(gw.w); v1[3] *= bf_hi(gw.w);
                    bf16_t* p = MRG + (size_t)row * 4096 + col;
                    if (!FIRST) { const u32x4 pw = *(const u32x4*)p;
                        v0[0] += bf_lo(pw.x); v0[1] += bf_hi(pw.x); v0[2] += bf_lo(pw.y); v0[3] += bf_hi(pw.y);
                        v1[0] += bf_lo(pw.z); v1[1] += bf_hi(pw.z); v1[2] += bf_lo(pw.w); v1[3] += bf_hi(pw.w); }
                    if constexpr (FIRST) { u32x4 w; w.x = cvt_pk_bf16(v0[0], v0[1]); w.y = cvt_pk_bf16(v0[2], v0[3]); w.z = cvt_pk_bf16(v1[0], v1[1]); w.w = cvt_pk_bf16(v1[2], v1[3]);
                        *(u32x4*)p = w; }
                    else { v0 = v0 * oscale; v1 = v1 * oscale; u32x2 w; w.x = pk4_fp8(v0[0], v0[1], v0[2], v0[3]); w.y = pk4_fp8(v1[0], v1[1], v1[2], v1[3]);
                        *(u32x2*)(M8 + (size_t)row * 4096 + col) = w; }
                }
            }
    }
};

struct EpiF32 {
    static constexpr bool PERM = false;
    const float* base; float* out; int ldc; float ascale;
    __device__ __forceinline__ void operator()(const f32x4 (&acc)[2][2][4][2], const Unit& u, int wr, int wc, int fr, int fq) const {
        const int col0 = u.pn * BM + wc * 32 + 4 * fq;
#pragma unroll
        for (int ai = 0; ai < 2; ++ai)
#pragma unroll
            for (int m = 0; m < 4; ++m) { const size_t off = (size_t)(u.pm * BM + ai * HALF + wr * 64 + m * 16 + fr) * ldc + col0;
#pragma unroll
                for (int bj = 0; bj < 2; ++bj)
#pragma unroll
                    for (int n = 0; n < 2; ++n) { f32x4 o = acc[ai][bj][m][n] * ascale; if (base) o = o + *(const f32x4*)(base + off + bj * HALF + n * 16); *(f32x4*)(out + off + bj * HALF + n * 16) = o; } }
    }
};
}

namespace att {
using bf16x8 = __attribute__((ext_vector_type(8))) short;
using s16x4  = __attribute__((ext_vector_type(4))) short;
using f32x16 = __attribute__((ext_vector_type(16))) float;
using u32x4  = __attribute__((ext_vector_type(4))) unsigned;
typedef unsigned short bf16_t;
constexpr int NW = 8, QBLK = 32, KVBLK = 64, SEQ = 8192, NHEAD = 16;
constexpr int SHM_V = KVBLK * 128 * 2, SHM_KN = KVBLK * 128 * 2, SHM_KR = KVBLK * 64 * 2;
constexpr int OFF_V = 0, OFF_KN = 2 * SHM_V, OFF_KR = OFF_KN + 2 * SHM_KN, OFF_WS = OFF_KR + 2 * SHM_KR, OFF_BIAS = OFF_WS + NW * 64 * 4, OFF_QR = OFF_BIAS + 2048, ATT_LDS_BYTES = OFF_QR + NW * 4096;
#define KSWZ(row, colB) ((row) * 256 + ((colB) ^ (((row) & 7) << 4)))
#define KRSWZ(row, chunk) ((row) * 128 + ((((chunk) ^ (((row) >> 1) & 7))) << 4))
#define ASBAR() __builtin_amdgcn_sched_barrier(0)
__device__ __forceinline__ int crow(int r, int hi) { return (r & 3) + 8 * (r >> 2) + 4 * hi; }
__device__ __forceinline__ unsigned cvtpk(float lo, float hi) { unsigned r; asm volatile("v_cvt_pk_bf16_f32 %0, %1, %2" : "=v"(r) : "v"(lo), "v"(hi)); return r; }
__device__ __forceinline__ bf16x8 ld8(const bf16_t* p) { return *reinterpret_cast<const bf16x8*>(p); }

constexpr float THR2 = 11.5f;
__device__ __forceinline__ void partialSM(f32x16& p0, f32x16& p1, float& m_reg, float& mn, float& alpha) {
  float pmax = p0[0];
#pragma unroll
  for (int r = 1; r < 16; ++r) pmax = fmaxf(pmax, p0[r]);
#pragma unroll
  for (int r = 0; r < 16; ++r) pmax = fmaxf(pmax, p1[r]);
  { auto rr = __builtin_amdgcn_permlane32_swap(__float_as_uint(pmax), __float_as_uint(pmax), false, false);
    pmax = fmaxf(__uint_as_float(rr[0]), __uint_as_float(rr[1])); }
  if (__builtin_expect(__all(pmax - m_reg <= THR2), 1)) { mn = m_reg; alpha = 1.f; }
  else { mn = fmaxf(m_reg, pmax); alpha = __builtin_amdgcn_exp2f(m_reg - mn); m_reg = mn; }
#pragma unroll
  for (int r = 0; r < 16; ++r) p0[r] = p0[r] - mn;
#pragma unroll
  for (int r = 0; r < 16; ++r) p1[r] = p1[r] - mn;
#pragma unroll
  for (int r = 0; r < 16; ++r) p0[r] = __builtin_amdgcn_exp2f(p0[r]);
}
__device__ __forceinline__ void finishSM(f32x16& p0, f32x16& p1, float alpha, float& l_reg, bf16x8& pa0, bf16x8& pa1, bf16x8& pa2, bf16x8& pa3) {
#pragma unroll
  for (int r = 0; r < 16; ++r) p1[r] = __builtin_amdgcn_exp2f(p1[r]);
  float ps = 0;
#pragma unroll
  for (int r = 0; r < 16; ++r) ps += p0[r];
#pragma unroll
  for (int r = 0; r < 16; ++r) ps += p1[r];
  { auto rr = __builtin_amdgcn_permlane32_swap(__float_as_uint(ps), __float_as_uint(ps), false, false);
    ps = __uint_as_float(rr[0]) + __uint_as_float(rr[1]); }
  l_reg = l_reg * alpha + ps;
#define PK4(P, BASE, OUT) do { unsigned a0 = cvtpk(P[BASE + 0], P[BASE + 1]), a1 = cvtpk(P[BASE + 2], P[BASE + 3]);   \
    unsigned b0 = cvtpk(P[BASE + 4], P[BASE + 5]), b1 = cvtpk(P[BASE + 6], P[BASE + 7]);                              \
    auto r0 = __builtin_amdgcn_permlane32_swap(a0, b0, false, false); auto r1 = __builtin_amdgcn_permlane32_swap(a1, b1, false, false); \
    u32x4 w = {r0[0], r1[0], r0[1], r1[1]}; OUT = *reinterpret_cast<bf16x8*>(&w); } while (0)
  PK4(p0, 0, pa0); PK4(p0, 8, pa1); PK4(p1, 0, pa2); PK4(p1, 8, pa3);
}
__device__ __forceinline__ int v_st(int k, int c) { const int kk = (k & ~0xC) | ((k & 4) << 1) | ((k & 8) >> 1); return ((kk >> 3) * 4 + (c >> 5)) * 512 + ((kk & 7) * 32 + (c & 31)) * 2; }
__device__ __forceinline__ int v_rd_base(int lane) { return ((lane & 3) << 3) | (((lane >> 2) & 3) << 6) | (((lane >> 4) & 1) << 5) | (((lane >> 5) & 1) << 8); }
constexpr int v_rd_off(int d0, int ks, int half) { return d0 * 512 + ks * 4096 + half * 2048; }
template <int OFF> __device__ __forceinline__ s16x4 tr_read(int vb) {
  s16x4 r; asm volatile("ds_read_b64_tr_b16 %0, %1 offset:%2" : "=&v"(r) : "v"(vb), "i"(OFF) : "memory"); return r;
}
template <int D0> __device__ __forceinline__ void pv_one(f32x16& od, int vb, bf16x8 pa0, bf16x8 pa1, bf16x8 pa2, bf16x8 pa3) {
  const s16x4 l0 = tr_read<v_rd_off(D0, 0, 0)>(vb), h0 = tr_read<v_rd_off(D0, 0, 1)>(vb), l1 = tr_read<v_rd_off(D0, 1, 0)>(vb), h1 = tr_read<v_rd_off(D0, 1, 1)>(vb);
  const s16x4 l2 = tr_read<v_rd_off(D0, 2, 0)>(vb), h2 = tr_read<v_rd_off(D0, 2, 1)>(vb), l3 = tr_read<v_rd_off(D0, 3, 0)>(vb), h3 = tr_read<v_rd_off(D0, 3, 1)>(vb);
  asm volatile("s_waitcnt lgkmcnt(0)" ::: "memory"); ASBAR();
#define PKV(L, H) (bf16x8){L[0], L[1], L[2], L[3], H[0], H[1], H[2], H[3]}
  od = __builtin_amdgcn_mfma_f32_32x32x16_bf16(pa0, PKV(l0, h0), od, 0, 0, 0);
  od = __builtin_amdgcn_mfma_f32_32x32x16_bf16(pa1, PKV(l1, h1), od, 0, 0, 0);
  od = __builtin_amdgcn_mfma_f32_32x32x16_bf16(pa2, PKV(l2, h2), od, 0, 0, 0);
  od = __builtin_amdgcn_mfma_f32_32x32x16_bf16(pa3, PKV(l3, h3), od, 0, 0, 0);
#undef PKV
}
__device__ __forceinline__ void pv_d0(f32x16* o, int vb, bf16x8 pa0, bf16x8 pa1, bf16x8 pa2, bf16x8 pa3) {
  pv_one<0>(o[0], vb, pa0, pa1, pa2, pa3); pv_one<1>(o[1], vb, pa0, pa1, pa2, pa3); pv_one<2>(o[2], vb, pa0, pa1, pa2, pa3); pv_one<3>(o[3], vb, pa0, pa1, pa2, pa3);
}
template <int NROPE> __device__ __forceinline__ void qkt(f32x16& p0, f32x16& p1, const char* Kn, const char* Kr, const bf16x8* qr, const char* qrl, int r32, int hi) {
  p0 = f32x16{}; p1 = f32x16{};
#pragma unroll
  for (int d0 = 0; d0 < 8; ++d0) { const int cb = (d0 * 16 + hi * 8) * 2;
    const bf16x8 b0 = *reinterpret_cast<const bf16x8*>(Kn + KSWZ(r32, cb));
    const bf16x8 b1 = *reinterpret_cast<const bf16x8*>(Kn + KSWZ(32 + r32, cb));
    p0 = __builtin_amdgcn_mfma_f32_32x32x16_bf16(b0, qr[d0], p0, 0, 0, 0);
    p1 = __builtin_amdgcn_mfma_f32_32x32x16_bf16(b1, qr[d0], p1, 0, 0, 0); }
#pragma unroll
  for (int d0 = 0; d0 < NROPE; ++d0) { const int ch = d0 * 2 + hi;
    const bf16x8 b0 = *reinterpret_cast<const bf16x8*>(Kr + KRSWZ(r32, ch));
    const bf16x8 b1 = *reinterpret_cast<const bf16x8*>(Kr + KRSWZ(32 + r32, ch));
    const bf16x8 qf = *reinterpret_cast<const bf16x8*>(qrl + d0 * 1024);
    p0 = __builtin_amdgcn_mfma_f32_32x32x16_bf16(b0, qf, p0, 0, 0, 0);
    p1 = __builtin_amdgcn_mfma_f32_32x32x16_bf16(b1, qf, p1, 0, 0, 0); }
}

__device__ __forceinline__ void mla_unit(int b, int h, int qb, const bf16_t* __restrict__ Q, const bf16_t* __restrict__ KN, const bf16_t* __restrict__ KR, const bf16_t* __restrict__ VM, unsigned char* __restrict__ O, float oscale, char* lds) {
  int tid_ = threadIdx.x; asm volatile("" : "+v"(tid_));
  const int tid = tid_, wid = tid >> 6, lane = tid & 63, r32 = lane & 31, hi = lane >> 5;
  char* V_lds = lds + OFF_V; char* Kn_lds = lds + OFF_KN; char* Kr_lds = lds + OFF_KR;
  float* ws = (float*)(lds + OFF_WS) + wid * 64; float* li_l = ws; float* al_l = ws + 32;
  float m_reg = -1e30f, l_reg = 0; f32x16 o[4] = {}; bf16x8 qr[8];
  char* qrl = lds + OFF_QR + wid * 4096 + (hi * 32 + r32) * 16;
  const long rowbase = (long)b * SEQ;
  const bf16_t* Qw = Q + (rowbase + qb * 256 + wid * QBLK + r32) * 3072 + h * 192 + hi * 8;
#pragma unroll
  for (int d0 = 0; d0 < 8; ++d0) qr[d0] = ld8(Qw + d0 * 16);
  const bf16_t* Kh = KN + rowbase * 2048 + h * 128; const bf16_t* Vh = VM + rowbase * 2048 + h * 128; const bf16_t* Krb = KR + rowbase * 64;
  const int sr = tid >> 4, sc = (tid & 15) * 8, vst0 = v_st(sr, sc), vst1 = v_st(32 + sr, sc);
  const int krr = tid >> 3, krc = tid & 7;
  const int vb0 = (int)(uintptr_t)V_lds + v_rd_base(lane);
  struct { bf16x8 vs0, vs1, ks0, ks1, kr0; } sr_[1];
#define SLOAD(i, k0) do { sr_[i].vs0 = ld8(&Vh[(long)((k0) + sr) * 2048 + sc]); sr_[i].vs1 = ld8(&Vh[(long)((k0) + 32 + sr) * 2048 + sc]); \
    sr_[i].ks0 = ld8(&Kh[(long)((k0) + sr) * 2048 + sc]); sr_[i].ks1 = ld8(&Kh[(long)((k0) + 32 + sr) * 2048 + sc]); sr_[i].kr0 = ld8(&Krb[(long)((k0) + krr) * 64 + krc * 8]); } while (0)
#define SWRITE(bb, i) do { *(bf16x8*)(V_lds + (bb) * SHM_V + vst0) = sr_[i].vs0; *(bf16x8*)(V_lds + (bb) * SHM_V + vst1) = sr_[i].vs1; const int kc = sc * 2; \
    *(bf16x8*)(Kn_lds + (bb) * SHM_KN + KSWZ(sr, kc)) = sr_[i].ks0; *(bf16x8*)(Kn_lds + (bb) * SHM_KN + KSWZ(32 + sr, kc)) = sr_[i].ks1; \
    *(bf16x8*)(Kr_lds + (bb) * SHM_KR + KRSWZ(krr, krc)) = sr_[i].kr0; } while (0)
#define SWAIT() asm volatile("s_waitcnt vmcnt(0)" ::: "memory")
#define RESC(a) do { if (__any((a) < 1.f)) { if (hi == 0) al_l[r32] = (a); asm volatile("s_waitcnt lgkmcnt(0)" ::: "memory"); \
    _Pragma("unroll") for (int d = 0; d < 4; ++d) _Pragma("unroll") for (int r = 0; r < 16; ++r) o[d][r] *= al_l[crow(r, hi)]; } } while (0)
  f32x16 pA0, pA1, pB0, pB1; float mnA, mnB, alA, alB; bf16x8 pa0, pa1, pa2, pa3; const int NT = SEQ / KVBLK;
  constexpr int SE = 0, SO = 0;
  __syncthreads();
#pragma unroll
  for (int d0 = 0; d0 < 4; ++d0) *(bf16x8*)(qrl + d0 * 1024) = ld8(Qw + (8 + d0) * 16);
  SLOAD(SE, 0); asm volatile("s_waitcnt vmcnt(0)" ::: "memory"); SWRITE(0, SE); __syncthreads();
  qkt<4>(pA0, pA1, Kn_lds, Kr_lds, qr, qrl, r32, hi); partialSM(pA0, pA1, m_reg, mnA, alA);
  SLOAD(SO, KVBLK);
  SWAIT(); SWRITE(1, SO); __syncthreads();
  for (int j = 1; j + 1 < NT; j += 2) {
    ASBAR(); qkt<4>(pB0, pB1, Kn_lds + SHM_KN, Kr_lds + SHM_KR, qr, qrl, r32, hi);
    finishSM(pA0, pA1, alA, l_reg, pa0, pa1, pa2, pa3); ASBAR();
    SLOAD(SE, (j + 1) * KVBLK); ASBAR();
    pv_d0(o, vb0, pa0, pa1, pa2, pa3); partialSM(pB0, pB1, m_reg, mnB, alB);
    __syncthreads(); SWAIT(); SWRITE(0, SE);
    RESC(alB); __syncthreads();
    ASBAR(); qkt<4>(pA0, pA1, Kn_lds, Kr_lds, qr, qrl, r32, hi);
    finishSM(pB0, pB1, alB, l_reg, pa0, pa1, pa2, pa3); ASBAR();
    SLOAD(SO, (j + 2) * KVBLK); ASBAR();
    pv_d0(o, vb0 + SHM_V, pa0, pa1, pa2, pa3); partialSM(pA0, pA1, m_reg, mnA, alA);
    __syncthreads(); SWAIT(); SWRITE(1, SO);
    RESC(alA); __syncthreads();
  }
  ASBAR(); qkt<4>(pB0, pB1, Kn_lds + SHM_KN, Kr_lds + SHM_KR, qr, qrl, r32, hi);
  finishSM(pA0, pA1, alA, l_reg, pa0, pa1, pa2, pa3); ASBAR();
  pv_d0(o, vb0, pa0, pa1, pa2, pa3); partialSM(pB0, pB1, m_reg, mnB, alB);
  __syncthreads(); RESC(alB);
  finishSM(pB0, pB1, alB, l_reg, pa0, pa1, pa2, pa3); ASBAR();
  pv_d0(o, vb0 + SHM_V, pa0, pa1, pa2, pa3);
  if (hi == 0) li_l[r32] = l_reg; asm volatile("s_waitcnt lgkmcnt(0)" ::: "memory");
  float rli[16];
#pragma unroll
  for (int r = 0; r < 16; ++r) rli[r] = __builtin_amdgcn_rcpf(li_l[crow(r, hi)]) * oscale;
  unsigned char* Ow = O + (rowbase + qb * 256 + wid * QBLK) * 2048 + h * 128;
#pragma unroll
  for (int r = 0; r < 16; ++r) { const int orow = crow(r, hi);
#pragma unroll
    for (int d0 = 0; d0 < 4; ++d0) Ow[(long)orow * 2048 + d0 * 32 + r32] = (unsigned char)(__builtin_amdgcn_cvt_pk_fp8_f32(o[d0][r] * rli[r], 0.f, 0, false) & 0xff); }
#undef SLOAD
#undef SWRITE
#undef SWAIT
#undef RESC
}

__device__ __forceinline__ void na_unit(int b, int h, int rg, const bf16_t* __restrict__ Q, const bf16_t* __restrict__ K, const bf16_t* __restrict__ V, const float* __restrict__ rpb, unsigned char* __restrict__ O, float oscale, char* lds) {
  int tid_ = threadIdx.x; asm volatile("" : "+v"(tid_));
  const int tid = tid_, wid = tid >> 6, lane = tid & 63, r32 = lane & 31, hi = lane >> 5;
  char* V_lds = lds + OFF_V; char* Kn_lds = lds + OFF_KN;
  float* ws = (float*)(lds + OFF_WS) + wid * 64; float* li_l = ws; float* al_l = ws + 32;
  float* bias_l = (float*)(lds + OFF_BIAS);
  const int r0 = rg * 4, rq = r0 + (wid >> 1), cq = 32 * (wid & 1) + r32;
  const int rs_w = min(max(rq - 4, 0), 120), cs = min(max(cq - 8, 0), 48);
  const int kr_lo = min(max(r0 - 4, 0), 120), kr_hi = min(max(r0 + 3 - 4, 0), 120) + 7, NT = kr_hi - kr_lo + 1;
  const long rowbase = (long)b * SEQ;
  float m_reg = -1e30f, l_reg = 0; f32x16 o[4] = {}; bf16x8 qr[8];
  const bf16_t* Qw = Q + (rowbase + rq * 64 + cq) * 2048 + h * 128 + hi * 8;
#pragma unroll
  for (int d0 = 0; d0 < 8; ++d0) qr[d0] = ld8(Qw + d0 * 16);
  const bf16_t* Kh = K + rowbase * 2048 + h * 128; const bf16_t* Vh = V + rowbase * 2048 + h * 128;
  const int sr = tid >> 4, sc = (tid & 15) * 8, vst0 = v_st(sr, sc), vst1 = v_st(32 + sr, sc);
  const int vb0 = (int)(uintptr_t)V_lds + v_rd_base(lane);
  __syncthreads();
  if (tid < 465) bias_l[tid] = rpb[h * 465 + tid] * 1.4426950408889634f;
  bf16x8 vs0, vs1, ks0, ks1;
#define NLOAD(k0) do { vs0 = ld8(&Vh[(long)((k0) + sr) * 2048 + sc]); vs1 = ld8(&Vh[(long)((k0) + 32 + sr) * 2048 + sc]); \
    ks0 = ld8(&Kh[(long)((k0) + sr) * 2048 + sc]); ks1 = ld8(&Kh[(long)((k0) + 32 + sr) * 2048 + sc]); } while (0)
#define NWRITE(bb) do { *(bf16x8*)(V_lds + (bb) * SHM_V + vst0) = vs0; *(bf16x8*)(V_lds + (bb) * SHM_V + vst1) = vs1; const int kc = sc * 2; \
    *(bf16x8*)(Kn_lds + (bb) * SHM_KN + KSWZ(sr, kc)) = ks0; *(bf16x8*)(Kn_lds + (bb) * SHM_KN + KSWZ(32 + sr, kc)) = ks1; } while (0)
  NLOAD(kr_lo * 64);
  for (int i = 0; i < NT; ++i) {
    const int kr = kr_lo + i, bb = i & 1;
    NWRITE(bb);
    if (i + 1 < NT) NLOAD((kr + 1) * 64);
    __syncthreads();
    if (kr >= rs_w && kr < rs_w + 8) {
      f32x16 p0, p1;
      qkt<0>(p0, p1, Kn_lds + bb * SHM_KN, nullptr, qr, nullptr, r32, hi);
      const float* brow = bias_l + (kr - rq + 7) * 31 + 15 - cq;
      float pmax = -1e30f;
#pragma unroll
      for (int r = 0; r < 16; ++r) { const int k0 = crow(r, hi), k1 = 32 + k0;
        const bool v0 = (k0 >= cs) && (k0 < cs + 16), v1 = (k1 >= cs) && (k1 < cs + 16);
        const float b0 = brow[v0 ? k0 : cq], b1 = brow[v1 ? k1 : cq];
        p0[r] = v0 ? p0[r] + b0 : -1e30f; p1[r] = v1 ? p1[r] + b1 : -1e30f;
        pmax = fmaxf(pmax, fmaxf(p0[r], p1[r])); }
      { auto rr = __builtin_amdgcn_permlane32_swap(__float_as_uint(pmax), __float_as_uint(pmax), false, false);
        pmax = fmaxf(__uint_as_float(rr[0]), __uint_as_float(rr[1])); }
      const float mn = fmaxf(m_reg, pmax), alpha = __builtin_amdgcn_exp2f(m_reg - mn); m_reg = mn;
#pragma unroll
      for (int r = 0; r < 16; ++r) { p0[r] = __builtin_amdgcn_exp2f(p0[r] - mn); p1[r] = __builtin_amdgcn_exp2f(p1[r] - mn); }
      float ps = 0;
#pragma unroll
      for (int r = 0; r < 16; ++r) ps += p0[r] + p1[r];
      { auto rr = __builtin_amdgcn_permlane32_swap(__float_as_uint(ps), __float_as_uint(ps), false, false);
        ps = __uint_as_float(rr[0]) + __uint_as_float(rr[1]); }
      l_reg = l_reg * alpha + ps;
      if (hi == 0) al_l[r32] = alpha; asm volatile("s_waitcnt lgkmcnt(0)" ::: "memory");
#pragma unroll
      for (int d = 0; d < 4; ++d)
#pragma unroll
        for (int r = 0; r < 16; ++r) o[d][r] *= al_l[crow(r, hi)];
      bf16x8 pa0, pa1, pa2, pa3;
      PK4(p0, 0, pa0); PK4(p0, 8, pa1); PK4(p1, 0, pa2); PK4(p1, 8, pa3);
      pv_d0(o, vb0 + bb * SHM_V, pa0, pa1, pa2, pa3);
    }
  }
  if (hi == 0) li_l[r32] = l_reg; asm volatile("s_waitcnt lgkmcnt(0)" ::: "memory");
  float rli[16];
#pragma unroll
  for (int r = 0; r < 16; ++r) rli[r] = __builtin_amdgcn_rcpf(li_l[crow(r, hi)]) * oscale;
  unsigned char* Ow = O + (rowbase + rq * 64 + 32 * (wid & 1)) * 2048 + h * 128;
#pragma unroll
  for (int r = 0; r < 16; ++r) { const int orow = crow(r, hi);
#pragma unroll
    for (int d0 = 0; d0 < 4; ++d0) Ow[(long)orow * 2048 + d0 * 32 + r32] = (unsigned char)(__builtin_amdgcn_cvt_pk_fp8_f32(o[d0][r] * rli[r], 0.f, 0, false) & 0xff); }
#undef NLOAD
#undef NWRITE
}
#undef PK4
}

namespace peer {
#define PLAS __attribute__((address_space(3)))
using bf16x8 = __attribute__((ext_vector_type(8))) short;
using bf16x2 = __attribute__((ext_vector_type(2))) __bf16;
using f32x16 = __attribute__((ext_vector_type(16))) float;
using f32x4  = __attribute__((ext_vector_type(4))) float;
using u32x4  = __attribute__((ext_vector_type(4))) unsigned;
typedef unsigned short bf16_t;
__device__ __forceinline__ int f2ord(float f) { const int u = __float_as_int(f); return u ^ ((u >> 31) & 0x7fffffff); }
__device__ __forceinline__ float ord2f(int s) { return __int_as_float(s ^ ((s >> 31) & 0x7fffffff)); }
__device__ __forceinline__ int crow(int r, int hi) { return (r & 3) + 8 * (r >> 2) + 4 * hi; }
__device__ __forceinline__ unsigned cvtpk(float lo, float hi) { unsigned r; asm volatile("v_cvt_pk_bf16_f32 %0, %1, %2" : "=v"(r) : "v"(lo), "v"(hi)); return r; }
__device__ __forceinline__ float bf_lo(unsigned w) { return __uint_as_float(w << 16); }
__device__ __forceinline__ float bf_hi(unsigned w) { return __uint_as_float(w & 0xffff0000u); }
__device__ __forceinline__ int swapmax(int m) { auto rr = __builtin_amdgcn_permlane32_swap((unsigned)m, (unsigned)m, false, false); const int a = (int)rr[0], b = (int)rr[1]; return a > b ? a : b; }

struct CandTab { int ci[50], cj[50]; };
constexpr CandTab make_cands() { CandTab t{}; int n = 0; for (int i = 0; i < 16; ++i) for (int j = 0; j < 16; ++j) if ((i + 1) * (j + 1) <= 16) { t.ci[n] = i; t.cj[n] = j; ++n; } return t; }
constexpr CandTab CT = make_cands();

constexpr int SEL_LDS_PER_WAVE = (2 * 16 + 16) * 64 * 4;

__device__ __forceinline__ void select32(int t0, int h, const float* __restrict__ QP, const bf16_t* __restrict__ SUBH, const bf16_t* __restrict__ SUBL, int* __restrict__ IDX, float* __restrict__ GATE, PLAS int* wl, int lane_) {
  int lane = lane_; asm volatile("" : "+v"(lane));
  const int r32 = lane & 31, hi = lane >> 5;
  PLAS int* topl = wl; PLAS int* winl = wl + 2 * 16 * 64;
  const float* qrow = QP + (size_t)(t0 + r32) * 2048;
  {
#pragma unroll 1
    for (int p = 0; p < 2; ++p) {
      bf16x8 qh[8], ql[8];
      const float* qp = qrow + h * 256 + p * 128 + hi * 8;
#pragma unroll
      for (int d0 = 0; d0 < 8; ++d0) {
        const f32x4 a = *(const f32x4*)(qp + d0 * 16), b = *(const f32x4*)(qp + d0 * 16 + 4);
        u32x4 wh, wlw;
        wh.x = cvtpk(a[0], a[1]); wh.y = cvtpk(a[2], a[3]); wh.z = cvtpk(b[0], b[1]); wh.w = cvtpk(b[2], b[3]);
        wlw.x = cvtpk(a[0] - bf_lo(wh.x), a[1] - bf_hi(wh.x)); wlw.y = cvtpk(a[2] - bf_lo(wh.y), a[3] - bf_hi(wh.y));
        wlw.z = cvtpk(b[0] - bf_lo(wh.z), b[1] - bf_hi(wh.z)); wlw.w = cvtpk(b[2] - bf_lo(wh.w), b[3] - bf_hi(wh.w));
        qh[d0] = *reinterpret_cast<bf16x8*>(&wh); ql[d0] = *reinterpret_cast<bf16x8*>(&wlw);
      }
      const size_t soff = ((size_t)(h * 2 + p) * 128 + r32) * 128 + hi * 8;
      int key[64];
#pragma unroll
      for (int kb = 0; kb < 4; ++kb) {
        f32x16 acc = f32x16{};
#pragma unroll
        for (int d0 = 0; d0 < 8; ++d0) {
          const bf16x8 ah = *reinterpret_cast<const bf16x8*>(SUBH + soff + (size_t)kb * 32 * 128 + d0 * 16);
          const bf16x8 al = *reinterpret_cast<const bf16x8*>(SUBL + soff + (size_t)kb * 32 * 128 + d0 * 16);
          acc = __builtin_amdgcn_mfma_f32_32x32x16_bf16(ah, qh[d0], acc, 0, 0, 0);
          acc = __builtin_amdgcn_mfma_f32_32x32x16_bf16(ah, ql[d0], acc, 0, 0, 0);
          acc = __builtin_amdgcn_mfma_f32_32x32x16_bf16(al, qh[d0], acc, 0, 0, 0);
        }
#pragma unroll
        for (int r = 0; r < 16; ++r) key[kb * 16 + r] = (f2ord(acc[r]) & ~127) | (kb * 32 + crow(r, hi));
      }
#pragma unroll 1
      for (int it = 0; it < 16; ++it) {
        int m = key[0];
#pragma unroll
        for (int i = 1; i < 64; ++i) m = key[i] > m ? key[i] : m;
        const int gm = swapmax(m);
        topl[(p * 16 + it) * 64 + lane] = gm;
#pragma unroll
        for (int i = 0; i < 64; ++i) key[i] = (key[i] == gm) ? (int)0x80000000 : key[i];
      }
    }
    int ck[25];
#pragma unroll
    for (int c = 0; c < 25; ++c) {
      const int i = hi ? CT.ci[2 * c + 1] : CT.ci[2 * c], j = hi ? CT.cj[2 * c + 1] : CT.cj[2 * c];
      const int k0 = topl[i * 64 + lane], k1 = topl[(16 + j) * 64 + lane];
      const float s = ord2f(k0 & ~127) + ord2f(k1 & ~127);
      ck[c] = (f2ord(s) & ~255) | (i << 4) | j;
    }
#pragma unroll 1
    for (int it = 0; it < 16; ++it) {
      int m = ck[0];
#pragma unroll
      for (int i = 1; i < 25; ++i) m = ck[i] > m ? ck[i] : m;
      const int gm = swapmax(m);
      winl[it * 64 + lane] = gm;
#pragma unroll
      for (int i = 0; i < 25; ++i) ck[i] = (ck[i] == gm) ? (int)0x80000000 : ck[i];
    }
    float e[16]; int wv[16]; float tot = 0.f;
    const float s0 = ord2f(winl[lane] & ~255);
#pragma unroll
    for (int k = 0; k < 16; ++k) { wv[k] = winl[k * 64 + lane]; e[k] = __builtin_amdgcn_exp2f((ord2f(wv[k] & ~255) - s0) * 1.4426950408889634f); tot += e[k]; }
    const float rtot = 1.0f / tot;
    int l2_ = lane_; asm volatile("" : "+v"(l2_));
    const size_t ob = (size_t)(t0 + (l2_ & 31)) * 128 + h * 16 + (l2_ >> 5) * 8;
#pragma unroll
    for (int k = 0; k < 8; ++k) {
      const int w = hi ? wv[8 + k] : wv[k]; const float ev = hi ? e[8 + k] : e[k];
      const int i = (w >> 4) & 15, j = w & 15;
      const int e0 = topl[i * 64 + lane] & 127, e1 = topl[(16 + j) * 64 + lane] & 127;
      IDX[ob + k] = e0 * 128 + e1; GATE[ob + k] = ev * rtot;
    }
  }
}

__device__ __forceinline__ float dot2(unsigned w, unsigned x, float acc) { return __builtin_amdgcn_fdot2_f32_bf16(__builtin_bit_cast(bf16x2, w), __builtin_bit_cast(bf16x2, x), acc, false); }
__device__ __forceinline__ float gelu_erf(float v) {
  const float av = fabsf(v), d = av * 0.2316418882f + 1.0f, t = __builtin_amdgcn_rcpf(d);
  float q = t * 0.5307027145f + (-0.7265760135f); q = q * t + 0.7107068705f; q = q * t + (-0.142248368f); q = q * t + 0.127414796f; q = q * t;
  const float e = __builtin_amdgcn_exp2f((v * v) * (-0.72134752044f));
  const float m = v * (q * e);
  return v < 0.f ? m : v - m;
}
__device__ __forceinline__ float wave_sum(float v) {
#pragma unroll
  for (int o = 1; o < 64; o <<= 1) v += __shfl_xor(v, o);
  return v;
}

typedef float f32x2 __attribute__((ext_vector_type(2)));
constexpr float USCALE = 64.0f, VSCALE = 4.0f;
__device__ __forceinline__ f32x2 fp8x2(unsigned w, bool hiword) { return hiword ? __builtin_amdgcn_cvt_pk_f32_fp8((int)w, true) : __builtin_amdgcn_cvt_pk_f32_fp8((int)w, false); }
template <bool STORE, bool FAKE = false> __device__ __forceinline__ void expert_token(int t, const bf16_t* __restrict__ H2, const unsigned char* __restrict__ U8, const unsigned char* __restrict__ V8, const int* __restrict__ IDX, const float* __restrict__ GATE,
                                             float* X1OUT, const float* __restrict__ fnorm, int lane_) {
  int lane = lane_; asm volatile("" : "+v"(lane));
  f32x2 hf[4][8];
  { const u32x4* hp = (const u32x4*)(H2 + (size_t)t * 4096) + 2 * lane;
#pragma unroll
    for (int k = 0; k < 4; ++k) { const u32x4 a = hp[128 * k], b = hp[128 * k + 1];
      hf[k][0] = (f32x2){bf_lo(a.x), bf_hi(a.x)}; hf[k][1] = (f32x2){bf_lo(a.y), bf_hi(a.y)}; hf[k][2] = (f32x2){bf_lo(a.z), bf_hi(a.z)}; hf[k][3] = (f32x2){bf_lo(a.w), bf_hi(a.w)};
      hf[k][4] = (f32x2){bf_lo(b.x), bf_hi(b.x)}; hf[k][5] = (f32x2){bf_lo(b.y), bf_hi(b.y)}; hf[k][6] = (f32x2){bf_lo(b.z), bf_hi(b.z)}; hf[k][7] = (f32x2){bf_lo(b.w), bf_hi(b.w)}; } }
  const int e0 = FAKE ? lane : IDX[(size_t)t * 128 + lane], e1 = FAKE ? lane + 64 : IDX[(size_t)t * 128 + 64 + lane];
  const float g0 = GATE[(size_t)t * 128 + lane], g1 = GATE[(size_t)t * 128 + 64 + lane];
  float c0 = 0.f, c1 = 0.f;
  u32x4 r0[4], r1[4], r2[4], r3[4];
#define ELOAD(dst, jj) do { const int jx_ = (jj); if (jx_ < 256) { const int sl_ = jx_ & 127; const int e_ = __builtin_amdgcn_readlane(sl_ < 64 ? e0 : e1, sl_ & 63); \
    const u32x4* rp_ = (const u32x4*)((jx_ < 128 ? U8 : V8) + (size_t)e_ * 4096) + lane; _Pragma("unroll") for (int k = 0; k < 4; ++k) dst[k] = rp_[64 * k]; } \
    asm volatile("" ::: "memory"); __builtin_amdgcn_sched_barrier(0); } while (0)
#define UDOT(R, OUT) do { f32x2 a0_ = {0.f, 0.f}, a1_ = {0.f, 0.f}, a2_ = {0.f, 0.f}, a3_ = {0.f, 0.f}; \
    _Pragma("unroll") for (int k = 0; k < 4; ++k) { \
      a0_ += fp8x2(R[k].x, false) * hf[k][0]; a1_ += fp8x2(R[k].x, true) * hf[k][1]; a2_ += fp8x2(R[k].y, false) * hf[k][2]; a3_ += fp8x2(R[k].y, true) * hf[k][3]; \
      a0_ += fp8x2(R[k].z, false) * hf[k][4]; a1_ += fp8x2(R[k].z, true) * hf[k][5]; a2_ += fp8x2(R[k].w, false) * hf[k][6]; a3_ += fp8x2(R[k].w, true) * hf[k][7]; } \
    a0_ += a1_; a2_ += a3_; a0_ += a2_; OUT = a0_.x + a0_.y; } while (0)
  ELOAD(r0, 0); ELOAD(r1, 1); ELOAD(r2, 2); ELOAD(r3, 3);
#pragma unroll 1
  for (int g = 0; g < 16; ++g) {
    float p[8];
    const int j = g * 8;
    UDOT(r0, p[0]); ELOAD(r0, j + 4); UDOT(r1, p[1]); ELOAD(r1, j + 5); UDOT(r2, p[2]); ELOAD(r2, j + 6); UDOT(r3, p[3]); ELOAD(r3, j + 7);
    UDOT(r0, p[4]); ELOAD(r0, j + 8); UDOT(r1, p[5]); ELOAD(r1, j + 9); UDOT(r2, p[6]); ELOAD(r2, j + 10); UDOT(r3, p[7]); ELOAD(r3, j + 11);
    float q4[4], q2[2], q1;
    { const bool up = (lane & 32) != 0;
#pragma unroll
      for (int i = 0; i < 4; ++i) { const float send = up ? p[i] : p[4 + i], keep = up ? p[4 + i] : p[i]; q4[i] = keep + __shfl_xor(send, 32); } }
    { const bool up = (lane & 16) != 0;
#pragma unroll
      for (int i = 0; i < 2; ++i) { const float send = up ? q4[i] : q4[2 + i], keep = up ? q4[2 + i] : q4[i]; q2[i] = keep + __shfl_xor(send, 16); } }
    { const bool up = (lane & 8) != 0; const float send = up ? q2[0] : q2[1], keep = up ? q2[1] : q2[0]; q1 = keep + __shfl_xor(send, 8); }
    q1 += __shfl_xor(q1, 4); q1 += __shfl_xor(q1, 2); q1 += __shfl_xor(q1, 1);
    const float got = __shfl(q1, 8 * (lane & 7));
    if ((lane >> 3) == (g & 7)) { if (g < 8) c0 = got; else c1 = got; }
  }
#undef UDOT
  c0 = g0 * gelu_erf(c0 * (1.0f / USCALE)) * (1.0f / VSCALE); c1 = g1 * gelu_erf(c1 * (1.0f / USCALE)) * (1.0f / VSCALE);
  f32x2 acc[4][8];
#pragma unroll
  for (int k = 0; k < 4; ++k)
#pragma unroll
    for (int i = 0; i < 8; ++i) acc[k][i] = (f32x2){0.f, 0.f};
#define VROW(R, C) do { const f32x2 cc_ = {(C), (C)}; _Pragma("unroll") for (int k = 0; k < 4; ++k) { \
      acc[k][0] += cc_ * fp8x2(R[k].x, false); acc[k][1] += cc_ * fp8x2(R[k].x, true); acc[k][2] += cc_ * fp8x2(R[k].y, false); acc[k][3] += cc_ * fp8x2(R[k].y, true); \
      acc[k][4] += cc_ * fp8x2(R[k].z, false); acc[k][5] += cc_ * fp8x2(R[k].z, true); acc[k][6] += cc_ * fp8x2(R[k].w, false); acc[k][7] += cc_ * fp8x2(R[k].w, true); } } while (0)
#define CJ(j) __int_as_float(__builtin_amdgcn_readlane(__float_as_int((j) < 64 ? c0 : c1), (j) & 63))
#pragma unroll 1
  for (int j = 0; j < 128; j += 4) {
    { const float c = CJ(j); VROW(r0, c); __builtin_amdgcn_sched_barrier(0); ELOAD(r0, 128 + j + 4); }
    { const float c = CJ(j + 1); VROW(r1, c); __builtin_amdgcn_sched_barrier(0); ELOAD(r1, 128 + j + 5); }
    { const float c = CJ(j + 2); VROW(r2, c); __builtin_amdgcn_sched_barrier(0); ELOAD(r2, 128 + j + 6); }
    { const float c = CJ(j + 3); VROW(r3, c); __builtin_amdgcn_sched_barrier(0); ELOAD(r3, 128 + j + 7); }
  }
#undef VROW
#undef CJ
#undef ELOAD
  int xo_ = 16 * lane; asm volatile("" : "+v"(xo_));
  float* xr = X1OUT + (size_t)t * 4096 + xo_; float ss = 0.f;
#ifdef PROBE_PEER_SCALE
#pragma unroll
  for (int k = 0; k < 4; ++k)
#pragma unroll
    for (int i = 0; i < 8; ++i) acc[k][i] *= PROBE_PEER_SCALE;
#endif
#pragma unroll
  for (int k = 0; k < 4; ++k)
#pragma unroll
    for (int q = 0; q < 4; ++q) { const f32x4 a = *(const f32x4*)(xr + 1024 * k + 4 * q);
      acc[k][2 * q] += (f32x2){a[0], a[1]}; acc[k][2 * q + 1] += (f32x2){a[2], a[3]};
      ss += acc[k][2 * q].x * acc[k][2 * q].x + acc[k][2 * q].y * acc[k][2 * q].y + acc[k][2 * q + 1].x * acc[k][2 * q + 1].x + acc[k][2 * q + 1].y * acc[k][2 * q + 1].y; }
  const float rstd = 1.0f / sqrtf(wave_sum(ss) * (1.0f / 4096.0f) + 1e-6f);
  const float* fn = fnorm + xo_;
#pragma unroll
  for (int k = 0; k < 4; ++k)
#pragma unroll
    for (int q = 0; q < 4; ++q) { const f32x4 g = *(const f32x4*)(fn + 1024 * k + 4 * q);
      f32x4 o; o[0] = acc[k][2 * q].x * rstd * g[0]; o[1] = acc[k][2 * q].y * rstd * g[1]; o[2] = acc[k][2 * q + 1].x * rstd * g[2]; o[3] = acc[k][2 * q + 1].y * rstd * g[3];
      if constexpr (STORE) { *(f32x4*)(xr + 1024 * k + 4 * q) = o; } else { asm volatile("" :: "v"(o)); } }
}
typedef unsigned v6u __attribute__((ext_vector_type(6)));
typedef float v32f __attribute__((ext_vector_type(32)));
typedef __bf16 v32bf __attribute__((ext_vector_type(32)));
typedef unsigned v16u __attribute__((ext_vector_type(16)));
constexpr float U6SCALE = 128.0f, V6SCALE = 4.0f;
constexpr int ROW6 = 3072;
__device__ __forceinline__ unsigned f32_to_e2m3(float x) {
  const unsigned sgn = (__float_as_uint(x) >> 26) & 32u; float a = fminf(fabsf(x), 7.5f);
  unsigned code;
  if (a < 1.0f) { code = (unsigned)__builtin_rintf(a * 8.0f); }
  else { unsigned u = __float_as_uint(a); u += 0x7FFFFu + ((u >> 20) & 1u); const unsigned e = (u >> 23) - 127u, m = (u >> 20) & 7u; code = ((e + 1u) << 3) | m; code = code > 31u ? 31u : code; }
  return code | sgn;
}
__device__ __forceinline__ void pack_row_fp6(const float* __restrict__ src, unsigned char* __restrict__ dst, float scale, int lane) {
  const f32x4* sp = (const f32x4*)(src + 64 * lane);
  unsigned w[12];
#pragma unroll
  for (int i = 0; i < 12; ++i) w[i] = 0u;
#pragma unroll
  for (int q = 0; q < 16; ++q) { const f32x4 v = sp[q] * scale;
#pragma unroll
    for (int j = 0; j < 4; ++j) { const int el = 4 * q + j, g = el >> 5, i = el & 31, pos = 6 * i, d = 6 * g + (pos >> 5), sh = pos & 31;
      const unsigned c = f32_to_e2m3(v[j]); w[d] |= c << sh; if (sh > 26) w[d + 1] |= c >> (32 - sh); } }
#pragma unroll
  for (int k = 0; k < 3; ++k) *(u32x4*)(dst + 1024 * k + 16 * lane) = (u32x4){w[4 * k], w[4 * k + 1], w[4 * k + 2], w[4 * k + 3]};
}
template <bool STORE> __device__ __forceinline__ void expert_tokens6(int t_first, int t_step, int t_end, const bf16_t* __restrict__ H2, const unsigned char* __restrict__ U6, const unsigned char* __restrict__ V6,
                                             const int* __restrict__ IDX, const float* __restrict__ GATE, float* X1OUT, const float* __restrict__ fnorm, int lane_) {
  int lane = lane_; asm volatile("" : "+v"(lane));
  int t = t_first; if (t >= t_end) return;
  const unsigned lo16 = (unsigned)lane * 16u;
  int e0 = IDX[(size_t)t * 128 + lane], e1 = IDX[(size_t)t * 128 + 64 + lane];
  u32x4 r0[3], r1[3], r2[3], r3[3];
#define ELOAD(dst, jj, EA, EB, TAB) do { const int sl_ = (jj) & 127; const int e_ = __builtin_amdgcn_readlane(sl_ < 64 ? (EA) : (EB), sl_ & 63); \
    const unsigned char* rb_ = (TAB) + (size_t)(unsigned)e_ * ROW6; _Pragma("unroll") for (int k = 0; k < 3; ++k) dst[k] = *(const u32x4*)(rb_ + (lo16 + 1024u * k)); \
    asm volatile("" ::: "memory"); __builtin_amdgcn_sched_barrier(0); } while (0)
#define GRPA(R) ((v6u){R[0].x, R[0].y, R[0].z, R[0].w, R[1].x, R[1].y})
#define GRPB(R) ((v6u){R[1].z, R[1].w, R[2].x, R[2].y, R[2].z, R[2].w})
  ELOAD(r0, 0, e0, e1, U6); ELOAD(r1, 1, e0, e1, U6); ELOAD(r2, 2, e0, e1, U6); ELOAD(r3, 3, e0, e1, U6);
#pragma unroll 1
  for (;;) {
    const int tn = t + t_step, tnx = tn < t_end ? tn : t;
    const int e0n = IDX[(size_t)tnx * 128 + lane], e1n = IDX[(size_t)tnx * 128 + 64 + lane];
    const float g0 = GATE[(size_t)t * 128 + lane], g1 = GATE[(size_t)t * 128 + 64 + lane];
    unsigned hq[32];
    { const u32x4* hp = (const u32x4*)(H2 + (size_t)t * 4096 + 64 * lane);
#pragma unroll
      for (int q = 0; q < 8; ++q) { const u32x4 a = hp[q]; hq[4 * q] = a.x; hq[4 * q + 1] = a.y; hq[4 * q + 2] = a.z; hq[4 * q + 3] = a.w; } }
    float c0 = 0.f, c1 = 0.f;
#define UDOT(R, OUT) do { float a0_ = 0.f, a1_ = 0.f, a2_ = 0.f, a3_ = 0.f; \
    asm volatile("" : "+v"(R[0].x)); \
    { const v16u b_ = __builtin_bit_cast(v16u, __builtin_amdgcn_cvt_scalef32_pk32_bf16_fp6(GRPA(R), 1.0f)); \
      _Pragma("unroll") for (int j = 0; j < 16; j += 4) { a0_ = dot2(b_[j], hq[j], a0_); a1_ = dot2(b_[j + 1], hq[j + 1], a1_); a2_ = dot2(b_[j + 2], hq[j + 2], a2_); a3_ = dot2(b_[j + 3], hq[j + 3], a3_); } } \
    asm volatile("" : "+v"(a0_), "+v"(a1_), "+v"(a2_), "+v"(a3_), "+v"(R[1].z)); \
    { const v16u b_ = __builtin_bit_cast(v16u, __builtin_amdgcn_cvt_scalef32_pk32_bf16_fp6(GRPB(R), 1.0f)); \
      _Pragma("unroll") for (int j = 0; j < 16; j += 4) { a0_ = dot2(b_[j], hq[16 + j], a0_); a1_ = dot2(b_[j + 1], hq[17 + j], a1_); a2_ = dot2(b_[j + 2], hq[18 + j], a2_); a3_ = dot2(b_[j + 3], hq[19 + j], a3_); } } \
    asm volatile("" : "+v"(a0_), "+v"(a1_), "+v"(a2_), "+v"(a3_)); \
    OUT = (a0_ + a1_) + (a2_ + a3_); } while (0)
#define RSCAT(G) do { float q4[4], q2[2], q1; \
      { const bool up = (lane & 32) != 0; _Pragma("unroll") for (int i = 0; i < 4; ++i) { const float send = up ? p[i] : p[4 + i], keep = up ? p[4 + i] : p[i]; q4[i] = keep + __shfl_xor(send, 32); } } \
      { const bool up = (lane & 16) != 0; _Pragma("unroll") for (int i = 0; i < 2; ++i) { const float send = up ? q4[i] : q4[2 + i], keep = up ? q4[2 + i] : q4[i]; q2[i] = keep + __shfl_xor(send, 16); } } \
      { const bool up = (lane & 8) != 0; const float send = up ? q2[0] : q2[1], keep = up ? q2[1] : q2[0]; q1 = keep + __shfl_xor(send, 8); } \
      q1 += __shfl_xor(q1, 4); q1 += __shfl_xor(q1, 2); q1 += __shfl_xor(q1, 1); \
      const float got = __shfl(q1, 8 * (lane & 7)); \
      if ((lane >> 3) == ((G) & 7)) { if ((G) < 8) c0 = got; else c1 = got; } } while (0)
#pragma unroll 1
    for (int g = 0; g < 15; ++g) {
      float p[8];
      const int j = g * 8;
      UDOT(r0, p[0]); ELOAD(r0, j + 4, e0, e1, U6); UDOT(r1, p[1]); ELOAD(r1, j + 5, e0, e1, U6); UDOT(r2, p[2]); ELOAD(r2, j + 6, e0, e1, U6); UDOT(r3, p[3]); ELOAD(r3, j + 7, e0, e1, U6);
      UDOT(r0, p[4]); ELOAD(r0, j + 8, e0, e1, U6); UDOT(r1, p[5]); ELOAD(r1, j + 9, e0, e1, U6); UDOT(r2, p[6]); ELOAD(r2, j + 10, e0, e1, U6); UDOT(r3, p[7]); ELOAD(r3, j + 11, e0, e1, U6);
      RSCAT(g);
    }
    { float p[8];
      UDOT(r0, p[0]); ELOAD(r0, 124, e0, e1, U6); UDOT(r1, p[1]); ELOAD(r1, 125, e0, e1, U6); UDOT(r2, p[2]); ELOAD(r2, 126, e0, e1, U6); UDOT(r3, p[3]); ELOAD(r3, 127, e0, e1, U6);
      UDOT(r0, p[4]); ELOAD(r0, 0, e0, e1, V6); UDOT(r1, p[5]); ELOAD(r1, 1, e0, e1, V6); UDOT(r2, p[6]); ELOAD(r2, 2, e0, e1, V6); UDOT(r3, p[7]); ELOAD(r3, 3, e0, e1, V6);
      RSCAT(15); }
#undef RSCAT
#undef UDOT
    c0 = g0 * gelu_erf(c0 * (1.0f / U6SCALE)) * (1.0f / V6SCALE); c1 = g1 * gelu_erf(c1 * (1.0f / U6SCALE)) * (1.0f / V6SCALE);
    float acc[64];
#pragma unroll
    for (int i = 0; i < 64; ++i) acc[i] = 0.f;
#define PIN16(B) asm volatile("" : "+v"(acc[B]), "+v"(acc[B + 1]), "+v"(acc[B + 2]), "+v"(acc[B + 3]), "+v"(acc[B + 4]), "+v"(acc[B + 5]), "+v"(acc[B + 6]), "+v"(acc[B + 7]), \
    "+v"(acc[B + 8]), "+v"(acc[B + 9]), "+v"(acc[B + 10]), "+v"(acc[B + 11]), "+v"(acc[B + 12]), "+v"(acc[B + 13]), "+v"(acc[B + 14]), "+v"(acc[B + 15]))
#define VROW(R, C) do { asm volatile("" : "+v"(R[0].x)); \
    { const v32f f_ = __builtin_amdgcn_cvt_scalef32_pk32_f32_fp6(GRPA(R), 1.0f); _Pragma("unroll") for (int i = 0; i < 32; ++i) acc[i] += (C) * f_[i]; } PIN16(0); PIN16(16); \
    asm volatile("" : "+v"(R[1].z)); \
    { const v32f f_ = __builtin_amdgcn_cvt_scalef32_pk32_f32_fp6(GRPB(R), 1.0f); _Pragma("unroll") for (int i = 0; i < 32; ++i) acc[32 + i] += (C) * f_[i]; } PIN16(32); PIN16(48); } while (0)
#define CJ(j) __int_as_float(__builtin_amdgcn_readlane(__float_as_int((j) < 64 ? c0 : c1), (j) & 63))
#pragma unroll 1
    for (int j = 0; j < 124; j += 4) {
      { const float c = CJ(j); VROW(r0, c); ELOAD(r0, j + 4, e0, e1, V6); }
      { const float c = CJ(j + 1); VROW(r1, c); ELOAD(r1, j + 5, e0, e1, V6); }
      { const float c = CJ(j + 2); VROW(r2, c); ELOAD(r2, j + 6, e0, e1, V6); }
      { const float c = CJ(j + 3); VROW(r3, c); ELOAD(r3, j + 7, e0, e1, V6); }
    }
    { const float c = CJ(124); VROW(r0, c); ELOAD(r0, 0, e0n, e1n, U6); }
    { const float c = CJ(125); VROW(r1, c); ELOAD(r1, 1, e0n, e1n, U6); }
    { const float c = CJ(126); VROW(r2, c); ELOAD(r2, 2, e0n, e1n, U6); }
    { const float c = CJ(127); VROW(r3, c); ELOAD(r3, 3, e0n, e1n, U6); }
#undef VROW
#undef PIN16
#undef CJ
    int xo_ = 64 * lane; asm volatile("" : "+v"(xo_));
    float* xr = X1OUT + (size_t)t * 4096 + xo_; float ss = 0.f;
#pragma unroll
    for (int k = 0; k < 4; ++k) {
#pragma unroll
      for (int q = 0; q < 4; ++q) { const f32x4 a = *(const f32x4*)(xr + 16 * k + 4 * q); const int b_ = 16 * k + 4 * q;
        acc[b_] += a[0]; acc[b_ + 1] += a[1]; acc[b_ + 2] += a[2]; acc[b_ + 3] += a[3];
        ss += (acc[b_] * acc[b_] + acc[b_ + 1] * acc[b_ + 1]) + (acc[b_ + 2] * acc[b_ + 2] + acc[b_ + 3] * acc[b_ + 3]); }
      asm volatile("" ::: "memory"); __builtin_amdgcn_sched_barrier(0); }
    const float rstd = 1.0f / sqrtf(wave_sum(ss) * (1.0f / 4096.0f) + 1e-6f);
    const float* fn = fnorm + xo_;
#pragma unroll
    for (int k = 0; k < 4; ++k) {
#pragma unroll
      for (int q = 0; q < 4; ++q) { const f32x4 g = *(const f32x4*)(fn + 16 * k + 4 * q); const int b_ = 16 * k + 4 * q;
        f32x4 o; o[0] = acc[b_] * rstd * g[0]; o[1] = acc[b_ + 1] * rstd * g[1]; o[2] = acc[b_ + 2] * rstd * g[2]; o[3] = acc[b_ + 3] * rstd * g[3];
        if constexpr (STORE) { *(f32x4*)(xr + 16 * k + 4 * q) = o; } else { asm volatile("" :: "v"(o)); } }
      asm volatile("" ::: "memory"); __builtin_amdgcn_sched_barrier(0); }
    if (tn >= t_end) break;
    t = tn; e0 = e0n; e1 = e1n;
  }
#undef ELOAD
#undef GRPA
#undef GRPB
}
#undef PLAS
}

constexpr int BATCH = 2, SEQ = 8192, DM = 4096, T = BATCH * SEQ;
constexpr int NCAT = 15872;
constexpr int NPH = 12;
#ifndef MK_CUTS
#define MK_CUTS 1
#endif
constexpr float EPS = 1e-6f;
constexpr float LOG2E = 1.4426950408889634f;
constexpr float MLA_QSCALE = 0.07216878364870322f * LOG2E;
constexpr float S_WIN = 64.f, S_PAB = 32.f, S_WOUT = 64.f, S_OA = 64.f, S_OB = 16.f, S_MRG = 16.f;
constexpr float NA_QSCALE = 0.08838834764831845f * LOG2E;

constexpr size_t MiB = 1u << 20;
constexpr size_t WS_CTL = 0, CTL_ZERO_BYTES = 1 * MiB;
constexpr size_t WS_ROPE = 1 * MiB;
constexpr size_t WS_RS = 1 * MiB + 65536;
constexpr size_t WS_WCAT = 2 * MiB;
constexpr size_t WS_WUQ = WS_WCAT + 124 * MiB;
constexpr size_t WS_WUKV = WS_WUQ + 5 * MiB;
constexpr size_t WS_PA = WS_WUKV + 4 * MiB;
constexpr size_t WS_PB = WS_PA + 16 * MiB;
constexpr size_t WS_WOUT = WS_PB + 16 * MiB;
constexpr size_t WS_WQ = WS_WOUT + 32 * MiB;
constexpr size_t WS_SUBH = WS_WQ + 16 * MiB;
constexpr size_t WS_SUBL = WS_SUBH + 512 * 1024;
constexpr size_t WS_R1 = WS_SUBL + 512 * 1024;
constexpr size_t WS_LAT = WS_R1 + 128 * MiB;
constexpr size_t WS_R2 = WS_LAT + 48 * MiB;
constexpr size_t WS_R3 = WS_R2 + 192 * MiB;
constexpr size_t WS_R4 = WS_R3 + 256 * MiB;
constexpr size_t WS_KR = WS_R4 + 224 * MiB;
constexpr size_t WS_IDX = WS_KR + 2 * MiB;
constexpr size_t WS_GATE = WS_IDX + 8 * MiB;
constexpr size_t WS_END = WS_GATE + 8 * MiB;
constexpr int CW_TMO = 0, CW_BAR = 4096;

constexpr int RING_BYTES = 131072, LDSCTL_OFF = RING_BYTES, MISC_OFF = LDSCTL_OFF + 320, LDS_BYTES = 147456;
constexpr int NWAVES = 8;

#define GAS __attribute__((address_space(1)))
#define LAS __attribute__((address_space(3)))
typedef unsigned short bf16;
typedef unsigned v4u __attribute__((ext_vector_type(4)));
typedef float f32x4 __attribute__((ext_vector_type(4)));
typedef float f32x8 __attribute__((ext_vector_type(8)));
typedef GAS unsigned gu32;
#define RLX_AGENT __ATOMIC_RELAXED, __HIP_MEMORY_SCOPE_AGENT
#define LDS_WAIT() asm volatile("s_waitcnt lgkmcnt(0)" ::: "memory")
#define VM_WAIT() asm volatile("s_waitcnt vmcnt(0)" ::: "memory")
__device__ __forceinline__ unsigned pkbf(float lo, float hi) { unsigned r; asm volatile("v_cvt_pk_bf16_f32 %0, %1, %2" : "=v"(r) : "v"(lo), "v"(hi)); return r; }

#define XB_TMO      128
#define XB_XCNT(j)  (256  + 64 * (j))
#define XB_XSUB(j)  (1280 + 64 * (j))
#define XB_XGEN(j)  (2304 + 64 * (j))
#define XB_TOP      3328
#define XB_TOPGEN   3392
#define XCD_BAR_WORDS 3456
#define XB_SPIN_CAP (1u << 22)
__device__ __forceinline__ unsigned xb_ld(unsigned* p)              { return __hip_atomic_load(p, __ATOMIC_RELAXED, __HIP_MEMORY_SCOPE_AGENT); }
__device__ __forceinline__ unsigned xb_add(unsigned* p, unsigned v) { return __hip_atomic_fetch_add(p, v, __ATOMIC_RELAXED, __HIP_MEMORY_SCOPE_AGENT); }
__device__ __forceinline__ unsigned xb_xcc_id() { return (unsigned)__builtin_amdgcn_s_getreg((3 << 11) | 20) & 0xFu; }
#define XB_SPIN(cond, bar) do { unsigned _sp = 0; while (cond) { __builtin_amdgcn_s_sleep(1); \
    if ((++_sp & 255u) == 0u) { if (xb_ld(&(bar)[XB_TMO])) break; if (_sp > XB_SPIN_CAP) { atomicAdd(&(bar)[XB_TMO], 1u); break; } } } } while (0)
struct XcdBarrier { unsigned* bar; unsigned x; volatile LAS unsigned* st; };
__device__ __forceinline__ XcdBarrier xcd_barrier_post(unsigned* bar, volatile LAS unsigned* st) {
    XcdBarrier b; b.bar = bar; b.x = xb_xcc_id(); b.st = st;
    if (threadIdx.x == 0) (void)xb_add(&bar[XB_XCNT(b.x)], 1u);
    return b;
}
__device__ __forceinline__ void xcd_barrier_complete(unsigned* bar, unsigned x, unsigned& nloc, unsigned& nx) {
    const unsigned G = gridDim.x * gridDim.y * gridDim.z;
    unsigned sum, cnt, mine, sp = 0u;
    for (;;) {
        sum = 0u; cnt = 0u; mine = 0u;
#pragma unroll
        for (unsigned j = 0; j < 16; ++j) { const unsigned c = xb_ld(&bar[XB_XCNT(j)]); sum += c; cnt += (c > 0u) ? 1u : 0u; mine = (j == x) ? c : mine; }
        if (sum == G) break;
        __builtin_amdgcn_s_sleep(1);
        if ((++sp & 255u) == 0u) { if (xb_ld(&bar[XB_TMO])) break; if (sp > XB_SPIN_CAP) { atomicAdd(&bar[XB_TMO], 1u); break; } }
    }
    nloc = mine > 0u ? mine : 1u; nx = cnt > 0u ? cnt : 1u;
}
__device__ __forceinline__ void xcd_barrier(const XcdBarrier& b) {
    asm volatile("s_waitcnt vmcnt(0)" ::: "memory");
    __syncthreads();
    if (threadIdx.x == 0) {
        unsigned* bar = b.bar;
        __builtin_amdgcn_s_waitcnt(0);
        unsigned nloc = b.st[0], nx = b.st[1];
        if (nloc == 0u) { xcd_barrier_complete(bar, b.x, nloc, nx); b.st[0] = nloc; b.st[1] = nx; }
        const unsigned old = xb_add(&bar[XB_XSUB(b.x)], 1u);
        const unsigned gen = old / nloc;
        if (old + 1u == (gen + 1u) * nloc) {
            __builtin_amdgcn_fence(__ATOMIC_RELEASE, "agent");
            asm volatile("s_waitcnt vmcnt(0)" ::: "memory");
            const unsigned og = xb_add(&bar[XB_TOP], 1u);
            const unsigned tg = og / nx;
            if (og + 1u == (tg + 1u) * nx) xb_add(&bar[XB_TOPGEN], 1u);
            else XB_SPIN(xb_ld(&bar[XB_TOPGEN]) == tg, bar);
            __builtin_amdgcn_fence(__ATOMIC_ACQUIRE, "agent");
            xb_add(&bar[XB_XGEN(b.x)], 1u);
            asm volatile("s_waitcnt vmcnt(0)" ::: "memory");
        } else {
            XB_SPIN(xb_ld(&bar[XB_XGEN(b.x)]) == gen, bar);
            __builtin_amdgcn_fence(__ATOMIC_ACQUIRE, "agent");
            asm volatile("s_waitcnt vmcnt(0)" ::: "memory");
        }
    }
    __syncthreads();
}

__device__ __forceinline__ float wave_sum(float v) {
#pragma unroll
    for (int o = 1; o < 64; o <<= 1) v += __shfl_xor(v, o);
    return v;
}
__device__ __forceinline__ void transpose_item(const float* W, int N, bf16* WT, int ldt, int row_off, const float* gk, LAS float* scr, int kb, int nb, int lane) {
    const int k0 = 64 * kb, n0 = 32 * nb;
#pragma unroll 8
    for (int i = 0; i < 32; ++i) { const int kk = 2 * i + (lane >> 5); float w = W[(size_t)(k0 + kk) * N + n0 + (lane & 31)]; if (gk) w *= gk[k0 + kk]; scr[kk * 33 + (lane & 31)] = w; }
    LDS_WAIT(); asm volatile("" ::: "memory");
    const int c = lane & 7;
#pragma unroll
    for (int j = 0; j < 4; ++j) { const int n = (lane >> 3) + 8 * j; const LAS float* s = scr + (8 * c) * 33 + n;
        v4u o; o.x = pkbf(s[0 * 33], s[1 * 33]); o.y = pkbf(s[2 * 33], s[3 * 33]); o.z = pkbf(s[4 * 33], s[5 * 33]); o.w = pkbf(s[6 * 33], s[7 * 33]);
        *(GAS v4u*)(WT + (size_t)(row_off + n0 + n) * ldt + k0 + 8 * c) = o; }
    LDS_WAIT(); asm volatile("" ::: "memory");
}
__device__ __forceinline__ void rms_row_to_bf16(const float* xrow, const float* gain, bf16* orow, int lane) {
    const GAS f32x4* xr = (const GAS f32x4*)xrow + lane; const GAS f32x4* gr = (const GAS f32x4*)gain + lane;
    f32x4 v[16]; float s = 0.f;
#pragma unroll
    for (int j = 0; j < 16; ++j) { v[j] = xr[64 * j]; s += (v[j].x * v[j].x + v[j].y * v[j].y) + (v[j].z * v[j].z + v[j].w * v[j].w); }
    const float rstd = 1.f / sqrtf(wave_sum(s) * (1.f / DM) + EPS);
    GAS unsigned long long* o8 = (GAS unsigned long long*)orow + lane;
#pragma unroll
    for (int j = 0; j < 16; ++j) { const f32x4 g = gr[64 * j];
        o8[64 * j] = (unsigned long long)pkbf(v[j].x * rstd * g.x, v[j].y * rstd * g.y) | ((unsigned long long)pkbf(v[j].z * rstd * g.z, v[j].w * rstd * g.w) << 32); }
}

__device__ __forceinline__ unsigned pk4f8(float a, float b, float c, float d) { int w = __builtin_amdgcn_cvt_pk_fp8_f32(a, b, 0, false); w = __builtin_amdgcn_cvt_pk_fp8_f32(c, d, w, true); return (unsigned)w; }
__device__ __forceinline__ void transpose_item8(const float* W, int N, unsigned char* WT, int ldt, int row_off, float scale, LAS float* scr, int kb, int nb, int lane) {
    const int k0 = 64 * kb, n0 = 32 * nb;
#pragma unroll 8
    for (int i = 0; i < 32; ++i) { const int kk = 2 * i + (lane >> 5); scr[kk * 33 + (lane & 31)] = W[(size_t)(k0 + kk) * N + n0 + (lane & 31)] * scale; }
    LDS_WAIT(); asm volatile("" ::: "memory");
    const int n = lane >> 1, kh = (lane & 1) * 32; const LAS float* s = scr + kh * 33 + n;
#pragma unroll
    for (int j = 0; j < 2; ++j) { v4u o;
        o.x = pk4f8(s[(16 * j + 0) * 33], s[(16 * j + 1) * 33], s[(16 * j + 2) * 33], s[(16 * j + 3) * 33]); o.y = pk4f8(s[(16 * j + 4) * 33], s[(16 * j + 5) * 33], s[(16 * j + 6) * 33], s[(16 * j + 7) * 33]);
        o.z = pk4f8(s[(16 * j + 8) * 33], s[(16 * j + 9) * 33], s[(16 * j + 10) * 33], s[(16 * j + 11) * 33]); o.w = pk4f8(s[(16 * j + 12) * 33], s[(16 * j + 13) * 33], s[(16 * j + 14) * 33], s[(16 * j + 15) * 33]);
        *(GAS v4u*)(WT + (size_t)(row_off + n0 + n) * ldt + k0 + kh + 16 * j) = o; }
    LDS_WAIT(); asm volatile("" ::: "memory");
}
__device__ __forceinline__ void rms_row_to_fp8(const float* xrow, const float* gain, unsigned char* orow, int lane) {
    const GAS f32x4* xr = (const GAS f32x4*)xrow + lane; const GAS f32x4* gr = (const GAS f32x4*)gain + lane;
    f32x4 v[16]; float s = 0.f;
#pragma unroll
    for (int j = 0; j < 16; ++j) { v[j] = xr[64 * j]; s += (v[j].x * v[j].x + v[j].y * v[j].y) + (v[j].z * v[j].z + v[j].w * v[j].w); }
    const float rstd = 1.f / sqrtf(wave_sum(s) * (1.f / DM) + EPS);
    GAS unsigned* o4 = (GAS unsigned*)orow + lane;
#pragma unroll
    for (int j = 0; j < 16; ++j) { const f32x4 g = gr[64 * j]; o4[64 * j] = pk4f8(v[j].x * rstd * g.x, v[j].y * rstd * g.y, v[j].z * rstd * g.z, v[j].w * rstd * g.w); }
}

struct Args {
    const float* in[19]; float* out; unsigned char* ws; int ph_lo, ph_hi, use_bar, pad;
};

__global__ void __launch_bounds__(NWAVES * 64, 2) mk_fwd(Args args) {
    extern __shared__ __attribute__((aligned(16))) unsigned char lds[];
    LAS unsigned char* ldsl = (LAS unsigned char*)lds;
    volatile LAS unsigned* MISC = (volatile LAS unsigned*)(ldsl + MISC_OFF);
    const int tid = threadIdx.x, lane = tid & 63, wave = __builtin_amdgcn_readfirstlane(tid >> 6);
    const int G = gridDim.x, bx = blockIdx.x;
    const int vcu = (G % 8 == 0) ? (bx % 8) * (G / 8) + bx / 8 : bx;
    const int gw = vcu * NWAVES + wave, NGW = G * NWAVES;
    unsigned char* ws = args.ws;
    gu32* ctl = (gu32*)(ws + WS_CTL);
    const float* x = args.in[0]; const float* attn_norm = args.in[1]; const float* w_in = args.in[2]; const float* q_norm = args.in[3]; const float* w_uq = args.in[4];
    const float* kv_norm = args.in[5]; const float* w_ukv = args.in[6]; const float* w_bmla = args.in[7]; const float* na_rpb = args.in[8]; const float* w_bna = args.in[9];
    const float* w_gate = args.in[10]; const float* b_gate = args.in[11]; const float* w_out = args.in[12]; const float* ffn_norm = args.in[13]; const float* peer_wq = args.in[14];
    const float* peer_sub = args.in[15]; const float* peer_u = args.in[16]; const float* peer_v = args.in[17]; const float* final_norm = args.in[18];
    float* out = args.out;
    float* ROPE = (float*)(ws + WS_ROPE); float* RS = (float*)(ws + WS_RS);
    bf16* WCAT = (bf16*)(ws + WS_WCAT); bf16* WUQ = (bf16*)(ws + WS_WUQ); bf16* WUKV = (bf16*)(ws + WS_WUKV); bf16* PA = (bf16*)(ws + WS_PA); bf16* PB = (bf16*)(ws + WS_PB);
    bf16* WOUT = (bf16*)(ws + WS_WOUT); bf16* WQ = (bf16*)(ws + WS_WQ); bf16* SUBH = (bf16*)(ws + WS_SUBH); bf16* SUBL = (bf16*)(ws + WS_SUBL);
    unsigned char* XN8 = ws + WS_R1; unsigned char* OA8 = ws + WS_R1; unsigned char* OB8 = ws + WS_R1 + 32 * MiB; bf16* H2 = (bf16*)(ws + WS_R1);
    bf16* LAT = (bf16*)(ws + WS_LAT);
    bf16* NAQ = (bf16*)(ws + WS_R2); bf16* NAK = (bf16*)(ws + WS_R2 + 64 * MiB); bf16* NAV = (bf16*)(ws + WS_R2 + 128 * MiB); bf16* MRG = (bf16*)(ws + WS_R2); unsigned char* MRG8 = ws + WS_R2 + 128 * MiB;
    bf16* GT = (bf16*)(ws + WS_R3); unsigned char* U8 = ws + WS_R3; unsigned char* V8 = ws + WS_R3 + 64 * MiB;
    bf16* QM = (bf16*)(ws + WS_R4); bf16* KN = (bf16*)(ws + WS_R4 + 96 * MiB); bf16* VM = (bf16*)(ws + WS_R4 + 160 * MiB); float* QP = (float*)(ws + WS_R4);
    bf16* KR = (bf16*)(ws + WS_KR); int* IDX = (int*)(ws + WS_IDX); float* GATE = (float*)(ws + WS_GATE);

    for (int u = tid; u < (LDS_BYTES - LDSCTL_OFF) / 4; u += NWAVES * 64) ((LAS unsigned*)(ldsl + LDSCTL_OFF))[u] = 0u;
    __syncthreads();
    XcdBarrier bar; bar.bar = (unsigned*)(ctl + CW_BAR); bar.x = 0; bar.st = nullptr;
    if (args.use_bar) bar = xcd_barrier_post((unsigned*)(ctl + CW_BAR), MISC + 8);
    const int lo = args.ph_lo, hi = args.ph_hi;
#ifndef MK_PHMASK
#define MK_PHMASK 0xFFF
#endif
#define IN(k) (((MK_PHMASK >> (k)) & 1) && lo <= (k) && (k) < hi)
#ifndef MK_FAKE
#define MK_FAKE false
#endif
#ifndef MK_DUP
#define MK_DUP -1
#endif
#define REPS(k) ((MK_DUP == (k)) ? 2 : 1)
#define SEAM(k) do { if (IN(k) && IN((k) + 1)) xcd_barrier(bar); } while (0)

    for (int rep_ = 0; rep_ < REPS(0); ++rep_) if (IN(0)) {
        LAS float* scr = (LAS float*)(ldsl + wave * 16384);
        constexpr int I0 = 64 * 234, I1 = 64 * 256, I2 = 12 * 96, I3 = 8 * 128, I4 = 32 * 128, I5 = 32 * 128, I6 = 64 * 128, I7 = 64 * 64;
        constexpr int NITEMS = I0 + I1 + I2 + I3 + I4 + I5 + I6 + I7;
        for (int it = gw; it < NITEMS; it += NGW) {
            int r = it;
            if (r < I0) { const int kb = r / 234, nb = r % 234; const int off = (nb >= 42) ? 192 : 0; transpose_item8(w_in, 7488, (unsigned char*)WCAT, 4096, off, S_WIN, scr, kb, nb, lane); continue; } r -= I0;
            if (r < I1) { transpose_item8(w_gate, 8192, (unsigned char*)WCAT, 4096, 7680, S_WIN, scr, r / 256, r % 256, lane); continue; } r -= I1;
            if (r < I2) { transpose_item(w_uq, 3072, WUQ, 768, 0, q_norm, scr, r / 96, r % 96, lane); continue; } r -= I2;
            if (r < I3) { transpose_item(w_ukv, 4096, WUKV, 512, 0, kv_norm, scr, r / 128, r % 128, lane); continue; } r -= I3;
            if (r < I4) { transpose_item8(w_bmla, 4096, (unsigned char*)PA, 2048, 0, S_PAB, scr, r / 128, r % 128, lane); continue; } r -= I4;
            if (r < I5) { transpose_item8(w_bna, 4096, (unsigned char*)PB, 2048, 0, S_PAB, scr, r / 128, r % 128, lane); continue; } r -= I5;
            if (r < I6) { transpose_item8(w_out, 4096, (unsigned char*)WOUT, 4096, 0, S_WOUT, scr, r / 128, r % 128, lane); continue; } r -= I6;
            transpose_item(peer_wq, 2048, WQ, 4096, 0, nullptr, scr, r / 64, r % 64, lane);
        }
        for (int i = gw * 64 + lane; i < 192 * 4096 / 16; i += NGW * 64) ((GAS v4u*)((unsigned char*)WCAT + (size_t)1344 * 4096))[i] = (v4u){0u, 0u, 0u, 0u};
        for (int i = gw * 64 + lane; i < 8 * 2 * 128 * 128 / 2; i += NGW * 64) { const float a = peer_sub[2 * i], b = peer_sub[2 * i + 1];
            const unsigned h = pkbf(a, b); const unsigned l = pkbf(a - __uint_as_float(h << 16), b - __uint_as_float(h & 0xffff0000u));
            ((GAS unsigned*)SUBH)[i] = h; ((GAS unsigned*)SUBL)[i] = l; }
        for (int i = gw * 64 + lane; i < 128 * 16; i += NGW * 64) { const int pos = i >> 4, j = i & 15; const float fr = powf(10000.0f, -(float)j / 16.0f); const float ang = (float)pos * fr;
            ROPE[2 * i] = cosf(ang); ROPE[2 * i + 1] = sinf(ang); }
        for (int m = gw; m < T; m += NGW) rms_row_to_fp8(x + (size_t)m * DM, attn_norm, XN8 + (size_t)m * DM, lane);
    }
    SEAM(0);
    for (int rep_ = 0; rep_ < REPS(1); ++rep_) if (IN(1)) {
        pg8::Gemm g{(const bf16*)XN8, WCAT, T, NCAT, DM, DM, DM}; pg8::StaticOrder S; S.init(T, NCAT, G, bx);
        pg8::EpiIn E{ws, WS_LAT, WS_R2, 64 * MiB, WS_R3, b_gate, NA_QSCALE, 1.0f / S_WIN};
        pg8::gemm_phase<pg8::EpiIn, pg8::StaticOrder, true, true>(ldsl, g, S, E);
    }
    SEAM(1);
    for (int rep_ = 0; rep_ < REPS(2); ++rep_) if (IN(2)) {
        for (int m = gw; m < T; m += NGW) {
            const bf16* row = LAT + (size_t)m * 1536;
            float sq = 0.f, skv = 0.f;
#pragma unroll
            for (int j = 0; j < 6; ++j) { const unsigned w = ((const GAS unsigned*)row)[lane + 64 * j]; const float a = __uint_as_float(w << 16), b = __uint_as_float(w & 0xffff0000u); sq += a * a + b * b; }
#pragma unroll
            for (int j = 0; j < 4; ++j) { const unsigned w = ((const GAS unsigned*)(row + 768))[lane + 64 * j]; const float a = __uint_as_float(w << 16), b = __uint_as_float(w & 0xffff0000u); skv += a * a + b * b; }
            sq = wave_sum(sq); skv = wave_sum(skv);
            if (lane == 0) { RS[2 * m] = 1.f / sqrtf(sq * (1.f / 768.f) + EPS); RS[2 * m + 1] = 1.f / sqrtf(skv * (1.f / 512.f) + EPS); }
            const float xk = __uint_as_float((unsigned)row[1280 + lane] << 16);
            const float xp = __shfl_xor(xk, 16);
            const int s = m & (SEQ - 1), pos = (lane < 32) ? (s >> 6) : (s & 63), j = lane & 15;
            const float c = ROPE[(pos * 16 + j) * 2], sn = ROPE[(pos * 16 + j) * 2 + 1];
            const float o = ((lane & 16) == 0) ? (xk * c - xp * sn) : (xp * sn + xk * c);
            KR[(size_t)m * 64 + lane] = (bf16)(pkbf(o, 0.f) & 0xffffu);
        }
    }
    SEAM(2);
    for (int rep_ = 0; rep_ < REPS(3); ++rep_) if (IN(3)) {
        { pg8::Gemm g{LAT, WUQ, T, 3072, 768, 1536, 768}; pg8::StaticOrder S; S.init(T, 3072, G, bx);
          pg8::EpiQ E{QM, RS, ROPE, MLA_QSCALE};
          pg8::gemm_phase<pg8::EpiQ, pg8::StaticOrder>(ldsl, g, S, E); }
        { pg8::Gemm g{LAT + 768, WUKV, T, 4096, 512, 1536, 512}; pg8::StaticOrder S; S.init(T, 4096, G, bx);
          pg8::EpiKV E{KN, VM, RS};
          pg8::gemm_phase<pg8::EpiKV, pg8::StaticOrder>(ldsl, g, S, E); }
    }
    SEAM(3);
    for (int rep_ = 0; rep_ < REPS(4); ++rep_) if (IN(4)) {
#ifndef NO_MLA
#pragma unroll 1
        for (int u = vcu; u < BATCH * 16 * 32; u += G) { const int bh = u >> 5, qb = u & 31; att::mla_unit(bh >> 4, bh & 15, qb, QM, KN, KR, VM, OA8, S_OA, (char*)lds); }
#endif
#ifndef NO_NA
#pragma unroll 1
        for (int u = vcu; u < BATCH * 16 * 32; u += G) { const int bh = u >> 5, rg = u & 31; att::na_unit(bh >> 4, bh & 15, rg, NAQ, NAK, NAV, na_rpb, OB8, S_OB, (char*)lds); }
#endif
        __syncthreads();
    }
    SEAM(4);
    for (int rep_ = 0; rep_ < REPS(5); ++rep_) if (IN(5)) {
        { pg8::Gemm g{(const bf16*)OA8, PA, T, DM, 2048, 2048, 2048}; pg8::StaticOrder S; S.init(T, DM, G, bx);
          pg8::EpiGate<true> E{GT, MRG, nullptr, 1.0f / (S_OA * S_PAB), 0.f};
          pg8::gemm_phase<pg8::EpiGate<true>, pg8::StaticOrder, true, true>(ldsl, g, S, E); }
    }
    SEAM(5);
    for (int rep_ = 0; rep_ < REPS(6); ++rep_) if (IN(6)) {
        { pg8::Gemm g{(const bf16*)OB8, PB, T, DM, 2048, 2048, 2048}; pg8::StaticOrder S; S.init(T, DM, G, bx);
          pg8::EpiGate<false> E{GT, MRG, MRG8, 1.0f / (S_OB * S_PAB), S_MRG};
          pg8::gemm_phase<pg8::EpiGate<false>, pg8::StaticOrder, true, true>(ldsl, g, S, E); }
    }
    SEAM(6);
    for (int rep_ = 0; rep_ < REPS(7); ++rep_) if (IN(7)) {
        pg8::Gemm g{(const bf16*)MRG8, WOUT, T, DM, DM, DM, DM}; pg8::StaticOrder S; S.init(T, DM, G, bx);
        pg8::EpiF32 E{x, out, DM, 1.0f / (S_MRG * S_WOUT)};
        pg8::gemm_phase<pg8::EpiF32, pg8::StaticOrder, true, true>(ldsl, g, S, E);
#ifdef PROBE_SKIP_ATTN
        VM_WAIT(); __syncthreads();
        for (size_t i = (size_t)gw * 64 + lane; i < (size_t)T * DM / 4; i += (size_t)NGW * 64) ((GAS f32x4*)out)[i] = ((const GAS f32x4*)x)[i];
#endif
    }
    SEAM(7);
    for (int rep_ = 0; rep_ < REPS(8); ++rep_) if (IN(8)) {
        for (int m = gw; m < T; m += NGW) rms_row_to_bf16(out + (size_t)m * DM, ffn_norm, H2 + (size_t)m * DM, lane);
        for (int r = gw; r < 2 * 16384; r += NGW) { const bool isu = r < 16384; const int e = isu ? r : r - 16384;
            peer::pack_row_fp6((isu ? peer_u : peer_v) + (size_t)e * DM, (isu ? U8 : V8) + (size_t)e * peer::ROW6, isu ? peer::U6SCALE : peer::V6SCALE, lane); }
    }
    SEAM(8);
    for (int rep_ = 0; rep_ < REPS(9); ++rep_) if (IN(9)) {
        pg8::Gemm g{H2, WQ, T, 2048, DM, DM, DM}; pg8::StaticOrder S; S.init(T, 2048, G, bx);
        pg8::EpiF32 E{nullptr, QP, 2048, 1.0f};
        pg8::gemm_phase<pg8::EpiF32, pg8::StaticOrder>(ldsl, g, S, E);
    }
    SEAM(9);
    for (int rep_ = 0; rep_ < REPS(10); ++rep_) if (IN(10)) {
        LAS int* wl = (LAS int*)(ldsl + wave * peer::SEL_LDS_PER_WAVE);
        for (int it = gw; it < (T / 32) * 8; it += NGW) peer::select32((it >> 3) * 32, it & 7, QP, SUBH, SUBL, IDX, GATE, wl, lane);
    }
    SEAM(10);
    for (int rep_ = 0; rep_ < REPS(11); ++rep_) if (IN(11)) {
#ifdef PROBE_SKIP_PEER
        for (int t = gw; t < T; t += NGW) { float* xr = out + (size_t)t * DM; f32x4 v[16]; float ss = 0.f;
            for (int j = 0; j < 16; ++j) { v[j] = ((const GAS f32x4*)xr)[lane + 64 * j]; ss += v[j].x * v[j].x + v[j].y * v[j].y + v[j].z * v[j].z + v[j].w * v[j].w; }
            const float rstd = 1.f / sqrtf(wave_sum(ss) * (1.f / DM) + EPS);
            for (int j = 0; j < 16; ++j) { const f32x4 g = ((const GAS f32x4*)final_norm)[lane + 64 * j]; ((GAS f32x4*)xr)[lane + 64 * j] = v[j] * rstd * g; } }
#else
        if (MK_DUP == 11 && rep_ == 0) peer::expert_tokens6<false>(gw, NGW, T, H2, U8, V8, IDX, GATE, out, final_norm, lane);
        else peer::expert_tokens6<true>(gw, NGW, T, H2, U8, V8, IDX, GATE, out, final_norm, lane);
#endif
    }
#undef IN
#undef SEAM
}

extern "C" void kernel_launch(void* const* d_in, const int* in_sizes, int n_in, void* d_out, int out_size, void* d_ws, size_t ws_size, hipStream_t stream) {
    static int grid = 0;
    if (grid == 0) {
        if (n_in != 19 || out_size != T * DM || ws_size < WS_END) { fprintf(stderr, "kernel_launch: shape mismatch: n_in %d out %d ws %zu (need %zu)\n", n_in, out_size, ws_size, (size_t)WS_END); grid = -1; return; }
        int dev = 0, cus = 0, per_cu = 0;
        if (hipGetDevice(&dev) != hipSuccess || hipDeviceGetAttribute(&cus, hipDeviceAttributeMultiprocessorCount, dev) != hipSuccess) { grid = -1; return; }
        if (hipFuncSetAttribute((const void*)mk_fwd, hipFuncAttributeMaxDynamicSharedMemorySize, LDS_BYTES) != hipSuccess) { fprintf(stderr, "kernel_launch: hipFuncSetAttribute failed\n"); grid = -1; return; }
        if (hipOccupancyMaxActiveBlocksPerMultiprocessor(&per_cu, (const void*)mk_fwd, NWAVES * 64, LDS_BYTES) != hipSuccess || per_cu < 1) { fprintf(stderr, "kernel_launch: occupancy query says %d blocks per CU\n", per_cu); }
        (void)hipGetLastError();
        grid = cus;
    }
    if (grid < 0) return;
    if (hipMemsetAsync((char*)d_ws + WS_CTL, 0, CTL_ZERO_BYTES, stream) != hipSuccess) return;
    Args a{};
    for (int i = 0; i < 19; ++i) a.in[i] = (const float*)d_in[i];
    a.out = (float*)d_out; a.ws = (unsigned char*)d_ws; a.pad = 0;
    constexpr int NL = MK_CUTS;
    for (int li = 0; li < NL; ++li) {
        a.ph_lo = (NL == 1) ? 0 : li; a.ph_hi = (NL == 1) ? NPH : li + 1; a.use_bar = (NL == 1) ? 1 : 0;
        hipLaunchKernelGGL(mk_fwd, dim3(grid), dim3(NWAVES * 64), LDS_BYTES, stream, a);
    }
}
```

```cpp
#include <hip/hip_runtime.h>
#include <hip/hip_bf16.h>
#include <cstdio>
#include <cstdint>

namespace pg8 {
#define PG8_LAS __attribute__((address_space(3)))
typedef unsigned short bf16_t;
typedef short bf16x8 __attribute__((ext_vector_type(8)));
typedef float f32x4 __attribute__((ext_vector_type(4)));
typedef float f32x2 __attribute__((ext_vector_type(2)));
typedef unsigned u32x4 __attribute__((ext_vector_type(4)));
typedef unsigned u32x2 __attribute__((ext_vector_type(2)));
constexpr int BM = 256, BK = 64, HALF = 128, HTB = HALF * BK * 2  , STAGE_BYTES = 8 * HTB, NXCD = 8, WGM = 8;

__host__ __device__ __forceinline__ int lds_byte(int r, int c) { const int st = (r >> 4) * 2 + (c >> 5), rr = r & 15, cc = c & 31, ob = rr * 64 + cc * 2; return st * 1024 + (ob ^ (((ob >> 9) & 1) << 5)); }
__host__ __device__ __forceinline__ void stage_rc(int b, int& R, int& C) { const int st = b / 1024, sb = b % 1024, swz = sb ^ (((sb >> 9) & 1) << 5); R = (st >> 1) * 16 + swz / 64; C = (st & 1) * 32 + (swz % 64) / 2; }
__host__ __device__ __forceinline__ int perm32(int rho) { const int n = rho >> 4, i = rho & 15; return 8 * (i >> 2) + 4 * n + (i & 3); }

struct Unit { int pm, pn; };
struct Gemm { const bf16_t* A; const bf16_t* Bt; int M, N, K, lda, ldb; };

struct StaticOrder {
    int nM, nN, nwg, G, c;
    __host__ __device__ void init(int M, int N, int G_, int c_) { nM = M / BM; nN = N / BM; nwg = nM * nN; G = G_; c = c_; }
    __host__ __device__ bool next(int i, Unit& u) const {
        const long L = (long)i * G + c; if (L >= nwg) return false;
        int wgid = (int)L; { const int q = nwg / NXCD, r = nwg % NXCD, xcd = wgid % NXCD, off = wgid / NXCD; wgid = (xcd < r ? xcd * (q + 1) : r * (q + 1) + (xcd - r) * q) + off; }
        const int nig = WGM * nN, gid = wgid / nig, fm = gid * WGM, gsz = (nM - fm) < WGM ? (nM - fm) : WGM;
        u.pm = fm + ((wgid % nig) % gsz); u.pn = (wgid % nig) / gsz; return true;
    }
    __device__ __forceinline__ void a_ready(const Unit&) const {}
    __device__ __forceinline__ void done(const Unit&) const {}
};

__device__ __forceinline__ unsigned cvt_pk_bf16(float lo, float hi) { unsigned r; asm volatile("v_cvt_pk_bf16_f32 %0, %1, %2" : "=v"(r) : "v"(lo), "v"(hi)); return r; }
__device__ __forceinline__ float bf_lo(unsigned w) { return __uint_as_float(w << 16); }
__device__ __forceinline__ float bf_hi(unsigned w) { return __uint_as_float(w & 0xffff0000u); }


typedef int v8i __attribute__((ext_vector_type(8)));
typedef int v4i __attribute__((ext_vector_type(4)));
typedef v8i v8i_a16 __attribute__((aligned(16)));
template <class Epi, class Sched, bool ALIGN_EPI = true, bool FP8 = false>
__device__ __forceinline__ void gemm_phase(PG8_LAS unsigned char* lds, const Gemm g, const Sched& S, const Epi& E) {
    int tid_ = threadIdx.x; asm volatile("" : "+v"(tid_));
    const int tid = tid_, wid = __builtin_amdgcn_readfirstlane(tid >> 6), lane = tid & 63, wr = wid >> 2, wc = wid & 3, fr = lane & 15, fq = lane >> 4;
    const int K = g.K, nt = FP8 ? K / 128 : K / BK;
    unsigned voffA[2], voffB[2];
#pragma unroll
    for (int i = 0; i < 2; ++i) { int R, C; stage_rc(tid * 16 + i * 8192, R, C); const int Rb = Epi::PERM ? ((R & ~31) + perm32(R & 31)) : R;
        voffA[i] = FP8 ? (unsigned)(R * g.lda + 2 * C) : (unsigned)(R * g.lda + C) * 2u; voffB[i] = FP8 ? (unsigned)(Rb * g.ldb + 2 * C) : (unsigned)(Rb * g.ldb + C) * 2u; }
    const size_t kstep = (size_t)(BK * 2);
    const size_t hstepA = (size_t)HALF * g.lda * (FP8 ? 1 : 2), hstepB = (size_t)HALF * g.ldb * (FP8 ? 1 : 2);
    const size_t tstepA = 2 * hstepA, tstepB = 2 * hstepB;
    const unsigned ldsw = (unsigned)wid * 1024u;
    const int aoff = lds_byte(wr * 64 + fr, FP8 ? fq * 16 : fq * 8), boff = lds_byte(wc * 32 + fr, FP8 ? fq * 16 : fq * 8);
#define PG8_SA(b, h) (((b) * 2 + (h)) * HTB)
#define PG8_SB(b, h) ((4 + (b) * 2 + (h)) * HTB)
#define PG8_STAGE(bufoff, gbase, voff) do { _Pragma("unroll") for (int _i = 0; _i < 2; ++_i) \
        __builtin_amdgcn_global_load_lds((const unsigned*)((const char*)(gbase) + (voff)[_i]), (PG8_LAS unsigned*)(lds + (bufoff) + ldsw + _i * 8192), 16, 0, 0); } while (0)
#define PG8_LDA(dst, b, h) do { if constexpr (FP8) { _Pragma("unroll") for (int m = 0; m < 4; ++m) { const bf16x8 lo_ = *(const PG8_LAS bf16x8*)(lds + PG8_SA(b, h) + aoff + m * 2048), hi_ = *(const PG8_LAS bf16x8*)(lds + PG8_SA(b, h) + aoff + m * 2048 + 16); \
            dst##8[m] = __builtin_shufflevector(__builtin_bit_cast(v4i, lo_), __builtin_bit_cast(v4i, hi_), 0, 1, 2, 3, 4, 5, 6, 7); } } \
        else { _Pragma("unroll") for (int m = 0; m < 4; ++m) _Pragma("unroll") for (int k = 0; k < 2; ++k) dst[m][k] = *(const PG8_LAS bf16x8*)(lds + PG8_SA(b, h) + aoff + m * 2048 + k * 1024); } } while (0)
#define PG8_LDB(dst, b, h) do { if constexpr (FP8) { _Pragma("unroll") for (int n = 0; n < 2; ++n) { const bf16x8 lo_ = *(const PG8_LAS bf16x8*)(lds + PG8_SB(b, h) + boff + n * 2048), hi_ = *(const PG8_LAS bf16x8*)(lds + PG8_SB(b, h) + boff + n * 2048 + 16); \
            dst##8[n] = __builtin_shufflevector(__builtin_bit_cast(v4i, lo_), __builtin_bit_cast(v4i, hi_), 0, 1, 2, 3, 4, 5, 6, 7); } } \
        else { _Pragma("unroll") for (int n = 0; n < 2; ++n) _Pragma("unroll") for (int k = 0; k < 2; ++k) dst[n][k] = *(const PG8_LAS bf16x8*)(lds + PG8_SB(b, h) + boff + n * 2048 + k * 1024); } } while (0)
#define PG8_V8(F) __builtin_shufflevector(__builtin_bit_cast(v4i, (F)[0]), __builtin_bit_cast(v4i, (F)[1]), 0, 1, 2, 3, 4, 5, 6, 7)
#define PG8_MMA(ai, bj, At, Bt) do { __builtin_amdgcn_s_setprio(1); _Pragma("unroll") for (int m = 0; m < 4; ++m) _Pragma("unroll") for (int n = 0; n < 2; ++n) { \
        if constexpr (FP8) asm volatile("v_mfma_f32_16x16x128_f8f6f4 %0, %1, %2, %0" : "+v"(acc[ai][bj][m][n]) : "v"(Bt##8[n]), "v"(At##8[m])); \
        else { _Pragma("unroll") for (int k = 0; k < 2; ++k) acc[ai][bj][m][n] = __builtin_amdgcn_mfma_f32_16x16x32_bf16(Bt[n][k], At[m][k], acc[ai][bj][m][n], 0, 0, 0); } } \
        __builtin_amdgcn_s_setprio(0); } while (0)
#define PG8_WAIT_V(n) asm volatile("s_waitcnt vmcnt(" #n ")" ::: "memory")
#define PG8_WAIT_L(n) asm volatile("s_waitcnt lgkmcnt(" #n ")" ::: "memory")
#define PG8_BAR __builtin_amdgcn_s_barrier()
#define PG8_SCHED __builtin_amdgcn_sched_barrier(0)
    Unit cur, nxt; int ui = 0;
    if (!S.next(0, cur)) return;
    f32x4 acc[2][2][4][2];
#pragma unroll
    for (int a = 0; a < 2; ++a)
#pragma unroll
        for (int b = 0; b < 2; ++b)
#pragma unroll
            for (int m = 0; m < 4; ++m)
#pragma unroll
                for (int n = 0; n < 2; ++n) acc[a][b][m][n] = (f32x4){0.f, 0.f, 0.f, 0.f};
    bf16x8 At[4][2], B0[2][2], B1[2][2]; v8i At8[4], B08[2], B18[2];
    const char* cA = (const char*)g.A + (size_t)cur.pm * tstepA; const char* cB = (const char*)g.Bt + (size_t)cur.pn * tstepB;
    S.a_ready(cur);
    PG8_STAGE(PG8_SB(0, 0), cB, voffB); PG8_STAGE(PG8_SB(0, 1), cB + hstepB, voffB); PG8_STAGE(PG8_SA(0, 0), cA, voffA); PG8_STAGE(PG8_SA(0, 1), cA + hstepA, voffA);
    if (wr == 1) PG8_BAR;
    PG8_WAIT_V(2); PG8_BAR;
    PG8_STAGE(PG8_SB(1, 0), cB + kstep, voffB); PG8_STAGE(PG8_SA(1, 0), cA + kstep, voffA); PG8_STAGE(PG8_SB(1, 1), cB + hstepB + kstep, voffB);
    PG8_WAIT_V(6); PG8_BAR;
    for (;;) {
        const bool has_next = S.next(ui + 1, nxt);
        const char* nA = has_next ? (const char*)g.A + (size_t)nxt.pm * tstepA : cA; const char* nB = has_next ? (const char*)g.Bt + (size_t)nxt.pn * tstepB : cB;
        for (int t = 0; t < nt; t += 2) {
            const bool last = (t == nt - 2);
            const char* a1 = cA + (size_t)(t + 1) * kstep;
            const char* a2 = last ? nA : cA + (size_t)(t + 2) * kstep; const char* b2 = last ? nB : cB + (size_t)(t + 2) * kstep;
            const char* a3 = a2 + kstep; const char* b3 = b2 + kstep;
            if (last && has_next) S.a_ready(nxt);
            PG8_LDB(B0, 0, 0); PG8_LDB(B1, 0, 1); PG8_SCHED; PG8_LDA(At, 0, 0); PG8_STAGE(PG8_SA(1, 1), a1 + hstepA, voffA);
            PG8_WAIT_V(8); PG8_WAIT_L(0); PG8_BAR; PG8_MMA(0, 0, At, B0); PG8_MMA(0, 1, At, B1); PG8_BAR; PG8_SCHED;
            PG8_LDA(At, 0, 1); PG8_STAGE(PG8_SB(0, 0), b2, voffB); PG8_STAGE(PG8_SB(0, 1), b2 + hstepB, voffB); PG8_STAGE(PG8_SA(0, 0), a2, voffA);
            PG8_WAIT_V(8); PG8_WAIT_L(0); PG8_BAR; PG8_MMA(1, 0, At, B0); PG8_MMA(1, 1, At, B1); PG8_BAR; PG8_SCHED;
            PG8_LDB(B0, 1, 0); PG8_LDB(B1, 1, 1); PG8_SCHED; PG8_LDA(At, 1, 0); PG8_STAGE(PG8_SA(0, 1), a2 + hstepA, voffA);
            PG8_WAIT_V(8); PG8_WAIT_L(0); PG8_BAR; PG8_MMA(0, 0, At, B0); PG8_MMA(0, 1, At, B1); PG8_BAR; PG8_SCHED;
            PG8_LDA(At, 1, 1); PG8_STAGE(PG8_SB(1, 0), b3, voffB); PG8_STAGE(PG8_SB(1, 1), b3 + hstepB, voffB); PG8_STAGE(PG8_SA(1, 0), a3, voffA);
            PG8_WAIT_V(8); PG8_WAIT_L(0); PG8_BAR; PG8_MMA(1, 0, At, B0); PG8_MMA(1, 1, At, B1); PG8_BAR; PG8_SCHED;
        }
        if constexpr (ALIGN_EPI) { if (wr == 0) PG8_BAR; }
        if constexpr (FP8) asm volatile("s_nop 15\n\ts_nop 7" ::: "memory");
        { int l_ = threadIdx.x; asm volatile("" : "+v"(l_));
          E(acc, cur, wr, wc, l_ & 15, (l_ >> 4) & 3); } S.done(cur);
        if (!has_next) break;
#pragma unroll
        for (int a = 0; a < 2; ++a)
#pragma unroll
            for (int b = 0; b < 2; ++b)
#pragma unroll
                for (int m = 0; m < 4; ++m)
#pragma unroll
                    for (int n = 0; n < 2; ++n) acc[a][b][m][n] = (f32x4){0.f, 0.f, 0.f, 0.f};
        cur = nxt; cA = nA; cB = nB; ++ui;
        if constexpr (ALIGN_EPI) { if (wr == 1) PG8_BAR; }
    }
    PG8_WAIT_V(0);
    if constexpr (!ALIGN_EPI) { if (wr == 0) PG8_BAR; }
    PG8_BAR;
#undef PG8_SA
#undef PG8_SB
#undef PG8_STAGE
#undef PG8_LDA
#undef PG8_LDB
#undef PG8_MMA
#undef PG8_V8
#undef PG8_WAIT_V
#undef PG8_WAIT_L
#undef PG8_BAR
#undef PG8_SCHED
}

__device__ __forceinline__ unsigned pk4_fp8(float a, float b, float c, float d) { int w = __builtin_amdgcn_cvt_pk_fp8_f32(a, b, 0, false); w = __builtin_amdgcn_cvt_pk_fp8_f32(c, d, w, true); return (unsigned)w; }
__device__ __forceinline__ float sigmoidf_fast(float x) { return __builtin_amdgcn_rcpf(1.0f + __builtin_amdgcn_exp2f(-1.4426950408889634f * x)); }

struct EpiIn {
    static constexpr bool PERM = true;
    unsigned char* wsb; size_t off_lat, off_na, na_stride, off_g; const float* bgate; float qscale; float ascale;
    __device__ __forceinline__ void operator()(const f32x4 (&acc)[2][2][4][2], const Unit& u, int wr, int wc, int fr, int fq) const {
        const int row0 = u.pm * BM + wr * 64 + fr; const int pn = u.pn;
        size_t boff; int ldc, colt; float sc = 1.f; bool gate = false;
        if (pn < 6) { boff = off_lat; ldc = 1536; colt = pn * 256; }
        else if (pn < 30) { const int t = (pn - 6) >> 3; boff = off_na + (size_t)t * na_stride; ldc = 2048; colt = ((pn - 6) & 7) * 256; if (t == 0) sc = qscale; }
        else { boff = off_g; ldc = 8192; colt = (pn - 30) * 256; gate = true; }
        bf16_t* base = (bf16_t*)(wsb + boff);
        const int col0 = colt + wc * 32 + 8 * fq;
        f32x4 bv[2][2];
#pragma unroll
        for (int bj = 0; bj < 2; ++bj)
#pragma unroll
            for (int n = 0; n < 2; ++n) bv[bj][n] = gate ? *(const f32x4*)(bgate + col0 + bj * HALF + 4 * n) : (f32x4){0.f, 0.f, 0.f, 0.f};
#pragma unroll
        for (int ai = 0; ai < 2; ++ai)
#pragma unroll
            for (int m = 0; m < 4; ++m) { bf16_t* rowp = base + (size_t)(row0 + ai * HALF + m * 16) * ldc + col0;
#pragma unroll
                for (int bj = 0; bj < 2; ++bj) { f32x4 v0 = acc[ai][bj][m][0] * ascale + bv[bj][0], v1 = acc[ai][bj][m][1] * ascale + bv[bj][1];
                    if (gate) {
#pragma unroll
                        for (int i = 0; i < 4; ++i) { v0[i] = sigmoidf_fast(v0[i]); v1[i] = sigmoidf_fast(v1[i]); } }
                    else { v0 = v0 * sc; v1 = v1 * sc; }
                    u32x4 w; w.x = cvt_pk_bf16(v0[0], v0[1]); w.y = cvt_pk_bf16(v0[2], v0[3]); w.z = cvt_pk_bf16(v1[0], v1[1]); w.w = cvt_pk_bf16(v1[2], v1[3]);
                    *(u32x4*)(rowp + bj * HALF) = w; } }
    }
};

struct EpiQ {
    static constexpr bool PERM = false;
    bf16_t* Q; const float* rs; const float* rope; float qscale;
    __device__ __forceinline__ void operator()(const f32x4 (&acc)[2][2][4][2], const Unit& u, int wr, int wc, int fr, int fq) const {
#pragma unroll
        for (int ai = 0; ai < 2; ++ai)
#pragma unroll
            for (int m = 0; m < 4; ++m) {
                const int row = u.pm * BM + ai * HALF + wr * 64 + m * 16 + fr;
                const float rstd = rs[2 * row] * qscale;
                const int s = row & 8191, grow = s >> 6, gcol = s & 63;
#pragma unroll
                for (int bj = 0; bj < 2; ++bj) {
                    const int gg = 8 * u.pn + 4 * bj + wc, kind = gg % 6;
                    f32x4 v0 = acc[ai][bj][m][0] * rstd, v1 = acc[ai][bj][m][1] * rstd;
                    if (kind >= 4) {
                        const int pos = (kind == 4) ? grow : gcol;
                        const f32x4 t0 = *(const f32x4*)(rope + (size_t)(pos * 16 + 4 * fq) * 2), t1 = *(const f32x4*)(rope + (size_t)(pos * 16 + 4 * fq) * 2 + 4);
                        const float c0 = t0[0], s0 = t0[1], c1 = t0[2], s1 = t0[3], c2 = t1[0], s2 = t1[1], c3 = t1[2], s3 = t1[3];
                        f32x4 o0, o1;
                        o0[0] = v0[0] * c0 - v1[0] * s0; o1[0] = v0[0] * s0 + v1[0] * c0;
                        o0[1] = v0[1] * c1 - v1[1] * s1; o1[1] = v0[1] * s1 + v1[1] * c1;
                        o0[2] = v0[2] * c2 - v1[2] * s2; o1[2] = v0[2] * s2 + v1[2] * c2;
                        o0[3] = v0[3] * c3 - v1[3] * s3; o1[3] = v0[3] * s3 + v1[3] * c3;
                        v0 = o0; v1 = o1;
                    }
                    bf16_t* p = Q + (size_t)row * 3072 + u.pn * BM + bj * HALF + wc * 32 + 4 * fq;
                    u32x2 w0, w1; w0.x = cvt_pk_bf16(v0[0], v0[1]); w0.y = cvt_pk_bf16(v0[2], v0[3]); w1.x = cvt_pk_bf16(v1[0], v1[1]); w1.y = cvt_pk_bf16(v1[2], v1[3]);
                    *(u32x2*)p = w0; *(u32x2*)(p + 16) = w1;
                }
            }
    }
};

struct EpiKV {
    static constexpr bool PERM = true;
    bf16_t* Kn; bf16_t* Vm; const float* rs;
    __device__ __forceinline__ void operator()(const f32x4 (&acc)[2][2][4][2], const Unit& u, int wr, int wc, int fr, int fq) const {
        const int col0 = u.pn * HALF + wc * 32 + 8 * fq;
#pragma unroll
        for (int ai = 0; ai < 2; ++ai)
#pragma unroll
            for (int m = 0; m < 4; ++m) {
                const int row = u.pm * BM + ai * HALF + wr * 64 + m * 16 + fr;
                const float rstd = rs[2 * row + 1];
#pragma unroll
                for (int bj = 0; bj < 2; ++bj) { const f32x4 v0 = acc[ai][bj][m][0] * rstd, v1 = acc[ai][bj][m][1] * rstd;
                    u32x4 w; w.x = cvt_pk_bf16(v0[0], v0[1]); w.y = cvt_pk_bf16(v0[2], v0[3]); w.z = cvt_pk_bf16(v1[0], v1[1]); w.w = cvt_pk_bf16(v1[2], v1[3]);
                    *(u32x4*)((bj == 0 ? Kn : Vm) + (size_t)row * 2048 + col0) = w; }
            }
    }
};


struct EpiQ8 {
    static constexpr bool PERM = false;
    unsigned char* Q8; const float* rs; const float* rope; float qscale;
    __device__ __forceinline__ void operator()(const f32x4 (&acc)[2][2][4][2], const Unit& u, int wr, int wc, int fr, int fq) const {
#pragma unroll
        for (int ai = 0; ai < 2; ++ai)
#pragma unroll
            for (int m = 0; m < 4; ++m) {
                const int row = u.pm * BM + ai * HALF + wr * 64 + m * 16 + fr;
                const float rstd = rs[2 * row] * qscale;
                const int s = row & 8191, grow = s >> 6, gcol = s & 63;
#pragma unroll
                for (int bj = 0; bj < 2; ++bj) {
                    const int gg = 8 * u.pn + 4 * bj + wc, kind = gg % 6;
                    f32x4 v0 = acc[ai][bj][m][0] * rstd, v1 = acc[ai][bj][m][1] * rstd;
                    if (kind >= 4) {
                        const int pos = (kind == 4) ? grow : gcol;
                        const f32x4 t0 = *(const f32x4*)(rope + (size_t)(pos * 16 + 4 * fq) * 2), t1 = *(const f32x4*)(rope + (size_t)(pos * 16 + 4 * fq) * 2 + 4);
                        const float c0 = t0[0], s0 = t0[1], c1 = t0[2], s1 = t0[3], c2 = t1[0], s2 = t1[1], c3 = t1[2], s3 = t1[3];
                        f32x4 o0, o1;
                        o0[0] = v0[0] * c0 - v1[0] * s0; o1[0] = v0[0] * s0 + v1[0] * c0;
                        o0[1] = v0[1] * c1 - v1[1] * s1; o1[1] = v0[1] * s1 + v1[1] * c1;
                        o0[2] = v0[2] * c2 - v1[2] * s2; o1[2] = v0[2] * s2 + v1[2] * c2;
                        o0[3] = v0[3] * c3 - v1[3] * s3; o1[3] = v0[3] * s3 + v1[3] * c3;
                        v0 = o0; v1 = o1;
                    }
                    unsigned char* p = Q8 + (size_t)row * 3072 + u.pn * BM + bj * HALF + wc * 32 + 4 * fq;
                    *(unsigned*)p = pk4_fp8(v0[0], v0[1], v0[2], v0[3]); *(unsigned*)(p + 16) = pk4_fp8(v1[0], v1[1], v1[2], v1[3]);
                }
            }
    }
};
struct EpiKV8 {
    static constexpr bool PERM = true;
    unsigned char* K8; unsigned char* VT8; const float* rs;
    __device__ __forceinline__ void operator()(const f32x4 (&acc)[2][2][4][2], const Unit& u, int wr, int wc, int fr, int fq) const {
        const int c0 = wc * 32 + 8 * fq, h = u.pn;
#pragma unroll
        for (int ai = 0; ai < 2; ++ai)
#pragma unroll
            for (int m = 0; m < 4; ++m) {
                const int row = u.pm * BM + ai * HALF + wr * 64 + m * 16 + fr;
                const float rstd = rs[2 * row + 1];
                { const f32x4 v0 = acc[ai][0][m][0] * rstd, v1 = acc[ai][0][m][1] * rstd;
                  u32x2 w; w.x = pk4_fp8(v0[0], v0[1], v0[2], v0[3]); w.y = pk4_fp8(v1[0], v1[1], v1[2], v1[3]);
                  *(u32x2*)(K8 + ((size_t)row * 16 + h) * 192 + c0) = w; }
                { const f32x4 v0 = acc[ai][1][m][0] * rstd, v1 = acc[ai][1][m][1] * rstd;
                  const unsigned w0 = pk4_fp8(v0[0], v0[1], v0[2], v0[3]), w1 = pk4_fp8(v1[0], v1[1], v1[2], v1[3]);
                  unsigned char* vp = VT8 + ((size_t)((row >> 13) * 16 + h) * 128 + c0) * 8192 + (row & 8191);
                  vp[0] = (unsigned char)(w0 & 0xff); vp[8192] = (unsigned char)((w0 >> 8) & 0xff); vp[2 * 8192] = (unsigned char)((w0 >> 16) & 0xff); vp[3 * 8192] = (unsigned char)(w0 >> 24);
                  vp[4 * 8192] = (unsigned char)(w1 & 0xff); vp[5 * 8192] = (unsigned char)((w1 >> 8) & 0xff); vp[6 * 8192] = (unsigned char)((w1 >> 16) & 0xff); vp[7 * 8192] = (unsigned char)(w1 >> 24); }
            }
    }
};

template <bool FIRST> struct EpiGate {
    static constexpr bool PERM = true;
    const bf16_t* G; bf16_t* MRG; unsigned char* M8; float ascale, oscale;
    __device__ __forceinline__ void operator()(const f32x4 (&acc)[2][2][4][2], const Unit& u, int wr, int wc, int fr, int fq) const {
        const int col0 = u.pn * BM + wc * 32 + 8 * fq;
#pragma unroll
        for (int ai = 0; ai < 2; ++ai)
#pragma unroll
            for (int m = 0; m < 4; ++m) {
                const int row = u.pm * BM + ai * HALF + wr * 64 + m * 16 + fr;
#pragma unroll
                for (int bj = 0; bj < 2; ++bj) {
                    const int col = col0 + bj * HALF;
                    const u32x4 gw = *(const u32x4*)(G + (size_t)row * 8192 + (FIRST ? 0 : 4096) + col);
                    f32x4 v0 = acc[ai][bj][m][0] * ascale, v1 = acc[ai][bj][m][1] * ascale;
                    v0[0] *= bf_lo(gw.x); v0[1] *= bf_hi(gw.x); v0[2] *= bf_lo(gw.y); v0[3] *= bf_hi(gw.y);
                    v1[0] *= bf_lo(gw.z); v1[1] *= bf_hi(gw.z); v1[2] *= bf_lo(gw.w); v1[3] *= bf_hi(gw.w);
                    bf16_t* p = MRG + (size_t)row * 4096 + col;
                    if (!FIRST) { const u32x4 pw = *(const u32x4*)p;
                        v0[0] += bf_lo(pw.x); v0[1] += bf_hi(pw.x); v0[2] += bf_lo(pw.y); v0[3] += bf_hi(pw.y);
                        v1[0] += bf_lo(pw.z); v1[1] += bf_hi(pw.z); v1[2] += bf_lo(pw.w); v1[3] += bf_hi(pw.w); }
                    if constexpr (FIRST) { u32x4 w; w.x = cvt_pk_bf16(v0[0], v0[1]); w.y = cvt_pk_bf16(v0[2], v0[3]); w.z = cvt_pk_bf16(v1[0], v1[1]); w.w = cvt_pk_bf16(v1[2], v1[3]);
                        *(u32x4*)p = w; }
                    else { v0 = v0 * oscale; v1 = v1 * oscale; u32x2 w; w.x = pk4_fp8(v0[0], v0[1], v0[2], v0[3]); w.y = pk4_fp8(v1[0], v1[1], v1[2], v1[3]);
                        *(u32x2*)(M8 + (size_t)row * 4096 + col) = w; }
                }
            }
    }
};

struct EpiF32 {
    static constexpr bool PERM = false;
    const float* base; float* out; int ldc; float ascale;
    __device__ __forceinline__ void operator()(const f32x4 (&acc)[2][2][4][2], const Unit& u, int wr, int wc, int fr, int fq) const {
        const int col0 = u.pn * BM + wc * 32 + 4 * fq;
#pragma unroll
        for (int ai = 0; ai < 2; ++ai)
#pragma unroll
            for (int m = 0; m < 4; ++m) { const size_t off = (size_t)(u.pm * BM + ai * HALF + wr * 64 + m * 16 + fr) * ldc + col0;
#pragma unroll
                for (int bj = 0; bj < 2; ++bj)
#pragma unroll
                    for (int n = 0; n < 2; ++n) { f32x4 o = acc[ai][bj][m][n] * ascale; if (base) o = o + *(const f32x4*)(base + off + bj * HALF + n * 16); *(f32x4*)(out + off + bj * HALF + n * 16) = o; } }
    }
};
}

namespace att {
using bf16x8 = __attribute__((ext_vector_type(8))) short;
using s16x4  = __attribute__((ext_vector_type(4))) short;
using f32x16 = __attribute__((ext_vector_type(16))) float;
using u32x4  = __attribute__((ext_vector_type(4))) unsigned;
typedef unsigned short bf16_t;
constexpr int NW = 8, QBLK = 32, KVBLK = 64, SEQ = 8192, NHEAD = 16;
constexpr int SHM_V = KVBLK * 128 * 2, SHM_KN = KVBLK * 128 * 2, SHM_KR = KVBLK * 64 * 2;
constexpr int OFF_V = 0, OFF_KN = 2 * SHM_V, OFF_KR = OFF_KN + 2 * SHM_KN, OFF_WS = OFF_KR + 2 * SHM_KR, OFF_BIAS = OFF_WS + NW * 64 * 4, OFF_QR = OFF_BIAS + 2048, ATT_LDS_BYTES = OFF_QR + NW * 4096;
#define KSWZ(row, colB) ((row) * 256 + ((colB) ^ (((row) & 7) << 4)))
#define KRSWZ(row, chunk) ((row) * 128 + ((((chunk) ^ (((row) >> 1) & 7))) << 4))
#define ASBAR() __builtin_amdgcn_sched_barrier(0)
__device__ __forceinline__ int crow(int r, int hi) { return (r & 3) + 8 * (r >> 2) + 4 * hi; }
__device__ __forceinline__ unsigned cvtpk(float lo, float hi) { unsigned r; asm volatile("v_cvt_pk_bf16_f32 %0, %1, %2" : "=v"(r) : "v"(lo), "v"(hi)); return r; }
__device__ __forceinline__ bf16x8 ld8(const bf16_t* p) { return *reinterpret_cast<const bf16x8*>(p); }

constexpr float THR2 = 11.5f;
__device__ __forceinline__ void partialSM(f32x16& p0, f32x16& p1, float& m_reg, float& mn, float& alpha) {
  float pmax = p0[0];
#pragma unroll
  for (int r = 1; r < 16; ++r) pmax = fmaxf(pmax, p0[r]);
#pragma unroll
  for (int r = 0; r < 16; ++r) pmax = fmaxf(pmax, p1[r]);
  { auto rr = __builtin_amdgcn_permlane32_swap(__float_as_uint(pmax), __float_as_uint(pmax), false, false);
    pmax = fmaxf(__uint_as_float(rr[0]), __uint_as_float(rr[1])); }
  if (__builtin_expect(__all(pmax - m_reg <= THR2), 1)) { mn = m_reg; alpha = 1.f; }
  else { mn = fmaxf(m_reg, pmax); alpha = __builtin_amdgcn_exp2f(m_reg - mn); m_reg = mn; }
#pragma unroll
  for (int r = 0; r < 16; ++r) p0[r] = p0[r] - mn;
#pragma unroll
  for (int r = 0; r < 16; ++r) p1[r] = p1[r] - mn;
#pragma unroll
  for (int r = 0; r < 16; ++r) p0[r] = __builtin_amdgcn_exp2f(p0[r]);
}
__device__ __forceinline__ void finishSM(f32x16& p0, f32x16& p1, float alpha, float& l_reg, bf16x8& pa0, bf16x8& pa1, bf16x8& pa2, bf16x8& pa3) {
#pragma unroll
  for (int r = 0; r < 16; ++r) p1[r] = __builtin_amdgcn_exp2f(p1[r]);
  float ps = 0;
#pragma unroll
  for (int r = 0; r < 16; ++r) ps += p0[r];
#pragma unroll
  for (int r = 0; r < 16; ++r) ps += p1[r];
  { auto rr = __builtin_amdgcn_permlane32_swap(__float_as_uint(ps), __float_as_uint(ps), false, false);
    ps = __uint_as_float(rr[0]) + __uint_as_float(rr[1]); }
  l_reg = l_reg * alpha + ps;
#define PK4(P, BASE, OUT) do { unsigned a0 = cvtpk(P[BASE + 0], P[BASE + 1]), a1 = cvtpk(P[BASE + 2], P[BASE + 3]);   \
    unsigned b0 = cvtpk(P[BASE + 4], P[BASE + 5]), b1 = cvtpk(P[BASE + 6], P[BASE + 7]);                              \
    auto r0 = __builtin_amdgcn_permlane32_swap(a0, b0, false, false); auto r1 = __builtin_amdgcn_permlane32_swap(a1, b1, false, false); \
    u32x4 w = {r0[0], r1[0], r0[1], r1[1]}; OUT = *reinterpret_cast<bf16x8*>(&w); } while (0)
  PK4(p0, 0, pa0); PK4(p0, 8, pa1); PK4(p1, 0, pa2); PK4(p1, 8, pa3);
}
__device__ __forceinline__ int v_st(int k, int c) { const int kk = (k & ~0xC) | ((k & 4) << 1) | ((k & 8) >> 1); return ((kk >> 3) * 4 + (c >> 5)) * 512 + ((kk & 7) * 32 + (c & 31)) * 2; }
__device__ __forceinline__ int v_rd_base(int lane) { return ((lane & 3) << 3) | (((lane >> 2) & 3) << 6) | (((lane >> 4) & 1) << 5) | (((lane >> 5) & 1) << 8); }
constexpr int v_rd_off(int d0, int ks, int half) { return d0 * 512 + ks * 4096 + half * 2048; }
template <int OFF> __device__ __forceinline__ s16x4 tr_read(int vb) {
  s16x4 r; asm volatile("ds_read_b64_tr_b16 %0, %1 offset:%2" : "=&v"(r) : "v"(vb), "i"(OFF) : "memory"); return r;
}
template <int D0> __device__ __forceinline__ void pv_one(f32x16& od, int vb, bf16x8 pa0, bf16x8 pa1, bf16x8 pa2, bf16x8 pa3) {
  const s16x4 l0 = tr_read<v_rd_off(D0, 0, 0)>(vb), h0 = tr_read<v_rd_off(D0, 0, 1)>(vb), l1 = tr_read<v_rd_off(D0, 1, 0)>(vb), h1 = tr_read<v_rd_off(D0, 1, 1)>(vb);
  const s16x4 l2 = tr_read<v_rd_off(D0, 2, 0)>(vb), h2 = tr_read<v_rd_off(D0, 2, 1)>(vb), l3 = tr_read<v_rd_off(D0, 3, 0)>(vb), h3 = tr_read<v_rd_off(D0, 3, 1)>(vb);
  asm volatile("s_waitcnt lgkmcnt(0)" ::: "memory"); ASBAR();
#define PKV(L, H) (bf16x8){L[0], L[1], L[2], L[3], H[0], H[1], H[2], H[3]}
  od = __builtin_amdgcn_mfma_f32_32x32x16_bf16(pa0, PKV(l0, h0), od, 0, 0, 0);
  od = __builtin_amdgcn_mfma_f32_32x32x16_bf16(pa1, PKV(l1, h1), od, 0, 0, 0);
  od = __builtin_amdgcn_mfma_f32_32x32x16_bf16(pa2, PKV(l2, h2), od, 0, 0, 0);
  od = __builtin_amdgcn_mfma_f32_32x32x16_bf16(pa3, PKV(l3, h3), od, 0, 0, 0);
#undef PKV
}
__device__ __forceinline__ void pv_d0(f32x16* o, int vb, bf16x8 pa0, bf16x8 pa1, bf16x8 pa2, bf16x8 pa3) {
  pv_one<0>(o[0], vb, pa0, pa1, pa2, pa3); pv_one<1>(o[1], vb, pa0, pa1, pa2, pa3); pv_one<2>(o[2], vb, pa0, pa1, pa2, pa3); pv_one<3>(o[3], vb, pa0, pa1, pa2, pa3);
}
template <int NROPE> __device__ __forceinline__ void qkt(f32x16& p0, f32x16& p1, const char* Kn, const char* Kr, const bf16x8* qr, const char* qrl, int r32, int hi) {
  p0 = f32x16{}; p1 = f32x16{};
#pragma unroll
  for (int d0 = 0; d0 < 8; ++d0) { const int cb = (d0 * 16 + hi * 8) * 2;
    const bf16x8 b0 = *reinterpret_cast<const bf16x8*>(Kn + KSWZ(r32, cb));
    const bf16x8 b1 = *reinterpret_cast<const bf16x8*>(Kn + KSWZ(32 + r32, cb));
    p0 = __builtin_amdgcn_mfma_f32_32x32x16_bf16(b0, qr[d0], p0, 0, 0, 0);
    p1 = __builtin_amdgcn_mfma_f32_32x32x16_bf16(b1, qr[d0], p1, 0, 0, 0); }
#pragma unroll
  for (int d0 = 0; d0 < NROPE; ++d0) { const int ch = d0 * 2 + hi;
    const bf16x8 b0 = *reinterpret_cast<const bf16x8*>(Kr + KRSWZ(r32, ch));
    const bf16x8 b1 = *reinterpret_cast<const bf16x8*>(Kr + KRSWZ(32 + r32, ch));
    const bf16x8 qf = *reinterpret_cast<const bf16x8*>(qrl + d0 * 1024);
    p0 = __builtin_amdgcn_mfma_f32_32x32x16_bf16(b0, qf, p0, 0, 0, 0);
    p1 = __builtin_amdgcn_mfma_f32_32x32x16_bf16(b1, qf, p1, 0, 0, 0); }
}

__device__ __forceinline__ void mla_unit(int b, int h, int qb, const bf16_t* __restrict__ Q, const bf16_t* __restrict__ KN, const bf16_t* __restrict__ KR, const bf16_t* __restrict__ VM, unsigned char* __restrict__ O, float oscale, char* lds) {
  int tid_ = threadIdx.x; asm volatile("" : "+v"(tid_));
  const int tid = tid_, wid = tid >> 6, lane = tid & 63, r32 = lane & 31, hi = lane >> 5;
  char* V_lds = lds + OFF_V; char* Kn_lds = lds + OFF_KN; char* Kr_lds = lds + OFF_KR;
  float* ws = (float*)(lds + OFF_WS) + wid * 64; float* li_l = ws; float* al_l = ws + 32;
  float m_reg = -1e30f, l_reg = 0; f32x16 o[4] = {}; bf16x8 qr[8];
  char* qrl = lds + OFF_QR + wid * 4096 + (hi * 32 + r32) * 16;
  const long rowbase = (long)b * SEQ;
  const bf16_t* Qw = Q + (rowbase + qb * 256 + wid * QBLK + r32) * 3072 + h * 192 + hi * 8;
#pragma unroll
  for (int d0 = 0; d0 < 8; ++d0) qr[d0] = ld8(Qw + d0 * 16);
  const bf16_t* Kh = KN + rowbase * 2048 + h * 128; const bf16_t* Vh = VM + rowbase * 2048 + h * 128; const bf16_t* Krb = KR + rowbase * 64;
  const int sr = tid >> 4, sc = (tid & 15) * 8, vst0 = v_st(sr, sc), vst1 = v_st(32 + sr, sc);
  const int krr = tid >> 3, krc = tid & 7;
  const int vb0 = (int)(uintptr_t)V_lds + v_rd_base(lane);
  struct { bf16x8 vs0, vs1, ks0, ks1, kr0; } sr_[1];
#define SLOAD(i, k0) do { sr_[i].vs0 = ld8(&Vh[(long)((k0) + sr) * 2048 + sc]); sr_[i].vs1 = ld8(&Vh[(long)((k0) + 32 + sr) * 2048 + sc]); \
    sr_[i].ks0 = ld8(&Kh[(long)((k0) + sr) * 2048 + sc]); sr_[i].ks1 = ld8(&Kh[(long)((k0) + 32 + sr) * 2048 + sc]); sr_[i].kr0 = ld8(&Krb[(long)((k0) + krr) * 64 + krc * 8]); } while (0)
#define SWRITE(bb, i) do { *(bf16x8*)(V_lds + (bb) * SHM_V + vst0) = sr_[i].vs0; *(bf16x8*)(V_lds + (bb) * SHM_V + vst1) = sr_[i].vs1; const int kc = sc * 2; \
    *(bf16x8*)(Kn_lds + (bb) * SHM_KN + KSWZ(sr, kc)) = sr_[i].ks0; *(bf16x8*)(Kn_lds + (bb) * SHM_KN + KSWZ(32 + sr, kc)) = sr_[i].ks1; \
    *(bf16x8*)(Kr_lds + (bb) * SHM_KR + KRSWZ(krr, krc)) = sr_[i].kr0; } while (0)
#define SWAIT() asm volatile("s_waitcnt vmcnt(0)" ::: "memory")
#define RESC(a) do { if (__any((a) < 1.f)) { if (hi == 0) al_l[r32] = (a); asm volatile("s_waitcnt lgkmcnt(0)" ::: "memory"); \
    _Pragma("unroll") for (int d = 0; d < 4; ++d) _Pragma("unroll") for (int r = 0; r < 16; ++r) o[d][r] *= al_l[crow(r, hi)]; } } while (0)
  f32x16 pA0, pA1, pB0, pB1; float mnA, mnB, alA, alB; bf16x8 pa0, pa1, pa2, pa3; const int NT = SEQ / KVBLK;
  constexpr int SE = 0, SO = 0;
  __syncthreads();
#pragma unroll
  for (int d0 = 0; d0 < 4; ++d0) *(bf16x8*)(qrl + d0 * 1024) = ld8(Qw + (8 + d0) * 16);
  SLOAD(SE, 0); asm volatile("s_waitcnt vmcnt(0)" ::: "memory"); SWRITE(0, SE); __syncthreads();
  qkt<4>(pA0, pA1, Kn_lds, Kr_lds, qr, qrl, r32, hi); partialSM(pA0, pA1, m_reg, mnA, alA);
  SLOAD(SO, KVBLK);
  SWAIT(); SWRITE(1, SO); __syncthreads();
  for (int j = 1; j + 1 < NT; j += 2) {
    ASBAR(); qkt<4>(pB0, pB1, Kn_lds + SHM_KN, Kr_lds + SHM_KR, qr, qrl, r32, hi);
    finishSM(pA0, pA1, alA, l_reg, pa0, pa1, pa2, pa3); ASBAR();
    SLOAD(SE, (j + 1) * KVBLK); ASBAR();
    pv_d0(o, vb0, pa0, pa1, pa2, pa3); partialSM(pB0, pB1, m_reg, mnB, alB);
    __syncthreads(); SWAIT(); SWRITE(0, SE);
    RESC(alB); __syncthreads();
    ASBAR(); qkt<4>(pA0, pA1, Kn_lds, Kr_lds, qr, qrl, r32, hi);
    finishSM(pB0, pB1, alB, l_reg, pa0, pa1, pa2, pa3); ASBAR();
    SLOAD(SO, (j + 2) * KVBLK); ASBAR();
    pv_d0(o, vb0 + SHM_V, pa0, pa1, pa2, pa3); partialSM(pA0, pA1, m_reg, mnA, alA);
    __syncthreads(); SWAIT(); SWRITE(1, SO);
    RESC(alA); __syncthreads();
  }
  ASBAR(); qkt<4>(pB0, pB1, Kn_lds + SHM_KN, Kr_lds + SHM_KR, qr, qrl, r32, hi);
  finishSM(pA0, pA1, alA, l_reg, pa0, pa1, pa2, pa3); ASBAR();
  pv_d0(o, vb0, pa0, pa1, pa2, pa3); partialSM(pB0, pB1, m_reg, mnB, alB);
  __syncthreads(); RESC(alB);
  finishSM(pB0, pB1, alB, l_reg, pa0, pa1, pa2, pa3); ASBAR();
  pv_d0(o, vb0 + SHM_V, pa0, pa1, pa2, pa3);
  if (hi == 0) li_l[r32] = l_reg; asm volatile("s_waitcnt lgkmcnt(0)" ::: "memory");
  float rli[16];
#pragma unroll
  for (int r = 0; r < 16; ++r) rli[r] = __builtin_amdgcn_rcpf(li_l[crow(r, hi)]) * oscale;
  unsigned char* Ow = O + (rowbase + qb * 256 + wid * QBLK) * 2048 + h * 128;
#pragma unroll
  for (int r = 0; r < 16; ++r) { const int orow = crow(r, hi);
#pragma unroll
    for (int d0 = 0; d0 < 4; ++d0) Ow[(long)orow * 2048 + d0 * 32 + r32] = (unsigned char)(__builtin_amdgcn_cvt_pk_fp8_f32(o[d0][r] * rli[r], 0.f, 0, false) & 0xff); }
#undef SLOAD
#undef SWRITE
#undef SWAIT
#undef RESC
}

__device__ __forceinline__ void na_unit(int b, int h, int rg, const bf16_t* __restrict__ Q, const bf16_t* __restrict__ K, const bf16_t* __restrict__ V, const float* __restrict__ rpb, unsigned char* __restrict__ O, float oscale, char* lds) {
  int tid_ = threadIdx.x; asm volatile("" : "+v"(tid_));
  const int tid = tid_, wid = tid >> 6, lane = tid & 63, r32 = lane & 31, hi = lane >> 5;
  char* V_lds = lds + OFF_V; char* Kn_lds = lds + OFF_KN;
  float* ws = (float*)(lds + OFF_WS) + wid * 64; float* li_l = ws; float* al_l = ws + 32;
  float* bias_l = (float*)(lds + OFF_BIAS);
  const int r0 = rg * 4, rq = r0 + (wid >> 1), cq = 32 * (wid & 1) + r32;
  const int rs_w = min(max(rq - 4, 0), 120), cs = min(max(cq - 8, 0), 48);
  const int kr_lo = min(max(r0 - 4, 0), 120), kr_hi = min(max(r0 + 3 - 4, 0), 120) + 7, NT = kr_hi - kr_lo + 1;
  const long rowbase = (long)b * SEQ;
  float m_reg = -1e30f, l_reg = 0; f32x16 o[4] = {}; bf16x8 qr[8];
  const bf16_t* Qw = Q + (rowbase + rq * 64 + cq) * 2048 + h * 128 + hi * 8;
#pragma unroll
  for (int d0 = 0; d0 < 8; ++d0) qr[d0] = ld8(Qw + d0 * 16);
  const bf16_t* Kh = K + rowbase * 2048 + h * 128; const bf16_t* Vh = V + rowbase * 2048 + h * 128;
  const int sr = tid >> 4, sc = (tid & 15) * 8, vst0 = v_st(sr, sc), vst1 = v_st(32 + sr, sc);
  const int vb0 = (int)(uintptr_t)V_lds + v_rd_base(lane);
  __syncthreads();
  if (tid < 465) bias_l[tid] = rpb[h * 465 + tid] * 1.4426950408889634f;
  bf16x8 vs0, vs1, ks0, ks1;
#define NLOAD(k0) do { vs0 = ld8(&Vh[(long)((k0) + sr) * 2048 + sc]); vs1 = ld8(&Vh[(long)((k0) + 32 + sr) * 2048 + sc]); \
    ks0 = ld8(&Kh[(long)((k0) + sr) * 2048 + sc]); ks1 = ld8(&Kh[(long)((k0) + 32 + sr) * 2048 + sc]); } while (0)
#define NWRITE(bb) do { *(bf16x8*)(V_lds + (bb) * SHM_V + vst0) = vs0; *(bf16x8*)(V_lds + (bb) * SHM_V + vst1) = vs1; const int kc = sc * 2; \
    *(bf16x8*)(Kn_lds + (bb) * SHM_KN + KSWZ(sr, kc)) = ks0; *(bf16x8*)(Kn_lds + (bb) * SHM_KN + KSWZ(32 + sr, kc)) = ks1; } while (0)
  NLOAD(kr_lo * 64);
  for (int i = 0; i < NT; ++i) {
    const int kr = kr_lo + i, bb = i & 1;
    NWRITE(bb);
    if (i + 1 < NT) NLOAD((kr + 1) * 64);
    __syncthreads();
    if (kr >= rs_w && kr < rs_w + 8) {
      f32x16 p0, p1;
      qkt<0>(p0, p1, Kn_lds + bb * SHM_KN, nullptr, qr, nullptr, r32, hi);
      const float* brow = bias_l + (kr - rq + 7) * 31 + 15 - cq;
      float pmax = -1e30f;
#pragma unroll
      for (int r = 0; r < 16; ++r) { const int k0 = crow(r, hi), k1 = 32 + k0;
        const bool v0 = (k0 >= cs) && (k0 < cs + 16), v1 = (k1 >= cs) && (k1 < cs + 16);
        const float b0 = brow[v0 ? k0 : cq], b1 = brow[v1 ? k1 : cq];
        p0[r] = v0 ? p0[r] + b0 : -1e30f; p1[r] = v1 ? p1[r] + b1 : -1e30f;
        pmax = fmaxf(pmax, fmaxf(p0[r], p1[r])); }
      { auto rr = __builtin_amdgcn_permlane32_swap(__float_as_uint(pmax), __float_as_uint(pmax), false, false);
        pmax = fmaxf(__uint_as_float(rr[0]), __uint_as_float(rr[1])); }
      const float mn = fmaxf(m_reg, pmax), alpha = __builtin_amdgcn_exp2f(m_reg - mn); m_reg = mn;
#pragma unroll
      for (int r = 0; r < 16; ++r) { p0[r] = __builtin_amdgcn_exp2f(p0[r] - mn); p1[r] = __builtin_amdgcn_exp2f(p1[r] - mn); }
      float ps = 0;
#pragma unroll
      for (int r = 0; r < 16; ++r) ps += p0[r] + p1[r];
      { auto rr = __builtin_amdgcn_permlane32_swap(__float_as_uint(ps), __float_as_uint(ps), false, false);
        ps = __uint_as_float(rr[0]) + __uint_as_float(rr[1]); }
      l_reg = l_reg * alpha + ps;
      if (hi == 0) al_l[r32] = alpha; asm volatile("s_waitcnt lgkmcnt(0)" ::: "memory");
#pragma unroll
      for (int d = 0; d < 4; ++d)
#pragma unroll
        for (int r = 0; r < 16; ++r) o[d][r] *= al_l[crow(r, hi)];
      bf16x8 pa0, pa1, pa2, pa3;
      PK4(p0, 0, pa0); PK4(p0, 8, pa1); PK4(p1, 0, pa2); PK4(p1, 8, pa3);
      pv_d0(o, vb0 + bb * SHM_V, pa0, pa1, pa2, pa3);
    }
  }
  if (hi == 0) li_l[r32] = l_reg; asm volatile("s_waitcnt lgkmcnt(0)" ::: "memory");
  float rli[16];
#pragma unroll
  for (int r = 0; r < 16; ++r) rli[r] = __builtin_amdgcn_rcpf(li_l[crow(r, hi)]) * oscale;
  unsigned char* Ow = O + (rowbase + rq * 64 + 32 * (wid & 1)) * 2048 + h * 128;
#pragma unroll
  for (int r = 0; r < 16; ++r) { const int orow = crow(r, hi);
#pragma unroll
    for (int d0 = 0; d0 < 4; ++d0) Ow[(long)orow * 2048 + d0 * 32 + r32] = (unsigned char)(__builtin_amdgcn_cvt_pk_fp8_f32(o[d0][r] * rli[r], 0.f, 0, false) & 0xff); }
#undef NLOAD
#undef NWRITE
}
#undef PK4
}

namespace att8 {
using f32x16 = __attribute__((ext_vector_type(16))) float;
using u32x4  = __attribute__((ext_vector_type(4))) unsigned;
using v8i    = __attribute__((ext_vector_type(8))) int;
using v4i    = __attribute__((ext_vector_type(4))) int;
constexpr int SEQ = 8192, KVBLK = 64, KT_BYTES = 12288, VT_BYTES = 8192, NSLOT = 3;
constexpr int OFF_K = 0, OFF_V = NSLOT * KT_BYTES, OFF_WS = OFF_V + NSLOT * VT_BYTES, LDS_BYTES = OFF_WS + 2048;
constexpr float SQ8 = 16.0f;
constexpr float PSH = 6.0f;
constexpr float THR8 = 2.0f;
__device__ __forceinline__ int crow(int r, int hi) { return (r & 3) + 8 * (r >> 2) + 4 * hi; }
__device__ __forceinline__ void glds16(const void* gsrc, unsigned lds_dst) { unsigned keep;
  asm volatile("s_mov_b32 %0, m0\n\ts_mov_b32 m0, %2\n\ts_nop 0\n\tglobal_load_lds_dwordx4 %1, off\n\ts_mov_b32 m0, %0" : "=&s"(keep) : "v"(gsrc), "s"(lds_dst) : "memory"); }
__device__ __forceinline__ void mfma64(f32x16& acc, const v8i& a, const v8i& b) { asm volatile("s_nop 3\n\tv_mfma_f32_32x32x64_f8f6f4 %0, %1, %2, %0" : "+v"(acc) : "v"(a), "v"(b)); }
#define MFMA_DRAIN2(X, Y) asm volatile("s_nop 15\n\ts_nop 7" : "+v"(X), "+v"(Y))
#define MFMA_DRAIN4(A, B, C_, D) asm volatile("s_nop 15\n\ts_nop 7" : "+v"(A), "+v"(B), "+v"(C_), "+v"(D))
__device__ __forceinline__ v8i ld32(const char* p0, const char* p1) { const v4i a = *reinterpret_cast<const v4i*>(p0), b = *reinterpret_cast<const v4i*>(p1); return __builtin_shufflevector(a, b, 0, 1, 2, 3, 4, 5, 6, 7); }
__device__ __forceinline__ unsigned pk4(float a, float b, float c, float d) { int w = __builtin_amdgcn_cvt_pk_fp8_f32(a, b, 0, false); w = __builtin_amdgcn_cvt_pk_fp8_f32(c, d, w, true); return (unsigned)w; }

__device__ __forceinline__ void mla8_unit(int b, int h, int qb, const unsigned char* __restrict__ Q8, const unsigned char* __restrict__ K8, const unsigned char* __restrict__ VT8, unsigned char* __restrict__ O8, float oscale, char* lds) {
  int tid_ = threadIdx.x; asm volatile("" : "+v"(tid_));
  const int tid = tid_, lane = tid & 63, r32 = lane & 31, hi = lane >> 5; const int wid = __builtin_amdgcn_readfirstlane(tid >> 6);
  float* ws = (float*)(lds + OFF_WS) + wid * 64; float* li_l = ws; float* al_l = ws + 32;
  const unsigned lds0 = (unsigned)(uintptr_t)lds;
  const long rowbase = (long)b * SEQ;
  constexpr float C = 1.0f / SQ8;
  const int l4 = lane >> 2, pc = lane & 3;
  const unsigned char* src0; const unsigned char* src1; const unsigned char* src2; unsigned dst0, dst1, dst2;
  { auto piece = [&](int id, const unsigned char*& src, unsigned& dst) {
      if (id < 12) { const int ks = id >> 2, rb = id & 3, i = 16 * rb + l4, key = 32 * ((i >> 2) & 1) + 16 * (i >> 5) + (i & 3) + 4 * ((i & 31) >> 3), c = pc ^ ((i >> 2) & 3);
        src = K8 + ((size_t)(rowbase + key) * 16 + h) * 192 + 64 * ks + 16 * c; dst = OFF_K + ks * 4096 + rb * 1024; }
      else { const int vid = id - 12, dblk = vid >> 1, hb = vid & 1, d = 32 * dblk + 16 * hb + l4, c = pc ^ ((d >> 2) & 3);
        src = VT8 + ((size_t)(b * 16 + h) * 128 + d) * SEQ + 16 * c; dst = OFF_V + dblk * 2048 + hb * 1024; } };
    piece(wid, src0, dst0); piece(wid + 8, src1, dst1); piece(wid < 4 ? wid + 16 : wid + 8, src2, dst2); }
  const size_t kstepK = (size_t)KVBLK * 16 * 192, kstepV = KVBLK;
  const size_t st0 = (wid < 8) ? kstepK : kstepV, st1 = (wid + 8 < 12) ? kstepK : kstepV, st2 = kstepV;
  const unsigned sl0 = (wid < 8) ? KT_BYTES : VT_BYTES, sl1 = (wid + 8 < 12) ? KT_BYTES : VT_BYTES, sl2 = VT_BYTES;
#define DMA_TILE(t, slot) do { glds16(src0 + (size_t)(t) * st0, (unsigned)__builtin_amdgcn_readfirstlane(lds0 + dst0 + (slot) * sl0)); \
    glds16(src1 + (size_t)(t) * st1, (unsigned)__builtin_amdgcn_readfirstlane(lds0 + dst1 + (slot) * sl1)); \
    if (wid < 4) glds16(src2 + (size_t)(t) * st2, (unsigned)__builtin_amdgcn_readfirstlane(lds0 + dst2 + (slot) * sl2)); } while (0)
#define WAIT_TILES_BEHIND(n) do { if (wid < 4) { if ((n) == 2) asm volatile("s_waitcnt vmcnt(6)" ::: "memory"); else if ((n) == 1) asm volatile("s_waitcnt vmcnt(3)" ::: "memory"); else asm volatile("s_waitcnt vmcnt(0)" ::: "memory"); } \
    else { if ((n) == 2) asm volatile("s_waitcnt vmcnt(4)" ::: "memory"); else if ((n) == 1) asm volatile("s_waitcnt vmcnt(2)" ::: "memory"); else asm volatile("s_waitcnt vmcnt(0)" ::: "memory"); } } while (0)
  const int sw = (r32 >> 2) & 3;
  const int kA = r32 * 64 + (((2 * hi) ^ sw) << 4), kB = r32 * 64 + (((2 * hi + 1) ^ sw) << 4);
  __syncthreads();
  const int NT = SEQ / KVBLK;
  DMA_TILE(0, 0); DMA_TILE(1, 1);
  v8i qf[3];
  { const unsigned char* qp = Q8 + (size_t)(rowbase + qb * 256 + wid * 32 + r32) * 3072 + h * 192 + 32 * hi;
#pragma unroll
    for (int ks = 0; ks < 3; ++ks) qf[ks] = ld32((const char*)qp + 64 * ks, (const char*)qp + 64 * ks + 16); }
  asm volatile("" : "+v"(qf[0]), "+v"(qf[1]), "+v"(qf[2]));
  float m_reg = -1e30f, l_reg = 0.f; f32x16 o[4];
#pragma unroll
  for (int d = 0; d < 4; ++d) o[d] = f32x16{};
  int slot = 0, slot2 = 2;
#pragma unroll 1
  for (int t = 0; t < NT; ++t) {
    if (t + 2 < NT) { DMA_TILE(t + 2, slot2); WAIT_TILES_BEHIND(2); } else if (t + 1 < NT) { WAIT_TILES_BEHIND(1); } else { WAIT_TILES_BEHIND(0); }
    __builtin_amdgcn_s_barrier(); asm volatile("" ::: "memory");
    const char* Kt = lds + OFF_K + slot * KT_BYTES; const char* Vt = lds + OFF_V + slot * VT_BYTES;
    f32x16 p0 = f32x16{}, p1 = f32x16{};
#pragma unroll
    for (int ks = 0; ks < 3; ++ks) { const v8i a0 = ld32(Kt + ks * 4096 + kA, Kt + ks * 4096 + kB), a1 = ld32(Kt + ks * 4096 + 2048 + kA, Kt + ks * 4096 + 2048 + kB);
      mfma64(p0, a0, qf[ks]); mfma64(p1, a1, qf[ks]); }
    MFMA_DRAIN2(p0, p1);
    float pmax = p0[0];
#pragma unroll
    for (int r = 1; r < 16; ++r) pmax = fmaxf(pmax, p0[r]);
#pragma unroll
    for (int r = 0; r < 16; ++r) pmax = fmaxf(pmax, p1[r]);
    { auto rr = __builtin_amdgcn_permlane32_swap(__float_as_uint(pmax), __float_as_uint(pmax), false, false); pmax = fmaxf(__uint_as_float(rr[0]), __uint_as_float(rr[1])); }
    float alpha = 1.f;
    if (!__all((pmax - m_reg) * C <= THR8)) { const float mn = fmaxf(m_reg, pmax); alpha = __builtin_amdgcn_exp2f((m_reg - mn) * C); m_reg = mn;
      if (hi == 0) al_l[r32] = alpha; asm volatile("s_waitcnt lgkmcnt(0)" ::: "memory");
      MFMA_DRAIN4(o[0], o[1], o[2], o[3]);
#pragma unroll
      for (int d = 0; d < 4; ++d)
#pragma unroll
        for (int r = 0; r < 16; ++r) o[d][r] *= al_l[crow(r, hi)]; }
    const float mc = PSH - m_reg * C; float ps = 0.f;
#pragma unroll
    for (int r = 0; r < 16; ++r) { p0[r] = __builtin_amdgcn_exp2f(fmaf(p0[r], C, mc)); p1[r] = __builtin_amdgcn_exp2f(fmaf(p1[r], C, mc)); ps += p0[r] + p1[r]; }
    { auto rr = __builtin_amdgcn_permlane32_swap(__float_as_uint(ps), __float_as_uint(ps), false, false); ps = __uint_as_float(rr[0]) + __uint_as_float(rr[1]); }
    l_reg = l_reg * alpha + ps;
    v8i pa;
    pa[0] = (int)pk4(p0[0], p0[1], p0[2], p0[3]); pa[1] = (int)pk4(p0[4], p0[5], p0[6], p0[7]); pa[2] = (int)pk4(p0[8], p0[9], p0[10], p0[11]); pa[3] = (int)pk4(p0[12], p0[13], p0[14], p0[15]);
    pa[4] = (int)pk4(p1[0], p1[1], p1[2], p1[3]); pa[5] = (int)pk4(p1[4], p1[5], p1[6], p1[7]); pa[6] = (int)pk4(p1[8], p1[9], p1[10], p1[11]); pa[7] = (int)pk4(p1[12], p1[13], p1[14], p1[15]);
#pragma unroll
    for (int d = 0; d < 4; ++d) { const v8i vb = ld32(Vt + d * 2048 + kA, Vt + d * 2048 + kB); mfma64(o[d], pa, vb); }
    asm volatile("s_waitcnt lgkmcnt(0)" ::: "memory");
    __builtin_amdgcn_s_barrier(); asm volatile("" ::: "memory");
    slot2 = slot; slot = (slot == NSLOT - 1) ? 0 : slot + 1;
  }
  MFMA_DRAIN4(o[0], o[1], o[2], o[3]);
  if (hi == 0) li_l[r32] = l_reg; asm volatile("s_waitcnt lgkmcnt(0)" ::: "memory");
  float rli[16];
#pragma unroll
  for (int r = 0; r < 16; ++r) rli[r] = __builtin_amdgcn_rcpf(li_l[crow(r, hi)]) * oscale;
  unsigned char* Ow = O8 + (size_t)(rowbase + qb * 256 + wid * 32) * 2048 + h * 128;
#pragma unroll
  for (int r = 0; r < 16; ++r) { const int orow = crow(r, hi);
#pragma unroll
    for (int d0 = 0; d0 < 4; ++d0) Ow[(long)orow * 2048 + d0 * 32 + r32] = (unsigned char)(__builtin_amdgcn_cvt_pk_fp8_f32(o[d0][r] * rli[r], 0.f, 0, false) & 0xff); }
#undef DMA_TILE
#undef WAIT_TILES_BEHIND
#undef MFMA_DRAIN2
#undef MFMA_DRAIN4
}
}

namespace peer {
#define PLAS __attribute__((address_space(3)))
using bf16x8 = __attribute__((ext_vector_type(8))) short;
using bf16x2 = __attribute__((ext_vector_type(2))) __bf16;
using f32x16 = __attribute__((ext_vector_type(16))) float;
using f32x4  = __attribute__((ext_vector_type(4))) float;
using u32x4  = __attribute__((ext_vector_type(4))) unsigned;
typedef unsigned short bf16_t;
__device__ __forceinline__ int f2ord(float f) { const int u = __float_as_int(f); return u ^ ((u >> 31) & 0x7fffffff); }
__device__ __forceinline__ float ord2f(int s) { return __int_as_float(s ^ ((s >> 31) & 0x7fffffff)); }
__device__ __forceinline__ int crow(int r, int hi) { return (r & 3) + 8 * (r >> 2) + 4 * hi; }
__device__ __forceinline__ unsigned cvtpk(float lo, float hi) { unsigned r; asm volatile("v_cvt_pk_bf16_f32 %0, %1, %2" : "=v"(r) : "v"(lo), "v"(hi)); return r; }
__device__ __forceinline__ float bf_lo(unsigned w) { return __uint_as_float(w << 16); }
__device__ __forceinline__ float bf_hi(unsigned w) { return __uint_as_float(w & 0xffff0000u); }
__device__ __forceinline__ int swapmax(int m) { auto rr = __builtin_amdgcn_permlane32_swap((unsigned)m, (unsigned)m, false, false); const int a = (int)rr[0], b = (int)rr[1]; return a > b ? a : b; }

struct CandTab { int ci[50], cj[50]; };
constexpr CandTab make_cands() { CandTab t{}; int n = 0; for (int i = 0; i < 16; ++i) for (int j = 0; j < 16; ++j) if ((i + 1) * (j + 1) <= 16) { t.ci[n] = i; t.cj[n] = j; ++n; } return t; }
constexpr CandTab CT = make_cands();

constexpr int SEL_LDS_PER_WAVE = (2 * 16 + 16) * 64 * 4;

__device__ __forceinline__ void select32(int t0, int h, const float* __restrict__ QP, const bf16_t* __restrict__ SUBH, const bf16_t* __restrict__ SUBL, int* __restrict__ IDX, float* __restrict__ GATE, PLAS int* wl, int lane_) {
  int lane = lane_; asm volatile("" : "+v"(lane));
  const int r32 = lane & 31, hi = lane >> 5;
  PLAS int* topl = wl; PLAS int* winl = wl + 2 * 16 * 64;
  const float* qrow = QP + (size_t)(t0 + r32) * 2048;
  {
#pragma unroll 1
    for (int p = 0; p < 2; ++p) {
      bf16x8 qh[8], ql[8];
      const float* qp = qrow + h * 256 + p * 128 + hi * 8;
#pragma unroll
      for (int d0 = 0; d0 < 8; ++d0) {
        const f32x4 a = *(const f32x4*)(qp + d0 * 16), b = *(const f32x4*)(qp + d0 * 16 + 4);
        u32x4 wh, wlw;
        wh.x = cvtpk(a[0], a[1]); wh.y = cvtpk(a[2], a[3]); wh.z = cvtpk(b[0], b[1]); wh.w = cvtpk(b[2], b[3]);
        wlw.x = cvtpk(a[0] - bf_lo(wh.x), a[1] - bf_hi(wh.x)); wlw.y = cvtpk(a[2] - bf_lo(wh.y), a[3] - bf_hi(wh.y));
        wlw.z = cvtpk(b[0] - bf_lo(wh.z), b[1] - bf_hi(wh.z)); wlw.w = cvtpk(b[2] - bf_lo(wh.w), b[3] - bf_hi(wh.w));
        qh[d0] = *reinterpret_cast<bf16x8*>(&wh); ql[d0] = *reinterpret_cast<bf16x8*>(&wlw);
      }
      const size_t soff = ((size_t)(h * 2 + p) * 128 + r32) * 128 + hi * 8;
      int key[64];
#pragma unroll
      for (int kb = 0; kb < 4; ++kb) {
        f32x16 acc = f32x16{};
#pragma unroll
        for (int d0 = 0; d0 < 8; ++d0) {
          const bf16x8 ah = *reinterpret_cast<const bf16x8*>(SUBH + soff + (size_t)kb * 32 * 128 + d0 * 16);
          const bf16x8 al = *reinterpret_cast<const bf16x8*>(SUBL + soff + (size_t)kb * 32 * 128 + d0 * 16);
          acc = __builtin_amdgcn_mfma_f32_32x32x16_bf16(ah, qh[d0], acc, 0, 0, 0);
          acc = __builtin_amdgcn_mfma_f32_32x32x16_bf16(ah, ql[d0], acc, 0, 0, 0);
          acc = __builtin_amdgcn_mfma_f32_32x32x16_bf16(al, qh[d0], acc, 0, 0, 0);
        }
#pragma unroll
        for (int r = 0; r < 16; ++r) key[kb * 16 + r] = (f2ord(acc[r]) & ~127) | (kb * 32 + crow(r, hi));
      }
#pragma unroll 1
      for (int it = 0; it < 16; ++it) {
        int m = key[0];
#pragma unroll
        for (int i = 1; i < 64; ++i) m = key[i] > m ? key[i] : m;
        const int gm = swapmax(m);
        topl[(p * 16 + it) * 64 + lane] = gm;
#pragma unroll
        for (int i = 0; i < 64; ++i) key[i] = (key[i] == gm) ? (int)0x80000000 : key[i];
      }
    }
    int ck[25];
#pragma unroll
    for (int c = 0; c < 25; ++c) {
      const int i = hi ? CT.ci[2 * c + 1] : CT.ci[2 * c], j = hi ? CT.cj[2 * c + 1] : CT.cj[2 * c];
      const int k0 = topl[i * 64 + lane], k1 = topl[(16 + j) * 64 + lane];
      const float s = ord2f(k0 & ~127) + ord2f(k1 & ~127);
      ck[c] = (f2ord(s) & ~255) | (i << 4) | j;
    }
#pragma unroll 1
    for (int it = 0; it < 16; ++it) {
      int m = ck[0];
#pragma unroll
      for (int i = 1; i < 25; ++i) m = ck[i] > m ? ck[i] : m;
      const int gm = swapmax(m);
      winl[it * 64 + lane] = gm;
#pragma unroll
      for (int i = 0; i < 25; ++i) ck[i] = (ck[i] == gm) ? (int)0x80000000 : ck[i];
    }
    float e[16]; int wv[16]; float tot = 0.f;
    const float s0 = ord2f(winl[lane] & ~255);
#pragma unroll
    for (int k = 0; k < 16; ++k) { wv[k] = winl[k * 64 + lane]; e[k] = __builtin_amdgcn_exp2f((ord2f(wv[k] & ~255) - s0) * 1.4426950408889634f); tot += e[k]; }
    const float rtot = 1.0f / tot;
    int l2_ = lane_; asm volatile("" : "+v"(l2_));
    const size_t ob = (size_t)(t0 + (l2_ & 31)) * 128 + h * 16 + (l2_ >> 5) * 8;
#pragma unroll
    for (int k = 0; k < 8; ++k) {
      const int w = hi ? wv[8 + k] : wv[k]; const float ev = hi ? e[8 + k] : e[k];
      const int i = (w >> 4) & 15, j = w & 15;
      const int e0 = topl[i * 64 + lane] & 127, e1 = topl[(16 + j) * 64 + lane] & 127;
      IDX[ob + k] = e0 * 128 + e1; GATE[ob + k] = ev * rtot;
    }
  }
}

__device__ __forceinline__ float dot2(unsigned w, unsigned x, float acc) { return __builtin_amdgcn_fdot2_f32_bf16(__builtin_bit_cast(bf16x2, w), __builtin_bit_cast(bf16x2, x), acc, false); }
__device__ __forceinline__ float gelu_erf(float v) {
  const float av = fabsf(v), d = av * 0.2316418882f + 1.0f, t = __builtin_amdgcn_rcpf(d);
  float q = t * 0.5307027145f + (-0.7265760135f); q = q * t + 0.7107068705f; q = q * t + (-0.142248368f); q = q * t + 0.127414796f; q = q * t;
  const float e = __builtin_amdgcn_exp2f((v * v) * (-0.72134752044f));
  const float m = v * (q * e);
  return v < 0.f ? m : v - m;
}
__device__ __forceinline__ float wave_sum(float v) {
#pragma unroll
  for (int o = 1; o < 64; o <<= 1) v += __shfl_xor(v, o);
  return v;
}

typedef float f32x2 __attribute__((ext_vector_type(2)));
constexpr float USCALE = 64.0f, VSCALE = 4.0f;
__device__ __forceinline__ f32x2 fp8x2(unsigned w, bool hiword) { return hiword ? __builtin_amdgcn_cvt_pk_f32_fp8((int)w, true) : __builtin_amdgcn_cvt_pk_f32_fp8((int)w, false); }
template <bool STORE, bool FAKE = false> __device__ __forceinline__ void expert_token(int t, const bf16_t* __restrict__ H2, const unsigned char* __restrict__ U8, const unsigned char* __restrict__ V8, const int* __restrict__ IDX, const float* __restrict__ GATE,
                                             float* X1OUT, const float* __restrict__ fnorm, int lane_) {
  int lane = lane_; asm volatile("" : "+v"(lane));
  f32x2 hf[4][8];
  { const u32x4* hp = (const u32x4*)(H2 + (size_t)t * 4096) + 2 * lane;
#pragma unroll
    for (int k = 0; k < 4; ++k) { const u32x4 a = hp[128 * k], b = hp[128 * k + 1];
      hf[k][0] = (f32x2){bf_lo(a.x), bf_hi(a.x)}; hf[k][1] = (f32x2){bf_lo(a.y), bf_hi(a.y)}; hf[k][2] = (f32x2){bf_lo(a.z), bf_hi(a.z)}; hf[k][3] = (f32x2){bf_lo(a.w), bf_hi(a.w)};
      hf[k][4] = (f32x2){bf_lo(b.x), bf_hi(b.x)}; hf[k][5] = (f32x2){bf_lo(b.y), bf_hi(b.y)}; hf[k][6] = (f32x2){bf_lo(b.z), bf_hi(b.z)}; hf[k][7] = (f32x2){bf_lo(b.w), bf_hi(b.w)}; } }
  const int e0 = FAKE ? lane : IDX[(size_t)t * 128 + lane], e1 = FAKE ? lane + 64 : IDX[(size_t)t * 128 + 64 + lane];
  const float g0 = GATE[(size_t)t * 128 + lane], g1 = GATE[(size_t)t * 128 + 64 + lane];
  float c0 = 0.f, c1 = 0.f;
  u32x4 r0[4], r1[4], r2[4], r3[4];
#define ELOAD(dst, jj) do { const int jx_ = (jj); if (jx_ < 256) { const int sl_ = jx_ & 127; const int e_ = __builtin_amdgcn_readlane(sl_ < 64 ? e0 : e1, sl_ & 63); \
    const u32x4* rp_ = (const u32x4*)((jx_ < 128 ? U8 : V8) + (size_t)e_ * 4096) + lane; _Pragma("unroll") for (int k = 0; k < 4; ++k) dst[k] = rp_[64 * k]; } \
    asm volatile("" ::: "memory"); __builtin_amdgcn_sched_barrier(0); } while (0)
#define UDOT(R, OUT) do { f32x2 a0_ = {0.f, 0.f}, a1_ = {0.f, 0.f}, a2_ = {0.f, 0.f}, a3_ = {0.f, 0.f}; \
    _Pragma("unroll") for (int k = 0; k < 4; ++k) { \
      a0_ += fp8x2(R[k].x, false) * hf[k][0]; a1_ += fp8x2(R[k].x, true) * hf[k][1]; a2_ += fp8x2(R[k].y, false) * hf[k][2]; a3_ += fp8x2(R[k].y, true) * hf[k][3]; \
      a0_ += fp8x2(R[k].z, false) * hf[k][4]; a1_ += fp8x2(R[k].z, true) * hf[k][5]; a2_ += fp8x2(R[k].w, false) * hf[k][6]; a3_ += fp8x2(R[k].w, true) * hf[k][7]; } \
    a0_ += a1_; a2_ += a3_; a0_ += a2_; OUT = a0_.x + a0_.y; } while (0)
  ELOAD(r0, 0); ELOAD(r1, 1); ELOAD(r2, 2); ELOAD(r3, 3);
#pragma unroll 1
  for (int g = 0; g < 16; ++g) {
    float p[8];
    const int j = g * 8;
    UDOT(r0, p[0]); ELOAD(r0, j + 4); UDOT(r1, p[1]); ELOAD(r1, j + 5); UDOT(r2, p[2]); ELOAD(r2, j + 6); UDOT(r3, p[3]); ELOAD(r3, j + 7);
    UDOT(r0, p[4]); ELOAD(r0, j + 8); UDOT(r1, p[5]); ELOAD(r1, j + 9); UDOT(r2, p[6]); ELOAD(r2, j + 10); UDOT(r3, p[7]); ELOAD(r3, j + 11);
    float q4[4], q2[2], q1;
    { const bool up = (lane & 32) != 0;
#pragma unroll
      for (int i = 0; i < 4; ++i) { const float send = up ? p[i] : p[4 + i], keep = up ? p[4 + i] : p[i]; q4[i] = keep + __shfl_xor(send, 32); } }
    { const bool up = (lane & 16) != 0;
#pragma unroll
      for (int i = 0; i < 2; ++i) { const float send = up ? q4[i] : q4[2 + i], keep = up ? q4[2 + i] : q4[i]; q2[i] = keep + __shfl_xor(send, 16); } }
    { const bool up = (lane & 8) != 0; const float send = up ? q2[0] : q2[1], keep = up ? q2[1] : q2[0]; q1 = keep + __shfl_xor(send, 8); }
    q1 += __shfl_xor(q1, 4); q1 += __shfl_xor(q1, 2); q1 += __shfl_xor(q1, 1);
    const float got = __shfl(q1, 8 * (lane & 7));
    if ((lane >> 3) == (g & 7)) { if (g < 8) c0 = got; else c1 = got; }
  }
#undef UDOT
  c0 = g0 * gelu_erf(c0 * (1.0f / USCALE)) * (1.0f / VSCALE); c1 = g1 * gelu_erf(c1 * (1.0f / USCALE)) * (1.0f / VSCALE);
  f32x2 acc[4][8];
#pragma unroll
  for (int k = 0; k < 4; ++k)
#pragma unroll
    for (int i = 0; i < 8; ++i) acc[k][i] = (f32x2){0.f, 0.f};
#define VROW(R, C) do { const f32x2 cc_ = {(C), (C)}; _Pragma("unroll") for (int k = 0; k < 4; ++k) { \
      acc[k][0] += cc_ * fp8x2(R[k].x, false); acc[k][1] += cc_ * fp8x2(R[k].x, true); acc[k][2] += cc_ * fp8x2(R[k].y, false); acc[k][3] += cc_ * fp8x2(R[k].y, true); \
      acc[k][4] += cc_ * fp8x2(R[k].z, false); acc[k][5] += cc_ * fp8x2(R[k].z, true); acc[k][6] += cc_ * fp8x2(R[k].w, false); acc[k][7] += cc_ * fp8x2(R[k].w, true); } } while (0)
#define CJ(j) __int_as_float(__builtin_amdgcn_readlane(__float_as_int((j) < 64 ? c0 : c1), (j) & 63))
#pragma unroll 1
  for (int j = 0; j < 128; j += 4) {
    { const float c = CJ(j); VROW(r0, c); __builtin_amdgcn_sched_barrier(0); ELOAD(r0, 128 + j + 4); }
    { const float c = CJ(j + 1); VROW(r1, c); __builtin_amdgcn_sched_barrier(0); ELOAD(r1, 128 + j + 5); }
    { const float c = CJ(j + 2); VROW(r2, c); __builtin_amdgcn_sched_barrier(0); ELOAD(r2, 128 + j + 6); }
    { const float c = CJ(j + 3); VROW(r3, c); __builtin_amdgcn_sched_barrier(0); ELOAD(r3, 128 + j + 7); }
  }
#undef VROW
#undef CJ
#undef ELOAD
  int xo_ = 16 * lane; asm volatile("" : "+v"(xo_));
  float* xr = X1OUT + (size_t)t * 4096 + xo_; float ss = 0.f;
#ifdef PROBE_PEER_SCALE
#pragma unroll
  for (int k = 0; k < 4; ++k)
#pragma unroll
    for (int i = 0; i < 8; ++i) acc[k][i] *= PROBE_PEER_SCALE;
#endif
#pragma unroll
  for (int k = 0; k < 4; ++k)
#pragma unroll
    for (int q = 0; q < 4; ++q) { const f32x4 a = *(const f32x4*)(xr + 1024 * k + 4 * q);
      acc[k][2 * q] += (f32x2){a[0], a[1]}; acc[k][2 * q + 1] += (f32x2){a[2], a[3]};
      ss += acc[k][2 * q].x * acc[k][2 * q].x + acc[k][2 * q].y * acc[k][2 * q].y + acc[k][2 * q + 1].x * acc[k][2 * q + 1].x + acc[k][2 * q + 1].y * acc[k][2 * q + 1].y; }
  const float rstd = 1.0f / sqrtf(wave_sum(ss) * (1.0f / 4096.0f) + 1e-6f);
  const float* fn = fnorm + xo_;
#pragma unroll
  for (int k = 0; k < 4; ++k)
#pragma unroll
    for (int q = 0; q < 4; ++q) { const f32x4 g = *(const f32x4*)(fn + 1024 * k + 4 * q);
      f32x4 o; o[0] = acc[k][2 * q].x * rstd * g[0]; o[1] = acc[k][2 * q].y * rstd * g[1]; o[2] = acc[k][2 * q + 1].x * rstd * g[2]; o[3] = acc[k][2 * q + 1].y * rstd * g[3];
      if constexpr (STORE) { *(f32x4*)(xr + 1024 * k + 4 * q) = o; } else { asm volatile("" :: "v"(o)); } }
}
typedef unsigned v6u __attribute__((ext_vector_type(6)));
typedef float v32f __attribute__((ext_vector_type(32)));
typedef __bf16 v32bf __attribute__((ext_vector_type(32)));
typedef unsigned v16u __attribute__((ext_vector_type(16)));
constexpr float U6SCALE = 128.0f, V6SCALE = 4.0f;
constexpr int ROW6 = 3072;
__device__ __forceinline__ unsigned f32_to_e2m3(float x) {
  const unsigned sgn = (__float_as_uint(x) >> 26) & 32u; float a = fminf(fabsf(x), 7.5f);
  unsigned code;
  if (a < 1.0f) { code = (unsigned)__builtin_rintf(a * 8.0f); }
  else { unsigned u = __float_as_uint(a); u += 0x7FFFFu + ((u >> 20) & 1u); const unsigned e = (u >> 23) - 127u, m = (u >> 20) & 7u; code = ((e + 1u) << 3) | m; code = code > 31u ? 31u : code; }
  return code | sgn;
}
__device__ __forceinline__ void pack_row_fp6(const float* __restrict__ src, unsigned char* __restrict__ dst, float scale, int lane) {
  const f32x4* sp = (const f32x4*)(src + 64 * lane);
  unsigned w[12];
#pragma unroll
  for (int i = 0; i < 12; ++i) w[i] = 0u;
#pragma unroll
  for (int q = 0; q < 16; ++q) { const f32x4 v = sp[q] * scale;
#pragma unroll
    for (int j = 0; j < 4; ++j) { const int el = 4 * q + j, g = el >> 5, i = el & 31, pos = 6 * i, d = 6 * g + (pos >> 5), sh = pos & 31;
      const unsigned c = f32_to_e2m3(v[j]); w[d] |= c << sh; if (sh > 26) w[d + 1] |= c >> (32 - sh); } }
#pragma unroll
  for (int k = 0; k < 3; ++k) *(u32x4*)(dst + 1024 * k + 16 * lane) = (u32x4){w[4 * k], w[4 * k + 1], w[4 * k + 2], w[4 * k + 3]};
}
template <bool STORE> __device__ __forceinline__ void expert_tokens6(int t_first, int t_step, int t_end, const bf16_t* __restrict__ H2, const unsigned char* __restrict__ U6, const unsigned char* __restrict__ V6,
                                             const int* __restrict__ IDX, const float* __restrict__ GATE, float* X1OUT, const float* __restrict__ fnorm, int lane_) {
  int lane = lane_; asm volatile("" : "+v"(lane));
  int t = t_first; if (t >= t_end) return;
  const unsigned lo16 = (unsigned)lane * 16u;
  int e0 = IDX[(size_t)t * 128 + lane], e1 = IDX[(size_t)t * 128 + 64 + lane];
  u32x4 r0[3], r1[3], r2[3], r3[3];
#define ELOAD(dst, jj, EA, EB, TAB) do { const int sl_ = (jj) & 127; const int e_ = __builtin_amdgcn_readlane(sl_ < 64 ? (EA) : (EB), sl_ & 63); \
    const unsigned char* rb_ = (TAB) + (size_t)(unsigned)e_ * ROW6; _Pragma("unroll") for (int k = 0; k < 3; ++k) dst[k] = *(const u32x4*)(rb_ + (lo16 + 1024u * k)); \
    asm volatile("" ::: "memory"); __builtin_amdgcn_sched_barrier(0); } while (0)
#define GRPA(R) ((v6u){R[0].x, R[0].y, R[0].z, R[0].w, R[1].x, R[1].y})
#define GRPB(R) ((v6u){R[1].z, R[1].w, R[2].x, R[2].y, R[2].z, R[2].w})
  ELOAD(r0, 0, e0, e1, U6); ELOAD(r1, 1, e0, e1, U6); ELOAD(r2, 2, e0, e1, U6); ELOAD(r3, 3, e0, e1, U6);
#pragma unroll 1
  for (;;) {
    const int tn = t + t_step, tnx = tn < t_end ? tn : t;
    const int e0n = IDX[(size_t)tnx * 128 + lane], e1n = IDX[(size_t)tnx * 128 + 64 + lane];
    const float g0 = GATE[(size_t)t * 128 + lane], g1 = GATE[(size_t)t * 128 + 64 + lane];
    unsigned hq[32];
    { const u32x4* hp = (const u32x4*)(H2 + (size_t)t * 4096 + 64 * lane);
#pragma unroll
      for (int q = 0; q < 8; ++q) { const u32x4 a = hp[q]; hq[4 * q] = a.x; hq[4 * q + 1] = a.y; hq[4 * q + 2] = a.z; hq[4 * q + 3] = a.w; } }
    float c0 = 0.f, c1 = 0.f;
#define UDOT(R, OUT) do { float a0_ = 0.f, a1_ = 0.f, a2_ = 0.f, a3_ = 0.f; \
    asm volatile("" : "+v"(R[0].x)); \
    { const v16u b_ = __builtin_bit_cast(v16u, __builtin_amdgcn_cvt_scalef32_pk32_bf16_fp6(GRPA(R), 1.0f)); \
      _Pragma("unroll") for (int j = 0; j < 16; j += 4) { a0_ = dot2(b_[j], hq[j], a0_); a1_ = dot2(b_[j + 1], hq[j + 1], a1_); a2_ = dot2(b_[j + 2], hq[j + 2], a2_); a3_ = dot2(b_[j + 3], hq[j + 3], a3_); } } \
    asm volatile("" : "+v"(a0_), "+v"(a1_), "+v"(a2_), "+v"(a3_), "+v"(R[1].z)); \
    { const v16u b_ = __builtin_bit_cast(v16u, __builtin_amdgcn_cvt_scalef32_pk32_bf16_fp6(GRPB(R), 1.0f)); \
      _Pragma("unroll") for (int j = 0; j < 16; j += 4) { a0_ = dot2(b_[j], hq[16 + j], a0_); a1_ = dot2(b_[j + 1], hq[17 + j], a1_); a2_ = dot2(b_[j + 2], hq[18 + j], a2_); a3_ = dot2(b_[j + 3], hq[19 + j], a3_); } } \
    asm volatile("" : "+v"(a0_), "+v"(a1_), "+v"(a2_), "+v"(a3_)); \
    OUT = (a0_ + a1_) + (a2_ + a3_); } while (0)
#define RSCAT(G) do { float q4[4], q2[2], q1; \
      { const bool up = (lane & 32) != 0; _Pragma("unroll") for (int i = 0; i < 4; ++i) { const float send = up ? p[i] : p[4 + i], keep = up ? p[4 + i] : p[i]; q4[i] = keep + __shfl_xor(send, 32); } } \
      { const bool up = (lane & 16) != 0; _Pragma("unroll") for (int i = 0; i < 2; ++i) { const float send = up ? q4[i] : q4[2 + i], keep = up ? q4[2 + i] : q4[i]; q2[i] = keep + __shfl_xor(send, 16); } } \
      { const bool up = (lane & 8) != 0; const float send = up ? q2[0] : q2[1], keep = up ? q2[1] : q2[0]; q1 = keep + __shfl_xor(send, 8); } \
      q1 += __shfl_xor(q1, 4); q1 += __shfl_xor(q1, 2); q1 += __shfl_xor(q1, 1); \
      const float got = __shfl(q1, 8 * (lane & 7)); \
      if ((lane >> 3) == ((G) & 7)) { if ((G) < 8) c0 = got; else c1 = got; } } while (0)
#pragma unroll 1
    for (int g = 0; g < 15; ++g) {
      float p[8];
      const int j = g * 8;
      UDOT(r0, p[0]); ELOAD(r0, j + 4, e0, e1, U6); UDOT(r1, p[1]); ELOAD(r1, j + 5, e0, e1, U6); UDOT(r2, p[2]); ELOAD(r2, j + 6, e0, e1, U6); UDOT(r3, p[3]); ELOAD(r3, j + 7, e0, e1, U6);
      UDOT(r0, p[4]); ELOAD(r0, j + 8, e0, e1, U6); UDOT(r1, p[5]); ELOAD(r1, j + 9, e0, e1, U6); UDOT(r2, p[6]); ELOAD(r2, j + 10, e0, e1, U6); UDOT(r3, p[7]); ELOAD(r3, j + 11, e0, e1, U6);
      RSCAT(g);
    }
    { float p[8];
      UDOT(r0, p[0]); ELOAD(r0, 124, e0, e1, U6); UDOT(r1, p[1]); ELOAD(r1, 125, e0, e1, U6); UDOT(r2, p[2]); ELOAD(r2, 126, e0, e1, U6); UDOT(r3, p[3]); ELOAD(r3, 127, e0, e1, U6);
      UDOT(r0, p[4]); ELOAD(r0, 0, e0, e1, V6); UDOT(r1, p[5]); ELOAD(r1, 1, e0, e1, V6); UDOT(r2, p[6]); ELOAD(r2, 2, e0, e1, V6); UDOT(r3, p[7]); ELOAD(r3, 3, e0, e1, V6);
      RSCAT(15); }
#undef RSCAT
#undef UDOT
    c0 = g0 * gelu_erf(c0 * (1.0f / U6SCALE)) * (1.0f / V6SCALE); c1 = g1 * gelu_erf(c1 * (1.0f / U6SCALE)) * (1.0f / V6SCALE);
    float acc[64];
#pragma unroll
    for (int i = 0; i < 64; ++i) acc[i] = 0.f;
#define PIN16(B) asm volatile("" : "+v"(acc[B]), "+v"(acc[B + 1]), "+v"(acc[B + 2]), "+v"(acc[B + 3]), "+v"(acc[B + 4]), "+v"(acc[B + 5]), "+v"(acc[B + 6]), "+v"(acc[B + 7]), \
    "+v"(acc[B + 8]), "+v"(acc[B + 9]), "+v"(acc[B + 10]), "+v"(acc[B + 11]), "+v"(acc[B + 12]), "+v"(acc[B + 13]), "+v"(acc[B + 14]), "+v"(acc[B + 15]))
#define VROW(R, C) do { asm volatile("" : "+v"(R[0].x)); \
    { const v32f f_ = __builtin_amdgcn_cvt_scalef32_pk32_f32_fp6(GRPA(R), 1.0f); _Pragma("unroll") for (int i = 0; i < 32; ++i) acc[i] += (C) * f_[i]; } PIN16(0); PIN16(16); \
    asm volatile("" : "+v"(R[1].z)); \
    { const v32f f_ = __builtin_amdgcn_cvt_scalef32_pk32_f32_fp6(GRPB(R), 1.0f); _Pragma("unroll") for (int i = 0; i < 32; ++i) acc[32 + i] += (C) * f_[i]; } PIN16(32); PIN16(48); } while (0)
#define CJ(j) __int_as_float(__builtin_amdgcn_readlane(__float_as_int((j) < 64 ? c0 : c1), (j) & 63))
#pragma unroll 1
    for (int j = 0; j < 124; j += 4) {
      { const float c = CJ(j); VROW(r0, c); ELOAD(r0, j + 4, e0, e1, V6); }
      { const float c = CJ(j + 1); VROW(r1, c); ELOAD(r1, j + 5, e0, e1, V6); }
      { const float c = CJ(j + 2); VROW(r2, c); ELOAD(r2, j + 6, e0, e1, V6); }
      { const float c = CJ(j + 3); VROW(r3, c); ELOAD(r3, j + 7, e0, e1, V6); }
    }
    { const float c = CJ(124); VROW(r0, c); ELOAD(r0, 0, e0n, e1n, U6); }
    { const float c = CJ(125); VROW(r1, c); ELOAD(r1, 1, e0n, e1n, U6); }
    { const float c = CJ(126); VROW(r2, c); ELOAD(r2, 2, e0n, e1n, U6); }
    { const float c = CJ(127); VROW(r3, c); ELOAD(r3, 3, e0n, e1n, U6); }
#undef VROW
#undef PIN16
#undef CJ
    int xo_ = 64 * lane; asm volatile("" : "+v"(xo_));
    float* xr = X1OUT + (size_t)t * 4096 + xo_; float ss = 0.f;
#pragma unroll
    for (int k = 0; k < 4; ++k) {
#pragma unroll
      for (int q = 0; q < 4; ++q) { const f32x4 a = *(const f32x4*)(xr + 16 * k + 4 * q); const int b_ = 16 * k + 4 * q;
        acc[b_] += a[0]; acc[b_ + 1] += a[1]; acc[b_ + 2] += a[2]; acc[b_ + 3] += a[3];
        ss += (acc[b_] * acc[b_] + acc[b_ + 1] * acc[b_ + 1]) + (acc[b_ + 2] * acc[b_ + 2] + acc[b_ + 3] * acc[b_ + 3]); }
      asm volatile("" ::: "memory"); __builtin_amdgcn_sched_barrier(0); }
    const float rstd = 1.0f / sqrtf(wave_sum(ss) * (1.0f / 4096.0f) + 1e-6f);
    const float* fn = fnorm + xo_;
#pragma unroll
    for (int k = 0; k < 4; ++k) {
#pragma unroll
      for (int q = 0; q < 4; ++q) { const f32x4 g = *(const f32x4*)(fn + 16 * k + 4 * q); const int b_ = 16 * k + 4 * q;
        f32x4 o; o[0] = acc[b_] * rstd * g[0]; o[1] = acc[b_ + 1] * rstd * g[1]; o[2] = acc[b_ + 2] * rstd * g[2]; o[3] = acc[b_ + 3] * rstd * g[3];
        if constexpr (STORE) { *(f32x4*)(xr + 16 * k + 4 * q) = o; } else { asm volatile("" :: "v"(o)); } }
      asm volatile("" ::: "memory"); __builtin_amdgcn_sched_barrier(0); }
    if (tn >= t_end) break;
    t = tn; e0 = e0n; e1 = e1n;
  }
#undef ELOAD
#undef GRPA
#undef GRPB
}
#undef PLAS
}

constexpr int BATCH = 2, SEQ = 8192, DM = 4096, T = BATCH * SEQ;
constexpr int NCAT = 15872;
constexpr int NPH = 12;
#ifndef MK_CUTS
#define MK_CUTS 1
#endif
constexpr float EPS = 1e-6f;
constexpr float LOG2E = 1.4426950408889634f;
constexpr float MLA_QSCALE = 0.07216878364870322f * LOG2E;
constexpr float S_WIN = 64.f, S_PAB = 32.f, S_WOUT = 64.f, S_OA = 64.f, S_OB = 16.f, S_MRG = 16.f;
constexpr float NA_QSCALE = 0.08838834764831845f * LOG2E;

constexpr size_t MiB = 1u << 20;
constexpr size_t WS_CTL = 0, CTL_ZERO_BYTES = 1 * MiB;
constexpr size_t WS_ROPE = 1 * MiB;
constexpr size_t WS_RS = 1 * MiB + 65536;
constexpr size_t WS_WCAT = 2 * MiB;
constexpr size_t WS_WUQ = WS_WCAT + 124 * MiB;
constexpr size_t WS_WUKV = WS_WUQ + 5 * MiB;
constexpr size_t WS_PA = WS_WUKV + 4 * MiB;
constexpr size_t WS_PB = WS_PA + 16 * MiB;
constexpr size_t WS_WOUT = WS_PB + 16 * MiB;
constexpr size_t WS_WQ = WS_WOUT + 32 * MiB;
constexpr size_t WS_SUBH = WS_WQ + 16 * MiB;
constexpr size_t WS_SUBL = WS_SUBH + 512 * 1024;
constexpr size_t WS_R1 = WS_SUBL + 512 * 1024;
constexpr size_t WS_LAT = WS_R1 + 128 * MiB;
constexpr size_t WS_R2 = WS_LAT + 48 * MiB;
constexpr size_t WS_R3 = WS_R2 + 192 * MiB;
constexpr size_t WS_R4 = WS_R3 + 256 * MiB;
constexpr size_t WS_KR = WS_R4 + 224 * MiB;
constexpr size_t WS_IDX = WS_KR + 2 * MiB;
constexpr size_t WS_GATE = WS_IDX + 8 * MiB;
constexpr size_t WS_END = WS_GATE + 8 * MiB;
constexpr int CW_TMO = 0, CW_BAR = 4096;

constexpr int RING_BYTES = 131072, LDSCTL_OFF = RING_BYTES, MISC_OFF = LDSCTL_OFF + 320, LDS_BYTES = 147456;
constexpr int NWAVES = 8;

#define GAS __attribute__((address_space(1)))
#define LAS __attribute__((address_space(3)))
typedef unsigned short bf16;
typedef unsigned v4u __attribute__((ext_vector_type(4)));
typedef float f32x4 __attribute__((ext_vector_type(4)));
typedef float f32x8 __attribute__((ext_vector_type(8)));
typedef GAS unsigned gu32;
#define RLX_AGENT __ATOMIC_RELAXED, __HIP_MEMORY_SCOPE_AGENT
#define LDS_WAIT() asm volatile("s_waitcnt lgkmcnt(0)" ::: "memory")
#define VM_WAIT() asm volatile("s_waitcnt vmcnt(0)" ::: "memory")
__device__ __forceinline__ unsigned pkbf(float lo, float hi) { unsigned r; asm volatile("v_cvt_pk_bf16_f32 %0, %1, %2" : "=v"(r) : "v"(lo), "v"(hi)); return r; }

#define XB_TMO      128
#define XB_XCNT(j)  (256  + 64 * (j))
#define XB_XSUB(j)  (1280 + 64 * (j))
#define XB_XGEN(j)  (2304 + 64 * (j))
#define XB_TOP      3328
#define XB_TOPGEN   3392
#define XCD_BAR_WORDS 3456
#define XB_SPIN_CAP (1u << 22)
__device__ __forceinline__ unsigned xb_ld(unsigned* p)              { return __hip_atomic_load(p, __ATOMIC_RELAXED, __HIP_MEMORY_SCOPE_AGENT); }
__device__ __forceinline__ unsigned xb_add(unsigned* p, unsigned v) { return __hip_atomic_fetch_add(p, v, __ATOMIC_RELAXED, __HIP_MEMORY_SCOPE_AGENT); }
__device__ __forceinline__ unsigned xb_xcc_id() { return (unsigned)__builtin_amdgcn_s_getreg((3 << 11) | 20) & 0xFu; }
#define XB_SPIN(cond, bar) do { unsigned _sp = 0; while (cond) { __builtin_amdgcn_s_sleep(1); \
    if ((++_sp & 255u) == 0u) { if (xb_ld(&(bar)[XB_TMO])) break; if (_sp > XB_SPIN_CAP) { atomicAdd(&(bar)[XB_TMO], 1u); break; } } } } while (0)
struct XcdBarrier { unsigned* bar; unsigned x; volatile LAS unsigned* st; };
__device__ __forceinline__ XcdBarrier xcd_barrier_post(unsigned* bar, volatile LAS unsigned* st) {
    XcdBarrier b; b.bar = bar; b.x = xb_xcc_id(); b.st = st;
    if (threadIdx.x == 0) (void)xb_add(&bar[XB_XCNT(b.x)], 1u);
    return b;
}
__device__ __forceinline__ void xcd_barrier_complete(unsigned* bar, unsigned x, unsigned& nloc, unsigned& nx) {
    const unsigned G = gridDim.x * gridDim.y * gridDim.z;
    unsigned sum, cnt, mine, sp = 0u;
    for (;;) {
        sum = 0u; cnt = 0u; mine = 0u;
#pragma unroll
        for (unsigned j = 0; j < 16; ++j) { const unsigned c = xb_ld(&bar[XB_XCNT(j)]); sum += c; cnt += (c > 0u) ? 1u : 0u; mine = (j == x) ? c : mine; }
        if (sum == G) break;
        __builtin_amdgcn_s_sleep(1);
        if ((++sp & 255u) == 0u) { if (xb_ld(&bar[XB_TMO])) break; if (sp > XB_SPIN_CAP) { atomicAdd(&bar[XB_TMO], 1u); break; } }
    }
    nloc = mine > 0u ? mine : 1u; nx = cnt > 0u ? cnt : 1u;
}
__device__ __forceinline__ void xcd_barrier(const XcdBarrier& b) {
    asm volatile("s_waitcnt vmcnt(0)" ::: "memory");
    __syncthreads();
    if (threadIdx.x == 0) {
        unsigned* bar = b.bar;
        __builtin_amdgcn_s_waitcnt(0);
        unsigned nloc = b.st[0], nx = b.st[1];
        if (nloc == 0u) { xcd_barrier_complete(bar, b.x, nloc, nx); b.st[0] = nloc; b.st[1] = nx; }
        const unsigned old = xb_add(&bar[XB_XSUB(b.x)], 1u);
        const unsigned gen = old / nloc;
        if (old + 1u == (gen + 1u) * nloc) {
            __builtin_amdgcn_fence(__ATOMIC_RELEASE, "agent");
            asm volatile("s_waitcnt vmcnt(0)" ::: "memory");
            const unsigned og = xb_add(&bar[XB_TOP], 1u);
            const unsigned tg = og / nx;
            if (og + 1u == (tg + 1u) * nx) xb_add(&bar[XB_TOPGEN], 1u);
            else XB_SPIN(xb_ld(&bar[XB_TOPGEN]) == tg, bar);
            __builtin_amdgcn_fence(__ATOMIC_ACQUIRE, "agent");
            xb_add(&bar[XB_XGEN(b.x)], 1u);
            asm volatile("s_waitcnt vmcnt(0)" ::: "memory");
        } else {
            XB_SPIN(xb_ld(&bar[XB_XGEN(b.x)]) == gen, bar);
            __builtin_amdgcn_fence(__ATOMIC_ACQUIRE, "agent");
            asm volatile("s_waitcnt vmcnt(0)" ::: "memory");
        }
    }
    __syncthreads();
}

__device__ __forceinline__ float wave_sum(float v) {
#pragma unroll
    for (int o = 1; o < 64; o <<= 1) v += __shfl_xor(v, o);
    return v;
}
__device__ __forceinline__ void transpose_item(const float* W, int N, bf16* WT, int ldt, int row_off, const float* gk, LAS float* scr, int kb, int nb, int lane) {
    const int k0 = 64 * kb, n0 = 32 * nb;
#pragma unroll 8
    for (int i = 0; i < 32; ++i) { const int kk = 2 * i + (lane >> 5); float w = W[(size_t)(k0 + kk) * N + n0 + (lane & 31)]; if (gk) w *= gk[k0 + kk]; scr[kk * 33 + (lane & 31)] = w; }
    LDS_WAIT(); asm volatile("" ::: "memory");
    const int c = lane & 7;
#pragma unroll
    for (int j = 0; j < 4; ++j) { const int n = (lane >> 3) + 8 * j; const LAS float* s = scr + (8 * c) * 33 + n;
        v4u o; o.x = pkbf(s[0 * 33], s[1 * 33]); o.y = pkbf(s[2 * 33], s[3 * 33]); o.z = pkbf(s[4 * 33], s[5 * 33]); o.w = pkbf(s[6 * 33], s[7 * 33]);
        *(GAS v4u*)(WT + (size_t)(row_off + n0 + n) * ldt + k0 + 8 * c) = o; }
    LDS_WAIT(); asm volatile("" ::: "memory");
}
__device__ __forceinline__ void rms_row_to_bf16(const float* xrow, const float* gain, bf16* orow, int lane) {
    const GAS f32x4* xr = (const GAS f32x4*)xrow + lane; const GAS f32x4* gr = (const GAS f32x4*)gain + lane;
    f32x4 v[16]; float s = 0.f;
#pragma unroll
    for (int j = 0; j < 16; ++j) { v[j] = xr[64 * j]; s += (v[j].x * v[j].x + v[j].y * v[j].y) + (v[j].z * v[j].z + v[j].w * v[j].w); }
    const float rstd = 1.f / sqrtf(wave_sum(s) * (1.f / DM) + EPS);
    GAS unsigned long long* o8 = (GAS unsigned long long*)orow + lane;
#pragma unroll
    for (int j = 0; j < 16; ++j) { const f32x4 g = gr[64 * j];
        o8[64 * j] = (unsigned long long)pkbf(v[j].x * rstd * g.x, v[j].y * rstd * g.y) | ((unsigned long long)pkbf(v[j].z * rstd * g.z, v[j].w * rstd * g.w) << 32); }
}

__device__ __forceinline__ unsigned pk4f8(float a, float b, float c, float d) { int w = __builtin_amdgcn_cvt_pk_fp8_f32(a, b, 0, false); w = __builtin_amdgcn_cvt_pk_fp8_f32(c, d, w, true); return (unsigned)w; }
__device__ __forceinline__ void transpose_item8(const float* W, int N, unsigned char* WT, int ldt, int row_off, float scale, LAS float* scr, int kb, int nb, int lane) {
    const int k0 = 64 * kb, n0 = 32 * nb;
#pragma unroll 8
    for (int i = 0; i < 32; ++i) { const int kk = 2 * i + (lane >> 5); scr[kk * 33 + (lane & 31)] = W[(size_t)(k0 + kk) * N + n0 + (lane & 31)] * scale; }
    LDS_WAIT(); asm volatile("" ::: "memory");
    const int n = lane >> 1, kh = (lane & 1) * 32; const LAS float* s = scr + kh * 33 + n;
#pragma unroll
    for (int j = 0; j < 2; ++j) { v4u o;
        o.x = pk4f8(s[(16 * j + 0) * 33], s[(16 * j + 1) * 33], s[(16 * j + 2) * 33], s[(16 * j + 3) * 33]); o.y = pk4f8(s[(16 * j + 4) * 33], s[(16 * j + 5) * 33], s[(16 * j + 6) * 33], s[(16 * j + 7) * 33]);
        o.z = pk4f8(s[(16 * j + 8) * 33], s[(16 * j + 9) * 33], s[(16 * j + 10) * 33], s[(16 * j + 11) * 33]); o.w = pk4f8(s[(16 * j + 12) * 33], s[(16 * j + 13) * 33], s[(16 * j + 14) * 33], s[(16 * j + 15) * 33]);
        *(GAS v4u*)(WT + (size_t)(row_off + n0 + n) * ldt + k0 + kh + 16 * j) = o; }
    LDS_WAIT(); asm volatile("" ::: "memory");
}
__device__ __forceinline__ void rms_row_to_fp8(const float* xrow, const float* gain, unsigned char* orow, int lane) {
    const GAS f32x4* xr = (const GAS f32x4*)xrow + lane; const GAS f32x4* gr = (const GAS f32x4*)gain + lane;
    f32x4 v[16]; float s = 0.f;
#pragma unroll
    for (int j = 0; j < 16; ++j) { v[j] = xr[64 * j]; s += (v[j].x * v[j].x + v[j].y * v[j].y) + (v[j].z * v[j].z + v[j].w * v[j].w); }
    const float rstd = 1.f / sqrtf(wave_sum(s) * (1.f / DM) + EPS);
    GAS unsigned* o4 = (GAS unsigned*)orow + lane;
#pragma unroll
    for (int j = 0; j < 16; ++j) { const f32x4 g = gr[64 * j]; o4[64 * j] = pk4f8(v[j].x * rstd * g.x, v[j].y * rstd * g.y, v[j].z * rstd * g.z, v[j].w * rstd * g.w); }
}

struct Args {
    const float* in[19]; float* out; unsigned char* ws; int ph_lo, ph_hi, use_bar, pad;
};

__global__ void __launch_bounds__(NWAVES * 64, 2) mk_fwd(Args args) {
    extern __shared__ __attribute__((aligned(16))) unsigned char lds[];
    LAS unsigned char* ldsl = (LAS unsigned char*)lds;
    volatile LAS unsigned* MISC = (volatile LAS unsigned*)(ldsl + MISC_OFF);
    const int tid = threadIdx.x, lane = tid & 63, wave = __builtin_amdgcn_readfirstlane(tid >> 6);
    const int G = gridDim.x, bx = blockIdx.x;
    const int vcu = (G % 8 == 0) ? (bx % 8) * (G / 8) + bx / 8 : bx;
    const int gw = vcu * NWAVES + wave, NGW = G * NWAVES;
    unsigned char* ws = args.ws;
    gu32* ctl = (gu32*)(ws + WS_CTL);
    const float* x = args.in[0]; const float* attn_norm = args.in[1]; const float* w_in = args.in[2]; const float* q_norm = args.in[3]; const float* w_uq = args.in[4];
    const float* kv_norm = args.in[5]; const float* w_ukv = args.in[6]; const float* w_bmla = args.in[7]; const float* na_rpb = args.in[8]; const float* w_bna = args.in[9];
    const float* w_gate = args.in[10]; const float* b_gate = args.in[11]; const float* w_out = args.in[12]; const float* ffn_norm = args.in[13]; const float* peer_wq = args.in[14];
    const float* peer_sub = args.in[15]; const float* peer_u = args.in[16]; const float* peer_v = args.in[17]; const float* final_norm = args.in[18];
    float* out = args.out;
    float* ROPE = (float*)(ws + WS_ROPE); float* RS = (float*)(ws + WS_RS);
    bf16* WCAT = (bf16*)(ws + WS_WCAT); bf16* WUQ = (bf16*)(ws + WS_WUQ); bf16* WUKV = (bf16*)(ws + WS_WUKV); bf16* PA = (bf16*)(ws + WS_PA); bf16* PB = (bf16*)(ws + WS_PB);
    bf16* WOUT = (bf16*)(ws + WS_WOUT); bf16* WQ = (bf16*)(ws + WS_WQ); bf16* SUBH = (bf16*)(ws + WS_SUBH); bf16* SUBL = (bf16*)(ws + WS_SUBL);
    unsigned char* XN8 = ws + WS_R1; unsigned char* OA8 = ws + WS_R1; unsigned char* OB8 = ws + WS_R1 + 32 * MiB; bf16* H2 = (bf16*)(ws + WS_R1);
    bf16* LAT = (bf16*)(ws + WS_LAT);
    bf16* NAQ = (bf16*)(ws + WS_R2); bf16* NAK = (bf16*)(ws + WS_R2 + 64 * MiB); bf16* NAV = (bf16*)(ws + WS_R2 + 128 * MiB); bf16* MRG = (bf16*)(ws + WS_R2); unsigned char* MRG8 = ws + WS_R2 + 128 * MiB;
    bf16* GT = (bf16*)(ws + WS_R3); unsigned char* U8 = ws + WS_R3; unsigned char* V8 = ws + WS_R3 + 64 * MiB;
    unsigned char* Q8 = ws + WS_R4; unsigned char* K8 = ws + WS_R4 + 48 * MiB; unsigned char* VT8 = ws + WS_R4 + 96 * MiB; float* QP = (float*)(ws + WS_R4);
    bf16* KR = (bf16*)(ws + WS_KR); int* IDX = (int*)(ws + WS_IDX); float* GATE = (float*)(ws + WS_GATE);

    for (int u = tid; u < (LDS_BYTES - LDSCTL_OFF) / 4; u += NWAVES * 64) ((LAS unsigned*)(ldsl + LDSCTL_OFF))[u] = 0u;
    __syncthreads();
    XcdBarrier bar; bar.bar = (unsigned*)(ctl + CW_BAR); bar.x = 0; bar.st = nullptr;
    if (args.use_bar) bar = xcd_barrier_post((unsigned*)(ctl + CW_BAR), MISC + 8);
    const int lo = args.ph_lo, hi = args.ph_hi;
#ifndef MK_PHMASK
#define MK_PHMASK 0xFFF
#endif
#define IN(k) (((MK_PHMASK >> (k)) & 1) && lo <= (k) && (k) < hi)
#ifndef MK_DUP4
#define MK_DUP4 0
#endif
#ifndef MK_FAKE
#define MK_FAKE false
#endif
#ifndef MK_DUP
#define MK_DUP -1
#endif
#define REPS(k) ((MK_DUP == (k)) ? 2 : 1)
#define SEAM(k) do { if (IN(k) && IN((k) + 1)) xcd_barrier(bar); } while (0)

    for (int rep_ = 0; rep_ < REPS(0); ++rep_) if (IN(0)) {
        LAS float* scr = (LAS float*)(ldsl + wave * 16384);
        constexpr int I0 = 64 * 234, I1 = 64 * 256, I2 = 12 * 96, I3 = 8 * 128, I4 = 32 * 128, I5 = 32 * 128, I6 = 64 * 128, I7 = 64 * 64;
        constexpr int NITEMS = I0 + I1 + I2 + I3 + I4 + I5 + I6 + I7;
        for (int it = gw; it < NITEMS; it += NGW) {
            int r = it;
            if (r < I0) { const int kb = r / 234, nb = r % 234; const int off = (nb >= 42) ? 192 : 0; transpose_item8(w_in, 7488, (unsigned char*)WCAT, 4096, off, S_WIN, scr, kb, nb, lane); continue; } r -= I0;
            if (r < I1) { transpose_item8(w_gate, 8192, (unsigned char*)WCAT, 4096, 7680, S_WIN, scr, r / 256, r % 256, lane); continue; } r -= I1;
            if (r < I2) { transpose_item(w_uq, 3072, WUQ, 768, 0, q_norm, scr, r / 96, r % 96, lane); continue; } r -= I2;
            if (r < I3) { transpose_item(w_ukv, 4096, WUKV, 512, 0, kv_norm, scr, r / 128, r % 128, lane); continue; } r -= I3;
            if (r < I4) { transpose_item8(w_bmla, 4096, (unsigned char*)PA, 2048, 0, S_PAB, scr, r / 128, r % 128, lane); continue; } r -= I4;
            if (r < I5) { transpose_item8(w_bna, 4096, (unsigned char*)PB, 2048, 0, S_PAB, scr, r / 128, r % 128, lane); continue; } r -= I5;
            if (r < I6) { transpose_item8(w_out, 4096, (unsigned char*)WOUT, 4096, 0, S_WOUT, scr, r / 128, r % 128, lane); continue; } r -= I6;
            transpose_item(peer_wq, 2048, WQ, 4096, 0, nullptr, scr, r / 64, r % 64, lane);
        }
        for (int i = gw * 64 + lane; i < 192 * 4096 / 16; i += NGW * 64) ((GAS v4u*)((unsigned char*)WCAT + (size_t)1344 * 4096))[i] = (v4u){0u, 0u, 0u, 0u};
        for (int i = gw * 64 + lane; i < 8 * 2 * 128 * 128 / 2; i += NGW * 64) { const float a = peer_sub[2 * i], b = peer_sub[2 * i + 1];
            const unsigned h = pkbf(a, b); const unsigned l = pkbf(a - __uint_as_float(h << 16), b - __uint_as_float(h & 0xffff0000u));
            ((GAS unsigned*)SUBH)[i] = h; ((GAS unsigned*)SUBL)[i] = l; }
        for (int i = gw * 64 + lane; i < 128 * 16; i += NGW * 64) { const int pos = i >> 4, j = i & 15; const float fr = powf(10000.0f, -(float)j / 16.0f); const float ang = (float)pos * fr;
            ROPE[2 * i] = cosf(ang); ROPE[2 * i + 1] = sinf(ang); }
        for (int m = gw; m < T; m += NGW) rms_row_to_fp8(x + (size_t)m * DM, attn_norm, XN8 + (size_t)m * DM, lane);
    }
    SEAM(0);
    for (int rep_ = 0; rep_ < REPS(1); ++rep_) if (IN(1)) {
        pg8::Gemm g{(const bf16*)XN8, WCAT, T, NCAT, DM, DM, DM}; pg8::StaticOrder S; S.init(T, NCAT, G, bx);
        pg8::EpiIn E{ws, WS_LAT, WS_R2, 64 * MiB, WS_R3, b_gate, NA_QSCALE, 1.0f / S_WIN};
        pg8::gemm_phase<pg8::EpiIn, pg8::StaticOrder, true, true>(ldsl, g, S, E);
    }
    SEAM(1);
    for (int rep_ = 0; rep_ < REPS(2); ++rep_) if (IN(2)) {
        for (int m = gw; m < T; m += NGW) {
            const bf16* row = LAT + (size_t)m * 1536;
            float sq = 0.f, skv = 0.f;
#pragma unroll
            for (int j = 0; j < 6; ++j) { const unsigned w = ((const GAS unsigned*)row)[lane + 64 * j]; const float a = __uint_as_float(w << 16), b = __uint_as_float(w & 0xffff0000u); sq += a * a + b * b; }
#pragma unroll
            for (int j = 0; j < 4; ++j) { const unsigned w = ((const GAS unsigned*)(row + 768))[lane + 64 * j]; const float a = __uint_as_float(w << 16), b = __uint_as_float(w & 0xffff0000u); skv += a * a + b * b; }
            sq = wave_sum(sq); skv = wave_sum(skv);
            if (lane == 0) { RS[2 * m] = 1.f / sqrtf(sq * (1.f / 768.f) + EPS); RS[2 * m + 1] = 1.f / sqrtf(skv * (1.f / 512.f) + EPS); }
            const float xk = __uint_as_float((unsigned)row[1280 + lane] << 16);
            const float xp = __shfl_xor(xk, 16);
            const int s = m & (SEQ - 1), pos = (lane < 32) ? (s >> 6) : (s & 63), j = lane & 15;
            const float c = ROPE[(pos * 16 + j) * 2], sn = ROPE[(pos * 16 + j) * 2 + 1];
            const float o = ((lane & 16) == 0) ? (xk * c - xp * sn) : (xp * sn + xk * c);
            KR[(size_t)m * 64 + lane] = (bf16)(pkbf(o, 0.f) & 0xffffu);
            { const unsigned char o8 = (unsigned char)(__builtin_amdgcn_cvt_pk_fp8_f32(o, 0.f, 0, false) & 0xff);
#pragma unroll
              for (int hh = 0; hh < 16; ++hh) K8[((size_t)m * 16 + hh) * 192 + 128 + lane] = o8; }
        }
    }
    SEAM(2);
    for (int rep_ = 0; rep_ < REPS(3); ++rep_) if (IN(3)) {
        { pg8::Gemm g{LAT, WUQ, T, 3072, 768, 1536, 768}; pg8::StaticOrder S; S.init(T, 3072, G, bx);
          pg8::EpiQ8 E{Q8, RS, ROPE, MLA_QSCALE * att8::SQ8};
          pg8::gemm_phase<pg8::EpiQ8, pg8::StaticOrder>(ldsl, g, S, E); }
        { pg8::Gemm g{LAT + 768, WUKV, T, 4096, 512, 1536, 512}; pg8::StaticOrder S; S.init(T, 4096, G, bx);
          pg8::EpiKV8 E{K8, VT8, RS};
          pg8::gemm_phase<pg8::EpiKV8, pg8::StaticOrder>(ldsl, g, S, E); }
    }
    SEAM(3);
    for (int rep_ = 0; rep_ < REPS(4); ++rep_) if (IN(4)) {
#ifndef NO_MLA
        if (!(MK_DUP == 4 && rep_ == 0 && MK_DUP4 == 2))
#pragma unroll 1
        for (int u = vcu; u < BATCH * 16 * 32; u += G) { const int bh = u >> 5, qb = u & 31; att8::mla8_unit(bh >> 4, bh & 15, qb, Q8, K8, VT8, OA8, S_OA, (char*)lds); }
#endif
#ifndef NO_NA
        if (!(MK_DUP == 4 && rep_ == 0 && MK_DUP4 == 1))
#pragma unroll 1
        for (int u = vcu; u < BATCH * 16 * 32; u += G) { const int bh = u >> 5, rg = u & 31; att::na_unit(bh >> 4, bh & 15, rg, NAQ, NAK, NAV, na_rpb, OB8, S_OB, (char*)lds); }
#endif
        __syncthreads();
    }
    SEAM(4);

#ifdef MK_CHECK
    {
        xcd_barrier(bar);
        gu32* chk = ctl + 8192;
        const float* xin_q_norm = q_norm; const float* xin_kv_norm = kv_norm;
#define F8DEC(byte) __builtin_amdgcn_cvt_f32_fp8((int)(byte), 0)
        if (bx < 8 && wave == 0) {
            const int ts[8] = {0, 37, 1000, 8191, 8192 + 5, 12345, 16000, 16383}; const int m = ts[bx];
            const bf16* row = LAT + (size_t)m * 1536; float sq = 0.f, skv = 0.f;
            for (int k = lane; k < 768; k += 64) { const float a = __uint_as_float((unsigned)row[k] << 16); sq += a * a; }
            for (int k = lane; k < 512; k += 64) { const float a = __uint_as_float((unsigned)row[768 + k] << 16); skv += a * a; }
            sq = wave_sum(sq); skv = wave_sum(skv);
            const float rq = 1.f / sqrtf(sq / 768.f + EPS), rkv = 1.f / sqrtf(skv / 512.f + EPS);
            float err = fmaxf(fabsf(RS[2 * m] - rq) / rq, fabsf(RS[2 * m + 1] - rkv) / rkv);
            const int s_ = m & (SEQ - 1), half = lane >> 5, j = lane & 15, hiq = (lane >> 4) & 1; const float pos = half ? (float)(s_ & 63) : (float)(s_ >> 6);
            const float ang = pos * powf(10000.0f, -(float)j / 16.0f), cs = cosf(ang), sn = sinf(ang);
            const float x1 = __uint_as_float((unsigned)row[1280 + half * 32 + j] << 16), x2 = __uint_as_float((unsigned)row[1280 + half * 32 + 16 + j] << 16);
            const float ref = hiq ? (x1 * sn + x2 * cs) : (x1 * cs - x2 * sn);
            const float got = __uint_as_float((unsigned)KR[(size_t)m * 64 + lane] << 16);
            float e2 = fabsf(got - ref); e2 = fmaxf(e2, __shfl_xor(e2, 1)); e2 = fmaxf(e2, __shfl_xor(e2, 2)); e2 = fmaxf(e2, __shfl_xor(e2, 4)); e2 = fmaxf(e2, __shfl_xor(e2, 8)); e2 = fmaxf(e2, __shfl_xor(e2, 16)); e2 = fmaxf(e2, __shfl_xor(e2, 32));
            err = fmaxf(err, e2);
            { float e3 = fabsf(F8DEC(K8[((size_t)m * 16 + 5) * 192 + 128 + lane]) - ref) - 0.07f * fabsf(ref); e3 = fmaxf(e3, __shfl_xor(e3, 1)); e3 = fmaxf(e3, __shfl_xor(e3, 2)); e3 = fmaxf(e3, __shfl_xor(e3, 4)); e3 = fmaxf(e3, __shfl_xor(e3, 8)); e3 = fmaxf(e3, __shfl_xor(e3, 16)); e3 = fmaxf(e3, __shfl_xor(e3, 32)); err = fmaxf(err, e3 + 0.03f); }
            if (lane == 0 && !(err < 0.05f)) atomicOr((unsigned*)chk, 1u);
        }
        if (bx >= 8 && bx < 16 && wave == 0) {
            const int ts[4] = {3, 4099, 12345, 16300}; const int m = ts[(bx - 8) & 3] + ((bx - 8) >> 2) * 64;
            {
                const int head = (lane * 5) & 15, kind = lane % 6, i = (lane * 7) & 31; const int col = head * 192 + kind * 32 + i;
                const int pcol = (kind >= 4) ? (head * 192 + kind * 32 + (i ^ 16)) : col;
                const bf16* row = LAT + (size_t)m * 1536; float a = 0.f, b = 0.f, sq = 0.f;
                for (int k = 0; k < 768; ++k) { const float c = __uint_as_float((unsigned)row[k] << 16); sq += c * c; const float cg = c * xin_q_norm[k]; a += cg * w_uq[(size_t)k * 3072 + col]; b += cg * w_uq[(size_t)k * 3072 + pcol]; }
                const float rq = 1.f / sqrtf(sq / 768.f + EPS); a *= rq; b *= rq; float ref = a;
                if (kind >= 4) { const int s_ = m & (SEQ - 1); const float pos = (kind == 4) ? (float)(s_ >> 6) : (float)(s_ & 63); const int j = i & 15; const float ang = pos * powf(10000.0f, -(float)j / 16.0f), cs = cosf(ang), sn = sinf(ang);
                    ref = (i < 16) ? (a * cs - b * sn) : (b * sn + a * cs); }
                ref *= MLA_QSCALE;
                const float got = F8DEC(Q8[(size_t)m * 3072 + col]) * (1.0f / att8::SQ8);
                if (!(fabsf(got - ref) < 0.08f * (0.03f + fabsf(ref)))) atomicOr((unsigned*)chk + 1, 1u);
            }
            {
                const int col = (lane * 67 + 13) & 4095; const bf16* row = LAT + (size_t)m * 1536 + 768; float a = 0.f, sq = 0.f;
                for (int k = 0; k < 512; ++k) { const float c = __uint_as_float((unsigned)row[k] << 16); sq += c * c; a += c * xin_kv_norm[k] * w_ukv[(size_t)k * 4096 + col]; }
                a *= 1.f / sqrtf(sq / 512.f + EPS);
                const int h = col >> 8, c = col & 255;
                const float got = (c < 128) ? F8DEC(K8[((size_t)m * 16 + h) * 192 + c]) : F8DEC(VT8[((size_t)((m >> 13) * 16 + h) * 128 + (c - 128)) * 8192 + (m & 8191)]);
                if (!(fabsf(got - a) < 0.08f * (0.2f + fabsf(a)))) atomicOr((unsigned*)chk + 2, 1u);
            }
        }
        if (bx >= 16 && bx < 48) {
            const int si = bx - 16; const int ts[8] = {1, 255, 256, 4097, 8190, 8192 + 77, 12000, 16383}; const int m = ts[si & 7], h = (si * 5 + (si >> 3) * 3) & 15;
            const int b = m >> 13; LAS float* sc = (LAS float*)ldsl; LAS float* red = sc + 8192; LAS float* qs = red + 512;
            if (tid < 192) qs[tid] = F8DEC(Q8[(size_t)m * 3072 + h * 192 + tid]) * (1.0f / att8::SQ8);
            __syncthreads();
            float mx = -1e30f;
            for (int k = tid; k < SEQ; k += 512) { const size_t kt = (size_t)b * SEQ + k; float s_ = 0.f;
                for (int d = 0; d < 192; ++d) s_ += qs[d] * F8DEC(K8[(kt * 16 + h) * 192 + d]);
                sc[k] = s_; mx = fmaxf(mx, s_); }
            red[tid] = mx; __syncthreads();
            for (int o = 256; o > 0; o >>= 1) { if (tid < o) red[tid] = fmaxf(red[tid], red[tid + o]); __syncthreads(); }
            mx = red[0]; __syncthreads();
            float sm = 0.f;
            for (int k = tid; k < SEQ; k += 512) { const float p_ = exp2f(sc[k] - mx); sc[k] = p_; sm += p_; }
            red[tid] = sm; __syncthreads();
            for (int o = 256; o > 0; o >>= 1) { if (tid < o) red[tid] += red[tid + o]; __syncthreads(); }
            sm = red[0]; __syncthreads();
            const int d = tid & 127, part = tid >> 7; float acc_ = 0.f;
            for (int k = part * 2048; k < (part + 1) * 2048; ++k) acc_ += sc[k] * F8DEC(VT8[((size_t)(b * 16 + h) * 128 + d) * 8192 + k]);
            red[tid] = acc_; __syncthreads();
            float e2 = 0.f, r2 = 0.f;
            if (tid < 128) { const float ref = (red[tid] + red[tid + 128] + red[tid + 256] + red[tid + 384]) / sm;
                const int w_ = (int)OA8[(size_t)m * 2048 + h * 128 + tid]; const float got = __builtin_amdgcn_cvt_f32_fp8(w_, 0) * (1.0f / S_OA);
                e2 = (got - ref) * (got - ref); r2 = ref * ref; }
            __syncthreads();
            if (tid < 128) { red[tid] = e2; red[128 + tid] = r2; }
            __syncthreads();
            if (tid == 0) { float se = 0.f, sr = 0.f; for (int i = 0; i < 128; ++i) { se += red[i]; sr += red[128 + i]; }
                if (!(se < 0.01f * sr)) atomicOr((unsigned*)chk + 3, 1u); }
            __syncthreads();
        }
#undef F8DEC
        xcd_barrier(bar);
    }
#endif
    for (int rep_ = 0; rep_ < REPS(5); ++rep_) if (IN(5)) {
        { pg8::Gemm g{(const bf16*)OA8, PA, T, DM, 2048, 2048, 2048}; pg8::StaticOrder S; S.init(T, DM, G, bx);
          pg8::EpiGate<true> E{GT, MRG, nullptr, 1.0f / (S_OA * S_PAB), 0.f};
          pg8::gemm_phase<pg8::EpiGate<true>, pg8::StaticOrder, true, true>(ldsl, g, S, E); }
    }
    SEAM(5);
    for (int rep_ = 0; rep_ < REPS(6); ++rep_) if (IN(6)) {
        { pg8::Gemm g{(const bf16*)OB8, PB, T, DM, 2048, 2048, 2048}; pg8::StaticOrder S; S.init(T, DM, G, bx);
          pg8::EpiGate<false> E{GT, MRG, MRG8, 1.0f / (S_OB * S_PAB), S_MRG};
          pg8::gemm_phase<pg8::EpiGate<false>, pg8::StaticOrder, true, true>(ldsl, g, S, E); }
    }
    SEAM(6);
    for (int rep_ = 0; rep_ < REPS(7); ++rep_) if (IN(7)) {
        pg8::Gemm g{(const bf16*)MRG8, WOUT, T, DM, DM, DM, DM}; pg8::StaticOrder S; S.init(T, DM, G, bx);
        pg8::EpiF32 E{x, out, DM, 1.0f / (S_MRG * S_WOUT)};
        pg8::gemm_phase<pg8::EpiF32, pg8::StaticOrder, true, true>(ldsl, g, S, E);
#ifdef PROBE_SKIP_ATTN
        VM_WAIT(); __syncthreads();
        for (size_t i = (size_t)gw * 64 + lane; i < (size_t)T * DM / 4; i += (size_t)NGW * 64) ((GAS f32x4*)out)[i] = ((const GAS f32x4*)x)[i];
#endif
    }
    SEAM(7);
    for (int rep_ = 0; rep_ < REPS(8); ++rep_) if (IN(8)) {
        for (int m = gw; m < T; m += NGW) rms_row_to_bf16(out + (size_t)m * DM, ffn_norm, H2 + (size_t)m * DM, lane);
        for (int r = gw; r < 2 * 16384; r += NGW) { const bool isu = r < 16384; const int e = isu ? r : r - 16384;
            peer::pack_row_fp6((isu ? peer_u : peer_v) + (size_t)e * DM, (isu ? U8 : V8) + (size_t)e * peer::ROW6, isu ? peer::U6SCALE : peer::V6SCALE, lane); }
    }
    SEAM(8);
    for (int rep_ = 0; rep_ < REPS(9); ++rep_) if (IN(9)) {
        pg8::Gemm g{H2, WQ, T, 2048, DM, DM, DM}; pg8::StaticOrder S; S.init(T, 2048, G, bx);
        pg8::EpiF32 E{nullptr, QP, 2048, 1.0f};
        pg8::gemm_phase<pg8::EpiF32, pg8::StaticOrder>(ldsl, g, S, E);
    }
    SEAM(9);
    for (int rep_ = 0; rep_ < REPS(10); ++rep_) if (IN(10)) {
        LAS int* wl = (LAS int*)(ldsl + wave * peer::SEL_LDS_PER_WAVE);
        for (int it = gw; it < (T / 32) * 8; it += NGW) peer::select32((it >> 3) * 32, it & 7, QP, SUBH, SUBL, IDX, GATE, wl, lane);
    }
    SEAM(10);
    for (int rep_ = 0; rep_ < REPS(11); ++rep_) if (IN(11)) {
#ifdef PROBE_SKIP_PEER
        for (int t = gw; t < T; t += NGW) { float* xr = out + (size_t)t * DM; f32x4 v[16]; float ss = 0.f;
            for (int j = 0; j < 16; ++j) { v[j] = ((const GAS f32x4*)xr)[lane + 64 * j]; ss += v[j].x * v[j].x + v[j].y * v[j].y + v[j].z * v[j].z + v[j].w * v[j].w; }
            const float rstd = 1.f / sqrtf(wave_sum(ss) * (1.f / DM) + EPS);
            for (int j = 0; j < 16; ++j) { const f32x4 g = ((const GAS f32x4*)final_norm)[lane + 64 * j]; ((GAS f32x4*)xr)[lane + 64 * j] = v[j] * rstd * g; } }
#else
        if (MK_DUP == 11 && rep_ == 0) peer::expert_tokens6<false>(gw, NGW, T, H2, U8, V8, IDX, GATE, out, final_norm, lane);
        else peer::expert_tokens6<true>(gw, NGW, T, H2, U8, V8, IDX, GATE, out, final_norm, lane);
#endif
    }

#ifdef MK_CHECK
    {
        xcd_barrier(bar);
        gu32* chk = ctl + 8192;
        const unsigned f0 = __hip_atomic_load(chk, RLX_AGENT), f1 = __hip_atomic_load(chk + 1, RLX_AGENT), f2 = __hip_atomic_load(chk + 2, RLX_AGENT), f3 = __hip_atomic_load(chk + 3, RLX_AGENT);
        const int nz = (f0 ? T / 2 : 0) + (f1 ? T / 4 : 0) + (f2 ? T / 8 : 0) + (f3 ? T / 16 : 0);
        for (int m = gw; m < nz; m += NGW) for (int j = 0; j < 16; ++j) ((GAS f32x4*)(out + (size_t)m * DM))[lane + 64 * j] = (f32x4){0.f, 0.f, 0.f, 0.f};
    }
#endif
#undef IN
#undef SEAM
}

extern "C" void kernel_launch(void* const* d_in, const int* in_sizes, int n_in, void* d_out, int out_size, void* d_ws, size_t ws_size, hipStream_t stream) {
    static int grid = 0;
    if (grid == 0) {
        if (n_in != 19 || out_size != T * DM || ws_size < WS_END) { fprintf(stderr, "kernel_launch: shape mismatch: n_in %d out %d ws %zu (need %zu)\n", n_in, out_size, ws_size, (size_t)WS_END); grid = -1; return; }
        int dev = 0, cus = 0, per_cu = 0;
        if (hipGetDevice(&dev) != hipSuccess || hipDeviceGetAttribute(&cus, hipDeviceAttributeMultiprocessorCount, dev) != hipSuccess) { grid = -1; return; }
        if (hipFuncSetAttribute((const void*)mk_fwd, hipFuncAttributeMaxDynamicSharedMemorySize, LDS_BYTES) != hipSuccess) { fprintf(stderr, "kernel_launch: hipFuncSetAttribute failed\n"); grid = -1; return; }
        if (hipOccupancyMaxActiveBlocksPerMultiprocessor(&per_cu, (const void*)mk_fwd, NWAVES * 64, LDS_BYTES) != hipSuccess || per_cu < 1) { fprintf(stderr, "kernel_launch: occupancy query says %d blocks per CU\n", per_cu); }
        (void)hipGetLastError();
        grid = cus;
    }
    if (grid < 0) return;
    if (hipMemsetAsync((char*)d_ws + WS_CTL, 0, CTL_ZERO_BYTES, stream) != hipSuccess) return;
    Args a{};
    for (int i = 0; i < 19; ++i) a.in[i] = (const float*)d_in[i];
    a.out = (float*)d_out; a.ws = (unsigned char*)d_ws; a.pad = 0;
    constexpr int NL = MK_CUTS;
    for (int li = 0; li < NL; ++li) {
        a.ph_lo = (NL == 1) ? 0 : li; a.ph_hi = (NL == 1) ? NPH : li + 1; a.use_bar = (NL == 1) ? 1 : 0;
        hipLaunchKernelGGL(mk_fwd, dim3(grid), dim3(NWAVES * 64), LDS_BYTES, stream, a);
    }
}
```

```cpp
#include <hip/hip_runtime.h>
#include <hip/hip_bf16.h>
#include <cstdio>
#include <cstdint>

namespace pg8 {
#define PG8_LAS __attribute__((address_space(3)))
typedef unsigned short bf16_t;
typedef short bf16x8 __attribute__((ext_vector_type(8)));
typedef float f32x4 __attribute__((ext_vector_type(4)));
typedef float f32x2 __attribute__((ext_vector_type(2)));
typedef unsigned u32x4 __attribute__((ext_vector_type(4)));
typedef unsigned u32x2 __attribute__((ext_vector_type(2)));
constexpr int BM = 256, BK = 64, HALF = 128, HTB = HALF * BK * 2  , STAGE_BYTES = 8 * HTB, NXCD = 8, WGM = 8;

__host__ __device__ __forceinline__ int lds_byte(int r, int c) { const int st = (r >> 4) * 2 + (c >> 5), rr = r & 15, cc = c & 31, ob = rr * 64 + cc * 2; return st * 1024 + (ob ^ (((ob >> 9) & 1) << 5)); }
__host__ __device__ __forceinline__ void stage_rc(int b, int& R, int& C) { const int st = b / 1024, sb = b % 1024, swz = sb ^ (((sb >> 9) & 1) << 5); R = (st >> 1) * 16 + swz / 64; C = (st & 1) * 32 + (swz % 64) / 2; }
__host__ __device__ __forceinline__ int lds_byte8(int r, int cb) { const int st = (r >> 4) * 2 + (cb >> 6), ob = (r & 15) * 64 + (cb & 63); return st * 1024 + (ob ^ (((ob >> 9) & 1) << 4)); }
__host__ __device__ __forceinline__ void stage_rc8(int b, int& R, int& CB) { const int st = b / 1024, sb = b % 1024, swz = sb ^ (((sb >> 9) & 1) << 4); R = (st >> 1) * 16 + swz / 64; CB = (st & 1) * 64 + swz % 64; }
__host__ __device__ __forceinline__ int perm32(int rho) { const int n = rho >> 4, i = rho & 15; return 8 * (i >> 2) + 4 * n + (i & 3); }

struct Unit { int pm, pn; };
struct Gemm { const bf16_t* A; const bf16_t* Bt; int M, N, K, lda, ldb; };

struct StaticOrder {
    int nM, nN, nwg, G, c;
    __host__ __device__ void init(int M, int N, int G_, int c_) { nM = M / BM; nN = N / BM; nwg = nM * nN; G = G_; c = c_; }
    __host__ __device__ bool next(int i, Unit& u) const {
        const long L = (long)i * G + c; if (L >= nwg) return false;
        int wgid = (int)L; { const int q = nwg / NXCD, r = nwg % NXCD, xcd = wgid % NXCD, off = wgid / NXCD; wgid = (xcd < r ? xcd * (q + 1) : r * (q + 1) + (xcd - r) * q) + off; }
        const int nig = WGM * nN, gid = wgid / nig, fm = gid * WGM, gsz = (nM - fm) < WGM ? (nM - fm) : WGM;
        u.pm = fm + ((wgid % nig) % gsz); u.pn = (wgid % nig) / gsz; return true;
    }
    __device__ __forceinline__ void a_ready(const Unit&) const {}
    __device__ __forceinline__ void done(const Unit&) const {}
};

__device__ __forceinline__ unsigned cvt_pk_bf16(float lo, float hi) { unsigned r; asm volatile("v_cvt_pk_bf16_f32 %0, %1, %2" : "=v"(r) : "v"(lo), "v"(hi)); return r; }
__device__ __forceinline__ float bf_lo(unsigned w) { return __uint_as_float(w << 16); }
__device__ __forceinline__ float bf_hi(unsigned w) { return __uint_as_float(w & 0xffff0000u); }


typedef int v8i __attribute__((ext_vector_type(8)));
typedef int v4i __attribute__((ext_vector_type(4)));
typedef v8i v8i_a16 __attribute__((aligned(16)));
template <class Epi, class Sched, bool ALIGN_EPI = true, bool FP8 = false>
__device__ __forceinline__ void gemm_phase(PG8_LAS unsigned char* lds, const Gemm g, const Sched& S, const Epi& E) {
    int tid_ = threadIdx.x; asm volatile("" : "+v"(tid_));
    const int tid = tid_, wid = __builtin_amdgcn_readfirstlane(tid >> 6), lane = tid & 63, wr = wid >> 2, wc = wid & 3, fr = lane & 15, fq = lane >> 4;
    const int K = g.K, nt = FP8 ? K / 128 : K / BK;
    unsigned voffA[2], voffB[2];
#pragma unroll
    for (int i = 0; i < 2; ++i) { int R, C; if constexpr (FP8) stage_rc8(tid * 16 + i * 8192, R, C); else stage_rc(tid * 16 + i * 8192, R, C); const int Rb = Epi::PERM ? ((R & ~31) + perm32(R & 31)) : R;
        voffA[i] = FP8 ? (unsigned)(R * g.lda + C) : (unsigned)(R * g.lda + C) * 2u; voffB[i] = FP8 ? (unsigned)(Rb * g.ldb + C) : (unsigned)(Rb * g.ldb + C) * 2u; }
    const size_t kstep = (size_t)(BK * 2);
    const size_t hstepA = (size_t)HALF * g.lda * (FP8 ? 1 : 2), hstepB = (size_t)HALF * g.ldb * (FP8 ? 1 : 2);
    const size_t tstepA = 2 * hstepA, tstepB = 2 * hstepB;
    const unsigned ldsw = (unsigned)wid * 1024u;
    const int aoff = FP8 ? lds_byte8(wr * 64 + fr, fq * 32) : lds_byte(wr * 64 + fr, fq * 8), boff = FP8 ? lds_byte8(wc * 32 + fr, fq * 32) : lds_byte(wc * 32 + fr, fq * 8);
    const int aoff2 = aoff ^ 16, boff2 = boff ^ 16;
#define PG8_SA(b, h) (((b) * 2 + (h)) * HTB)
#define PG8_SB(b, h) ((4 + (b) * 2 + (h)) * HTB)
#define PG8_STAGE(bufoff, gbase, voff) do { _Pragma("unroll") for (int _i = 0; _i < 2; ++_i) \
        __builtin_amdgcn_global_load_lds((const unsigned*)((const char*)(gbase) + (voff)[_i]), (PG8_LAS unsigned*)(lds + (bufoff) + ldsw + _i * 8192), 16, 0, 0); } while (0)
#define PG8_LDA(dst, b, h) do { if constexpr (FP8) { _Pragma("unroll") for (int m = 0; m < 4; ++m) { const bf16x8 lo_ = *(const PG8_LAS bf16x8*)(lds + PG8_SA(b, h) + aoff + m * 2048), hi_ = *(const PG8_LAS bf16x8*)(lds + PG8_SA(b, h) + aoff2 + m * 2048); \
            dst##8[m] = __builtin_shufflevector(__builtin_bit_cast(v4i, lo_), __builtin_bit_cast(v4i, hi_), 0, 1, 2, 3, 4, 5, 6, 7); } } \
        else { _Pragma("unroll") for (int m = 0; m < 4; ++m) _Pragma("unroll") for (int k = 0; k < 2; ++k) dst[m][k] = *(const PG8_LAS bf16x8*)(lds + PG8_SA(b, h) + aoff + m * 2048 + k * 1024); } } while (0)
#define PG8_LDB(dst, b, h) do { if constexpr (FP8) { _Pragma("unroll") for (int n = 0; n < 2; ++n) { const bf16x8 lo_ = *(const PG8_LAS bf16x8*)(lds + PG8_SB(b, h) + boff + n * 2048), hi_ = *(const PG8_LAS bf16x8*)(lds + PG8_SB(b, h) + boff2 + n * 2048); \
            dst##8[n] = __builtin_shufflevector(__builtin_bit_cast(v4i, lo_), __builtin_bit_cast(v4i, hi_), 0, 1, 2, 3, 4, 5, 6, 7); } } \
        else { _Pragma("unroll") for (int n = 0; n < 2; ++n) _Pragma("unroll") for (int k = 0; k < 2; ++k) dst[n][k] = *(const PG8_LAS bf16x8*)(lds + PG8_SB(b, h) + boff + n * 2048 + k * 1024); } } while (0)
#define PG8_V8(F) __builtin_shufflevector(__builtin_bit_cast(v4i, (F)[0]), __builtin_bit_cast(v4i, (F)[1]), 0, 1, 2, 3, 4, 5, 6, 7)
#define PG8_MMA(ai, bj, At, Bt) do { __builtin_amdgcn_s_setprio(1); _Pragma("unroll") for (int m = 0; m < 4; ++m) _Pragma("unroll") for (int n = 0; n < 2; ++n) { \
        if constexpr (FP8) asm volatile("v_mfma_f32_16x16x128_f8f6f4 %0, %1, %2, %0" : "+v"(acc[ai][bj][m][n]) : "v"(Bt##8[n]), "v"(At##8[m])); \
        else { _Pragma("unroll") for (int k = 0; k < 2; ++k) acc[ai][bj][m][n] = __builtin_amdgcn_mfma_f32_16x16x32_bf16(Bt[n][k], At[m][k], acc[ai][bj][m][n], 0, 0, 0); } } \
        __builtin_amdgcn_s_setprio(0); } while (0)
#define PG8_WAIT_V(n) asm volatile("s_waitcnt vmcnt(" #n ")" ::: "memory")
#define PG8_WAIT_L(n) asm volatile("s_waitcnt lgkmcnt(" #n ")" ::: "memory")
#define PG8_BAR __builtin_amdgcn_s_barrier()
#define PG8_SCHED __builtin_amdgcn_sched_barrier(0)
    Unit cur, nxt; int ui = 0;
    if (!S.next(0, cur)) return;
    f32x4 acc[2][2][4][2];
#pragma unroll
    for (int a = 0; a < 2; ++a)
#pragma unroll
        for (int b = 0; b < 2; ++b)
#pragma unroll
            for (int m = 0; m < 4; ++m)
#pragma unroll
                for (int n = 0; n < 2; ++n) acc[a][b][m][n] = (f32x4){0.f, 0.f, 0.f, 0.f};
    bf16x8 At[4][2], B0[2][2], B1[2][2]; v8i At8[4], B08[2], B18[2];
    const char* cA = (const char*)g.A + (size_t)cur.pm * tstepA; const char* cB = (const char*)g.Bt + (size_t)cur.pn * tstepB;
    S.a_ready(cur);
    PG8_STAGE(PG8_SB(0, 0), cB, voffB); PG8_STAGE(PG8_SB(0, 1), cB + hstepB, voffB); PG8_STAGE(PG8_SA(0, 0), cA, voffA); PG8_STAGE(PG8_SA(0, 1), cA + hstepA, voffA);
    if (wr == 1) PG8_BAR;
    PG8_WAIT_V(2); PG8_BAR;
    PG8_STAGE(PG8_SB(1, 0), cB + kstep, voffB); PG8_STAGE(PG8_SA(1, 0), cA + kstep, voffA); PG8_STAGE(PG8_SB(1, 1), cB + hstepB + kstep, voffB);
    PG8_WAIT_V(6); PG8_BAR;
    for (;;) {
        const bool has_next = S.next(ui + 1, nxt);
        const char* nA = has_next ? (const char*)g.A + (size_t)nxt.pm * tstepA : cA; const char* nB = has_next ? (const char*)g.Bt + (size_t)nxt.pn * tstepB : cB;
        for (int t = 0; t < nt; t += 2) {
            const bool last = (t == nt - 2);
            const char* a1 = cA + (size_t)(t + 1) * kstep;
            const char* a2 = last ? nA : cA + (size_t)(t + 2) * kstep; const char* b2 = last ? nB : cB + (size_t)(t + 2) * kstep;
            const char* a3 = a2 + kstep; const char* b3 = b2 + kstep;
            if (last && has_next) S.a_ready(nxt);
            PG8_LDB(B0, 0, 0); PG8_LDB(B1, 0, 1); PG8_SCHED; PG8_LDA(At, 0, 0); PG8_STAGE(PG8_SA(1, 1), a1 + hstepA, voffA);
            PG8_WAIT_V(8); PG8_WAIT_L(0); PG8_BAR; PG8_MMA(0, 0, At, B0); PG8_MMA(0, 1, At, B1); PG8_BAR; PG8_SCHED;
            PG8_LDA(At, 0, 1); PG8_STAGE(PG8_SB(0, 0), b2, voffB); PG8_STAGE(PG8_SB(0, 1), b2 + hstepB, voffB); PG8_STAGE(PG8_SA(0, 0), a2, voffA);
            PG8_WAIT_V(8); PG8_WAIT_L(0); PG8_BAR; PG8_MMA(1, 0, At, B0); PG8_MMA(1, 1, At, B1); PG8_BAR; PG8_SCHED;
            PG8_LDB(B0, 1, 0); PG8_LDB(B1, 1, 1); PG8_SCHED; PG8_LDA(At, 1, 0); PG8_STAGE(PG8_SA(0, 1), a2 + hstepA, voffA);
            PG8_WAIT_V(8); PG8_WAIT_L(0); PG8_BAR; PG8_MMA(0, 0, At, B0); PG8_MMA(0, 1, At, B1); PG8_BAR; PG8_SCHED;
            PG8_LDA(At, 1, 1); PG8_STAGE(PG8_SB(1, 0), b3, voffB); PG8_STAGE(PG8_SB(1, 1), b3 + hstepB, voffB); PG8_STAGE(PG8_SA(1, 0), a3, voffA);
            PG8_WAIT_V(8); PG8_WAIT_L(0); PG8_BAR; PG8_MMA(1, 0, At, B0); PG8_MMA(1, 1, At, B1); PG8_BAR; PG8_SCHED;
        }
        if constexpr (ALIGN_EPI) { if (wr == 0) PG8_BAR; }
        if constexpr (FP8) asm volatile("s_nop 15\n\ts_nop 7" ::: "memory");
        { int l_ = threadIdx.x; asm volatile("" : "+v"(l_));
          E(acc, cur, wr, wc, l_ & 15, (l_ >> 4) & 3); } S.done(cur);
        if (!has_next) break;
#pragma unroll
        for (int a = 0; a < 2; ++a)
#pragma unroll
            for (int b = 0; b < 2; ++b)
#pragma unroll
                for (int m = 0; m < 4; ++m)
#pragma unroll
                    for (int n = 0; n < 2; ++n) acc[a][b][m][n] = (f32x4){0.f, 0.f, 0.f, 0.f};
        cur = nxt; cA = nA; cB = nB; ++ui;
        if constexpr (ALIGN_EPI) { if (wr == 1) PG8_BAR; }
    }
    PG8_WAIT_V(0);
    if constexpr (!ALIGN_EPI) { if (wr == 0) PG8_BAR; }
    PG8_BAR;
#undef PG8_SA
#undef PG8_SB
#undef PG8_STAGE
#undef PG8_LDA
#undef PG8_LDB
#undef PG8_MMA
#undef PG8_V8
#undef PG8_WAIT_V
#undef PG8_WAIT_L
#undef PG8_BAR
#undef PG8_SCHED
}

__device__ __forceinline__ unsigned pk4_fp8(float a, float b, float c, float d) { int w = __builtin_amdgcn_cvt_pk_fp8_f32(a, b, 0, false); w = __builtin_amdgcn_cvt_pk_fp8_f32(c, d, w, true); return (unsigned)w; }
__device__ __forceinline__ float sigmoidf_fast(float x) { return __builtin_amdgcn_rcpf(1.0f + __builtin_amdgcn_exp2f(-1.4426950408889634f * x)); }

struct EpiIn {
    static constexpr bool PERM = true;
    unsigned char* wsb; size_t off_lat, off_na, na_stride, off_g; const float* bgate; float qscale; float ascale;
    __device__ __forceinline__ void operator()(const f32x4 (&acc)[2][2][4][2], const Unit& u, int wr, int wc, int fr, int fq) const {
        const int row0 = u.pm * BM + wr * 64 + fr; const int pn = u.pn;
        size_t boff; int ldc, colt; float sc = 1.f; bool gate = false;
        if (pn < 6) { boff = off_lat; ldc = 1536; colt = pn * 256; }
        else if (pn < 30) { const int t = (pn - 6) >> 3; boff = off_na + (size_t)t * na_stride; ldc = 2048; colt = ((pn - 6) & 7) * 256; if (t == 0) sc = qscale; }
        else { boff = off_g; ldc = 8192; colt = (pn - 30) * 256; gate = true; }
        bf16_t* base = (bf16_t*)(wsb + boff);
        const int col0 = colt + wc * 32 + 8 * fq;
        f32x4 bv[2][2];
#pragma unroll
        for (int bj = 0; bj < 2; ++bj)
#pragma unroll
            for (int n = 0; n < 2; ++n) bv[bj][n] = gate ? *(const f32x4*)(bgate + col0 + bj * HALF + 4 * n) : (f32x4){0.f, 0.f, 0.f, 0.f};
#pragma unroll
        for (int ai = 0; ai < 2; ++ai)
#pragma unroll
            for (int m = 0; m < 4; ++m) { bf16_t* rowp = base + (size_t)(row0 + ai * HALF + m * 16) * ldc + col0;
#pragma unroll
                for (int bj = 0; bj < 2; ++bj) { f32x4 v0 = acc[ai][bj][m][0] * ascale + bv[bj][0], v1 = acc[ai][bj][m][1] * ascale + bv[bj][1];
                    if (gate) {
#pragma unroll
                        for (int i = 0; i < 4; ++i) { v0[i] = sigmoidf_fast(v0[i]); v1[i] = sigmoidf_fast(v1[i]); } }
                    else { v0 = v0 * sc; v1 = v1 * sc; }
                    u32x4 w; w.x = cvt_pk_bf16(v0[0], v0[1]); w.y = cvt_pk_bf16(v0[2], v0[3]); w.z = cvt_pk_bf16(v1[0], v1[1]); w.w = cvt_pk_bf16(v1[2], v1[3]);
                    *(u32x4*)(rowp + bj * HALF) = w; } }
    }
};

struct EpiQ {
    static constexpr bool PERM = false;
    bf16_t* Q; const float* rs; const float* rope; float qscale;
    __device__ __forceinline__ void operator()(const f32x4 (&acc)[2][2][4][2], const Unit& u, int wr, int wc, int fr, int fq) const {
#pragma unroll
        for (int ai = 0; ai < 2; ++ai)
#pragma unroll
            for (int m = 0; m < 4; ++m) {
                const int row = u.pm * BM + ai * HALF + wr * 64 + m * 16 + fr;
                const float rstd = rs[2 * row] * qscale;
                const int s = row & 8191, grow = s >> 6, gcol = s & 63;
#pragma unroll
                for (int bj = 0; bj < 2; ++bj) {
                    const int gg = 8 * u.pn + 4 * bj + wc, kind = gg % 6;
                    f32x4 v0 = acc[ai][bj][m][0] * rstd, v1 = acc[ai][bj][m][1] * rstd;
                    if (kind >= 4) {
                        const int pos = (kind == 4) ? grow : gcol;
                        const f32x4 t0 = *(const f32x4*)(rope + (size_t)(pos * 16 + 4 * fq) * 2), t1 = *(const f32x4*)(rope + (size_t)(pos * 16 + 4 * fq) * 2 + 4);
                        const float c0 = t0[0], s0 = t0[1], c1 = t0[2], s1 = t0[3], c2 = t1[0], s2 = t1[1], c3 = t1[2], s3 = t1[3];
                        f32x4 o0, o1;
                        o0[0] = v0[0] * c0 - v1[0] * s0; o1[0] = v0[0] * s0 + v1[0] * c0;
                        o0[1] = v0[1] * c1 - v1[1] * s1; o1[1] = v0[1] * s1 + v1[1] * c1;
                        o0[2] = v0[2] * c2 - v1[2] * s2; o1[2] = v0[2] * s2 + v1[2] * c2;
                        o0[3] = v0[3] * c3 - v1[3] * s3; o1[3] = v0[3] * s3 + v1[3] * c3;
                        v0 = o0; v1 = o1;
                    }
                    bf16_t* p = Q + (size_t)row * 3072 + u.pn * BM + bj * HALF + wc * 32 + 4 * fq;
                    u32x2 w0, w1; w0.x = cvt_pk_bf16(v0[0], v0[1]); w0.y = cvt_pk_bf16(v0[2], v0[3]); w1.x = cvt_pk_bf16(v1[0], v1[1]); w1.y = cvt_pk_bf16(v1[2], v1[3]);
                    *(u32x2*)p = w0; *(u32x2*)(p + 16) = w1;
                }
            }
    }
};

struct EpiKV {
    static constexpr bool PERM = true;
    bf16_t* Kn; bf16_t* Vm; const float* rs;
    __device__ __forceinline__ void operator()(const f32x4 (&acc)[2][2][4][2], const Unit& u, int wr, int wc, int fr, int fq) const {
        const int col0 = u.pn * HALF + wc * 32 + 8 * fq;
#pragma unroll
        for (int ai = 0; ai < 2; ++ai)
#pragma unroll
            for (int m = 0; m < 4; ++m) {
                const int row = u.pm * BM + ai * HALF + wr * 64 + m * 16 + fr;
                const float rstd = rs[2 * row + 1];
#pragma unroll
                for (int bj = 0; bj < 2; ++bj) { const f32x4 v0 = acc[ai][bj][m][0] * rstd, v1 = acc[ai][bj][m][1] * rstd;
                    u32x4 w; w.x = cvt_pk_bf16(v0[0], v0[1]); w.y = cvt_pk_bf16(v0[2], v0[3]); w.z = cvt_pk_bf16(v1[0], v1[1]); w.w = cvt_pk_bf16(v1[2], v1[3]);
                    *(u32x4*)((bj == 0 ? Kn : Vm) + (size_t)row * 2048 + col0) = w; }
            }
    }
};


struct EpiQ8 {
    static constexpr bool PERM = false;
    unsigned char* Q8; const float* rs; const float* rope; float qscale;
    __device__ __forceinline__ void operator()(const f32x4 (&acc)[2][2][4][2], const Unit& u, int wr, int wc, int fr, int fq) const {
#pragma unroll
        for (int ai = 0; ai < 2; ++ai)
#pragma unroll
            for (int m = 0; m < 4; ++m) {
                const int row = u.pm * BM + ai * HALF + wr * 64 + m * 16 + fr;
                const float rstd = rs[2 * row] * qscale;
                const int s = row & 8191, grow = s >> 6, gcol = s & 63;
#pragma unroll
                for (int bj = 0; bj < 2; ++bj) {
                    const int gg = 8 * u.pn + 4 * bj + wc, kind = gg % 6;
                    f32x4 v0 = acc[ai][bj][m][0] * rstd, v1 = acc[ai][bj][m][1] * rstd;
                    if (kind >= 4) {
                        const int pos = (kind == 4) ? grow : gcol;
                        const f32x4 t0 = *(const f32x4*)(rope + (size_t)(pos * 16 + 4 * fq) * 2), t1 = *(const f32x4*)(rope + (size_t)(pos * 16 + 4 * fq) * 2 + 4);
                        const float c0 = t0[0], s0 = t0[1], c1 = t0[2], s1 = t0[3], c2 = t1[0], s2 = t1[1], c3 = t1[2], s3 = t1[3];
                        f32x4 o0, o1;
                        o0[0] = v0[0] * c0 - v1[0] * s0; o1[0] = v0[0] * s0 + v1[0] * c0;
                        o0[1] = v0[1] * c1 - v1[1] * s1; o1[1] = v0[1] * s1 + v1[1] * c1;
                        o0[2] = v0[2] * c2 - v1[2] * s2; o1[2] = v0[2] * s2 + v1[2] * c2;
                        o0[3] = v0[3] * c3 - v1[3] * s3; o1[3] = v0[3] * s3 + v1[3] * c3;
                        v0 = o0; v1 = o1;
                    }
                    unsigned char* p = Q8 + (size_t)row * 3072 + u.pn * BM + bj * HALF + wc * 32 + 4 * fq;
                    *(unsigned*)p = pk4_fp8(v0[0], v0[1], v0[2], v0[3]); *(unsigned*)(p + 16) = pk4_fp8(v1[0], v1[1], v1[2], v1[3]);
                }
            }
    }
};
struct EpiKV8 {
    static constexpr bool PERM = true;
    unsigned char* K8; unsigned char* VT8; const float* rs;
    __device__ __forceinline__ void operator()(const f32x4 (&acc)[2][2][4][2], const Unit& u, int wr, int wc, int fr, int fq) const {
        const int c0 = wc * 32 + 8 * fq, h = u.pn;
#pragma unroll
        for (int ai = 0; ai < 2; ++ai)
#pragma unroll
            for (int m = 0; m < 4; ++m) {
                const int row = u.pm * BM + ai * HALF + wr * 64 + m * 16 + fr;
                const float rstd = rs[2 * row + 1];
                { const f32x4 v0 = acc[ai][0][m][0] * rstd, v1 = acc[ai][0][m][1] * rstd;
                  u32x2 w; w.x = pk4_fp8(v0[0], v0[1], v0[2], v0[3]); w.y = pk4_fp8(v1[0], v1[1], v1[2], v1[3]);
                  *(u32x2*)(K8 + ((size_t)row * 16 + h) * 192 + c0) = w; }
                { const f32x4 v0 = acc[ai][1][m][0] * rstd, v1 = acc[ai][1][m][1] * rstd;
                  const unsigned w0 = pk4_fp8(v0[0], v0[1], v0[2], v0[3]), w1 = pk4_fp8(v1[0], v1[1], v1[2], v1[3]);
                  unsigned char* vp = VT8 + ((size_t)((row >> 13) * 16 + h) * 128 + c0) * 8192 + (row & 8191);
                  vp[0] = (unsigned char)(w0 & 0xff); vp[8192] = (unsigned char)((w0 >> 8) & 0xff); vp[2 * 8192] = (unsigned char)((w0 >> 16) & 0xff); vp[3 * 8192] = (unsigned char)(w0 >> 24);
                  vp[4 * 8192] = (unsigned char)(w1 & 0xff); vp[5 * 8192] = (unsigned char)((w1 >> 8) & 0xff); vp[6 * 8192] = (unsigned char)((w1 >> 16) & 0xff); vp[7 * 8192] = (unsigned char)(w1 >> 24); }
            }
    }
};

template <bool FIRST> struct EpiGate {
    static constexpr bool PERM = true;
    const bf16_t* G; bf16_t* MRG; unsigned char* M8; float ascale, oscale;
    __device__ __forceinline__ void operator()(const f32x4 (&acc)[2][2][4][2], const Unit& u, int wr, int wc, int fr, int fq) const {
        const int col0 = u.pn * BM + wc * 32 + 8 * fq;
#pragma unroll
        for (int ai = 0; ai < 2; ++ai)
#pragma unroll
            for (int m = 0; m < 4; ++m) {
                const int row = u.pm * BM + ai * HALF + wr * 64 + m * 16 + fr;
#pragma unroll
                for (int bj = 0; bj < 2; ++bj) {
                    const int col = col0 + bj * HALF;
                    const u32x4 gw = *(const u32x4*)(G + (size_t)row * 8192 + (FIRST ? 0 : 4096) + col);
                    f32x4 v0 = acc[ai][bj][m][0] * ascale, v1 = acc[ai][bj][m][1] * ascale;
                    v0[0] *= bf_lo(gw.x); v0[1] *= bf_hi(gw.x); v0[2] *= bf_lo(gw.y); v0[3] *= bf_hi(gw.y);
                    v1[0] *= bf_lo(gw.z); v1[1] *= bf_hi(gw.z); v1[2] *= bf_lo(gw.w); v1[3] *= bf_hi(gw.w);
                    bf16_t* p = MRG + (size_t)row * 4096 + col;
                    if (!FIRST) { const u32x4 pw = *(const u32x4*)p;
                        v0[0] += bf_lo(pw.x); v0[1] += bf_hi(pw.x); v0[2] += bf_lo(pw.y); v0[3] += bf_hi(pw.y);
                        v1[0] += bf_lo(pw.z); v1[1] += bf_hi(pw.z); v1[2] += bf_lo(pw.w); v1[3] += bf_hi(pw.w); }
                    if constexpr (FIRST) { u32x4 w; w.x = cvt_pk_bf16(v0[0], v0[1]); w.y = cvt_pk_bf16(v0[2], v0[3]); w.z = cvt_pk_bf16(v1[0], v1[1]); w.w = cvt_pk_bf16(v1[2], v1[3]);
                        *(u32x4*)p = w; }
                    else { v0 = v0 * oscale; v1 = v1 * oscale; u32x2 w; w.x = pk4_fp8(v0[0], v0[1], v0[2], v0[3]); w.y = pk4_fp8(v1[0], v1[1], v1[2], v1[3]);
                        *(u32x2*)(M8 + (size_t)row * 4096 + col) = w; }
                }
            }
    }
};

struct EpiF32 {
    static constexpr bool PERM = false;
    const float* base; float* out; int ldc; float ascale;
    __device__ __forceinline__ void operator()(const f32x4 (&acc)[2][2][4][2], const Unit& u, int wr, int wc, int fr, int fq) const {
        const int col0 = u.pn * BM + wc * 32 + 4 * fq;
#pragma unroll
        for (int ai = 0; ai < 2; ++ai)
#pragma unroll
            for (int m = 0; m < 4; ++m) { const size_t off = (size_t)(u.pm * BM + ai * HALF + wr * 64 + m * 16 + fr) * ldc + col0;
#pragma unroll
                for (int bj = 0; bj < 2; ++bj)
#pragma unroll
                    for (int n = 0; n < 2; ++n) { f32x4 o = acc[ai][bj][m][n] * ascale; if (base) o = o + *(const f32x4*)(base + off + bj * HALF + n * 16); *(f32x4*)(out + off + bj * HALF + n * 16) = o; } }
    }
};
}

namespace att {
using bf16x8 = __attribute__((ext_vector_type(8))) short;
using s16x4  = __attribute__((ext_vector_type(4))) short;
using f32x16 = __attribute__((ext_vector_type(16))) float;
using u32x4  = __attribute__((ext_vector_type(4))) unsigned;
typedef unsigned short bf16_t;
constexpr int NW = 8, QBLK = 32, KVBLK = 64, SEQ = 8192, NHEAD = 16;
constexpr int SHM_V = KVBLK * 128 * 2, SHM_KN = KVBLK * 128 * 2, SHM_KR = KVBLK * 64 * 2;
constexpr int OFF_V = 0, OFF_KN = 2 * SHM_V, OFF_KR = OFF_KN + 2 * SHM_KN, OFF_WS = OFF_KR + 2 * SHM_KR, OFF_BIAS = OFF_WS + NW * 64 * 4, OFF_QR = OFF_BIAS + 2048, ATT_LDS_BYTES = OFF_QR + NW * 4096;
#define KSWZ(row, colB) ((row) * 256 + ((colB) ^ (((row) & 7) << 4)))
#define KRSWZ(row, chunk) ((row) * 128 + ((((chunk) ^ (((row) >> 1) & 7))) << 4))
#define ASBAR() __builtin_amdgcn_sched_barrier(0)
__device__ __forceinline__ int crow(int r, int hi) { return (r & 3) + 8 * (r >> 2) + 4 * hi; }
__device__ __forceinline__ unsigned cvtpk(float lo, float hi) { unsigned r; asm volatile("v_cvt_pk_bf16_f32 %0, %1, %2" : "=v"(r) : "v"(lo), "v"(hi)); return r; }
__device__ __forceinline__ bf16x8 ld8(const bf16_t* p) { return *reinterpret_cast<const bf16x8*>(p); }

constexpr float THR2 = 11.5f;
__device__ __forceinline__ void partialSM(f32x16& p0, f32x16& p1, float& m_reg, float& mn, float& alpha) {
  float pmax = p0[0];
#pragma unroll
  for (int r = 1; r < 16; ++r) pmax = fmaxf(pmax, p0[r]);
#pragma unroll
  for (int r = 0; r < 16; ++r) pmax = fmaxf(pmax, p1[r]);
  { auto rr = __builtin_amdgcn_permlane32_swap(__float_as_uint(pmax), __float_as_uint(pmax), false, false);
    pmax = fmaxf(__uint_as_float(rr[0]), __uint_as_float(rr[1])); }
  if (__builtin_expect(__all(pmax - m_reg <= THR2), 1)) { mn = m_reg; alpha = 1.f; }
  else { mn = fmaxf(m_reg, pmax); alpha = __builtin_amdgcn_exp2f(m_reg - mn); m_reg = mn; }
#pragma unroll
  for (int r = 0; r < 16; ++r) p0[r] = p0[r] - mn;
#pragma unroll
  for (int r = 0; r < 16; ++r) p1[r] = p1[r] - mn;
#pragma unroll
  for (int r = 0; r < 16; ++r) p0[r] = __builtin_amdgcn_exp2f(p0[r]);
}
__device__ __forceinline__ void finishSM(f32x16& p0, f32x16& p1, float alpha, float& l_reg, bf16x8& pa0, bf16x8& pa1, bf16x8& pa2, bf16x8& pa3) {
#pragma unroll
  for (int r = 0; r < 16; ++r) p1[r] = __builtin_amdgcn_exp2f(p1[r]);
  float ps = 0;
#pragma unroll
  for (int r = 0; r < 16; ++r) ps += p0[r];
#pragma unroll
  for (int r = 0; r < 16; ++r) ps += p1[r];
  { auto rr = __builtin_amdgcn_permlane32_swap(__float_as_uint(ps), __float_as_uint(ps), false, false);
    ps = __uint_as_float(rr[0]) + __uint_as_float(rr[1]); }
  l_reg = l_reg * alpha + ps;
#define PK4(P, BASE, OUT) do { unsigned a0 = cvtpk(P[BASE + 0], P[BASE + 1]), a1 = cvtpk(P[BASE + 2], P[BASE + 3]);   \
    unsigned b0 = cvtpk(P[BASE + 4], P[BASE + 5]), b1 = cvtpk(P[BASE + 6], P[BASE + 7]);                              \
    auto r0 = __builtin_amdgcn_permlane32_swap(a0, b0, false, false); auto r1 = __builtin_amdgcn_permlane32_swap(a1, b1, false, false); \
    u32x4 w = {r0[0], r1[0], r0[1], r1[1]}; OUT = *reinterpret_cast<bf16x8*>(&w); } while (0)
  PK4(p0, 0, pa0); PK4(p0, 8, pa1); PK4(p1, 0, pa2); PK4(p1, 8, pa3);
}
__device__ __forceinline__ int v_st(int k, int c) { const int kk = (k & ~0xC) | ((k & 4) << 1) | ((k & 8) >> 1); return ((kk >> 3) * 4 + (c >> 5)) * 512 + ((kk & 7) * 32 + (c & 31)) * 2; }
__device__ __forceinline__ int v_rd_base(int lane) { return ((lane & 3) << 3) | (((lane >> 2) & 3) << 6) | (((lane >> 4) & 1) << 5) | (((lane >> 5) & 1) << 8); }
constexpr int v_rd_off(int d0, int ks, int half) { return d0 * 512 + ks * 4096 + half * 2048; }
template <int OFF> __device__ __forceinline__ s16x4 tr_read(int vb) {
  s16x4 r; asm volatile("ds_read_b64_tr_b16 %0, %1 offset:%2" : "=&v"(r) : "v"(vb), "i"(OFF) : "memory"); return r;
}
template <int D0> __device__ __forceinline__ void pv_one(f32x16& od, int vb, bf16x8 pa0, bf16x8 pa1, bf16x8 pa2, bf16x8 pa3) {
  const s16x4 l0 = tr_read<v_rd_off(D0, 0, 0)>(vb), h0 = tr_read<v_rd_off(D0, 0, 1)>(vb), l1 = tr_read<v_rd_off(D0, 1, 0)>(vb), h1 = tr_read<v_rd_off(D0, 1, 1)>(vb);
  const s16x4 l2 = tr_read<v_rd_off(D0, 2, 0)>(vb), h2 = tr_read<v_rd_off(D0, 2, 1)>(vb), l3 = tr_read<v_rd_off(D0, 3, 0)>(vb), h3 = tr_read<v_rd_off(D0, 3, 1)>(vb);
  asm volatile("s_waitcnt lgkmcnt(0)" ::: "memory"); ASBAR();
#define PKV(L, H) (bf16x8){L[0], L[1], L[2], L[3], H[0], H[1], H[2], H[3]}
  od = __builtin_amdgcn_mfma_f32_32x32x16_bf16(pa0, PKV(l0, h0), od, 0, 0, 0);
  od = __builtin_amdgcn_mfma_f32_32x32x16_bf16(pa1, PKV(l1, h1), od, 0, 0, 0);
  od = __builtin_amdgcn_mfma_f32_32x32x16_bf16(pa2, PKV(l2, h2), od, 0, 0, 0);
  od = __builtin_amdgcn_mfma_f32_32x32x16_bf16(pa3, PKV(l3, h3), od, 0, 0, 0);
#undef PKV
}
__device__ __forceinline__ void pv_d0(f32x16* o, int vb, bf16x8 pa0, bf16x8 pa1, bf16x8 pa2, bf16x8 pa3) {
  pv_one<0>(o[0], vb, pa0, pa1, pa2, pa3); pv_one<1>(o[1], vb, pa0, pa1, pa2, pa3); pv_one<2>(o[2], vb, pa0, pa1, pa2, pa3); pv_one<3>(o[3], vb, pa0, pa1, pa2, pa3);
}
template <int NROPE> __device__ __forceinline__ void qkt(f32x16& p0, f32x16& p1, const char* Kn, const char* Kr, const bf16x8* qr, const char* qrl, int r32, int hi) {
  p0 = f32x16{}; p1 = f32x16{};
#pragma unroll
  for (int d0 = 0; d0 < 8; ++d0) { const int cb = (d0 * 16 + hi * 8) * 2;
    const bf16x8 b0 = *reinterpret_cast<const bf16x8*>(Kn + KSWZ(r32, cb));
    const bf16x8 b1 = *reinterpret_cast<const bf16x8*>(Kn + KSWZ(32 + r32, cb));
    p0 = __builtin_amdgcn_mfma_f32_32x32x16_bf16(b0, qr[d0], p0, 0, 0, 0);
    p1 = __builtin_amdgcn_mfma_f32_32x32x16_bf16(b1, qr[d0], p1, 0, 0, 0); }
#pragma unroll
  for (int d0 = 0; d0 < NROPE; ++d0) { const int ch = d0 * 2 + hi;
    const bf16x8 b0 = *reinterpret_cast<const bf16x8*>(Kr + KRSWZ(r32, ch));
    const bf16x8 b1 = *reinterpret_cast<const bf16x8*>(Kr + KRSWZ(32 + r32, ch));
    const bf16x8 qf = *reinterpret_cast<const bf16x8*>(qrl + d0 * 1024);
    p0 = __builtin_amdgcn_mfma_f32_32x32x16_bf16(b0, qf, p0, 0, 0, 0);
    p1 = __builtin_amdgcn_mfma_f32_32x32x16_bf16(b1, qf, p1, 0, 0, 0); }
}

__device__ __forceinline__ void mla_unit(int b, int h, int qb, const bf16_t* __restrict__ Q, const bf16_t* __restrict__ KN, const bf16_t* __restrict__ KR, const bf16_t* __restrict__ VM, unsigned char* __restrict__ O, float oscale, char* lds) {
  int tid_ = threadIdx.x; asm volatile("" : "+v"(tid_));
  const int tid = tid_, wid = tid >> 6, lane = tid & 63, r32 = lane & 31, hi = lane >> 5;
  char* V_lds = lds + OFF_V; char* Kn_lds = lds + OFF_KN; char* Kr_lds = lds + OFF_KR;
  float* ws = (float*)(lds + OFF_WS) + wid * 64; float* li_l = ws; float* al_l = ws + 32;
  float m_reg = -1e30f, l_reg = 0; f32x16 o[4] = {}; bf16x8 qr[8];
  char* qrl = lds + OFF_QR + wid * 4096 + (hi * 32 + r32) * 16;
  const long rowbase = (long)b * SEQ;
  const bf16_t* Qw = Q + (rowbase + qb * 256 + wid * QBLK + r32) * 3072 + h * 192 + hi * 8;
#pragma unroll
  for (int d0 = 0; d0 < 8; ++d0) qr[d0] = ld8(Qw + d0 * 16);
  const bf16_t* Kh = KN + rowbase * 2048 + h * 128; const bf16_t* Vh = VM + rowbase * 2048 + h * 128; const bf16_t* Krb = KR + rowbase * 64;
  const int sr = tid >> 4, sc = (tid & 15) * 8, vst0 = v_st(sr, sc), vst1 = v_st(32 + sr, sc);
  const int krr = tid >> 3, krc = tid & 7;
  const int vb0 = (int)(uintptr_t)V_lds + v_rd_base(lane);
  struct { bf16x8 vs0, vs1, ks0, ks1, kr0; } sr_[1];
#define SLOAD(i, k0) do { sr_[i].vs0 = ld8(&Vh[(long)((k0) + sr) * 2048 + sc]); sr_[i].vs1 = ld8(&Vh[(long)((k0) + 32 + sr) * 2048 + sc]); \
    sr_[i].ks0 = ld8(&Kh[(long)((k0) + sr) * 2048 + sc]); sr_[i].ks1 = ld8(&Kh[(long)((k0) + 32 + sr) * 2048 + sc]); sr_[i].kr0 = ld8(&Krb[(long)((k0) + krr) * 64 + krc * 8]); } while (0)
#define SWRITE(bb, i) do { *(bf16x8*)(V_lds + (bb) * SHM_V + vst0) = sr_[i].vs0; *(bf16x8*)(V_lds + (bb) * SHM_V + vst1) = sr_[i].vs1; const int kc = sc * 2; \
    *(bf16x8*)(Kn_lds + (bb) * SHM_KN + KSWZ(sr, kc)) = sr_[i].ks0; *(bf16x8*)(Kn_lds + (bb) * SHM_KN + KSWZ(32 + sr, kc)) = sr_[i].ks1; \
    *(bf16x8*)(Kr_lds + (bb) * SHM_KR + KRSWZ(krr, krc)) = sr_[i].kr0; } while (0)
#define SWAIT() asm volatile("s_waitcnt vmcnt(0)" ::: "memory")
#define RESC(a) do { if (__any((a) < 1.f)) { if (hi == 0) al_l[r32] = (a); asm volatile("s_waitcnt lgkmcnt(0)" ::: "memory"); \
    _Pragma("unroll") for (int d = 0; d < 4; ++d) _Pragma("unroll") for (int r = 0; r < 16; ++r) o[d][r] *= al_l[crow(r, hi)]; } } while (0)
  f32x16 pA0, pA1, pB0, pB1; float mnA, mnB, alA, alB; bf16x8 pa0, pa1, pa2, pa3; const int NT = SEQ / KVBLK;
  constexpr int SE = 0, SO = 0;
  __syncthreads();
#pragma unroll
  for (int d0 = 0; d0 < 4; ++d0) *(bf16x8*)(qrl + d0 * 1024) = ld8(Qw + (8 + d0) * 16);
  SLOAD(SE, 0); asm volatile("s_waitcnt vmcnt(0)" ::: "memory"); SWRITE(0, SE); __syncthreads();
  qkt<4>(pA0, pA1, Kn_lds, Kr_lds, qr, qrl, r32, hi); partialSM(pA0, pA1, m_reg, mnA, alA);
  SLOAD(SO, KVBLK);
  SWAIT(); SWRITE(1, SO); __syncthreads();
  for (int j = 1; j + 1 < NT; j += 2) {
    ASBAR(); qkt<4>(pB0, pB1, Kn_lds + SHM_KN, Kr_lds + SHM_KR, qr, qrl, r32, hi);
    finishSM(pA0, pA1, alA, l_reg, pa0, pa1, pa2, pa3); ASBAR();
    SLOAD(SE, (j + 1) * KVBLK); ASBAR();
    pv_d0(o, vb0, pa0, pa1, pa2, pa3); partialSM(pB0, pB1, m_reg, mnB, alB);
    __syncthreads(); SWAIT(); SWRITE(0, SE);
    RESC(alB); __syncthreads();
    ASBAR(); qkt<4>(pA0, pA1, Kn_lds, Kr_lds, qr, qrl, r32, hi);
    finishSM(pB0, pB1, alB, l_reg, pa0, pa1, pa2, pa3); ASBAR();
    SLOAD(SO, (j + 2) * KVBLK); ASBAR();
    pv_d0(o, vb0 + SHM_V, pa0, pa1, pa2, pa3); partialSM(pA0, pA1, m_reg, mnA, alA);
    __syncthreads(); SWAIT(); SWRITE(1, SO);
    RESC(alA); __syncthreads();
  }
  ASBAR(); qkt<4>(pB0, pB1, Kn_lds + SHM_KN, Kr_lds + SHM_KR, qr, qrl, r32, hi);
  finishSM(pA0, pA1, alA, l_reg, pa0, pa1, pa2, pa3); ASBAR();
  pv_d0(o, vb0, pa0, pa1, pa2, pa3); partialSM(pB0, pB1, m_reg, mnB, alB);
  __syncthreads(); RESC(alB);
  finishSM(pB0, pB1, alB, l_reg, pa0, pa1, pa2, pa3); ASBAR();
  pv_d0(o, vb0 + SHM_V, pa0, pa1, pa2, pa3);
  if (hi == 0) li_l[r32] = l_reg; asm volatile("s_waitcnt lgkmcnt(0)" ::: "memory");
  float rli[16];
#pragma unroll
  for (int r = 0; r < 16; ++r) rli[r] = __builtin_amdgcn_rcpf(li_l[crow(r, hi)]) * oscale;
  unsigned char* Ow = O + (rowbase + qb * 256 + wid * QBLK) * 2048 + h * 128;
#pragma unroll
  for (int r = 0; r < 16; ++r) { const int orow = crow(r, hi);
#pragma unroll
    for (int d0 = 0; d0 < 4; ++d0) Ow[(long)orow * 2048 + d0 * 32 + r32] = (unsigned char)(__builtin_amdgcn_cvt_pk_fp8_f32(o[d0][r] * rli[r], 0.f, 0, false) & 0xff); }
#undef SLOAD
#undef SWRITE
#undef SWAIT
#undef RESC
}

__device__ __forceinline__ void na_unit(int b, int h, int rg, const bf16_t* __restrict__ Q, const bf16_t* __restrict__ K, const bf16_t* __restrict__ V, const float* __restrict__ rpb, unsigned char* __restrict__ O, float oscale, char* lds) {
  int tid_ = threadIdx.x; asm volatile("" : "+v"(tid_));
  const int tid = tid_, wid = tid >> 6, lane = tid & 63, r32 = lane & 31, hi = lane >> 5;
  char* V_lds = lds + OFF_V; char* Kn_lds = lds + OFF_KN;
  float* ws = (float*)(lds + OFF_WS) + wid * 64; float* li_l = ws; float* al_l = ws + 32;
  float* bias_l = (float*)(lds + OFF_BIAS);
  const int r0 = rg * 4, rq = r0 + (wid >> 1), cq = 32 * (wid & 1) + r32;
  const int rs_w = min(max(rq - 4, 0), 120), cs = min(max(cq - 8, 0), 48);
  const int kr_lo = min(max(r0 - 4, 0), 120), kr_hi = min(max(r0 + 3 - 4, 0), 120) + 7, NT = kr_hi - kr_lo + 1;
  const long rowbase = (long)b * SEQ;
  float m_reg = -1e30f, l_reg = 0; f32x16 o[4] = {}; bf16x8 qr[8];
  const bf16_t* Qw = Q + (rowbase + rq * 64 + cq) * 2048 + h * 128 + hi * 8;
#pragma unroll
  for (int d0 = 0; d0 < 8; ++d0) qr[d0] = ld8(Qw + d0 * 16);
  const bf16_t* Kh = K + rowbase * 2048 + h * 128; const bf16_t* Vh = V + rowbase * 2048 + h * 128;
  const int sr = tid >> 4, sc = (tid & 15) * 8, vst0 = v_st(sr, sc), vst1 = v_st(32 + sr, sc);
  const int vb0 = (int)(uintptr_t)V_lds + v_rd_base(lane);
  __syncthreads();
  if (tid < 465) bias_l[tid] = rpb[h * 465 + tid] * 1.4426950408889634f;
  bf16x8 vs0, vs1, ks0, ks1;
#define NLOAD(k0) do { vs0 = ld8(&Vh[(long)((k0) + sr) * 2048 + sc]); vs1 = ld8(&Vh[(long)((k0) + 32 + sr) * 2048 + sc]); \
    ks0 = ld8(&Kh[(long)((k0) + sr) * 2048 + sc]); ks1 = ld8(&Kh[(long)((k0) + 32 + sr) * 2048 + sc]); } while (0)
#define NWRITE(bb) do { *(bf16x8*)(V_lds + (bb) * SHM_V + vst0) = vs0; *(bf16x8*)(V_lds + (bb) * SHM_V + vst1) = vs1; const int kc = sc * 2; \
    *(bf16x8*)(Kn_lds + (bb) * SHM_KN + KSWZ(sr, kc)) = ks0; *(bf16x8*)(Kn_lds + (bb) * SHM_KN + KSWZ(32 + sr, kc)) = ks1; } while (0)
  NLOAD(kr_lo * 64);
  for (int i = 0; i < NT; ++i) {
    const int kr = kr_lo + i, bb = i & 1;
    NWRITE(bb);
    if (i + 1 < NT) NLOAD((kr + 1) * 64);
    __syncthreads();
    if (kr >= rs_w && kr < rs_w + 8) {
      f32x16 p0, p1;
      qkt<0>(p0, p1, Kn_lds + bb * SHM_KN, nullptr, qr, nullptr, r32, hi);
      const float* brow = bias_l + (kr - rq + 7) * 31 + 15 - cq;
      float pmax = -1e30f;
#pragma unroll
      for (int r = 0; r < 16; ++r) { const int k0 = crow(r, hi), k1 = 32 + k0;
        const bool v0 = (k0 >= cs) && (k0 < cs + 16), v1 = (k1 >= cs) && (k1 < cs + 16);
        const float b0 = brow[v0 ? k0 : cq], b1 = brow[v1 ? k1 : cq];
        p0[r] = v0 ? p0[r] + b0 : -1e30f; p1[r] = v1 ? p1[r] + b1 : -1e30f;
        pmax = fmaxf(pmax, fmaxf(p0[r], p1[r])); }
      { auto rr = __builtin_amdgcn_permlane32_swap(__float_as_uint(pmax), __float_as_uint(pmax), false, false);
        pmax = fmaxf(__uint_as_float(rr[0]), __uint_as_float(rr[1])); }
      const float mn = fmaxf(m_reg, pmax), alpha = __builtin_amdgcn_exp2f(m_reg - mn); m_reg = mn;
#pragma unroll
      for (int r = 0; r < 16; ++r) { p0[r] = __builtin_amdgcn_exp2f(p0[r] - mn); p1[r] = __builtin_amdgcn_exp2f(p1[r] - mn); }
      float ps = 0;
#pragma unroll
      for (int r = 0; r < 16; ++r) ps += p0[r] + p1[r];
      { auto rr = __builtin_amdgcn_permlane32_swap(__float_as_uint(ps), __float_as_uint(ps), false, false);
        ps = __uint_as_float(rr[0]) + __uint_as_float(rr[1]); }
      l_reg = l_reg * alpha + ps;
      if (hi == 0) al_l[r32] = alpha; asm volatile("s_waitcnt lgkmcnt(0)" ::: "memory");
#pragma unroll
      for (int d = 0; d < 4; ++d)
#pragma unroll
        for (int r = 0; r < 16; ++r) o[d][r] *= al_l[crow(r, hi)];
      bf16x8 pa0, pa1, pa2, pa3;
      PK4(p0, 0, pa0); PK4(p0, 8, pa1); PK4(p1, 0, pa2); PK4(p1, 8, pa3);
      pv_d0(o, vb0 + bb * SHM_V, pa0, pa1, pa2, pa3);
    }
  }
  if (hi == 0) li_l[r32] = l_reg; asm volatile("s_waitcnt lgkmcnt(0)" ::: "memory");
  float rli[16];
#pragma unroll
  for (int r = 0; r < 16; ++r) rli[r] = __builtin_amdgcn_rcpf(li_l[crow(r, hi)]) * oscale;
  unsigned char* Ow = O + (rowbase + rq * 64 + 32 * (wid & 1)) * 2048 + h * 128;
#pragma unroll
  for (int r = 0; r < 16; ++r) { const int orow = crow(r, hi);
#pragma unroll
    for (int d0 = 0; d0 < 4; ++d0) Ow[(long)orow * 2048 + d0 * 32 + r32] = (unsigned char)(__builtin_amdgcn_cvt_pk_fp8_f32(o[d0][r] * rli[r], 0.f, 0, false) & 0xff); }
#undef NLOAD
#undef NWRITE
}
#undef PK4
}

namespace att8 {
using f32x16 = __attribute__((ext_vector_type(16))) float;
using u32x4  = __attribute__((ext_vector_type(4))) unsigned;
using v8i    = __attribute__((ext_vector_type(8))) int;
using v4i    = __attribute__((ext_vector_type(4))) int;
constexpr int SEQ = 8192, KVBLK = 64, KT_BYTES = 12288, VT_BYTES = 8192, NSLOT = 5;
constexpr int OFF_K = 0, OFF_V = NSLOT * KT_BYTES, OFF_WS = OFF_V + NSLOT * VT_BYTES, LDS_BYTES = OFF_WS + 2048;
constexpr float SQ8 = 16.0f;
constexpr float PSH = 6.0f;
constexpr float THR8 = 2.0f;
__device__ __forceinline__ int crow(int r, int hi) { return (r & 3) + 8 * (r >> 2) + 4 * hi; }
__device__ __forceinline__ void glds16(const void* gsrc, unsigned lds_dst) { unsigned keep;
  asm volatile("s_mov_b32 %0, m0\n\ts_mov_b32 m0, %2\n\ts_nop 0\n\tglobal_load_lds_dwordx4 %1, off\n\ts_mov_b32 m0, %0" : "=&s"(keep) : "v"(gsrc), "s"(lds_dst) : "memory"); }
template <bool ON = true> __device__ __forceinline__ void mfma64(f32x16& acc, const v8i& a, const v8i& b) { if constexpr (!ON) { asm volatile("" : "+v"(acc) : "v"(a), "v"(b)); return; } asm volatile("s_nop 3\n\tv_mfma_f32_32x32x64_f8f6f4 %0, %1, %2, %0" : "+v"(acc) : "v"(a), "v"(b)); }
#define MFMA_DRAIN2(X, Y) asm volatile("s_nop 15\n\ts_nop 7" : "+v"(X), "+v"(Y))
#define MFMA_DRAIN4(A, B, C_, D) asm volatile("s_nop 15\n\ts_nop 7" : "+v"(A), "+v"(B), "+v"(C_), "+v"(D))
__device__ __forceinline__ v8i ld32(const char* p0, const char* p1) { const v4i a = *reinterpret_cast<const v4i*>(p0), b = *reinterpret_cast<const v4i*>(p1); return __builtin_shufflevector(a, b, 0, 1, 2, 3, 4, 5, 6, 7); }
__device__ __forceinline__ unsigned pk4(float a, float b, float c, float d) { int w = __builtin_amdgcn_cvt_pk_fp8_f32(a, b, 0, false); w = __builtin_amdgcn_cvt_pk_fp8_f32(c, d, w, true); return (unsigned)w; }

template <int VAR = 0> __device__ __forceinline__ void mla8_unit(int b, int h, int qb, const unsigned char* __restrict__ Q8, const unsigned char* __restrict__ K8, const unsigned char* __restrict__ VT8, unsigned char* __restrict__ O8, float oscale, char* lds) {
  int tid_ = threadIdx.x; asm volatile("" : "+v"(tid_));
  const int tid = tid_, lane = tid & 63, r32 = lane & 31, hi = lane >> 5; const int wid = __builtin_amdgcn_readfirstlane(tid >> 6);
  float* ws = (float*)(lds + OFF_WS) + wid * 64; float* li_l = ws; float* al_l = ws + 32;
  const unsigned lds0 = (unsigned)(uintptr_t)lds;
  const long rowbase = (long)b * SEQ;
  constexpr float C = 1.0f / SQ8;
  const int l4 = lane >> 2, pc = lane & 3;
  const unsigned char* src0; const unsigned char* src1; const unsigned char* src2; unsigned dst0, dst1, dst2;
  { auto piece = [&](int id, const unsigned char*& src, unsigned& dst) {
      if (id < 12) { const int ks = id >> 2, rb = id & 3, i = 16 * rb + l4, key = 32 * ((i >> 2) & 1) + 16 * (i >> 5) + (i & 3) + 4 * ((i & 31) >> 3), c = pc ^ ((i >> 2) & 3);
        src = K8 + ((size_t)(rowbase + key) * 16 + h) * 192 + 64 * ks + 16 * c; dst = OFF_K + ks * 4096 + rb * 1024; }
      else { const int vid = id - 12, dblk = vid >> 1, hb = vid & 1, d = 32 * dblk + 16 * hb + l4, c = pc ^ ((d >> 2) & 3);
        src = VT8 + ((size_t)(b * 16 + h) * 128 + d) * SEQ + 16 * c; dst = OFF_V + dblk * 2048 + hb * 1024; } };
    piece(wid, src0, dst0); piece(wid + 8, src1, dst1); piece(wid < 4 ? wid + 16 : wid + 8, src2, dst2); }
  const size_t kstepK = (size_t)KVBLK * 16 * 192, kstepV = KVBLK;
  const size_t st0 = (wid < 8) ? kstepK : kstepV, st1 = (wid + 8 < 12) ? kstepK : kstepV, st2 = kstepV;
  const unsigned sl0 = (wid < 8) ? KT_BYTES : VT_BYTES, sl1 = (wid + 8 < 12) ? KT_BYTES : VT_BYTES, sl2 = VT_BYTES;
#define DMA_TILE(t, slot) do { glds16(src0 + (size_t)(t) * st0, (unsigned)__builtin_amdgcn_readfirstlane(lds0 + dst0 + (slot) * sl0)); \
    glds16(src1 + (size_t)(t) * st1, (unsigned)__builtin_amdgcn_readfirstlane(lds0 + dst1 + (slot) * sl1)); \
    if (wid < 4) glds16(src2 + (size_t)(t) * st2, (unsigned)__builtin_amdgcn_readfirstlane(lds0 + dst2 + (slot) * sl2)); } while (0)
#define WAIT_TILES_BEHIND(n) do { if (wid < 4) { if ((n) == 2) asm volatile("s_waitcnt vmcnt(6)" ::: "memory"); else if ((n) == 1) asm volatile("s_waitcnt vmcnt(3)" ::: "memory"); else asm volatile("s_waitcnt vmcnt(0)" ::: "memory"); } \
    else { if ((n) == 2) asm volatile("s_waitcnt vmcnt(4)" ::: "memory"); else if ((n) == 1) asm volatile("s_waitcnt vmcnt(2)" ::: "memory"); else asm volatile("s_waitcnt vmcnt(0)" ::: "memory"); } } while (0)
  const int sw = (r32 >> 2) & 3;
  const int kA = r32 * 64 + (((2 * hi) ^ sw) << 4), kB = r32 * 64 + (((2 * hi + 1) ^ sw) << 4);
  __syncthreads();
  const int NT = SEQ / KVBLK;
  DMA_TILE(0, 0); DMA_TILE(1, 1); DMA_TILE(2, 2);
  v8i qf[3];
  { const unsigned char* qp = Q8 + (size_t)(rowbase + qb * 256 + wid * 32 + r32) * 3072 + h * 192 + 32 * hi;
#pragma unroll
    for (int ks = 0; ks < 3; ++ks) qf[ks] = ld32((const char*)qp + 64 * ks, (const char*)qp + 64 * ks + 16); }
  asm volatile("" : "+v"(qf[0]), "+v"(qf[1]), "+v"(qf[2]));
  float m_reg = -1e30f, l_reg = 0.f; f32x16 o[4];
#pragma unroll
  for (int d = 0; d < 4; ++d) o[d] = f32x16{};
  v8i pa = {0, 0, 0, 0, 0, 0, 0, 0};
  if (wid >= 4) __builtin_amdgcn_s_barrier();
  int slot = 0, slotp = NSLOT - 1, slot3 = 3;
#pragma unroll 1
  for (int t = 0; t < NT; ++t) {
    __builtin_amdgcn_s_barrier(); asm volatile("" ::: "memory");
    const bool dma_on = !(VAR & 4) && (t + 3 < NT);
    const char* Kt = lds + OFF_K + slot * KT_BYTES; const char* Vp = lds + OFF_V + slotp * VT_BYTES;
    f32x16 p0 = f32x16{}, p1 = f32x16{};
    v8i ka[3], kb[3];
#pragma unroll
    for (int ks = 0; ks < 3; ++ks) { ka[ks] = ld32(Kt + ks * 4096 + kA, Kt + ks * 4096 + kB); kb[ks] = ld32(Kt + ks * 4096 + 2048 + kA, Kt + ks * 4096 + 2048 + kB); }
    mfma64<!(VAR & 2)>(p0, ka[0], qf[0]);
    if (dma_on) glds16(src0 + (size_t)(t + 3) * st0, (unsigned)__builtin_amdgcn_readfirstlane(lds0 + dst0 + slot3 * sl0));
    mfma64<!(VAR & 2)>(p1, kb[0], qf[0]);
    mfma64<!(VAR & 2)>(p0, ka[1], qf[1]);
    if (dma_on) glds16(src1 + (size_t)(t + 3) * st1, (unsigned)__builtin_amdgcn_readfirstlane(lds0 + dst1 + slot3 * sl1));
    mfma64<!(VAR & 2)>(p1, kb[1], qf[1]);
    mfma64<!(VAR & 2)>(p0, ka[2], qf[2]);
    if (dma_on && wid < 4) glds16(src2 + (size_t)(t + 3) * st2, (unsigned)__builtin_amdgcn_readfirstlane(lds0 + dst2 + slot3 * sl2));
    mfma64<!(VAR & 2)>(p1, kb[2], qf[2]);
    if (t > 0) {
      v8i vb[4];
#pragma unroll
      for (int d = 0; d < 4; ++d) vb[d] = ld32(Vp + d * 2048 + kA, Vp + d * 2048 + kB);
#pragma unroll
      for (int d = 0; d < 4; ++d) mfma64<!(VAR & 2)>(o[d], pa, vb[d]); }
    { const int ahead = (NT - 2 - t) < 2 ? (NT - 2 - t) : 2; if (ahead >= 2) WAIT_TILES_BEHIND(2); else if (ahead == 1) WAIT_TILES_BEHIND(1); else WAIT_TILES_BEHIND(0); }
    asm volatile("s_waitcnt lgkmcnt(0)" ::: "memory");
    __builtin_amdgcn_s_barrier(); asm volatile("" ::: "memory");
    MFMA_DRAIN2(p0, p1);
    if constexpr (VAR & 1) { asm volatile("" : "+v"(p0), "+v"(p1)); l_reg += p0[0]; } else {
    float pmax = p0[0];
#pragma unroll
    for (int r = 1; r < 16; ++r) pmax = fmaxf(pmax, p0[r]);
#pragma unroll
    for (int r = 0; r < 16; ++r) pmax = fmaxf(pmax, p1[r]);
    { auto rr = __builtin_amdgcn_permlane32_swap(__float_as_uint(pmax), __float_as_uint(pmax), false, false); pmax = fmaxf(__uint_as_float(rr[0]), __uint_as_float(rr[1])); }
    float alpha = 1.f;
    if (!__all((pmax - m_reg) * C <= THR8)) { const float mn = fmaxf(m_reg, pmax); alpha = __builtin_amdgcn_exp2f((m_reg - mn) * C); m_reg = mn;
      if (hi == 0) al_l[r32] = alpha; asm volatile("s_waitcnt lgkmcnt(0)" ::: "memory");
      MFMA_DRAIN4(o[0], o[1], o[2], o[3]);
#pragma unroll
      for (int d = 0; d < 4; ++d)
#pragma unroll
        for (int r = 0; r < 16; ++r) o[d][r] *= al_l[crow(r, hi)]; }
    const float mc = PSH - m_reg * C; float ps = 0.f;
#pragma unroll
    for (int r = 0; r < 16; ++r) { p0[r] = __builtin_amdgcn_exp2f(fmaf(p0[r], C, mc)); p1[r] = __builtin_amdgcn_exp2f(fmaf(p1[r], C, mc)); ps += p0[r] + p1[r]; }
    { auto rr = __builtin_amdgcn_permlane32_swap(__float_as_uint(ps), __float_as_uint(ps), false, false); ps = __uint_as_float(rr[0]) + __uint_as_float(rr[1]); }
    l_reg = l_reg * alpha + ps; }
    pa[0] = (int)pk4(p0[0], p0[1], p0[2], p0[3]); pa[1] = (int)pk4(p0[4], p0[5], p0[6], p0[7]); pa[2] = (int)pk4(p0[8], p0[9], p0[10], p0[11]); pa[3] = (int)pk4(p0[12], p0[13], p0[14], p0[15]);
    pa[4] = (int)pk4(p1[0], p1[1], p1[2], p1[3]); pa[5] = (int)pk4(p1[4], p1[5], p1[6], p1[7]); pa[6] = (int)pk4(p1[8], p1[9], p1[10], p1[11]); pa[7] = (int)pk4(p1[12], p1[13], p1[14], p1[15]);
    slotp = slot; slot = (slot == NSLOT - 1) ? 0 : slot + 1; slot3 = (slot3 == NSLOT - 1) ? 0 : slot3 + 1;
  }
  if (wid < 4) __builtin_amdgcn_s_barrier();
  { const char* Vp = lds + OFF_V + slotp * VT_BYTES;
#pragma unroll
    for (int d = 0; d < 4; ++d) { const v8i vb = ld32(Vp + d * 2048 + kA, Vp + d * 2048 + kB); mfma64(o[d], pa, vb); } }
  MFMA_DRAIN4(o[0], o[1], o[2], o[3]);
  if (hi == 0) li_l[r32] = l_reg; asm volatile("s_waitcnt lgkmcnt(0)" ::: "memory");
  float rli[16];
#pragma unroll
  for (int r = 0; r < 16; ++r) rli[r] = __builtin_amdgcn_rcpf(li_l[crow(r, hi)]) * oscale;
  unsigned char* Ow = O8 + (size_t)(rowbase + qb * 256 + wid * 32) * 2048 + h * 128;
#pragma unroll
  for (int r = 0; r < 16; ++r) { const int orow = crow(r, hi);
#pragma unroll
    for (int d0 = 0; d0 < 4; ++d0) Ow[(long)orow * 2048 + d0 * 32 + r32] = (unsigned char)(__builtin_amdgcn_cvt_pk_fp8_f32(o[d0][r] * rli[r], 0.f, 0, false) & 0xff); }
#undef DMA_TILE
#undef WAIT_TILES_BEHIND
#undef MFMA_DRAIN2
#undef MFMA_DRAIN4
}
}

namespace peer {
#define PLAS __attribute__((address_space(3)))
using bf16x8 = __attribute__((ext_vector_type(8))) short;
using bf16x2 = __attribute__((ext_vector_type(2))) __bf16;
using f32x16 = __attribute__((ext_vector_type(16))) float;
using f32x4  = __attribute__((ext_vector_type(4))) float;
using u32x4  = __attribute__((ext_vector_type(4))) unsigned;
typedef unsigned short bf16_t;
__device__ __forceinline__ int f2ord(float f) { const int u = __float_as_int(f); return u ^ ((u >> 31) & 0x7fffffff); }
__device__ __forceinline__ float ord2f(int s) { return __int_as_float(s ^ ((s >> 31) & 0x7fffffff)); }
__device__ __forceinline__ int crow(int r, int hi) { return (r & 3) + 8 * (r >> 2) + 4 * hi; }
__device__ __forceinline__ unsigned cvtpk(float lo, float hi) { unsigned r; asm volatile("v_cvt_pk_bf16_f32 %0, %1, %2" : "=v"(r) : "v"(lo), "v"(hi)); return r; }
__device__ __forceinline__ float bf_lo(unsigned w) { return __uint_as_float(w << 16); }
__device__ __forceinline__ float bf_hi(unsigned w) { return __uint_as_float(w & 0xffff0000u); }
__device__ __forceinline__ int swapmax(int m) { auto rr = __builtin_amdgcn_permlane32_swap((unsigned)m, (unsigned)m, false, false); const int a = (int)rr[0], b = (int)rr[1]; return a > b ? a : b; }

struct CandTab { int ci[50], cj[50]; };
constexpr CandTab make_cands() { CandTab t{}; int n = 0; for (int i = 0; i < 16; ++i) for (int j = 0; j < 16; ++j) if ((i + 1) * (j + 1) <= 16) { t.ci[n] = i; t.cj[n] = j; ++n; } return t; }
constexpr CandTab CT = make_cands();

constexpr int SEL_LDS_PER_WAVE = (2 * 16 + 16) * 64 * 4;

__device__ __forceinline__ void select32(int t0, int h, const float* __restrict__ QP, const bf16_t* __restrict__ SUBH, const bf16_t* __restrict__ SUBL, int* __restrict__ IDX, float* __restrict__ GATE, PLAS int* wl, int lane_) {
  int lane = lane_; asm volatile("" : "+v"(lane));
  const int r32 = lane & 31, hi = lane >> 5;
  PLAS int* topl = wl; PLAS int* winl = wl + 2 * 16 * 64;
  const float* qrow = QP + (size_t)(t0 + r32) * 2048;
  {
#pragma unroll 1
    for (int p = 0; p < 2; ++p) {
      bf16x8 qh[8], ql[8];
      const float* qp = qrow + h * 256 + p * 128 + hi * 8;
#pragma unroll
      for (int d0 = 0; d0 < 8; ++d0) {
        const f32x4 a = *(const f32x4*)(qp + d0 * 16), b = *(const f32x4*)(qp + d0 * 16 + 4);
        u32x4 wh, wlw;
        wh.x = cvtpk(a[0], a[1]); wh.y = cvtpk(a[2], a[3]); wh.z = cvtpk(b[0], b[1]); wh.w = cvtpk(b[2], b[3]);
        wlw.x = cvtpk(a[0] - bf_lo(wh.x), a[1] - bf_hi(wh.x)); wlw.y = cvtpk(a[2] - bf_lo(wh.y), a[3] - bf_hi(wh.y));
        wlw.z = cvtpk(b[0] - bf_lo(wh.z), b[1] - bf_hi(wh.z)); wlw.w = cvtpk(b[2] - bf_lo(wh.w), b[3] - bf_hi(wh.w));
        qh[d0] = *reinterpret_cast<bf16x8*>(&wh); ql[d0] = *reinterpret_cast<bf16x8*>(&wlw);
      }
      const size_t soff = ((size_t)(h * 2 + p) * 128 + r32) * 128 + hi * 8;
      int key[64];
#pragma unroll
      for (int kb = 0; kb < 4; ++kb) {
        f32x16 acc = f32x16{};
#pragma unroll
        for (int d0 = 0; d0 < 8; ++d0) {
          const bf16x8 ah = *reinterpret_cast<const bf16x8*>(SUBH + soff + (size_t)kb * 32 * 128 + d0 * 16);
          const bf16x8 al = *reinterpret_cast<const bf16x8*>(SUBL + soff + (size_t)kb * 32 * 128 + d0 * 16);
          acc = __builtin_amdgcn_mfma_f32_32x32x16_bf16(ah, qh[d0], acc, 0, 0, 0);
          acc = __builtin_amdgcn_mfma_f32_32x32x16_bf16(ah, ql[d0], acc, 0, 0, 0);
          acc = __builtin_amdgcn_mfma_f32_32x32x16_bf16(al, qh[d0], acc, 0, 0, 0);
        }
#pragma unroll
        for (int r = 0; r < 16; ++r) key[kb * 16 + r] = (f2ord(acc[r]) & ~127) | (kb * 32 + crow(r, hi));
      }
#pragma unroll 1
      for (int it = 0; it < 16; ++it) {
        int m = key[0];
#pragma unroll
        for (int i = 1; i < 64; ++i) m = key[i] > m ? key[i] : m;
        const int gm = swapmax(m);
        topl[(p * 16 + it) * 64 + lane] = gm;
#pragma unroll
        for (int i = 0; i < 64; ++i) key[i] = (key[i] == gm) ? (int)0x80000000 : key[i];
      }
    }
    int ck[25];
#pragma unroll
    for (int c = 0; c < 25; ++c) {
      const int i = hi ? CT.ci[2 * c + 1] : CT.ci[2 * c], j = hi ? CT.cj[2 * c + 1] : CT.cj[2 * c];
      const int k0 = topl[i * 64 + lane], k1 = topl[(16 + j) * 64 + lane];
      const float s = ord2f(k0 & ~127) + ord2f(k1 & ~127);
      ck[c] = (f2ord(s) & ~255) | (i << 4) | j;
    }
#pragma unroll 1
    for (int it = 0; it < 16; ++it) {
      int m = ck[0];
#pragma unroll
      for (int i = 1; i < 25; ++i) m = ck[i] > m ? ck[i] : m;
      const int gm = swapmax(m);
      winl[it * 64 + lane] = gm;
#pragma unroll
      for (int i = 0; i < 25; ++i) ck[i] = (ck[i] == gm) ? (int)0x80000000 : ck[i];
    }
    float e[16]; int wv[16]; float tot = 0.f;
    const float s0 = ord2f(winl[lane] & ~255);
#pragma unroll
    for (int k = 0; k < 16; ++k) { wv[k] = winl[k * 64 + lane]; e[k] = __builtin_amdgcn_exp2f((ord2f(wv[k] & ~255) - s0) * 1.4426950408889634f); tot += e[k]; }
    const float rtot = 1.0f / tot;
    int l2_ = lane_; asm volatile("" : "+v"(l2_));
    const size_t ob = (size_t)(t0 + (l2_ & 31)) * 128 + h * 16 + (l2_ >> 5) * 8;
#pragma unroll
    for (int k = 0; k < 8; ++k) {
      const int w = hi ? wv[8 + k] : wv[k]; const float ev = hi ? e[8 + k] : e[k];
      const int i = (w >> 4) & 15, j = w & 15;
      const int e0 = topl[i * 64 + lane] & 127, e1 = topl[(16 + j) * 64 + lane] & 127;
      IDX[ob + k] = e0 * 128 + e1; GATE[ob + k] = ev * rtot;
    }
  }
}

__device__ __forceinline__ float dot2(unsigned w, unsigned x, float acc) { return __builtin_amdgcn_fdot2_f32_bf16(__builtin_bit_cast(bf16x2, w), __builtin_bit_cast(bf16x2, x), acc, false); }
__device__ __forceinline__ float gelu_erf(float v) {
  const float av = fabsf(v), d = av * 0.2316418882f + 1.0f, t = __builtin_amdgcn_rcpf(d);
  float q = t * 0.5307027145f + (-0.7265760135f); q = q * t + 0.7107068705f; q = q * t + (-0.142248368f); q = q * t + 0.127414796f; q = q * t;
  const float e = __builtin_amdgcn_exp2f((v * v) * (-0.72134752044f));
  const float m = v * (q * e);
  return v < 0.f ? m : v - m;
}
__device__ __forceinline__ float wave_sum(float v) {
#pragma unroll
  for (int o = 1; o < 64; o <<= 1) v += __shfl_xor(v, o);
  return v;
}

typedef float f32x2 __attribute__((ext_vector_type(2)));
constexpr float USCALE = 64.0f, VSCALE = 4.0f;
__device__ __forceinline__ f32x2 fp8x2(unsigned w, bool hiword) { return hiword ? __builtin_amdgcn_cvt_pk_f32_fp8((int)w, true) : __builtin_amdgcn_cvt_pk_f32_fp8((int)w, false); }
template <bool STORE, bool FAKE = false> __device__ __forceinline__ void expert_token(int t, const bf16_t* __restrict__ H2, const unsigned char* __restrict__ U8, const unsigned char* __restrict__ V8, const int* __restrict__ IDX, const float* __restrict__ GATE,
                                             float* X1OUT, const float* __restrict__ fnorm, int lane_) {
  int lane = lane_; asm volatile("" : "+v"(lane));
  f32x2 hf[4][8];
  { const u32x4* hp = (const u32x4*)(H2 + (size_t)t * 4096) + 2 * lane;
#pragma unroll
    for (int k = 0; k < 4; ++k) { const u32x4 a = hp[128 * k], b = hp[128 * k + 1];
      hf[k][0] = (f32x2){bf_lo(a.x), bf_hi(a.x)}; hf[k][1] = (f32x2){bf_lo(a.y), bf_hi(a.y)}; hf[k][2] = (f32x2){bf_lo(a.z), bf_hi(a.z)}; hf[k][3] = (f32x2){bf_lo(a.w), bf_hi(a.w)};
      hf[k][4] = (f32x2){bf_lo(b.x), bf_hi(b.x)}; hf[k][5] = (f32x2){bf_lo(b.y), bf_hi(b.y)}; hf[k][6] = (f32x2){bf_lo(b.z), bf_hi(b.z)}; hf[k][7] = (f32x2){bf_lo(b.w), bf_hi(b.w)}; } }
  const int e0 = FAKE ? lane : IDX[(size_t)t * 128 + lane], e1 = FAKE ? lane + 64 : IDX[(size_t)t * 128 + 64 + lane];
  const float g0 = GATE[(size_t)t * 128 + lane], g1 = GATE[(size_t)t * 128 + 64 + lane];
  float c0 = 0.f, c1 = 0.f;
  u32x4 r0[4], r1[4], r2[4], r3[4];
#define ELOAD(dst, jj) do { const int jx_ = (jj); if (jx_ < 256) { const int sl_ = jx_ & 127; const int e_ = __builtin_amdgcn_readlane(sl_ < 64 ? e0 : e1, sl_ & 63); \
    const u32x4* rp_ = (const u32x4*)((jx_ < 128 ? U8 : V8) + (size_t)e_ * 4096) + lane; _Pragma("unroll") for (int k = 0; k < 4; ++k) dst[k] = rp_[64 * k]; } \
    asm volatile("" ::: "memory"); __builtin_amdgcn_sched_barrier(0); } while (0)
#define UDOT(R, OUT) do { f32x2 a0_ = {0.f, 0.f}, a1_ = {0.f, 0.f}, a2_ = {0.f, 0.f}, a3_ = {0.f, 0.f}; \
    _Pragma("unroll") for (int k = 0; k < 4; ++k) { \
      a0_ += fp8x2(R[k].x, false) * hf[k][0]; a1_ += fp8x2(R[k].x, true) * hf[k][1]; a2_ += fp8x2(R[k].y, false) * hf[k][2]; a3_ += fp8x2(R[k].y, true) * hf[k][3]; \
      a0_ += fp8x2(R[k].z, false) * hf[k][4]; a1_ += fp8x2(R[k].z, true) * hf[k][5]; a2_ += fp8x2(R[k].w, false) * hf[k][6]; a3_ += fp8x2(R[k].w, true) * hf[k][7]; } \
    a0_ += a1_; a2_ += a3_; a0_ += a2_; OUT = a0_.x + a0_.y; } while (0)
  ELOAD(r0, 0); ELOAD(r1, 1); ELOAD(r2, 2); ELOAD(r3, 3);
#pragma unroll 1
  for (int g = 0; g < 16; ++g) {
    float p[8];
    const int j = g * 8;
    UDOT(r0, p[0]); ELOAD(r0, j + 4); UDOT(r1, p[1]); ELOAD(r1, j + 5); UDOT(r2, p[2]); ELOAD(r2, j + 6); UDOT(r3, p[3]); ELOAD(r3, j + 7);
    UDOT(r0, p[4]); ELOAD(r0, j + 8); UDOT(r1, p[5]); ELOAD(r1, j + 9); UDOT(r2, p[6]); ELOAD(r2, j + 10); UDOT(r3, p[7]); ELOAD(r3, j + 11);
    float q4[4], q2[2], q1;
    { const bool up = (lane & 32) != 0;
#pragma unroll
      for (int i = 0; i < 4; ++i) { const float send = up ? p[i] : p[4 + i], keep = up ? p[4 + i] : p[i]; q4[i] = keep + __shfl_xor(send, 32); } }
    { const bool up = (lane & 16) != 0;
#pragma unroll
      for (int i = 0; i < 2; ++i) { const float send = up ? q4[i] : q4[2 + i], keep = up ? q4[2 + i] : q4[i]; q2[i] = keep + __shfl_xor(send, 16); } }
    { const bool up = (lane & 8) != 0; const float send = up ? q2[0] : q2[1], keep = up ? q2[1] : q2[0]; q1 = keep + __shfl_xor(send, 8); }
    q1 += __shfl_xor(q1, 4); q1 += __shfl_xor(q1, 2); q1 += __shfl_xor(q1, 1);
    const float got = __shfl(q1, 8 * (lane & 7));
    if ((lane >> 3) == (g & 7)) { if (g < 8) c0 = got; else c1 = got; }
  }
#undef UDOT
  c0 = g0 * gelu_erf(c0 * (1.0f / USCALE)) * (1.0f / VSCALE); c1 = g1 * gelu_erf(c1 * (1.0f / USCALE)) * (1.0f / VSCALE);
  f32x2 acc[4][8];
#pragma unroll
  for (int k = 0; k < 4; ++k)
#pragma unroll
    for (int i = 0; i < 8; ++i) acc[k][i] = (f32x2){0.f, 0.f};
#define VROW(R, C) do { const f32x2 cc_ = {(C), (C)}; _Pragma("unroll") for (int k = 0; k < 4; ++k) { \
      acc[k][0] += cc_ * fp8x2(R[k].x, false); acc[k][1] += cc_ * fp8x2(R[k].x, true); acc[k][2] += cc_ * fp8x2(R[k].y, false); acc[k][3] += cc_ * fp8x2(R[k].y, true); \
      acc[k][4] += cc_ * fp8x2(R[k].z, false); acc[k][5] += cc_ * fp8x2(R[k].z, true); acc[k][6] += cc_ * fp8x2(R[k].w, false); acc[k][7] += cc_ * fp8x2(R[k].w, true); } } while (0)
#define CJ(j) __int_as_float(__builtin_amdgcn_readlane(__float_as_int((j) < 64 ? c0 : c1), (j) & 63))
#pragma unroll 1
  for (int j = 0; j < 128; j += 4) {
    { const float c = CJ(j); VROW(r0, c); __builtin_amdgcn_sched_barrier(0); ELOAD(r0, 128 + j + 4); }
    { const float c = CJ(j + 1); VROW(r1, c); __builtin_amdgcn_sched_barrier(0); ELOAD(r1, 128 + j + 5); }
    { const float c = CJ(j + 2); VROW(r2, c); __builtin_amdgcn_sched_barrier(0); ELOAD(r2, 128 + j + 6); }
    { const float c = CJ(j + 3); VROW(r3, c); __builtin_amdgcn_sched_barrier(0); ELOAD(r3, 128 + j + 7); }
  }
#undef VROW
#undef CJ
#undef ELOAD
  int xo_ = 16 * lane; asm volatile("" : "+v"(xo_));
  float* xr = X1OUT + (size_t)t * 4096 + xo_; float ss = 0.f;
#ifdef PROBE_PEER_SCALE
#pragma unroll
  for (int k = 0; k < 4; ++k)
#pragma unroll
    for (int i = 0; i < 8; ++i) acc[k][i] *= PROBE_PEER_SCALE;
#endif
#pragma unroll
  for (int k = 0; k < 4; ++k)
#pragma unroll
    for (int q = 0; q < 4; ++q) { const f32x4 a = *(const f32x4*)(xr + 1024 * k + 4 * q);
      acc[k][2 * q] += (f32x2){a[0], a[1]}; acc[k][2 * q + 1] += (f32x2){a[2], a[3]};
      ss += acc[k][2 * q].x * acc[k][2 * q].x + acc[k][2 * q].y * acc[k][2 * q].y + acc[k][2 * q + 1].x * acc[k][2 * q + 1].x + acc[k][2 * q + 1].y * acc[k][2 * q + 1].y; }
  const float rstd = 1.0f / sqrtf(wave_sum(ss) * (1.0f / 4096.0f) + 1e-6f);
  const float* fn = fnorm + xo_;
#pragma unroll
  for (int k = 0; k < 4; ++k)
#pragma unroll
    for (int q = 0; q < 4; ++q) { const f32x4 g = *(const f32x4*)(fn + 1024 * k + 4 * q);
      f32x4 o; o[0] = acc[k][2 * q].x * rstd * g[0]; o[1] = acc[k][2 * q].y * rstd * g[1]; o[2] = acc[k][2 * q + 1].x * rstd * g[2]; o[3] = acc[k][2 * q + 1].y * rstd * g[3];
      if constexpr (STORE) { *(f32x4*)(xr + 1024 * k + 4 * q) = o; } else { asm volatile("" :: "v"(o)); } }
}
typedef unsigned v6u __attribute__((ext_vector_type(6)));
typedef float v32f __attribute__((ext_vector_type(32)));
typedef __bf16 v32bf __attribute__((ext_vector_type(32)));
typedef unsigned v16u __attribute__((ext_vector_type(16)));
constexpr float U6SCALE = 128.0f, V6SCALE = 4.0f;
constexpr int ROW6 = 3072;
__device__ __forceinline__ unsigned f32_to_e2m3(float x) {
  const unsigned sgn = (__float_as_uint(x) >> 26) & 32u; float a = fminf(fabsf(x), 7.5f);
  unsigned code;
  if (a < 1.0f) { code = (unsigned)__builtin_rintf(a * 8.0f); }
  else { unsigned u = __float_as_uint(a); u += 0x7FFFFu + ((u >> 20) & 1u); const unsigned e = (u >> 23) - 127u, m = (u >> 20) & 7u; code = ((e + 1u) << 3) | m; code = code > 31u ? 31u : code; }
  return code | sgn;
}
__device__ __forceinline__ void pack_row_fp6(const float* __restrict__ src, unsigned char* __restrict__ dst, float scale, int lane) {
  const f32x4* sp = (const f32x4*)(src + 64 * lane);
  unsigned w[12];
#pragma unroll
  for (int i = 0; i < 12; ++i) w[i] = 0u;
#pragma unroll
  for (int q = 0; q < 16; ++q) { const f32x4 v = sp[q] * scale;
#pragma unroll
    for (int j = 0; j < 4; ++j) { const int el = 4 * q + j, g = el >> 5, i = el & 31, pos = 6 * i, d = 6 * g + (pos >> 5), sh = pos & 31;
      const unsigned c = f32_to_e2m3(v[j]); w[d] |= c << sh; if (sh > 26) w[d + 1] |= c >> (32 - sh); } }
#pragma unroll
  for (int k = 0; k < 3; ++k) *(u32x4*)(dst + 1024 * k + 16 * lane) = (u32x4){w[4 * k], w[4 * k + 1], w[4 * k + 2], w[4 * k + 3]};
}
template <bool STORE> __device__ __forceinline__ void expert_tokens6(int t_first, int t_step, int t_end, const bf16_t* __restrict__ H2, const unsigned char* __restrict__ U6, const unsigned char* __restrict__ V6,
                                             const int* __restrict__ IDX, const float* __restrict__ GATE, float* X1OUT, const float* __restrict__ fnorm, int lane_) {
  int lane = lane_; asm volatile("" : "+v"(lane));
  int t = t_first; if (t >= t_end) return;
  const unsigned lo16 = (unsigned)lane * 16u;
  int e0 = IDX[(size_t)t * 128 + lane], e1 = IDX[(size_t)t * 128 + 64 + lane];
  u32x4 r0[3], r1[3], r2[3], r3[3];
#define ELOAD(dst, jj, EA, EB, TAB) do { const int sl_ = (jj) & 127; const int e_ = __builtin_amdgcn_readlane(sl_ < 64 ? (EA) : (EB), sl_ & 63); \
    const unsigned char* rb_ = (TAB) + (size_t)(unsigned)e_ * ROW6; _Pragma("unroll") for (int k = 0; k < 3; ++k) dst[k] = *(const u32x4*)(rb_ + (lo16 + 1024u * k)); \
    asm volatile("" ::: "memory"); __builtin_amdgcn_sched_barrier(0); } while (0)
#define GRPA(R) ((v6u){R[0].x, R[0].y, R[0].z, R[0].w, R[1].x, R[1].y})
#define GRPB(R) ((v6u){R[1].z, R[1].w, R[2].x, R[2].y, R[2].z, R[2].w})
  ELOAD(r0, 0, e0, e1, U6); ELOAD(r1, 1, e0, e1, U6); ELOAD(r2, 2, e0, e1, U6); ELOAD(r3, 3, e0, e1, U6);
#pragma unroll 1
  for (;;) {
    const int tn = t + t_step, tnx = tn < t_end ? tn : t;
    const int e0n = IDX[(size_t)tnx * 128 + lane], e1n = IDX[(size_t)tnx * 128 + 64 + lane];
    const float g0 = GATE[(size_t)t * 128 + lane], g1 = GATE[(size_t)t * 128 + 64 + lane];
    unsigned hq[32];
    { const u32x4* hp = (const u32x4*)(H2 + (size_t)t * 4096 + 64 * lane);
#pragma unroll
      for (int q = 0; q < 8; ++q) { const u32x4 a = hp[q]; hq[4 * q] = a.x; hq[4 * q + 1] = a.y; hq[4 * q + 2] = a.z; hq[4 * q + 3] = a.w; } }
    float c0 = 0.f, c1 = 0.f;
#define UDOT(R, OUT) do { float a0_ = 0.f, a1_ = 0.f, a2_ = 0.f, a3_ = 0.f; \
    asm volatile("" : "+v"(R[0].x)); \
    { const v16u b_ = __builtin_bit_cast(v16u, __builtin_amdgcn_cvt_scalef32_pk32_bf16_fp6(GRPA(R), 1.0f)); \
      _Pragma("unroll") for (int j = 0; j < 16; j += 4) { a0_ = dot2(b_[j], hq[j], a0_); a1_ = dot2(b_[j + 1], hq[j + 1], a1_); a2_ = dot2(b_[j + 2], hq[j + 2], a2_); a3_ = dot2(b_[j + 3], hq[j + 3], a3_); } } \
    asm volatile("" : "+v"(a0_), "+v"(a1_), "+v"(a2_), "+v"(a3_), "+v"(R[1].z)); \
    { const v16u b_ = __builtin_bit_cast(v16u, __builtin_amdgcn_cvt_scalef32_pk32_bf16_fp6(GRPB(R), 1.0f)); \
      _Pragma("unroll") for (int j = 0; j < 16; j += 4) { a0_ = dot2(b_[j], hq[16 + j], a0_); a1_ = dot2(b_[j + 1], hq[17 + j], a1_); a2_ = dot2(b_[j + 2], hq[18 + j], a2_); a3_ = dot2(b_[j + 3], hq[19 + j], a3_); } } \
    asm volatile("" : "+v"(a0_), "+v"(a1_), "+v"(a2_), "+v"(a3_)); \
    OUT = (a0_ + a1_) + (a2_ + a3_); } while (0)
#define RSCAT(G) do { float q4[4], q2[2], q1; \
      { const bool up = (lane & 32) != 0; _Pragma("unroll") for (int i = 0; i < 4; ++i) { const float send = up ? p[i] : p[4 + i], keep = up ? p[4 + i] : p[i]; q4[i] = keep + __shfl_xor(send, 32); } } \
      { const bool up = (lane & 16) != 0; _Pragma("unroll") for (int i = 0; i < 2; ++i) { const float send = up ? q4[i] : q4[2 + i], keep = up ? q4[2 + i] : q4[i]; q2[i] = keep + __shfl_xor(send, 16); } } \
      { const bool up = (lane & 8) != 0; const float send = up ? q2[0] : q2[1], keep = up ? q2[1] : q2[0]; q1 = keep + __shfl_xor(send, 8); } \
      q1 += __shfl_xor(q1, 4); q1 += __shfl_xor(q1, 2); q1 += __shfl_xor(q1, 1); \
      const float got = __shfl(q1, 8 * (lane & 7)); \
      if ((lane >> 3) == ((G) & 7)) { if ((G) < 8) c0 = got; else c1 = got; } } while (0)
#pragma unroll 1
    for (int g = 0; g < 15; ++g) {
      float p[8];
      const int j = g * 8;
      UDOT(r0, p[0]); ELOAD(r0, j + 4, e0, e1, U6); UDOT(r1, p[1]); ELOAD(r1, j + 5, e0, e1, U6); UDOT(r2, p[2]); ELOAD(r2, j + 6, e0, e1, U6); UDOT(r3, p[3]); ELOAD(r3, j + 7, e0, e1, U6);
      UDOT(r0, p[4]); ELOAD(r0, j + 8, e0, e1, U6); UDOT(r1, p[5]); ELOAD(r1, j + 9, e0, e1, U6); UDOT(r2, p[6]); ELOAD(r2, j + 10, e0, e1, U6); UDOT(r3, p[7]); ELOAD(r3, j + 11, e0, e1, U6);
      RSCAT(g);
    }
    { float p[8];
      UDOT(r0, p[0]); ELOAD(r0, 124, e0, e1, U6); UDOT(r1, p[1]); ELOAD(r1, 125, e0, e1, U6); UDOT(r2, p[2]); ELOAD(r2, 126, e0, e1, U6); UDOT(r3, p[3]); ELOAD(r3, 127, e0, e1, U6);
      UDOT(r0, p[4]); ELOAD(r0, 0, e0, e1, V6); UDOT(r1, p[5]); ELOAD(r1, 1, e0, e1, V6); UDOT(r2, p[6]); ELOAD(r2, 2, e0, e1, V6); UDOT(r3, p[7]); ELOAD(r3, 3, e0, e1, V6);
      RSCAT(15); }
#undef RSCAT
#undef UDOT
    c0 = g0 * gelu_erf(c0 * (1.0f / U6SCALE)) * (1.0f / V6SCALE); c1 = g1 * gelu_erf(c1 * (1.0f / U6SCALE)) * (1.0f / V6SCALE);
    float acc[64];
#pragma unroll
    for (int i = 0; i < 64; ++i) acc[i] = 0.f;
#define PIN16(B) asm volatile("" : "+v"(acc[B]), "+v"(acc[B + 1]), "+v"(acc[B + 2]), "+v"(acc[B + 3]), "+v"(acc[B + 4]), "+v"(acc[B + 5]), "+v"(acc[B + 6]), "+v"(acc[B + 7]), \
    "+v"(acc[B + 8]), "+v"(acc[B + 9]), "+v"(acc[B + 10]), "+v"(acc[B + 11]), "+v"(acc[B + 12]), "+v"(acc[B + 13]), "+v"(acc[B + 14]), "+v"(acc[B + 15]))
#define VROW(R, C) do { asm volatile("" : "+v"(R[0].x)); \
    { const v32f f_ = __builtin_amdgcn_cvt_scalef32_pk32_f32_fp6(GRPA(R), 1.0f); _Pragma("unroll") for (int i = 0; i < 32; ++i) acc[i] += (C) * f_[i]; } PIN16(0); PIN16(16); \
    asm volatile("" : "+v"(R[1].z)); \
    { const v32f f_ = __builtin_amdgcn_cvt_scalef32_pk32_f32_fp6(GRPB(R), 1.0f); _Pragma("unroll") for (int i = 0; i < 32; ++i) acc[32 + i] += (C) * f_[i]; } PIN16(32); PIN16(48); } while (0)
#define CJ(j) __int_as_float(__builtin_amdgcn_readlane(__float_as_int((j) < 64 ? c0 : c1), (j) & 63))
#pragma unroll 1
    for (int j = 0; j < 124; j += 4) {
      { const float c = CJ(j); VROW(r0, c); ELOAD(r0, j + 4, e0, e1, V6); }
      { const float c = CJ(j + 1); VROW(r1, c); ELOAD(r1, j + 5, e0, e1, V6); }
      { const float c = CJ(j + 2); VROW(r2, c); ELOAD(r2, j + 6, e0, e1, V6); }
      { const float c = CJ(j + 3); VROW(r3, c); ELOAD(r3, j + 7, e0, e1, V6); }
    }
    { const float c = CJ(124); VROW(r0, c); ELOAD(r0, 0, e0n, e1n, U6); }
    { const float c = CJ(125); VROW(r1, c); ELOAD(r1, 1, e0n, e1n, U6); }
    { const float c = CJ(126); VROW(r2, c); ELOAD(r2, 2, e0n, e1n, U6); }
    { const float c = CJ(127); VROW(r3, c); ELOAD(r3, 3, e0n, e1n, U6); }
#undef VROW
#undef PIN16
#undef CJ
    int xo_ = 64 * lane; asm volatile("" : "+v"(xo_));
    float* xr = X1OUT + (size_t)t * 4096 + xo_; float ss = 0.f;
#pragma unroll
    for (int k = 0; k < 4; ++k) {
#pragma unroll
      for (int q = 0; q < 4; ++q) { const f32x4 a = *(const f32x4*)(xr + 16 * k + 4 * q); const int b_ = 16 * k + 4 * q;
        acc[b_] += a[0]; acc[b_ + 1] += a[1]; acc[b_ + 2] += a[2]; acc[b_ + 3] += a[3];
        ss += (acc[b_] * acc[b_] + acc[b_ + 1] * acc[b_ + 1]) + (acc[b_ + 2] * acc[b_ + 2] + acc[b_ + 3] * acc[b_ + 3]); }
      asm volatile("" ::: "memory"); __builtin_amdgcn_sched_barrier(0); }
    const float rstd = 1.0f / sqrtf(wave_sum(ss) * (1.0f / 4096.0f) + 1e-6f);
    const float* fn = fnorm + xo_;
#pragma unroll
    for (int k = 0; k < 4; ++k) {
#pragma unroll
      for (int q = 0; q < 4; ++q) { const f32x4 g = *(const f32x4*)(fn + 16 * k + 4 * q); const int b_ = 16 * k + 4 * q;
        f32x4 o; o[0] = acc[b_] * rstd * g[0]; o[1] = acc[b_ + 1] * rstd * g[1]; o[2] = acc[b_ + 2] * rstd * g[2]; o[3] = acc[b_ + 3] * rstd * g[3];
        if constexpr (STORE) { *(f32x4*)(xr + 16 * k + 4 * q) = o; } else { asm volatile("" :: "v"(o)); } }
      asm volatile("" ::: "memory"); __builtin_amdgcn_sched_barrier(0); }
    if (tn >= t_end) break;
    t = tn; e0 = e0n; e1 = e1n;
  }
#undef ELOAD
#undef GRPA
#undef GRPB
}
#undef PLAS
}

constexpr int BATCH = 2, SEQ = 8192, DM = 4096, T = BATCH * SEQ;
constexpr int NCAT = 15872;
constexpr int NPH = 12;
#ifndef MK_CUTS
#define MK_CUTS 1
#endif
constexpr float EPS = 1e-6f;
constexpr float LOG2E = 1.4426950408889634f;
constexpr float MLA_QSCALE = 0.07216878364870322f * LOG2E;
constexpr float S_WIN = 64.f, S_PAB = 32.f, S_WOUT = 64.f, S_OA = 64.f, S_OB = 16.f, S_MRG = 16.f;
constexpr float NA_QSCALE = 0.08838834764831845f * LOG2E;

constexpr size_t MiB = 1u << 20;
constexpr size_t WS_CTL = 0, CTL_ZERO_BYTES = 1 * MiB;
constexpr size_t WS_ROPE = 1 * MiB;
constexpr size_t WS_RS = 1 * MiB + 65536;
constexpr size_t WS_WCAT = 2 * MiB;
constexpr size_t WS_WUQ = WS_WCAT + 124 * MiB;
constexpr size_t WS_WUKV = WS_WUQ + 5 * MiB;
constexpr size_t WS_PA = WS_WUKV + 4 * MiB;
constexpr size_t WS_PB = WS_PA + 16 * MiB;
constexpr size_t WS_WOUT = WS_PB + 16 * MiB;
constexpr size_t WS_WQ = WS_WOUT + 32 * MiB;
constexpr size_t WS_SUBH = WS_WQ + 16 * MiB;
constexpr size_t WS_SUBL = WS_SUBH + 512 * 1024;
constexpr size_t WS_R1 = WS_SUBL + 512 * 1024;
constexpr size_t WS_LAT = WS_R1 + 128 * MiB;
constexpr size_t WS_R2 = WS_LAT + 48 * MiB;
constexpr size_t WS_R3 = WS_R2 + 192 * MiB;
constexpr size_t WS_R4 = WS_R3 + 256 * MiB;
constexpr size_t WS_KR = WS_R4 + 224 * MiB;
constexpr size_t WS_IDX = WS_KR + 2 * MiB;
constexpr size_t WS_GATE = WS_IDX + 8 * MiB;
constexpr size_t WS_END = WS_GATE + 8 * MiB;
constexpr int CW_TMO = 0, CW_BAR = 4096;

constexpr int RING_BYTES = 131072, LDSCTL_OFF = RING_BYTES, MISC_OFF = LDSCTL_OFF + 320, LDS_BYTES = 147456;
constexpr int NWAVES = 8;

#define GAS __attribute__((address_space(1)))
#define LAS __attribute__((address_space(3)))
typedef unsigned short bf16;
typedef unsigned v4u __attribute__((ext_vector_type(4)));
typedef float f32x4 __attribute__((ext_vector_type(4)));
typedef float f32x8 __attribute__((ext_vector_type(8)));
typedef GAS unsigned gu32;
#define RLX_AGENT __ATOMIC_RELAXED, __HIP_MEMORY_SCOPE_AGENT
#define LDS_WAIT() asm volatile("s_waitcnt lgkmcnt(0)" ::: "memory")
#define VM_WAIT() asm volatile("s_waitcnt vmcnt(0)" ::: "memory")
__device__ __forceinline__ unsigned pkbf(float lo, float hi) { unsigned r; asm volatile("v_cvt_pk_bf16_f32 %0, %1, %2" : "=v"(r) : "v"(lo), "v"(hi)); return r; }

#define XB_TMO      128
#define XB_XCNT(j)  (256  + 64 * (j))
#define XB_XSUB(j)  (1280 + 64 * (j))
#define XB_XGEN(j)  (2304 + 64 * (j))
#define XB_TOP      3328
#define XB_TOPGEN   3392
#define XCD_BAR_WORDS 3456
#define XB_SPIN_CAP (1u << 22)
__device__ __forceinline__ unsigned xb_ld(unsigned* p)              { return __hip_atomic_load(p, __ATOMIC_RELAXED, __HIP_MEMORY_SCOPE_AGENT); }
__device__ __forceinline__ unsigned xb_add(unsigned* p, unsigned v) { return __hip_atomic_fetch_add(p, v, __ATOMIC_RELAXED, __HIP_MEMORY_SCOPE_AGENT); }
__device__ __forceinline__ unsigned xb_xcc_id() { return (unsigned)__builtin_amdgcn_s_getreg((3 << 11) | 20) & 0xFu; }
#define XB_SPIN(cond, bar) do { unsigned _sp = 0; while (cond) { __builtin_amdgcn_s_sleep(1); \
    if ((++_sp & 255u) == 0u) { if (xb_ld(&(bar)[XB_TMO])) break; if (_sp > XB_SPIN_CAP) { atomicAdd(&(bar)[XB_TMO], 1u); break; } } } } while (0)
struct XcdBarrier { unsigned* bar; unsigned x; volatile LAS unsigned* st; };
__device__ __forceinline__ XcdBarrier xcd_barrier_post(unsigned* bar, volatile LAS unsigned* st) {
    XcdBarrier b; b.bar = bar; b.x = xb_xcc_id(); b.st = st;
    if (threadIdx.x == 0) (void)xb_add(&bar[XB_XCNT(b.x)], 1u);
    return b;
}
__device__ __forceinline__ void xcd_barrier_complete(unsigned* bar, unsigned x, unsigned& nloc, unsigned& nx) {
    const unsigned G = gridDim.x * gridDim.y * gridDim.z;
    unsigned sum, cnt, mine, sp = 0u;
    for (;;) {
        sum = 0u; cnt = 0u; mine = 0u;
#pragma unroll
        for (unsigned j = 0; j < 16; ++j) { const unsigned c = xb_ld(&bar[XB_XCNT(j)]); sum += c; cnt += (c > 0u) ? 1u : 0u; mine = (j == x) ? c : mine; }
        if (sum == G) break;
        __builtin_amdgcn_s_sleep(1);
        if ((++sp & 255u) == 0u) { if (xb_ld(&bar[XB_TMO])) break; if (sp > XB_SPIN_CAP) { atomicAdd(&bar[XB_TMO], 1u); break; } }
    }
    nloc = mine > 0u ? mine : 1u; nx = cnt > 0u ? cnt : 1u;
}
__device__ __forceinline__ void xcd_barrier(const XcdBarrier& b) {
    asm volatile("s_waitcnt vmcnt(0)" ::: "memory");
    __syncthreads();
    if (threadIdx.x == 0) {
        unsigned* bar = b.bar;
        __builtin_amdgcn_s_waitcnt(0);
        unsigned nloc = b.st[0], nx = b.st[1];
        if (nloc == 0u) { xcd_barrier_complete(bar, b.x, nloc, nx); b.st[0] = nloc; b.st[1] = nx; }
        const unsigned old = xb_add(&bar[XB_XSUB(b.x)], 1u);
        const unsigned gen = old / nloc;
        if (old + 1u == (gen + 1u) * nloc) {
            __builtin_amdgcn_fence(__ATOMIC_RELEASE, "agent");
            asm volatile("s_waitcnt vmcnt(0)" ::: "memory");
            const unsigned og = xb_add(&bar[XB_TOP], 1u);
            const unsigned tg = og / nx;
            if (og + 1u == (tg + 1u) * nx) xb_add(&bar[XB_TOPGEN], 1u);
            else XB_SPIN(xb_ld(&bar[XB_TOPGEN]) == tg, bar);
            __builtin_amdgcn_fence(__ATOMIC_ACQUIRE, "agent");
            xb_add(&bar[XB_XGEN(b.x)], 1u);
            asm volatile("s_waitcnt vmcnt(0)" ::: "memory");
        } else {
            XB_SPIN(xb_ld(&bar[XB_XGEN(b.x)]) == gen, bar);
            __builtin_amdgcn_fence(__ATOMIC_ACQUIRE, "agent");
            asm volatile("s_waitcnt vmcnt(0)" ::: "memory");
        }
    }
    __syncthreads();
}

__device__ __forceinline__ float wave_sum(float v) {
#pragma unroll
    for (int o = 1; o < 64; o <<= 1) v += __shfl_xor(v, o);
    return v;
}
__device__ __forceinline__ void transpose_item(const float* W, int N, bf16* WT, int ldt, int row_off, const float* gk, LAS float* scr, int kb, int nb, int lane) {
    const int k0 = 64 * kb, n0 = 32 * nb;
#pragma unroll 8
    for (int i = 0; i < 32; ++i) { const int kk = 2 * i + (lane >> 5); float w = W[(size_t)(k0 + kk) * N + n0 + (lane & 31)]; if (gk) w *= gk[k0 + kk]; scr[kk * 33 + (lane & 31)] = w; }
    LDS_WAIT(); asm volatile("" ::: "memory");
    const int c = lane & 7;
#pragma unroll
    for (int j = 0; j < 4; ++j) { const int n = (lane >> 3) + 8 * j; const LAS float* s = scr + (8 * c) * 33 + n;
        v4u o; o.x = pkbf(s[0 * 33], s[1 * 33]); o.y = pkbf(s[2 * 33], s[3 * 33]); o.z = pkbf(s[4 * 33], s[5 * 33]); o.w = pkbf(s[6 * 33], s[7 * 33]);
        *(GAS v4u*)(WT + (size_t)(row_off + n0 + n) * ldt + k0 + 8 * c) = o; }
    LDS_WAIT(); asm volatile("" ::: "memory");
}
__device__ __forceinline__ void rms_row_to_bf16(const float* xrow, const float* gain, bf16* orow, int lane) {
    const GAS f32x4* xr = (const GAS f32x4*)xrow + lane; const GAS f32x4* gr = (const GAS f32x4*)gain + lane;
    f32x4 v[16]; float s = 0.f;
#pragma unroll
    for (int j = 0; j < 16; ++j) { v[j] = xr[64 * j]; s += (v[j].x * v[j].x + v[j].y * v[j].y) + (v[j].z * v[j].z + v[j].w * v[j].w); }
    const float rstd = 1.f / sqrtf(wave_sum(s) * (1.f / DM) + EPS);
    GAS unsigned long long* o8 = (GAS unsigned long long*)orow + lane;
#pragma unroll
    for (int j = 0; j < 16; ++j) { const f32x4 g = gr[64 * j];
        o8[64 * j] = (unsigned long long)pkbf(v[j].x * rstd * g.x, v[j].y * rstd * g.y) | ((unsigned long long)pkbf(v[j].z * rstd * g.z, v[j].w * rstd * g.w) << 32); }
}

__device__ __forceinline__ unsigned pk4f8(float a, float b, float c, float d) { int w = __builtin_amdgcn_cvt_pk_fp8_f32(a, b, 0, false); w = __builtin_amdgcn_cvt_pk_fp8_f32(c, d, w, true); return (unsigned)w; }
__device__ __forceinline__ void transpose_item8(const float* W, int N, unsigned char* WT, int ldt, int row_off, float scale, LAS float* scr, int kb, int nb, int lane) {
    const int k0 = 64 * kb, n0 = 32 * nb;
#pragma unroll 8
    for (int i = 0; i < 32; ++i) { const int kk = 2 * i + (lane >> 5); scr[kk * 33 + (lane & 31)] = W[(size_t)(k0 + kk) * N + n0 + (lane & 31)] * scale; }
    LDS_WAIT(); asm volatile("" ::: "memory");
    const int n = lane >> 1, kh = (lane & 1) * 32; const LAS float* s = scr + kh * 33 + n;
#pragma unroll
    for (int j = 0; j < 2; ++j) { v4u o;
        o.x = pk4f8(s[(16 * j + 0) * 33], s[(16 * j + 1) * 33], s[(16 * j + 2) * 33], s[(16 * j + 3) * 33]); o.y = pk4f8(s[(16 * j + 4) * 33], s[(16 * j + 5) * 33], s[(16 * j + 6) * 33], s[(16 * j + 7) * 33]);
        o.z = pk4f8(s[(16 * j + 8) * 33], s[(16 * j + 9) * 33], s[(16 * j + 10) * 33], s[(16 * j + 11) * 33]); o.w = pk4f8(s[(16 * j + 12) * 33], s[(16 * j + 13) * 33], s[(16 * j + 14) * 33], s[(16 * j + 15) * 33]);
        *(GAS v4u*)(WT + (size_t)(row_off + n0 + n) * ldt + k0 + kh + 16 * j) = o; }
    LDS_WAIT(); asm volatile("" ::: "memory");
}
__device__ __forceinline__ void rms_row_to_fp8(const float* xrow, const float* gain, unsigned char* orow, int lane) {
    const GAS f32x4* xr = (const GAS f32x4*)xrow + lane; const GAS f32x4* gr = (const GAS f32x4*)gain + lane;
    f32x4 v[16]; float s = 0.f;
#pragma unroll
    for (int j = 0; j < 16; ++j) { v[j] = xr[64 * j]; s += (v[j].x * v[j].x + v[j].y * v[j].y) + (v[j].z * v[j].z + v[j].w * v[j].w); }
    const float rstd = 1.f / sqrtf(wave_sum(s) * (1.f / DM) + EPS);
    GAS unsigned* o4 = (GAS unsigned*)orow + lane;
#pragma unroll
    for (int j = 0; j < 16; ++j) { const f32x4 g = gr[64 * j]; o4[64 * j] = pk4f8(v[j].x * rstd * g.x, v[j].y * rstd * g.y, v[j].z * rstd * g.z, v[j].w * rstd * g.w); }
}

struct Args {
    const float* in[19]; float* out; unsigned char* ws; int ph_lo, ph_hi, use_bar, pad;
};

__global__ void __launch_bounds__(NWAVES * 64, 2) mk_fwd(Args args) {
    extern __shared__ __attribute__((aligned(16))) unsigned char lds[];
    LAS unsigned char* ldsl = (LAS unsigned char*)lds;
    volatile LAS unsigned* MISC = (volatile LAS unsigned*)(ldsl + MISC_OFF);
    const int tid = threadIdx.x, lane = tid & 63, wave = __builtin_amdgcn_readfirstlane(tid >> 6);
    const int G = gridDim.x, bx = blockIdx.x;
    const int vcu = (G % 8 == 0) ? (bx % 8) * (G / 8) + bx / 8 : bx;
    const int gw = vcu * NWAVES + wave, NGW = G * NWAVES;
    unsigned char* ws = args.ws;
    gu32* ctl = (gu32*)(ws + WS_CTL);
    const float* x = args.in[0]; const float* attn_norm = args.in[1]; const float* w_in = args.in[2]; const float* q_norm = args.in[3]; const float* w_uq = args.in[4];
    const float* kv_norm = args.in[5]; const float* w_ukv = args.in[6]; const float* w_bmla = args.in[7]; const float* na_rpb = args.in[8]; const float* w_bna = args.in[9];
    const float* w_gate = args.in[10]; const float* b_gate = args.in[11]; const float* w_out = args.in[12]; const float* ffn_norm = args.in[13]; const float* peer_wq = args.in[14];
    const float* peer_sub = args.in[15]; const float* peer_u = args.in[16]; const float* peer_v = args.in[17]; const float* final_norm = args.in[18];
    float* out = args.out;
    float* ROPE = (float*)(ws + WS_ROPE); float* RS = (float*)(ws + WS_RS);
    bf16* WCAT = (bf16*)(ws + WS_WCAT); bf16* WUQ = (bf16*)(ws + WS_WUQ); bf16* WUKV = (bf16*)(ws + WS_WUKV); bf16* PA = (bf16*)(ws + WS_PA); bf16* PB = (bf16*)(ws + WS_PB);
    bf16* WOUT = (bf16*)(ws + WS_WOUT); bf16* WQ = (bf16*)(ws + WS_WQ); bf16* SUBH = (bf16*)(ws + WS_SUBH); bf16* SUBL = (bf16*)(ws + WS_SUBL);
    unsigned char* XN8 = ws + WS_R1; unsigned char* OA8 = ws + WS_R1; unsigned char* OB8 = ws + WS_R1 + 32 * MiB; bf16* H2 = (bf16*)(ws + WS_R1);
    bf16* LAT = (bf16*)(ws + WS_LAT);
    bf16* NAQ = (bf16*)(ws + WS_R2); bf16* NAK = (bf16*)(ws + WS_R2 + 64 * MiB); bf16* NAV = (bf16*)(ws + WS_R2 + 128 * MiB); bf16* MRG = (bf16*)(ws + WS_R2); unsigned char* MRG8 = ws + WS_R2 + 128 * MiB;
    bf16* GT = (bf16*)(ws + WS_R3); unsigned char* U8 = ws + WS_R3; unsigned char* V8 = ws + WS_R3 + 64 * MiB;
    unsigned char* Q8 = ws + WS_R4; unsigned char* K8 = ws + WS_R4 + 48 * MiB; unsigned char* VT8 = ws + WS_R4 + 96 * MiB; float* QP = (float*)(ws + WS_R4);
    bf16* KR = (bf16*)(ws + WS_KR); int* IDX = (int*)(ws + WS_IDX); float* GATE = (float*)(ws + WS_GATE);

    for (int u = tid; u < (LDS_BYTES - LDSCTL_OFF) / 4; u += NWAVES * 64) ((LAS unsigned*)(ldsl + LDSCTL_OFF))[u] = 0u;
    __syncthreads();
    XcdBarrier bar; bar.bar = (unsigned*)(ctl + CW_BAR); bar.x = 0; bar.st = nullptr;
    if (args.use_bar) bar = xcd_barrier_post((unsigned*)(ctl + CW_BAR), MISC + 8);
    const int lo = args.ph_lo, hi = args.ph_hi;
#ifndef MK_PHMASK
#define MK_PHMASK 0xFFF
#endif
#define IN(k) (((MK_PHMASK >> (k)) & 1) && lo <= (k) && (k) < hi)
#ifndef MK_VAR
#define MK_VAR 0
#endif
#ifndef MK_DUP4
#define MK_DUP4 0
#endif
#ifndef MK_FAKE
#define MK_FAKE false
#endif
#ifndef MK_DUP
#define MK_DUP -1
#endif
#define REPS(k) ((MK_DUP == (k)) ? 2 : 1)
#define SEAM(k) do { if (IN(k) && IN((k) + 1)) xcd_barrier(bar); } while (0)

    for (int rep_ = 0; rep_ < REPS(0); ++rep_) if (IN(0)) {
        LAS float* scr = (LAS float*)(ldsl + wave * 16384);
        constexpr int I0 = 64 * 234, I1 = 64 * 256, I2 = 12 * 96, I3 = 8 * 128, I4 = 32 * 128, I5 = 32 * 128, I6 = 64 * 128, I7 = 64 * 64;
        constexpr int NITEMS = I0 + I1 + I2 + I3 + I4 + I5 + I6 + I7;
        for (int it = gw; it < NITEMS; it += NGW) {
            int r = it;
            if (r < I0) { const int kb = r / 234, nb = r % 234; const int off = (nb >= 42) ? 192 : 0; transpose_item8(w_in, 7488, (unsigned char*)WCAT, 4096, off, S_WIN, scr, kb, nb, lane); continue; } r -= I0;
            if (r < I1) { transpose_item8(w_gate, 8192, (unsigned char*)WCAT, 4096, 7680, S_WIN, scr, r / 256, r % 256, lane); continue; } r -= I1;
            if (r < I2) { transpose_item(w_uq, 3072, WUQ, 768, 0, q_norm, scr, r / 96, r % 96, lane); continue; } r -= I2;
            if (r < I3) { transpose_item(w_ukv, 4096, WUKV, 512, 0, kv_norm, scr, r / 128, r % 128, lane); continue; } r -= I3;
            if (r < I4) { transpose_item8(w_bmla, 4096, (unsigned char*)PA, 2048, 0, S_PAB, scr, r / 128, r % 128, lane); continue; } r -= I4;
            if (r < I5) { transpose_item8(w_bna, 4096, (unsigned char*)PB, 2048, 0, S_PAB, scr, r / 128, r % 128, lane); continue; } r -= I5;
            if (r < I6) { transpose_item8(w_out, 4096, (unsigned char*)WOUT, 4096, 0, S_WOUT, scr, r / 128, r % 128, lane); continue; } r -= I6;
            transpose_item(peer_wq, 2048, WQ, 4096, 0, nullptr, scr, r / 64, r % 64, lane);
        }
        for (int i = gw * 64 + lane; i < 192 * 4096 / 16; i += NGW * 64) ((GAS v4u*)((unsigned char*)WCAT + (size_t)1344 * 4096))[i] = (v4u){0u, 0u, 0u, 0u};
        for (int i = gw * 64 + lane; i < 8 * 2 * 128 * 128 / 2; i += NGW * 64) { const float a = peer_sub[2 * i], b = peer_sub[2 * i + 1];
            const unsigned h = pkbf(a, b); const unsigned l = pkbf(a - __uint_as_float(h << 16), b - __uint_as_float(h & 0xffff0000u));
            ((GAS unsigned*)SUBH)[i] = h; ((GAS unsigned*)SUBL)[i] = l; }
        for (int i = gw * 64 + lane; i < 128 * 16; i += NGW * 64) { const int pos = i >> 4, j = i & 15; const float fr = powf(10000.0f, -(float)j / 16.0f); const float ang = (float)pos * fr;
            ROPE[2 * i] = cosf(ang); ROPE[2 * i + 1] = sinf(ang); }
        for (int m = gw; m < T; m += NGW) rms_row_to_fp8(x + (size_t)m * DM, attn_norm, XN8 + (size_t)m * DM, lane);
    }
    SEAM(0);
    for (int rep_ = 0; rep_ < REPS(1); ++rep_) if (IN(1)) {
        pg8::Gemm g{(const bf16*)XN8, WCAT, T, NCAT, DM, DM, DM}; pg8::StaticOrder S; S.init(T, NCAT, G, bx);
        pg8::EpiIn E{ws, WS_LAT, WS_R2, 64 * MiB, WS_R3, b_gate, NA_QSCALE, 1.0f / S_WIN};
        pg8::gemm_phase<pg8::EpiIn, pg8::StaticOrder, true, true>(ldsl, g, S, E);
    }
    SEAM(1);
    for (int rep_ = 0; rep_ < REPS(2); ++rep_) if (IN(2)) {
        for (int m = gw; m < T; m += NGW) {
            const bf16* row = LAT + (size_t)m * 1536;
            float sq = 0.f, skv = 0.f;
#pragma unroll
            for (int j = 0; j < 6; ++j) { const unsigned w = ((const GAS unsigned*)row)[lane + 64 * j]; const float a = __uint_as_float(w << 16), b = __uint_as_float(w & 0xffff0000u); sq += a * a + b * b; }
#pragma unroll
            for (int j = 0; j < 4; ++j) { const unsigned w = ((const GAS unsigned*)(row + 768))[lane + 64 * j]; const float a = __uint_as_float(w << 16), b = __uint_as_float(w & 0xffff0000u); skv += a * a + b * b; }
            sq = wave_sum(sq); skv = wave_sum(skv);
            if (lane == 0) { RS[2 * m] = 1.f / sqrtf(sq * (1.f / 768.f) + EPS); RS[2 * m + 1] = 1.f / sqrtf(skv * (1.f / 512.f) + EPS); }
            const float xk = __uint_as_float((unsigned)row[1280 + lane] << 16);
            const float xp = __shfl_xor(xk, 16);
            const int s = m & (SEQ - 1), pos = (lane < 32) ? (s >> 6) : (s & 63), j = lane & 15;
            const float c = ROPE[(pos * 16 + j) * 2], sn = ROPE[(pos * 16 + j) * 2 + 1];
            const float o = ((lane & 16) == 0) ? (xk * c - xp * sn) : (xp * sn + xk * c);
            KR[(size_t)m * 64 + lane] = (bf16)(pkbf(o, 0.f) & 0xffffu);
            { const unsigned char o8 = (unsigned char)(__builtin_amdgcn_cvt_pk_fp8_f32(o, 0.f, 0, false) & 0xff);
#pragma unroll
              for (int hh = 0; hh < 16; ++hh) K8[((size_t)m * 16 + hh) * 192 + 128 + lane] = o8; }
        }
    }
    SEAM(2);
    for (int rep_ = 0; rep_ < REPS(3); ++rep_) if (IN(3)) {
        { pg8::Gemm g{LAT, WUQ, T, 3072, 768, 1536, 768}; pg8::StaticOrder S; S.init(T, 3072, G, bx);
          pg8::EpiQ8 E{Q8, RS, ROPE, MLA_QSCALE * att8::SQ8};
          pg8::gemm_phase<pg8::EpiQ8, pg8::StaticOrder>(ldsl, g, S, E); }
        { pg8::Gemm g{LAT + 768, WUKV, T, 4096, 512, 1536, 512}; pg8::StaticOrder S; S.init(T, 4096, G, bx);
          pg8::EpiKV8 E{K8, VT8, RS};
          pg8::gemm_phase<pg8::EpiKV8, pg8::StaticOrder>(ldsl, g, S, E); }
    }
    SEAM(3);
    for (int rep_ = 0; rep_ < REPS(4); ++rep_) if (IN(4)) {
#ifndef NO_MLA
        if (!(MK_DUP == 4 && rep_ == 0 && MK_DUP4 == 2))
#pragma unroll 1
        for (int u = vcu; u < BATCH * 16 * 32; u += G) { const int bh = u >> 5, qb = u & 31; if (MK_DUP == 4 && rep_ == 0) att8::mla8_unit<MK_VAR>(bh >> 4, bh & 15, qb, Q8, K8, VT8, OA8, S_OA, (char*)lds); else att8::mla8_unit<0>(bh >> 4, bh & 15, qb, Q8, K8, VT8, OA8, S_OA, (char*)lds); }
#endif
#ifndef NO_NA
        if (!(MK_DUP == 4 && rep_ == 0 && MK_DUP4 == 1))
#pragma unroll 1
        for (int u = vcu; u < BATCH * 16 * 32; u += G) { const int bh = u >> 5, rg = u & 31; att::na_unit(bh >> 4, bh & 15, rg, NAQ, NAK, NAV, na_rpb, OB8, S_OB, (char*)lds); }
#endif
        __syncthreads();
    }
    SEAM(4);

#ifdef MK_CHECK
    {
        xcd_barrier(bar);
        gu32* chk = ctl + 8192;
        const float* xin_q_norm = q_norm; const float* xin_kv_norm = kv_norm;
#define F8DEC(byte) __builtin_amdgcn_cvt_f32_fp8((int)(byte), 0)
        if (bx < 8 && wave == 0) {
            const int ts[8] = {0, 37, 1000, 8191, 8192 + 5, 12345, 16000, 16383}; const int m = ts[bx];
            const bf16* row = LAT + (size_t)m * 1536; float sq = 0.f, skv = 0.f;
            for (int k = lane; k < 768; k += 64) { const float a = __uint_as_float((unsigned)row[k] << 16); sq += a * a; }
            for (int k = lane; k < 512; k += 64) { const float a = __uint_as_float((unsigned)row[768 + k] << 16); skv += a * a; }
            sq = wave_sum(sq); skv = wave_sum(skv);
            const float rq = 1.f / sqrtf(sq / 768.f + EPS), rkv = 1.f / sqrtf(skv / 512.f + EPS);
            float err = fmaxf(fabsf(RS[2 * m] - rq) / rq, fabsf(RS[2 * m + 1] - rkv) / rkv);
            const int s_ = m & (SEQ - 1), half = lane >> 5, j = lane & 15, hiq = (lane >> 4) & 1; const float pos = half ? (float)(s_ & 63) : (float)(s_ >> 6);
            const float ang = pos * powf(10000.0f, -(float)j / 16.0f), cs = cosf(ang), sn = sinf(ang);
            const float x1 = __uint_as_float((unsigned)row[1280 + half * 32 + j] << 16), x2 = __uint_as_float((unsigned)row[1280 + half * 32 + 16 + j] << 16);
            const float ref = hiq ? (x1 * sn + x2 * cs) : (x1 * cs - x2 * sn);
            const float got = __uint_as_float((unsigned)KR[(size_t)m * 64 + lane] << 16);
            float e2 = fabsf(got - ref); e2 = fmaxf(e2, __shfl_xor(e2, 1)); e2 = fmaxf(e2, __shfl_xor(e2, 2)); e2 = fmaxf(e2, __shfl_xor(e2, 4)); e2 = fmaxf(e2, __shfl_xor(e2, 8)); e2 = fmaxf(e2, __shfl_xor(e2, 16)); e2 = fmaxf(e2, __shfl_xor(e2, 32));
            err = fmaxf(err, e2);
            { float e3 = fabsf(F8DEC(K8[((size_t)m * 16 + 5) * 192 + 128 + lane]) - ref) - 0.07f * fabsf(ref); e3 = fmaxf(e3, __shfl_xor(e3, 1)); e3 = fmaxf(e3, __shfl_xor(e3, 2)); e3 = fmaxf(e3, __shfl_xor(e3, 4)); e3 = fmaxf(e3, __shfl_xor(e3, 8)); e3 = fmaxf(e3, __shfl_xor(e3, 16)); e3 = fmaxf(e3, __shfl_xor(e3, 32)); err = fmaxf(err, e3 + 0.03f); }
            if (lane == 0 && !(err < 0.05f)) atomicOr((unsigned*)chk, 1u);
        }
        if (bx >= 8 && bx < 16 && wave == 0) {
            const int ts[4] = {3, 4099, 12345, 16300}; const int m = ts[(bx - 8) & 3] + ((bx - 8) >> 2) * 64;
            {
                const int head = (lane * 5) & 15, kind = lane % 6, i = (lane * 7) & 31; const int col = head * 192 + kind * 32 + i;
                const int pcol = (kind >= 4) ? (head * 192 + kind * 32 + (i ^ 16)) : col;
                const bf16* row = LAT + (size_t)m * 1536; float a = 0.f, b = 0.f, sq = 0.f;
                for (int k = 0; k < 768; ++k) { const float c = __uint_as_float((unsigned)row[k] << 16); sq += c * c; const float cg = c * xin_q_norm[k]; a += cg * w_uq[(size_t)k * 3072 + col]; b += cg * w_uq[(size_t)k * 3072 + pcol]; }
                const float rq = 1.f / sqrtf(sq / 768.f + EPS); a *= rq; b *= rq; float ref = a;
                if (kind >= 4) { const int s_ = m & (SEQ - 1); const float pos = (kind == 4) ? (float)(s_ >> 6) : (float)(s_ & 63); const int j = i & 15; const float ang = pos * powf(10000.0f, -(float)j / 16.0f), cs = cosf(ang), sn = sinf(ang);
                    ref = (i < 16) ? (a * cs - b * sn) : (b * sn + a * cs); }
                ref *= MLA_QSCALE;
                const float got = F8DEC(Q8[(size_t)m * 3072 + col]) * (1.0f / att8::SQ8);
                if (!(fabsf(got - ref) < 0.08f * (0.03f + fabsf(ref)))) atomicOr((unsigned*)chk + 1, 1u);
            }
            {
                const int col = (lane * 67 + 13) & 4095; const bf16* row = LAT + (size_t)m * 1536 + 768; float a = 0.f, sq = 0.f;
                for (int k = 0; k < 512; ++k) { const float c = __uint_as_float((unsigned)row[k] << 16); sq += c * c; a += c * xin_kv_norm[k] * w_ukv[(size_t)k * 4096 + col]; }
                a *= 1.f / sqrtf(sq / 512.f + EPS);
                const int h = col >> 8, c = col & 255;
                const float got = (c < 128) ? F8DEC(K8[((size_t)m * 16 + h) * 192 + c]) : F8DEC(VT8[((size_t)((m >> 13) * 16 + h) * 128 + (c - 128)) * 8192 + (m & 8191)]);
                if (!(fabsf(got - a) < 0.08f * (0.2f + fabsf(a)))) atomicOr((unsigned*)chk + 2, 1u);
            }
        }
        if (bx >= 16 && bx < 48) {
            const int si = bx - 16; const int ts[8] = {1, 255, 256, 4097, 8190, 8192 + 77, 12000, 16383}; const int m = ts[si & 7], h = (si * 5 + (si >> 3) * 3) & 15;
            const int b = m >> 13; LAS float* sc = (LAS float*)ldsl; LAS float* red = sc + 8192; LAS float* qs = red + 512;
            if (tid < 192) qs[tid] = F8DEC(Q8[(size_t)m * 3072 + h * 192 + tid]) * (1.0f / att8::SQ8);
            __syncthreads();
            float mx = -1e30f;
            for (int k = tid; k < SEQ; k += 512) { const size_t kt = (size_t)b * SEQ + k; float s_ = 0.f;
                for (int d = 0; d < 192; ++d) s_ += qs[d] * F8DEC(K8[(kt * 16 + h) * 192 + d]);
                sc[k] = s_; mx = fmaxf(mx, s_); }
            red[tid] = mx; __syncthreads();
            for (int o = 256; o > 0; o >>= 1) { if (tid < o) red[tid] = fmaxf(red[tid], red[tid + o]); __syncthreads(); }
            mx = red[0]; __syncthreads();
            float sm = 0.f;
            for (int k = tid; k < SEQ; k += 512) { const float p_ = exp2f(sc[k] - mx); sc[k] = p_; sm += p_; }
            red[tid] = sm; __syncthreads();
            for (int o = 256; o > 0; o >>= 1) { if (tid < o) red[tid] += red[tid + o]; __syncthreads(); }
            sm = red[0]; __syncthreads();
            const int d = tid & 127, part = tid >> 7; float acc_ = 0.f;
            for (int k = part * 2048; k < (part + 1) * 2048; ++k) acc_ += sc[k] * F8DEC(VT8[((size_t)(b * 16 + h) * 128 + d) * 8192 + k]);
            red[tid] = acc_; __syncthreads();
            float e2 = 0.f, r2 = 0.f;
            if (tid < 128) { const float ref = (red[tid] + red[tid + 128] + red[tid + 256] + red[tid + 384]) / sm;
                const int w_ = (int)OA8[(size_t)m * 2048 + h * 128 + tid]; const float got = __builtin_amdgcn_cvt_f32_fp8(w_, 0) * (1.0f / S_OA);
                e2 = (got - ref) * (got - ref); r2 = ref * ref; }
            __syncthreads();
            if (tid < 128) { red[tid] = e2; red[128 + tid] = r2; }
            __syncthreads();
            if (tid == 0) { float se = 0.f, sr = 0.f; for (int i = 0; i < 128; ++i) { se += red[i]; sr += red[128 + i]; }
                if (!(se < 0.01f * sr)) atomicOr((unsigned*)chk + 3, 1u); }
            __syncthreads();
        }
#undef F8DEC
        xcd_barrier(bar);
    }
#endif
    for (int rep_ = 0; rep_ < REPS(5); ++rep_) if (IN(5)) {
        { pg8::Gemm g{(const bf16*)OA8, PA, T, DM, 2048, 2048, 2048}; pg8::StaticOrder S; S.init(T, DM, G, bx);
          pg8::EpiGate<true> E{GT, MRG, nullptr, 1.0f / (S_OA * S_PAB), 0.f};
          pg8::gemm_phase<pg8::EpiGate<true>, pg8::StaticOrder, true, true>(ldsl, g, S, E); }
    }
    SEAM(5);
    for (int rep_ = 0; rep_ < REPS(6); ++rep_) if (IN(6)) {
        { pg8::Gemm g{(const bf16*)OB8, PB, T, DM, 2048, 2048, 2048}; pg8::StaticOrder S; S.init(T, DM, G, bx);
          pg8::EpiGate<false> E{GT, MRG, MRG8, 1.0f / (S_OB * S_PAB), S_MRG};
          pg8::gemm_phase<pg8::EpiGate<false>, pg8::StaticOrder, true, true>(ldsl, g, S, E); }
    }
    SEAM(6);
    for (int rep_ = 0; rep_ < REPS(7); ++rep_) if (IN(7)) {
        pg8::Gemm g{(const bf16*)MRG8, WOUT, T, DM, DM, DM, DM}; pg8::StaticOrder S; S.init(T, DM, G, bx);
        pg8::EpiF32 E{x, out, DM, 1.0f / (S_MRG * S_WOUT)};
        pg8::gemm_phase<pg8::EpiF32, pg8::StaticOrder, true, true>(ldsl, g, S, E);
#ifdef PROBE_SKIP_ATTN
        VM_WAIT(); __syncthreads();
        for (size_t i = (size_t)gw * 64 + lane; i < (size_t)T * DM / 4; i += (size_t)NGW * 64) ((GAS f32x4*)out)[i] = ((const GAS f32x4*)x)[i];
#endif
    }
    SEAM(7);
    for (int rep_ = 0; rep_ < REPS(8); ++rep_) if (IN(8)) {
        for (int m = gw; m < T; m += NGW) rms_row_to_bf16(out + (size_t)m * DM, ffn_norm, H2 + (size_t)m * DM, lane);
        for (int r = gw; r < 2 * 16384; r += NGW) { const bool isu = r < 16384; const int e = isu ? r : r - 16384;
            peer::pack_row_fp6((isu ? peer_u : peer_v) + (size_t)e * DM, (isu ? U8 : V8) + (size_t)e * peer::ROW6, isu ? peer::U6SCALE : peer::V6SCALE, lane); }
    }
    SEAM(8);
    for (int rep_ = 0; rep_ < REPS(9); ++rep_) if (IN(9)) {
        pg8::Gemm g{H2, WQ, T, 2048, DM, DM, DM}; pg8::StaticOrder S; S.init(T, 2048, G, bx);
        pg8::EpiF32 E{nullptr, QP, 2048, 1.0f};
        pg8::gemm_phase<pg8::EpiF32, pg8::StaticOrder>(ldsl, g, S, E);
    }
    SEAM(9);
    for (int rep_ = 0; rep_ < REPS(10); ++rep_) if (IN(10)) {
        LAS int* wl = (LAS int*)(ldsl + wave * peer::SEL_LDS_PER_WAVE);
        for (int it = gw; it < (T / 32) * 8; it += NGW) peer::select32((it >> 3) * 32, it & 7, QP, SUBH, SUBL, IDX, GATE, wl, lane);
    }
    SEAM(10);
    for (int rep_ = 0; rep_ < REPS(11); ++rep_) if (IN(11)) {
#ifdef PROBE_SKIP_PEER
        for (int t = gw; t < T; t += NGW) { float* xr = out + (size_t)t * DM; f32x4 v[16]; float ss = 0.f;
            for (int j = 0; j < 16; ++j) { v[j] = ((const GAS f32x4*)xr)[lane + 64 * j]; ss += v[j].x * v[j].x + v[j].y * v[j].y + v[j].z * v[j].z + v[j].w * v[j].w; }
            const float rstd = 1.f / sqrtf(wave_sum(ss) * (1.f / DM) + EPS);
            for (int j = 0; j < 16; ++j) { const f32x4 g = ((const GAS f32x4*)final_norm)[lane + 64 * j]; ((GAS f32x4*)xr)[lane + 64 * j] = v[j] * rstd * g; } }
#else
        if (MK_DUP == 11 && rep_ == 0) peer::expert_tokens6<false>(gw, NGW, T, H2, U8, V8, IDX, GATE, out, final_norm, lane);
        else peer::expert_tokens6<true>(gw, NGW, T, H2, U8, V8, IDX, GATE, out, final_norm, lane);
#endif
    }

#ifdef MK_CHECK
    {
        xcd_barrier(bar);
        gu32* chk = ctl + 8192;
        const unsigned f0 = __hip_atomic_load(chk, RLX_AGENT), f1 = __hip_atomic_load(chk + 1, RLX_AGENT), f2 = __hip_atomic_load(chk + 2, RLX_AGENT), f3 = __hip_atomic_load(chk + 3, RLX_AGENT);
        const int nz = (f0 ? T / 2 : 0) + (f1 ? T / 4 : 0) + (f2 ? T / 8 : 0) + (f3 ? T / 16 : 0);
        for (int m = gw; m < nz; m += NGW) for (int j = 0; j < 16; ++j) ((GAS f32x4*)(out + (size_t)m * DM))[lane + 64 * j] = (f32x4){0.f, 0.f, 0.f, 0.f};
    }
#endif
#undef IN
#undef SEAM
}

extern "C" void kernel_launch(void* const* d_in, const int* in_sizes, int n_in, void* d_out, int out_size, void* d_ws, size_t ws_size, hipStream_t stream) {
    static int grid = 0;
    if (grid == 0) {
        if (n_in != 19 || out_size != T * DM || ws_size < WS_END) { fprintf(stderr, "kernel_launch: shape mismatch: n_in %d out %d ws %zu (need %zu)\n", n_in, out_size, ws_size, (size_t)WS_END); grid = -1; return; }
        int dev = 0, cus = 0, per_cu = 0;
        if (hipGetDevice(&dev) != hipSuccess || hipDeviceGetAttribute(&cus, hipDeviceAttributeMultiprocessorCount, dev) != hipSuccess) { grid = -1; return; }
        if (hipFuncSetAttribute((const void*)mk_fwd, hipFuncAttributeMaxDynamicSharedMemorySize, LDS_BYTES) != hipSuccess) { fprintf(stderr, "kernel_launch: hipFuncSetAttribute failed\n"); grid = -1; return; }
        if (hipOccupancyMaxActiveBlocksPerMultiprocessor(&per_cu, (const void*)mk_fwd, NWAVES * 64, LDS_BYTES) != hipSuccess || per_cu < 1) { fprintf(stderr, "kernel_launch: occupancy query says %d blocks per CU\n", per_cu); }
        (void)hipGetLastError();
        grid = cus;
    }
    if (grid < 0) return;
    if (hipMemsetAsync((char*)d_ws + WS_CTL, 0, CTL_ZERO_BYTES, stream) != hipSuccess) return;
    Args a{};
    for (int i = 0; i < 19; ++i) a.in[i] = (const float*)d_in[i];
    a.out = (float*)d_out; a.ws = (unsigned char*)d_ws; a.pad = 0;
    constexpr int NL = MK_CUTS;
    for (int li = 0; li < NL; ++li) {
        a.ph_lo = (NL == 1) ? 0 : li; a.ph_hi = (NL == 1) ? NPH : li + 1; a.use_bar = (NL == 1) ? 1 : 0;
        hipLaunchKernelGGL(mk_fwd, dim3(grid), dim3(NWAVES * 64), LDS_BYTES, stream, a);
    }
}
```

```cpp
#include <hip/hip_runtime.h>
#include <hip/hip_bf16.h>
#include <cstdio>
#include <cstdint>

namespace pg8 {
#define PG8_LAS __attribute__((address_space(3)))
typedef unsigned short bf16_t;
typedef short bf16x8 __attribute__((ext_vector_type(8)));
typedef float f32x4 __attribute__((ext_vector_type(4)));
typedef float f32x2 __attribute__((ext_vector_type(2)));
typedef unsigned u32x4 __attribute__((ext_vector_type(4)));
typedef unsigned u32x2 __attribute__((ext_vector_type(2)));
constexpr int BM = 256, BK = 64, HALF = 128, HTB = HALF * BK * 2  , STAGE_BYTES = 8 * HTB, NXCD = 8;

__host__ __device__ __forceinline__ int lds_byte(int r, int c) { const int st = (r >> 4) * 2 + (c >> 5), rr = r & 15, cc = c & 31, ob = rr * 64 + cc * 2; return st * 1024 + (ob ^ (((ob >> 9) & 1) << 5)); }
__host__ __device__ __forceinline__ void stage_rc(int b, int& R, int& C) { const int st = b / 1024, sb = b % 1024, swz = sb ^ (((sb >> 9) & 1) << 5); R = (st >> 1) * 16 + swz / 64; C = (st & 1) * 32 + (swz % 64) / 2; }
__host__ __device__ __forceinline__ int lds_byte8(int r, int cb) { const int st = (r >> 4) * 2 + (cb >> 6), ob = (r & 15) * 64 + (cb & 63); return st * 1024 + (ob ^ (((ob >> 9) & 1) << 4)); }
__host__ __device__ __forceinline__ void stage_rc8(int b, int& R, int& CB) { const int st = b / 1024, sb = b % 1024, swz = sb ^ (((sb >> 9) & 1) << 4); R = (st >> 1) * 16 + swz / 64; CB = (st & 1) * 64 + swz % 64; }
__host__ __device__ __forceinline__ int perm32(int rho) { const int n = rho >> 4, i = rho & 15; return 8 * (i >> 2) + 4 * n + (i & 3); }

struct Unit { int pm, pn; };
struct Gemm { const bf16_t* A; const bf16_t* Bt; int M, N, K, lda, ldb; };

template <int WGM> struct StaticOrderT {
    int nM, nN, nwg, G, c;
    __host__ __device__ void init(int M, int N, int G_, int c_) { nM = M / BM; nN = N / BM; nwg = nM * nN; G = G_; c = c_; }
    __host__ __device__ bool next(int i, Unit& u) const {
        const long L = (long)i * G + c; if (L >= nwg) return false;
        int wgid = (int)L; { const int q = nwg / NXCD, r = nwg % NXCD, xcd = wgid % NXCD, off = wgid / NXCD; wgid = (xcd < r ? xcd * (q + 1) : r * (q + 1) + (xcd - r) * q) + off; }
        const int nig = WGM * nN, gid = wgid / nig, fm = gid * WGM, gsz = (nM - fm) < WGM ? (nM - fm) : WGM;
        u.pm = fm + ((wgid % nig) % gsz); u.pn = (wgid % nig) / gsz; return true;
    }
    __device__ __forceinline__ void a_ready(const Unit&) const {}
    __device__ __forceinline__ void done(const Unit&) const {}
};
using StaticOrder = StaticOrderT<4>;

__device__ __forceinline__ unsigned cvt_pk_bf16(float lo, float hi) { unsigned r; asm volatile("v_cvt_pk_bf16_f32 %0, %1, %2" : "=v"(r) : "v"(lo), "v"(hi)); return r; }
__device__ __forceinline__ float bf_lo(unsigned w) { return __uint_as_float(w << 16); }
__device__ __forceinline__ float bf_hi(unsigned w) { return __uint_as_float(w & 0xffff0000u); }


typedef int v8i __attribute__((ext_vector_type(8)));
typedef int v4i __attribute__((ext_vector_type(4)));
typedef v8i v8i_a16 __attribute__((aligned(16)));
template <class Epi, class Sched, bool ALIGN_EPI = true, bool FP8 = false, int GV = 0>
__device__ __forceinline__ void gemm_phase(PG8_LAS unsigned char* lds, const Gemm g, const Sched& S, const Epi& E) {
    int tid_ = threadIdx.x; asm volatile("" : "+v"(tid_));
    const int tid = tid_, wid = __builtin_amdgcn_readfirstlane(tid >> 6), lane = tid & 63, wr = wid >> 2, wc = wid & 3, fr = lane & 15, fq = lane >> 4;
    const int K = g.K, nt = FP8 ? K / 128 : K / BK;
    unsigned voffA[2], voffB[2];
#pragma unroll
    for (int i = 0; i < 2; ++i) { int R, C; if constexpr (FP8) stage_rc8(tid * 16 + i * 8192, R, C); else stage_rc(tid * 16 + i * 8192, R, C); const int Rb = Epi::PERM ? ((R & ~31) + perm32(R & 31)) : R;
        voffA[i] = FP8 ? (unsigned)(R * g.lda + C) : (unsigned)(R * g.lda + C) * 2u; voffB[i] = FP8 ? (unsigned)(Rb * g.ldb + C) : (unsigned)(Rb * g.ldb + C) * 2u; }
    const size_t kstep = (size_t)(BK * 2);
    const size_t hstepA = (size_t)HALF * g.lda * (FP8 ? 1 : 2), hstepB = (size_t)HALF * g.ldb * (FP8 ? 1 : 2);
    const size_t tstepA = 2 * hstepA, tstepB = 2 * hstepB;
    const unsigned ldsw = (unsigned)wid * 1024u;
    const int aoff = FP8 ? lds_byte8(wr * 64 + fr, fq * 32) : lds_byte(wr * 64 + fr, fq * 8), boff = FP8 ? lds_byte8(wc * 32 + fr, fq * 32) : lds_byte(wc * 32 + fr, fq * 8);
    const int aoff2 = aoff ^ 16, boff2 = boff ^ 16;
#define PG8_SA(b, h) (((b) * 2 + (h)) * HTB)
#define PG8_SB(b, h) ((4 + (b) * 2 + (h)) * HTB)
#define PG8_STAGE(bufoff, gbase, voff) do { _Pragma("unroll") for (int _i = 0; _i < 2; ++_i) \
        __builtin_amdgcn_global_load_lds((const unsigned*)((const char*)(gbase) + (voff)[_i]), (PG8_LAS unsigned*)(lds + (bufoff) + ldsw + _i * 8192), 16, 0, 0); } while (0)
#define PG8_LDA(dst, b, h) do { if constexpr (FP8) { _Pragma("unroll") for (int m = 0; m < 4; ++m) { const bf16x8 lo_ = *(const PG8_LAS bf16x8*)(lds + PG8_SA(b, h) + aoff + m * 2048), hi_ = *(const PG8_LAS bf16x8*)(lds + PG8_SA(b, h) + aoff2 + m * 2048); \
            dst##8[m] = __builtin_shufflevector(__builtin_bit_cast(v4i, lo_), __builtin_bit_cast(v4i, hi_), 0, 1, 2, 3, 4, 5, 6, 7); } } \
        else { _Pragma("unroll") for (int m = 0; m < 4; ++m) _Pragma("unroll") for (int k = 0; k < 2; ++k) dst[m][k] = *(const PG8_LAS bf16x8*)(lds + PG8_SA(b, h) + aoff + m * 2048 + k * 1024); } } while (0)
#define PG8_LDB(dst, b, h) do { if constexpr (FP8) { _Pragma("unroll") for (int n = 0; n < 2; ++n) { const bf16x8 lo_ = *(const PG8_LAS bf16x8*)(lds + PG8_SB(b, h) + boff + n * 2048), hi_ = *(const PG8_LAS bf16x8*)(lds + PG8_SB(b, h) + boff2 + n * 2048); \
            dst##8[n] = __builtin_shufflevector(__builtin_bit_cast(v4i, lo_), __builtin_bit_cast(v4i, hi_), 0, 1, 2, 3, 4, 5, 6, 7); } } \
        else { _Pragma("unroll") for (int n = 0; n < 2; ++n) _Pragma("unroll") for (int k = 0; k < 2; ++k) dst[n][k] = *(const PG8_LAS bf16x8*)(lds + PG8_SB(b, h) + boff + n * 2048 + k * 1024); } } while (0)
#define PG8_V8(F) __builtin_shufflevector(__builtin_bit_cast(v4i, (F)[0]), __builtin_bit_cast(v4i, (F)[1]), 0, 1, 2, 3, 4, 5, 6, 7)
#define PG8_MMA(ai, bj, At, Bt) do { __builtin_amdgcn_s_setprio(1); _Pragma("unroll") for (int m = 0; m < 4; ++m) _Pragma("unroll") for (int n = 0; n < 2; ++n) { \
        if constexpr (FP8 && (GV & 1)) asm volatile("" : "+v"(acc[ai][bj][m][n]) : "v"(Bt##8[n]), "v"(At##8[m])); \
        else if constexpr (FP8) asm volatile("v_mfma_f32_16x16x128_f8f6f4 %0, %1, %2, %0" : "+v"(acc[ai][bj][m][n]) : "v"(Bt##8[n]), "v"(At##8[m])); \
        else { _Pragma("unroll") for (int k = 0; k < 2; ++k) acc[ai][bj][m][n] = __builtin_amdgcn_mfma_f32_16x16x32_bf16(Bt[n][k], At[m][k], acc[ai][bj][m][n], 0, 0, 0); } } \
        __builtin_amdgcn_s_setprio(0); } while (0)
#define PG8_WAIT_V(n) asm volatile("s_waitcnt vmcnt(" #n ")" ::: "memory")
#define PG8_WAIT_L(n) asm volatile("s_waitcnt lgkmcnt(" #n ")" ::: "memory")
#define PG8_BAR __builtin_amdgcn_s_barrier()
#define PG8_SCHED __builtin_amdgcn_sched_barrier(0)
    Unit cur, nxt; int ui = 0;
    if (!S.next(0, cur)) return;
    f32x4 acc[2][2][4][2];
#pragma unroll
    for (int a = 0; a < 2; ++a)
#pragma unroll
        for (int b = 0; b < 2; ++b)
#pragma unroll
            for (int m = 0; m < 4; ++m)
#pragma unroll
                for (int n = 0; n < 2; ++n) acc[a][b][m][n] = (f32x4){0.f, 0.f, 0.f, 0.f};
    bf16x8 At[4][2], B0[2][2], B1[2][2]; v8i At8[4], B08[2], B18[2];
    const char* cA = (const char*)g.A + (size_t)cur.pm * tstepA; const char* cB = (const char*)g.Bt + (size_t)cur.pn * tstepB;
    S.a_ready(cur);
    PG8_STAGE(PG8_SB(0, 0), cB, voffB); PG8_STAGE(PG8_SB(0, 1), cB + hstepB, voffB); PG8_STAGE(PG8_SA(0, 0), cA, voffA); PG8_STAGE(PG8_SA(0, 1), cA + hstepA, voffA);
    if (wr == 1) PG8_BAR;
    PG8_WAIT_V(2); PG8_BAR;
    PG8_STAGE(PG8_SB(1, 0), cB + kstep, voffB); PG8_STAGE(PG8_SA(1, 0), cA + kstep, voffA); PG8_STAGE(PG8_SB(1, 1), cB + hstepB + kstep, voffB);
    PG8_WAIT_V(6); PG8_BAR;
    for (;;) {
        const bool has_next = S.next(ui + 1, nxt);
        const char* nA = has_next ? (const char*)g.A + (size_t)nxt.pm * tstepA : cA; const char* nB = has_next ? (const char*)g.Bt + (size_t)nxt.pn * tstepB : cB;
        for (int t = 0; t < nt; t += 2) {
            const bool last = (t == nt - 2);
            const char* a1 = cA + (size_t)(t + 1) * kstep;
            const char* a2 = last ? nA : cA + (size_t)(t + 2) * kstep; const char* b2 = last ? nB : cB + (size_t)(t + 2) * kstep;
            const char* a3 = a2 + kstep; const char* b3 = b2 + kstep;
            if (last && has_next) S.a_ready(nxt);
            PG8_LDB(B0, 0, 0); PG8_LDB(B1, 0, 1); PG8_SCHED; PG8_LDA(At, 0, 0); PG8_STAGE(PG8_SA(1, 1), a1 + hstepA, voffA);
            PG8_WAIT_V(8); PG8_WAIT_L(0); PG8_BAR; PG8_MMA(0, 0, At, B0); PG8_MMA(0, 1, At, B1); PG8_BAR; PG8_SCHED;
            PG8_LDA(At, 0, 1); PG8_STAGE(PG8_SB(0, 0), b2, voffB); PG8_STAGE(PG8_SB(0, 1), b2 + hstepB, voffB); PG8_STAGE(PG8_SA(0, 0), a2, voffA);
            PG8_WAIT_V(8); PG8_WAIT_L(0); PG8_BAR; PG8_MMA(1, 0, At, B0); PG8_MMA(1, 1, At, B1); PG8_BAR; PG8_SCHED;
            PG8_LDB(B0, 1, 0); PG8_LDB(B1, 1, 1); PG8_SCHED; PG8_LDA(At, 1, 0); PG8_STAGE(PG8_SA(0, 1), a2 + hstepA, voffA);
            PG8_WAIT_V(8); PG8_WAIT_L(0); PG8_BAR; PG8_MMA(0, 0, At, B0); PG8_MMA(0, 1, At, B1); PG8_BAR; PG8_SCHED;
            PG8_LDA(At, 1, 1); PG8_STAGE(PG8_SB(1, 0), b3, voffB); PG8_STAGE(PG8_SB(1, 1), b3 + hstepB, voffB); PG8_STAGE(PG8_SA(1, 0), a3, voffA);
            PG8_WAIT_V(8); PG8_WAIT_L(0); PG8_BAR; PG8_MMA(1, 0, At, B0); PG8_MMA(1, 1, At, B1); PG8_BAR; PG8_SCHED;
        }
        if constexpr (ALIGN_EPI) { if (wr == 0) PG8_BAR; }
        if constexpr (FP8) asm volatile("s_nop 15\n\ts_nop 7" ::: "memory");
        { int l_ = threadIdx.x; asm volatile("" : "+v"(l_));
          if constexpr ((GV & 2) != 0) { asm volatile("" :: "v"(acc[0][0][0][0]), "v"(acc[1][1][3][1])); } else E(acc, cur, wr, wc, l_ & 15, (l_ >> 4) & 3); } S.done(cur);
        if (!has_next) break;
#pragma unroll
        for (int a = 0; a < 2; ++a)
#pragma unroll
            for (int b = 0; b < 2; ++b)
#pragma unroll
                for (int m = 0; m < 4; ++m)
#pragma unroll
                    for (int n = 0; n < 2; ++n) acc[a][b][m][n] = (f32x4){0.f, 0.f, 0.f, 0.f};
        cur = nxt; cA = nA; cB = nB; ++ui;
        if constexpr (ALIGN_EPI) { if (wr == 1) PG8_BAR; }
    }
    PG8_WAIT_V(0);
    if constexpr (!ALIGN_EPI) { if (wr == 0) PG8_BAR; }
    PG8_BAR;
#undef PG8_SA
#undef PG8_SB
#undef PG8_STAGE
#undef PG8_LDA
#undef PG8_LDB
#undef PG8_MMA
#undef PG8_V8
#undef PG8_WAIT_V
#undef PG8_WAIT_L
#undef PG8_BAR
#undef PG8_SCHED
}

__device__ __forceinline__ unsigned pk4_fp8(float a, float b, float c, float d) { int w = __builtin_amdgcn_cvt_pk_fp8_f32(a, b, 0, false); w = __builtin_amdgcn_cvt_pk_fp8_f32(c, d, w, true); return (unsigned)w; }
__device__ __forceinline__ float sigmoid256_fast(float x) { return __builtin_amdgcn_rcpf(0.00390625f + __builtin_amdgcn_exp2f(-1.4426950408889634f * x - 8.0f)); }
__device__ __forceinline__ float sigmoidf_fast(float x) { return __builtin_amdgcn_rcpf(1.0f + __builtin_amdgcn_exp2f(-1.4426950408889634f * x)); }

struct EpiIn {
    static constexpr bool PERM = true;
    unsigned char* wsb; size_t off_lat, off_na, na_stride, off_g; const float* bgate; float qscale; float ascale;
    __device__ __forceinline__ void operator()(const f32x4 (&acc)[2][2][4][2], const Unit& u, int wr, int wc, int fr, int fq) const {
        const int row0 = u.pm * BM + wr * 64 + fr; const int pn = u.pn;
        size_t boff; int ldc, colt; float sc = 1.f; bool gate = false;
        if (pn < 6) { boff = off_lat; ldc = 1536; colt = pn * 256; }
        else if (pn < 30) { const int t = (pn - 6) >> 3; boff = off_na + (size_t)t * na_stride; ldc = 2048; colt = ((pn - 6) & 7) * 256; if (t == 0) sc = qscale; }
        else { boff = off_g; ldc = 8192; colt = (pn - 30) * 256; gate = true; }
        bf16_t* base = (bf16_t*)(wsb + boff);
        const int col0 = colt + wc * 32 + 8 * fq;
        f32x4 bv[2][2];
#pragma unroll
        for (int bj = 0; bj < 2; ++bj)
#pragma unroll
            for (int n = 0; n < 2; ++n) bv[bj][n] = gate ? *(const f32x4*)(bgate + col0 + bj * HALF + 4 * n) : (f32x4){0.f, 0.f, 0.f, 0.f};
#pragma unroll
        for (int ai = 0; ai < 2; ++ai)
#pragma unroll
            for (int m = 0; m < 4; ++m) { bf16_t* rowp = base + (size_t)(row0 + ai * HALF + m * 16) * ldc + col0;
#pragma unroll
                for (int bj = 0; bj < 2; ++bj) { f32x4 v0 = acc[ai][bj][m][0] * ascale + bv[bj][0], v1 = acc[ai][bj][m][1] * ascale + bv[bj][1];
                    if (gate) {
#pragma unroll
                        for (int i = 0; i < 4; ++i) { v0[i] = sigmoid256_fast(v0[i]); v1[i] = sigmoid256_fast(v1[i]); }
                        u32x2 w; w.x = pk4_fp8(v0[0], v0[1], v0[2], v0[3]); w.y = pk4_fp8(v1[0], v1[1], v1[2], v1[3]);
                        *(u32x2*)(wsb + boff + (size_t)(row0 + ai * HALF + m * 16) * 8192 + col0 + bj * HALF) = w; }
                    else { v0 = v0 * sc; v1 = v1 * sc;
                        u32x4 w; w.x = cvt_pk_bf16(v0[0], v0[1]); w.y = cvt_pk_bf16(v0[2], v0[3]); w.z = cvt_pk_bf16(v1[0], v1[1]); w.w = cvt_pk_bf16(v1[2], v1[3]);
                        *(u32x4*)(rowp + bj * HALF) = w; } } }
    }
};

struct EpiQ {
    static constexpr bool PERM = false;
    bf16_t* Q; const float* rs; const float* rope; float qscale;
    __device__ __forceinline__ void operator()(const f32x4 (&acc)[2][2][4][2], const Unit& u, int wr, int wc, int fr, int fq) const {
#pragma unroll
        for (int ai = 0; ai < 2; ++ai)
#pragma unroll
            for (int m = 0; m < 4; ++m) {
                const int row = u.pm * BM + ai * HALF + wr * 64 + m * 16 + fr;
                const float rstd = rs[2 * row] * qscale;
                const int s = row & 8191, grow = s >> 6, gcol = s & 63;
#pragma unroll
                for (int bj = 0; bj < 2; ++bj) {
                    const int gg = 8 * u.pn + 4 * bj + wc, kind = gg % 6;
                    f32x4 v0 = acc[ai][bj][m][0] * rstd, v1 = acc[ai][bj][m][1] * rstd;
                    if (kind >= 4) {
                        const int pos = (kind == 4) ? grow : gcol;
                        const f32x4 t0 = *(const f32x4*)(rope + (size_t)(pos * 16 + 4 * fq) * 2), t1 = *(const f32x4*)(rope + (size_t)(pos * 16 + 4 * fq) * 2 + 4);
                        const float c0 = t0[0], s0 = t0[1], c1 = t0[2], s1 = t0[3], c2 = t1[0], s2 = t1[1], c3 = t1[2], s3 = t1[3];
                        f32x4 o0, o1;
                        o0[0] = v0[0] * c0 - v1[0] * s0; o1[0] = v0[0] * s0 + v1[0] * c0;
                        o0[1] = v0[1] * c1 - v1[1] * s1; o1[1] = v0[1] * s1 + v1[1] * c1;
                        o0[2] = v0[2] * c2 - v1[2] * s2; o1[2] = v0[2] * s2 + v1[2] * c2;
                        o0[3] = v0[3] * c3 - v1[3] * s3; o1[3] = v0[3] * s3 + v1[3] * c3;
                        v0 = o0; v1 = o1;
                    }
                    bf16_t* p = Q + (size_t)row * 3072 + u.pn * BM + bj * HALF + wc * 32 + 4 * fq;
                    u32x2 w0, w1; w0.x = cvt_pk_bf16(v0[0], v0[1]); w0.y = cvt_pk_bf16(v0[2], v0[3]); w1.x = cvt_pk_bf16(v1[0], v1[1]); w1.y = cvt_pk_bf16(v1[2], v1[3]);
                    *(u32x2*)p = w0; *(u32x2*)(p + 16) = w1;
                }
            }
    }
};

struct EpiKV {
    static constexpr bool PERM = true;
    bf16_t* Kn; bf16_t* Vm; const float* rs;
    __device__ __forceinline__ void operator()(const f32x4 (&acc)[2][2][4][2], const Unit& u, int wr, int wc, int fr, int fq) const {
        const int col0 = u.pn * HALF + wc * 32 + 8 * fq;
#pragma unroll
        for (int ai = 0; ai < 2; ++ai)
#pragma unroll
            for (int m = 0; m < 4; ++m) {
                const int row = u.pm * BM + ai * HALF + wr * 64 + m * 16 + fr;
                const float rstd = rs[2 * row + 1];
#pragma unroll
                for (int bj = 0; bj < 2; ++bj) { const f32x4 v0 = acc[ai][bj][m][0] * rstd, v1 = acc[ai][bj][m][1] * rstd;
                    u32x4 w; w.x = cvt_pk_bf16(v0[0], v0[1]); w.y = cvt_pk_bf16(v0[2], v0[3]); w.z = cvt_pk_bf16(v1[0], v1[1]); w.w = cvt_pk_bf16(v1[2], v1[3]);
                    *(u32x4*)((bj == 0 ? Kn : Vm) + (size_t)row * 2048 + col0) = w; }
            }
    }
};


struct EpiQ8 {
    static constexpr bool PERM = false;
    unsigned char* Q8; const float* rs; const float* rope; float qscale;
    __device__ __forceinline__ void operator()(const f32x4 (&acc)[2][2][4][2], const Unit& u, int wr, int wc, int fr, int fq) const {
        float rsv[8];
#pragma unroll
        for (int i = 0; i < 8; ++i) rsv[i] = rs[2 * (u.pm * BM + (i >> 2) * HALF + wr * 64 + (i & 3) * 16 + fr)];
#pragma unroll
        for (int ai = 0; ai < 2; ++ai)
#pragma unroll
            for (int m = 0; m < 4; ++m) {
                const int row = u.pm * BM + ai * HALF + wr * 64 + m * 16 + fr;
                const float rstd = rsv[4 * ai + m] * qscale;
                const int s = row & 8191, grow = s >> 6, gcol = s & 63;
#pragma unroll
                for (int bj = 0; bj < 2; ++bj) {
                    const int gg = 8 * u.pn + 4 * bj + wc, kind = gg % 6;
                    f32x4 v0 = acc[ai][bj][m][0] * rstd, v1 = acc[ai][bj][m][1] * rstd;
                    if (kind >= 4) {
                        const int pos = (kind == 4) ? grow : gcol;
                        const f32x4 t0 = *(const f32x4*)(rope + (size_t)(pos * 16 + 4 * fq) * 2), t1 = *(const f32x4*)(rope + (size_t)(pos * 16 + 4 * fq) * 2 + 4);
                        const float c0 = t0[0], s0 = t0[1], c1 = t0[2], s1 = t0[3], c2 = t1[0], s2 = t1[1], c3 = t1[2], s3 = t1[3];
                        f32x4 o0, o1;
                        o0[0] = v0[0] * c0 - v1[0] * s0; o1[0] = v0[0] * s0 + v1[0] * c0;
                        o0[1] = v0[1] * c1 - v1[1] * s1; o1[1] = v0[1] * s1 + v1[1] * c1;
                        o0[2] = v0[2] * c2 - v1[2] * s2; o1[2] = v0[2] * s2 + v1[2] * c2;
                        o0[3] = v0[3] * c3 - v1[3] * s3; o1[3] = v0[3] * s3 + v1[3] * c3;
                        v0 = o0; v1 = o1;
                    }
                    unsigned char* p = Q8 + (size_t)row * 3072 + u.pn * BM + bj * HALF + wc * 32 + 4 * fq;
                    *(unsigned*)p = pk4_fp8(v0[0], v0[1], v0[2], v0[3]); *(unsigned*)(p + 16) = pk4_fp8(v1[0], v1[1], v1[2], v1[3]);
                }
            }
    }
};
struct EpiKV8 {
    static constexpr bool PERM = true;
    unsigned char* K8; unsigned char* VT8; const float* rs;
    __device__ __forceinline__ void operator()(const f32x4 (&acc)[2][2][4][2], const Unit& u, int wr, int wc, int fr, int fq) const {
        const int c0 = wc * 32 + 8 * fq, h = u.pn;
        float rsv[8];
#pragma unroll
        for (int i = 0; i < 8; ++i) rsv[i] = rs[2 * (u.pm * BM + (i >> 2) * HALF + wr * 64 + (i & 3) * 16 + fr) + 1];
#pragma unroll
        for (int ai = 0; ai < 2; ++ai)
#pragma unroll
            for (int m = 0; m < 4; ++m) {
                const int row = u.pm * BM + ai * HALF + wr * 64 + m * 16 + fr;
                const float rstd = rsv[4 * ai + m];
                { const f32x4 v0 = acc[ai][0][m][0] * rstd, v1 = acc[ai][0][m][1] * rstd;
                  u32x2 w; w.x = pk4_fp8(v0[0], v0[1], v0[2], v0[3]); w.y = pk4_fp8(v1[0], v1[1], v1[2], v1[3]);
                  *(u32x2*)(K8 + ((size_t)row * 16 + h) * 192 + c0) = w; }
                { const f32x4 v0 = acc[ai][1][m][0] * rstd, v1 = acc[ai][1][m][1] * rstd;
                  const unsigned w0 = pk4_fp8(v0[0], v0[1], v0[2], v0[3]), w1 = pk4_fp8(v1[0], v1[1], v1[2], v1[3]);
                  unsigned char* vp = VT8 + ((size_t)((row >> 13) * 16 + h) * 128 + c0) * 8192 + (row & 8191);
                  vp[0] = (unsigned char)(w0 & 0xff); vp[8192] = (unsigned char)((w0 >> 8) & 0xff); vp[2 * 8192] = (unsigned char)((w0 >> 16) & 0xff); vp[3 * 8192] = (unsigned char)(w0 >> 24);
                  vp[4 * 8192] = (unsigned char)(w1 & 0xff); vp[5 * 8192] = (unsigned char)((w1 >> 8) & 0xff); vp[6 * 8192] = (unsigned char)((w1 >> 16) & 0xff); vp[7 * 8192] = (unsigned char)(w1 >> 24); }
            }
    }
};

template <bool FIRST> struct EpiGate {
    static constexpr bool PERM = true;
    const unsigned char* G8; unsigned char* Y8; unsigned char* M8; float ascale, yscale, oscale;
    __device__ __forceinline__ void operator()(const f32x4 (&acc)[2][2][4][2], const Unit& u, int wr, int wc, int fr, int fq) const {
        const int col0 = u.pn * BM + wc * 32 + 8 * fq;
        const int rowb = u.pm * BM + wr * 64 + fr;
        u32x2 gw[2][4], pw[2][4];
        const float iy = 1.0f / yscale;
#define EG_LOAD(B_, S_) _Pragma("unroll") for (int i_ = 0; i_ < 4; ++i_) { const int it_ = 4 * (B_) + i_, ai_ = it_ >> 3, m_ = (it_ >> 1) & 3, bj_ = it_ & 1; \
            const int row_ = rowb + ai_ * HALF + m_ * 16, col_ = col0 + bj_ * HALF; \
            gw[S_][i_] = *(const u32x2*)(G8 + (size_t)row_ * 8192 + (FIRST ? 0 : 4096) + col_); \
            if (!FIRST) pw[S_][i_] = *(const u32x2*)(Y8 + (size_t)row_ * 4096 + col_); }
#define EG_COMP(B_, S_) _Pragma("unroll") for (int i_ = 0; i_ < 4; ++i_) { const int it_ = 4 * (B_) + i_, ai_ = it_ >> 3, m_ = (it_ >> 1) & 3, bj_ = it_ & 1; \
            const int row_ = rowb + ai_ * HALF + m_ * 16, col_ = col0 + bj_ * HALF; const u32x2 g_ = gw[S_][i_]; \
            f32x4 v0 = acc[ai_][bj_][m_][0] * ascale, v1 = acc[ai_][bj_][m_][1] * ascale; \
            { const f32x2 a_ = __builtin_amdgcn_cvt_pk_f32_fp8((int)g_.x, false), b_ = __builtin_amdgcn_cvt_pk_f32_fp8((int)g_.x, true), c_ = __builtin_amdgcn_cvt_pk_f32_fp8((int)g_.y, false), d_ = __builtin_amdgcn_cvt_pk_f32_fp8((int)g_.y, true); \
              v0[0] *= a_.x; v0[1] *= a_.y; v0[2] *= b_.x; v0[3] *= b_.y; v1[0] *= c_.x; v1[1] *= c_.y; v1[2] *= d_.x; v1[3] *= d_.y; } \
            if constexpr (FIRST) { v0 = v0 * yscale; v1 = v1 * yscale; u32x2 w; w.x = pk4_fp8(v0[0], v0[1], v0[2], v0[3]); w.y = pk4_fp8(v1[0], v1[1], v1[2], v1[3]); \
                *(u32x2*)(Y8 + (size_t)row_ * 4096 + col_) = w; } \
            else { const u32x2 p_ = pw[S_][i_]; \
                { const f32x2 a_ = __builtin_amdgcn_cvt_pk_f32_fp8((int)p_.x, false), b_ = __builtin_amdgcn_cvt_pk_f32_fp8((int)p_.x, true), c_ = __builtin_amdgcn_cvt_pk_f32_fp8((int)p_.y, false), d_ = __builtin_amdgcn_cvt_pk_f32_fp8((int)p_.y, true); \
                  v0[0] += a_.x * iy; v0[1] += a_.y * iy; v0[2] += b_.x * iy; v0[3] += b_.y * iy; v1[0] += c_.x * iy; v1[1] += c_.y * iy; v1[2] += d_.x * iy; v1[3] += d_.y * iy; } \
                v0 = v0 * oscale; v1 = v1 * oscale; u32x2 w; w.x = pk4_fp8(v0[0], v0[1], v0[2], v0[3]); w.y = pk4_fp8(v1[0], v1[1], v1[2], v1[3]); \
                *(u32x2*)(M8 + (size_t)row_ * 4096 + col_) = w; } }
        EG_LOAD(0, 0) EG_LOAD(1, 1)
        EG_COMP(0, 0) EG_LOAD(2, 0)
        EG_COMP(1, 1) EG_LOAD(3, 1)
        EG_COMP(2, 0)
        EG_COMP(3, 1)
#undef EG_LOAD
#undef EG_COMP
    }
};

template <bool BASE> struct EpiF32T {
    static constexpr bool PERM = false;
    const float* base; float* out; int ldc; float ascale;
    __device__ __forceinline__ void operator()(const f32x4 (&acc)[2][2][4][2], const Unit& u, int wr, int wc, int fr, int fq) const {
        const int col0 = u.pn * BM + wc * 32 + 4 * fq;
        const size_t off0 = (size_t)(u.pm * BM + wr * 64 + fr) * ldc + col0;
        f32x4 bv[2][8];
#define EF_OFF(it_) (off0 + (size_t)((((it_) >> 4) & 1) * HALF + (((it_) >> 2) & 3) * 16) * ldc + (((it_) >> 1) & 1) * HALF + ((it_) & 1) * 16)
#define EF_LOAD(B_, S_) if constexpr (BASE) { _Pragma("unroll") for (int i_ = 0; i_ < 8; ++i_) { const int it_ = 8 * (B_) + i_; bv[S_][i_] = *(const f32x4*)(base + EF_OFF(it_)); } }
#define EF_COMP(B_, S_) _Pragma("unroll") for (int i_ = 0; i_ < 8; ++i_) { const int it_ = 8 * (B_) + i_; f32x4 o = acc[(it_ >> 4) & 1][(it_ >> 1) & 1][(it_ >> 2) & 3][it_ & 1] * ascale; \
            if constexpr (BASE) o = o + bv[S_][i_]; *(f32x4*)(out + EF_OFF(it_)) = o; }
        EF_LOAD(0, 0) EF_LOAD(1, 1)
        EF_COMP(0, 0) EF_LOAD(2, 0)
        EF_COMP(1, 1) EF_LOAD(3, 1)
        EF_COMP(2, 0)
        EF_COMP(3, 1)
#undef EF_OFF
#undef EF_LOAD
#undef EF_COMP
    }
};
struct EpiX1 {
    static constexpr bool PERM = true;
    const float* x; bf16_t* X1; float ascale;
    __device__ __forceinline__ void operator()(const f32x4 (&acc)[2][2][4][2], const Unit& u, int wr, int wc, int fr, int fq) const {
        const int col0 = u.pn * BM + wc * 32 + 8 * fq;
        const int rowb = u.pm * BM + wr * 64 + fr;
        f32x4 bv[2][4][2];
#define EX_LOAD(B_, S_) _Pragma("unroll") for (int i_ = 0; i_ < 4; ++i_) { const int it_ = 4 * (B_) + i_, ai_ = it_ >> 3, m_ = (it_ >> 1) & 3, bj_ = it_ & 1; \
            const float* p_ = x + (size_t)(rowb + ai_ * HALF + m_ * 16) * 4096 + col0 + bj_ * HALF; bv[S_][i_][0] = *(const f32x4*)p_; bv[S_][i_][1] = *(const f32x4*)(p_ + 4); }
#define EX_COMP(B_, S_) _Pragma("unroll") for (int i_ = 0; i_ < 4; ++i_) { const int it_ = 4 * (B_) + i_, ai_ = it_ >> 3, m_ = (it_ >> 1) & 3, bj_ = it_ & 1; \
            const f32x4 v0 = acc[ai_][bj_][m_][0] * ascale + bv[S_][i_][0], v1 = acc[ai_][bj_][m_][1] * ascale + bv[S_][i_][1]; \
            u32x4 w; w.x = cvt_pk_bf16(v0[0], v0[1]); w.y = cvt_pk_bf16(v0[2], v0[3]); w.z = cvt_pk_bf16(v1[0], v1[1]); w.w = cvt_pk_bf16(v1[2], v1[3]); \
            *(u32x4*)(X1 + (size_t)(rowb + ai_ * HALF + m_ * 16) * 4096 + col0 + bj_ * HALF) = w; }
        EX_LOAD(0, 0) EX_LOAD(1, 1)
        EX_COMP(0, 0) EX_LOAD(2, 0)
        EX_COMP(1, 1) EX_LOAD(3, 1)
        EX_COMP(2, 0)
        EX_COMP(3, 1)
#undef EX_LOAD
#undef EX_COMP
    }
};
}

namespace att {
using bf16x8 = __attribute__((ext_vector_type(8))) short;
using s16x4  = __attribute__((ext_vector_type(4))) short;
using f32x16 = __attribute__((ext_vector_type(16))) float;
using u32x4  = __attribute__((ext_vector_type(4))) unsigned;
typedef unsigned short bf16_t;
constexpr int NW = 8, QBLK = 32, KVBLK = 64, SEQ = 8192, NHEAD = 16;
constexpr int SHM_V = KVBLK * 128 * 2, SHM_KN = KVBLK * 128 * 2, SHM_KR = KVBLK * 64 * 2;
constexpr int OFF_V = 0, OFF_KN = 2 * SHM_V, OFF_KR = OFF_KN + 2 * SHM_KN, OFF_WS = OFF_KR + 2 * SHM_KR, OFF_BIAS = OFF_WS + NW * 64 * 4, OFF_QR = OFF_BIAS + 2048, ATT_LDS_BYTES = OFF_QR + NW * 4096;
#define KSWZ(row, colB) ((row) * 256 + ((colB) ^ (((row) & 7) << 4)))
#define KRSWZ(row, chunk) ((row) * 128 + ((((chunk) ^ (((row) >> 1) & 7))) << 4))
#define ASBAR() __builtin_amdgcn_sched_barrier(0)
__device__ __forceinline__ int crow(int r, int hi) { return (r & 3) + 8 * (r >> 2) + 4 * hi; }
__device__ __forceinline__ unsigned cvtpk(float lo, float hi) { unsigned r; asm volatile("v_cvt_pk_bf16_f32 %0, %1, %2" : "=v"(r) : "v"(lo), "v"(hi)); return r; }
__device__ __forceinline__ bf16x8 ld8(const bf16_t* p) { return *reinterpret_cast<const bf16x8*>(p); }

constexpr float THR2 = 11.5f;
__device__ __forceinline__ void partialSM(f32x16& p0, f32x16& p1, float& m_reg, float& mn, float& alpha) {
  float pmax = p0[0];
#pragma unroll
  for (int r = 1; r < 16; ++r) pmax = fmaxf(pmax, p0[r]);
#pragma unroll
  for (int r = 0; r < 16; ++r) pmax = fmaxf(pmax, p1[r]);
  { auto rr = __builtin_amdgcn_permlane32_swap(__float_as_uint(pmax), __float_as_uint(pmax), false, false);
    pmax = fmaxf(__uint_as_float(rr[0]), __uint_as_float(rr[1])); }
  if (__builtin_expect(__all(pmax - m_reg <= THR2), 1)) { mn = m_reg; alpha = 1.f; }
  else { mn = fmaxf(m_reg, pmax); alpha = __builtin_amdgcn_exp2f(m_reg - mn); m_reg = mn; }
#pragma unroll
  for (int r = 0; r < 16; ++r) p0[r] = p0[r] - mn;
#pragma unroll
  for (int r = 0; r < 16; ++r) p1[r] = p1[r] - mn;
#pragma unroll
  for (int r = 0; r < 16; ++r) p0[r] = __builtin_amdgcn_exp2f(p0[r]);
}
__device__ __forceinline__ void finishSM(f32x16& p0, f32x16& p1, float alpha, float& l_reg, bf16x8& pa0, bf16x8& pa1, bf16x8& pa2, bf16x8& pa3) {
#pragma unroll
  for (int r = 0; r < 16; ++r) p1[r] = __builtin_amdgcn_exp2f(p1[r]);
  float ps = 0;
#pragma unroll
  for (int r = 0; r < 16; ++r) ps += p0[r];
#pragma unroll
  for (int r = 0; r < 16; ++r) ps += p1[r];
  { auto rr = __builtin_amdgcn_permlane32_swap(__float_as_uint(ps), __float_as_uint(ps), false, false);
    ps = __uint_as_float(rr[0]) + __uint_as_float(rr[1]); }
  l_reg = l_reg * alpha + ps;
#define PK4(P, BASE, OUT) do { unsigned a0 = cvtpk(P[BASE + 0], P[BASE + 1]), a1 = cvtpk(P[BASE + 2], P[BASE + 3]);   \
    unsigned b0 = cvtpk(P[BASE + 4], P[BASE + 5]), b1 = cvtpk(P[BASE + 6], P[BASE + 7]);                              \
    auto r0 = __builtin_amdgcn_permlane32_swap(a0, b0, false, false); auto r1 = __builtin_amdgcn_permlane32_swap(a1, b1, false, false); \
    u32x4 w = {r0[0], r1[0], r0[1], r1[1]}; OUT = *reinterpret_cast<bf16x8*>(&w); } while (0)
  PK4(p0, 0, pa0); PK4(p0, 8, pa1); PK4(p1, 0, pa2); PK4(p1, 8, pa3);
}
__device__ __forceinline__ int v_st(int k, int c) { const int kk = (k & ~0xC) | ((k & 4) << 1) | ((k & 8) >> 1); return ((kk >> 3) * 4 + (c >> 5)) * 512 + ((kk & 7) * 32 + (c & 31)) * 2; }
__device__ __forceinline__ int v_rd_base(int lane) { return ((lane & 3) << 3) | (((lane >> 2) & 3) << 6) | (((lane >> 4) & 1) << 5) | (((lane >> 5) & 1) << 8); }
constexpr int v_rd_off(int d0, int ks, int half) { return d0 * 512 + ks * 4096 + half * 2048; }
template <int OFF> __device__ __forceinline__ s16x4 tr_read(int vb) {
  s16x4 r; asm volatile("ds_read_b64_tr_b16 %0, %1 offset:%2" : "=&v"(r) : "v"(vb), "i"(OFF) : "memory"); return r;
}
template <int D0> __device__ __forceinline__ void pv_one(f32x16& od, int vb, bf16x8 pa0, bf16x8 pa1, bf16x8 pa2, bf16x8 pa3) {
  const s16x4 l0 = tr_read<v_rd_off(D0, 0, 0)>(vb), h0 = tr_read<v_rd_off(D0, 0, 1)>(vb), l1 = tr_read<v_rd_off(D0, 1, 0)>(vb), h1 = tr_read<v_rd_off(D0, 1, 1)>(vb);
  const s16x4 l2 = tr_read<v_rd_off(D0, 2, 0)>(vb), h2 = tr_read<v_rd_off(D0, 2, 1)>(vb), l3 = tr_read<v_rd_off(D0, 3, 0)>(vb), h3 = tr_read<v_rd_off(D0, 3, 1)>(vb);
  asm volatile("s_waitcnt lgkmcnt(0)" ::: "memory"); ASBAR();
#define PKV(L, H) (bf16x8){L[0], L[1], L[2], L[3], H[0], H[1], H[2], H[3]}
  od = __builtin_amdgcn_mfma_f32_32x32x16_bf16(pa0, PKV(l0, h0), od, 0, 0, 0);
  od = __builtin_amdgcn_mfma_f32_32x32x16_bf16(pa1, PKV(l1, h1), od, 0, 0, 0);
  od = __builtin_amdgcn_mfma_f32_32x32x16_bf16(pa2, PKV(l2, h2), od, 0, 0, 0);
  od = __builtin_amdgcn_mfma_f32_32x32x16_bf16(pa3, PKV(l3, h3), od, 0, 0, 0);
#undef PKV
}
__device__ __forceinline__ void pv_d0(f32x16* o, int vb, bf16x8 pa0, bf16x8 pa1, bf16x8 pa2, bf16x8 pa3) {
  pv_one<0>(o[0], vb, pa0, pa1, pa2, pa3); pv_one<1>(o[1], vb, pa0, pa1, pa2, pa3); pv_one<2>(o[2], vb, pa0, pa1, pa2, pa3); pv_one<3>(o[3], vb, pa0, pa1, pa2, pa3);
}
template <int NROPE> __device__ __forceinline__ void qkt(f32x16& p0, f32x16& p1, const char* Kn, const char* Kr, const bf16x8* qr, const char* qrl, int r32, int hi) {
  p0 = f32x16{}; p1 = f32x16{};
#pragma unroll
  for (int d0 = 0; d0 < 8; ++d0) { const int cb = (d0 * 16 + hi * 8) * 2;
    const bf16x8 b0 = *reinterpret_cast<const bf16x8*>(Kn + KSWZ(r32, cb));
    const bf16x8 b1 = *reinterpret_cast<const bf16x8*>(Kn + KSWZ(32 + r32, cb));
    p0 = __builtin_amdgcn_mfma_f32_32x32x16_bf16(b0, qr[d0], p0, 0, 0, 0);
    p1 = __builtin_amdgcn_mfma_f32_32x32x16_bf16(b1, qr[d0], p1, 0, 0, 0); }
#pragma unroll
  for (int d0 = 0; d0 < NROPE; ++d0) { const int ch = d0 * 2 + hi;
    const bf16x8 b0 = *reinterpret_cast<const bf16x8*>(Kr + KRSWZ(r32, ch));
    const bf16x8 b1 = *reinterpret_cast<const bf16x8*>(Kr + KRSWZ(32 + r32, ch));
    const bf16x8 qf = *reinterpret_cast<const bf16x8*>(qrl + d0 * 1024);
    p0 = __builtin_amdgcn_mfma_f32_32x32x16_bf16(b0, qf, p0, 0, 0, 0);
    p1 = __builtin_amdgcn_mfma_f32_32x32x16_bf16(b1, qf, p1, 0, 0, 0); }
}

__device__ __forceinline__ void mla_unit(int b, int h, int qb, const bf16_t* __restrict__ Q, const bf16_t* __restrict__ KN, const bf16_t* __restrict__ KR, const bf16_t* __restrict__ VM, unsigned char* __restrict__ O, float oscale, char* lds) {
  int tid_ = threadIdx.x; asm volatile("" : "+v"(tid_));
  const int tid = tid_, wid = tid >> 6, lane = tid & 63, r32 = lane & 31, hi = lane >> 5;
  char* V_lds = lds + OFF_V; char* Kn_lds = lds + OFF_KN; char* Kr_lds = lds + OFF_KR;
  float* ws = (float*)(lds + OFF_WS) + wid * 64; float* li_l = ws; float* al_l = ws + 32;
  float m_reg = -1e30f, l_reg = 0; f32x16 o[4] = {}; bf16x8 qr[8];
  char* qrl = lds + OFF_QR + wid * 4096 + (hi * 32 + r32) * 16;
  const long rowbase = (long)b * SEQ;
  const bf16_t* Qw = Q + (rowbase + qb * 256 + wid * QBLK + r32) * 3072 + h * 192 + hi * 8;
#pragma unroll
  for (int d0 = 0; d0 < 8; ++d0) qr[d0] = ld8(Qw + d0 * 16);
  const bf16_t* Kh = KN + rowbase * 2048 + h * 128; const bf16_t* Vh = VM + rowbase * 2048 + h * 128; const bf16_t* Krb = KR + rowbase * 64;
  const int sr = tid >> 4, sc = (tid & 15) * 8, vst0 = v_st(sr, sc), vst1 = v_st(32 + sr, sc);
  const int krr = tid >> 3, krc = tid & 7;
  const int vb0 = (int)(uintptr_t)V_lds + v_rd_base(lane);
  struct { bf16x8 vs0, vs1, ks0, ks1, kr0; } sr_[1];
#define SLOAD(i, k0) do { sr_[i].vs0 = ld8(&Vh[(long)((k0) + sr) * 2048 + sc]); sr_[i].vs1 = ld8(&Vh[(long)((k0) + 32 + sr) * 2048 + sc]); \
    sr_[i].ks0 = ld8(&Kh[(long)((k0) + sr) * 2048 + sc]); sr_[i].ks1 = ld8(&Kh[(long)((k0) + 32 + sr) * 2048 + sc]); sr_[i].kr0 = ld8(&Krb[(long)((k0) + krr) * 64 + krc * 8]); } while (0)
#define SWRITE(bb, i) do { *(bf16x8*)(V_lds + (bb) * SHM_V + vst0) = sr_[i].vs0; *(bf16x8*)(V_lds + (bb) * SHM_V + vst1) = sr_[i].vs1; const int kc = sc * 2; \
    *(bf16x8*)(Kn_lds + (bb) * SHM_KN + KSWZ(sr, kc)) = sr_[i].ks0; *(bf16x8*)(Kn_lds + (bb) * SHM_KN + KSWZ(32 + sr, kc)) = sr_[i].ks1; \
    *(bf16x8*)(Kr_lds + (bb) * SHM_KR + KRSWZ(krr, krc)) = sr_[i].kr0; } while (0)
#define SWAIT() asm volatile("s_waitcnt vmcnt(0)" ::: "memory")
#define RESC(a) do { if (__any((a) < 1.f)) { if (hi == 0) al_l[r32] = (a); asm volatile("s_waitcnt lgkmcnt(0)" ::: "memory"); \
    _Pragma("unroll") for (int d = 0; d < 4; ++d) _Pragma("unroll") for (int r = 0; r < 16; ++r) o[d][r] *= al_l[crow(r, hi)]; } } while (0)
  f32x16 pA0, pA1, pB0, pB1; float mnA, mnB, alA, alB; bf16x8 pa0, pa1, pa2, pa3; const int NT = SEQ / KVBLK;
  constexpr int SE = 0, SO = 0;
  __syncthreads();
#pragma unroll
  for (int d0 = 0; d0 < 4; ++d0) *(bf16x8*)(qrl + d0 * 1024) = ld8(Qw + (8 + d0) * 16);
  SLOAD(SE, 0); asm volatile("s_waitcnt vmcnt(0)" ::: "memory"); SWRITE(0, SE); __syncthreads();
  qkt<4>(pA0, pA1, Kn_lds, Kr_lds, qr, qrl, r32, hi); partialSM(pA0, pA1, m_reg, mnA, alA);
  SLOAD(SO, KVBLK);
  SWAIT(); SWRITE(1, SO); __syncthreads();
  for (int j = 1; j + 1 < NT; j += 2) {
    ASBAR(); qkt<4>(pB0, pB1, Kn_lds + SHM_KN, Kr_lds + SHM_KR, qr, qrl, r32, hi);
    finishSM(pA0, pA1, alA, l_reg, pa0, pa1, pa2, pa3); ASBAR();
    SLOAD(SE, (j + 1) * KVBLK); ASBAR();
    pv_d0(o, vb0, pa0, pa1, pa2, pa3); partialSM(pB0, pB1, m_reg, mnB, alB);
    __syncthreads(); SWAIT(); SWRITE(0, SE);
    RESC(alB); __syncthreads();
    ASBAR(); qkt<4>(pA0, pA1, Kn_lds, Kr_lds, qr, qrl, r32, hi);
    finishSM(pB0, pB1, alB, l_reg, pa0, pa1, pa2, pa3); ASBAR();
    SLOAD(SO, (j + 2) * KVBLK); ASBAR();
    pv_d0(o, vb0 + SHM_V, pa0, pa1, pa2, pa3); partialSM(pA0, pA1, m_reg, mnA, alA);
    __syncthreads(); SWAIT(); SWRITE(1, SO);
    RESC(alA); __syncthreads();
  }
  ASBAR(); qkt<4>(pB0, pB1, Kn_lds + SHM_KN, Kr_lds + SHM_KR, qr, qrl, r32, hi);
  finishSM(pA0, pA1, alA, l_reg, pa0, pa1, pa2, pa3); ASBAR();
  pv_d0(o, vb0, pa0, pa1, pa2, pa3); partialSM(pB0, pB1, m_reg, mnB, alB);
  __syncthreads(); RESC(alB);
  finishSM(pB0, pB1, alB, l_reg, pa0, pa1, pa2, pa3); ASBAR();
  pv_d0(o, vb0 + SHM_V, pa0, pa1, pa2, pa3);
  if (hi == 0) li_l[r32] = l_reg; asm volatile("s_waitcnt lgkmcnt(0)" ::: "memory");
  float rli[16];
#pragma unroll
  for (int r = 0; r < 16; ++r) rli[r] = __builtin_amdgcn_rcpf(li_l[crow(r, hi)]) * oscale;
  unsigned char* Ow = O + (rowbase + qb * 256 + wid * QBLK) * 2048 + h * 128;
#pragma unroll
  for (int r = 0; r < 16; ++r) { const int orow = crow(r, hi);
#pragma unroll
    for (int d0 = 0; d0 < 4; ++d0) Ow[(long)orow * 2048 + d0 * 32 + r32] = (unsigned char)(__builtin_amdgcn_cvt_pk_fp8_f32(o[d0][r] * rli[r], 0.f, 0, false) & 0xff); }
#undef SLOAD
#undef SWRITE
#undef SWAIT
#undef RESC
}

template <int NVAR = 0> __device__ __forceinline__ void na_unit(int b, int h, int rg, const bf16_t* __restrict__ Q, const bf16_t* __restrict__ K, const bf16_t* __restrict__ V, const float* __restrict__ rpb, unsigned char* __restrict__ O, float oscale, char* lds) {
  int tid_ = threadIdx.x; asm volatile("" : "+v"(tid_));
  const int tid = tid_, wid = tid >> 6, lane = tid & 63, r32 = lane & 31, hi = lane >> 5;
  char* V_lds = lds + OFF_V; char* Kn_lds = lds + OFF_KN;
  float* ws = (float*)(lds + OFF_WS) + wid * 64; float* li_l = ws; float* al_l = ws + 32;
  float* bias_l = (float*)(lds + OFF_BIAS);
  const int r0 = rg * 4, rq = r0 + (wid >> 1), cq = 32 * (wid & 1) + r32;
  const int rs_w = min(max(rq - 4, 0), 120), cs = min(max(cq - 8, 0), 48);
  const int kr_lo = min(max(r0 - 4, 0), 120), kr_hi = min(max(r0 + 3 - 4, 0), 120) + 7, NT = kr_hi - kr_lo + 1;
  const long rowbase = (long)b * SEQ;
  float m_reg = -1e30f, l_reg = 0; f32x16 o[4] = {}; bf16x8 qr[8];
  const bf16_t* Qw = Q + (rowbase + rq * 64 + cq) * 2048 + h * 128 + hi * 8;
#pragma unroll
  for (int d0 = 0; d0 < 8; ++d0) qr[d0] = ld8(Qw + d0 * 16);
  const bf16_t* Kh = K + rowbase * 2048 + h * 128; const bf16_t* Vh = V + rowbase * 2048 + h * 128;
  const int sr = tid >> 4, sc = (tid & 15) * 8, vst0 = v_st(sr, sc), vst1 = v_st(32 + sr, sc);
  const int vb0 = (int)(uintptr_t)V_lds + v_rd_base(lane);
  __syncthreads();
  if (tid < 465) bias_l[tid] = rpb[h * 465 + tid] * 1.4426950408889634f;
  bf16x8 vsA0, vsA1, ksA0, ksA1, vsB0, vsB1, ksB0, ksB1;
#define NLOAD(S, k0) do { vs##S##0 = ld8(&Vh[(long)((k0) + sr) * 2048 + sc]); vs##S##1 = ld8(&Vh[(long)((k0) + 32 + sr) * 2048 + sc]); \
    ks##S##0 = ld8(&Kh[(long)((k0) + sr) * 2048 + sc]); ks##S##1 = ld8(&Kh[(long)((k0) + 32 + sr) * 2048 + sc]); } while (0)
#define NWRITE(S, bb) do { *(bf16x8*)(V_lds + (bb) * SHM_V + vst0) = vs##S##0; *(bf16x8*)(V_lds + (bb) * SHM_V + vst1) = vs##S##1; const int kc = sc * 2; \
    *(bf16x8*)(Kn_lds + (bb) * SHM_KN + KSWZ(sr, kc)) = ks##S##0; *(bf16x8*)(Kn_lds + (bb) * SHM_KN + KSWZ(32 + sr, kc)) = ks##S##1; } while (0)
#define NCOMPUTE(bb, kr) do { if (!(NVAR & 1) && (kr) >= rs_w && (kr) < rs_w + 8) { \
      f32x16 p0, p1; \
      qkt<0>(p0, p1, Kn_lds + (bb) * SHM_KN, nullptr, qr, nullptr, r32, hi); \
      const float* brow = bias_l + ((kr) - rq + 7) * 31 + 15 - cq; \
      float pmax = -1e30f; \
      _Pragma("unroll") for (int r = 0; r < 16; ++r) { const int k0 = crow(r, hi), k1 = 32 + k0; \
        const bool v0 = (k0 >= cs) && (k0 < cs + 16), v1 = (k1 >= cs) && (k1 < cs + 16); \
        const float b0 = brow[v0 ? k0 : cq], b1 = brow[v1 ? k1 : cq]; \
        p0[r] = v0 ? p0[r] + b0 : -1e30f; p1[r] = v1 ? p1[r] + b1 : -1e30f; \
        pmax = fmaxf(pmax, fmaxf(p0[r], p1[r])); } \
      { auto rr = __builtin_amdgcn_permlane32_swap(__float_as_uint(pmax), __float_as_uint(pmax), false, false); \
        pmax = fmaxf(__uint_as_float(rr[0]), __uint_as_float(rr[1])); } \
      const float mn = fmaxf(m_reg, pmax), alpha = __builtin_amdgcn_exp2f(m_reg - mn); m_reg = mn; \
      _Pragma("unroll") for (int r = 0; r < 16; ++r) { p0[r] = __builtin_amdgcn_exp2f(p0[r] - mn); p1[r] = __builtin_amdgcn_exp2f(p1[r] - mn); } \
      float ps = 0; \
      _Pragma("unroll") for (int r = 0; r < 16; ++r) ps += p0[r] + p1[r]; \
      { auto rr = __builtin_amdgcn_permlane32_swap(__float_as_uint(ps), __float_as_uint(ps), false, false); \
        ps = __uint_as_float(rr[0]) + __uint_as_float(rr[1]); } \
      l_reg = l_reg * alpha + ps; \
      if (__any(alpha < 1.f)) { if (hi == 0) al_l[r32] = alpha; asm volatile("s_waitcnt lgkmcnt(0)" ::: "memory"); \
        _Pragma("unroll") for (int d = 0; d < 4; ++d) _Pragma("unroll") for (int r = 0; r < 16; ++r) o[d][r] *= al_l[crow(r, hi)]; } \
      bf16x8 pa0, pa1, pa2, pa3; \
      PK4(p0, 0, pa0); PK4(p0, 8, pa1); PK4(p1, 0, pa2); PK4(p1, 8, pa3); \
      pv_d0(o, vb0 + (bb) * SHM_V, pa0, pa1, pa2, pa3); } } while (0)
  NLOAD(A, kr_lo * 64); if (NT > 1) NLOAD(B, (kr_lo + 1) * 64);
#pragma unroll 1
  for (int i = 0; i < NT; i += 2) {
    const int kr = kr_lo + i;
    NWRITE(A, 0);
    if (i + 2 < NT) NLOAD(A, (kr + 2) * 64);
    __syncthreads();
    NCOMPUTE(0, kr);
    if (i + 1 < NT) {
      NWRITE(B, 1);
      if (i + 3 < NT) NLOAD(B, (kr + 3) * 64);
      __syncthreads();
      NCOMPUTE(1, kr + 1);
    }
  }
#undef NCOMPUTE
  if (hi == 0) li_l[r32] = l_reg; asm volatile("s_waitcnt lgkmcnt(0)" ::: "memory");
  float rli[16];
#pragma unroll
  for (int r = 0; r < 16; ++r) rli[r] = __builtin_amdgcn_rcpf(li_l[crow(r, hi)]) * oscale;
  unsigned char* Ow = O + (rowbase + rq * 64 + 32 * (wid & 1)) * 2048 + h * 128;
#pragma unroll
  for (int r = 0; r < 16; ++r) { const int orow = crow(r, hi);
#pragma unroll
    for (int d0 = 0; d0 < 4; ++d0) Ow[(long)orow * 2048 + d0 * 32 + r32] = (unsigned char)(__builtin_amdgcn_cvt_pk_fp8_f32(o[d0][r] * rli[r], 0.f, 0, false) & 0xff); }
#undef NLOAD
#undef NWRITE
}
#undef PK4
}

namespace att8 {
using f32x16 = __attribute__((ext_vector_type(16))) float;
using u32x4  = __attribute__((ext_vector_type(4))) unsigned;
using v8i    = __attribute__((ext_vector_type(8))) int;
using v4i    = __attribute__((ext_vector_type(4))) int;
constexpr int SEQ = 8192, KVBLK = 64, KT_BYTES = 12288, VT_BYTES = 8192, NSLOT = 5;
constexpr int OFF_K = 0, OFF_V = NSLOT * KT_BYTES, OFF_WS = OFF_V + NSLOT * VT_BYTES, LDS_BYTES = OFF_WS + 2048;
constexpr float SQ8 = 1.0f;
constexpr float PSH = 6.0f;
constexpr float THR8 = 2.0f;
__device__ __forceinline__ int crow(int r, int hi) { return (r & 3) + 8 * (r >> 2) + 4 * hi; }
__device__ __forceinline__ void glds16(const void* gsrc, unsigned lds_dst) { unsigned keep;
  asm volatile("s_mov_b32 %0, m0\n\ts_mov_b32 m0, %2\n\ts_nop 0\n\tglobal_load_lds_dwordx4 %1, off\n\ts_mov_b32 m0, %0" : "=&s"(keep) : "v"(gsrc), "s"(lds_dst) : "memory"); }
template <bool ON = true> __device__ __forceinline__ void mfma64(f32x16& acc, const v8i& a, const v8i& b) { if constexpr (!ON) { asm volatile("" : "+v"(acc) : "v"(a), "v"(b)); return; } asm volatile("s_nop 3\n\tv_mfma_f32_32x32x64_f8f6f4 %0, %1, %2, %0" : "+v"(acc) : "v"(a), "v"(b)); }
template <bool ON = true> __device__ __forceinline__ void mfma64z(f32x16& acc, const v8i& a, const v8i& b) { if constexpr (!ON) { acc = f32x16{}; asm volatile("" : "+v"(acc) : "v"(a), "v"(b)); return; } asm volatile("s_nop 3\n\tv_mfma_f32_32x32x64_f8f6f4 %0, %1, %2, 0" : "=v"(acc) : "v"(a), "v"(b)); }
template <bool ON = true> __device__ __forceinline__ void mfma64c(f32x16& acc, const v8i& a, const v8i& b, const f32x16& cin) { if constexpr (!ON) { acc = cin; asm volatile("" : "+v"(acc) : "v"(a), "v"(b)); return; } asm volatile("s_nop 3\n\tv_mfma_f32_32x32x64_f8f6f4 %0, %1, %2, %3" : "=&v"(acc) : "v"(a), "v"(b), "v"(cin)); }
#define MFMA_DRAIN2(X, Y) asm volatile("s_nop 15\n\ts_nop 7" : "+v"(X), "+v"(Y))
#define MFMA_DRAIN4(A, B, C_, D) asm volatile("s_nop 15\n\ts_nop 7" : "+v"(A), "+v"(B), "+v"(C_), "+v"(D))
__device__ __forceinline__ v8i ld32(const char* p0, const char* p1) { const v4i a = *reinterpret_cast<const v4i*>(p0), b = *reinterpret_cast<const v4i*>(p1); return __builtin_shufflevector(a, b, 0, 1, 2, 3, 4, 5, 6, 7); }
__device__ __forceinline__ unsigned pk4(float a, float b, float c, float d) { int w = __builtin_amdgcn_cvt_pk_fp8_f32(a, b, 0, false); w = __builtin_amdgcn_cvt_pk_fp8_f32(c, d, w, true); return (unsigned)w; }

template <int VAR = 0> __device__ __forceinline__ void mla8_unit(int b, int h, int qb, const unsigned char* __restrict__ Q8, const unsigned char* __restrict__ K8, const unsigned char* __restrict__ VT8, unsigned char* __restrict__ O8, float oscale, char* lds, unsigned* tstat = nullptr) {
  int tid_ = threadIdx.x; asm volatile("" : "+v"(tid_));
  const int tid = tid_, lane = tid & 63, r32 = lane & 31, hi = lane >> 5; const int wid = __builtin_amdgcn_readfirstlane(tid >> 6);
  unsigned long long tM_ = 0, tV_ = 0, tW_ = 0, ts0_ = 0, ts1_ = 0, ts2_ = 0, ts3_ = 0, ts4_ = 0;
#define STAMP(x) do { if constexpr (VAR & 8) { __builtin_amdgcn_sched_barrier(0); asm volatile("s_memtime %0\n\ts_waitcnt lgkmcnt(0)" : "=s"(x) :: "memory"); __builtin_amdgcn_sched_barrier(0); } } while (0)
  float* ws = (float*)(lds + OFF_WS) + wid * 64; float* li_l = ws; float* al_l = ws + 32;
  const unsigned lds0 = (unsigned)(uintptr_t)lds;
  const long rowbase = (long)b * SEQ;
  constexpr float C = 1.0f / SQ8;
  const int l4 = lane >> 2, pc = lane & 3;
  const unsigned char* src0; const unsigned char* src1; const unsigned char* src2; unsigned dst0, dst1, dst2;
  { auto piece = [&](int id, const unsigned char*& src, unsigned& dst) {
      if (id < 12) { const int ks = id >> 2, rb = id & 3, i = 16 * rb + l4, key = 32 * ((i >> 2) & 1) + 16 * (i >> 5) + (i & 3) + 4 * ((i & 31) >> 3), c = pc ^ ((i >> 2) & 3);
        src = K8 + ((size_t)(rowbase + key) * 16 + h) * 192 + 64 * ks + 16 * c; dst = OFF_K + ks * 4096 + rb * 1024; }
      else { const int vid = id - 12, dblk = vid >> 1, hb = vid & 1, d = 32 * dblk + 16 * hb + l4, c = pc ^ ((d >> 2) & 3);
        src = VT8 + ((size_t)(b * 16 + h) * 128 + d) * SEQ + 16 * c; dst = OFF_V + dblk * 2048 + hb * 1024; } };
    piece(wid, src0, dst0); piece(wid + 8, src1, dst1); piece(wid < 4 ? wid + 16 : wid + 8, src2, dst2); }
  const size_t kstepK = (size_t)KVBLK * 16 * 192, kstepV = KVBLK;
  const size_t st0 = (wid < 8) ? kstepK : kstepV, st1 = (wid + 8 < 12) ? kstepK : kstepV, st2 = kstepV;
  const unsigned sl0 = (wid < 8) ? KT_BYTES : VT_BYTES, sl1 = (wid + 8 < 12) ? KT_BYTES : VT_BYTES, sl2 = VT_BYTES;
#define DMA_TILE(t, slot) do { glds16(src0 + (size_t)(t) * st0, (unsigned)__builtin_amdgcn_readfirstlane(lds0 + dst0 + (slot) * sl0)); \
    glds16(src1 + (size_t)(t) * st1, (unsigned)__builtin_amdgcn_readfirstlane(lds0 + dst1 + (slot) * sl1)); \
    if (wid < 4) glds16(src2 + (size_t)(t) * st2, (unsigned)__builtin_amdgcn_readfirstlane(lds0 + dst2 + (slot) * sl2)); } while (0)
#define WAIT_TILES_BEHIND(n) do { if (wid < 4) { if ((n) == 2) asm volatile("s_waitcnt vmcnt(6)" ::: "memory"); else if ((n) == 1) asm volatile("s_waitcnt vmcnt(3)" ::: "memory"); else asm volatile("s_waitcnt vmcnt(0)" ::: "memory"); } \
    else { if ((n) == 2) asm volatile("s_waitcnt vmcnt(4)" ::: "memory"); else if ((n) == 1) asm volatile("s_waitcnt vmcnt(2)" ::: "memory"); else asm volatile("s_waitcnt vmcnt(0)" ::: "memory"); } } while (0)
  const int sw = (r32 >> 2) & 3;
  const int kA = r32 * 64 + (((2 * hi) ^ sw) << 4), kB = r32 * 64 + (((2 * hi + 1) ^ sw) << 4);
  __syncthreads();
  const int NT = SEQ / KVBLK;
  DMA_TILE(0, 0); DMA_TILE(1, 1); DMA_TILE(2, 2);
  v8i qf[3];
  { const unsigned char* qp = Q8 + (size_t)(rowbase + qb * 256 + wid * 32 + r32) * 3072 + h * 192 + 32 * hi;
#pragma unroll
    for (int ks = 0; ks < 3; ++ks) qf[ks] = ld32((const char*)qp + 64 * ks, (const char*)qp + 64 * ks + 16); }
  asm volatile("" : "+v"(qf[0]), "+v"(qf[1]), "+v"(qf[2]));
  float m_reg = 0.f; f32x16 o[5]; f32x16 negm;
#pragma unroll
  for (int d = 0; d < 5; ++d) o[d] = f32x16{};
  { float nm0 = PSH; asm volatile("" : "+v"(nm0));
#pragma unroll
    for (int r = 0; r < 16; ++r) negm[r] = nm0; }
  v8i pa = {0, 0, 0, 0, 0, 0, 0, 0};
  const v8i ones8 = {0x38383838, 0x38383838, 0x38383838, 0x38383838, 0x38383838, 0x38383838, 0x38383838, 0x38383838};
  v8i ka[3], kb[3];
  __syncthreads();
#pragma unroll
  for (int ks = 0; ks < 3; ++ks) { ka[ks] = ld32(lds + OFF_K + ks * 4096 + kA, lds + OFF_K + ks * 4096 + kB); kb[ks] = ld32(lds + OFF_K + ks * 4096 + 2048 + kA, lds + OFF_K + ks * 4096 + 2048 + kB); }
  if (wid >= 4) __builtin_amdgcn_s_barrier();
  int slot = 0, slotp = 0, slot3 = 3;
#pragma unroll 1
  for (int t = 0; t < NT; ++t) {
    STAMP(ts0_);
    __builtin_amdgcn_s_barrier(); asm volatile("" ::: "memory");
    STAMP(ts1_);
    const bool dma_on = !(VAR & 4) && (t + 3 < NT);
    const char* Kt = lds + OFF_K + slot * KT_BYTES; const char* Vp = lds + OFF_V + slotp * VT_BYTES;
    f32x16 p0, p1;
    v8i vb0, vb1;
    __builtin_amdgcn_s_setprio(2);
    mfma64c<!(VAR & 2)>(p0, ka[0], qf[0], negm);
    if (dma_on) glds16(src0 + (size_t)(t + 3) * st0, (unsigned)__builtin_amdgcn_readfirstlane(lds0 + dst0 + slot3 * sl0));
    mfma64c<!(VAR & 2)>(p1, kb[0], qf[0], negm);
    __builtin_amdgcn_sched_barrier(0); vb0 = ld32(Vp + kA, Vp + kB); __builtin_amdgcn_sched_barrier(0);
    mfma64<!(VAR & 2)>(p0, ka[1], qf[1]);
    if (dma_on) glds16(src1 + (size_t)(t + 3) * st1, (unsigned)__builtin_amdgcn_readfirstlane(lds0 + dst1 + slot3 * sl1));
    mfma64<!(VAR & 2)>(p1, kb[1], qf[1]);
    __builtin_amdgcn_sched_barrier(0); vb1 = ld32(Vp + 2048 + kA, Vp + 2048 + kB); __builtin_amdgcn_sched_barrier(0);
    mfma64<!(VAR & 2)>(p0, ka[2], qf[2]);
    if (dma_on && wid < 4) glds16(src2 + (size_t)(t + 3) * st2, (unsigned)__builtin_amdgcn_readfirstlane(lds0 + dst2 + slot3 * sl2));
    mfma64<!(VAR & 2)>(p1, kb[2], qf[2]);
    mfma64<!(VAR & 2)>(o[4], pa, ones8);
    mfma64<!(VAR & 2)>(o[0], pa, vb0);
    __builtin_amdgcn_sched_barrier(0);
    { const v8i vb2 = ld32(Vp + 2 * 2048 + kA, Vp + 2 * 2048 + kB);
      __builtin_amdgcn_sched_barrier(0);
      mfma64<!(VAR & 2)>(o[1], pa, vb1);
      __builtin_amdgcn_sched_barrier(0);
      const v8i vb3 = ld32(Vp + 3 * 2048 + kA, Vp + 3 * 2048 + kB);
      __builtin_amdgcn_sched_barrier(0);
      mfma64<!(VAR & 2)>(o[2], pa, vb2);
      mfma64<!(VAR & 2)>(o[3], pa, vb3); }
    __builtin_amdgcn_s_setprio(0);
    { const int ahead = (NT - 2 - t) < 2 ? (NT - 2 - t) : 2; if (ahead >= 2) WAIT_TILES_BEHIND(2); else if (ahead == 1) WAIT_TILES_BEHIND(1); else WAIT_TILES_BEHIND(0); }
    asm volatile("s_waitcnt lgkmcnt(0)" ::: "memory");
    STAMP(ts2_);
    __builtin_amdgcn_s_barrier(); asm volatile("" ::: "memory");
    STAMP(ts3_);
    { const char* Kn = lds + OFF_K + ((slot == NSLOT - 1) ? 0 : slot + 1) * KT_BYTES;
      if (t + 1 < NT) {
#pragma unroll
        for (int ks = 0; ks < 3; ++ks) { ka[ks] = ld32(Kn + ks * 4096 + kA, Kn + ks * 4096 + kB); kb[ks] = ld32(Kn + ks * 4096 + 2048 + kA, Kn + ks * 4096 + 2048 + kB); } } }
    MFMA_DRAIN2(p0, p1);
    if constexpr (VAR & 1) { asm volatile("" : "+v"(p0), "+v"(p1)); } else {
    float pmax = p0[0];
#pragma unroll
    for (int r = 1; r < 16; ++r) pmax = fmaxf(pmax, p0[r]);
#pragma unroll
    for (int r = 0; r < 16; ++r) pmax = fmaxf(pmax, p1[r]);
    { auto rr = __builtin_amdgcn_permlane32_swap(__float_as_uint(pmax), __float_as_uint(pmax), false, false); pmax = fmaxf(__uint_as_float(rr[0]), __uint_as_float(rr[1])); }
    const float grow = pmax - PSH;
    if (t == 0 || !__all(grow <= THR8)) {
      const float delta = (t == 0) ? grow : fmaxf(grow, 0.f);
      const float alpha = (t == 0) ? 1.f : __builtin_amdgcn_exp2f(-delta); m_reg += delta;
      if (hi == 0) al_l[r32] = alpha; asm volatile("s_waitcnt lgkmcnt(0)" ::: "memory");
      MFMA_DRAIN4(o[0], o[1], o[2], o[3]); asm volatile("s_nop 7" : "+v"(o[4]));
#pragma unroll
      for (int d = 0; d < 5; ++d)
#pragma unroll
        for (int r = 0; r < 16; ++r) o[d][r] *= al_l[crow(r, hi)];
#pragma unroll
      for (int r = 0; r < 16; ++r) { p0[r] -= delta; p1[r] -= delta; }
      const float nm = PSH - m_reg;
#pragma unroll
      for (int r = 0; r < 16; ++r) negm[r] = nm;
      asm volatile("" : "+v"(negm)); }
#pragma unroll
    for (int r = 0; r < 16; ++r) { p0[r] = __builtin_amdgcn_exp2f(p0[r]); p1[r] = __builtin_amdgcn_exp2f(p1[r]); } }
    pa[0] = (int)pk4(p0[0], p0[1], p0[2], p0[3]); pa[1] = (int)pk4(p0[4], p0[5], p0[6], p0[7]); pa[2] = (int)pk4(p0[8], p0[9], p0[10], p0[11]); pa[3] = (int)pk4(p0[12], p0[13], p0[14], p0[15]);
    pa[4] = (int)pk4(p1[0], p1[1], p1[2], p1[3]); pa[5] = (int)pk4(p1[4], p1[5], p1[6], p1[7]); pa[6] = (int)pk4(p1[8], p1[9], p1[10], p1[11]); pa[7] = (int)pk4(p1[12], p1[13], p1[14], p1[15]);
    asm volatile("" : "+v"(ka[0]), "+v"(ka[1]), "+v"(ka[2]), "+v"(kb[0]), "+v"(kb[1]), "+v"(kb[2]));
    slotp = slot; slot = (slot == NSLOT - 1) ? 0 : slot + 1; slot3 = (slot3 == NSLOT - 1) ? 0 : slot3 + 1;
    STAMP(ts4_);
    if constexpr (VAR & 8) { tW_ += (ts1_ - ts0_) + (ts3_ - ts2_); tM_ += ts2_ - ts1_; tV_ += ts4_ - ts3_; }
  }
  if constexpr (VAR & 8) { if (tstat && blockIdx.x == 77 && tid == 64 * 5) { tstat[0] = (unsigned)(tM_ >> 4); tstat[1] = (unsigned)(tV_ >> 4); tstat[2] = (unsigned)(tW_ >> 4); } }
#undef STAMP
  if (wid < 4) __builtin_amdgcn_s_barrier();
  { const char* Vp = lds + OFF_V + slotp * VT_BYTES;
    mfma64(o[4], pa, ones8);
#pragma unroll
    for (int d = 0; d < 4; ++d) { const v8i vb = ld32(Vp + d * 2048 + kA, Vp + d * 2048 + kB); mfma64(o[d], pa, vb); } }
  MFMA_DRAIN4(o[0], o[1], o[2], o[3]); asm volatile("s_nop 15\n\ts_nop 7" : "+v"(o[4]));
  float rli[16];
#pragma unroll
  for (int r = 0; r < 16; ++r) rli[r] = __builtin_amdgcn_rcpf(o[4][r]) * oscale;
  unsigned char* Ow = O8 + (size_t)(rowbase + qb * 256 + wid * 32) * 2048 + h * 128;
#pragma unroll
  for (int r = 0; r < 16; ++r) { const int orow = crow(r, hi);
#pragma unroll
    for (int d0 = 0; d0 < 4; ++d0) Ow[(long)orow * 2048 + d0 * 32 + r32] = (unsigned char)(__builtin_amdgcn_cvt_pk_fp8_f32(o[d0][r] * rli[r], 0.f, 0, false) & 0xff); }
#undef DMA_TILE
#undef WAIT_TILES_BEHIND
#undef MFMA_DRAIN2
#undef MFMA_DRAIN4
}
}

namespace peer {
#define PLAS __attribute__((address_space(3)))
using bf16x8 = __attribute__((ext_vector_type(8))) short;
using bf16x2 = __attribute__((ext_vector_type(2))) __bf16;
using f32x16 = __attribute__((ext_vector_type(16))) float;
using f32x4  = __attribute__((ext_vector_type(4))) float;
using u32x4  = __attribute__((ext_vector_type(4))) unsigned;
using u32x2  = __attribute__((ext_vector_type(2))) unsigned;
typedef unsigned short bf16_t;
__device__ __forceinline__ int f2ord(float f) { const int u = __float_as_int(f); return u ^ ((u >> 31) & 0x7fffffff); }
__device__ __forceinline__ float ord2f(int s) { return __int_as_float(s ^ ((s >> 31) & 0x7fffffff)); }
__device__ __forceinline__ int crow(int r, int hi) { return (r & 3) + 8 * (r >> 2) + 4 * hi; }
__device__ __forceinline__ unsigned cvtpk(float lo, float hi) { unsigned r; asm volatile("v_cvt_pk_bf16_f32 %0, %1, %2" : "=v"(r) : "v"(lo), "v"(hi)); return r; }
__device__ __forceinline__ float bf_lo(unsigned w) { return __uint_as_float(w << 16); }
__device__ __forceinline__ float bf_hi(unsigned w) { return __uint_as_float(w & 0xffff0000u); }
__device__ __forceinline__ int swapmax(int m) { auto rr = __builtin_amdgcn_permlane32_swap((unsigned)m, (unsigned)m, false, false); const int a = (int)rr[0], b = (int)rr[1]; return a > b ? a : b; }

struct CandTab { int ci[50], cj[50]; };
constexpr CandTab make_cands() { CandTab t{}; int n = 0; for (int i = 0; i < 16; ++i) for (int j = 0; j < 16; ++j) if ((i + 1) * (j + 1) <= 16) { t.ci[n] = i; t.cj[n] = j; ++n; } return t; }
constexpr CandTab CT = make_cands();

constexpr int SEL_LDS_PER_WAVE = (2 * 16 + 16) * 64 * 4;

__device__ __forceinline__ void select32(int t0, int h, const float* __restrict__ QP, const bf16_t* __restrict__ SUBH, const bf16_t* __restrict__ SUBL, int* __restrict__ IDX, float* __restrict__ GATE, PLAS int* wl, int lane_) {
  int lane = lane_; asm volatile("" : "+v"(lane));
  const int r32 = lane & 31, hi = lane >> 5;
  PLAS int* topl = wl; PLAS int* winl = wl + 2 * 16 * 64;
  const float* qrow = QP + (size_t)(t0 + r32) * 2048;
  {
#pragma unroll 1
    for (int p = 0; p < 2; ++p) {
      bf16x8 qh[8], ql[8];
      const float* qp = qrow + h * 256 + p * 128 + hi * 8;
#pragma unroll
      for (int d0 = 0; d0 < 8; ++d0) {
        const f32x4 a = *(const f32x4*)(qp + d0 * 16), b = *(const f32x4*)(qp + d0 * 16 + 4);
        u32x4 wh, wlw;
        wh.x = cvtpk(a[0], a[1]); wh.y = cvtpk(a[2], a[3]); wh.z = cvtpk(b[0], b[1]); wh.w = cvtpk(b[2], b[3]);
        wlw.x = cvtpk(a[0] - bf_lo(wh.x), a[1] - bf_hi(wh.x)); wlw.y = cvtpk(a[2] - bf_lo(wh.y), a[3] - bf_hi(wh.y));
        wlw.z = cvtpk(b[0] - bf_lo(wh.z), b[1] - bf_hi(wh.z)); wlw.w = cvtpk(b[2] - bf_lo(wh.w), b[3] - bf_hi(wh.w));
        qh[d0] = *reinterpret_cast<bf16x8*>(&wh); ql[d0] = *reinterpret_cast<bf16x8*>(&wlw);
      }
      const size_t soff = ((size_t)(h * 2 + p) * 128 + r32) * 128 + hi * 8;
      int key[64];
#pragma unroll
      for (int kb = 0; kb < 4; ++kb) {
        f32x16 acc = f32x16{};
#pragma unroll
        for (int d0 = 0; d0 < 8; ++d0) {
          const bf16x8 ah = *reinterpret_cast<const bf16x8*>(SUBH + soff + (size_t)kb * 32 * 128 + d0 * 16);
          const bf16x8 al = *reinterpret_cast<const bf16x8*>(SUBL + soff + (size_t)kb * 32 * 128 + d0 * 16);
          acc = __builtin_amdgcn_mfma_f32_32x32x16_bf16(ah, qh[d0], acc, 0, 0, 0);
          acc = __builtin_amdgcn_mfma_f32_32x32x16_bf16(ah, ql[d0], acc, 0, 0, 0);
          acc = __builtin_amdgcn_mfma_f32_32x32x16_bf16(al, qh[d0], acc, 0, 0, 0);
        }
#pragma unroll
        for (int r = 0; r < 16; ++r) key[kb * 16 + r] = (f2ord(acc[r]) & ~127) | (kb * 32 + crow(r, hi));
      }
#pragma unroll 1
      for (int it = 0; it < 16; ++it) {
        int m = key[0];
#pragma unroll
        for (int i = 1; i < 64; ++i) m = key[i] > m ? key[i] : m;
        const int gm = swapmax(m);
        topl[(p * 16 + it) * 64 + lane] = gm;
#pragma unroll
        for (int i = 0; i < 64; ++i) key[i] = (key[i] == gm) ? (int)0x80000000 : key[i];
      }
    }
    int ck[25];
#pragma unroll
    for (int c = 0; c < 25; ++c) {
      const int i = hi ? CT.ci[2 * c + 1] : CT.ci[2 * c], j = hi ? CT.cj[2 * c + 1] : CT.cj[2 * c];
      const int k0 = topl[i * 64 + lane], k1 = topl[(16 + j) * 64 + lane];
      const float s = ord2f(k0 & ~127) + ord2f(k1 & ~127);
      ck[c] = (f2ord(s) & ~255) | (i << 4) | j;
    }
#pragma unroll 1
    for (int it = 0; it < 16; ++it) {
      int m = ck[0];
#pragma unroll
      for (int i = 1; i < 25; ++i) m = ck[i] > m ? ck[i] : m;
      const int gm = swapmax(m);
      winl[it * 64 + lane] = gm;
#pragma unroll
      for (int i = 0; i < 25; ++i) ck[i] = (ck[i] == gm) ? (int)0x80000000 : ck[i];
    }
    float e[16]; int wv[16]; float tot = 0.f;
    const float s0 = ord2f(winl[lane] & ~255);
#pragma unroll
    for (int k = 0; k < 16; ++k) { wv[k] = winl[k * 64 + lane]; e[k] = __builtin_amdgcn_exp2f((ord2f(wv[k] & ~255) - s0) * 1.4426950408889634f); tot += e[k]; }
    const float rtot = 1.0f / tot;
    int l2_ = lane_; asm volatile("" : "+v"(l2_));
    const size_t ob = (size_t)(t0 + (l2_ & 31)) * 128 + h * 16 + (l2_ >> 5) * 8;
#pragma unroll
    for (int k = 0; k < 8; ++k) {
      const int w = hi ? wv[8 + k] : wv[k]; const float ev = hi ? e[8 + k] : e[k];
      const int i = (w >> 4) & 15, j = w & 15;
      const int e0 = topl[i * 64 + lane] & 127, e1 = topl[(16 + j) * 64 + lane] & 127;
      IDX[ob + k] = e0 * 128 + e1; GATE[ob + k] = ev * rtot;
    }
  }
}

__device__ __forceinline__ float dot2(unsigned w, unsigned x, float acc) { return __builtin_amdgcn_fdot2_f32_bf16(__builtin_bit_cast(bf16x2, w), __builtin_bit_cast(bf16x2, x), acc, false); }
__device__ __forceinline__ float gelu_erf(float v) {
  const float av = fabsf(v), d = av * 0.2316418882f + 1.0f, t = __builtin_amdgcn_rcpf(d);
  float q = t * 0.5307027145f + (-0.7265760135f); q = q * t + 0.7107068705f; q = q * t + (-0.142248368f); q = q * t + 0.127414796f; q = q * t;
  const float e = __builtin_amdgcn_exp2f((v * v) * (-0.72134752044f));
  const float m = v * (q * e);
  return v < 0.f ? m : v - m;
}
__device__ __forceinline__ float wave_sum(float v) {
#pragma unroll
  for (int o = 1; o < 64; o <<= 1) v += __shfl_xor(v, o);
  return v;
}

typedef float f32x2 __attribute__((ext_vector_type(2)));
constexpr float USCALE = 64.0f, VSCALE = 4.0f;
__device__ __forceinline__ f32x2 fp8x2(unsigned w, bool hiword) { return hiword ? __builtin_amdgcn_cvt_pk_f32_fp8((int)w, true) : __builtin_amdgcn_cvt_pk_f32_fp8((int)w, false); }
template <bool STORE, bool FAKE = false> __device__ __forceinline__ void expert_token(int t, const bf16_t* __restrict__ H2, const unsigned char* __restrict__ U8, const unsigned char* __restrict__ V8, const int* __restrict__ IDX, const float* __restrict__ GATE,
                                             float* X1OUT, const float* __restrict__ fnorm, int lane_) {
  int lane = lane_; asm volatile("" : "+v"(lane));
  f32x2 hf[4][8];
  { const u32x4* hp = (const u32x4*)(H2 + (size_t)t * 4096) + 2 * lane;
#pragma unroll
    for (int k = 0; k < 4; ++k) { const u32x4 a = hp[128 * k], b = hp[128 * k + 1];
      hf[k][0] = (f32x2){bf_lo(a.x), bf_hi(a.x)}; hf[k][1] = (f32x2){bf_lo(a.y), bf_hi(a.y)}; hf[k][2] = (f32x2){bf_lo(a.z), bf_hi(a.z)}; hf[k][3] = (f32x2){bf_lo(a.w), bf_hi(a.w)};
      hf[k][4] = (f32x2){bf_lo(b.x), bf_hi(b.x)}; hf[k][5] = (f32x2){bf_lo(b.y), bf_hi(b.y)}; hf[k][6] = (f32x2){bf_lo(b.z), bf_hi(b.z)}; hf[k][7] = (f32x2){bf_lo(b.w), bf_hi(b.w)}; } }
  const int e0 = FAKE ? lane : IDX[(size_t)t * 128 + lane], e1 = FAKE ? lane + 64 : IDX[(size_t)t * 128 + 64 + lane];
  const float g0 = GATE[(size_t)t * 128 + lane], g1 = GATE[(size_t)t * 128 + 64 + lane];
  float c0 = 0.f, c1 = 0.f;
  u32x4 r0[4], r1[4], r2[4], r3[4];
#define ELOAD(dst, jj) do { const int jx_ = (jj); if (jx_ < 256) { const int sl_ = jx_ & 127; const int e_ = __builtin_amdgcn_readlane(sl_ < 64 ? e0 : e1, sl_ & 63); \
    const u32x4* rp_ = (const u32x4*)((jx_ < 128 ? U8 : V8) + (size_t)e_ * 4096) + lane; _Pragma("unroll") for (int k = 0; k < 4; ++k) dst[k] = rp_[64 * k]; } \
    asm volatile("" ::: "memory"); __builtin_amdgcn_sched_barrier(0); } while (0)
#define UDOT(R, OUT) do { f32x2 a0_ = {0.f, 0.f}, a1_ = {0.f, 0.f}, a2_ = {0.f, 0.f}, a3_ = {0.f, 0.f}; \
    _Pragma("unroll") for (int k = 0; k < 4; ++k) { \
      a0_ += fp8x2(R[k].x, false) * hf[k][0]; a1_ += fp8x2(R[k].x, true) * hf[k][1]; a2_ += fp8x2(R[k].y, false) * hf[k][2]; a3_ += fp8x2(R[k].y, true) * hf[k][3]; \
      a0_ += fp8x2(R[k].z, false) * hf[k][4]; a1_ += fp8x2(R[k].z, true) * hf[k][5]; a2_ += fp8x2(R[k].w, false) * hf[k][6]; a3_ += fp8x2(R[k].w, true) * hf[k][7]; } \
    a0_ += a1_; a2_ += a3_; a0_ += a2_; OUT = a0_.x + a0_.y; } while (0)
  ELOAD(r0, 0); ELOAD(r1, 1); ELOAD(r2, 2); ELOAD(r3, 3);
#pragma unroll 1
  for (int g = 0; g < 16; ++g) {
    float p[8];
    const int j = g * 8;
    UDOT(r0, p[0]); ELOAD(r0, j + 4); UDOT(r1, p[1]); ELOAD(r1, j + 5); UDOT(r2, p[2]); ELOAD(r2, j + 6); UDOT(r3, p[3]); ELOAD(r3, j + 7);
    UDOT(r0, p[4]); ELOAD(r0, j + 8); UDOT(r1, p[5]); ELOAD(r1, j + 9); UDOT(r2, p[6]); ELOAD(r2, j + 10); UDOT(r3, p[7]); ELOAD(r3, j + 11);
    float q4[4], q2[2], q1;
    { const bool up = (lane & 32) != 0;
#pragma unroll
      for (int i = 0; i < 4; ++i) { const float send = up ? p[i] : p[4 + i], keep = up ? p[4 + i] : p[i]; q4[i] = keep + __shfl_xor(send, 32); } }
    { const bool up = (lane & 16) != 0;
#pragma unroll
      for (int i = 0; i < 2; ++i) { const float send = up ? q4[i] : q4[2 + i], keep = up ? q4[2 + i] : q4[i]; q2[i] = keep + __shfl_xor(send, 16); } }
    { const bool up = (lane & 8) != 0; const float send = up ? q2[0] : q2[1], keep = up ? q2[1] : q2[0]; q1 = keep + __shfl_xor(send, 8); }
    q1 += __shfl_xor(q1, 4); q1 += __shfl_xor(q1, 2); q1 += __shfl_xor(q1, 1);
    const float got = __shfl(q1, 8 * (lane & 7));
    if ((lane >> 3) == (g & 7)) { if (g < 8) c0 = got; else c1 = got; }
  }
#undef UDOT
  c0 = g0 * gelu_erf(c0 * (1.0f / USCALE)) * (1.0f / VSCALE); c1 = g1 * gelu_erf(c1 * (1.0f / USCALE)) * (1.0f / VSCALE);
  f32x2 acc[4][8];
#pragma unroll
  for (int k = 0; k < 4; ++k)
#pragma unroll
    for (int i = 0; i < 8; ++i) acc[k][i] = (f32x2){0.f, 0.f};
#define VROW(R, C) do { const f32x2 cc_ = {(C), (C)}; _Pragma("unroll") for (int k = 0; k < 4; ++k) { \
      acc[k][0] += cc_ * fp8x2(R[k].x, false); acc[k][1] += cc_ * fp8x2(R[k].x, true); acc[k][2] += cc_ * fp8x2(R[k].y, false); acc[k][3] += cc_ * fp8x2(R[k].y, true); \
      acc[k][4] += cc_ * fp8x2(R[k].z, false); acc[k][5] += cc_ * fp8x2(R[k].z, true); acc[k][6] += cc_ * fp8x2(R[k].w, false); acc[k][7] += cc_ * fp8x2(R[k].w, true); } } while (0)
#define CJ(j) __int_as_float(__builtin_amdgcn_readlane(__float_as_int((j) < 64 ? c0 : c1), (j) & 63))
#pragma unroll 1
  for (int j = 0; j < 128; j += 4) {
    { const float c = CJ(j); VROW(r0, c); __builtin_amdgcn_sched_barrier(0); ELOAD(r0, 128 + j + 4); }
    { const float c = CJ(j + 1); VROW(r1, c); __builtin_amdgcn_sched_barrier(0); ELOAD(r1, 128 + j + 5); }
    { const float c = CJ(j + 2); VROW(r2, c); __builtin_amdgcn_sched_barrier(0); ELOAD(r2, 128 + j + 6); }
    { const float c = CJ(j + 3); VROW(r3, c); __builtin_amdgcn_sched_barrier(0); ELOAD(r3, 128 + j + 7); }
  }
#undef VROW
#undef CJ
#undef ELOAD
  int xo_ = 16 * lane; asm volatile("" : "+v"(xo_));
  float* xr = X1OUT + (size_t)t * 4096 + xo_; float ss = 0.f;
#ifdef PROBE_PEER_SCALE
#pragma unroll
  for (int k = 0; k < 4; ++k)
#pragma unroll
    for (int i = 0; i < 8; ++i) acc[k][i] *= PROBE_PEER_SCALE;
#endif
#pragma unroll
  for (int k = 0; k < 4; ++k)
#pragma unroll
    for (int q = 0; q < 4; ++q) { const f32x4 a = *(const f32x4*)(xr + 1024 * k + 4 * q);
      acc[k][2 * q] += (f32x2){a[0], a[1]}; acc[k][2 * q + 1] += (f32x2){a[2], a[3]};
      ss += acc[k][2 * q].x * acc[k][2 * q].x + acc[k][2 * q].y * acc[k][2 * q].y + acc[k][2 * q + 1].x * acc[k][2 * q + 1].x + acc[k][2 * q + 1].y * acc[k][2 * q + 1].y; }
  const float rstd = 1.0f / sqrtf(wave_sum(ss) * (1.0f / 4096.0f) + 1e-6f);
  const float* fn = fnorm + xo_;
#pragma unroll
  for (int k = 0; k < 4; ++k)
#pragma unroll
    for (int q = 0; q < 4; ++q) { const f32x4 g = *(const f32x4*)(fn + 1024 * k + 4 * q);
      f32x4 o; o[0] = acc[k][2 * q].x * rstd * g[0]; o[1] = acc[k][2 * q].y * rstd * g[1]; o[2] = acc[k][2 * q + 1].x * rstd * g[2]; o[3] = acc[k][2 * q + 1].y * rstd * g[3];
      if constexpr (STORE) { *(f32x4*)(xr + 1024 * k + 4 * q) = o; } else { asm volatile("" :: "v"(o)); } }
}
typedef unsigned v6u __attribute__((ext_vector_type(6)));
typedef float v32f __attribute__((ext_vector_type(32)));
typedef __bf16 v32bf __attribute__((ext_vector_type(32)));
typedef unsigned v16u __attribute__((ext_vector_type(16)));
constexpr float U6SCALE = 128.0f, V6SCALE = 4.0f;
constexpr int ROW6 = 3072;
__device__ __forceinline__ unsigned f32_to_e2m3(float x) {
  const unsigned sgn = (__float_as_uint(x) >> 26) & 32u; float a = fminf(fabsf(x), 7.5f);
  unsigned code;
  if (a < 1.0f) { code = (unsigned)__builtin_rintf(a * 8.0f); }
  else { unsigned u = __float_as_uint(a); u += 0x7FFFFu + ((u >> 20) & 1u); const unsigned e = (u >> 23) - 127u, m = (u >> 20) & 7u; code = ((e + 1u) << 3) | m; code = code > 31u ? 31u : code; }
  return code | sgn;
}
typedef float v16f __attribute__((ext_vector_type(16)));
__device__ __forceinline__ void pack_row_fp6(const float* __restrict__ src, unsigned char* __restrict__ dst, float scale, int lane) {
  const f32x4* sp = (const f32x4*)(src + 16 * lane);
  v16f c[4];
#pragma unroll
  for (int j = 0; j < 4; ++j)
#pragma unroll
    for (int q = 0; q < 4; ++q) { const f32x4 v = sp[256 * j + q] * scale; c[j][4 * q] = v[0]; c[j][4 * q + 1] = v[1]; c[j][4 * q + 2] = v[2]; c[j][4 * q + 3] = v[3]; }
  v16f ea, oa, eb, ob;
#pragma unroll
  for (int i = 0; i < 8; ++i) { ea[i] = c[0][2 * i]; oa[i] = c[0][2 * i + 1]; ea[8 + i] = c[1][2 * i]; oa[8 + i] = c[1][2 * i + 1]; eb[i] = c[2][2 * i]; ob[i] = c[2][2 * i + 1]; eb[8 + i] = c[3][2 * i]; ob[8 + i] = c[3][2 * i + 1]; }
  const v6u ga = __builtin_amdgcn_cvt_scalef32_2xpk16_fp6_f32(ea, oa, 1.0f), gb = __builtin_amdgcn_cvt_scalef32_2xpk16_fp6_f32(eb, ob, 1.0f);
  *(u32x4*)(dst + 16 * lane) = (u32x4){ga[0], ga[1], ga[2], ga[3]};
  *(u32x4*)(dst + 1024 + 16 * lane) = (u32x4){ga[4], ga[5], gb[0], gb[1]};
  *(u32x4*)(dst + 2048 + 16 * lane) = (u32x4){gb[2], gb[3], gb[4], gb[5]};
}
template <bool STORE, int LV = 0> __device__ __forceinline__ void expert_tokens6(int t_first, int t_step, int t_end, const bf16_t* __restrict__ H2, const unsigned char* __restrict__ U6, const unsigned char* __restrict__ V6,
                                             const int* __restrict__ IDX, const float* __restrict__ GATE, float* X1OUT, const float* __restrict__ fnorm, int lane_) {
  int lane = lane_; asm volatile("" : "+v"(lane));
  int t = t_first; if (t >= t_end) return;
  const unsigned lo16 = (unsigned)lane * 16u;
  int e0 = IDX[(size_t)t * 128 + lane], e1 = IDX[(size_t)t * 128 + 64 + lane];
  u32x4 r0[3], r1[3], r2[3], r3[3];
#define ELOAD(dst, jj, EA, EB, TAB) do { const int sl_ = (jj) & 127; const int e_ = __builtin_amdgcn_readlane(sl_ < 64 ? (EA) : (EB), sl_ & 63); \
    const unsigned char* rb_ = (TAB) + (size_t)(unsigned)e_ * ROW6; _Pragma("unroll") for (int k = 0; k < 3; ++k) dst[k] = *(const u32x4*)(rb_ + (lo16 + 1024u * ((LV & 1) && k == 2 ? 1 : k))); \
    asm volatile("" ::: "memory"); __builtin_amdgcn_sched_barrier(0); } while (0)
#define GRPA(R) ((v6u){R[0].x, R[0].y, R[0].z, R[0].w, R[1].x, R[1].y})
#define GRPB(R) ((v6u){R[1].z, R[1].w, R[2].x, R[2].y, R[2].z, R[2].w})
  ELOAD(r0, 0, e0, e1, U6); ELOAD(r1, 1, e0, e1, U6); ELOAD(r2, 2, e0, e1, U6); ELOAD(r3, 3, e0, e1, U6);
#pragma unroll 1
  for (;;) {
    const int tn = t + t_step, tnx = tn < t_end ? tn : t;
    const int e0n = IDX[(size_t)tnx * 128 + lane], e1n = IDX[(size_t)tnx * 128 + 64 + lane];
    const float g0 = GATE[(size_t)t * 128 + lane], g1 = GATE[(size_t)t * 128 + 64 + lane];
    unsigned hq[32];
    { const u32x4* hp = (const u32x4*)(H2 + (size_t)t * 4096 + 16 * lane);
#pragma unroll
      for (int q = 0; q < 8; ++q) { const u32x4 a = hp[128 * (q >> 1) + (q & 1)]; hq[4 * q] = a.x; hq[4 * q + 1] = a.y; hq[4 * q + 2] = a.z; hq[4 * q + 3] = a.w; } }
    float c0 = 0.f, c1 = 0.f;
#define UDOT(R, OUT) do { if constexpr ((LV & 2) != 0) { OUT = __uint_as_float(R[0].x ^ R[1].y ^ R[2].z); break; } float a0_ = 0.f, a1_ = 0.f, a2_ = 0.f, a3_ = 0.f; \
    asm volatile("" : "+v"(R[0].x)); \
    { const v16u b_ = __builtin_bit_cast(v16u, __builtin_amdgcn_cvt_scalef32_pk32_bf16_fp6(GRPA(R), 1.0f)); \
      _Pragma("unroll") for (int j = 0; j < 16; j += 4) { a0_ = dot2(b_[j], hq[j], a0_); a1_ = dot2(b_[j + 1], hq[j + 1], a1_); a2_ = dot2(b_[j + 2], hq[j + 2], a2_); a3_ = dot2(b_[j + 3], hq[j + 3], a3_); } } \
    asm volatile("" : "+v"(a0_), "+v"(a1_), "+v"(a2_), "+v"(a3_), "+v"(R[1].z)); \
    { const v16u b_ = __builtin_bit_cast(v16u, __builtin_amdgcn_cvt_scalef32_pk32_bf16_fp6(GRPB(R), 1.0f)); \
      _Pragma("unroll") for (int j = 0; j < 16; j += 4) { a0_ = dot2(b_[j], hq[16 + j], a0_); a1_ = dot2(b_[j + 1], hq[17 + j], a1_); a2_ = dot2(b_[j + 2], hq[18 + j], a2_); a3_ = dot2(b_[j + 3], hq[19 + j], a3_); } } \
    asm volatile("" : "+v"(a0_), "+v"(a1_), "+v"(a2_), "+v"(a3_)); \
    OUT = (a0_ + a1_) + (a2_ + a3_); } while (0)
#define RSCAT(G) do { float q4[4], q2[2], q1; \
      { const bool up = (lane & 32) != 0; _Pragma("unroll") for (int i = 0; i < 4; ++i) { const float send = up ? p[i] : p[4 + i], keep = up ? p[4 + i] : p[i]; q4[i] = keep + __shfl_xor(send, 32); } } \
      { const bool up = (lane & 16) != 0; _Pragma("unroll") for (int i = 0; i < 2; ++i) { const float send = up ? q4[i] : q4[2 + i], keep = up ? q4[2 + i] : q4[i]; q2[i] = keep + __shfl_xor(send, 16); } } \
      { const bool up = (lane & 8) != 0; const float send = up ? q2[0] : q2[1], keep = up ? q2[1] : q2[0]; q1 = keep + __shfl_xor(send, 8); } \
      q1 += __shfl_xor(q1, 4); q1 += __shfl_xor(q1, 2); q1 += __shfl_xor(q1, 1); \
      const float got = __shfl(q1, 8 * (lane & 7)); \
      if ((lane >> 3) == ((G) & 7)) { if ((G) < 8) c0 = got; else c1 = got; } } while (0)
#pragma unroll 1
    for (int g = 0; g < 15; ++g) {
      float p[8];
      const int j = g * 8;
      UDOT(r0, p[0]); ELOAD(r0, j + 4, e0, e1, U6); UDOT(r1, p[1]); ELOAD(r1, j + 5, e0, e1, U6); UDOT(r2, p[2]); ELOAD(r2, j + 6, e0, e1, U6); UDOT(r3, p[3]); ELOAD(r3, j + 7, e0, e1, U6);
      UDOT(r0, p[4]); ELOAD(r0, j + 8, e0, e1, U6); UDOT(r1, p[5]); ELOAD(r1, j + 9, e0, e1, U6); UDOT(r2, p[6]); ELOAD(r2, j + 10, e0, e1, U6); UDOT(r3, p[7]); ELOAD(r3, j + 11, e0, e1, U6);
      RSCAT(g);
    }
    { float p[8];
      UDOT(r0, p[0]); ELOAD(r0, 124, e0, e1, U6); UDOT(r1, p[1]); ELOAD(r1, 125, e0, e1, U6); UDOT(r2, p[2]); ELOAD(r2, 126, e0, e1, U6); UDOT(r3, p[3]); ELOAD(r3, 127, e0, e1, U6);
      UDOT(r0, p[4]); ELOAD(r0, 0, e0, e1, V6); UDOT(r1, p[5]); ELOAD(r1, 1, e0, e1, V6); UDOT(r2, p[6]); ELOAD(r2, 2, e0, e1, V6); UDOT(r3, p[7]); ELOAD(r3, 3, e0, e1, V6);
      RSCAT(15); }
#undef RSCAT
#undef UDOT
    c0 = g0 * gelu_erf(c0 * (1.0f / U6SCALE)) * (1.0f / V6SCALE); c1 = g1 * gelu_erf(c1 * (1.0f / U6SCALE)) * (1.0f / V6SCALE);
    float acc[64];
#pragma unroll
    for (int i = 0; i < 64; ++i) acc[i] = 0.f;
#define PIN16(B) asm volatile("" : "+v"(acc[B]), "+v"(acc[B + 1]), "+v"(acc[B + 2]), "+v"(acc[B + 3]), "+v"(acc[B + 4]), "+v"(acc[B + 5]), "+v"(acc[B + 6]), "+v"(acc[B + 7]), \
    "+v"(acc[B + 8]), "+v"(acc[B + 9]), "+v"(acc[B + 10]), "+v"(acc[B + 11]), "+v"(acc[B + 12]), "+v"(acc[B + 13]), "+v"(acc[B + 14]), "+v"(acc[B + 15]))
#define VROW(R, C) do { if constexpr ((LV & 2) != 0) { acc[0] += (C) * __uint_as_float(R[0].x ^ R[1].y ^ R[2].z); break; } asm volatile("" : "+v"(R[0].x)); \
    { const v32f f_ = __builtin_amdgcn_cvt_scalef32_pk32_f32_fp6(GRPA(R), 1.0f); _Pragma("unroll") for (int i = 0; i < 32; ++i) acc[i] += (C) * f_[i]; } PIN16(0); PIN16(16); \
    asm volatile("" : "+v"(R[1].z)); \
    { const v32f f_ = __builtin_amdgcn_cvt_scalef32_pk32_f32_fp6(GRPB(R), 1.0f); _Pragma("unroll") for (int i = 0; i < 32; ++i) acc[32 + i] += (C) * f_[i]; } PIN16(32); PIN16(48); } while (0)
#define CJ(j) __int_as_float(__builtin_amdgcn_readlane(__float_as_int((j) < 64 ? c0 : c1), (j) & 63))
#pragma unroll 1
    for (int j = 0; j < 124; j += 4) {
      { const float c = CJ(j); VROW(r0, c); ELOAD(r0, j + 4, e0, e1, V6); }
      { const float c = CJ(j + 1); VROW(r1, c); ELOAD(r1, j + 5, e0, e1, V6); }
      { const float c = CJ(j + 2); VROW(r2, c); ELOAD(r2, j + 6, e0, e1, V6); }
      { const float c = CJ(j + 3); VROW(r3, c); ELOAD(r3, j + 7, e0, e1, V6); }
    }
    { const float c = CJ(124); VROW(r0, c); ELOAD(r0, 0, e0n, e1n, U6); }
    { const float c = CJ(125); VROW(r1, c); ELOAD(r1, 1, e0n, e1n, U6); }
    { const float c = CJ(126); VROW(r2, c); ELOAD(r2, 2, e0n, e1n, U6); }
    { const float c = CJ(127); VROW(r3, c); ELOAD(r3, 3, e0n, e1n, U6); }
#undef VROW
#undef PIN16
#undef CJ
    int xo_ = 16 * lane; asm volatile("" : "+v"(xo_));
    float* xr = X1OUT + (size_t)t * 4096 + xo_; float ss = 0.f;
#pragma unroll
    for (int k = 0; k < 4; ++k) {
#pragma unroll
      for (int q = 0; q < 4; ++q) { const f32x4 a = *(const f32x4*)(xr + 1024 * k + 4 * q); const int b_ = 16 * k + 4 * q;
        acc[b_] += a[0]; acc[b_ + 1] += a[1]; acc[b_ + 2] += a[2]; acc[b_ + 3] += a[3];
        ss += (acc[b_] * acc[b_] + acc[b_ + 1] * acc[b_ + 1]) + (acc[b_ + 2] * acc[b_ + 2] + acc[b_ + 3] * acc[b_ + 3]); }
      asm volatile("" ::: "memory"); __builtin_amdgcn_sched_barrier(0); }
    const float rstd = 1.0f / sqrtf(wave_sum(ss) * (1.0f / 4096.0f) + 1e-6f);
    const float* fn = fnorm + xo_;
#pragma unroll
    for (int k = 0; k < 4; ++k) {
#pragma unroll
      for (int q = 0; q < 4; ++q) { const f32x4 g = *(const f32x4*)(fn + 1024 * k + 4 * q); const int b_ = 16 * k + 4 * q;
        f32x4 o; o[0] = acc[b_] * rstd * g[0]; o[1] = acc[b_ + 1] * rstd * g[1]; o[2] = acc[b_ + 2] * rstd * g[2]; o[3] = acc[b_ + 3] * rstd * g[3];
        if constexpr (STORE) { *(f32x4*)(xr + 1024 * k + 4 * q) = o; } else { asm volatile("" :: "v"(o)); } }
      asm volatile("" ::: "memory"); __builtin_amdgcn_sched_barrier(0); }
    if (tn >= t_end) break;
    t = tn; e0 = e0n; e1 = e1n;
  }
#undef ELOAD
#undef GRPA
#undef GRPB
}
constexpr float U4SCALE = 128.0f, V4SCALE = 5.656854249f;
constexpr int ROW4 = 2048;
__device__ __forceinline__ void pack_row_fp4(const float* __restrict__ src, unsigned char* __restrict__ dst, float scale, int lane) {
  const f32x4* sp = (const f32x4*)(src + 16 * lane);
  f32x4 c[16];
#pragma unroll
  for (int j = 0; j < 4; ++j)
#pragma unroll
    for (int q = 0; q < 4; ++q) c[4 * j + q] = sp[256 * j + q] * scale;
#pragma unroll
  for (int k = 0; k < 2; ++k) { u32x4 o;
#pragma unroll
    for (int d = 0; d < 4; ++d) { unsigned w = 0;
      const f32x4 a = c[4 * (2 * k + (d >> 1)) + 2 * (d & 1)], b = c[4 * (2 * k + (d >> 1)) + 2 * (d & 1) + 1];
      w = __builtin_amdgcn_cvt_scalef32_pk_fp4_f32(w, a[0], a[1], 1.0f, 0); w = __builtin_amdgcn_cvt_scalef32_pk_fp4_f32(w, a[2], a[3], 1.0f, 1);
      w = __builtin_amdgcn_cvt_scalef32_pk_fp4_f32(w, b[0], b[1], 1.0f, 2); w = __builtin_amdgcn_cvt_scalef32_pk_fp4_f32(w, b[2], b[3], 1.0f, 3);
      o[d] = w; }
    *(u32x4*)(dst + 1024 * k + 16 * lane) = o; }
}
template <bool STORE, int LV = 0> __device__ __forceinline__ void expert_tokens4(int t_first, int t_step, int t_end, const bf16_t* __restrict__ H2, const unsigned char* __restrict__ U4, const unsigned char* __restrict__ V4,
                                             const int* __restrict__ IDX, const float* __restrict__ GATE, const bf16_t* __restrict__ X1B, float* __restrict__ OUT, const float* __restrict__ fnorm, int lane_) {
  int lane = lane_; asm volatile("" : "+v"(lane));
  int t = t_first; if (t >= t_end) return;
  const unsigned lo16 = (unsigned)lane * 16u;
  int e0 = IDX[(size_t)t * 128 + lane], e1 = IDX[(size_t)t * 128 + 64 + lane];
  u32x4 r0[2], r1[2], r2[2], r3[2], r4[2], r5[2], r6[2], r7[2];
#define ELOAD(dst, jj, EA, EB, TAB) do { const int sl_ = (jj) & 127; const int e_ = __builtin_amdgcn_readlane(sl_ < 64 ? (EA) : (EB), sl_ & 63); \
    const unsigned char* rb_ = (TAB) + (size_t)(unsigned)e_ * ROW4; dst[0] = *(const u32x4*)(rb_ + lo16); dst[1] = *(const u32x4*)(rb_ + (lo16 + 1024u)); \
    asm volatile("" ::: "memory"); __builtin_amdgcn_sched_barrier(0); } while (0)
  ELOAD(r0, 0, e0, e1, U4); ELOAD(r1, 1, e0, e1, U4); ELOAD(r2, 2, e0, e1, U4); ELOAD(r3, 3, e0, e1, U4);
  ELOAD(r4, 4, e0, e1, U4); ELOAD(r5, 5, e0, e1, U4); ELOAD(r6, 6, e0, e1, U4); ELOAD(r7, 7, e0, e1, U4);
#pragma unroll 1
  for (;;) {
    const int tn = t + t_step, tnx = tn < t_end ? tn : t;
    const int e0n = IDX[(size_t)tnx * 128 + lane], e1n = IDX[(size_t)tnx * 128 + 64 + lane];
    const float g0 = GATE[(size_t)t * 128 + lane], g1 = GATE[(size_t)t * 128 + 64 + lane];
    unsigned hq[32];
    { const u32x4* hp = (const u32x4*)(H2 + (size_t)t * 4096 + 16 * lane);
#pragma unroll
      for (int q = 0; q < 8; ++q) { const u32x4 a = hp[128 * (q >> 1) + (q & 1)]; hq[4 * q] = a.x; hq[4 * q + 1] = a.y; hq[4 * q + 2] = a.z; hq[4 * q + 3] = a.w; } }
    float c0 = 0.f, c1 = 0.f;
#define CVB(W, B) __builtin_bit_cast(unsigned, __builtin_amdgcn_cvt_scalef32_pk_bf16_fp4((W), 1.0f, (B)))
#define UDOT(R, OUT) do { float a0_ = 0.f, a1_ = 0.f, a2_ = 0.f, a3_ = 0.f; \
    asm volatile("" : "+v"(R[0].x)); \
    _Pragma("unroll") for (int k = 0; k < 2; ++k) { _Pragma("unroll") for (int d = 0; d < 4; ++d) { const unsigned w_ = R[k][d]; const int hb_ = 16 * k + 4 * d; \
      a0_ = dot2(CVB(w_, 0), hq[hb_], a0_); a1_ = dot2(CVB(w_, 1), hq[hb_ + 1], a1_); a2_ = dot2(CVB(w_, 2), hq[hb_ + 2], a2_); a3_ = dot2(CVB(w_, 3), hq[hb_ + 3], a3_); } \
      asm volatile("" : "+v"(a0_), "+v"(a1_), "+v"(a2_), "+v"(a3_)); } \
    OUT = (a0_ + a1_) + (a2_ + a3_); } while (0)
#define RSCAT(G) do { float q4[4], q2[2], q1; \
      { const bool up = (lane & 32) != 0; _Pragma("unroll") for (int i = 0; i < 4; ++i) { const float send = up ? p[i] : p[4 + i], keep = up ? p[4 + i] : p[i]; q4[i] = keep + __shfl_xor(send, 32); } } \
      { const bool up = (lane & 16) != 0; _Pragma("unroll") for (int i = 0; i < 2; ++i) { const float send = up ? q4[i] : q4[2 + i], keep = up ? q4[2 + i] : q4[i]; q2[i] = keep + __shfl_xor(send, 16); } } \
      { const bool up = (lane & 8) != 0; const float send = up ? q2[0] : q2[1], keep = up ? q2[1] : q2[0]; q1 = keep + __shfl_xor(send, 8); } \
      q1 += __shfl_xor(q1, 4); q1 += __shfl_xor(q1, 2); q1 += __shfl_xor(q1, 1); \
      const float got = __shfl(q1, 8 * (lane & 7)); \
      if ((lane >> 3) == ((G) & 7)) { if ((G) < 8) c0 = got; else c1 = got; } } while (0)
#pragma unroll 1
    for (int g = 0; g < 15; ++g) {
      float p[8];
      const int j = g * 8;
      UDOT(r0, p[0]); ELOAD(r0, j + 8, e0, e1, U4); UDOT(r1, p[1]); ELOAD(r1, j + 9, e0, e1, U4); UDOT(r2, p[2]); ELOAD(r2, j + 10, e0, e1, U4); UDOT(r3, p[3]); ELOAD(r3, j + 11, e0, e1, U4);
      UDOT(r4, p[4]); ELOAD(r4, j + 12, e0, e1, U4); UDOT(r5, p[5]); ELOAD(r5, j + 13, e0, e1, U4); UDOT(r6, p[6]); ELOAD(r6, j + 14, e0, e1, U4); UDOT(r7, p[7]); ELOAD(r7, j + 15, e0, e1, U4);
      RSCAT(g);
    }
    { float p[8];
      UDOT(r0, p[0]); ELOAD(r0, 0, e0, e1, V4); UDOT(r1, p[1]); ELOAD(r1, 1, e0, e1, V4); UDOT(r2, p[2]); ELOAD(r2, 2, e0, e1, V4); UDOT(r3, p[3]); ELOAD(r3, 3, e0, e1, V4);
      UDOT(r4, p[4]); ELOAD(r4, 4, e0, e1, V4); UDOT(r5, p[5]); ELOAD(r5, 5, e0, e1, V4); UDOT(r6, p[6]); ELOAD(r6, 6, e0, e1, V4); UDOT(r7, p[7]); ELOAD(r7, 7, e0, e1, V4);
      RSCAT(15); }
#undef RSCAT
#undef UDOT
#undef CVB
    c0 = g0 * gelu_erf(c0 * (1.0f / U4SCALE)) * (1.0f / V4SCALE); c1 = g1 * gelu_erf(c1 * (1.0f / U4SCALE)) * (1.0f / V4SCALE);
    f32x2 acc[32];
#pragma unroll
    for (int i = 0; i < 32; ++i) acc[i] = (f32x2){0.f, 0.f};
#define PIN8(B) asm volatile("" : "+v"(acc[B]), "+v"(acc[B + 1]), "+v"(acc[B + 2]), "+v"(acc[B + 3]), "+v"(acc[B + 4]), "+v"(acc[B + 5]), "+v"(acc[B + 6]), "+v"(acc[B + 7]))
#define VROW(R, C) do { asm volatile("" : "+v"(R[0].x)); const f32x2 cc_ = (f32x2){(C), (C)}; \
    _Pragma("unroll") for (int k = 0; k < 2; ++k) { _Pragma("unroll") for (int d = 0; d < 4; ++d) { const unsigned w_ = R[k][d]; const int ab_ = 16 * k + 4 * d; \
      acc[ab_] += cc_ * __builtin_amdgcn_cvt_scalef32_pk_f32_fp4(w_, 1.0f, 0); acc[ab_ + 1] += cc_ * __builtin_amdgcn_cvt_scalef32_pk_f32_fp4(w_, 1.0f, 1); \
      acc[ab_ + 2] += cc_ * __builtin_amdgcn_cvt_scalef32_pk_f32_fp4(w_, 1.0f, 2); acc[ab_ + 3] += cc_ * __builtin_amdgcn_cvt_scalef32_pk_f32_fp4(w_, 1.0f, 3); } \
      PIN8(16 * k); PIN8(16 * k + 8); } } while (0)
#define CJ(j) __int_as_float(__builtin_amdgcn_readlane(__float_as_int((j) < 64 ? c0 : c1), (j) & 63))
#pragma unroll 1
    for (int j = 0; j < 120; j += 8) {
      { const float c = CJ(j); VROW(r0, c); ELOAD(r0, j + 8, e0, e1, V4); }
      { const float c = CJ(j + 1); VROW(r1, c); ELOAD(r1, j + 9, e0, e1, V4); }
      { const float c = CJ(j + 2); VROW(r2, c); ELOAD(r2, j + 10, e0, e1, V4); }
      { const float c = CJ(j + 3); VROW(r3, c); ELOAD(r3, j + 11, e0, e1, V4); }
      { const float c = CJ(j + 4); VROW(r4, c); ELOAD(r4, j + 12, e0, e1, V4); }
      { const float c = CJ(j + 5); VROW(r5, c); ELOAD(r5, j + 13, e0, e1, V4); }
      { const float c = CJ(j + 6); VROW(r6, c); ELOAD(r6, j + 14, e0, e1, V4); }
      { const float c = CJ(j + 7); VROW(r7, c); ELOAD(r7, j + 15, e0, e1, V4); }
    }
    { const float c = CJ(120); VROW(r0, c); ELOAD(r0, 0, e0n, e1n, U4); }
    { const float c = CJ(121); VROW(r1, c); ELOAD(r1, 1, e0n, e1n, U4); }
    { const float c = CJ(122); VROW(r2, c); ELOAD(r2, 2, e0n, e1n, U4); }
    { const float c = CJ(123); VROW(r3, c); ELOAD(r3, 3, e0n, e1n, U4); }
    { const float c = CJ(124); VROW(r4, c); ELOAD(r4, 4, e0n, e1n, U4); }
    { const float c = CJ(125); VROW(r5, c); ELOAD(r5, 5, e0n, e1n, U4); }
    { const float c = CJ(126); VROW(r6, c); ELOAD(r6, 6, e0n, e1n, U4); }
    { const float c = CJ(127); VROW(r7, c); ELOAD(r7, 7, e0n, e1n, U4); }
#undef VROW
#undef PIN8
#undef CJ
    int xo_ = 16 * lane; asm volatile("" : "+v"(xo_));
    float* xr = OUT + (size_t)t * 4096 + xo_; const bf16_t* x1r = X1B + (size_t)t * 4096 + xo_; float ss = 0.f;
#pragma unroll
    for (int k = 0; k < 4; ++k) {
#pragma unroll
      for (int q = 0; q < 2; ++q) { const u32x4 a = *(const u32x4*)(x1r + 1024 * k + 8 * q); const int b_ = 8 * k + 4 * q;
#pragma unroll
        for (int i = 0; i < 4; ++i) { acc[b_ + i] += (f32x2){__uint_as_float(a[i] << 16), __uint_as_float(a[i] & 0xffff0000u)}; ss += acc[b_ + i].x * acc[b_ + i].x + acc[b_ + i].y * acc[b_ + i].y; } }
      asm volatile("" ::: "memory"); __builtin_amdgcn_sched_barrier(0); }
    const float rstd = 1.0f / sqrtf(wave_sum(ss) * (1.0f / 4096.0f) + 1e-6f);
    const float* fn = fnorm + xo_;
#pragma unroll
    for (int k = 0; k < 4; ++k) {
#pragma unroll
      for (int q = 0; q < 4; ++q) { const f32x4 g = *(const f32x4*)(fn + 1024 * k + 4 * q); const int b_ = 8 * k + 2 * q;
        f32x4 o; o[0] = acc[b_].x * rstd * g[0]; o[1] = acc[b_].y * rstd * g[1]; o[2] = acc[b_ + 1].x * rstd * g[2]; o[3] = acc[b_ + 1].y * rstd * g[3];
        if constexpr (STORE) { *(f32x4*)(xr + 1024 * k + 4 * q) = o; } else { asm volatile("" :: "v"(o)); } }
      asm volatile("" ::: "memory"); __builtin_amdgcn_sched_barrier(0); }
    if (tn >= t_end) break;
    t = tn; e0 = e0n; e1 = e1n;
  }
#undef ELOAD
}
constexpr int NWIN = 16;
__device__ __forceinline__ void pack_row_fp4w(const float* __restrict__ src, unsigned char* __restrict__ dst, int e, float scale, int lane) {
  const f32x4* sp = (const f32x4*)(src + 16 * lane);
  f32x4 c[16];
#pragma unroll
  for (int j = 0; j < 4; ++j)
#pragma unroll
    for (int q = 0; q < 4; ++q) c[4 * j + q] = sp[256 * j + q] * scale;
#pragma unroll
  for (int j = 0; j < 4; ++j) { unsigned w0 = 0, w1 = 0;
    w0 = __builtin_amdgcn_cvt_scalef32_pk_fp4_f32(w0, c[4 * j][0], c[4 * j][1], 1.0f, 0); w0 = __builtin_amdgcn_cvt_scalef32_pk_fp4_f32(w0, c[4 * j][2], c[4 * j][3], 1.0f, 1);
    w0 = __builtin_amdgcn_cvt_scalef32_pk_fp4_f32(w0, c[4 * j + 1][0], c[4 * j + 1][1], 1.0f, 2); w0 = __builtin_amdgcn_cvt_scalef32_pk_fp4_f32(w0, c[4 * j + 1][2], c[4 * j + 1][3], 1.0f, 3);
    w1 = __builtin_amdgcn_cvt_scalef32_pk_fp4_f32(w1, c[4 * j + 2][0], c[4 * j + 2][1], 1.0f, 0); w1 = __builtin_amdgcn_cvt_scalef32_pk_fp4_f32(w1, c[4 * j + 2][2], c[4 * j + 2][3], 1.0f, 1);
    w1 = __builtin_amdgcn_cvt_scalef32_pk_fp4_f32(w1, c[4 * j + 3][0], c[4 * j + 3][1], 1.0f, 2); w1 = __builtin_amdgcn_cvt_scalef32_pk_fp4_f32(w1, c[4 * j + 3][2], c[4 * j + 3][3], 1.0f, 3);
    *(u32x2*)(dst + ((size_t)(4 * j + (lane >> 4)) * 16384 + e) * 128 + 8 * (lane & 15)) = (u32x2){w0, w1}; }
}
constexpr float U4ISCALE = 192.0f, H8ISCALE = 20.0f;
__device__ __forceinline__ unsigned q4nib(float x) { return (unsigned)(int)__builtin_rintf(__builtin_amdgcn_fmed3f(x, -8.0f, 7.0f)) & 15u; }
__device__ __forceinline__ void pack_row_i4w(const float* __restrict__ src, unsigned char* __restrict__ dst, int e, float scale, int lane) {
  const f32x4* sp = (const f32x4*)(src + 16 * lane);
  f32x4 c[16];
#pragma unroll
  for (int j = 0; j < 4; ++j)
#pragma unroll
    for (int q = 0; q < 4; ++q) c[4 * j + q] = sp[256 * j + q] * scale;
#pragma unroll
  for (int j = 0; j < 4; ++j) { unsigned w0 = 0, w1 = 0;
#pragma unroll
    for (int i = 0; i < 8; ++i) { w0 |= q4nib(c[4 * j + (i >> 2)][i & 3]) << (4 * i); w1 |= q4nib(c[4 * j + 2 + (i >> 2)][i & 3]) << (4 * i); }
    *(u32x2*)(dst + ((size_t)(4 * j + (lane >> 4)) * 16384 + e) * 128 + 8 * (lane & 15)) = (u32x2){w0, w1}; }
}
__device__ __forceinline__ void expert_tokens_w(const unsigned char* __restrict__ HHI, const unsigned char* __restrict__ HLO, const unsigned char* __restrict__ U4, const unsigned char* __restrict__ V4, const int* __restrict__ IDX, const float* __restrict__ GATE,
                                                const bf16_t* __restrict__ X1B, bf16_t* X2B, float* __restrict__ OUT, const float* __restrict__ fnorm, PLAS float* cl, int lane_, int wave, int ntok) {
  int lane = lane_; asm volatile("" : "+v"(lane));
  const int g = lane >> 3, c = lane & 7;
  const int xcd = (int)(blockIdx.x & 7), nbx = ((int)gridDim.x - xcd + 7) >> 3, xw = (int)(blockIdx.x >> 3) * 8 + wave, ostep = 8 * nbx * 8;
  const unsigned c16 = 16u * (unsigned)c;
  PLAS int* el = (PLAS int*)(cl + 1024);
  constexpr unsigned WINB = 16384u * 128u;
#pragma unroll 1
  for (int o = xcd + 8 * xw; o < ntok / 8; o += ostep) {
    const int t0 = 8 * o;
#pragma unroll
    for (int q = 0; q < 4; ++q) { const int idx = q * 256 + lane * 4; *(PLAS u32x4*)(el + idx) = *(const u32x4*)(IDX + (size_t)t0 * 128 + idx); }
    asm volatile("s_waitcnt vmcnt(0) lgkmcnt(0)" ::: "memory");
#define EW_ROWS(IT, TAB, R) do { const int it_ = (IT) < 128 ? (IT) : 127; const unsigned char* tb_ = (TAB) + (size_t)(it_ >> 3) * WINB; PLAS const u32x4* ep_ = (PLAS const u32x4*)(el + (it_ & 7) * 128 + 16 * g); \
      _Pragma("unroll") for (int q = 0; q < 4; ++q) { const u32x4 e_ = ep_[q];     \
        R[4 * q] = *(const u32x4*)(tb_ + (e_.x * 128u + c16)); R[4 * q + 1] = *(const u32x4*)(tb_ + (e_.y * 128u + c16)); \
        R[4 * q + 2] = *(const u32x4*)(tb_ + (e_.z * 128u + c16)); R[4 * q + 3] = *(const u32x4*)(tb_ + (e_.w * 128u + c16)); } } while (0)
#define EW_HQ(IT, HQ) do { const int it_ = (IT) < 128 ? (IT) : 127; const size_t ho_ = (size_t)(t0 + (it_ & 7)) * 2048 + 128 * (it_ >> 3) + 16 * c;     \
      HQ[0] = *(const u32x4*)(HHI + ho_); HQ[1] = *(const u32x4*)(HLO + ho_); } while (0)
#define EW_NEXT(IT, TAB) const int itn_ = ((IT) + 1) < 128 ? ((IT) + 1) : 127; const unsigned char* tbn_ = (TAB) + (size_t)(itn_ >> 3) * WINB; u32x4 en_[4]; \
      { PLAS const u32x4* epn_ = (PLAS const u32x4*)(el + (itn_ & 7) * 128 + 16 * g); _Pragma("unroll") for (int q = 0; q < 4; ++q) en_[q] = epn_[q]; }
#define EW_UCOMP(IT, R, HQ, TAB, RN) do { float p[16]; EW_NEXT(IT, TAB) \
      _Pragma("unroll") for (int i = 0; i < 16; ++i) { int ah = 0, al = 0;     \
        _Pragma("unroll") for (int d = 0; d < 4; ++d) { ah = __builtin_amdgcn_sdot8((int)R[i][d], (int)HQ[0][d], ah, false); al = __builtin_amdgcn_sdot8((int)R[i][d], (int)HQ[1][d], al, false); } \
        p[i] = (float)(16 * ah + al); \
        RN[i] = *(const u32x4*)(tbn_ + (en_[i >> 2][i & 3] * 128u + c16)); __builtin_amdgcn_sched_barrier(0); } \
      float q8[8], q4[4], q2[2]; \
      { const bool up = (c & 4) != 0; _Pragma("unroll") for (int k = 0; k < 8; ++k) { const float send = up ? p[k] : p[8 + k], keep = up ? p[8 + k] : p[k]; q8[k] = keep + __shfl_xor(send, 4); } } \
      { const bool up = (c & 2) != 0; _Pragma("unroll") for (int k = 0; k < 4; ++k) { const float send = up ? q8[k] : q8[4 + k], keep = up ? q8[4 + k] : q8[k]; q4[k] = keep + __shfl_xor(send, 2); } } \
      { const bool up = (c & 1) != 0; _Pragma("unroll") for (int k = 0; k < 2; ++k) { const float send = up ? q4[k] : q4[2 + k], keep = up ? q4[2 + k] : q4[k]; q2[k] = keep + __shfl_xor(send, 1); } } \
      PLAS f32x2* dl = (PLAS f32x2*)(cl + ((IT) & 7) * 128 + 16 * g + 2 * c); \
      f32x2 acc2 = ((IT) < 8) ? (f32x2){0.f, 0.f} : *dl; acc2.x += q2[0]; acc2.y += q2[1]; *dl = acc2; } while (0)
    { u32x4 rA[16], rB[16], hA[2], hB[2];
      EW_ROWS(0, U4, rA); EW_HQ(0, hA);
#pragma unroll 1
      for (int it = 0; it < 128; it += 2) {
        EW_HQ(it + 1, hB); EW_UCOMP(it, rA, hA, U4, rB); __builtin_amdgcn_sched_barrier(0);
        EW_HQ(it + 2, hA); EW_UCOMP(it + 1, rB, hB, U4, rA); __builtin_amdgcn_sched_barrier(0);
      } }
#pragma unroll 1
    for (int tt = 0; tt < 8; ++tt) { const int t = t0 + tt;
      PLAS f32x2* dl = (PLAS f32x2*)(cl + tt * 128 + 16 * g + 2 * c); const f32x2 d2 = *dl;
      const f32x2 g2 = *(const f32x2*)(GATE + (size_t)t * 128 + 16 * g + 2 * c);
      *dl = (f32x2){g2.x * gelu_erf(d2.x * (1.0f / (U4ISCALE * H8ISCALE))) * (1.0f / V4SCALE), g2.y * gelu_erf(d2.y * (1.0f / (U4ISCALE * H8ISCALE))) * (1.0f / V4SCALE)}; }
    asm volatile("s_waitcnt lgkmcnt(0)" ::: "memory");
#define EW_VCOMP(IT, R, RN) do { const int t_ = t0 + ((IT) & 7), w_ = (IT) >> 3; float ci[16]; EW_NEXT(IT, V4) \
      { PLAS const f32x4* cp = (PLAS const f32x4*)(cl + ((IT) & 7) * 128 + 16 * g); \
        _Pragma("unroll") for (int q = 0; q < 4; ++q) { const f32x4 a = cp[q]; ci[4 * q] = a[0]; ci[4 * q + 1] = a[1]; ci[4 * q + 2] = a[2]; ci[4 * q + 3] = a[3]; } } \
      const size_t xo = (size_t)t_ * 4096 + 256 * w_ + 32 * c + 4 * g; \
      const u32x2 xa = *(const u32x2*)(X1B + xo); \
      f32x2 acc[16]; \
      _Pragma("unroll") for (int m = 0; m < 16; ++m) acc[m] = (f32x2){0.f, 0.f}; \
      _Pragma("unroll") for (int i = 0; i < 16; ++i) { const f32x2 cc = (f32x2){ci[i], ci[i]}; \
        _Pragma("unroll") for (int d = 0; d < 4; ++d) { const unsigned wd = R[i][d]; \
          acc[4 * d] += cc * __builtin_amdgcn_cvt_scalef32_pk_f32_fp4(wd, 1.0f, 0); acc[4 * d + 1] += cc * __builtin_amdgcn_cvt_scalef32_pk_f32_fp4(wd, 1.0f, 1); \
          acc[4 * d + 2] += cc * __builtin_amdgcn_cvt_scalef32_pk_f32_fp4(wd, 1.0f, 2); acc[4 * d + 3] += cc * __builtin_amdgcn_cvt_scalef32_pk_f32_fp4(wd, 1.0f, 3); } \
        RN[i] = *(const u32x4*)(tbn_ + (en_[i >> 2][i & 3] * 128u + c16)); __builtin_amdgcn_sched_barrier(0); } \
      f32x2 s8[8], s4[4], s2[2]; \
      { const bool up = (g & 4) != 0; _Pragma("unroll") for (int k = 0; k < 8; ++k) { const f32x2 send = up ? acc[k] : acc[8 + k], keep = up ? acc[8 + k] : acc[k]; s8[k] = (f32x2){keep.x + __shfl_xor(send.x, 32), keep.y + __shfl_xor(send.y, 32)}; } } \
      { const bool up = (g & 2) != 0; _Pragma("unroll") for (int k = 0; k < 4; ++k) { const f32x2 send = up ? s8[k] : s8[4 + k], keep = up ? s8[4 + k] : s8[k]; s4[k] = (f32x2){keep.x + __shfl_xor(send.x, 16), keep.y + __shfl_xor(send.y, 16)}; } } \
      { const bool up = (g & 1) != 0; _Pragma("unroll") for (int k = 0; k < 2; ++k) { const f32x2 send = up ? s4[k] : s4[2 + k], keep = up ? s4[2 + k] : s4[k]; s2[k] = (f32x2){keep.x + __shfl_xor(send.x, 8), keep.y + __shfl_xor(send.y, 8)}; } } \
      const float y0 = s2[0].x + __uint_as_float(xa.x << 16), y1 = s2[0].y + __uint_as_float(xa.x & 0xffff0000u), y2 = s2[1].x + __uint_as_float(xa.y << 16), y3 = s2[1].y + __uint_as_float(xa.y & 0xffff0000u); \
      unsigned r0_, r1_; asm volatile("v_cvt_pk_bf16_f32 %0, %1, %2" : "=v"(r0_) : "v"(y0), "v"(y1)); asm volatile("v_cvt_pk_bf16_f32 %0, %1, %2" : "=v"(r1_) : "v"(y2), "v"(y3)); \
      *(u32x2*)(X2B + xo) = (u32x2){r0_, r1_}; } while (0)
    { u32x4 rA[16], rB[16];
      EW_ROWS(0, V4, rA);
#pragma unroll 1
      for (int it = 0; it < 128; it += 2) {
        EW_VCOMP(it, rA, rB); __builtin_amdgcn_sched_barrier(0);
        EW_VCOMP(it + 1, rB, rA); __builtin_amdgcn_sched_barrier(0);
      } }
#undef EW_ROWS
#undef EW_NEXT
#undef EW_HQ
#undef EW_UCOMP
#undef EW_VCOMP
    asm volatile("s_waitcnt vmcnt(0)" ::: "memory");
#pragma unroll 1
    for (int tt = 0; tt < 8; ++tt) { const int t = t0 + tt;
      const u32x4* xr = (const u32x4*)(X2B + (size_t)t * 4096) + lane;
      u32x4 v[8]; float ss = 0.f;
#pragma unroll
      for (int j = 0; j < 8; ++j) { v[j] = xr[64 * j];
#pragma unroll
        for (int i = 0; i < 4; ++i) { const float a = __uint_as_float(v[j][i] << 16), b = __uint_as_float(v[j][i] & 0xffff0000u); ss += a * a + b * b; } }
      const float rstd = 1.0f / sqrtf(wave_sum(ss) * (1.0f / 4096.0f) + 1e-6f);
      const f32x4* fn = (const f32x4*)fnorm + 2 * lane; f32x4* op = (f32x4*)(OUT + (size_t)t * 4096) + 2 * lane;
#pragma unroll
      for (int j = 0; j < 8; ++j) { const f32x4 g0 = fn[128 * j], g1 = fn[128 * j + 1];
        op[128 * j] = (f32x4){__uint_as_float(v[j].x << 16) * rstd * g0[0], __uint_as_float(v[j].x & 0xffff0000u) * rstd * g0[1], __uint_as_float(v[j].y << 16) * rstd * g0[2], __uint_as_float(v[j].y & 0xffff0000u) * rstd * g0[3]};
        op[128 * j + 1] = (f32x4){__uint_as_float(v[j].z << 16) * rstd * g1[0], __uint_as_float(v[j].z & 0xffff0000u) * rstd * g1[1], __uint_as_float(v[j].w << 16) * rstd * g1[2], __uint_as_float(v[j].w & 0xffff0000u) * rstd * g1[3]}; }
    }
    asm volatile("s_waitcnt lgkmcnt(0)" ::: "memory");
  }
}
#undef PLAS
}

constexpr int BATCH = 2, SEQ = 8192, DM = 4096, T = BATCH * SEQ;
constexpr int NCAT = 15872;
constexpr int NPH = 12;
#ifndef MK_CUTS
#define MK_CUTS 1
#endif
constexpr float EPS = 1e-6f;
constexpr float LOG2E = 1.4426950408889634f;
constexpr float MLA_QSCALE = 0.07216878364870322f * LOG2E;
constexpr float S_WIN = 64.f, S_PAB = 32.f, S_WOUT = 64.f, S_OA = 64.f, S_OB = 16.f, S_MRG = 16.f, S_Y = 128.f;
constexpr float NA_QSCALE = 0.08838834764831845f * LOG2E;

constexpr size_t MiB = 1u << 20;
constexpr size_t WS_CTL = 0, CTL_ZERO_BYTES = 1 * MiB;
constexpr size_t WS_ROPE = 1 * MiB;
constexpr size_t WS_RS = 1 * MiB + 65536;
constexpr size_t WS_WCAT = 2 * MiB;
constexpr size_t WS_WUQ = WS_WCAT + 124 * MiB;
constexpr size_t WS_WUKV = WS_WUQ + 5 * MiB;
constexpr size_t WS_PA = WS_WUKV + 4 * MiB;
constexpr size_t WS_PB = WS_PA + 16 * MiB;
constexpr size_t WS_WOUT = WS_PB + 16 * MiB;
constexpr size_t WS_WQ = WS_WOUT + 32 * MiB;
constexpr size_t WS_SUBH = WS_WQ + 16 * MiB;
constexpr size_t WS_SUBL = WS_SUBH + 512 * 1024;
constexpr size_t WS_R1 = WS_SUBL + 512 * 1024;
constexpr size_t WS_LAT = WS_R1 + 128 * MiB;
constexpr size_t WS_R2 = WS_LAT + 48 * MiB;
constexpr size_t WS_R3 = WS_R2 + 192 * MiB;
constexpr size_t WS_R4 = WS_R3 + 256 * MiB;
constexpr size_t WS_KR = WS_R4 + 224 * MiB;
constexpr size_t WS_IDX = WS_KR + 2 * MiB;
constexpr size_t WS_GATE = WS_IDX + 8 * MiB;
constexpr size_t WS_END = WS_GATE + 8 * MiB;
constexpr int CW_TMO = 0, CW_BAR = 4096;

constexpr int RING_BYTES = 131072, LDSCTL_OFF = RING_BYTES, MISC_OFF = LDSCTL_OFF + 320, LDS_BYTES = 147456;
constexpr int NWAVES = 8;

#define GAS __attribute__((address_space(1)))
#define LAS __attribute__((address_space(3)))
typedef unsigned short bf16;
typedef unsigned v4u __attribute__((ext_vector_type(4)));
typedef float f32x4 __attribute__((ext_vector_type(4)));
typedef float f32x8 __attribute__((ext_vector_type(8)));
typedef GAS unsigned gu32;
#define RLX_AGENT __ATOMIC_RELAXED, __HIP_MEMORY_SCOPE_AGENT
#define LDS_WAIT() asm volatile("s_waitcnt lgkmcnt(0)" ::: "memory")
#define VM_WAIT() asm volatile("s_waitcnt vmcnt(0)" ::: "memory")
__device__ __forceinline__ unsigned pkbf(float lo, float hi) { unsigned r; asm volatile("v_cvt_pk_bf16_f32 %0, %1, %2" : "=v"(r) : "v"(lo), "v"(hi)); return r; }

#define XB_TMO      128
#define XB_XCNT(j)  (256  + 64 * (j))
#define XB_XSUB(j)  (1280 + 64 * (j))
#define XB_XGEN(j)  (2304 + 64 * (j))
#define XB_TOP      3328
#define XB_TOPGEN   3392
#define XCD_BAR_WORDS 3456
#define XB_SPIN_CAP (1u << 22)
__device__ __forceinline__ unsigned xb_ld(unsigned* p)              { return __hip_atomic_load(p, __ATOMIC_RELAXED, __HIP_MEMORY_SCOPE_AGENT); }
__device__ __forceinline__ unsigned xb_add(unsigned* p, unsigned v) { return __hip_atomic_fetch_add(p, v, __ATOMIC_RELAXED, __HIP_MEMORY_SCOPE_AGENT); }
__device__ __forceinline__ unsigned xb_xcc_id() { return (unsigned)__builtin_amdgcn_s_getreg((3 << 11) | 20) & 0xFu; }
#define XB_SPIN(cond, bar) do { unsigned _sp = 0; while (cond) { __builtin_amdgcn_s_sleep(1); \
    if ((++_sp & 255u) == 0u) { if (xb_ld(&(bar)[XB_TMO])) break; if (_sp > XB_SPIN_CAP) { atomicAdd(&(bar)[XB_TMO], 1u); break; } } } } while (0)
struct XcdBarrier { unsigned* bar; unsigned x; volatile LAS unsigned* st; };
__device__ __forceinline__ XcdBarrier xcd_barrier_post(unsigned* bar, volatile LAS unsigned* st) {
    XcdBarrier b; b.bar = bar; b.x = xb_xcc_id(); b.st = st;
    if (threadIdx.x == 0) (void)xb_add(&bar[XB_XCNT(b.x)], 1u);
    return b;
}
__device__ __forceinline__ void xcd_barrier_complete(unsigned* bar, unsigned x, unsigned& nloc, unsigned& nx) {
    const unsigned G = gridDim.x * gridDim.y * gridDim.z;
    unsigned sum, cnt, mine, sp = 0u;
    for (;;) {
        sum = 0u; cnt = 0u; mine = 0u;
#pragma unroll
        for (unsigned j = 0; j < 16; ++j) { const unsigned c = xb_ld(&bar[XB_XCNT(j)]); sum += c; cnt += (c > 0u) ? 1u : 0u; mine = (j == x) ? c : mine; }
        if (sum == G) break;
        __builtin_amdgcn_s_sleep(1);
        if ((++sp & 255u) == 0u) { if (xb_ld(&bar[XB_TMO])) break; if (sp > XB_SPIN_CAP) { atomicAdd(&bar[XB_TMO], 1u); break; } }
    }
    nloc = mine > 0u ? mine : 1u; nx = cnt > 0u ? cnt : 1u;
}
__device__ __forceinline__ void xcd_barrier(const XcdBarrier& b) {
    asm volatile("s_waitcnt vmcnt(0)" ::: "memory");
    __syncthreads();
    if (threadIdx.x == 0) {
        unsigned* bar = b.bar;
        __builtin_amdgcn_s_waitcnt(0);
        unsigned nloc = b.st[0], nx = b.st[1];
        if (nloc == 0u) { xcd_barrier_complete(bar, b.x, nloc, nx); b.st[0] = nloc; b.st[1] = nx; }
        const unsigned old = xb_add(&bar[XB_XSUB(b.x)], 1u);
        const unsigned gen = old / nloc;
        if (old + 1u == (gen + 1u) * nloc) {
            __builtin_amdgcn_fence(__ATOMIC_RELEASE, "agent");
            asm volatile("s_waitcnt vmcnt(0)" ::: "memory");
            const unsigned og = xb_add(&bar[XB_TOP], 1u);
            const unsigned tg = og / nx;
            if (og + 1u == (tg + 1u) * nx) xb_add(&bar[XB_TOPGEN], 1u);
            else XB_SPIN(xb_ld(&bar[XB_TOPGEN]) == tg, bar);
            __builtin_amdgcn_fence(__ATOMIC_ACQUIRE, "agent");
            xb_add(&bar[XB_XGEN(b.x)], 1u);
            asm volatile("s_waitcnt vmcnt(0)" ::: "memory");
        } else {
            XB_SPIN(xb_ld(&bar[XB_XGEN(b.x)]) == gen, bar);
            __builtin_amdgcn_fence(__ATOMIC_ACQUIRE, "agent");
            asm volatile("s_waitcnt vmcnt(0)" ::: "memory");
        }
    }
    __syncthreads();
}

__device__ __forceinline__ float wave_sum(float v) {
#pragma unroll
    for (int o = 1; o < 64; o <<= 1) v += __shfl_xor(v, o);
    return v;
}
__device__ __forceinline__ void transpose_item(const float* W, int N, bf16* WT, int ldt, int row_off, const float* gk, LAS float* scr, int kb, int nb, int lane) {
    const int k0 = 64 * kb, n0 = 32 * nb;
    { f32x4 v[8]; const int r8 = lane >> 3, c4 = (lane & 7) * 4;
#pragma unroll
      for (int i = 0; i < 8; ++i) v[i] = *(const GAS f32x4*)(W + (size_t)(k0 + 8 * i + r8) * N + n0 + c4);
#pragma unroll
      for (int i = 0; i < 8; ++i) { const int kk = 8 * i + r8; const float g = gk ? gk[k0 + kk] : 1.0f; LAS float* d = scr + kk * 33 + c4; d[0] = v[i].x * g; d[1] = v[i].y * g; d[2] = v[i].z * g; d[3] = v[i].w * g; } }
    LDS_WAIT(); asm volatile("" ::: "memory");
    const int c = lane & 7;
#pragma unroll
    for (int j = 0; j < 4; ++j) { const int n = (lane >> 3) + 8 * j; const LAS float* s = scr + (8 * c) * 33 + n;
        v4u o; o.x = pkbf(s[0 * 33], s[1 * 33]); o.y = pkbf(s[2 * 33], s[3 * 33]); o.z = pkbf(s[4 * 33], s[5 * 33]); o.w = pkbf(s[6 * 33], s[7 * 33]);
        *(GAS v4u*)(WT + (size_t)(row_off + n0 + n) * ldt + k0 + 8 * c) = o; }
    LDS_WAIT(); asm volatile("" ::: "memory");
}
__device__ __forceinline__ void rms_rowbf_to_bf16(const bf16* xrow, const float* gain, bf16* orow, unsigned* hhi, unsigned* hlo, float s8, int lane) {
    const GAS pg8::u32x4* xr = (const GAS pg8::u32x4*)xrow + lane; const GAS f32x4* gr = (const GAS f32x4*)gain + 2 * lane;
    pg8::u32x4 v[8]; float s = 0.f;
#pragma unroll
    for (int j = 0; j < 8; ++j) { v[j] = xr[64 * j];
#pragma unroll
        for (int i = 0; i < 4; ++i) { const float a = __uint_as_float(v[j][i] << 16), b = __uint_as_float(v[j][i] & 0xffff0000u); s += a * a + b * b; } }
    const float rstd = 1.f / sqrtf(wave_sum(s) * (1.f / DM) + EPS);
    GAS pg8::u32x4* o = (GAS pg8::u32x4*)orow + lane;
#pragma unroll
    for (int j = 0; j < 8; ++j) { const f32x4 g0 = gr[128 * j], g1 = gr[128 * j + 1]; pg8::u32x4 w;
        w.x = pkbf(__uint_as_float(v[j].x << 16) * rstd * g0.x, __uint_as_float(v[j].x & 0xffff0000u) * rstd * g0.y); w.y = pkbf(__uint_as_float(v[j].y << 16) * rstd * g0.z, __uint_as_float(v[j].y & 0xffff0000u) * rstd * g0.w);
        w.z = pkbf(__uint_as_float(v[j].z << 16) * rstd * g1.x, __uint_as_float(v[j].z & 0xffff0000u) * rstd * g1.y); w.w = pkbf(__uint_as_float(v[j].w << 16) * rstd * g1.z, __uint_as_float(v[j].w & 0xffff0000u) * rstd * g1.w);
        o[64 * j] = w;
        { const float q0 = rstd * s8; unsigned wh = 0, wl = 0;
          const float e_[8] = {__uint_as_float(v[j].x << 16) * q0 * g0.x, __uint_as_float(v[j].x & 0xffff0000u) * q0 * g0.y, __uint_as_float(v[j].y << 16) * q0 * g0.z, __uint_as_float(v[j].y & 0xffff0000u) * q0 * g0.w,
                               __uint_as_float(v[j].z << 16) * q0 * g1.x, __uint_as_float(v[j].z & 0xffff0000u) * q0 * g1.y, __uint_as_float(v[j].w << 16) * q0 * g1.z, __uint_as_float(v[j].w & 0xffff0000u) * q0 * g1.w};
#pragma unroll
          for (int i = 0; i < 8; ++i) { const int q = (int)__builtin_rintf(__builtin_amdgcn_fmed3f(e_[i], -128.0f, 119.0f)); const int lo = ((q + 8) & 15) - 8, hi = (q - lo) >> 4;
            wh |= ((unsigned)hi & 15u) << (4 * i); wl |= ((unsigned)lo & 15u) << (4 * i); }
          hhi[lane + 64 * j] = wh; hlo[lane + 64 * j] = wl; } }
}
__device__ __forceinline__ void rms_row_to_bf16(const float* xrow, const float* gain, bf16* orow, int lane) {
    const GAS f32x4* xr = (const GAS f32x4*)xrow + lane; const GAS f32x4* gr = (const GAS f32x4*)gain + lane;
    f32x4 v[16]; float s = 0.f;
#pragma unroll
    for (int j = 0; j < 16; ++j) { v[j] = xr[64 * j]; s += (v[j].x * v[j].x + v[j].y * v[j].y) + (v[j].z * v[j].z + v[j].w * v[j].w); }
    const float rstd = 1.f / sqrtf(wave_sum(s) * (1.f / DM) + EPS);
    GAS unsigned long long* o8 = (GAS unsigned long long*)orow + lane;
#pragma unroll
    for (int j = 0; j < 16; ++j) { const f32x4 g = gr[64 * j];
        o8[64 * j] = (unsigned long long)pkbf(v[j].x * rstd * g.x, v[j].y * rstd * g.y) | ((unsigned long long)pkbf(v[j].z * rstd * g.z, v[j].w * rstd * g.w) << 32); }
}

__device__ __forceinline__ unsigned pk4f8(float a, float b, float c, float d) { int w = __builtin_amdgcn_cvt_pk_fp8_f32(a, b, 0, false); w = __builtin_amdgcn_cvt_pk_fp8_f32(c, d, w, true); return (unsigned)w; }
__device__ __forceinline__ void transpose_item8(const float* W, int N, unsigned char* WT, int ldt, int row_off, float scale, LAS float* scr, int kb, int nb, int lane) {
    const int k0 = 64 * kb, n0 = 32 * nb;
    { f32x4 v[8]; const int r8 = lane >> 3, c4 = (lane & 7) * 4;
#pragma unroll
      for (int i = 0; i < 8; ++i) v[i] = *(const GAS f32x4*)(W + (size_t)(k0 + 8 * i + r8) * N + n0 + c4);
#pragma unroll
      for (int i = 0; i < 8; ++i) { LAS float* d = scr + (8 * i + r8) * 33 + c4; d[0] = v[i].x * scale; d[1] = v[i].y * scale; d[2] = v[i].z * scale; d[3] = v[i].w * scale; } }
    LDS_WAIT(); asm volatile("" ::: "memory");
    const int n = lane >> 1, kh = (lane & 1) * 32; const LAS float* s = scr + kh * 33 + n;
#pragma unroll
    for (int j = 0; j < 2; ++j) { v4u o;
        o.x = pk4f8(s[(16 * j + 0) * 33], s[(16 * j + 1) * 33], s[(16 * j + 2) * 33], s[(16 * j + 3) * 33]); o.y = pk4f8(s[(16 * j + 4) * 33], s[(16 * j + 5) * 33], s[(16 * j + 6) * 33], s[(16 * j + 7) * 33]);
        o.z = pk4f8(s[(16 * j + 8) * 33], s[(16 * j + 9) * 33], s[(16 * j + 10) * 33], s[(16 * j + 11) * 33]); o.w = pk4f8(s[(16 * j + 12) * 33], s[(16 * j + 13) * 33], s[(16 * j + 14) * 33], s[(16 * j + 15) * 33]);
        *(GAS v4u*)(WT + (size_t)(row_off + n0 + n) * ldt + k0 + kh + 16 * j) = o; }
    LDS_WAIT(); asm volatile("" ::: "memory");
}
__device__ __forceinline__ void rms_row_to_fp8(const float* xrow, const float* gain, unsigned char* orow, int lane) {
    const GAS f32x4* xr = (const GAS f32x4*)xrow + lane; const GAS f32x4* gr = (const GAS f32x4*)gain + lane;
    f32x4 v[16]; float s = 0.f;
#pragma unroll
    for (int j = 0; j < 16; ++j) { v[j] = xr[64 * j]; s += (v[j].x * v[j].x + v[j].y * v[j].y) + (v[j].z * v[j].z + v[j].w * v[j].w); }
    const float rstd = 1.f / sqrtf(wave_sum(s) * (1.f / DM) + EPS);
    GAS unsigned* o4 = (GAS unsigned*)orow + lane;
#pragma unroll
    for (int j = 0; j < 16; ++j) { const f32x4 g = gr[64 * j]; o4[64 * j] = pk4f8(v[j].x * rstd * g.x, v[j].y * rstd * g.y, v[j].z * rstd * g.z, v[j].w * rstd * g.w); }
}

struct Args {
    const float* in[19]; float* out; unsigned char* ws; int ph_lo, ph_hi, use_bar, pad;
};

__global__ void __launch_bounds__(NWAVES * 64, 2) mk_fwd(Args args) {
    extern __shared__ __attribute__((aligned(16))) unsigned char lds[];
    LAS unsigned char* ldsl = (LAS unsigned char*)lds;
    volatile LAS unsigned* MISC = (volatile LAS unsigned*)(ldsl + MISC_OFF);
    const int tid = threadIdx.x, lane = tid & 63, wave = __builtin_amdgcn_readfirstlane(tid >> 6);
    const int G = gridDim.x, bx = blockIdx.x;
    const int vcu = (G % 8 == 0) ? (bx % 8) * (G / 8) + bx / 8 : bx;
    const int gw = vcu * NWAVES + wave, NGW = G * NWAVES;
    unsigned char* ws = args.ws;
    gu32* ctl = (gu32*)(ws + WS_CTL);
    const float* x = args.in[0]; const float* attn_norm = args.in[1]; const float* w_in = args.in[2]; const float* q_norm = args.in[3]; const float* w_uq = args.in[4];
    const float* kv_norm = args.in[5]; const float* w_ukv = args.in[6]; const float* w_bmla = args.in[7]; const float* na_rpb = args.in[8]; const float* w_bna = args.in[9];
    const float* w_gate = args.in[10]; const float* b_gate = args.in[11]; const float* w_out = args.in[12]; const float* ffn_norm = args.in[13]; const float* peer_wq = args.in[14];
    const float* peer_sub = args.in[15]; const float* peer_u = args.in[16]; const float* peer_v = args.in[17]; const float* final_norm = args.in[18];
    float* out = args.out;
    float* ROPE = (float*)(ws + WS_ROPE); float* RS = (float*)(ws + WS_RS);
    bf16* WCAT = (bf16*)(ws + WS_WCAT); bf16* WUQ = (bf16*)(ws + WS_WUQ); bf16* WUKV = (bf16*)(ws + WS_WUKV); bf16* PA = (bf16*)(ws + WS_PA); bf16* PB = (bf16*)(ws + WS_PB);
    bf16* WOUT = (bf16*)(ws + WS_WOUT); bf16* WQ = (bf16*)(ws + WS_WQ); bf16* SUBH = (bf16*)(ws + WS_SUBH); bf16* SUBL = (bf16*)(ws + WS_SUBL);
    unsigned char* XN8 = ws + WS_R1; unsigned char* OA8 = ws + WS_R1; unsigned char* OB8 = ws + WS_R1 + 32 * MiB; bf16* H2 = (bf16*)(ws + WS_R1);
    bf16* LAT = (bf16*)(ws + WS_LAT);
    bf16* NAQ = (bf16*)(ws + WS_R2); bf16* NAK = (bf16*)(ws + WS_R2 + 64 * MiB); bf16* NAV = (bf16*)(ws + WS_R2 + 128 * MiB); unsigned char* Y8 = ws + WS_R2; unsigned char* MRG8 = ws + WS_R2 + 128 * MiB;
    const unsigned char* G8 = ws + WS_R3; bf16* X1B = (bf16*)(ws + WS_R3 + 128 * MiB); unsigned char* HHI = ws + WS_R2 + 128 * MiB; unsigned char* HLO = ws + WS_R2 + 160 * MiB;     unsigned char* U8 = ws + WS_R3; unsigned char* V8 = ws + WS_R3 + 64 * MiB;
    unsigned char* Q8 = ws + WS_R4; unsigned char* K8 = ws + WS_R4 + 48 * MiB; unsigned char* VT8 = ws + WS_R4 + 96 * MiB; float* QP = (float*)(ws + WS_R4);
    bf16* KR = (bf16*)(ws + WS_KR); int* IDX = (int*)(ws + WS_IDX); float* GATE = (float*)(ws + WS_GATE);

    for (int u = tid; u < (LDS_BYTES - LDSCTL_OFF) / 4; u += NWAVES * 64) ((LAS unsigned*)(ldsl + LDSCTL_OFF))[u] = 0u;
    __syncthreads();
    XcdBarrier bar; bar.bar = (unsigned*)(ctl + CW_BAR); bar.x = 0; bar.st = nullptr;
    if (args.use_bar) bar = xcd_barrier_post((unsigned*)(ctl + CW_BAR), MISC + 8);
    const int lo = args.ph_lo, hi = args.ph_hi;
#ifndef MK_PHMASK
#define MK_PHMASK 0xFFF
#endif
#define IN(k) (((MK_PHMASK >> (k)) & 1) && lo <= (k) && (k) < hi)
#ifndef MK_VAR
#define MK_VAR 0
#endif
#ifndef MK_DUP4
#define MK_DUP4 0
#endif
#ifndef MK_FAKE
#define MK_FAKE false
#endif
#ifndef MK_DUP
#define MK_DUP -1
#endif
#define REPS(k) ((MK_DUP == (k)) ? 2 : 1)
#define SEAM(k) do { if (IN(k) && IN((k) + 1)) xcd_barrier(bar); } while (0)

    for (int rep_ = 0; rep_ < REPS(0); ++rep_) if (IN(0)) {
        LAS float* scr = (LAS float*)(ldsl + wave * 16384);
        constexpr int I0 = 64 * 234, I1 = 64 * 256, I2 = 12 * 96, I3 = 8 * 128, I4 = 32 * 128, I5 = 32 * 128, I6 = 64 * 128, I7 = 64 * 64;
        constexpr int NITEMS = I0 + I1 + I2 + I3 + I4 + I5 + I6 + I7;
        for (int it = gw; it < NITEMS; it += NGW) {
            int r = it;
            if (r < I0) { const int kb = r / 234, nb = r % 234; const int off = (nb >= 42) ? 192 : 0; transpose_item8(w_in, 7488, (unsigned char*)WCAT, 4096, off, S_WIN, scr, kb, nb, lane); continue; } r -= I0;
            if (r < I1) { transpose_item8(w_gate, 8192, (unsigned char*)WCAT, 4096, 7680, S_WIN, scr, r / 256, r % 256, lane); continue; } r -= I1;
            if (r < I2) { transpose_item(w_uq, 3072, WUQ, 768, 0, q_norm, scr, r / 96, r % 96, lane); continue; } r -= I2;
            if (r < I3) { transpose_item(w_ukv, 4096, WUKV, 512, 0, kv_norm, scr, r / 128, r % 128, lane); continue; } r -= I3;
            if (r < I4) { transpose_item8(w_bmla, 4096, (unsigned char*)PA, 2048, 0, S_PAB, scr, r / 128, r % 128, lane); continue; } r -= I4;
            if (r < I5) { transpose_item8(w_bna, 4096, (unsigned char*)PB, 2048, 0, S_PAB, scr, r / 128, r % 128, lane); continue; } r -= I5;
            if (r < I6) { transpose_item8(w_out, 4096, (unsigned char*)WOUT, 4096, 0, S_WOUT, scr, r / 128, r % 128, lane); continue; } r -= I6;
            transpose_item(peer_wq, 2048, WQ, 4096, 0, nullptr, scr, r / 64, r % 64, lane);
        }
        for (int i = gw * 64 + lane; i < 192 * 4096 / 16; i += NGW * 64) ((GAS v4u*)((unsigned char*)WCAT + (size_t)1344 * 4096))[i] = (v4u){0u, 0u, 0u, 0u};
        for (int i = gw * 64 + lane; i < 8 * 2 * 128 * 128 / 2; i += NGW * 64) { const float a = peer_sub[2 * i], b = peer_sub[2 * i + 1];
            const unsigned h = pkbf(a, b); const unsigned l = pkbf(a - __uint_as_float(h << 16), b - __uint_as_float(h & 0xffff0000u));
            ((GAS unsigned*)SUBH)[i] = h; ((GAS unsigned*)SUBL)[i] = l; }
        for (int i = gw * 64 + lane; i < 128 * 16; i += NGW * 64) { const int pos = i >> 4, j = i & 15; const float fr = powf(10000.0f, -(float)j / 16.0f); const float ang = (float)pos * fr;
            ROPE[2 * i] = cosf(ang); ROPE[2 * i + 1] = sinf(ang); }
        for (int m = gw; m < T; m += NGW) rms_row_to_fp8(x + (size_t)m * DM, attn_norm, XN8 + (size_t)m * DM, lane);
    }
    SEAM(0);
    for (int rep_ = 0; rep_ < REPS(1); ++rep_) if (IN(1)) {
        pg8::Gemm g{(const bf16*)XN8, WCAT, T, NCAT, DM, DM, DM}; pg8::StaticOrder S; S.init(T, NCAT, G, bx);
        pg8::EpiIn E{ws, WS_LAT, WS_R2, 64 * MiB, WS_R3, b_gate, NA_QSCALE, 1.0f / S_WIN};
        pg8::gemm_phase<pg8::EpiIn, pg8::StaticOrder, true, true>(ldsl, g, S, E);
    }
    SEAM(1);
    for (int rep_ = 0; rep_ < REPS(2); ++rep_) if (IN(2)) {
        for (int m = gw; m < T; m += NGW) {
            const bf16* row = LAT + (size_t)m * 1536;
            float sq = 0.f, skv = 0.f;
#pragma unroll
            for (int j = 0; j < 6; ++j) { const unsigned w = ((const GAS unsigned*)row)[lane + 64 * j]; const float a = __uint_as_float(w << 16), b = __uint_as_float(w & 0xffff0000u); sq += a * a + b * b; }
#pragma unroll
            for (int j = 0; j < 4; ++j) { const unsigned w = ((const GAS unsigned*)(row + 768))[lane + 64 * j]; const float a = __uint_as_float(w << 16), b = __uint_as_float(w & 0xffff0000u); skv += a * a + b * b; }
            sq = wave_sum(sq); skv = wave_sum(skv);
            if (lane == 0) { RS[2 * m] = 1.f / sqrtf(sq * (1.f / 768.f) + EPS); RS[2 * m + 1] = 1.f / sqrtf(skv * (1.f / 512.f) + EPS); }
            const float xk = __uint_as_float((unsigned)row[1280 + lane] << 16);
            const float xp = __shfl_xor(xk, 16);
            const int s = m & (SEQ - 1), pos = (lane < 32) ? (s >> 6) : (s & 63), j = lane & 15;
            const float c = ROPE[(pos * 16 + j) * 2], sn = ROPE[(pos * 16 + j) * 2 + 1];
            const float o = ((lane & 16) == 0) ? (xk * c - xp * sn) : (xp * sn + xk * c);
            KR[(size_t)m * 64 + lane] = (bf16)(pkbf(o, 0.f) & 0xffffu);
            { const unsigned char o8 = (unsigned char)(__builtin_amdgcn_cvt_pk_fp8_f32(o, 0.f, 0, false) & 0xff);
#pragma unroll
              for (int hh = 0; hh < 16; ++hh) K8[((size_t)m * 16 + hh) * 192 + 128 + lane] = o8; }
        }
    }
    SEAM(2);
    for (int rep_ = 0; rep_ < REPS(3); ++rep_) if (IN(3)) {
        { pg8::Gemm g{LAT, WUQ, T, 3072, 768, 1536, 768}; pg8::StaticOrder S; S.init(T, 3072, G, bx);
          pg8::EpiQ8 E{Q8, RS, ROPE, MLA_QSCALE * att8::SQ8};
          pg8::gemm_phase<pg8::EpiQ8, pg8::StaticOrder>(ldsl, g, S, E); }
        { pg8::Gemm g{LAT + 768, WUKV, T, 4096, 512, 1536, 512}; pg8::StaticOrder S; S.init(T, 4096, G, bx);
          pg8::EpiKV8 E{K8, VT8, RS};
          pg8::gemm_phase<pg8::EpiKV8, pg8::StaticOrder>(ldsl, g, S, E); }
    }
    SEAM(3);
    for (int rep_ = 0; rep_ < REPS(4); ++rep_) if (IN(4)) {
#ifndef NO_MLA
        if (!(MK_DUP == 4 && rep_ == 0 && MK_DUP4 == 2))
#pragma unroll 1
        for (int u = vcu; u < BATCH * 16 * 32; u += G) { const int bh = u >> 5, qb = u & 31; if (MK_DUP == 4 && rep_ == 0) att8::mla8_unit<MK_VAR>(bh >> 4, bh & 15, qb, Q8, K8, VT8, OA8, S_OA, (char*)lds, (unsigned*)(ctl + 8200)); else att8::mla8_unit<0>(bh >> 4, bh & 15, qb, Q8, K8, VT8, OA8, S_OA, (char*)lds); }
#endif
#ifndef NO_NA
        if (!(MK_DUP == 4 && rep_ == 0 && MK_DUP4 == 1))
#pragma unroll 1
        for (int u = vcu; u < BATCH * 16 * 32; u += G) { const int bh = u >> 5, rg = u & 31; if (MK_DUP == 4 && rep_ == 0) att::na_unit<MK_VAR>(bh >> 4, bh & 15, rg, NAQ, NAK, NAV, na_rpb, OB8, S_OB, (char*)lds); else att::na_unit<0>(bh >> 4, bh & 15, rg, NAQ, NAK, NAV, na_rpb, OB8, S_OB, (char*)lds); }
#endif
        __syncthreads();
    }
    SEAM(4);

#ifdef MK_CHECK
    {
        xcd_barrier(bar);
        gu32* chk = ctl + 8192;
        const float* xin_q_norm = q_norm; const float* xin_kv_norm = kv_norm;
#define F8DEC(byte) __builtin_amdgcn_cvt_f32_fp8((int)(byte), 0)
        if (bx < 8 && wave == 0) {
            const int ts[8] = {0, 37, 1000, 8191, 8192 + 5, 12345, 16000, 16383}; const int m = ts[bx];
            const bf16* row = LAT + (size_t)m * 1536; float sq = 0.f, skv = 0.f;
            for (int k = lane; k < 768; k += 64) { const float a = __uint_as_float((unsigned)row[k] << 16); sq += a * a; }
            for (int k = lane; k < 512; k += 64) { const float a = __uint_as_float((unsigned)row[768 + k] << 16); skv += a * a; }
            sq = wave_sum(sq); skv = wave_sum(skv);
            const float rq = 1.f / sqrtf(sq / 768.f + EPS), rkv = 1.f / sqrtf(skv / 512.f + EPS);
            float err = fmaxf(fabsf(RS[2 * m] - rq) / rq, fabsf(RS[2 * m + 1] - rkv) / rkv);
            const int s_ = m & (SEQ - 1), half = lane >> 5, j = lane & 15, hiq = (lane >> 4) & 1; const float pos = half ? (float)(s_ & 63) : (float)(s_ >> 6);
            const float ang = pos * powf(10000.0f, -(float)j / 16.0f), cs = cosf(ang), sn = sinf(ang);
            const float x1 = __uint_as_float((unsigned)row[1280 + half * 32 + j] << 16), x2 = __uint_as_float((unsigned)row[1280 + half * 32 + 16 + j] << 16);
            const float ref = hiq ? (x1 * sn + x2 * cs) : (x1 * cs - x2 * sn);
            const float got = __uint_as_float((unsigned)KR[(size_t)m * 64 + lane] << 16);
            float e2 = fabsf(got - ref); e2 = fmaxf(e2, __shfl_xor(e2, 1)); e2 = fmaxf(e2, __shfl_xor(e2, 2)); e2 = fmaxf(e2, __shfl_xor(e2, 4)); e2 = fmaxf(e2, __shfl_xor(e2, 8)); e2 = fmaxf(e2, __shfl_xor(e2, 16)); e2 = fmaxf(e2, __shfl_xor(e2, 32));
            err = fmaxf(err, e2);
            { float e3 = fabsf(F8DEC(K8[((size_t)m * 16 + 5) * 192 + 128 + lane]) - ref) - 0.07f * fabsf(ref); e3 = fmaxf(e3, __shfl_xor(e3, 1)); e3 = fmaxf(e3, __shfl_xor(e3, 2)); e3 = fmaxf(e3, __shfl_xor(e3, 4)); e3 = fmaxf(e3, __shfl_xor(e3, 8)); e3 = fmaxf(e3, __shfl_xor(e3, 16)); e3 = fmaxf(e3, __shfl_xor(e3, 32)); err = fmaxf(err, e3 + 0.03f); }
            if (lane == 0 && !(err < 0.05f)) atomicOr((unsigned*)chk, 1u);
        }
        if (bx >= 8 && bx < 16 && wave == 0) {
            const int ts[4] = {3, 4099, 12345, 16300}; const int m = ts[(bx - 8) & 3] + ((bx - 8) >> 2) * 64;
            {
                const int head = (lane * 5) & 15, kind = lane % 6, i = (lane * 7) & 31; const int col = head * 192 + kind * 32 + i;
                const int pcol = (kind >= 4) ? (head * 192 + kind * 32 + (i ^ 16)) : col;
                const bf16* row = LAT + (size_t)m * 1536; float a = 0.f, b = 0.f, sq = 0.f;
                for (int k = 0; k < 768; ++k) { const float c = __uint_as_float((unsigned)row[k] << 16); sq += c * c; const float cg = c * xin_q_norm[k]; a += cg * w_uq[(size_t)k * 3072 + col]; b += cg * w_uq[(size_t)k * 3072 + pcol]; }
                const float rq = 1.f / sqrtf(sq / 768.f + EPS); a *= rq; b *= rq; float ref = a;
                if (kind >= 4) { const int s_ = m & (SEQ - 1); const float pos = (kind == 4) ? (float)(s_ >> 6) : (float)(s_ & 63); const int j = i & 15; const float ang = pos * powf(10000.0f, -(float)j / 16.0f), cs = cosf(ang), sn = sinf(ang);
                    ref = (i < 16) ? (a * cs - b * sn) : (b * sn + a * cs); }
                ref *= MLA_QSCALE;
                const float got = F8DEC(Q8[(size_t)m * 3072 + col]) * (1.0f / att8::SQ8);
                if (!(fabsf(got - ref) < 0.08f * (0.03f + fabsf(ref)))) atomicOr((unsigned*)chk + 1, 1u);
            }
            {
                const int col = (lane * 67 + 13) & 4095; const bf16* row = LAT + (size_t)m * 1536 + 768; float a = 0.f, sq = 0.f;
                for (int k = 0; k < 512; ++k) { const float c = __uint_as_float((unsigned)row[k] << 16); sq += c * c; a += c * xin_kv_norm[k] * w_ukv[(size_t)k * 4096 + col]; }
                a *= 1.f / sqrtf(sq / 512.f + EPS);
                const int h = col >> 8, c = col & 255;
                const float got = (c < 128) ? F8DEC(K8[((size_t)m * 16 + h) * 192 + c]) : F8DEC(VT8[((size_t)((m >> 13) * 16 + h) * 128 + (c - 128)) * 8192 + (m & 8191)]);
                if (!(fabsf(got - a) < 0.08f * (0.2f + fabsf(a)))) atomicOr((unsigned*)chk + 2, 1u);
            }
        }
        if (bx >= 16 && bx < 48) {
            const int si = bx - 16; const int ts[8] = {1, 255, 256, 4097, 8190, 8192 + 77, 12000, 16383}; const int m = ts[si & 7], h = (si * 5 + (si >> 3) * 3) & 15;
            const int b = m >> 13; LAS float* sc = (LAS float*)ldsl; LAS float* red = sc + 8192; LAS float* qs = red + 512;
            if (tid < 192) qs[tid] = F8DEC(Q8[(size_t)m * 3072 + h * 192 + tid]) * (1.0f / att8::SQ8);
            __syncthreads();
            float mx = -1e30f;
            for (int k = tid; k < SEQ; k += 512) { const size_t kt = (size_t)b * SEQ + k; float s_ = 0.f;
                for (int d = 0; d < 192; ++d) s_ += qs[d] * F8DEC(K8[(kt * 16 + h) * 192 + d]);
                sc[k] = s_; mx = fmaxf(mx, s_); }
            red[tid] = mx; __syncthreads();
            for (int o = 256; o > 0; o >>= 1) { if (tid < o) red[tid] = fmaxf(red[tid], red[tid + o]); __syncthreads(); }
            mx = red[0]; __syncthreads();
            float sm = 0.f;
            for (int k = tid; k < SEQ; k += 512) { const float p_ = exp2f(sc[k] - mx); sc[k] = p_; sm += p_; }
            red[tid] = sm; __syncthreads();
            for (int o = 256; o > 0; o >>= 1) { if (tid < o) red[tid] += red[tid + o]; __syncthreads(); }
            sm = red[0]; __syncthreads();
            const int d = tid & 127, part = tid >> 7; float acc_ = 0.f;
            for (int k = part * 2048; k < (part + 1) * 2048; ++k) acc_ += sc[k] * F8DEC(VT8[((size_t)(b * 16 + h) * 128 + d) * 8192 + k]);
            red[tid] = acc_; __syncthreads();
            float e2 = 0.f, r2 = 0.f;
            if (tid < 128) { const float ref = (red[tid] + red[tid + 128] + red[tid + 256] + red[tid + 384]) / sm;
                const int w_ = (int)OA8[(size_t)m * 2048 + h * 128 + tid]; const float got = __builtin_amdgcn_cvt_f32_fp8(w_, 0) * (1.0f / S_OA);
                e2 = (got - ref) * (got - ref); r2 = ref * ref; }
            __syncthreads();
            if (tid < 128) { red[tid] = e2; red[128 + tid] = r2; }
            __syncthreads();
            if (tid == 0) { float se = 0.f, sr = 0.f; for (int i = 0; i < 128; ++i) { se += red[i]; sr += red[128 + i]; }
                if (!(se < 0.01f * sr)) atomicOr((unsigned*)chk + 3, 1u); }
            __syncthreads();
        }
#undef F8DEC
        xcd_barrier(bar);
    }
#endif
    for (int rep_ = 0; rep_ < REPS(5); ++rep_) if (IN(5)) {
        { pg8::Gemm g{(const bf16*)OA8, PA, T, DM, 2048, 2048, 2048}; pg8::StaticOrder S; S.init(T, DM, G, bx);
          pg8::EpiGate<true> E{G8, Y8, nullptr, 1.0f / (S_OA * S_PAB * 256.0f), S_Y, 0.f};
          if (MK_DUP == 5 && rep_ == 0) pg8::gemm_phase<pg8::EpiGate<true>, pg8::StaticOrder, true, true, MK_VAR>(ldsl, g, S, E); else
          pg8::gemm_phase<pg8::EpiGate<true>, pg8::StaticOrder, true, true>(ldsl, g, S, E); }
    }
    for (int rep_ = 0; rep_ < REPS(6); ++rep_) if (IN(6)) {
        { pg8::Gemm g{(const bf16*)OB8, PB, T, DM, 2048, 2048, 2048}; pg8::StaticOrder S; S.init(T, DM, G, bx);
          pg8::EpiGate<false> E{G8, Y8, MRG8, 1.0f / (S_OB * S_PAB * 256.0f), S_Y, S_MRG};
          pg8::gemm_phase<pg8::EpiGate<false>, pg8::StaticOrder, true, true>(ldsl, g, S, E); }
    }
    SEAM(6);
    for (int rep_ = 0; rep_ < REPS(7); ++rep_) if (IN(7)) {
        pg8::Gemm g{(const bf16*)MRG8, WOUT, T, DM, DM, DM, DM}; pg8::StaticOrder S; S.init(T, DM, G, bx);
        pg8::EpiX1 E{x, X1B, 1.0f / (S_MRG * S_WOUT)};
        if (MK_DUP == 7 && rep_ == 0) pg8::gemm_phase<pg8::EpiX1, pg8::StaticOrder, true, true, MK_VAR>(ldsl, g, S, E); else
        pg8::gemm_phase<pg8::EpiX1, pg8::StaticOrder, true, true>(ldsl, g, S, E);
#ifdef PROBE_SKIP_ATTN
        VM_WAIT(); __syncthreads();
        for (size_t i = (size_t)gw * 64 + lane; i < (size_t)T * DM / 4; i += (size_t)NGW * 64) ((GAS f32x4*)out)[i] = ((const GAS f32x4*)x)[i];
#endif
    }
    SEAM(7);
    for (int rep_ = 0; rep_ < REPS(8); ++rep_) if (IN(8)) {
        for (int m = gw; m < T; m += NGW) rms_rowbf_to_bf16(X1B + (size_t)m * DM, ffn_norm, H2 + (size_t)m * DM, (unsigned*)(HHI + (size_t)m * 2048), (unsigned*)(HLO + (size_t)m * 2048), peer::H8ISCALE, lane);
    }
    SEAM(8);
    for (int rep_ = 0; rep_ < REPS(9); ++rep_) if (IN(9)) {
        pg8::Gemm g{H2, WQ, T, 2048, DM, DM, DM}; pg8::StaticOrder S; S.init(T, 2048, G, bx);
        pg8::EpiF32T<false> E{nullptr, QP, 2048, 1.0f};
        pg8::gemm_phase<pg8::EpiF32T<false>, pg8::StaticOrder>(ldsl, g, S, E);
    }
    SEAM(9);
    for (int rep_ = 0; rep_ < REPS(10); ++rep_) if (IN(10)) {
        LAS int* wl = (LAS int*)(ldsl + wave * peer::SEL_LDS_PER_WAVE);
#pragma unroll 1
        for (int pass = 0; pass < 2; ++pass) {
            if (((pass ^ wave) & 1) == 0) { for (int it = gw; it < (T / 32) * 8; it += NGW) peer::select32((it >> 3) * 32, it & 7, QP, SUBH, SUBL, IDX, GATE, wl, lane); }
            else { for (int r = gw; r < 2 * 16384; r += NGW) { const bool isu = r < 16384; const int e = isu ? r : r - 16384;
                if (isu) peer::pack_row_i4w(peer_u + (size_t)e * DM, U8, e, peer::U4ISCALE, lane); else peer::pack_row_fp4w(peer_v + (size_t)e * DM, V8, e, peer::V4SCALE, lane); } }
        }
    }
    SEAM(10);
    for (int rep_ = 0; rep_ < REPS(11); ++rep_) if (IN(11)) {
#ifdef PROBE_SKIP_PEER
        for (int t = gw; t < T; t += NGW) { float* xr = out + (size_t)t * DM; f32x4 v[16]; float ss = 0.f;
            for (int j = 0; j < 16; ++j) { v[j] = ((const GAS f32x4*)xr)[lane + 64 * j]; ss += v[j].x * v[j].x + v[j].y * v[j].y + v[j].z * v[j].z + v[j].w * v[j].w; }
            const float rstd = 1.f / sqrtf(wave_sum(ss) * (1.f / DM) + EPS);
            for (int j = 0; j < 16; ++j) { const f32x4 g = ((const GAS f32x4*)final_norm)[lane + 64 * j]; ((GAS f32x4*)xr)[lane + 64 * j] = v[j] * rstd * g; } }
#else
        if (MK_DUP == 11 && rep_ == 0) peer::expert_tokens4<false, MK_VAR>(gw, NGW, T, H2, U8, V8, IDX, GATE, (const unsigned short*)X1B, out, final_norm, lane);
        else peer::expert_tokens_w(HHI, HLO, U8, V8, IDX, GATE, (const unsigned short*)X1B, (unsigned short*)(ws + WS_R2), out, final_norm, (LAS float*)(ldsl + wave * 8192), lane, wave, T);
#endif
    }

#ifdef MK_CHECK
    {
        xcd_barrier(bar);
        gu32* chk = ctl + 8192;
        const unsigned f0 = __hip_atomic_load(chk, RLX_AGENT), f1 = __hip_atomic_load(chk + 1, RLX_AGENT), f2 = __hip_atomic_load(chk + 2, RLX_AGENT), f3 = __hip_atomic_load(chk + 3, RLX_AGENT);
        const int nz = (f0 ? T / 2 : 0) + (f1 ? T / 4 : 0) + (f2 ? T / 8 : 0) + (f3 ? T / 16 : 0);
        for (int m = gw; m < nz; m += NGW) for (int j = 0; j < 16; ++j) ((GAS f32x4*)(out + (size_t)m * DM))[lane + 64 * j] = (f32x4){0.f, 0.f, 0.f, 0.f};
    }
#endif

#ifdef MK_TSTAT
    {
        xcd_barrier(bar);
        const unsigned a = __hip_atomic_load(ctl + 8200, RLX_AGENT), b = __hip_atomic_load(ctl + 8201, RLX_AGENT), c = __hip_atomic_load(ctl + 8202, RLX_AGENT);
        const float tot = (float)a + (float)b + (float)c + 1.0f;
        const int d1 = (int)(10.0f * (float)(MK_TSTAT == 1 ? a : b) / tot), d2 = (int)(10.0f * (float)c / tot);
        const int nz = (int)((float)T * ((float)d1 * 0.1f + (float)d2 * 0.01f));
        for (int m = gw; m < nz; m += NGW) for (int j = 0; j < 16; ++j) ((GAS f32x4*)(out + (size_t)m * DM))[lane + 64 * j] = (f32x4){0.f, 0.f, 0.f, 0.f};
    }
#endif
#undef IN
#undef SEAM
}

extern "C" void kernel_launch(void* const* d_in, const int* in_sizes, int n_in, void* d_out, int out_size, void* d_ws, size_t ws_size, hipStream_t stream) {
    static int grid = 0;
    if (grid == 0) {
        if (n_in != 19 || out_size != T * DM || ws_size < WS_END) { fprintf(stderr, "kernel_launch: shape mismatch: n_in %d out %d ws %zu (need %zu)\n", n_in, out_size, ws_size, (size_t)WS_END); grid = -1; return; }
        int dev = 0, cus = 0, per_cu = 0;
        if (hipGetDevice(&dev) != hipSuccess || hipDeviceGetAttribute(&cus, hipDeviceAttributeMultiprocessorCount, dev) != hipSuccess) { grid = -1; return; }
        if (hipFuncSetAttribute((const void*)mk_fwd, hipFuncAttributeMaxDynamicSharedMemorySize, LDS_BYTES) != hipSuccess) { fprintf(stderr, "kernel_launch: hipFuncSetAttribute failed\n"); grid = -1; return; }
        if (hipOccupancyMaxActiveBlocksPerMultiprocessor(&per_cu, (const void*)mk_fwd, NWAVES * 64, LDS_BYTES) != hipSuccess || per_cu < 1) { fprintf(stderr, "kernel_launch: occupancy query says %d blocks per CU\n", per_cu); }
        (void)hipGetLastError();
        grid = cus;
    }
    if (grid < 0) return;
    if (hipMemsetAsync((char*)d_ws + WS_CTL, 0, CTL_ZERO_BYTES, stream) != hipSuccess) return;
    Args a{};
    for (int i = 0; i < 19; ++i) a.in[i] = (const float*)d_in[i];
    a.out = (float*)d_out; a.ws = (unsigned char*)d_ws; a.pad = 0;
    constexpr int NL = MK_CUTS;
    for (int li = 0; li < NL; ++li) {
        a.ph_lo = (NL == 1) ? 0 : li; a.ph_hi = (NL == 1) ? NPH : li + 1; a.use_bar = (NL == 1) ? 1 : 0;
        hipLaunchKernelGGL(mk_fwd, dim3(grid), dim3(NWAVES * 64), LDS_BYTES, stream, a);
    }
}
```

```cpp
#include <hip/hip_runtime.h>
#include <hip/hip_bf16.h>
#include <cstdio>
#include <cstdint>

namespace pg8 {
#define PG8_LAS __attribute__((address_space(3)))
typedef unsigned short bf16_t;
typedef short bf16x8 __attribute__((ext_vector_type(8)));
typedef float f32x4 __attribute__((ext_vector_type(4)));
typedef float f32x2 __attribute__((ext_vector_type(2)));
typedef unsigned u32x4 __attribute__((ext_vector_type(4)));
typedef unsigned u32x2 __attribute__((ext_vector_type(2)));
constexpr int BM = 256, BK = 64, HALF = 128, HTB = HALF * BK * 2  , STAGE_BYTES = 8 * HTB, NXCD = 8;

__host__ __device__ __forceinline__ int lds_byte(int r, int c) { const int st = (r >> 4) * 2 + (c >> 5), rr = r & 15, cc = c & 31, ob = rr * 64 + cc * 2; return st * 1024 + (ob ^ (((ob >> 9) & 1) << 5)); }
__host__ __device__ __forceinline__ void stage_rc(int b, int& R, int& C) { const int st = b / 1024, sb = b % 1024, swz = sb ^ (((sb >> 9) & 1) << 5); R = (st >> 1) * 16 + swz / 64; C = (st & 1) * 32 + (swz % 64) / 2; }
__host__ __device__ __forceinline__ int lds_byte8(int r, int cb) { const int st = (r >> 4) * 2 + (cb >> 6), ob = (r & 15) * 64 + (cb & 63); return st * 1024 + (ob ^ (((ob >> 9) & 1) << 4)); }
__host__ __device__ __forceinline__ void stage_rc8(int b, int& R, int& CB) { const int st = b / 1024, sb = b % 1024, swz = sb ^ (((sb >> 9) & 1) << 4); R = (st >> 1) * 16 + swz / 64; CB = (st & 1) * 64 + swz % 64; }
__host__ __device__ __forceinline__ int perm32(int rho) { const int n = rho >> 4, i = rho & 15; return 8 * (i >> 2) + 4 * n + (i & 3); }

struct Unit { int pm, pn; };
struct Gemm { const bf16_t* A; const bf16_t* Bt; int M, N, K, lda, ldb; };

template <int WGM> struct StaticOrderT {
    int nM, nN, nwg, G, c;
    __host__ __device__ void init(int M, int N, int G_, int c_) { nM = M / BM; nN = N / BM; nwg = nM * nN; G = G_; c = c_; }
    __host__ __device__ bool next(int i, Unit& u) const {
        const long L = (long)i * G + c; if (L >= nwg) return false;
        int wgid = (int)L; { const int q = nwg / NXCD, r = nwg % NXCD, xcd = wgid % NXCD, off = wgid / NXCD; wgid = (xcd < r ? xcd * (q + 1) : r * (q + 1) + (xcd - r) * q) + off; }
        const int nig = WGM * nN, gid = wgid / nig, fm = gid * WGM, gsz = (nM - fm) < WGM ? (nM - fm) : WGM;
        u.pm = fm + ((wgid % nig) % gsz); u.pn = (wgid % nig) / gsz; return true;
    }
    __device__ __forceinline__ void a_ready(const Unit&) const {}
    __device__ __forceinline__ void done(const Unit&) const {}
};
using StaticOrder = StaticOrderT<6>;

__device__ __forceinline__ unsigned cvt_pk_bf16(float lo, float hi) { unsigned r; asm volatile("v_cvt_pk_bf16_f32 %0, %1, %2" : "=v"(r) : "v"(lo), "v"(hi)); return r; }
__device__ __forceinline__ float bf_lo(unsigned w) { return __uint_as_float(w << 16); }
__device__ __forceinline__ float bf_hi(unsigned w) { return __uint_as_float(w & 0xffff0000u); }


typedef int v8i __attribute__((ext_vector_type(8)));
typedef int v4i __attribute__((ext_vector_type(4)));
typedef v8i v8i_a16 __attribute__((aligned(16)));
template <class Epi, class Sched, bool ALIGN_EPI = true, bool FP8 = false, int GV = 0>
__device__ __forceinline__ void gemm_phase(PG8_LAS unsigned char* lds, const Gemm g, const Sched& S, const Epi& E) {
    int tid_ = threadIdx.x; asm volatile("" : "+v"(tid_));
    const int tid = tid_, wid = __builtin_amdgcn_readfirstlane(tid >> 6), lane = tid & 63, wr = wid >> 2, wc = wid & 3, fr = lane & 15, fq = lane >> 4;
    const int K = g.K, nt = FP8 ? K / 128 : K / BK;
    unsigned voffA[2], voffB[2];
#pragma unroll
    for (int i = 0; i < 2; ++i) { int R, C; if constexpr (FP8) stage_rc8(tid * 16 + i * 8192, R, C); else stage_rc(tid * 16 + i * 8192, R, C); const int Rb = Epi::PERM ? ((R & ~31) + perm32(R & 31)) : R;
        voffA[i] = FP8 ? (unsigned)(R * g.lda + C) : (unsigned)(R * g.lda + C) * 2u; voffB[i] = FP8 ? (unsigned)(Rb * g.ldb + C) : (unsigned)(Rb * g.ldb + C) * 2u; }
    const size_t kstep = (size_t)(BK * 2);
    const size_t hstepA = (size_t)HALF * g.lda * (FP8 ? 1 : 2), hstepB = (size_t)HALF * g.ldb * (FP8 ? 1 : 2);
    const size_t tstepA = 2 * hstepA, tstepB = 2 * hstepB;
    const unsigned ldsw = (unsigned)wid * 1024u;
    const int aoff = FP8 ? lds_byte8(wr * 64 + fr, fq * 32) : lds_byte(wr * 64 + fr, fq * 8), boff = FP8 ? lds_byte8(wc * 32 + fr, fq * 32) : lds_byte(wc * 32 + fr, fq * 8);
    const int aoff2 = aoff ^ 16, boff2 = boff ^ 16;
#define PG8_SA(b, h) (((b) * 2 + (h)) * HTB)
#define PG8_SB(b, h) ((4 + (b) * 2 + (h)) * HTB)
#define PG8_STAGE(bufoff, gbase, voff) do { _Pragma("unroll") for (int _i = 0; _i < 2; ++_i) \
        __builtin_amdgcn_global_load_lds((const unsigned*)((const char*)(gbase) + (voff)[_i]), (PG8_LAS unsigned*)(lds + (bufoff) + ldsw + _i * 8192), 16, 0, 0); } while (0)
#define PG8_LDA(dst, b, h) do { if constexpr (FP8) { _Pragma("unroll") for (int m = 0; m < 4; ++m) { const bf16x8 lo_ = *(const PG8_LAS bf16x8*)(lds + PG8_SA(b, h) + aoff + m * 2048), hi_ = *(const PG8_LAS bf16x8*)(lds + PG8_SA(b, h) + aoff2 + m * 2048); \
            dst##8[m] = __builtin_shufflevector(__builtin_bit_cast(v4i, lo_), __builtin_bit_cast(v4i, hi_), 0, 1, 2, 3, 4, 5, 6, 7); } } \
        else { _Pragma("unroll") for (int m = 0; m < 4; ++m) _Pragma("unroll") for (int k = 0; k < 2; ++k) dst[m][k] = *(const PG8_LAS bf16x8*)(lds + PG8_SA(b, h) + aoff + m * 2048 + k * 1024); } } while (0)
#define PG8_LDB(dst, b, h) do { if constexpr (FP8) { _Pragma("unroll") for (int n = 0; n < 2; ++n) { const bf16x8 lo_ = *(const PG8_LAS bf16x8*)(lds + PG8_SB(b, h) + boff + n * 2048), hi_ = *(const PG8_LAS bf16x8*)(lds + PG8_SB(b, h) + boff2 + n * 2048); \
            dst##8[n] = __builtin_shufflevector(__builtin_bit_cast(v4i, lo_), __builtin_bit_cast(v4i, hi_), 0, 1, 2, 3, 4, 5, 6, 7); } } \
        else { _Pragma("unroll") for (int n = 0; n < 2; ++n) _Pragma("unroll") for (int k = 0; k < 2; ++k) dst[n][k] = *(const PG8_LAS bf16x8*)(lds + PG8_SB(b, h) + boff + n * 2048 + k * 1024); } } while (0)
#define PG8_V8(F) __builtin_shufflevector(__builtin_bit_cast(v4i, (F)[0]), __builtin_bit_cast(v4i, (F)[1]), 0, 1, 2, 3, 4, 5, 6, 7)
#define PG8_MMA(ai, bj, At, Bt) do { __builtin_amdgcn_s_setprio(1); _Pragma("unroll") for (int m = 0; m < 4; ++m) _Pragma("unroll") for (int n = 0; n < 2; ++n) { \
        if constexpr (FP8 && (GV & 1)) asm volatile("" : "+v"(acc[ai][bj][m][n]) : "v"(Bt##8[n]), "v"(At##8[m])); \
        else if constexpr (FP8) asm volatile("v_mfma_f32_16x16x128_f8f6f4 %0, %1, %2, %0" : "+v"(acc[ai][bj][m][n]) : "v"(Bt##8[n]), "v"(At##8[m])); \
        else { _Pragma("unroll") for (int k = 0; k < 2; ++k) acc[ai][bj][m][n] = __builtin_amdgcn_mfma_f32_16x16x32_bf16(Bt[n][k], At[m][k], acc[ai][bj][m][n], 0, 0, 0); } } \
        __builtin_amdgcn_s_setprio(0); } while (0)
#define PG8_WAIT_V(n) asm volatile("s_waitcnt vmcnt(" #n ")" ::: "memory")
#define PG8_WAIT_L(n) asm volatile("s_waitcnt lgkmcnt(" #n ")" ::: "memory")
#define PG8_BAR __builtin_amdgcn_s_barrier()
#define PG8_SCHED __builtin_amdgcn_sched_barrier(0)
    Unit cur, nxt; int ui = 0;
    if (!S.next(0, cur)) return;
    f32x4 acc[2][2][4][2];
#pragma unroll
    for (int a = 0; a < 2; ++a)
#pragma unroll
        for (int b = 0; b < 2; ++b)
#pragma unroll
            for (int m = 0; m < 4; ++m)
#pragma unroll
                for (int n = 0; n < 2; ++n) acc[a][b][m][n] = (f32x4){0.f, 0.f, 0.f, 0.f};
    bf16x8 At[4][2], B0[2][2], B1[2][2]; v8i At8[4], B08[2], B18[2];
    const char* cA = (const char*)g.A + (size_t)cur.pm * tstepA; const char* cB = (const char*)g.Bt + (size_t)cur.pn * tstepB;
    S.a_ready(cur);
    PG8_STAGE(PG8_SB(0, 0), cB, voffB); PG8_STAGE(PG8_SB(0, 1), cB + hstepB, voffB); PG8_STAGE(PG8_SA(0, 0), cA, voffA); PG8_STAGE(PG8_SA(0, 1), cA + hstepA, voffA);
    if (wr == 1) PG8_BAR;
    PG8_WAIT_V(2); PG8_BAR;
    PG8_STAGE(PG8_SB(1, 0), cB + kstep, voffB); PG8_STAGE(PG8_SA(1, 0), cA + kstep, voffA); PG8_STAGE(PG8_SB(1, 1), cB + hstepB + kstep, voffB);
    PG8_WAIT_V(6); PG8_BAR;
    for (;;) {
        const bool has_next = S.next(ui + 1, nxt);
        const char* nA = has_next ? (const char*)g.A + (size_t)nxt.pm * tstepA : cA; const char* nB = has_next ? (const char*)g.Bt + (size_t)nxt.pn * tstepB : cB;
        for (int t = 0; t < nt; t += 2) {
            const bool last = (t == nt - 2);
            const char* a1 = cA + (size_t)(t + 1) * kstep;
            const char* a2 = last ? nA : cA + (size_t)(t + 2) * kstep; const char* b2 = last ? nB : cB + (size_t)(t + 2) * kstep;
            const char* a3 = a2 + kstep; const char* b3 = b2 + kstep;
            if (last && has_next) S.a_ready(nxt);
            PG8_LDB(B0, 0, 0); PG8_LDB(B1, 0, 1); PG8_SCHED; PG8_LDA(At, 0, 0); PG8_STAGE(PG8_SA(1, 1), a1 + hstepA, voffA);
            PG8_WAIT_V(8); PG8_WAIT_L(0); PG8_BAR; PG8_MMA(0, 0, At, B0); PG8_MMA(0, 1, At, B1); PG8_BAR; PG8_SCHED;
            PG8_LDA(At, 0, 1); PG8_STAGE(PG8_SB(0, 0), b2, voffB); PG8_STAGE(PG8_SB(0, 1), b2 + hstepB, voffB); PG8_STAGE(PG8_SA(0, 0), a2, voffA);
            PG8_WAIT_V(8); PG8_WAIT_L(0); PG8_BAR; PG8_MMA(1, 0, At, B0); PG8_MMA(1, 1, At, B1); PG8_BAR; PG8_SCHED;
            PG8_LDB(B0, 1, 0); PG8_LDB(B1, 1, 1); PG8_SCHED; PG8_LDA(At, 1, 0); PG8_STAGE(PG8_SA(0, 1), a2 + hstepA, voffA);
            PG8_WAIT_V(8); PG8_WAIT_L(0); PG8_BAR; PG8_MMA(0, 0, At, B0); PG8_MMA(0, 1, At, B1); PG8_BAR; PG8_SCHED;
            PG8_LDA(At, 1, 1); PG8_STAGE(PG8_SB(1, 0), b3, voffB); PG8_STAGE(PG8_SB(1, 1), b3 + hstepB, voffB); PG8_STAGE(PG8_SA(1, 0), a3, voffA);
            PG8_WAIT_V(8); PG8_WAIT_L(0); PG8_BAR; PG8_MMA(1, 0, At, B0); PG8_MMA(1, 1, At, B1); PG8_BAR; PG8_SCHED;
        }
        if constexpr (ALIGN_EPI) { if (wr == 0) PG8_BAR; }
        if constexpr (FP8) asm volatile("s_nop 15\n\ts_nop 7" ::: "memory");
        { int l_ = threadIdx.x; asm volatile("" : "+v"(l_));
          if constexpr ((GV & 2) != 0) { asm volatile("" :: "v"(acc[0][0][0][0]), "v"(acc[1][1][3][1])); } else E(acc, cur, wr, wc, l_ & 15, (l_ >> 4) & 3); } S.done(cur);
        if (!has_next) break;
#pragma unroll
        for (int a = 0; a < 2; ++a)
#pragma unroll
            for (int b = 0; b < 2; ++b)
#pragma unroll
                for (int m = 0; m < 4; ++m)
#pragma unroll
                    for (int n = 0; n < 2; ++n) acc[a][b][m][n] = (f32x4){0.f, 0.f, 0.f, 0.f};
        cur = nxt; cA = nA; cB = nB; ++ui;
        if constexpr (ALIGN_EPI) { if (wr == 1) PG8_BAR; }
    }
    PG8_WAIT_V(0);
    if constexpr (!ALIGN_EPI) { if (wr == 0) PG8_BAR; }
    PG8_BAR;
#undef PG8_SA
#undef PG8_SB
#undef PG8_STAGE
#undef PG8_LDA
#undef PG8_LDB
#undef PG8_MMA
#undef PG8_V8
#undef PG8_WAIT_V
#undef PG8_WAIT_L
#undef PG8_BAR
#undef PG8_SCHED
}

__device__ __forceinline__ unsigned pk4_fp8(float a, float b, float c, float d) { int w = __builtin_amdgcn_cvt_pk_fp8_f32(a, b, 0, false); w = __builtin_amdgcn_cvt_pk_fp8_f32(c, d, w, true); return (unsigned)w; }
__device__ __forceinline__ float sigmoid256_fast(float x) { return __builtin_amdgcn_rcpf(0.00390625f + __builtin_amdgcn_exp2f(-1.4426950408889634f * x - 8.0f)); }
__device__ __forceinline__ float sigmoidf_fast(float x) { return __builtin_amdgcn_rcpf(1.0f + __builtin_amdgcn_exp2f(-1.4426950408889634f * x)); }

struct EpiIn {
    static constexpr bool PERM = true;
    unsigned char* wsb; size_t off_lat, off_na, na_stride, off_g; const float* bgate; float qscale; float ascale; size_t off_lat8; float lat8scale;
    __device__ __forceinline__ void operator()(const f32x4 (&acc)[2][2][4][2], const Unit& u, int wr, int wc, int fr, int fq) const {
        const int row0 = u.pm * BM + wr * 64 + fr; const int pn = u.pn;
        size_t boff; int ldc, colt; float sc = 1.f; bool gate = false;
        if (pn < 6) { boff = off_lat; ldc = 1536; colt = pn * 256; }
        else if (pn < 30) { const int t = (pn - 6) >> 3; boff = off_na + (size_t)t * na_stride; ldc = 2048; colt = ((pn - 6) & 7) * 256; if (t == 0) sc = qscale; }
        else { boff = off_g; ldc = 8192; colt = (pn - 30) * 256; gate = true; }
        bf16_t* base = (bf16_t*)(wsb + boff);
        const int col0 = colt + wc * 32 + 8 * fq;
        f32x4 bv[2][2];
#pragma unroll
        for (int bj = 0; bj < 2; ++bj)
#pragma unroll
            for (int n = 0; n < 2; ++n) bv[bj][n] = gate ? *(const f32x4*)(bgate + col0 + bj * HALF + 4 * n) : (f32x4){0.f, 0.f, 0.f, 0.f};
#pragma unroll
        for (int ai = 0; ai < 2; ++ai)
#pragma unroll
            for (int m = 0; m < 4; ++m) { bf16_t* rowp = base + (size_t)(row0 + ai * HALF + m * 16) * ldc + col0;
#pragma unroll
                for (int bj = 0; bj < 2; ++bj) { f32x4 v0 = acc[ai][bj][m][0] * ascale + bv[bj][0], v1 = acc[ai][bj][m][1] * ascale + bv[bj][1];
                    if (gate) {
#pragma unroll
                        for (int i = 0; i < 4; ++i) { v0[i] = sigmoid256_fast(v0[i]); v1[i] = sigmoid256_fast(v1[i]); }
                        u32x2 w; w.x = pk4_fp8(v0[0], v0[1], v0[2], v0[3]); w.y = pk4_fp8(v1[0], v1[1], v1[2], v1[3]);
                        *(u32x2*)(wsb + boff + (size_t)(row0 + ai * HALF + m * 16) * 8192 + col0 + bj * HALF) = w; }
                    else { v0 = v0 * sc; v1 = v1 * sc;
                        if (pn >= 6) { u32x4 w; w.x = cvt_pk_bf16(v0[0], v0[1]); w.y = cvt_pk_bf16(v0[2], v0[3]); w.z = cvt_pk_bf16(v1[0], v1[1]); w.w = cvt_pk_bf16(v1[2], v1[3]);
                            *(u32x4*)(rowp + bj * HALF) = w; }
                        else if (col0 + bj * HALF < 1344) {     const f32x4 a0 = v0 * lat8scale, a1 = v1 * lat8scale; u32x2 w8; w8.x = pk4_fp8(a0[0], a0[1], a0[2], a0[3]); w8.y = pk4_fp8(a1[0], a1[1], a1[2], a1[3]);
                            *(u32x2*)(wsb + off_lat8 + (size_t)(row0 + ai * HALF + m * 16) * 1536 + col0 + bj * HALF) = w8; } } } }
    }
};

struct EpiQ {
    static constexpr bool PERM = false;
    bf16_t* Q; const float* rs; const float* rope; float qscale;
    __device__ __forceinline__ void operator()(const f32x4 (&acc)[2][2][4][2], const Unit& u, int wr, int wc, int fr, int fq) const {
#pragma unroll
        for (int ai = 0; ai < 2; ++ai)
#pragma unroll
            for (int m = 0; m < 4; ++m) {
                const int row = u.pm * BM + ai * HALF + wr * 64 + m * 16 + fr;
                const float rstd = rs[2 * row] * qscale;
                const int s = row & 8191, grow = s >> 6, gcol = s & 63;
#pragma unroll
                for (int bj = 0; bj < 2; ++bj) {
                    const int gg = 8 * u.pn + 4 * bj + wc, kind = gg % 6;
                    f32x4 v0 = acc[ai][bj][m][0] * rstd, v1 = acc[ai][bj][m][1] * rstd;
                    if (kind >= 4) {
                        const int pos = (kind == 4) ? grow : gcol;
                        const f32x4 t0 = *(const f32x4*)(rope + (size_t)(pos * 16 + 4 * fq) * 2), t1 = *(const f32x4*)(rope + (size_t)(pos * 16 + 4 * fq) * 2 + 4);
                        const float c0 = t0[0], s0 = t0[1], c1 = t0[2], s1 = t0[3], c2 = t1[0], s2 = t1[1], c3 = t1[2], s3 = t1[3];
                        f32x4 o0, o1;
                        o0[0] = v0[0] * c0 - v1[0] * s0; o1[0] = v0[0] * s0 + v1[0] * c0;
                        o0[1] = v0[1] * c1 - v1[1] * s1; o1[1] = v0[1] * s1 + v1[1] * c1;
                        o0[2] = v0[2] * c2 - v1[2] * s2; o1[2] = v0[2] * s2 + v1[2] * c2;
                        o0[3] = v0[3] * c3 - v1[3] * s3; o1[3] = v0[3] * s3 + v1[3] * c3;
                        v0 = o0; v1 = o1;
                    }
                    bf16_t* p = Q + (size_t)row * 3072 + u.pn * BM + bj * HALF + wc * 32 + 4 * fq;
                    u32x2 w0, w1; w0.x = cvt_pk_bf16(v0[0], v0[1]); w0.y = cvt_pk_bf16(v0[2], v0[3]); w1.x = cvt_pk_bf16(v1[0], v1[1]); w1.y = cvt_pk_bf16(v1[2], v1[3]);
                    *(u32x2*)p = w0; *(u32x2*)(p + 16) = w1;
                }
            }
    }
};

struct EpiKV {
    static constexpr bool PERM = true;
    bf16_t* Kn; bf16_t* Vm; const float* rs;
    __device__ __forceinline__ void operator()(const f32x4 (&acc)[2][2][4][2], const Unit& u, int wr, int wc, int fr, int fq) const {
        const int col0 = u.pn * HALF + wc * 32 + 8 * fq;
#pragma unroll
        for (int ai = 0; ai < 2; ++ai)
#pragma unroll
            for (int m = 0; m < 4; ++m) {
                const int row = u.pm * BM + ai * HALF + wr * 64 + m * 16 + fr;
                const float rstd = rs[2 * row + 1];
#pragma unroll
                for (int bj = 0; bj < 2; ++bj) { const f32x4 v0 = acc[ai][bj][m][0] * rstd, v1 = acc[ai][bj][m][1] * rstd;
                    u32x4 w; w.x = cvt_pk_bf16(v0[0], v0[1]); w.y = cvt_pk_bf16(v0[2], v0[3]); w.z = cvt_pk_bf16(v1[0], v1[1]); w.w = cvt_pk_bf16(v1[2], v1[3]);
                    *(u32x4*)((bj == 0 ? Kn : Vm) + (size_t)row * 2048 + col0) = w; }
            }
    }
};


struct EpiQ8 {
    static constexpr bool PERM = false;
    unsigned char* Q8; const float* rs; const float* rope; float qscale;
    __device__ __forceinline__ void operator()(const f32x4 (&acc)[2][2][4][2], const Unit& u, int wr, int wc, int fr, int fq) const {
        float rsv[8];
#pragma unroll
        for (int i = 0; i < 8; ++i) rsv[i] = rs[2 * (u.pm * BM + (i >> 2) * HALF + wr * 64 + (i & 3) * 16 + fr)];
#pragma unroll
        for (int ai = 0; ai < 2; ++ai)
#pragma unroll
            for (int m = 0; m < 4; ++m) {
                const int row = u.pm * BM + ai * HALF + wr * 64 + m * 16 + fr;
                const float rstd = rsv[4 * ai + m] * qscale;
                const int s = row & 8191, grow = s >> 6, gcol = s & 63;
#pragma unroll
                for (int bj = 0; bj < 2; ++bj) {
                    const int gg = 8 * u.pn + 4 * bj + wc, kind = gg % 6;
                    f32x4 v0 = acc[ai][bj][m][0] * rstd, v1 = acc[ai][bj][m][1] * rstd;
                    if (kind >= 4) {
                        const int pos = (kind == 4) ? grow : gcol;
                        const f32x4 t0 = *(const f32x4*)(rope + (size_t)(pos * 16 + 4 * fq) * 2), t1 = *(const f32x4*)(rope + (size_t)(pos * 16 + 4 * fq) * 2 + 4);
                        const float c0 = t0[0], s0 = t0[1], c1 = t0[2], s1 = t0[3], c2 = t1[0], s2 = t1[1], c3 = t1[2], s3 = t1[3];
                        f32x4 o0, o1;
                        o0[0] = v0[0] * c0 - v1[0] * s0; o1[0] = v0[0] * s0 + v1[0] * c0;
                        o0[1] = v0[1] * c1 - v1[1] * s1; o1[1] = v0[1] * s1 + v1[1] * c1;
                        o0[2] = v0[2] * c2 - v1[2] * s2; o1[2] = v0[2] * s2 + v1[2] * c2;
                        o0[3] = v0[3] * c3 - v1[3] * s3; o1[3] = v0[3] * s3 + v1[3] * c3;
                        v0 = o0; v1 = o1;
                    }
                    unsigned char* p = Q8 + (size_t)row * 3072 + u.pn * BM + bj * HALF + wc * 32 + 4 * fq;
                    *(unsigned*)p = pk4_fp8(v0[0], v0[1], v0[2], v0[3]); *(unsigned*)(p + 16) = pk4_fp8(v1[0], v1[1], v1[2], v1[3]);
                }
            }
    }
};
struct EpiKV8 {
    static constexpr bool PERM = true;
    unsigned char* K8; unsigned char* VT8; const float* rs; float ascale;
    __device__ __forceinline__ void operator()(const f32x4 (&acc)[2][2][4][2], const Unit& u, int wr, int wc, int fr, int fq) const {
        const int c0 = wc * 32 + 8 * fq, h = u.pn;
        float rsv[8];
#pragma unroll
        for (int i = 0; i < 8; ++i) rsv[i] = rs[2 * (u.pm * BM + (i >> 2) * HALF + wr * 64 + (i & 3) * 16 + fr) + 1] * ascale;
#pragma unroll
        for (int ai = 0; ai < 2; ++ai)
#pragma unroll
            for (int m = 0; m < 4; ++m) {
                const int row = u.pm * BM + ai * HALF + wr * 64 + m * 16 + fr;
                const float rstd = rsv[4 * ai + m];
                { const f32x4 v0 = acc[ai][0][m][0] * rstd, v1 = acc[ai][0][m][1] * rstd;
                  u32x2 w; w.x = pk4_fp8(v0[0], v0[1], v0[2], v0[3]); w.y = pk4_fp8(v1[0], v1[1], v1[2], v1[3]);
                  *(u32x2*)(K8 + ((size_t)row * 16 + h) * 192 + c0) = w; }
                { const f32x4 v0 = acc[ai][1][m][0] * rstd, v1 = acc[ai][1][m][1] * rstd;
                  const unsigned w0 = pk4_fp8(v0[0], v0[1], v0[2], v0[3]), w1 = pk4_fp8(v1[0], v1[1], v1[2], v1[3]);
                  unsigned char* vp = VT8 + ((size_t)((row >> 13) * 16 + h) * 128 + c0) * 8192 + (row & 8191);
                  vp[0] = (unsigned char)(w0 & 0xff); vp[8192] = (unsigned char)((w0 >> 8) & 0xff); vp[2 * 8192] = (unsigned char)((w0 >> 16) & 0xff); vp[3 * 8192] = (unsigned char)(w0 >> 24);
                  vp[4 * 8192] = (unsigned char)(w1 & 0xff); vp[5 * 8192] = (unsigned char)((w1 >> 8) & 0xff); vp[6 * 8192] = (unsigned char)((w1 >> 16) & 0xff); vp[7 * 8192] = (unsigned char)(w1 >> 24); }
            }
    }
};

template <bool FIRST> struct EpiGate {
    static constexpr bool PERM = true;
    const unsigned char* G8; unsigned char* Y8; unsigned char* M8; float ascale, yscale, oscale;
    __device__ __forceinline__ void operator()(const f32x4 (&acc)[2][2][4][2], const Unit& u, int wr, int wc, int fr, int fq) const {
        const int col0 = u.pn * BM + wc * 32 + 8 * fq;
        const int rowb = u.pm * BM + wr * 64 + fr;
        u32x2 gw[2][4], pw[2][4];
        const float iy = 1.0f / yscale;
#define EG_LOAD(B_, S_) _Pragma("unroll") for (int i_ = 0; i_ < 4; ++i_) { const int it_ = 4 * (B_) + i_, ai_ = it_ >> 3, m_ = (it_ >> 1) & 3, bj_ = it_ & 1; \
            const int row_ = rowb + ai_ * HALF + m_ * 16, col_ = col0 + bj_ * HALF; \
            gw[S_][i_] = *(const u32x2*)(G8 + (size_t)row_ * 8192 + (FIRST ? 0 : 4096) + col_); \
            if (!FIRST) pw[S_][i_] = *(const u32x2*)(Y8 + (size_t)row_ * 4096 + col_); }
#define EG_COMP(B_, S_) _Pragma("unroll") for (int i_ = 0; i_ < 4; ++i_) { const int it_ = 4 * (B_) + i_, ai_ = it_ >> 3, m_ = (it_ >> 1) & 3, bj_ = it_ & 1; \
            const int row_ = rowb + ai_ * HALF + m_ * 16, col_ = col0 + bj_ * HALF; const u32x2 g_ = gw[S_][i_]; \
            f32x4 v0 = acc[ai_][bj_][m_][0] * ascale, v1 = acc[ai_][bj_][m_][1] * ascale; \
            { const f32x2 a_ = __builtin_amdgcn_cvt_pk_f32_fp8((int)g_.x, false), b_ = __builtin_amdgcn_cvt_pk_f32_fp8((int)g_.x, true), c_ = __builtin_amdgcn_cvt_pk_f32_fp8((int)g_.y, false), d_ = __builtin_amdgcn_cvt_pk_f32_fp8((int)g_.y, true); \
              v0[0] *= a_.x; v0[1] *= a_.y; v0[2] *= b_.x; v0[3] *= b_.y; v1[0] *= c_.x; v1[1] *= c_.y; v1[2] *= d_.x; v1[3] *= d_.y; } \
            if constexpr (FIRST) { v0 = v0 * yscale; v1 = v1 * yscale; u32x2 w; w.x = pk4_fp8(v0[0], v0[1], v0[2], v0[3]); w.y = pk4_fp8(v1[0], v1[1], v1[2], v1[3]); \
                *(u32x2*)(Y8 + (size_t)row_ * 4096 + col_) = w; } \
            else { const u32x2 p_ = pw[S_][i_]; \
                { const f32x2 a_ = __builtin_amdgcn_cvt_pk_f32_fp8((int)p_.x, false), b_ = __builtin_amdgcn_cvt_pk_f32_fp8((int)p_.x, true), c_ = __builtin_amdgcn_cvt_pk_f32_fp8((int)p_.y, false), d_ = __builtin_amdgcn_cvt_pk_f32_fp8((int)p_.y, true); \
                  v0[0] += a_.x * iy; v0[1] += a_.y * iy; v0[2] += b_.x * iy; v0[3] += b_.y * iy; v1[0] += c_.x * iy; v1[1] += c_.y * iy; v1[2] += d_.x * iy; v1[3] += d_.y * iy; } \
                v0 = v0 * oscale; v1 = v1 * oscale; u32x2 w; w.x = pk4_fp8(v0[0], v0[1], v0[2], v0[3]); w.y = pk4_fp8(v1[0], v1[1], v1[2], v1[3]); \
                *(u32x2*)(M8 + (size_t)row_ * 4096 + col_) = w; } }
        EG_LOAD(0, 0) EG_LOAD(1, 1)
        EG_COMP(0, 0) EG_LOAD(2, 0)
        EG_COMP(1, 1) EG_LOAD(3, 1)
        EG_COMP(2, 0)
        EG_COMP(3, 1)
#undef EG_LOAD
#undef EG_COMP
    }
};

template <bool BASE> struct EpiF32T {
    static constexpr bool PERM = false;
    const float* base; float* out; int ldc; float ascale;
    __device__ __forceinline__ void operator()(const f32x4 (&acc)[2][2][4][2], const Unit& u, int wr, int wc, int fr, int fq) const {
        const int col0 = u.pn * BM + wc * 32 + 4 * fq;
        const size_t off0 = (size_t)(u.pm * BM + wr * 64 + fr) * ldc + col0;
        f32x4 bv[2][8];
#define EF_OFF(it_) (off0 + (size_t)((((it_) >> 4) & 1) * HALF + (((it_) >> 2) & 3) * 16) * ldc + (((it_) >> 1) & 1) * HALF + ((it_) & 1) * 16)
#define EF_LOAD(B_, S_) if constexpr (BASE) { _Pragma("unroll") for (int i_ = 0; i_ < 8; ++i_) { const int it_ = 8 * (B_) + i_; bv[S_][i_] = *(const f32x4*)(base + EF_OFF(it_)); } }
#define EF_COMP(B_, S_) _Pragma("unroll") for (int i_ = 0; i_ < 8; ++i_) { const int it_ = 8 * (B_) + i_; f32x4 o = acc[(it_ >> 4) & 1][(it_ >> 1) & 1][(it_ >> 2) & 3][it_ & 1] * ascale; \
            if constexpr (BASE) o = o + bv[S_][i_]; *(f32x4*)(out + EF_OFF(it_)) = o; }
        EF_LOAD(0, 0) EF_LOAD(1, 1)
        EF_COMP(0, 0) EF_LOAD(2, 0)
        EF_COMP(1, 1) EF_LOAD(3, 1)
        EF_COMP(2, 0)
        EF_COMP(3, 1)
#undef EF_OFF
#undef EF_LOAD
#undef EF_COMP
    }
};
struct EpiF32RS {
    static constexpr bool PERM = false;
    const float* rs; float* out; int ldc;
    __device__ __forceinline__ void operator()(const f32x4 (&acc)[2][2][4][2], const Unit& u, int wr, int wc, int fr, int fq) const {
        const int col0 = u.pn * BM + wc * 32 + 4 * fq;
        const int row0 = u.pm * BM + wr * 64 + fr;
        float rsv[8];
#pragma unroll
        for (int i = 0; i < 8; ++i) rsv[i] = rs[2 * (row0 + (i >> 2) * HALF + (i & 3) * 16)];
#pragma unroll
        for (int ai = 0; ai < 2; ++ai)
#pragma unroll
            for (int m = 0; m < 4; ++m) { const float r = rsv[4 * ai + m]; const size_t off = (size_t)(row0 + ai * HALF + m * 16) * ldc + col0;
#pragma unroll
                for (int bj = 0; bj < 2; ++bj)
#pragma unroll
                    for (int n = 0; n < 2; ++n) *(f32x4*)(out + off + bj * HALF + n * 16) = acc[ai][bj][m][n] * r; }
    }
};
struct EpiX1 {
    static constexpr bool PERM = true;
    const float* x; bf16_t* X1; float ascale;
    __device__ __forceinline__ void operator()(const f32x4 (&acc)[2][2][4][2], const Unit& u, int wr, int wc, int fr, int fq) const {
        const int col0 = u.pn * BM + wc * 32 + 8 * fq;
        const int rowb = u.pm * BM + wr * 64 + fr;
        f32x4 bv[2][4][2];
#define EX_LOAD(B_, S_) _Pragma("unroll") for (int i_ = 0; i_ < 4; ++i_) { const int it_ = 4 * (B_) + i_, ai_ = it_ >> 3, m_ = (it_ >> 1) & 3, bj_ = it_ & 1; \
            const float* p_ = x + (size_t)(rowb + ai_ * HALF + m_ * 16) * 4096 + col0 + bj_ * HALF; bv[S_][i_][0] = *(const f32x4*)p_; bv[S_][i_][1] = *(const f32x4*)(p_ + 4); }
#define EX_COMP(B_, S_) _Pragma("unroll") for (int i_ = 0; i_ < 4; ++i_) { const int it_ = 4 * (B_) + i_, ai_ = it_ >> 3, m_ = (it_ >> 1) & 3, bj_ = it_ & 1; \
            const f32x4 v0 = acc[ai_][bj_][m_][0] * ascale + bv[S_][i_][0], v1 = acc[ai_][bj_][m_][1] * ascale + bv[S_][i_][1]; \
            u32x4 w; w.x = cvt_pk_bf16(v0[0], v0[1]); w.y = cvt_pk_bf16(v0[2], v0[3]); w.z = cvt_pk_bf16(v1[0], v1[1]); w.w = cvt_pk_bf16(v1[2], v1[3]); \
            *(u32x4*)(X1 + (size_t)(rowb + ai_ * HALF + m_ * 16) * 4096 + col0 + bj_ * HALF) = w; }
        EX_LOAD(0, 0) EX_LOAD(1, 1)
        EX_COMP(0, 0) EX_LOAD(2, 0)
        EX_COMP(1, 1) EX_LOAD(3, 1)
        EX_COMP(2, 0)
        EX_COMP(3, 1)
#undef EX_LOAD
#undef EX_COMP
    }
};
}

namespace att {
using bf16x8 = __attribute__((ext_vector_type(8))) short;
using s16x4  = __attribute__((ext_vector_type(4))) short;
using f32x16 = __attribute__((ext_vector_type(16))) float;
using u32x4  = __attribute__((ext_vector_type(4))) unsigned;
typedef unsigned short bf16_t;
constexpr int NW = 8, QBLK = 32, KVBLK = 64, SEQ = 8192, NHEAD = 16;
constexpr int SHM_V = KVBLK * 128 * 2, SHM_KN = KVBLK * 128 * 2, SHM_KR = KVBLK * 64 * 2;
constexpr int OFF_V = 0, OFF_KN = 2 * SHM_V, OFF_KR = OFF_KN + 2 * SHM_KN, OFF_WS = OFF_KR + 2 * SHM_KR, OFF_BIAS = OFF_WS + NW * 64 * 4, OFF_QR = OFF_BIAS + 2048, ATT_LDS_BYTES = OFF_QR + NW * 4096;
#define KSWZ(row, colB) ((row) * 256 + ((colB) ^ (((row) & 7) << 4)))
#define KRSWZ(row, chunk) ((row) * 128 + ((((chunk) ^ (((row) >> 1) & 7))) << 4))
#define ASBAR() __builtin_amdgcn_sched_barrier(0)
__device__ __forceinline__ int crow(int r, int hi) { return (r & 3) + 8 * (r >> 2) + 4 * hi; }
__device__ __forceinline__ unsigned cvtpk(float lo, float hi) { unsigned r; asm volatile("v_cvt_pk_bf16_f32 %0, %1, %2" : "=v"(r) : "v"(lo), "v"(hi)); return r; }
__device__ __forceinline__ bf16x8 ld8(const bf16_t* p) { return *reinterpret_cast<const bf16x8*>(p); }

constexpr float THR2 = 11.5f;
__device__ __forceinline__ void partialSM(f32x16& p0, f32x16& p1, float& m_reg, float& mn, float& alpha) {
  float pmax = p0[0];
#pragma unroll
  for (int r = 1; r < 16; ++r) pmax = fmaxf(pmax, p0[r]);
#pragma unroll
  for (int r = 0; r < 16; ++r) pmax = fmaxf(pmax, p1[r]);
  { auto rr = __builtin_amdgcn_permlane32_swap(__float_as_uint(pmax), __float_as_uint(pmax), false, false);
    pmax = fmaxf(__uint_as_float(rr[0]), __uint_as_float(rr[1])); }
  if (__builtin_expect(__all(pmax - m_reg <= THR2), 1)) { mn = m_reg; alpha = 1.f; }
  else { mn = fmaxf(m_reg, pmax); alpha = __builtin_amdgcn_exp2f(m_reg - mn); m_reg = mn; }
#pragma unroll
  for (int r = 0; r < 16; ++r) p0[r] = p0[r] - mn;
#pragma unroll
  for (int r = 0; r < 16; ++r) p1[r] = p1[r] - mn;
#pragma unroll
  for (int r = 0; r < 16; ++r) p0[r] = __builtin_amdgcn_exp2f(p0[r]);
}
__device__ __forceinline__ void finishSM(f32x16& p0, f32x16& p1, float alpha, float& l_reg, bf16x8& pa0, bf16x8& pa1, bf16x8& pa2, bf16x8& pa3) {
#pragma unroll
  for (int r = 0; r < 16; ++r) p1[r] = __builtin_amdgcn_exp2f(p1[r]);
  float ps = 0;
#pragma unroll
  for (int r = 0; r < 16; ++r) ps += p0[r];
#pragma unroll
  for (int r = 0; r < 16; ++r) ps += p1[r];
  { auto rr = __builtin_amdgcn_permlane32_swap(__float_as_uint(ps), __float_as_uint(ps), false, false);
    ps = __uint_as_float(rr[0]) + __uint_as_float(rr[1]); }
  l_reg = l_reg * alpha + ps;
#define PK4(P, BASE, OUT) do { unsigned a0 = cvtpk(P[BASE + 0], P[BASE + 1]), a1 = cvtpk(P[BASE + 2], P[BASE + 3]);   \
    unsigned b0 = cvtpk(P[BASE + 4], P[BASE + 5]), b1 = cvtpk(P[BASE + 6], P[BASE + 7]);                              \
    auto r0 = __builtin_amdgcn_permlane32_swap(a0, b0, false, false); auto r1 = __builtin_amdgcn_permlane32_swap(a1, b1, false, false); \
    u32x4 w = {r0[0], r1[0], r0[1], r1[1]}; OUT = *reinterpret_cast<bf16x8*>(&w); } while (0)
  PK4(p0, 0, pa0); PK4(p0, 8, pa1); PK4(p1, 0, pa2); PK4(p1, 8, pa3);
}
__device__ __forceinline__ int v_st(int k, int c) { const int kk = (k & ~0xC) | ((k & 4) << 1) | ((k & 8) >> 1); return ((kk >> 3) * 4 + (c >> 5)) * 512 + ((kk & 7) * 32 + (c & 31)) * 2; }
__device__ __forceinline__ int v_rd_base(int lane) { return ((lane & 3) << 3) | (((lane >> 2) & 3) << 6) | (((lane >> 4) & 1) << 5) | (((lane >> 5) & 1) << 8); }
constexpr int v_rd_off(int d0, int ks, int half) { return d0 * 512 + ks * 4096 + half * 2048; }
template <int OFF> __device__ __forceinline__ s16x4 tr_read(int vb) {
  s16x4 r; asm volatile("ds_read_b64_tr_b16 %0, %1 offset:%2" : "=&v"(r) : "v"(vb), "i"(OFF) : "memory"); return r;
}
template <int D0> __device__ __forceinline__ void pv_one(f32x16& od, int vb, bf16x8 pa0, bf16x8 pa1, bf16x8 pa2, bf16x8 pa3) {
  const s16x4 l0 = tr_read<v_rd_off(D0, 0, 0)>(vb), h0 = tr_read<v_rd_off(D0, 0, 1)>(vb), l1 = tr_read<v_rd_off(D0, 1, 0)>(vb), h1 = tr_read<v_rd_off(D0, 1, 1)>(vb);
  const s16x4 l2 = tr_read<v_rd_off(D0, 2, 0)>(vb), h2 = tr_read<v_rd_off(D0, 2, 1)>(vb), l3 = tr_read<v_rd_off(D0, 3, 0)>(vb), h3 = tr_read<v_rd_off(D0, 3, 1)>(vb);
  asm volatile("s_waitcnt lgkmcnt(0)" ::: "memory"); ASBAR();
#define PKV(L, H) (bf16x8){L[0], L[1], L[2], L[3], H[0], H[1], H[2], H[3]}
  od = __builtin_amdgcn_mfma_f32_32x32x16_bf16(pa0, PKV(l0, h0), od, 0, 0, 0);
  od = __builtin_amdgcn_mfma_f32_32x32x16_bf16(pa1, PKV(l1, h1), od, 0, 0, 0);
  od = __builtin_amdgcn_mfma_f32_32x32x16_bf16(pa2, PKV(l2, h2), od, 0, 0, 0);
  od = __builtin_amdgcn_mfma_f32_32x32x16_bf16(pa3, PKV(l3, h3), od, 0, 0, 0);
#undef PKV
}
__device__ __forceinline__ void pv_d0(f32x16* o, int vb, bf16x8 pa0, bf16x8 pa1, bf16x8 pa2, bf16x8 pa3) {
  pv_one<0>(o[0], vb, pa0, pa1, pa2, pa3); pv_one<1>(o[1], vb, pa0, pa1, pa2, pa3); pv_one<2>(o[2], vb, pa0, pa1, pa2, pa3); pv_one<3>(o[3], vb, pa0, pa1, pa2, pa3);
}
template <int NROPE> __device__ __forceinline__ void qkt(f32x16& p0, f32x16& p1, const char* Kn, const char* Kr, const bf16x8* qr, const char* qrl, int r32, int hi) {
  p0 = f32x16{}; p1 = f32x16{};
#pragma unroll
  for (int d0 = 0; d0 < 8; ++d0) { const int cb = (d0 * 16 + hi * 8) * 2;
    const bf16x8 b0 = *reinterpret_cast<const bf16x8*>(Kn + KSWZ(r32, cb));
    const bf16x8 b1 = *reinterpret_cast<const bf16x8*>(Kn + KSWZ(32 + r32, cb));
    p0 = __builtin_amdgcn_mfma_f32_32x32x16_bf16(b0, qr[d0], p0, 0, 0, 0);
    p1 = __builtin_amdgcn_mfma_f32_32x32x16_bf16(b1, qr[d0], p1, 0, 0, 0); }
#pragma unroll
  for (int d0 = 0; d0 < NROPE; ++d0) { const int ch = d0 * 2 + hi;
    const bf16x8 b0 = *reinterpret_cast<const bf16x8*>(Kr + KRSWZ(r32, ch));
    const bf16x8 b1 = *reinterpret_cast<const bf16x8*>(Kr + KRSWZ(32 + r32, ch));
    const bf16x8 qf = *reinterpret_cast<const bf16x8*>(qrl + d0 * 1024);
    p0 = __builtin_amdgcn_mfma_f32_32x32x16_bf16(b0, qf, p0, 0, 0, 0);
    p1 = __builtin_amdgcn_mfma_f32_32x32x16_bf16(b1, qf, p1, 0, 0, 0); }
}

__device__ __forceinline__ void mla_unit(int b, int h, int qb, const bf16_t* __restrict__ Q, const bf16_t* __restrict__ KN, const bf16_t* __restrict__ KR, const bf16_t* __restrict__ VM, unsigned char* __restrict__ O, float oscale, char* lds) {
  int tid_ = threadIdx.x; asm volatile("" : "+v"(tid_));
  const int tid = tid_, wid = tid >> 6, lane = tid & 63, r32 = lane & 31, hi = lane >> 5;
  char* V_lds = lds + OFF_V; char* Kn_lds = lds + OFF_KN; char* Kr_lds = lds + OFF_KR;
  float* ws = (float*)(lds + OFF_WS) + wid * 64; float* li_l = ws; float* al_l = ws + 32;
  float m_reg = -1e30f, l_reg = 0; f32x16 o[4] = {}; bf16x8 qr[8];
  char* qrl = lds + OFF_QR + wid * 4096 + (hi * 32 + r32) * 16;
  const long rowbase = (long)b * SEQ;
  const bf16_t* Qw = Q + (rowbase + qb * 256 + wid * QBLK + r32) * 3072 + h * 192 + hi * 8;
#pragma unroll
  for (int d0 = 0; d0 < 8; ++d0) qr[d0] = ld8(Qw + d0 * 16);
  const bf16_t* Kh = KN + rowbase * 2048 + h * 128; const bf16_t* Vh = VM + rowbase * 2048 + h * 128; const bf16_t* Krb = KR + rowbase * 64;
  const int sr = tid >> 4, sc = (tid & 15) * 8, vst0 = v_st(sr, sc), vst1 = v_st(32 + sr, sc);
  const int krr = tid >> 3, krc = tid & 7;
  const int vb0 = (int)(uintptr_t)V_lds + v_rd_base(lane);
  struct { bf16x8 vs0, vs1, ks0, ks1, kr0; } sr_[1];
#define SLOAD(i, k0) do { sr_[i].vs0 = ld8(&Vh[(long)((k0) + sr) * 2048 + sc]); sr_[i].vs1 = ld8(&Vh[(long)((k0) + 32 + sr) * 2048 + sc]); \
    sr_[i].ks0 = ld8(&Kh[(long)((k0) + sr) * 2048 + sc]); sr_[i].ks1 = ld8(&Kh[(long)((k0) + 32 + sr) * 2048 + sc]); sr_[i].kr0 = ld8(&Krb[(long)((k0) + krr) * 64 + krc * 8]); } while (0)
#define SWRITE(bb, i) do { *(bf16x8*)(V_lds + (bb) * SHM_V + vst0) = sr_[i].vs0; *(bf16x8*)(V_lds + (bb) * SHM_V + vst1) = sr_[i].vs1; const int kc = sc * 2; \
    *(bf16x8*)(Kn_lds + (bb) * SHM_KN + KSWZ(sr, kc)) = sr_[i].ks0; *(bf16x8*)(Kn_lds + (bb) * SHM_KN + KSWZ(32 + sr, kc)) = sr_[i].ks1; \
    *(bf16x8*)(Kr_lds + (bb) * SHM_KR + KRSWZ(krr, krc)) = sr_[i].kr0; } while (0)
#define SWAIT() asm volatile("s_waitcnt vmcnt(0)" ::: "memory")
#define RESC(a) do { if (__any((a) < 1.f)) { if (hi == 0) al_l[r32] = (a); asm volatile("s_waitcnt lgkmcnt(0)" ::: "memory"); \
    _Pragma("unroll") for (int d = 0; d < 4; ++d) _Pragma("unroll") for (int r = 0; r < 16; ++r) o[d][r] *= al_l[crow(r, hi)]; } } while (0)
  f32x16 pA0, pA1, pB0, pB1; float mnA, mnB, alA, alB; bf16x8 pa0, pa1, pa2, pa3; const int NT = SEQ / KVBLK;
  constexpr int SE = 0, SO = 0;
  __syncthreads();
#pragma unroll
  for (int d0 = 0; d0 < 4; ++d0) *(bf16x8*)(qrl + d0 * 1024) = ld8(Qw + (8 + d0) * 16);
  SLOAD(SE, 0); asm volatile("s_waitcnt vmcnt(0)" ::: "memory"); SWRITE(0, SE); __syncthreads();
  qkt<4>(pA0, pA1, Kn_lds, Kr_lds, qr, qrl, r32, hi); partialSM(pA0, pA1, m_reg, mnA, alA);
  SLOAD(SO, KVBLK);
  SWAIT(); SWRITE(1, SO); __syncthreads();
  for (int j = 1; j + 1 < NT; j += 2) {
    ASBAR(); qkt<4>(pB0, pB1, Kn_lds + SHM_KN, Kr_lds + SHM_KR, qr, qrl, r32, hi);
    finishSM(pA0, pA1, alA, l_reg, pa0, pa1, pa2, pa3); ASBAR();
    SLOAD(SE, (j + 1) * KVBLK); ASBAR();
    pv_d0(o, vb0, pa0, pa1, pa2, pa3); partialSM(pB0, pB1, m_reg, mnB, alB);
    __syncthreads(); SWAIT(); SWRITE(0, SE);
    RESC(alB); __syncthreads();
    ASBAR(); qkt<4>(pA0, pA1, Kn_lds, Kr_lds, qr, qrl, r32, hi);
    finishSM(pB0, pB1, alB, l_reg, pa0, pa1, pa2, pa3); ASBAR();
    SLOAD(SO, (j + 2) * KVBLK); ASBAR();
    pv_d0(o, vb0 + SHM_V, pa0, pa1, pa2, pa3); partialSM(pA0, pA1, m_reg, mnA, alA);
    __syncthreads(); SWAIT(); SWRITE(1, SO);
    RESC(alA); __syncthreads();
  }
  ASBAR(); qkt<4>(pB0, pB1, Kn_lds + SHM_KN, Kr_lds + SHM_KR, qr, qrl, r32, hi);
  finishSM(pA0, pA1, alA, l_reg, pa0, pa1, pa2, pa3); ASBAR();
  pv_d0(o, vb0, pa0, pa1, pa2, pa3); partialSM(pB0, pB1, m_reg, mnB, alB);
  __syncthreads(); RESC(alB);
  finishSM(pB0, pB1, alB, l_reg, pa0, pa1, pa2, pa3); ASBAR();
  pv_d0(o, vb0 + SHM_V, pa0, pa1, pa2, pa3);
  if (hi == 0) li_l[r32] = l_reg; asm volatile("s_waitcnt lgkmcnt(0)" ::: "memory");
  float rli[16];
#pragma unroll
  for (int r = 0; r < 16; ++r) rli[r] = __builtin_amdgcn_rcpf(li_l[crow(r, hi)]) * oscale;
  unsigned char* Ow = O + (rowbase + qb * 256 + wid * QBLK) * 2048 + h * 128;
#pragma unroll
  for (int r = 0; r < 16; ++r) { const int orow = crow(r, hi);
#pragma unroll
    for (int d0 = 0; d0 < 4; ++d0) Ow[(long)orow * 2048 + d0 * 32 + r32] = (unsigned char)(__builtin_amdgcn_cvt_pk_fp8_f32(o[d0][r] * rli[r], 0.f, 0, false) & 0xff); }
#undef SLOAD
#undef SWRITE
#undef SWAIT
#undef RESC
}

template <int NVAR = 0> __device__ __forceinline__ void na_unit(int b, int h, int rg, const bf16_t* __restrict__ Q, const bf16_t* __restrict__ K, const bf16_t* __restrict__ V, const float* __restrict__ rpb, unsigned char* __restrict__ O, float oscale, char* lds) {
  int tid_ = threadIdx.x; asm volatile("" : "+v"(tid_));
  const int tid = tid_, wid = tid >> 6, lane = tid & 63, r32 = lane & 31, hi = lane >> 5;
  char* V_lds = lds + OFF_V; char* Kn_lds = lds + OFF_KN;
  float* ws = (float*)(lds + OFF_WS) + wid * 64; float* li_l = ws; float* al_l = ws + 32;
  float* bias_l = (float*)(lds + OFF_BIAS);
  const int r0 = rg * 4, rq = r0 + (wid >> 1), cq = 32 * (wid & 1) + r32;
  const int rs_w = min(max(rq - 4, 0), 120), cs = min(max(cq - 8, 0), 48);
  const int kr_lo = min(max(r0 - 4, 0), 120), kr_hi = min(max(r0 + 3 - 4, 0), 120) + 7, NT = kr_hi - kr_lo + 1;
  const long rowbase = (long)b * SEQ;
  float m_reg = -1e30f, l_reg = 0; f32x16 o[4] = {}; bf16x8 qr[8];
  const bf16_t* Qw = Q + (rowbase + rq * 64 + cq) * 2048 + h * 128 + hi * 8;
#pragma unroll
  for (int d0 = 0; d0 < 8; ++d0) qr[d0] = ld8(Qw + d0 * 16);
  const bf16_t* Kh = K + rowbase * 2048 + h * 128; const bf16_t* Vh = V + rowbase * 2048 + h * 128;
  const int sr = tid >> 4, sc = (tid & 15) * 8, vst0 = v_st(sr, sc), vst1 = v_st(32 + sr, sc);
  const int vb0 = (int)(uintptr_t)V_lds + v_rd_base(lane);
  __syncthreads();
  if (tid < 465) bias_l[tid] = rpb[h * 465 + tid] * 1.4426950408889634f;
  bf16x8 vsA0, vsA1, ksA0, ksA1, vsB0, vsB1, ksB0, ksB1;
#define NLOAD(S, k0) do { vs##S##0 = ld8(&Vh[(long)((k0) + sr) * 2048 + sc]); vs##S##1 = ld8(&Vh[(long)((k0) + 32 + sr) * 2048 + sc]); \
    ks##S##0 = ld8(&Kh[(long)((k0) + sr) * 2048 + sc]); ks##S##1 = ld8(&Kh[(long)((k0) + 32 + sr) * 2048 + sc]); } while (0)
#define NWRITE(S, bb) do { *(bf16x8*)(V_lds + (bb) * SHM_V + vst0) = vs##S##0; *(bf16x8*)(V_lds + (bb) * SHM_V + vst1) = vs##S##1; const int kc = sc * 2; \
    *(bf16x8*)(Kn_lds + (bb) * SHM_KN + KSWZ(sr, kc)) = ks##S##0; *(bf16x8*)(Kn_lds + (bb) * SHM_KN + KSWZ(32 + sr, kc)) = ks##S##1; } while (0)
#define NCOMPUTE(bb, kr) do { if (!(NVAR & 1) && (kr) >= rs_w && (kr) < rs_w + 8) { \
      f32x16 p0, p1; \
      qkt<0>(p0, p1, Kn_lds + (bb) * SHM_KN, nullptr, qr, nullptr, r32, hi); \
      const float* brow = bias_l + ((kr) - rq + 7) * 31 + 15 - cq; \
      float pmax = -1e30f; \
      _Pragma("unroll") for (int r = 0; r < 16; ++r) { const int k0 = crow(r, hi), k1 = 32 + k0; \
        const bool v0 = (k0 >= cs) && (k0 < cs + 16), v1 = (k1 >= cs) && (k1 < cs + 16); \
        const float b0 = brow[v0 ? k0 : cq], b1 = brow[v1 ? k1 : cq]; \
        p0[r] = v0 ? p0[r] + b0 : -1e30f; p1[r] = v1 ? p1[r] + b1 : -1e30f; \
        pmax = fmaxf(pmax, fmaxf(p0[r], p1[r])); } \
      { auto rr = __builtin_amdgcn_permlane32_swap(__float_as_uint(pmax), __float_as_uint(pmax), false, false); \
        pmax = fmaxf(__uint_as_float(rr[0]), __uint_as_float(rr[1])); } \
      const float mn = fmaxf(m_reg, pmax), alpha = __builtin_amdgcn_exp2f(m_reg - mn); m_reg = mn; \
      _Pragma("unroll") for (int r = 0; r < 16; ++r) { p0[r] = __builtin_amdgcn_exp2f(p0[r] - mn); p1[r] = __builtin_amdgcn_exp2f(p1[r] - mn); } \
      float ps = 0; \
      _Pragma("unroll") for (int r = 0; r < 16; ++r) ps += p0[r] + p1[r]; \
      { auto rr = __builtin_amdgcn_permlane32_swap(__float_as_uint(ps), __float_as_uint(ps), false, false); \
        ps = __uint_as_float(rr[0]) + __uint_as_float(rr[1]); } \
      l_reg = l_reg * alpha + ps; \
      if (__any(alpha < 1.f)) { if (hi == 0) al_l[r32] = alpha; asm volatile("s_waitcnt lgkmcnt(0)" ::: "memory"); \
        _Pragma("unroll") for (int d = 0; d < 4; ++d) _Pragma("unroll") for (int r = 0; r < 16; ++r) o[d][r] *= al_l[crow(r, hi)]; } \
      bf16x8 pa0, pa1, pa2, pa3; \
      PK4(p0, 0, pa0); PK4(p0, 8, pa1); PK4(p1, 0, pa2); PK4(p1, 8, pa3); \
      pv_d0(o, vb0 + (bb) * SHM_V, pa0, pa1, pa2, pa3); } } while (0)
  NLOAD(A, kr_lo * 64); if (NT > 1) NLOAD(B, (kr_lo + 1) * 64);
#pragma unroll 1
  for (int i = 0; i < NT; i += 2) {
    const int kr = kr_lo + i;
    NWRITE(A, 0);
    if (i + 2 < NT) NLOAD(A, (kr + 2) * 64);
    __syncthreads();
    NCOMPUTE(0, kr);
    if (i + 1 < NT) {
      NWRITE(B, 1);
      if (i + 3 < NT) NLOAD(B, (kr + 3) * 64);
      __syncthreads();
      NCOMPUTE(1, kr + 1);
    }
  }
#undef NCOMPUTE
  if (hi == 0) li_l[r32] = l_reg; asm volatile("s_waitcnt lgkmcnt(0)" ::: "memory");
  float rli[16];
#pragma unroll
  for (int r = 0; r < 16; ++r) rli[r] = __builtin_amdgcn_rcpf(li_l[crow(r, hi)]) * oscale;
  unsigned char* Ow = O + (rowbase + rq * 64 + 32 * (wid & 1)) * 2048 + h * 128;
#pragma unroll
  for (int r = 0; r < 16; ++r) { const int orow = crow(r, hi);
#pragma unroll
    for (int d0 = 0; d0 < 4; ++d0) Ow[(long)orow * 2048 + d0 * 32 + r32] = (unsigned char)(__builtin_amdgcn_cvt_pk_fp8_f32(o[d0][r] * rli[r], 0.f, 0, false) & 0xff); }
#undef NLOAD
#undef NWRITE
}
#undef PK4
}

namespace att8 {
using f32x16 = __attribute__((ext_vector_type(16))) float;
using u32x4  = __attribute__((ext_vector_type(4))) unsigned;
using v8i    = __attribute__((ext_vector_type(8))) int;
using v4i    = __attribute__((ext_vector_type(4))) int;
constexpr int SEQ = 8192, KVBLK = 64, KT_BYTES = 12288, VT_BYTES = 8192, NSLOT = 5;
constexpr int OFF_K = 0, OFF_V = NSLOT * KT_BYTES, OFF_WS = OFF_V + NSLOT * VT_BYTES, LDS_BYTES = OFF_WS + 2048;
constexpr float SQ8 = 1.0f;
constexpr float PSH = 6.0f;
constexpr float THR8 = 2.0f;
__device__ __forceinline__ int crow(int r, int hi) { return (r & 3) + 8 * (r >> 2) + 4 * hi; }
__device__ __forceinline__ void glds16(const void* gsrc, unsigned lds_dst) { unsigned keep;
  asm volatile("s_mov_b32 %0, m0\n\ts_mov_b32 m0, %2\n\ts_nop 0\n\tglobal_load_lds_dwordx4 %1, off\n\ts_mov_b32 m0, %0" : "=&s"(keep) : "v"(gsrc), "s"(lds_dst) : "memory"); }
template <bool ON = true> __device__ __forceinline__ void mfma64(f32x16& acc, const v8i& a, const v8i& b) { if constexpr (!ON) { asm volatile("" : "+v"(acc) : "v"(a), "v"(b)); return; } asm volatile("s_nop 3\n\tv_mfma_f32_32x32x64_f8f6f4 %0, %1, %2, %0" : "+v"(acc) : "v"(a), "v"(b)); }
template <bool ON = true> __device__ __forceinline__ void mfma64z(f32x16& acc, const v8i& a, const v8i& b) { if constexpr (!ON) { acc = f32x16{}; asm volatile("" : "+v"(acc) : "v"(a), "v"(b)); return; } asm volatile("s_nop 3\n\tv_mfma_f32_32x32x64_f8f6f4 %0, %1, %2, 0" : "=v"(acc) : "v"(a), "v"(b)); }
template <bool ON = true> __device__ __forceinline__ void mfma64c(f32x16& acc, const v8i& a, const v8i& b, const f32x16& cin) { if constexpr (!ON) { acc = cin; asm volatile("" : "+v"(acc) : "v"(a), "v"(b)); return; } asm volatile("s_nop 3\n\tv_mfma_f32_32x32x64_f8f6f4 %0, %1, %2, %3" : "=&v"(acc) : "v"(a), "v"(b), "v"(cin)); }
#define MFMA_DRAIN2(X, Y) asm volatile("s_nop 15\n\ts_nop 7" : "+v"(X), "+v"(Y))
#define MFMA_DRAIN4(A, B, C_, D) asm volatile("s_nop 15\n\ts_nop 7" : "+v"(A), "+v"(B), "+v"(C_), "+v"(D))
__device__ __forceinline__ v8i ld32(const char* p0, const char* p1) { const v4i a = *reinterpret_cast<const v4i*>(p0), b = *reinterpret_cast<const v4i*>(p1); return __builtin_shufflevector(a, b, 0, 1, 2, 3, 4, 5, 6, 7); }
__device__ __forceinline__ unsigned pk4(float a, float b, float c, float d) { int w = __builtin_amdgcn_cvt_pk_fp8_f32(a, b, 0, false); w = __builtin_amdgcn_cvt_pk_fp8_f32(c, d, w, true); return (unsigned)w; }

template <int VAR = 0> __device__ __forceinline__ void mla8_unit(int b, int h, int qb, const unsigned char* __restrict__ Q8, const unsigned char* __restrict__ K8, const unsigned char* __restrict__ VT8, unsigned char* __restrict__ O8, float oscale, char* lds, unsigned* tstat = nullptr) {
  int tid_ = threadIdx.x; asm volatile("" : "+v"(tid_));
  const int tid = tid_, lane = tid & 63, r32 = lane & 31, hi = lane >> 5; const int wid = __builtin_amdgcn_readfirstlane(tid >> 6);
  unsigned long long tM_ = 0, tV_ = 0, tW_ = 0, ts0_ = 0, ts1_ = 0, ts2_ = 0, ts3_ = 0, ts4_ = 0;
#define STAMP(x) do { if constexpr (VAR & 8) { __builtin_amdgcn_sched_barrier(0); asm volatile("s_memtime %0\n\ts_waitcnt lgkmcnt(0)" : "=s"(x) :: "memory"); __builtin_amdgcn_sched_barrier(0); } } while (0)
  float* ws = (float*)(lds + OFF_WS) + wid * 64; float* li_l = ws; float* al_l = ws + 32;
  const unsigned lds0 = (unsigned)(uintptr_t)lds;
  const long rowbase = (long)b * SEQ;
  constexpr float C = 1.0f / SQ8;
  const int l4 = lane >> 2, pc = lane & 3;
  const unsigned char* src0; const unsigned char* src1; const unsigned char* src2; unsigned dst0, dst1, dst2;
  { auto piece = [&](int id, const unsigned char*& src, unsigned& dst) {
      if (id < 12) { const int ks = id >> 2, rb = id & 3, i = 16 * rb + l4, key = 32 * ((i >> 2) & 1) + 16 * (i >> 5) + (i & 3) + 4 * ((i & 31) >> 3), c = pc ^ ((i >> 2) & 3);
        src = K8 + ((size_t)(rowbase + key) * 16 + h) * 192 + 64 * ks + 16 * c; dst = OFF_K + ks * 4096 + rb * 1024; }
      else { const int vid = id - 12, dblk = vid >> 1, hb = vid & 1, d = 32 * dblk + 16 * hb + l4, c = pc ^ ((d >> 2) & 3);
        src = VT8 + ((size_t)(b * 16 + h) * 128 + d) * SEQ + 16 * c; dst = OFF_V + dblk * 2048 + hb * 1024; } };
    piece(wid, src0, dst0); piece(wid + 8, src1, dst1); piece(wid < 4 ? wid + 16 : wid + 8, src2, dst2); }
  const size_t kstepK = (size_t)KVBLK * 16 * 192, kstepV = KVBLK;
  const size_t st0 = (wid < 8) ? kstepK : kstepV, st1 = (wid + 8 < 12) ? kstepK : kstepV, st2 = kstepV;
  const unsigned sl0 = (wid < 8) ? KT_BYTES : VT_BYTES, sl1 = (wid + 8 < 12) ? KT_BYTES : VT_BYTES, sl2 = VT_BYTES;
#define DMA_TILE(t, slot) do { glds16(src0 + (size_t)(t) * st0, (unsigned)__builtin_amdgcn_readfirstlane(lds0 + dst0 + (slot) * sl0)); \
    glds16(src1 + (size_t)(t) * st1, (unsigned)__builtin_amdgcn_readfirstlane(lds0 + dst1 + (slot) * sl1)); \
    if (wid < 4) glds16(src2 + (size_t)(t) * st2, (unsigned)__builtin_amdgcn_readfirstlane(lds0 + dst2 + (slot) * sl2)); } while (0)
#define WAIT_TILES_BEHIND(n) do { if (wid < 4) { if ((n) == 2) asm volatile("s_waitcnt vmcnt(6)" ::: "memory"); else if ((n) == 1) asm volatile("s_waitcnt vmcnt(3)" ::: "memory"); else asm volatile("s_waitcnt vmcnt(0)" ::: "memory"); } \
    else { if ((n) == 2) asm volatile("s_waitcnt vmcnt(4)" ::: "memory"); else if ((n) == 1) asm volatile("s_waitcnt vmcnt(2)" ::: "memory"); else asm volatile("s_waitcnt vmcnt(0)" ::: "memory"); } } while (0)
  const int sw = (r32 >> 2) & 3;
  const int kA = r32 * 64 + (((2 * hi) ^ sw) << 4), kB = r32 * 64 + (((2 * hi + 1) ^ sw) << 4);
  __syncthreads();
  const int NT = SEQ / KVBLK;
  DMA_TILE(0, 0); DMA_TILE(1, 1); DMA_TILE(2, 2);
  v8i qf[3];
  { const unsigned char* qp = Q8 + (size_t)(rowbase + qb * 256 + wid * 32 + r32) * 3072 + h * 192 + 32 * hi;
#pragma unroll
    for (int ks = 0; ks < 3; ++ks) qf[ks] = ld32((const char*)qp + 64 * ks, (const char*)qp + 64 * ks + 16); }
  asm volatile("" : "+v"(qf[0]), "+v"(qf[1]), "+v"(qf[2]));
  float m_reg = 0.f; f32x16 o[5]; f32x16 negm;
#pragma unroll
  for (int d = 0; d < 5; ++d) o[d] = f32x16{};
  { float nm0 = PSH; asm volatile("" : "+v"(nm0));
#pragma unroll
    for (int r = 0; r < 16; ++r) negm[r] = nm0; }
  v8i pa = {0, 0, 0, 0, 0, 0, 0, 0};
  const v8i ones8 = {0x38383838, 0x38383838, 0x38383838, 0x38383838, 0x38383838, 0x38383838, 0x38383838, 0x38383838};
  v8i ka[3], kb[3];
  __syncthreads();
#pragma unroll
  for (int ks = 0; ks < 3; ++ks) { ka[ks] = ld32(lds + OFF_K + ks * 4096 + kA, lds + OFF_K + ks * 4096 + kB); kb[ks] = ld32(lds + OFF_K + ks * 4096 + 2048 + kA, lds + OFF_K + ks * 4096 + 2048 + kB); }
  if (wid >= 4) __builtin_amdgcn_s_barrier();
  int slot = 0, slotp = 0, slot3 = 3;
#pragma unroll 1
  for (int t = 0; t < NT; ++t) {
    STAMP(ts0_);
    __builtin_amdgcn_s_barrier(); asm volatile("" ::: "memory");
    STAMP(ts1_);
    const bool dma_on = !(VAR & 4) && (t + 3 < NT);
    const char* Kt = lds + OFF_K + slot * KT_BYTES; const char* Vp = lds + OFF_V + slotp * VT_BYTES;
    f32x16 p0, p1;
    v8i vb0, vb1;
    __builtin_amdgcn_s_setprio(2);
    mfma64c<!(VAR & 2)>(p0, ka[0], qf[0], negm);
    if (dma_on) glds16(src0 + (size_t)(t + 3) * st0, (unsigned)__builtin_amdgcn_readfirstlane(lds0 + dst0 + slot3 * sl0));
    mfma64c<!(VAR & 2)>(p1, kb[0], qf[0], negm);
    __builtin_amdgcn_sched_barrier(0); vb0 = ld32(Vp + kA, Vp + kB); __builtin_amdgcn_sched_barrier(0);
    mfma64<!(VAR & 2)>(p0, ka[1], qf[1]);
    if (dma_on) glds16(src1 + (size_t)(t + 3) * st1, (unsigned)__builtin_amdgcn_readfirstlane(lds0 + dst1 + slot3 * sl1));
    mfma64<!(VAR & 2)>(p1, kb[1], qf[1]);
    __builtin_amdgcn_sched_barrier(0); vb1 = ld32(Vp + 2048 + kA, Vp + 2048 + kB); __builtin_amdgcn_sched_barrier(0);
    mfma64<!(VAR & 2)>(p0, ka[2], qf[2]);
    if (dma_on && wid < 4) glds16(src2 + (size_t)(t + 3) * st2, (unsigned)__builtin_amdgcn_readfirstlane(lds0 + dst2 + slot3 * sl2));
    mfma64<!(VAR & 2)>(p1, kb[2], qf[2]);
    mfma64<!(VAR & 2)>(o[4], pa, ones8);
    mfma64<!(VAR & 2)>(o[0], pa, vb0);
    __builtin_amdgcn_sched_barrier(0);
    { const v8i vb2 = ld32(Vp + 2 * 2048 + kA, Vp + 2 * 2048 + kB);
      __builtin_amdgcn_sched_barrier(0);
      mfma64<!(VAR & 2)>(o[1], pa, vb1);
      __builtin_amdgcn_sched_barrier(0);
      const v8i vb3 = ld32(Vp + 3 * 2048 + kA, Vp + 3 * 2048 + kB);
      __builtin_amdgcn_sched_barrier(0);
      mfma64<!(VAR & 2)>(o[2], pa, vb2);
      mfma64<!(VAR & 2)>(o[3], pa, vb3); }
    __builtin_amdgcn_s_setprio(0);
    { const int ahead = (NT - 2 - t) < 2 ? (NT - 2 - t) : 2; if (ahead >= 2) WAIT_TILES_BEHIND(2); else if (ahead == 1) WAIT_TILES_BEHIND(1); else WAIT_TILES_BEHIND(0); }
    asm volatile("s_waitcnt lgkmcnt(0)" ::: "memory");
    STAMP(ts2_);
    __builtin_amdgcn_s_barrier(); asm volatile("" ::: "memory");
    STAMP(ts3_);
    { const char* Kn = lds + OFF_K + ((slot == NSLOT - 1) ? 0 : slot + 1) * KT_BYTES;
      if (t + 1 < NT) {
#pragma unroll
        for (int ks = 0; ks < 3; ++ks) { ka[ks] = ld32(Kn + ks * 4096 + kA, Kn + ks * 4096 + kB); kb[ks] = ld32(Kn + ks * 4096 + 2048 + kA, Kn + ks * 4096 + 2048 + kB); } } }
    MFMA_DRAIN2(p0, p1);
    if constexpr (VAR & 1) { asm volatile("" : "+v"(p0), "+v"(p1)); } else {
    float pmax = p0[0];
#pragma unroll
    for (int r = 1; r < 16; ++r) pmax = fmaxf(pmax, p0[r]);
#pragma unroll
    for (int r = 0; r < 16; ++r) pmax = fmaxf(pmax, p1[r]);
    { auto rr = __builtin_amdgcn_permlane32_swap(__float_as_uint(pmax), __float_as_uint(pmax), false, false); pmax = fmaxf(__uint_as_float(rr[0]), __uint_as_float(rr[1])); }
    const float grow = pmax - PSH;
    if (t == 0 || !__all(grow <= THR8)) {
      const float delta = (t == 0) ? grow : fmaxf(grow, 0.f);
      const float alpha = (t == 0) ? 1.f : __builtin_amdgcn_exp2f(-delta); m_reg += delta;
      if (hi == 0) al_l[r32] = alpha; asm volatile("s_waitcnt lgkmcnt(0)" ::: "memory");
      MFMA_DRAIN4(o[0], o[1], o[2], o[3]); asm volatile("s_nop 7" : "+v"(o[4]));
#pragma unroll
      for (int d = 0; d < 5; ++d)
#pragma unroll
        for (int r = 0; r < 16; ++r) o[d][r] *= al_l[crow(r, hi)];
#pragma unroll
      for (int r = 0; r < 16; ++r) { p0[r] -= delta; p1[r] -= delta; }
      const float nm = PSH - m_reg;
#pragma unroll
      for (int r = 0; r < 16; ++r) negm[r] = nm;
      asm volatile("" : "+v"(negm)); }
#pragma unroll
    for (int r = 0; r < 16; ++r) { p0[r] = __builtin_amdgcn_exp2f(p0[r]); p1[r] = __builtin_amdgcn_exp2f(p1[r]); } }
    pa[0] = (int)pk4(p0[0], p0[1], p0[2], p0[3]); pa[1] = (int)pk4(p0[4], p0[5], p0[6], p0[7]); pa[2] = (int)pk4(p0[8], p0[9], p0[10], p0[11]); pa[3] = (int)pk4(p0[12], p0[13], p0[14], p0[15]);
    pa[4] = (int)pk4(p1[0], p1[1], p1[2], p1[3]); pa[5] = (int)pk4(p1[4], p1[5], p1[6], p1[7]); pa[6] = (int)pk4(p1[8], p1[9], p1[10], p1[11]); pa[7] = (int)pk4(p1[12], p1[13], p1[14], p1[15]);
    asm volatile("" : "+v"(ka[0]), "+v"(ka[1]), "+v"(ka[2]), "+v"(kb[0]), "+v"(kb[1]), "+v"(kb[2]));
    slotp = slot; slot = (slot == NSLOT - 1) ? 0 : slot + 1; slot3 = (slot3 == NSLOT - 1) ? 0 : slot3 + 1;
    STAMP(ts4_);
    if constexpr (VAR & 8) { tW_ += (ts1_ - ts0_) + (ts3_ - ts2_); tM_ += ts2_ - ts1_; tV_ += ts4_ - ts3_; }
  }
  if constexpr (VAR & 8) { if (tstat && blockIdx.x == 77 && tid == 64 * 5) { tstat[0] = (unsigned)(tM_ >> 4); tstat[1] = (unsigned)(tV_ >> 4); tstat[2] = (unsigned)(tW_ >> 4); } }
#undef STAMP
  if (wid < 4) __builtin_amdgcn_s_barrier();
  { const char* Vp = lds + OFF_V + slotp * VT_BYTES;
    mfma64(o[4], pa, ones8);
#pragma unroll
    for (int d = 0; d < 4; ++d) { const v8i vb = ld32(Vp + d * 2048 + kA, Vp + d * 2048 + kB); mfma64(o[d], pa, vb); } }
  MFMA_DRAIN4(o[0], o[1], o[2], o[3]); asm volatile("s_nop 15\n\ts_nop 7" : "+v"(o[4]));
  float rli[16];
#pragma unroll
  for (int r = 0; r < 16; ++r) rli[r] = __builtin_amdgcn_rcpf(o[4][r]) * oscale;
  unsigned char* Ow = O8 + (size_t)(rowbase + qb * 256 + wid * 32) * 2048 + h * 128;
#pragma unroll
  for (int r = 0; r < 16; ++r) { const int orow = crow(r, hi);
#pragma unroll
    for (int d0 = 0; d0 < 4; ++d0) Ow[(long)orow * 2048 + d0 * 32 + r32] = (unsigned char)(__builtin_amdgcn_cvt_pk_fp8_f32(o[d0][r] * rli[r], 0.f, 0, false) & 0xff); }
#undef DMA_TILE
#undef WAIT_TILES_BEHIND
#undef MFMA_DRAIN2
#undef MFMA_DRAIN4
}
}

namespace peer {
#define PLAS __attribute__((address_space(3)))
using bf16x8 = __attribute__((ext_vector_type(8))) short;
using bf16x2 = __attribute__((ext_vector_type(2))) __bf16;
using f32x16 = __attribute__((ext_vector_type(16))) float;
using f32x4  = __attribute__((ext_vector_type(4))) float;
using u32x4  = __attribute__((ext_vector_type(4))) unsigned;
using u32x2  = __attribute__((ext_vector_type(2))) unsigned;
typedef unsigned short bf16_t;
__device__ __forceinline__ int f2ord(float f) { const int u = __float_as_int(f); return u ^ ((u >> 31) & 0x7fffffff); }
__device__ __forceinline__ float ord2f(int s) { return __int_as_float(s ^ ((s >> 31) & 0x7fffffff)); }
__device__ __forceinline__ int crow(int r, int hi) { return (r & 3) + 8 * (r >> 2) + 4 * hi; }
__device__ __forceinline__ unsigned cvtpk(float lo, float hi) { unsigned r; asm volatile("v_cvt_pk_bf16_f32 %0, %1, %2" : "=v"(r) : "v"(lo), "v"(hi)); return r; }
__device__ __forceinline__ float bf_lo(unsigned w) { return __uint_as_float(w << 16); }
__device__ __forceinline__ float bf_hi(unsigned w) { return __uint_as_float(w & 0xffff0000u); }
__device__ __forceinline__ int swapmax(int m) { auto rr = __builtin_amdgcn_permlane32_swap((unsigned)m, (unsigned)m, false, false); const int a = (int)rr[0], b = (int)rr[1]; return a > b ? a : b; }

struct CandTab { int ci[50], cj[50]; };
constexpr CandTab make_cands() { CandTab t{}; int n = 0; for (int i = 0; i < 16; ++i) for (int j = 0; j < 16; ++j) if ((i + 1) * (j + 1) <= 16) { t.ci[n] = i; t.cj[n] = j; ++n; } return t; }
constexpr CandTab CT = make_cands();

constexpr int SEL_LDS_PER_WAVE = (2 * 16 + 16) * 64 * 4;

__device__ __forceinline__ void select32(int t0, int h, const float* __restrict__ QP, const bf16_t* __restrict__ SUBH, const bf16_t* __restrict__ SUBL, int* __restrict__ IDX, float* __restrict__ GATE, PLAS int* wl, int lane_) {
  int lane = lane_; asm volatile("" : "+v"(lane));
  const int r32 = lane & 31, hi = lane >> 5;
  PLAS int* topl = wl; PLAS int* winl = wl + 2 * 16 * 64;
  const float* qrow = QP + (size_t)(t0 + r32) * 2048;
  {
#pragma unroll 1
    for (int p = 0; p < 2; ++p) {
      bf16x8 qh[8], ql[8];
      const float* qp = qrow + h * 256 + p * 128 + hi * 8;
#pragma unroll
      for (int d0 = 0; d0 < 8; ++d0) {
        const f32x4 a = *(const f32x4*)(qp + d0 * 16), b = *(const f32x4*)(qp + d0 * 16 + 4);
        u32x4 wh, wlw;
        wh.x = cvtpk(a[0], a[1]); wh.y = cvtpk(a[2], a[3]); wh.z = cvtpk(b[0], b[1]); wh.w = cvtpk(b[2], b[3]);
        wlw.x = cvtpk(a[0] - bf_lo(wh.x), a[1] - bf_hi(wh.x)); wlw.y = cvtpk(a[2] - bf_lo(wh.y), a[3] - bf_hi(wh.y));
        wlw.z = cvtpk(b[0] - bf_lo(wh.z), b[1] - bf_hi(wh.z)); wlw.w = cvtpk(b[2] - bf_lo(wh.w), b[3] - bf_hi(wh.w));
        qh[d0] = *reinterpret_cast<bf16x8*>(&wh); ql[d0] = *reinterpret_cast<bf16x8*>(&wlw);
      }
      const size_t soff = ((size_t)(h * 2 + p) * 128 + r32) * 128 + hi * 8;
      int key[64];
#pragma unroll
      for (int kb = 0; kb < 4; ++kb) {
        f32x16 acc = f32x16{};
#pragma unroll
        for (int d0 = 0; d0 < 8; ++d0) {
          const bf16x8 ah = *reinterpret_cast<const bf16x8*>(SUBH + soff + (size_t)kb * 32 * 128 + d0 * 16);
          const bf16x8 al = *reinterpret_cast<const bf16x8*>(SUBL + soff + (size_t)kb * 32 * 128 + d0 * 16);
          acc = __builtin_amdgcn_mfma_f32_32x32x16_bf16(ah, qh[d0], acc, 0, 0, 0);
          acc = __builtin_amdgcn_mfma_f32_32x32x16_bf16(ah, ql[d0], acc, 0, 0, 0);
          acc = __builtin_amdgcn_mfma_f32_32x32x16_bf16(al, qh[d0], acc, 0, 0, 0);
        }
#pragma unroll
        for (int r = 0; r < 16; ++r) key[kb * 16 + r] = (f2ord(acc[r]) & ~127) | (kb * 32 + crow(r, hi));
      }
#pragma unroll 1
      for (int it = 0; it < 16; ++it) {
        int m = key[0];
#pragma unroll
        for (int i = 1; i < 64; ++i) m = key[i] > m ? key[i] : m;
        const int gm = swapmax(m);
        topl[(p * 16 + it) * 64 + lane] = gm;
#pragma unroll
        for (int i = 0; i < 64; ++i) key[i] = (key[i] == gm) ? (int)0x80000000 : key[i];
      }
    }
    int ck[25];
#pragma unroll
    for (int c = 0; c < 25; ++c) {
      const int i = hi ? CT.ci[2 * c + 1] : CT.ci[2 * c], j = hi ? CT.cj[2 * c + 1] : CT.cj[2 * c];
      const int k0 = topl[i * 64 + lane], k1 = topl[(16 + j) * 64 + lane];
      const float s = ord2f(k0 & ~127) + ord2f(k1 & ~127);
      ck[c] = (f2ord(s) & ~255) | (i << 4) | j;
    }
#pragma unroll 1
    for (int it = 0; it < 16; ++it) {
      int m = ck[0];
#pragma unroll
      for (int i = 1; i < 25; ++i) m = ck[i] > m ? ck[i] : m;
      const int gm = swapmax(m);
      winl[it * 64 + lane] = gm;
#pragma unroll
      for (int i = 0; i < 25; ++i) ck[i] = (ck[i] == gm) ? (int)0x80000000 : ck[i];
    }
    float e[16]; int wv[16]; float tot = 0.f;
    const float s0 = ord2f(winl[lane] & ~255);
#pragma unroll
    for (int k = 0; k < 16; ++k) { wv[k] = winl[k * 64 + lane]; e[k] = __builtin_amdgcn_exp2f((ord2f(wv[k] & ~255) - s0) * 1.4426950408889634f); tot += e[k]; }
    const float rtot = 1.0f / tot;
    int l2_ = lane_; asm volatile("" : "+v"(l2_));
    const size_t ob = (size_t)(t0 + (l2_ & 31)) * 128 + h * 16 + (l2_ >> 5) * 8;
#pragma unroll
    for (int k = 0; k < 8; ++k) {
      const int w = hi ? wv[8 + k] : wv[k]; const float ev = hi ? e[8 + k] : e[k];
      const int i = (w >> 4) & 15, j = w & 15;
      const int e0 = topl[i * 64 + lane] & 127, e1 = topl[(16 + j) * 64 + lane] & 127;
      IDX[ob + k] = e0 * 128 + e1; GATE[ob + k] = ev * rtot;
    }
  }
}

__device__ __forceinline__ float dot2(unsigned w, unsigned x, float acc) { return __builtin_amdgcn_fdot2_f32_bf16(__builtin_bit_cast(bf16x2, w), __builtin_bit_cast(bf16x2, x), acc, false); }
__device__ __forceinline__ float gelu_erf(float v) {
  const float av = fabsf(v), d = av * 0.2316418882f + 1.0f, t = __builtin_amdgcn_rcpf(d);
  float q = t * 0.5307027145f + (-0.7265760135f); q = q * t + 0.7107068705f; q = q * t + (-0.142248368f); q = q * t + 0.127414796f; q = q * t;
  const float e = __builtin_amdgcn_exp2f((v * v) * (-0.72134752044f));
  const float m = v * (q * e);
  return v < 0.f ? m : v - m;
}
__device__ __forceinline__ float wave_sum(float v) {
#pragma unroll
  for (int o = 1; o < 64; o <<= 1) v += __shfl_xor(v, o);
  return v;
}

typedef float f32x2 __attribute__((ext_vector_type(2)));
constexpr float USCALE = 64.0f, VSCALE = 4.0f;
__device__ __forceinline__ f32x2 fp8x2(unsigned w, bool hiword) { return hiword ? __builtin_amdgcn_cvt_pk_f32_fp8((int)w, true) : __builtin_amdgcn_cvt_pk_f32_fp8((int)w, false); }
template <bool STORE, bool FAKE = false> __device__ __forceinline__ void expert_token(int t, const bf16_t* __restrict__ H2, const unsigned char* __restrict__ U8, const unsigned char* __restrict__ V8, const int* __restrict__ IDX, const float* __restrict__ GATE,
                                             float* X1OUT, const float* __restrict__ fnorm, int lane_) {
  int lane = lane_; asm volatile("" : "+v"(lane));
  f32x2 hf[4][8];
  { const u32x4* hp = (const u32x4*)(H2 + (size_t)t * 4096) + 2 * lane;
#pragma unroll
    for (int k = 0; k < 4; ++k) { const u32x4 a = hp[128 * k], b = hp[128 * k + 1];
      hf[k][0] = (f32x2){bf_lo(a.x), bf_hi(a.x)}; hf[k][1] = (f32x2){bf_lo(a.y), bf_hi(a.y)}; hf[k][2] = (f32x2){bf_lo(a.z), bf_hi(a.z)}; hf[k][3] = (f32x2){bf_lo(a.w), bf_hi(a.w)};
      hf[k][4] = (f32x2){bf_lo(b.x), bf_hi(b.x)}; hf[k][5] = (f32x2){bf_lo(b.y), bf_hi(b.y)}; hf[k][6] = (f32x2){bf_lo(b.z), bf_hi(b.z)}; hf[k][7] = (f32x2){bf_lo(b.w), bf_hi(b.w)}; } }
  const int e0 = FAKE ? lane : IDX[(size_t)t * 128 + lane], e1 = FAKE ? lane + 64 : IDX[(size_t)t * 128 + 64 + lane];
  const float g0 = GATE[(size_t)t * 128 + lane], g1 = GATE[(size_t)t * 128 + 64 + lane];
  float c0 = 0.f, c1 = 0.f;
  u32x4 r0[4], r1[4], r2[4], r3[4];
#define ELOAD(dst, jj) do { const int jx_ = (jj); if (jx_ < 256) { const int sl_ = jx_ & 127; const int e_ = __builtin_amdgcn_readlane(sl_ < 64 ? e0 : e1, sl_ & 63); \
    const u32x4* rp_ = (const u32x4*)((jx_ < 128 ? U8 : V8) + (size_t)e_ * 4096) + lane; _Pragma("unroll") for (int k = 0; k < 4; ++k) dst[k] = rp_[64 * k]; } \
    asm volatile("" ::: "memory"); __builtin_amdgcn_sched_barrier(0); } while (0)
#define UDOT(R, OUT) do { f32x2 a0_ = {0.f, 0.f}, a1_ = {0.f, 0.f}, a2_ = {0.f, 0.f}, a3_ = {0.f, 0.f}; \
    _Pragma("unroll") for (int k = 0; k < 4; ++k) { \
      a0_ += fp8x2(R[k].x, false) * hf[k][0]; a1_ += fp8x2(R[k].x, true) * hf[k][1]; a2_ += fp8x2(R[k].y, false) * hf[k][2]; a3_ += fp8x2(R[k].y, true) * hf[k][3]; \
      a0_ += fp8x2(R[k].z, false) * hf[k][4]; a1_ += fp8x2(R[k].z, true) * hf[k][5]; a2_ += fp8x2(R[k].w, false) * hf[k][6]; a3_ += fp8x2(R[k].w, true) * hf[k][7]; } \
    a0_ += a1_; a2_ += a3_; a0_ += a2_; OUT = a0_.x + a0_.y; } while (0)
  ELOAD(r0, 0); ELOAD(r1, 1); ELOAD(r2, 2); ELOAD(r3, 3);
#pragma unroll 1
  for (int g = 0; g < 16; ++g) {
    float p[8];
    const int j = g * 8;
    UDOT(r0, p[0]); ELOAD(r0, j + 4); UDOT(r1, p[1]); ELOAD(r1, j + 5); UDOT(r2, p[2]); ELOAD(r2, j + 6); UDOT(r3, p[3]); ELOAD(r3, j + 7);
    UDOT(r0, p[4]); ELOAD(r0, j + 8); UDOT(r1, p[5]); ELOAD(r1, j + 9); UDOT(r2, p[6]); ELOAD(r2, j + 10); UDOT(r3, p[7]); ELOAD(r3, j + 11);
    float q4[4], q2[2], q1;
    { const bool up = (lane & 32) != 0;
#pragma unroll
      for (int i = 0; i < 4; ++i) { const float send = up ? p[i] : p[4 + i], keep = up ? p[4 + i] : p[i]; q4[i] = keep + __shfl_xor(send, 32); } }
    { const bool up = (lane & 16) != 0;
#pragma unroll
      for (int i = 0; i < 2; ++i) { const float send = up ? q4[i] : q4[2 + i], keep = up ? q4[2 + i] : q4[i]; q2[i] = keep + __shfl_xor(send, 16); } }
    { const bool up = (lane & 8) != 0; const float send = up ? q2[0] : q2[1], keep = up ? q2[1] : q2[0]; q1 = keep + __shfl_xor(send, 8); }
    q1 += __shfl_xor(q1, 4); q1 += __shfl_xor(q1, 2); q1 += __shfl_xor(q1, 1);
    const float got = __shfl(q1, 8 * (lane & 7));
    if ((lane >> 3) == (g & 7)) { if (g < 8) c0 = got; else c1 = got; }
  }
#undef UDOT
  c0 = g0 * gelu_erf(c0 * (1.0f / USCALE)) * (1.0f / VSCALE); c1 = g1 * gelu_erf(c1 * (1.0f / USCALE)) * (1.0f / VSCALE);
  f32x2 acc[4][8];
#pragma unroll
  for (int k = 0; k < 4; ++k)
#pragma unroll
    for (int i = 0; i < 8; ++i) acc[k][i] = (f32x2){0.f, 0.f};
#define VROW(R, C) do { const f32x2 cc_ = {(C), (C)}; _Pragma("unroll") for (int k = 0; k < 4; ++k) { \
      acc[k][0] += cc_ * fp8x2(R[k].x, false); acc[k][1] += cc_ * fp8x2(R[k].x, true); acc[k][2] += cc_ * fp8x2(R[k].y, false); acc[k][3] += cc_ * fp8x2(R[k].y, true); \
      acc[k][4] += cc_ * fp8x2(R[k].z, false); acc[k][5] += cc_ * fp8x2(R[k].z, true); acc[k][6] += cc_ * fp8x2(R[k].w, false); acc[k][7] += cc_ * fp8x2(R[k].w, true); } } while (0)
#define CJ(j) __int_as_float(__builtin_amdgcn_readlane(__float_as_int((j) < 64 ? c0 : c1), (j) & 63))
#pragma unroll 1
  for (int j = 0; j < 128; j += 4) {
    { const float c = CJ(j); VROW(r0, c); __builtin_amdgcn_sched_barrier(0); ELOAD(r0, 128 + j + 4); }
    { const float c = CJ(j + 1); VROW(r1, c); __builtin_amdgcn_sched_barrier(0); ELOAD(r1, 128 + j + 5); }
    { const float c = CJ(j + 2); VROW(r2, c); __builtin_amdgcn_sched_barrier(0); ELOAD(r2, 128 + j + 6); }
    { const float c = CJ(j + 3); VROW(r3, c); __builtin_amdgcn_sched_barrier(0); ELOAD(r3, 128 + j + 7); }
  }
#undef VROW
#undef CJ
#undef ELOAD
  int xo_ = 16 * lane; asm volatile("" : "+v"(xo_));
  float* xr = X1OUT + (size_t)t * 4096 + xo_; float ss = 0.f;
#ifdef PROBE_PEER_SCALE
#pragma unroll
  for (int k = 0; k < 4; ++k)
#pragma unroll
    for (int i = 0; i < 8; ++i) acc[k][i] *= PROBE_PEER_SCALE;
#endif
#pragma unroll
  for (int k = 0; k < 4; ++k)
#pragma unroll
    for (int q = 0; q < 4; ++q) { const f32x4 a = *(const f32x4*)(xr + 1024 * k + 4 * q);
      acc[k][2 * q] += (f32x2){a[0], a[1]}; acc[k][2 * q + 1] += (f32x2){a[2], a[3]};
      ss += acc[k][2 * q].x * acc[k][2 * q].x + acc[k][2 * q].y * acc[k][2 * q].y + acc[k][2 * q + 1].x * acc[k][2 * q + 1].x + acc[k][2 * q + 1].y * acc[k][2 * q + 1].y; }
  const float rstd = 1.0f / sqrtf(wave_sum(ss) * (1.0f / 4096.0f) + 1e-6f);
  const float* fn = fnorm + xo_;
#pragma unroll
  for (int k = 0; k < 4; ++k)
#pragma unroll
    for (int q = 0; q < 4; ++q) { const f32x4 g = *(const f32x4*)(fn + 1024 * k + 4 * q);
      f32x4 o; o[0] = acc[k][2 * q].x * rstd * g[0]; o[1] = acc[k][2 * q].y * rstd * g[1]; o[2] = acc[k][2 * q + 1].x * rstd * g[2]; o[3] = acc[k][2 * q + 1].y * rstd * g[3];
      if constexpr (STORE) { *(f32x4*)(xr + 1024 * k + 4 * q) = o; } else { asm volatile("" :: "v"(o)); } }
}
typedef unsigned v6u __attribute__((ext_vector_type(6)));
typedef float v32f __attribute__((ext_vector_type(32)));
typedef __bf16 v32bf __attribute__((ext_vector_type(32)));
typedef unsigned v16u __attribute__((ext_vector_type(16)));
constexpr float U6SCALE = 128.0f, V6SCALE = 4.0f;
constexpr int ROW6 = 3072;
__device__ __forceinline__ unsigned f32_to_e2m3(float x) {
  const unsigned sgn = (__float_as_uint(x) >> 26) & 32u; float a = fminf(fabsf(x), 7.5f);
  unsigned code;
  if (a < 1.0f) { code = (unsigned)__builtin_rintf(a * 8.0f); }
  else { unsigned u = __float_as_uint(a); u += 0x7FFFFu + ((u >> 20) & 1u); const unsigned e = (u >> 23) - 127u, m = (u >> 20) & 7u; code = ((e + 1u) << 3) | m; code = code > 31u ? 31u : code; }
  return code | sgn;
}
typedef float v16f __attribute__((ext_vector_type(16)));
__device__ __forceinline__ void pack_row_fp6(const float* __restrict__ src, unsigned char* __restrict__ dst, float scale, int lane) {
  const f32x4* sp = (const f32x4*)(src + 16 * lane);
  v16f c[4];
#pragma unroll
  for (int j = 0; j < 4; ++j)
#pragma unroll
    for (int q = 0; q < 4; ++q) { const f32x4 v = sp[256 * j + q] * scale; c[j][4 * q] = v[0]; c[j][4 * q + 1] = v[1]; c[j][4 * q + 2] = v[2]; c[j][4 * q + 3] = v[3]; }
  v16f ea, oa, eb, ob;
#pragma unroll
  for (int i = 0; i < 8; ++i) { ea[i] = c[0][2 * i]; oa[i] = c[0][2 * i + 1]; ea[8 + i] = c[1][2 * i]; oa[8 + i] = c[1][2 * i + 1]; eb[i] = c[2][2 * i]; ob[i] = c[2][2 * i + 1]; eb[8 + i] = c[3][2 * i]; ob[8 + i] = c[3][2 * i + 1]; }
  const v6u ga = __builtin_amdgcn_cvt_scalef32_2xpk16_fp6_f32(ea, oa, 1.0f), gb = __builtin_amdgcn_cvt_scalef32_2xpk16_fp6_f32(eb, ob, 1.0f);
  *(u32x4*)(dst + 16 * lane) = (u32x4){ga[0], ga[1], ga[2], ga[3]};
  *(u32x4*)(dst + 1024 + 16 * lane) = (u32x4){ga[4], ga[5], gb[0], gb[1]};
  *(u32x4*)(dst + 2048 + 16 * lane) = (u32x4){gb[2], gb[3], gb[4], gb[5]};
}
template <bool STORE, int LV = 0> __device__ __forceinline__ void expert_tokens6(int t_first, int t_step, int t_end, const bf16_t* __restrict__ H2, const unsigned char* __restrict__ U6, const unsigned char* __restrict__ V6,
                                             const int* __restrict__ IDX, const float* __restrict__ GATE, float* X1OUT, const float* __restrict__ fnorm, int lane_) {
  int lane = lane_; asm volatile("" : "+v"(lane));
  int t = t_first; if (t >= t_end) return;
  const unsigned lo16 = (unsigned)lane * 16u;
  int e0 = IDX[(size_t)t * 128 + lane], e1 = IDX[(size_t)t * 128 + 64 + lane];
  u32x4 r0[3], r1[3], r2[3], r3[3];
#define ELOAD(dst, jj, EA, EB, TAB) do { const int sl_ = (jj) & 127; const int e_ = __builtin_amdgcn_readlane(sl_ < 64 ? (EA) : (EB), sl_ & 63); \
    const unsigned char* rb_ = (TAB) + (size_t)(unsigned)e_ * ROW6; _Pragma("unroll") for (int k = 0; k < 3; ++k) dst[k] = *(const u32x4*)(rb_ + (lo16 + 1024u * ((LV & 1) && k == 2 ? 1 : k))); \
    asm volatile("" ::: "memory"); __builtin_amdgcn_sched_barrier(0); } while (0)
#define GRPA(R) ((v6u){R[0].x, R[0].y, R[0].z, R[0].w, R[1].x, R[1].y})
#define GRPB(R) ((v6u){R[1].z, R[1].w, R[2].x, R[2].y, R[2].z, R[2].w})
  ELOAD(r0, 0, e0, e1, U6); ELOAD(r1, 1, e0, e1, U6); ELOAD(r2, 2, e0, e1, U6); ELOAD(r3, 3, e0, e1, U6);
#pragma unroll 1
  for (;;) {
    const int tn = t + t_step, tnx = tn < t_end ? tn : t;
    const int e0n = IDX[(size_t)tnx * 128 + lane], e1n = IDX[(size_t)tnx * 128 + 64 + lane];
    const float g0 = GATE[(size_t)t * 128 + lane], g1 = GATE[(size_t)t * 128 + 64 + lane];
    unsigned hq[32];
    { const u32x4* hp = (const u32x4*)(H2 + (size_t)t * 4096 + 16 * lane);
#pragma unroll
      for (int q = 0; q < 8; ++q) { const u32x4 a = hp[128 * (q >> 1) + (q & 1)]; hq[4 * q] = a.x; hq[4 * q + 1] = a.y; hq[4 * q + 2] = a.z; hq[4 * q + 3] = a.w; } }
    float c0 = 0.f, c1 = 0.f;
#define UDOT(R, OUT) do { if constexpr ((LV & 2) != 0) { OUT = __uint_as_float(R[0].x ^ R[1].y ^ R[2].z); break; } float a0_ = 0.f, a1_ = 0.f, a2_ = 0.f, a3_ = 0.f; \
    asm volatile("" : "+v"(R[0].x)); \
    { const v16u b_ = __builtin_bit_cast(v16u, __builtin_amdgcn_cvt_scalef32_pk32_bf16_fp6(GRPA(R), 1.0f)); \
      _Pragma("unroll") for (int j = 0; j < 16; j += 4) { a0_ = dot2(b_[j], hq[j], a0_); a1_ = dot2(b_[j + 1], hq[j + 1], a1_); a2_ = dot2(b_[j + 2], hq[j + 2], a2_); a3_ = dot2(b_[j + 3], hq[j + 3], a3_); } } \
    asm volatile("" : "+v"(a0_), "+v"(a1_), "+v"(a2_), "+v"(a3_), "+v"(R[1].z)); \
    { const v16u b_ = __builtin_bit_cast(v16u, __builtin_amdgcn_cvt_scalef32_pk32_bf16_fp6(GRPB(R), 1.0f)); \
      _Pragma("unroll") for (int j = 0; j < 16; j += 4) { a0_ = dot2(b_[j], hq[16 + j], a0_); a1_ = dot2(b_[j + 1], hq[17 + j], a1_); a2_ = dot2(b_[j + 2], hq[18 + j], a2_); a3_ = dot2(b_[j + 3], hq[19 + j], a3_); } } \
    asm volatile("" : "+v"(a0_), "+v"(a1_), "+v"(a2_), "+v"(a3_)); \
    OUT = (a0_ + a1_) + (a2_ + a3_); } while (0)
#define RSCAT(G) do { float q4[4], q2[2], q1; \
      { const bool up = (lane & 32) != 0; _Pragma("unroll") for (int i = 0; i < 4; ++i) { const float send = up ? p[i] : p[4 + i], keep = up ? p[4 + i] : p[i]; q4[i] = keep + __shfl_xor(send, 32); } } \
      { const bool up = (lane & 16) != 0; _Pragma("unroll") for (int i = 0; i < 2; ++i) { const float send = up ? q4[i] : q4[2 + i], keep = up ? q4[2 + i] : q4[i]; q2[i] = keep + __shfl_xor(send, 16); } } \
      { const bool up = (lane & 8) != 0; const float send = up ? q2[0] : q2[1], keep = up ? q2[1] : q2[0]; q1 = keep + __shfl_xor(send, 8); } \
      q1 += __shfl_xor(q1, 4); q1 += __shfl_xor(q1, 2); q1 += __shfl_xor(q1, 1); \
      const float got = __shfl(q1, 8 * (lane & 7)); \
      if ((lane >> 3) == ((G) & 7)) { if ((G) < 8) c0 = got; else c1 = got; } } while (0)
#pragma unroll 1
    for (int g = 0; g < 15; ++g) {
      float p[8];
      const int j = g * 8;
      UDOT(r0, p[0]); ELOAD(r0, j + 4, e0, e1, U6); UDOT(r1, p[1]); ELOAD(r1, j + 5, e0, e1, U6); UDOT(r2, p[2]); ELOAD(r2, j + 6, e0, e1, U6); UDOT(r3, p[3]); ELOAD(r3, j + 7, e0, e1, U6);
      UDOT(r0, p[4]); ELOAD(r0, j + 8, e0, e1, U6); UDOT(r1, p[5]); ELOAD(r1, j + 9, e0, e1, U6); UDOT(r2, p[6]); ELOAD(r2, j + 10, e0, e1, U6); UDOT(r3, p[7]); ELOAD(r3, j + 11, e0, e1, U6);
      RSCAT(g);
    }
    { float p[8];
      UDOT(r0, p[0]); ELOAD(r0, 124, e0, e1, U6); UDOT(r1, p[1]); ELOAD(r1, 125, e0, e1, U6); UDOT(r2, p[2]); ELOAD(r2, 126, e0, e1, U6); UDOT(r3, p[3]); ELOAD(r3, 127, e0, e1, U6);
      UDOT(r0, p[4]); ELOAD(r0, 0, e0, e1, V6); UDOT(r1, p[5]); ELOAD(r1, 1, e0, e1, V6); UDOT(r2, p[6]); ELOAD(r2, 2, e0, e1, V6); UDOT(r3, p[7]); ELOAD(r3, 3, e0, e1, V6);
      RSCAT(15); }
#undef RSCAT
#undef UDOT
    c0 = g0 * gelu_erf(c0 * (1.0f / U6SCALE)) * (1.0f / V6SCALE); c1 = g1 * gelu_erf(c1 * (1.0f / U6SCALE)) * (1.0f / V6SCALE);
    float acc[64];
#pragma unroll
    for (int i = 0; i < 64; ++i) acc[i] = 0.f;
#define PIN16(B) asm volatile("" : "+v"(acc[B]), "+v"(acc[B + 1]), "+v"(acc[B + 2]), "+v"(acc[B + 3]), "+v"(acc[B + 4]), "+v"(acc[B + 5]), "+v"(acc[B + 6]), "+v"(acc[B + 7]), \
    "+v"(acc[B + 8]), "+v"(acc[B + 9]), "+v"(acc[B + 10]), "+v"(acc[B + 11]), "+v"(acc[B + 12]), "+v"(acc[B + 13]), "+v"(acc[B + 14]), "+v"(acc[B + 15]))
#define VROW(R, C) do { if constexpr ((LV & 2) != 0) { acc[0] += (C) * __uint_as_float(R[0].x ^ R[1].y ^ R[2].z); break; } asm volatile("" : "+v"(R[0].x)); \
    { const v32f f_ = __builtin_amdgcn_cvt_scalef32_pk32_f32_fp6(GRPA(R), 1.0f); _Pragma("unroll") for (int i = 0; i < 32; ++i) acc[i] += (C) * f_[i]; } PIN16(0); PIN16(16); \
    asm volatile("" : "+v"(R[1].z)); \
    { const v32f f_ = __builtin_amdgcn_cvt_scalef32_pk32_f32_fp6(GRPB(R), 1.0f); _Pragma("unroll") for (int i = 0; i < 32; ++i) acc[32 + i] += (C) * f_[i]; } PIN16(32); PIN16(48); } while (0)
#define CJ(j) __int_as_float(__builtin_amdgcn_readlane(__float_as_int((j) < 64 ? c0 : c1), (j) & 63))
#pragma unroll 1
    for (int j = 0; j < 124; j += 4) {
      { const float c = CJ(j); VROW(r0, c); ELOAD(r0, j + 4, e0, e1, V6); }
      { const float c = CJ(j + 1); VROW(r1, c); ELOAD(r1, j + 5, e0, e1, V6); }
      { const float c = CJ(j + 2); VROW(r2, c); ELOAD(r2, j + 6, e0, e1, V6); }
      { const float c = CJ(j + 3); VROW(r3, c); ELOAD(r3, j + 7, e0, e1, V6); }
    }
    { const float c = CJ(124); VROW(r0, c); ELOAD(r0, 0, e0n, e1n, U6); }
    { const float c = CJ(125); VROW(r1, c); ELOAD(r1, 1, e0n, e1n, U6); }
    { const float c = CJ(126); VROW(r2, c); ELOAD(r2, 2, e0n, e1n, U6); }
    { const float c = CJ(127); VROW(r3, c); ELOAD(r3, 3, e0n, e1n, U6); }
#undef VROW
#undef PIN16
#undef CJ
    int xo_ = 16 * lane; asm volatile("" : "+v"(xo_));
    float* xr = X1OUT + (size_t)t * 4096 + xo_; float ss = 0.f;
#pragma unroll
    for (int k = 0; k < 4; ++k) {
#pragma unroll
      for (int q = 0; q < 4; ++q) { const f32x4 a = *(const f32x4*)(xr + 1024 * k + 4 * q); const int b_ = 16 * k + 4 * q;
        acc[b_] += a[0]; acc[b_ + 1] += a[1]; acc[b_ + 2] += a[2]; acc[b_ + 3] += a[3];
        ss += (acc[b_] * acc[b_] + acc[b_ + 1] * acc[b_ + 1]) + (acc[b_ + 2] * acc[b_ + 2] + acc[b_ + 3] * acc[b_ + 3]); }
      asm volatile("" ::: "memory"); __builtin_amdgcn_sched_barrier(0); }
    const float rstd = 1.0f / sqrtf(wave_sum(ss) * (1.0f / 4096.0f) + 1e-6f);
    const float* fn = fnorm + xo_;
#pragma unroll
    for (int k = 0; k < 4; ++k) {
#pragma unroll
      for (int q = 0; q < 4; ++q) { const f32x4 g = *(const f32x4*)(fn + 1024 * k + 4 * q); const int b_ = 16 * k + 4 * q;
        f32x4 o; o[0] = acc[b_] * rstd * g[0]; o[1] = acc[b_ + 1] * rstd * g[1]; o[2] = acc[b_ + 2] * rstd * g[2]; o[3] = acc[b_ + 3] * rstd * g[3];
        if constexpr (STORE) { *(f32x4*)(xr + 1024 * k + 4 * q) = o; } else { asm volatile("" :: "v"(o)); } }
      asm volatile("" ::: "memory"); __builtin_amdgcn_sched_barrier(0); }
    if (tn >= t_end) break;
    t = tn; e0 = e0n; e1 = e1n;
  }
#undef ELOAD
#undef GRPA
#undef GRPB
}
constexpr float U4SCALE = 128.0f, V4SCALE = 5.656854249f;
constexpr int ROW4 = 2048;
__device__ __forceinline__ void pack_row_fp4(const float* __restrict__ src, unsigned char* __restrict__ dst, float scale, int lane) {
  const f32x4* sp = (const f32x4*)(src + 16 * lane);
  f32x4 c[16];
#pragma unroll
  for (int j = 0; j < 4; ++j)
#pragma unroll
    for (int q = 0; q < 4; ++q) c[4 * j + q] = sp[256 * j + q] * scale;
#pragma unroll
  for (int k = 0; k < 2; ++k) { u32x4 o;
#pragma unroll
    for (int d = 0; d < 4; ++d) { unsigned w = 0;
      const f32x4 a = c[4 * (2 * k + (d >> 1)) + 2 * (d & 1)], b = c[4 * (2 * k + (d >> 1)) + 2 * (d & 1) + 1];
      w = __builtin_amdgcn_cvt_scalef32_pk_fp4_f32(w, a[0], a[1], 1.0f, 0); w = __builtin_amdgcn_cvt_scalef32_pk_fp4_f32(w, a[2], a[3], 1.0f, 1);
      w = __builtin_amdgcn_cvt_scalef32_pk_fp4_f32(w, b[0], b[1], 1.0f, 2); w = __builtin_amdgcn_cvt_scalef32_pk_fp4_f32(w, b[2], b[3], 1.0f, 3);
      o[d] = w; }
    *(u32x4*)(dst + 1024 * k + 16 * lane) = o; }
}
template <bool STORE, int LV = 0> __device__ __forceinline__ void expert_tokens4(int t_first, int t_step, int t_end, const bf16_t* __restrict__ H2, const unsigned char* __restrict__ U4, const unsigned char* __restrict__ V4,
                                             const int* __restrict__ IDX, const float* __restrict__ GATE, const bf16_t* __restrict__ X1B, float* __restrict__ OUT, const float* __restrict__ fnorm, int lane_) {
  int lane = lane_; asm volatile("" : "+v"(lane));
  int t = t_first; if (t >= t_end) return;
  const unsigned lo16 = (unsigned)lane * 16u;
  int e0 = IDX[(size_t)t * 128 + lane], e1 = IDX[(size_t)t * 128 + 64 + lane];
  u32x4 r0[2], r1[2], r2[2], r3[2], r4[2], r5[2], r6[2], r7[2];
#define ELOAD(dst, jj, EA, EB, TAB) do { const int sl_ = (jj) & 127; const int e_ = __builtin_amdgcn_readlane(sl_ < 64 ? (EA) : (EB), sl_ & 63); \
    const unsigned char* rb_ = (TAB) + (size_t)(unsigned)e_ * ROW4; dst[0] = *(const u32x4*)(rb_ + lo16); dst[1] = *(const u32x4*)(rb_ + (lo16 + 1024u)); \
    asm volatile("" ::: "memory"); __builtin_amdgcn_sched_barrier(0); } while (0)
  ELOAD(r0, 0, e0, e1, U4); ELOAD(r1, 1, e0, e1, U4); ELOAD(r2, 2, e0, e1, U4); ELOAD(r3, 3, e0, e1, U4);
  ELOAD(r4, 4, e0, e1, U4); ELOAD(r5, 5, e0, e1, U4); ELOAD(r6, 6, e0, e1, U4); ELOAD(r7, 7, e0, e1, U4);
#pragma unroll 1
  for (;;) {
    const int tn = t + t_step, tnx = tn < t_end ? tn : t;
    const int e0n = IDX[(size_t)tnx * 128 + lane], e1n = IDX[(size_t)tnx * 128 + 64 + lane];
    const float g0 = GATE[(size_t)t * 128 + lane], g1 = GATE[(size_t)t * 128 + 64 + lane];
    unsigned hq[32];
    { const u32x4* hp = (const u32x4*)(H2 + (size_t)t * 4096 + 16 * lane);
#pragma unroll
      for (int q = 0; q < 8; ++q) { const u32x4 a = hp[128 * (q >> 1) + (q & 1)]; hq[4 * q] = a.x; hq[4 * q + 1] = a.y; hq[4 * q + 2] = a.z; hq[4 * q + 3] = a.w; } }
    float c0 = 0.f, c1 = 0.f;
#define CVB(W, B) __builtin_bit_cast(unsigned, __builtin_amdgcn_cvt_scalef32_pk_bf16_fp4((W), 1.0f, (B)))
#define UDOT(R, OUT) do { float a0_ = 0.f, a1_ = 0.f, a2_ = 0.f, a3_ = 0.f; \
    asm volatile("" : "+v"(R[0].x)); \
    _Pragma("unroll") for (int k = 0; k < 2; ++k) { _Pragma("unroll") for (int d = 0; d < 4; ++d) { const unsigned w_ = R[k][d]; const int hb_ = 16 * k + 4 * d; \
      a0_ = dot2(CVB(w_, 0), hq[hb_], a0_); a1_ = dot2(CVB(w_, 1), hq[hb_ + 1], a1_); a2_ = dot2(CVB(w_, 2), hq[hb_ + 2], a2_); a3_ = dot2(CVB(w_, 3), hq[hb_ + 3], a3_); } \
      asm volatile("" : "+v"(a0_), "+v"(a1_), "+v"(a2_), "+v"(a3_)); } \
    OUT = (a0_ + a1_) + (a2_ + a3_); } while (0)
#define RSCAT(G) do { float q4[4], q2[2], q1; \
      { const bool up = (lane & 32) != 0; _Pragma("unroll") for (int i = 0; i < 4; ++i) { const float send = up ? p[i] : p[4 + i], keep = up ? p[4 + i] : p[i]; q4[i] = keep + __shfl_xor(send, 32); } } \
      { const bool up = (lane & 16) != 0; _Pragma("unroll") for (int i = 0; i < 2; ++i) { const float send = up ? q4[i] : q4[2 + i], keep = up ? q4[2 + i] : q4[i]; q2[i] = keep + __shfl_xor(send, 16); } } \
      { const bool up = (lane & 8) != 0; const float send = up ? q2[0] : q2[1], keep = up ? q2[1] : q2[0]; q1 = keep + __shfl_xor(send, 8); } \
      q1 += __shfl_xor(q1, 4); q1 += __shfl_xor(q1, 2); q1 += __shfl_xor(q1, 1); \
      const float got = __shfl(q1, 8 * (lane & 7)); \
      if ((lane >> 3) == ((G) & 7)) { if ((G) < 8) c0 = got; else c1 = got; } } while (0)
#pragma unroll 1
    for (int g = 0; g < 15; ++g) {
      float p[8];
      const int j = g * 8;
      UDOT(r0, p[0]); ELOAD(r0, j + 8, e0, e1, U4); UDOT(r1, p[1]); ELOAD(r1, j + 9, e0, e1, U4); UDOT(r2, p[2]); ELOAD(r2, j + 10, e0, e1, U4); UDOT(r3, p[3]); ELOAD(r3, j + 11, e0, e1, U4);
      UDOT(r4, p[4]); ELOAD(r4, j + 12, e0, e1, U4); UDOT(r5, p[5]); ELOAD(r5, j + 13, e0, e1, U4); UDOT(r6, p[6]); ELOAD(r6, j + 14, e0, e1, U4); UDOT(r7, p[7]); ELOAD(r7, j + 15, e0, e1, U4);
      RSCAT(g);
    }
    { float p[8];
      UDOT(r0, p[0]); ELOAD(r0, 0, e0, e1, V4); UDOT(r1, p[1]); ELOAD(r1, 1, e0, e1, V4); UDOT(r2, p[2]); ELOAD(r2, 2, e0, e1, V4); UDOT(r3, p[3]); ELOAD(r3, 3, e0, e1, V4);
      UDOT(r4, p[4]); ELOAD(r4, 4, e0, e1, V4); UDOT(r5, p[5]); ELOAD(r5, 5, e0, e1, V4); UDOT(r6, p[6]); ELOAD(r6, 6, e0, e1, V4); UDOT(r7, p[7]); ELOAD(r7, 7, e0, e1, V4);
      RSCAT(15); }
#undef RSCAT
#undef UDOT
#undef CVB
    c0 = g0 * gelu_erf(c0 * (1.0f / U4SCALE)) * (1.0f / V4SCALE); c1 = g1 * gelu_erf(c1 * (1.0f / U4SCALE)) * (1.0f / V4SCALE);
    f32x2 acc[32];
#pragma unroll
    for (int i = 0; i < 32; ++i) acc[i] = (f32x2){0.f, 0.f};
#define PIN8(B) asm volatile("" : "+v"(acc[B]), "+v"(acc[B + 1]), "+v"(acc[B + 2]), "+v"(acc[B + 3]), "+v"(acc[B + 4]), "+v"(acc[B + 5]), "+v"(acc[B + 6]), "+v"(acc[B + 7]))
#define VROW(R, C) do { asm volatile("" : "+v"(R[0].x)); const f32x2 cc_ = (f32x2){(C), (C)}; \
    _Pragma("unroll") for (int k = 0; k < 2; ++k) { _Pragma("unroll") for (int d = 0; d < 4; ++d) { const unsigned w_ = R[k][d]; const int ab_ = 16 * k + 4 * d; \
      acc[ab_] += cc_ * __builtin_amdgcn_cvt_scalef32_pk_f32_fp4(w_, 1.0f, 0); acc[ab_ + 1] += cc_ * __builtin_amdgcn_cvt_scalef32_pk_f32_fp4(w_, 1.0f, 1); \
      acc[ab_ + 2] += cc_ * __builtin_amdgcn_cvt_scalef32_pk_f32_fp4(w_, 1.0f, 2); acc[ab_ + 3] += cc_ * __builtin_amdgcn_cvt_scalef32_pk_f32_fp4(w_, 1.0f, 3); } \
      PIN8(16 * k); PIN8(16 * k + 8); } } while (0)
#define CJ(j) __int_as_float(__builtin_amdgcn_readlane(__float_as_int((j) < 64 ? c0 : c1), (j) & 63))
#pragma unroll 1
    for (int j = 0; j < 120; j += 8) {
      { const float c = CJ(j); VROW(r0, c); ELOAD(r0, j + 8, e0, e1, V4); }
      { const float c = CJ(j + 1); VROW(r1, c); ELOAD(r1, j + 9, e0, e1, V4); }
      { const float c = CJ(j + 2); VROW(r2, c); ELOAD(r2, j + 10, e0, e1, V4); }
      { const float c = CJ(j + 3); VROW(r3, c); ELOAD(r3, j + 11, e0, e1, V4); }
      { const float c = CJ(j + 4); VROW(r4, c); ELOAD(r4, j + 12, e0, e1, V4); }
      { const float c = CJ(j + 5); VROW(r5, c); ELOAD(r5, j + 13, e0, e1, V4); }
      { const float c = CJ(j + 6); VROW(r6, c); ELOAD(r6, j + 14, e0, e1, V4); }
      { const float c = CJ(j + 7); VROW(r7, c); ELOAD(r7, j + 15, e0, e1, V4); }
    }
    { const float c = CJ(120); VROW(r0, c); ELOAD(r0, 0, e0n, e1n, U4); }
    { const float c = CJ(121); VROW(r1, c); ELOAD(r1, 1, e0n, e1n, U4); }
    { const float c = CJ(122); VROW(r2, c); ELOAD(r2, 2, e0n, e1n, U4); }
    { const float c = CJ(123); VROW(r3, c); ELOAD(r3, 3, e0n, e1n, U4); }
    { const float c = CJ(124); VROW(r4, c); ELOAD(r4, 4, e0n, e1n, U4); }
    { const float c = CJ(125); VROW(r5, c); ELOAD(r5, 5, e0n, e1n, U4); }
    { const float c = CJ(126); VROW(r6, c); ELOAD(r6, 6, e0n, e1n, U4); }
    { const float c = CJ(127); VROW(r7, c); ELOAD(r7, 7, e0n, e1n, U4); }
#undef VROW
#undef PIN8
#undef CJ
    int xo_ = 16 * lane; asm volatile("" : "+v"(xo_));
    float* xr = OUT + (size_t)t * 4096 + xo_; const bf16_t* x1r = X1B + (size_t)t * 4096 + xo_; float ss = 0.f;
#pragma unroll
    for (int k = 0; k < 4; ++k) {
#pragma unroll
      for (int q = 0; q < 2; ++q) { const u32x4 a = *(const u32x4*)(x1r + 1024 * k + 8 * q); const int b_ = 8 * k + 4 * q;
#pragma unroll
        for (int i = 0; i < 4; ++i) { acc[b_ + i] += (f32x2){__uint_as_float(a[i] << 16), __uint_as_float(a[i] & 0xffff0000u)}; ss += acc[b_ + i].x * acc[b_ + i].x + acc[b_ + i].y * acc[b_ + i].y; } }
      asm volatile("" ::: "memory"); __builtin_amdgcn_sched_barrier(0); }
    const float rstd = 1.0f / sqrtf(wave_sum(ss) * (1.0f / 4096.0f) + 1e-6f);
    const float* fn = fnorm + xo_;
#pragma unroll
    for (int k = 0; k < 4; ++k) {
#pragma unroll
      for (int q = 0; q < 4; ++q) { const f32x4 g = *(const f32x4*)(fn + 1024 * k + 4 * q); const int b_ = 8 * k + 2 * q;
        f32x4 o; o[0] = acc[b_].x * rstd * g[0]; o[1] = acc[b_].y * rstd * g[1]; o[2] = acc[b_ + 1].x * rstd * g[2]; o[3] = acc[b_ + 1].y * rstd * g[3];
        if constexpr (STORE) { *(f32x4*)(xr + 1024 * k + 4 * q) = o; } else { asm volatile("" :: "v"(o)); } }
      asm volatile("" ::: "memory"); __builtin_amdgcn_sched_barrier(0); }
    if (tn >= t_end) break;
    t = tn; e0 = e0n; e1 = e1n;
  }
#undef ELOAD
}
constexpr int NWIN = 16;
__device__ __forceinline__ void pack_row_fp4w(const float* __restrict__ src, unsigned char* __restrict__ dst, int e, float scale, int lane) {
  const f32x4* sp = (const f32x4*)(src + 16 * lane);
  f32x4 c[16];
#pragma unroll
  for (int j = 0; j < 4; ++j)
#pragma unroll
    for (int q = 0; q < 4; ++q) c[4 * j + q] = sp[256 * j + q] * scale;
#pragma unroll
  for (int j = 0; j < 4; ++j) { unsigned w0 = 0, w1 = 0;
    w0 = __builtin_amdgcn_cvt_scalef32_pk_fp4_f32(w0, c[4 * j][0], c[4 * j][1], 1.0f, 0); w0 = __builtin_amdgcn_cvt_scalef32_pk_fp4_f32(w0, c[4 * j][2], c[4 * j][3], 1.0f, 1);
    w0 = __builtin_amdgcn_cvt_scalef32_pk_fp4_f32(w0, c[4 * j + 1][0], c[4 * j + 1][1], 1.0f, 2); w0 = __builtin_amdgcn_cvt_scalef32_pk_fp4_f32(w0, c[4 * j + 1][2], c[4 * j + 1][3], 1.0f, 3);
    w1 = __builtin_amdgcn_cvt_scalef32_pk_fp4_f32(w1, c[4 * j + 2][0], c[4 * j + 2][1], 1.0f, 0); w1 = __builtin_amdgcn_cvt_scalef32_pk_fp4_f32(w1, c[4 * j + 2][2], c[4 * j + 2][3], 1.0f, 1);
    w1 = __builtin_amdgcn_cvt_scalef32_pk_fp4_f32(w1, c[4 * j + 3][0], c[4 * j + 3][1], 1.0f, 2); w1 = __builtin_amdgcn_cvt_scalef32_pk_fp4_f32(w1, c[4 * j + 3][2], c[4 * j + 3][3], 1.0f, 3);
    *(u32x2*)(dst + ((size_t)(4 * j + (lane >> 4)) * 16384 + e) * 128 + 8 * (lane & 15)) = (u32x2){w0, w1}; }
}
constexpr float U4ISCALE = 192.0f, H8ISCALE = 20.0f;
__device__ __forceinline__ unsigned q4nib(float x) { return (unsigned)(int)__builtin_rintf(__builtin_amdgcn_fmed3f(x, -8.0f, 7.0f)) & 15u; }
__device__ __forceinline__ void pack_row_i4w(const float* __restrict__ src, unsigned char* __restrict__ dst, int e, float scale, int lane) {
  const f32x4* sp = (const f32x4*)(src + 16 * lane);
  f32x4 c[16];
#pragma unroll
  for (int j = 0; j < 4; ++j)
#pragma unroll
    for (int q = 0; q < 4; ++q) c[4 * j + q] = sp[256 * j + q] * scale;
#pragma unroll
  for (int j = 0; j < 4; ++j) { unsigned w0 = 0, w1 = 0;
#pragma unroll
    for (int i = 0; i < 8; ++i) { w0 |= q4nib(c[4 * j + (i >> 2)][i & 3]) << (4 * i); w1 |= q4nib(c[4 * j + 2 + (i >> 2)][i & 3]) << (4 * i); }
    *(u32x2*)(dst + ((size_t)(4 * j + (lane >> 4)) * 16384 + e) * 128 + 8 * (lane & 15)) = (u32x2){w0, w1}; }
}
__device__ __forceinline__ void pack_load(const float* __restrict__ src, int lane, f32x4 (&c)[16]) {
  const f32x4* sp = (const f32x4*)(src + 16 * lane);
#pragma unroll
  for (int j = 0; j < 4; ++j)
#pragma unroll
    for (int q = 0; q < 4; ++q) c[4 * j + q] = sp[256 * j + q];
}
__device__ __forceinline__ void pack_fin_i4w(const f32x4 (&c)[16], unsigned char* __restrict__ dst, int e, float scale, int lane) {
#pragma unroll
  for (int j = 0; j < 4; ++j) { unsigned w0 = 0, w1 = 0;
#pragma unroll
    for (int i = 0; i < 8; ++i) { w0 |= q4nib(c[4 * j + (i >> 2)][i & 3] * scale) << (4 * i); w1 |= q4nib(c[4 * j + 2 + (i >> 2)][i & 3] * scale) << (4 * i); }
    *(u32x2*)(dst + ((size_t)(4 * j + (lane >> 4)) * 16384 + e) * 128 + 8 * (lane & 15)) = (u32x2){w0, w1}; }
}
__device__ __forceinline__ void pack_fin_fp4w(const f32x4 (&c)[16], unsigned char* __restrict__ dst, int e, float scale, int lane) {
#pragma unroll
  for (int j = 0; j < 4; ++j) { unsigned w0 = 0, w1 = 0;
    const f32x4 a0 = c[4 * j] * scale, a1 = c[4 * j + 1] * scale, a2 = c[4 * j + 2] * scale, a3 = c[4 * j + 3] * scale;
    w0 = __builtin_amdgcn_cvt_scalef32_pk_fp4_f32(w0, a0[0], a0[1], 1.0f, 0); w0 = __builtin_amdgcn_cvt_scalef32_pk_fp4_f32(w0, a0[2], a0[3], 1.0f, 1);
    w0 = __builtin_amdgcn_cvt_scalef32_pk_fp4_f32(w0, a1[0], a1[1], 1.0f, 2); w0 = __builtin_amdgcn_cvt_scalef32_pk_fp4_f32(w0, a1[2], a1[3], 1.0f, 3);
    w1 = __builtin_amdgcn_cvt_scalef32_pk_fp4_f32(w1, a2[0], a2[1], 1.0f, 0); w1 = __builtin_amdgcn_cvt_scalef32_pk_fp4_f32(w1, a2[2], a2[3], 1.0f, 1);
    w1 = __builtin_amdgcn_cvt_scalef32_pk_fp4_f32(w1, a3[0], a3[1], 1.0f, 2); w1 = __builtin_amdgcn_cvt_scalef32_pk_fp4_f32(w1, a3[2], a3[3], 1.0f, 3);
    *(u32x2*)(dst + ((size_t)(4 * j + (lane >> 4)) * 16384 + e) * 128 + 8 * (lane & 15)) = (u32x2){w0, w1}; }
}
constexpr float V4ISCALE = 8.44f;
__device__ __forceinline__ int swap32_addi(int x, int y) { auto r = __builtin_amdgcn_permlane32_swap((unsigned)x, (unsigned)y, false, false); return (int)r[0] + (int)r[1]; }
__device__ __forceinline__ int swap16_addi(int x, int y) { auto r = __builtin_amdgcn_permlane16_swap((unsigned)x, (unsigned)y, false, false); return (int)r[0] + (int)r[1]; }
__device__ __forceinline__ int ror8i(int v) { return __builtin_amdgcn_update_dpp(0, v, 0x128, 0xf, 0xf, true); }
template <int CTRL> __device__ __forceinline__ float dppf(float v) { return __int_as_float(__builtin_amdgcn_update_dpp(0, __float_as_int(v), CTRL, 0xf, 0xf, true)); }
__device__ __forceinline__ void expert_tokens_w(const unsigned char* __restrict__ HHI, const unsigned char* __restrict__ HLO, const unsigned char* __restrict__ U4, const unsigned char* __restrict__ V4, const int* __restrict__ IDX, const float* __restrict__ GATE,
                                                const bf16_t* __restrict__ X1B, bf16_t* X2B, float* __restrict__ OUT, const float* __restrict__ fnorm, PLAS float* cl, int lane_, int wave, int ntok) {
  int lane = lane_; asm volatile("" : "+v"(lane));
  const int g = lane >> 3, c = lane & 7;
  const int xcd = (int)(blockIdx.x & 7), nbx = ((int)gridDim.x - xcd + 7) >> 3, xw = (int)(blockIdx.x >> 3) * 8 + wave, ostep = 8 * nbx * 8;
  const unsigned c16 = 16u * (unsigned)c;
  PLAS int* el = (PLAS int*)(cl + 1024);
  constexpr unsigned WINB = 16384u * 128u;
#pragma unroll 1
  for (int o = xcd + 8 * xw; o < ntok / 8; o += ostep) {
    const int t0 = 8 * o;
#pragma unroll
    for (int q = 0; q < 4; ++q) { const int idx = q * 256 + lane * 4; *(PLAS u32x4*)(el + idx) = *(const u32x4*)(IDX + (size_t)t0 * 128 + idx); }
    asm volatile("s_waitcnt vmcnt(0) lgkmcnt(0)" ::: "memory");
#define EW_ROWS(IT, TAB, R) do { const int it_ = (IT) < 128 ? (IT) : 127; const unsigned char* tb_ = (TAB) + (size_t)(it_ >> 3) * WINB; PLAS const u32x4* ep_ = (PLAS const u32x4*)(el + (it_ & 7) * 128 + 16 * g); \
      _Pragma("unroll") for (int q = 0; q < 4; ++q) { const u32x4 e_ = ep_[q];     \
        R[4 * q] = *(const u32x4*)(tb_ + (e_.x * 128u + c16)); R[4 * q + 1] = *(const u32x4*)(tb_ + (e_.y * 128u + c16)); \
        R[4 * q + 2] = *(const u32x4*)(tb_ + (e_.z * 128u + c16)); R[4 * q + 3] = *(const u32x4*)(tb_ + (e_.w * 128u + c16)); } } while (0)
#define EW_HQ(IT, HQ) do { const int it_ = (IT) < 128 ? (IT) : 127; const size_t ho_ = (size_t)(t0 + (it_ & 7)) * 2048 + 128 * (it_ >> 3) + 16 * c;     \
      HQ[0] = *(const u32x4*)(HHI + ho_); HQ[1] = *(const u32x4*)(HLO + ho_); } while (0)
#define EW_UCOMP(IT, R, HQ) do { float p[16]; \
      _Pragma("unroll") for (int i = 0; i < 16; ++i) { int ah = 0, al = 0;     \
        _Pragma("unroll") for (int d = 0; d < 4; ++d) { ah = __builtin_amdgcn_sdot8((int)R[i][d], (int)HQ[0][d], ah, false); al = __builtin_amdgcn_sdot8((int)R[i][d], (int)HQ[1][d], al, false); } \
        p[i] = (float)(16 * ah + al); } \
      float q8[8], q4[4], q2[2]; \
        \
      { const bool up = (c & 4) != 0; _Pragma("unroll") for (int k = 0; k < 8; ++k) { const float t1 = p[k] + dppf<0x141>(p[k]), t2 = p[8 + k] + dppf<0x141>(p[8 + k]); q8[k] = up ? t2 : t1; } } \
      { const bool up = (c & 2) != 0; _Pragma("unroll") for (int k = 0; k < 4; ++k) { const float t1 = q8[k] + dppf<0x4E>(q8[k]), t2 = q8[4 + k] + dppf<0x4E>(q8[4 + k]); q4[k] = up ? t2 : t1; } } \
      { const bool up = (c & 1) != 0; _Pragma("unroll") for (int k = 0; k < 2; ++k) { const float t1 = q4[k] + dppf<0xB1>(q4[k]), t2 = q4[2 + k] + dppf<0xB1>(q4[2 + k]); q2[k] = up ? t2 : t1; } } \
      PLAS f32x2* dl = (PLAS f32x2*)(cl + ((IT) & 7) * 128 + 16 * g + 2 * c); \
      f32x2 acc2 = ((IT) < 8) ? (f32x2){0.f, 0.f} : *dl; acc2.x += q2[0]; acc2.y += q2[1]; *dl = acc2; } while (0)
    { u32x4 rA[16], rB[16], hA[2], hB[2];
      EW_ROWS(0, U4, rA); EW_HQ(0, hA);
#pragma unroll 1
      for (int it = 0; it < 128; it += 2) {
        EW_ROWS(it + 1, U4, rB); EW_HQ(it + 1, hB); __builtin_amdgcn_sched_barrier(0);
        EW_UCOMP(it, rA, hA); __builtin_amdgcn_sched_barrier(0);
        EW_ROWS(it + 2, U4, rA); EW_HQ(it + 2, hA); __builtin_amdgcn_sched_barrier(0);
        EW_UCOMP(it + 1, rB, hB); __builtin_amdgcn_sched_barrier(0);
      } }
    { float cv[8][2];
#pragma unroll
      for (int tt = 0; tt < 8; ++tt) { const f32x2 d2 = *(PLAS const f32x2*)(cl + tt * 128 + 16 * g + 2 * c); const f32x2 g2 = *(const f32x2*)(GATE + (size_t)(t0 + tt) * 128 + 16 * g + 2 * c);
        cv[tt][0] = g2.x * gelu_erf(d2.x * (1.0f / (U4ISCALE * H8ISCALE))); cv[tt][1] = g2.y * gelu_erf(d2.y * (1.0f / (U4ISCALE * H8ISCALE))); }
      asm volatile("s_waitcnt lgkmcnt(0)" ::: "memory");
      PLAS unsigned char* cbp = (PLAS unsigned char*)cl;
#pragma unroll
      for (int tt = 0; tt < 8; ++tt) { float mx = fmaxf(fabsf(cv[tt][0]), fabsf(cv[tt][1]));
#pragma unroll
        for (int o = 1; o < 64; o <<= 1) mx = fmaxf(mx, __shfl_xor(mx, o));
        const float sc = mx > 0.f ? 119.0f / mx : 0.f;
        const int q0 = (int)__builtin_rintf(cv[tt][0] * sc), q1 = (int)__builtin_rintf(cv[tt][1] * sc);
        const int l0 = ((q0 + 8) & 15) - 8, h0 = (q0 - l0) >> 4, l1 = ((q1 + 8) & 15) - 8, h1 = (q1 - l1) >> 4;
        *(PLAS unsigned short*)(cbp + tt * 256 + 16 * g + 2 * c) = (unsigned short)((h0 & 15) | ((h1 & 15) << 8));
        *(PLAS unsigned short*)(cbp + tt * 256 + 128 + 16 * g + 2 * c) = (unsigned short)((l0 & 15) | ((l1 & 15) << 8));
        if (lane == 0) cl[768 + tt] = mx * (1.0f / (119.0f * V4ISCALE)); }
      asm volatile("s_waitcnt lgkmcnt(0)" ::: "memory");
      if (lane < 32) {
#pragma unroll
        for (int tt = 0; tt < 8; ++tt) { const u32x2 b = *(PLAS const u32x2*)(cbp + tt * 256 + (lane >> 4) * 128 + 8 * (lane & 15));
          const unsigned w = (b.x & 0xFu) | ((b.x >> 4) & 0xF0u) | ((b.x >> 8) & 0xF00u) | ((b.x >> 12) & 0xF000u) | ((b.y & 0xFu) << 16) | (((b.y >> 4) & 0xF0u) << 16) | (((b.y >> 8) & 0xF00u) << 16) | (((b.y >> 12) & 0xF000u) << 16);
          ((PLAS unsigned*)cl)[512 + tt * 32 + lane] = w; } }
      asm volatile("s_waitcnt lgkmcnt(0)" ::: "memory"); }
    { u32x4 R0[16], R1[16];
#define EW_VLOAD(IT, H, RR) do { const int it_ = (IT) < 128 ? (IT) : 127; const unsigned char* tb_ = V4 + (size_t)(it_ >> 3) * WINB; PLAS const u32x4* ep_ = (PLAS const u32x4*)(el + (it_ & 7) * 128 + 16 * g + 8 * (H)); \
      _Pragma("unroll") for (int q = 0; q < 2; ++q) { const u32x4 e_ = ep_[q]; RR[8 * (H) + 4 * q] = *(const u32x4*)(tb_ + (e_.x * 128u + c16)); RR[8 * (H) + 4 * q + 1] = *(const u32x4*)(tb_ + (e_.y * 128u + c16)); \
        RR[8 * (H) + 4 * q + 2] = *(const u32x4*)(tb_ + (e_.z * 128u + c16)); RR[8 * (H) + 4 * q + 3] = *(const u32x4*)(tb_ + (e_.w * 128u + c16)); } } while (0)
      EW_VLOAD(0, 0, R0); EW_VLOAD(0, 1, R0);
#define EW_D8(T_, N_) do { if (h) { ah[N_] = __builtin_amdgcn_sdot8((int)(T_), CH, ah[N_], false); al[N_] = __builtin_amdgcn_sdot8((int)(T_), CL, al[N_], false); } \
                else { asm("v_dot8_i32_i4 %0, %1, %2, 0" : "=v"(ah[N_]) : "v"(T_), "v"(CH)); asm("v_dot8_i32_i4 %0, %1, %2, 0" : "=v"(al[N_]) : "v"(T_), "v"(CL)); } } while (0)
      auto viter = [&](const int it, u32x4 (&RC)[16], u32x4 (&RN)[16]) {
        const int tt = it & 7, w_ = it >> 3;
        const u32x2 chh = *(PLAS const u32x2*)((PLAS unsigned*)cl + 512 + tt * 32 + 2 * g), cll = *(PLAS const u32x2*)((PLAS unsigned*)cl + 512 + tt * 32 + 16 + 2 * g);
        const float osc = cl[768 + tt];
        int ah[32], al[32];
#pragma unroll
        for (int h = 0; h < 2; ++h) { const int CH = (int)(h ? chh.y : chh.x), CL = (int)(h ? cll.y : cll.x);
#pragma unroll
          for (int d = 0; d < 4; ++d) { unsigned pp[4], qq[4];
#pragma unroll
            for (int m = 0; m < 4; ++m) { const unsigned x = RC[8 * h + 2 * m][d], y = RC[8 * h + 2 * m + 1][d];
              pp[m] = (x & 0x0F0F0F0Fu) | ((y << 4) & 0xF0F0F0F0u); qq[m] = ((x >> 4) & 0x0F0F0F0Fu) | (y & 0xF0F0F0F0u); }
#pragma unroll
            for (int par = 0; par < 2; ++par) { const unsigned s0 = par ? qq[0] : pp[0], s1 = par ? qq[1] : pp[1], s2_ = par ? qq[2] : pp[2], s3 = par ? qq[3] : pp[3];
              const unsigned u0 = __builtin_amdgcn_perm(s1, s0, 0x05010400u), u1 = __builtin_amdgcn_perm(s1, s0, 0x07030602u), w0 = __builtin_amdgcn_perm(s3, s2_, 0x05010400u), w1 = __builtin_amdgcn_perm(s3, s2_, 0x07030602u);
              const unsigned t0_ = __builtin_amdgcn_perm(w0, u0, 0x05040100u), t2_ = __builtin_amdgcn_perm(w0, u0, 0x07060302u), t4_ = __builtin_amdgcn_perm(w1, u1, 0x05040100u), t6_ = __builtin_amdgcn_perm(w1, u1, 0x07060302u);
              const int cb_ = 8 * d + par;
              EW_D8(t0_, cb_); EW_D8(t2_, cb_ + 2); EW_D8(t4_, cb_ + 4); EW_D8(t6_, cb_ + 6);
            } }
          __builtin_amdgcn_sched_barrier(0);
          EW_VLOAD(it + 1, h, RN);
          __builtin_amdgcn_sched_barrier(0); }
        int acc[32];
#pragma unroll
        for (int n = 0; n < 32; ++n) acc[n] = 16 * ah[n] + al[n];
        int s16[16], s8i[8], s4i[4];
#pragma unroll
        for (int k = 0; k < 16; ++k) s16[k] = swap32_addi(acc[k], acc[16 + k]);
#pragma unroll
        for (int k = 0; k < 8; ++k) s8i[k] = swap16_addi(s16[k], s16[8 + k]);
        { const bool up = (g & 1) != 0;
#pragma unroll
          for (int k = 0; k < 4; ++k) { const int t1 = s8i[k] + ror8i(s8i[k]), t2 = s8i[4 + k] + ror8i(s8i[4 + k]); s4i[k] = up ? t2 : t1; } }
        const float y0 = (float)s4i[0] * osc, y1 = (float)s4i[1] * osc, y2 = (float)s4i[2] * osc, y3 = (float)s4i[3] * osc;
        unsigned r0_, r1_; asm volatile("v_cvt_pk_bf16_f32 %0, %1, %2" : "=v"(r0_) : "v"(y0), "v"(y1)); asm volatile("v_cvt_pk_bf16_f32 %0, %1, %2" : "=v"(r1_) : "v"(y2), "v"(y3));
        *(u32x2*)(X2B + (size_t)(t0 + tt) * 4096 + 256 * w_ + 32 * c + 4 * g) = (u32x2){r0_, r1_};
      };
#pragma unroll 1
      for (int it = 0; it < 128; it += 2) { viter(it, R0, R1); __builtin_amdgcn_sched_barrier(0); viter(it + 1, R1, R0); __builtin_amdgcn_sched_barrier(0); }
#undef EW_D8
#undef EW_VLOAD
    }
#undef EW_ROWS
#undef EW_HQ
#undef EW_UCOMP
    asm volatile("s_waitcnt vmcnt(0)" ::: "memory");
#pragma unroll 1
    for (int tt = 0; tt < 8; ++tt) { const int t = t0 + tt;
      int l2 = lane; asm volatile("" : "+v"(l2));
      const u32x4* xr = (const u32x4*)(X2B + (size_t)t * 4096) + l2;
      const u32x4* x1r = (const u32x4*)(X1B + (size_t)t * 4096) + l2;
      u32x4 v[8], w1[8]; float ss = 0.f;
#pragma unroll
      for (int j = 0; j < 8; ++j) { v[j] = xr[64 * j]; w1[j] = x1r[64 * j]; }
#define XSUM_LO(j, i) (__uint_as_float(v[j][i] << 16) + __uint_as_float(w1[j][i] << 16))
#define XSUM_HI(j, i) (__uint_as_float(v[j][i] & 0xffff0000u) + __uint_as_float(w1[j][i] & 0xffff0000u))
#pragma unroll
      for (int j = 0; j < 8; ++j)
#pragma unroll
        for (int i = 0; i < 4; ++i) { const float a = XSUM_LO(j, i), b = XSUM_HI(j, i); ss += a * a + b * b; }
      const float rstd = 1.0f / sqrtf(wave_sum(ss) * (1.0f / 4096.0f) + 1e-6f);
      const f32x4* fn = (const f32x4*)fnorm + 2 * l2; f32x4* op = (f32x4*)(OUT + (size_t)t * 4096) + 2 * l2;
#pragma unroll
      for (int j = 0; j < 8; ++j) { const f32x4 g0 = fn[128 * j], g1 = fn[128 * j + 1];
        op[128 * j] = (f32x4){XSUM_LO(j, 0) * rstd * g0[0], XSUM_HI(j, 0) * rstd * g0[1], XSUM_LO(j, 1) * rstd * g0[2], XSUM_HI(j, 1) * rstd * g0[3]};
        op[128 * j + 1] = (f32x4){XSUM_LO(j, 2) * rstd * g1[0], XSUM_HI(j, 2) * rstd * g1[1], XSUM_LO(j, 3) * rstd * g1[2], XSUM_HI(j, 3) * rstd * g1[3]}; }
#undef XSUM_LO
#undef XSUM_HI
    }
    asm volatile("s_waitcnt lgkmcnt(0)" ::: "memory");
  }
}
#undef PLAS
}

constexpr int BATCH = 2, SEQ = 8192, DM = 4096, T = BATCH * SEQ;
constexpr int NCAT = 15872;
constexpr int NPH = 12;
#ifndef MK_CUTS
#define MK_CUTS 1
#endif
constexpr float EPS = 1e-6f;
constexpr float LOG2E = 1.4426950408889634f;
constexpr float MLA_QSCALE = 0.07216878364870322f * LOG2E;
constexpr float S_WIN = 64.f, S_PAB = 32.f, S_WOUT = 64.f, S_OA = 64.f, S_OB = 16.f, S_MRG = 16.f, S_Y = 128.f, S_LAT = 16.f, S_WU = 32.f;
constexpr float NA_QSCALE = 0.08838834764831845f * LOG2E;

constexpr size_t MiB = 1u << 20;
constexpr size_t WS_CTL = 0, CTL_ZERO_BYTES = 1 * MiB;
constexpr size_t WS_ROPE = 1 * MiB;
constexpr size_t WS_RS = 1 * MiB + 65536;
constexpr size_t WS_WCAT = 2 * MiB;
constexpr size_t WS_WUQ = WS_WCAT + 124 * MiB;
constexpr size_t WS_WUKV = WS_WUQ + 5 * MiB;
constexpr size_t WS_PA = WS_WUKV + 4 * MiB;
constexpr size_t WS_PB = WS_PA + 16 * MiB;
constexpr size_t WS_WOUT = WS_PB + 16 * MiB;
constexpr size_t WS_WQ = WS_WOUT + 32 * MiB;
constexpr size_t WS_SUBH = WS_WQ + 16 * MiB;
constexpr size_t WS_SUBL = WS_SUBH + 512 * 1024;
constexpr size_t WS_R1 = WS_SUBL + 512 * 1024;
constexpr size_t WS_LAT = WS_R1 + 128 * MiB;
constexpr size_t WS_R2 = WS_LAT + 48 * MiB;
constexpr size_t WS_R3 = WS_R2 + 192 * MiB;
constexpr size_t WS_R4 = WS_R3 + 256 * MiB;
constexpr size_t WS_KR = WS_R4 + 224 * MiB;
constexpr size_t WS_IDX = WS_KR + 2 * MiB;
constexpr size_t WS_GATE = WS_IDX + 8 * MiB;
constexpr size_t WS_END = WS_GATE + 8 * MiB;
constexpr int CW_TMO = 0, CW_BAR = 4096;

constexpr int RING_BYTES = 131072, LDSCTL_OFF = RING_BYTES, MISC_OFF = LDSCTL_OFF + 320, LDS_BYTES = 147456;
constexpr int NWAVES = 8;

#define GAS __attribute__((address_space(1)))
#define LAS __attribute__((address_space(3)))
typedef unsigned short bf16;
typedef unsigned v4u __attribute__((ext_vector_type(4)));
typedef float f32x4 __attribute__((ext_vector_type(4)));
typedef float f32x8 __attribute__((ext_vector_type(8)));
typedef GAS unsigned gu32;
#define RLX_AGENT __ATOMIC_RELAXED, __HIP_MEMORY_SCOPE_AGENT
#define LDS_WAIT() asm volatile("s_waitcnt lgkmcnt(0)" ::: "memory")
#define VM_WAIT() asm volatile("s_waitcnt vmcnt(0)" ::: "memory")
__device__ __forceinline__ unsigned pkbf(float lo, float hi) { unsigned r; asm volatile("v_cvt_pk_bf16_f32 %0, %1, %2" : "=v"(r) : "v"(lo), "v"(hi)); return r; }

#define XB_TMO      128
#define XB_XCNT(j)  (256  + 64 * (j))
#define XB_XSUB(j)  (1280 + 64 * (j))
#define XB_XGEN(j)  (2304 + 64 * (j))
#define XB_TOP      3328
#define XB_TOPGEN   3392
#define XCD_BAR_WORDS 3456
#define XB_SPIN_CAP (1u << 22)
__device__ __forceinline__ unsigned xb_ld(unsigned* p)              { return __hip_atomic_load(p, __ATOMIC_RELAXED, __HIP_MEMORY_SCOPE_AGENT); }
__device__ __forceinline__ unsigned xb_add(unsigned* p, unsigned v) { return __hip_atomic_fetch_add(p, v, __ATOMIC_RELAXED, __HIP_MEMORY_SCOPE_AGENT); }
__device__ __forceinline__ unsigned xb_xcc_id() { return (unsigned)__builtin_amdgcn_s_getreg((3 << 11) | 20) & 0xFu; }
#define XB_SPIN(cond, bar) do { unsigned _sp = 0; while (cond) { __builtin_amdgcn_s_sleep(1); \
    if ((++_sp & 255u) == 0u) { if (xb_ld(&(bar)[XB_TMO])) break; if (_sp > XB_SPIN_CAP) { atomicAdd(&(bar)[XB_TMO], 1u); break; } } } } while (0)
struct XcdBarrier { unsigned* bar; unsigned x; volatile LAS unsigned* st; };
__device__ __forceinline__ XcdBarrier xcd_barrier_post(unsigned* bar, volatile LAS unsigned* st) {
    XcdBarrier b; b.bar = bar; b.x = xb_xcc_id(); b.st = st;
    if (threadIdx.x == 0) (void)xb_add(&bar[XB_XCNT(b.x)], 1u);
    return b;
}
__device__ __forceinline__ void xcd_barrier_complete(unsigned* bar, unsigned x, unsigned& nloc, unsigned& nx) {
    const unsigned G = gridDim.x * gridDim.y * gridDim.z;
    unsigned sum, cnt, mine, sp = 0u;
    for (;;) {
        sum = 0u; cnt = 0u; mine = 0u;
#pragma unroll
        for (unsigned j = 0; j < 16; ++j) { const unsigned c = xb_ld(&bar[XB_XCNT(j)]); sum += c; cnt += (c > 0u) ? 1u : 0u; mine = (j == x) ? c : mine; }
        if (sum == G) break;
        __builtin_amdgcn_s_sleep(1);
        if ((++sp & 255u) == 0u) { if (xb_ld(&bar[XB_TMO])) break; if (sp > XB_SPIN_CAP) { atomicAdd(&bar[XB_TMO], 1u); break; } }
    }
    nloc = mine > 0u ? mine : 1u; nx = cnt > 0u ? cnt : 1u;
}
__device__ __forceinline__ void xcd_barrier(const XcdBarrier& b) {
    asm volatile("s_waitcnt vmcnt(0)" ::: "memory");
    __syncthreads();
    if (threadIdx.x == 0) {
        unsigned* bar = b.bar;
        __builtin_amdgcn_s_waitcnt(0);
        unsigned nloc = b.st[0], nx = b.st[1];
        if (nloc == 0u) { xcd_barrier_complete(bar, b.x, nloc, nx); b.st[0] = nloc; b.st[1] = nx; }
        const unsigned old = xb_add(&bar[XB_XSUB(b.x)], 1u);
        const unsigned gen = old / nloc;
        if (old + 1u == (gen + 1u) * nloc) {
            __builtin_amdgcn_fence(__ATOMIC_RELEASE, "agent");
            asm volatile("s_waitcnt vmcnt(0)" ::: "memory");
            const unsigned og = xb_add(&bar[XB_TOP], 1u);
            const unsigned tg = og / nx;
            if (og + 1u == (tg + 1u) * nx) xb_add(&bar[XB_TOPGEN], 1u);
            else XB_SPIN(xb_ld(&bar[XB_TOPGEN]) == tg, bar);
            __builtin_amdgcn_fence(__ATOMIC_ACQUIRE, "agent");
            xb_add(&bar[XB_XGEN(b.x)], 1u);
            asm volatile("s_waitcnt vmcnt(0)" ::: "memory");
        } else {
            XB_SPIN(xb_ld(&bar[XB_XGEN(b.x)]) == gen, bar);
            __builtin_amdgcn_fence(__ATOMIC_ACQUIRE, "agent");
            asm volatile("s_waitcnt vmcnt(0)" ::: "memory");
        }
    }
    __syncthreads();
}

__device__ __forceinline__ float wave_sum(float v) {
#pragma unroll
    for (int o = 1; o < 64; o <<= 1) v += __shfl_xor(v, o);
    return v;
}
__device__ __forceinline__ void transpose_item(const float* W, int N, bf16* WT, int ldt, int row_off, const float* gk, LAS float* scr, int kb, int nb, int lane) {
    const int k0 = 64 * kb, n0 = 32 * nb;
    { f32x4 v[8]; const int r8 = lane >> 3, c4 = (lane & 7) * 4;
#pragma unroll
      for (int i = 0; i < 8; ++i) v[i] = *(const GAS f32x4*)(W + (size_t)(k0 + 8 * i + r8) * N + n0 + c4);
#pragma unroll
      for (int i = 0; i < 8; ++i) { const int kk = 8 * i + r8; const float g = gk ? gk[k0 + kk] : 1.0f; LAS float* d = scr + kk * 33 + c4; d[0] = v[i].x * g; d[1] = v[i].y * g; d[2] = v[i].z * g; d[3] = v[i].w * g; } }
    LDS_WAIT(); asm volatile("" ::: "memory");
    const int c = lane & 7;
#pragma unroll
    for (int j = 0; j < 4; ++j) { const int n = (lane >> 3) + 8 * j; const LAS float* s = scr + (8 * c) * 33 + n;
        v4u o; o.x = pkbf(s[0 * 33], s[1 * 33]); o.y = pkbf(s[2 * 33], s[3 * 33]); o.z = pkbf(s[4 * 33], s[5 * 33]); o.w = pkbf(s[6 * 33], s[7 * 33]);
        *(GAS v4u*)(WT + (size_t)(row_off + n0 + n) * ldt + k0 + 8 * c) = o; }
    LDS_WAIT(); asm volatile("" ::: "memory");
}
__device__ __forceinline__ void rms_rowbf_to_bf16(const bf16* xrow, const float* gain, float* rs_out, unsigned* hhi, unsigned* hlo, float s8, int lane) {
    const GAS pg8::u32x4* xr = (const GAS pg8::u32x4*)xrow + lane; const GAS f32x4* gr = (const GAS f32x4*)gain + 2 * lane;
    pg8::u32x4 v[8]; float s = 0.f;
#pragma unroll
    for (int j = 0; j < 8; ++j) { v[j] = xr[64 * j];
#pragma unroll
        for (int i = 0; i < 4; ++i) { const float a = __uint_as_float(v[j][i] << 16), b = __uint_as_float(v[j][i] & 0xffff0000u); s += a * a + b * b; } }
    const float rstd = 1.f / sqrtf(wave_sum(s) * (1.f / DM) + EPS);
    if (lane == 0) *rs_out = rstd;
#pragma unroll
    for (int j = 0; j < 8; ++j) { const f32x4 g0 = gr[128 * j], g1 = gr[128 * j + 1];
        { const float q0 = rstd * s8; unsigned wh = 0, wl = 0;
          const float e_[8] = {__uint_as_float(v[j].x << 16) * q0 * g0.x, __uint_as_float(v[j].x & 0xffff0000u) * q0 * g0.y, __uint_as_float(v[j].y << 16) * q0 * g0.z, __uint_as_float(v[j].y & 0xffff0000u) * q0 * g0.w,
                               __uint_as_float(v[j].z << 16) * q0 * g1.x, __uint_as_float(v[j].z & 0xffff0000u) * q0 * g1.y, __uint_as_float(v[j].w << 16) * q0 * g1.z, __uint_as_float(v[j].w & 0xffff0000u) * q0 * g1.w};
#pragma unroll
          for (int i = 0; i < 8; ++i) { const int q = (int)__builtin_rintf(__builtin_amdgcn_fmed3f(e_[i], -128.0f, 119.0f)); const int lo = ((q + 8) & 15) - 8, hi = (q - lo) >> 4;
            wh |= ((unsigned)hi & 15u) << (4 * i); wl |= ((unsigned)lo & 15u) << (4 * i); }
          hhi[lane + 64 * j] = wh; hlo[lane + 64 * j] = wl; } }
}
__device__ __forceinline__ void rms_row_to_bf16(const float* xrow, const float* gain, bf16* orow, int lane) {
    const GAS f32x4* xr = (const GAS f32x4*)xrow + lane; const GAS f32x4* gr = (const GAS f32x4*)gain + lane;
    f32x4 v[16]; float s = 0.f;
#pragma unroll
    for (int j = 0; j < 16; ++j) { v[j] = xr[64 * j]; s += (v[j].x * v[j].x + v[j].y * v[j].y) + (v[j].z * v[j].z + v[j].w * v[j].w); }
    const float rstd = 1.f / sqrtf(wave_sum(s) * (1.f / DM) + EPS);
    GAS unsigned long long* o8 = (GAS unsigned long long*)orow + lane;
#pragma unroll
    for (int j = 0; j < 16; ++j) { const f32x4 g = gr[64 * j];
        o8[64 * j] = (unsigned long long)pkbf(v[j].x * rstd * g.x, v[j].y * rstd * g.y) | ((unsigned long long)pkbf(v[j].z * rstd * g.z, v[j].w * rstd * g.w) << 32); }
}

__device__ __forceinline__ unsigned pk4f8(float a, float b, float c, float d) { int w = __builtin_amdgcn_cvt_pk_fp8_f32(a, b, 0, false); w = __builtin_amdgcn_cvt_pk_fp8_f32(c, d, w, true); return (unsigned)w; }
__device__ __forceinline__ void transpose_item8(const float* W, int N, unsigned char* WT, int ldt, int row_off, float scale, LAS float* scr, int kb, int nb, int lane) {
    const int k0 = 64 * kb, n0 = 32 * nb;
    { f32x4 v[8]; const int r8 = lane >> 3, c4 = (lane & 7) * 4;
#pragma unroll
      for (int i = 0; i < 8; ++i) v[i] = *(const GAS f32x4*)(W + (size_t)(k0 + 8 * i + r8) * N + n0 + c4);
#pragma unroll
      for (int i = 0; i < 8; ++i) { LAS float* d = scr + (8 * i + r8) * 33 + c4; d[0] = v[i].x * scale; d[1] = v[i].y * scale; d[2] = v[i].z * scale; d[3] = v[i].w * scale; } }
    LDS_WAIT(); asm volatile("" ::: "memory");
    const int n = lane >> 1, kh = (lane & 1) * 32; const LAS float* s = scr + kh * 33 + n;
#pragma unroll
    for (int j = 0; j < 2; ++j) { v4u o;
        o.x = pk4f8(s[(16 * j + 0) * 33], s[(16 * j + 1) * 33], s[(16 * j + 2) * 33], s[(16 * j + 3) * 33]); o.y = pk4f8(s[(16 * j + 4) * 33], s[(16 * j + 5) * 33], s[(16 * j + 6) * 33], s[(16 * j + 7) * 33]);
        o.z = pk4f8(s[(16 * j + 8) * 33], s[(16 * j + 9) * 33], s[(16 * j + 10) * 33], s[(16 * j + 11) * 33]); o.w = pk4f8(s[(16 * j + 12) * 33], s[(16 * j + 13) * 33], s[(16 * j + 14) * 33], s[(16 * j + 15) * 33]);
        *(GAS v4u*)(WT + (size_t)(row_off + n0 + n) * ldt + k0 + kh + 16 * j) = o; }
    LDS_WAIT(); asm volatile("" ::: "memory");
}
__device__ __forceinline__ void tp_load(const float* W, int N, int kb, int nb, int lane, f32x4 (&v)[8]) {
    const int k0 = 64 * kb, n0 = 32 * nb, r8 = lane >> 3, c4 = (lane & 7) * 4;
#pragma unroll
    for (int i = 0; i < 8; ++i) v[i] = *(const GAS f32x4*)(W + (size_t)(k0 + 8 * i + r8) * N + n0 + c4);
}
__device__ __forceinline__ void tp_fin(const f32x4 (&v)[8], bool is8, unsigned char* WT, int ldt, int row_off, float scale, const float* gk, LAS float* scr, int kb, int nb, int lane) {
    const int k0 = 64 * kb, n0 = 32 * nb, r8 = lane >> 3, c4 = (lane & 7) * 4;
#pragma unroll
    for (int i = 0; i < 8; ++i) { const int kk = 8 * i + r8; const float g = gk ? gk[k0 + kk] * scale : scale; LAS float* d = scr + kk * 33 + c4; d[0] = v[i].x * g; d[1] = v[i].y * g; d[2] = v[i].z * g; d[3] = v[i].w * g; }
    LDS_WAIT(); asm volatile("" ::: "memory");
    if (is8) { const int n = lane >> 1, kh = (lane & 1) * 32; const LAS float* s = scr + kh * 33 + n;
#pragma unroll
        for (int j = 0; j < 2; ++j) { v4u o;
            o.x = pk4f8(s[(16 * j + 0) * 33], s[(16 * j + 1) * 33], s[(16 * j + 2) * 33], s[(16 * j + 3) * 33]); o.y = pk4f8(s[(16 * j + 4) * 33], s[(16 * j + 5) * 33], s[(16 * j + 6) * 33], s[(16 * j + 7) * 33]);
            o.z = pk4f8(s[(16 * j + 8) * 33], s[(16 * j + 9) * 33], s[(16 * j + 10) * 33], s[(16 * j + 11) * 33]); o.w = pk4f8(s[(16 * j + 12) * 33], s[(16 * j + 13) * 33], s[(16 * j + 14) * 33], s[(16 * j + 15) * 33]);
            *(GAS v4u*)(WT + (size_t)(row_off + n0 + n) * ldt + k0 + kh + 16 * j) = o; } }
    else { const int c = lane & 7; bf16* WTb = (bf16*)WT;
#pragma unroll
        for (int j = 0; j < 4; ++j) { const int n = (lane >> 3) + 8 * j; const LAS float* s = scr + (8 * c) * 33 + n;
            v4u o; o.x = pkbf(s[0 * 33], s[1 * 33]); o.y = pkbf(s[2 * 33], s[3 * 33]); o.z = pkbf(s[4 * 33], s[5 * 33]); o.w = pkbf(s[6 * 33], s[7 * 33]);
            *(GAS v4u*)(WTb + (size_t)(row_off + n0 + n) * ldt + k0 + 8 * c) = o; } }
    LDS_WAIT(); asm volatile("" ::: "memory");
}
__device__ __forceinline__ void rms_row_to_fp8(const float* xrow, const float* gain, unsigned char* orow, int lane) {
    const GAS f32x4* xr = (const GAS f32x4*)xrow + lane; const GAS f32x4* gr = (const GAS f32x4*)gain + lane;
    f32x4 v[16]; float s = 0.f;
#pragma unroll
    for (int j = 0; j < 16; ++j) { v[j] = xr[64 * j]; s += (v[j].x * v[j].x + v[j].y * v[j].y) + (v[j].z * v[j].z + v[j].w * v[j].w); }
    const float rstd = 1.f / sqrtf(wave_sum(s) * (1.f / DM) + EPS);
    GAS unsigned* o4 = (GAS unsigned*)orow + lane;
#pragma unroll
    for (int j = 0; j < 16; ++j) { const f32x4 g = gr[64 * j]; o4[64 * j] = pk4f8(v[j].x * rstd * g.x, v[j].y * rstd * g.y, v[j].z * rstd * g.z, v[j].w * rstd * g.w); }
}

struct Args {
    const float* in[19]; float* out; unsigned char* ws; int ph_lo, ph_hi, use_bar, pad;
};

__global__ void __launch_bounds__(NWAVES * 64, 2) mk_fwd(Args args) {
    extern __shared__ __attribute__((aligned(16))) unsigned char lds[];
    LAS unsigned char* ldsl = (LAS unsigned char*)lds;
    volatile LAS unsigned* MISC = (volatile LAS unsigned*)(ldsl + MISC_OFF);
    const int tid = threadIdx.x, lane = tid & 63, wave = __builtin_amdgcn_readfirstlane(tid >> 6);
    const int G = gridDim.x, bx = blockIdx.x;
    const int vcu = (G % 8 == 0) ? (bx % 8) * (G / 8) + bx / 8 : bx;
    const int gw = vcu * NWAVES + wave, NGW = G * NWAVES;
    unsigned char* ws = args.ws;
    gu32* ctl = (gu32*)(ws + WS_CTL);
    const float* x = args.in[0]; const float* attn_norm = args.in[1]; const float* w_in = args.in[2]; const float* q_norm = args.in[3]; const float* w_uq = args.in[4];
    const float* kv_norm = args.in[5]; const float* w_ukv = args.in[6]; const float* w_bmla = args.in[7]; const float* na_rpb = args.in[8]; const float* w_bna = args.in[9];
    const float* w_gate = args.in[10]; const float* b_gate = args.in[11]; const float* w_out = args.in[12]; const float* ffn_norm = args.in[13]; const float* peer_wq = args.in[14];
    const float* peer_sub = args.in[15]; const float* peer_u = args.in[16]; const float* peer_v = args.in[17]; const float* final_norm = args.in[18];
    float* out = args.out;
    float* ROPE = (float*)(ws + WS_ROPE); float* RS = (float*)(ws + WS_RS);
    bf16* WCAT = (bf16*)(ws + WS_WCAT); bf16* WUQ = (bf16*)(ws + WS_WUQ); bf16* WUKV = (bf16*)(ws + WS_WUKV); bf16* PA = (bf16*)(ws + WS_PA); bf16* PB = (bf16*)(ws + WS_PB);
    bf16* WOUT = (bf16*)(ws + WS_WOUT); bf16* WQ = (bf16*)(ws + WS_WQ); bf16* SUBH = (bf16*)(ws + WS_SUBH); bf16* SUBL = (bf16*)(ws + WS_SUBL);
    unsigned char* XN8 = ws + WS_R1; unsigned char* OA8 = ws + WS_R1; unsigned char* OB8 = ws + WS_R1 + 32 * MiB; bf16* H2 = (bf16*)(ws + WS_R1);
    bf16* LAT = (bf16*)(ws + WS_LAT);
    bf16* NAQ = (bf16*)(ws + WS_R2); bf16* NAK = (bf16*)(ws + WS_R2 + 64 * MiB); bf16* NAV = (bf16*)(ws + WS_R2 + 128 * MiB); unsigned char* Y8 = ws + WS_R2; unsigned char* MRG8 = ws + WS_R2 + 128 * MiB;
    const unsigned char* G8 = ws + WS_R3; bf16* X1B = (bf16*)(ws + WS_R3 + 128 * MiB); unsigned char* HHI = ws + WS_R2 + 128 * MiB; unsigned char* HLO = ws + WS_R2 + 160 * MiB;     unsigned char* U8 = ws + WS_R3; unsigned char* V8 = ws + WS_R3 + 64 * MiB;
    unsigned char* Q8 = ws + WS_R4; unsigned char* K8 = ws + WS_R4 + 48 * MiB; unsigned char* VT8 = ws + WS_R4 + 96 * MiB; float* QP = (float*)(ws + WS_R4);
    bf16* KR = (bf16*)(ws + WS_KR); int* IDX = (int*)(ws + WS_IDX); float* GATE = (float*)(ws + WS_GATE);

    for (int u = tid; u < (LDS_BYTES - LDSCTL_OFF) / 4; u += NWAVES * 64) ((LAS unsigned*)(ldsl + LDSCTL_OFF))[u] = 0u;
    __syncthreads();
    XcdBarrier bar; bar.bar = (unsigned*)(ctl + CW_BAR); bar.x = 0; bar.st = nullptr;
    if (args.use_bar) bar = xcd_barrier_post((unsigned*)(ctl + CW_BAR), MISC + 8);
    const int lo = args.ph_lo, hi = args.ph_hi;
#ifndef MK_PHMASK
#define MK_PHMASK 0xFFF
#endif
#define IN(k) (((MK_PHMASK >> (k)) & 1) && lo <= (k) && (k) < hi)
#ifndef MK_VAR
#define MK_VAR 0
#endif
#ifndef MK_DUP4
#define MK_DUP4 0
#endif
#ifndef MK_FAKE
#define MK_FAKE false
#endif
#ifndef MK_DUP
#define MK_DUP -1
#endif
#define REPS(k) ((MK_DUP == (k)) ? 2 : 1)
#define SEAM(k) do { if (IN(k) && IN((k) + 1)) xcd_barrier(bar); } while (0)

    for (int rep_ = 0; rep_ < REPS(0); ++rep_) if (IN(0)) {
        LAS float* scr = (LAS float*)(ldsl + wave * 16384);
        constexpr int I0 = 64 * 234, I1 = 64 * 256, I2 = 12 * 96, I3 = 8 * 128, I4 = 32 * 128, I5 = 32 * 128, I6 = 64 * 128, I7 = 64 * 64;
        constexpr int NITEMS = I0 + I1 + I2 + I3 + I4 + I5 + I6 + I7;
#define TP_RESOLVE(IT, W_, N_, kb_, nb_, WT_, ldt_, roff_, sc_, gk_, is8_) do { int r = (IT); \
            if (r < I0) { kb_ = r / 234; nb_ = r % 234; W_ = w_in; N_ = 7488; WT_ = (unsigned char*)WCAT; ldt_ = 4096; roff_ = (nb_ >= 42) ? 192 : 0; sc_ = S_WIN; gk_ = nullptr; is8_ = true; break; } r -= I0; \
            if (r < I1) { kb_ = r / 256; nb_ = r % 256; W_ = w_gate; N_ = 8192; WT_ = (unsigned char*)WCAT; ldt_ = 4096; roff_ = 7680; sc_ = S_WIN; gk_ = nullptr; is8_ = true; break; } r -= I1; \
            if (r < I2) { kb_ = r / 96; nb_ = r % 96; W_ = w_uq; N_ = 3072; WT_ = (unsigned char*)WUQ; ldt_ = 768; roff_ = 0; sc_ = S_WU; gk_ = q_norm; is8_ = true; break; } r -= I2; \
            if (r < I3) { kb_ = r / 128; nb_ = r % 128; W_ = w_ukv; N_ = 4096; WT_ = (unsigned char*)WUKV; ldt_ = 512; roff_ = 0; sc_ = S_WU; gk_ = kv_norm; is8_ = true; break; } r -= I3; \
            if (r < I4) { kb_ = r / 128; nb_ = r % 128; W_ = w_bmla; N_ = 4096; WT_ = (unsigned char*)PA; ldt_ = 2048; roff_ = 0; sc_ = S_PAB; gk_ = nullptr; is8_ = true; break; } r -= I4; \
            if (r < I5) { kb_ = r / 128; nb_ = r % 128; W_ = w_bna; N_ = 4096; WT_ = (unsigned char*)PB; ldt_ = 2048; roff_ = 0; sc_ = S_PAB; gk_ = nullptr; is8_ = true; break; } r -= I5; \
            if (r < I6) { kb_ = r / 128; nb_ = r % 128; W_ = w_out; N_ = 4096; WT_ = (unsigned char*)WOUT; ldt_ = 4096; roff_ = 0; sc_ = S_WOUT; gk_ = nullptr; is8_ = true; break; } r -= I6; \
            kb_ = r / 64; nb_ = r % 64; W_ = peer_wq; N_ = 2048; WT_ = (unsigned char*)WQ; ldt_ = 4096; roff_ = 0; sc_ = 1.0f; gk_ = ffn_norm; is8_ = false; } while (0)
#pragma unroll 1
        for (int it = gw; it < NITEMS; it += 2 * NGW) {
            const int itB = it + NGW; const bool hasB = itB < NITEMS;
            const float* Wa; int Na, kba, nba, ldta, roffa; unsigned char* WTa; float sca; const float* gka; bool is8a;
            const float* Wb; int Nb, kbb, nbb, ldtb, roffb; unsigned char* WTb; float scb; const float* gkb; bool is8b;
            TP_RESOLVE(it, Wa, Na, kba, nba, WTa, ldta, roffa, sca, gka, is8a);
            TP_RESOLVE(hasB ? itB : it, Wb, Nb, kbb, nbb, WTb, ldtb, roffb, scb, gkb, is8b);
            f32x4 va[8], vb[8];
            tp_load(Wa, Na, kba, nba, lane, va);
            tp_load(Wb, Nb, kbb, nbb, lane, vb);
            __builtin_amdgcn_sched_barrier(0);
            tp_fin(va, is8a, WTa, ldta, roffa, sca, gka, scr, kba, nba, lane);
            if (hasB) tp_fin(vb, is8b, WTb, ldtb, roffb, scb, gkb, scr, kbb, nbb, lane);
        }
#undef TP_RESOLVE
        for (int i = gw * 64 + lane; i < 192 * 4096 / 16; i += NGW * 64) ((GAS v4u*)((unsigned char*)WCAT + (size_t)1344 * 4096))[i] = (v4u){0u, 0u, 0u, 0u};
        for (int i = gw * 64 + lane; i < 8 * 2 * 128 * 128 / 2; i += NGW * 64) { const float a = peer_sub[2 * i], b = peer_sub[2 * i + 1];
            const unsigned h = pkbf(a, b); const unsigned l = pkbf(a - __uint_as_float(h << 16), b - __uint_as_float(h & 0xffff0000u));
            ((GAS unsigned*)SUBH)[i] = h; ((GAS unsigned*)SUBL)[i] = l; }
        for (int i = gw * 64 + lane; i < 128 * 16; i += NGW * 64) { const int pos = i >> 4, j = i & 15; const float fr = powf(10000.0f, -(float)j / 16.0f); const float ang = (float)pos * fr;
            ROPE[2 * i] = cosf(ang); ROPE[2 * i + 1] = sinf(ang); }
        for (int m = gw; m < T; m += NGW) rms_row_to_fp8(x + (size_t)m * DM, attn_norm, XN8 + (size_t)m * DM, lane);
    }
    SEAM(0);
    for (int rep_ = 0; rep_ < REPS(1); ++rep_) if (IN(1)) {
        pg8::Gemm g{(const bf16*)XN8, WCAT, T, NCAT, DM, DM, DM}; pg8::StaticOrder S; S.init(T, NCAT, G, bx);
        pg8::EpiIn E{ws, WS_LAT, WS_R2, 64 * MiB, WS_R3, b_gate, NA_QSCALE, 1.0f / S_WIN, WS_R4 + 160 * MiB, S_LAT};
        pg8::gemm_phase<pg8::EpiIn, pg8::StaticOrder, true, true>(ldsl, g, S, E);
    }
    SEAM(1);
    for (int rep_ = 0; rep_ < REPS(2); ++rep_) if (IN(2)) {
        for (int m = gw; m < T; m += NGW) {
            const unsigned char* row8 = ws + WS_R4 + 160 * MiB + (size_t)m * 1536;
            float sq = 0.f, skv = 0.f;
#pragma unroll
            for (int j = 0; j < 3; ++j) { const int w = (int)((const GAS unsigned*)row8)[lane + 64 * j]; const pg8::f32x2 a = __builtin_amdgcn_cvt_pk_f32_fp8(w, false), b = __builtin_amdgcn_cvt_pk_f32_fp8(w, true); sq += (a.x * a.x + a.y * a.y) + (b.x * b.x + b.y * b.y); }
#pragma unroll
            for (int j = 0; j < 2; ++j) { const int w = (int)((const GAS unsigned*)(row8 + 768))[lane + 64 * j]; const pg8::f32x2 a = __builtin_amdgcn_cvt_pk_f32_fp8(w, false), b = __builtin_amdgcn_cvt_pk_f32_fp8(w, true); skv += (a.x * a.x + a.y * a.y) + (b.x * b.x + b.y * b.y); }
            sq = wave_sum(sq) * (1.f / (S_LAT * S_LAT)); skv = wave_sum(skv) * (1.f / (S_LAT * S_LAT));
            if (lane == 0) { RS[2 * m] = 1.f / sqrtf(sq * (1.f / 768.f) + EPS); RS[2 * m + 1] = 1.f / sqrtf(skv * (1.f / 512.f) + EPS); }
            const float xk = __builtin_amdgcn_cvt_f32_fp8((int)row8[1280 + lane], 0) * (1.f / S_LAT);
            const float xp = __shfl_xor(xk, 16);
            const int s = m & (SEQ - 1), pos = (lane < 32) ? (s >> 6) : (s & 63), j = lane & 15;
            const float c = ROPE[(pos * 16 + j) * 2], sn = ROPE[(pos * 16 + j) * 2 + 1];
            const float o = ((lane & 16) == 0) ? (xk * c - xp * sn) : (xp * sn + xk * c);
            { const unsigned char o8 = (unsigned char)(__builtin_amdgcn_cvt_pk_fp8_f32(o, 0.f, 0, false) & 0xff);
#pragma unroll
              for (int hh = 0; hh < 16; ++hh) K8[((size_t)m * 16 + hh) * 192 + 128 + lane] = o8; }
        }
    }
    SEAM(2);
    for (int rep_ = 0; rep_ < REPS(3); ++rep_) if (IN(3)) {
        const unsigned char* LAT8 = ws + WS_R4 + 160 * MiB;
        { pg8::Gemm g{(const bf16*)LAT8, WUQ, T, 3072, 768, 1536, 768}; pg8::StaticOrder S; S.init(T, 3072, G, bx);
          pg8::EpiQ8 E{Q8, RS, ROPE, MLA_QSCALE * att8::SQ8 / (S_LAT * S_WU)};
          pg8::gemm_phase<pg8::EpiQ8, pg8::StaticOrder, true, true>(ldsl, g, S, E); }
        { pg8::Gemm g{(const bf16*)(LAT8 + 768), WUKV, T, 4096, 512, 1536, 512}; pg8::StaticOrder S; S.init(T, 4096, G, bx);
          pg8::EpiKV8 E{K8, VT8, RS, 1.0f / (S_LAT * S_WU)};
          pg8::gemm_phase<pg8::EpiKV8, pg8::StaticOrder, true, true>(ldsl, g, S, E); }
    }
    SEAM(3);
    for (int rep_ = 0; rep_ < REPS(4); ++rep_) if (IN(4)) {
#ifndef NO_MLA
        if (!(MK_DUP == 4 && rep_ == 0 && MK_DUP4 == 2))
#pragma unroll 1
        for (int u = vcu; u < BATCH * 16 * 32; u += G) { const int bh = u >> 5, qb = u & 31; if (MK_DUP == 4 && rep_ == 0) att8::mla8_unit<MK_VAR>(bh >> 4, bh & 15, qb, Q8, K8, VT8, OA8, S_OA, (char*)lds, (unsigned*)(ctl + 8200)); else att8::mla8_unit<0>(bh >> 4, bh & 15, qb, Q8, K8, VT8, OA8, S_OA, (char*)lds); }
#endif
#ifndef NO_NA
        if (!(MK_DUP == 4 && rep_ == 0 && MK_DUP4 == 1))
#pragma unroll 1
        for (int u = vcu; u < BATCH * 16 * 32; u += G) { const int bh = u >> 5, rg = u & 31; if (MK_DUP == 4 && rep_ == 0) att::na_unit<MK_VAR>(bh >> 4, bh & 15, rg, NAQ, NAK, NAV, na_rpb, OB8, S_OB, (char*)lds); else att::na_unit<0>(bh >> 4, bh & 15, rg, NAQ, NAK, NAV, na_rpb, OB8, S_OB, (char*)lds); }
#endif
        __syncthreads();
    }
    SEAM(4);

#ifdef MK_CHECK
    {
        xcd_barrier(bar);
        gu32* chk = ctl + 8192;
        const float* xin_q_norm = q_norm; const float* xin_kv_norm = kv_norm;
#define F8DEC(byte) __builtin_amdgcn_cvt_f32_fp8((int)(byte), 0)
        if (bx < 8 && wave == 0) {
            const int ts[8] = {0, 37, 1000, 8191, 8192 + 5, 12345, 16000, 16383}; const int m = ts[bx];
            const bf16* row = LAT + (size_t)m * 1536; float sq = 0.f, skv = 0.f;
            for (int k = lane; k < 768; k += 64) { const float a = __uint_as_float((unsigned)row[k] << 16); sq += a * a; }
            for (int k = lane; k < 512; k += 64) { const float a = __uint_as_float((unsigned)row[768 + k] << 16); skv += a * a; }
            sq = wave_sum(sq); skv = wave_sum(skv);
            const float rq = 1.f / sqrtf(sq / 768.f + EPS), rkv = 1.f / sqrtf(skv / 512.f + EPS);
            float err = fmaxf(fabsf(RS[2 * m] - rq) / rq, fabsf(RS[2 * m + 1] - rkv) / rkv);
            const int s_ = m & (SEQ - 1), half = lane >> 5, j = lane & 15, hiq = (lane >> 4) & 1; const float pos = half ? (float)(s_ & 63) : (float)(s_ >> 6);
            const float ang = pos * powf(10000.0f, -(float)j / 16.0f), cs = cosf(ang), sn = sinf(ang);
            const float x1 = __uint_as_float((unsigned)row[1280 + half * 32 + j] << 16), x2 = __uint_as_float((unsigned)row[1280 + half * 32 + 16 + j] << 16);
            const float ref = hiq ? (x1 * sn + x2 * cs) : (x1 * cs - x2 * sn);
            const float got = __uint_as_float((unsigned)KR[(size_t)m * 64 + lane] << 16);
            float e2 = fabsf(got - ref); e2 = fmaxf(e2, __shfl_xor(e2, 1)); e2 = fmaxf(e2, __shfl_xor(e2, 2)); e2 = fmaxf(e2, __shfl_xor(e2, 4)); e2 = fmaxf(e2, __shfl_xor(e2, 8)); e2 = fmaxf(e2, __shfl_xor(e2, 16)); e2 = fmaxf(e2, __shfl_xor(e2, 32));
            err = fmaxf(err, e2);
            { float e3 = fabsf(F8DEC(K8[((size_t)m * 16 + 5) * 192 + 128 + lane]) - ref) - 0.07f * fabsf(ref); e3 = fmaxf(e3, __shfl_xor(e3, 1)); e3 = fmaxf(e3, __shfl_xor(e3, 2)); e3 = fmaxf(e3, __shfl_xor(e3, 4)); e3 = fmaxf(e3, __shfl_xor(e3, 8)); e3 = fmaxf(e3, __shfl_xor(e3, 16)); e3 = fmaxf(e3, __shfl_xor(e3, 32)); err = fmaxf(err, e3 + 0.03f); }
            if (lane == 0 && !(err < 0.05f)) atomicOr((unsigned*)chk, 1u);
        }
        if (bx >= 8 && bx < 16 && wave == 0) {
            const int ts[4] = {3, 4099, 12345, 16300}; const int m = ts[(bx - 8) & 3] + ((bx - 8) >> 2) * 64;
            {
                const int head = (lane * 5) & 15, kind = lane % 6, i = (lane * 7) & 31; const int col = head * 192 + kind * 32 + i;
                const int pcol = (kind >= 4) ? (head * 192 + kind * 32 + (i ^ 16)) : col;
                const bf16* row = LAT + (size_t)m * 1536; float a = 0.f, b = 0.f, sq = 0.f;
                for (int k = 0; k < 768; ++k) { const float c = __uint_as_float((unsigned)row[k] << 16); sq += c * c; const float cg = c * xin_q_norm[k]; a += cg * w_uq[(size_t)k * 3072 + col]; b += cg * w_uq[(size_t)k * 3072 + pcol]; }
                const float rq = 1.f / sqrtf(sq / 768.f + EPS); a *= rq; b *= rq; float ref = a;
                if (kind >= 4) { const int s_ = m & (SEQ - 1); const float pos = (kind == 4) ? (float)(s_ >> 6) : (float)(s_ & 63); const int j = i & 15; const float ang = pos * powf(10000.0f, -(float)j / 16.0f), cs = cosf(ang), sn = sinf(ang);
                    ref = (i < 16) ? (a * cs - b * sn) : (b * sn + a * cs); }
                ref *= MLA_QSCALE;
                const float got = F8DEC(Q8[(size_t)m * 3072 + col]) * (1.0f / att8::SQ8);
                if (!(fabsf(got - ref) < 0.08f * (0.03f + fabsf(ref)))) atomicOr((unsigned*)chk + 1, 1u);
            }
            {
                const int col = (lane * 67 + 13) & 4095; const bf16* row = LAT + (size_t)m * 1536 + 768; float a = 0.f, sq = 0.f;
                for (int k = 0; k < 512; ++k) { const float c = __uint_as_float((unsigned)row[k] << 16); sq += c * c; a += c * xin_kv_norm[k] * w_ukv[(size_t)k * 4096 + col]; }
                a *= 1.f / sqrtf(sq / 512.f + EPS);
                const int h = col >> 8, c = col & 255;
                const float got = (c < 128) ? F8DEC(K8[((size_t)m * 16 + h) * 192 + c]) : F8DEC(VT8[((size_t)((m >> 13) * 16 + h) * 128 + (c - 128)) * 8192 + (m & 8191)]);
                if (!(fabsf(got - a) < 0.08f * (0.2f + fabsf(a)))) atomicOr((unsigned*)chk + 2, 1u);
            }
        }
        if (bx >= 16 && bx < 48) {
            const int si = bx - 16; const int ts[8] = {1, 255, 256, 4097, 8190, 8192 + 77, 12000, 16383}; const int m = ts[si & 7], h = (si * 5 + (si >> 3) * 3) & 15;
            const int b = m >> 13; LAS float* sc = (LAS float*)ldsl; LAS float* red = sc + 8192; LAS float* qs = red + 512;
            if (tid < 192) qs[tid] = F8DEC(Q8[(size_t)m * 3072 + h * 192 + tid]) * (1.0f / att8::SQ8);
            __syncthreads();
            float mx = -1e30f;
            for (int k = tid; k < SEQ; k += 512) { const size_t kt = (size_t)b * SEQ + k; float s_ = 0.f;
                for (int d = 0; d < 192; ++d) s_ += qs[d] * F8DEC(K8[(kt * 16 + h) * 192 + d]);
                sc[k] = s_; mx = fmaxf(mx, s_); }
            red[tid] = mx; __syncthreads();
            for (int o = 256; o > 0; o >>= 1) { if (tid < o) red[tid] = fmaxf(red[tid], red[tid + o]); __syncthreads(); }
            mx = red[0]; __syncthreads();
            float sm = 0.f;
            for (int k = tid; k < SEQ; k += 512) { const float p_ = exp2f(sc[k] - mx); sc[k] = p_; sm += p_; }
            red[tid] = sm; __syncthreads();
            for (int o = 256; o > 0; o >>= 1) { if (tid < o) red[tid] += red[tid + o]; __syncthreads(); }
            sm = red[0]; __syncthreads();
            const int d = tid & 127, part = tid >> 7; float acc_ = 0.f;
            for (int k = part * 2048; k < (part + 1) * 2048; ++k) acc_ += sc[k] * F8DEC(VT8[((size_t)(b * 16 + h) * 128 + d) * 8192 + k]);
            red[tid] = acc_; __syncthreads();
            float e2 = 0.f, r2 = 0.f;
            if (tid < 128) { const float ref = (red[tid] + red[tid + 128] + red[tid + 256] + red[tid + 384]) / sm;
                const int w_ = (int)OA8[(size_t)m * 2048 + h * 128 + tid]; const float got = __builtin_amdgcn_cvt_f32_fp8(w_, 0) * (1.0f / S_OA);
                e2 = (got - ref) * (got - ref); r2 = ref * ref; }
            __syncthreads();
            if (tid < 128) { red[tid] = e2; red[128 + tid] = r2; }
            __syncthreads();
            if (tid == 0) { float se = 0.f, sr = 0.f; for (int i = 0; i < 128; ++i) { se += red[i]; sr += red[128 + i]; }
                if (!(se < 0.01f * sr)) atomicOr((unsigned*)chk + 3, 1u); }
            __syncthreads();
        }
#undef F8DEC
        xcd_barrier(bar);
    }
#endif
    for (int rep_ = 0; rep_ < REPS(5); ++rep_) if (IN(5)) {
        { pg8::Gemm g{(const bf16*)OA8, PA, T, DM, 2048, 2048, 2048}; pg8::StaticOrder S; S.init(T, DM, G, bx);
          pg8::EpiGate<true> E{G8, Y8, nullptr, 1.0f / (S_OA * S_PAB * 256.0f), S_Y, 0.f};
          if (MK_DUP == 5 && rep_ == 0) pg8::gemm_phase<pg8::EpiGate<true>, pg8::StaticOrder, true, true, MK_VAR>(ldsl, g, S, E); else
          pg8::gemm_phase<pg8::EpiGate<true>, pg8::StaticOrder, true, true>(ldsl, g, S, E); }
    }
    for (int rep_ = 0; rep_ < REPS(6); ++rep_) if (IN(6)) {
        { pg8::Gemm g{(const bf16*)OB8, PB, T, DM, 2048, 2048, 2048}; pg8::StaticOrder S; S.init(T, DM, G, bx);
          pg8::EpiGate<false> E{G8, Y8, MRG8, 1.0f / (S_OB * S_PAB * 256.0f), S_Y, S_MRG};
          pg8::gemm_phase<pg8::EpiGate<false>, pg8::StaticOrder, true, true>(ldsl, g, S, E); }
    }
    SEAM(6);
    for (int rep_ = 0; rep_ < REPS(7); ++rep_) if (IN(7)) {
        pg8::Gemm g{(const bf16*)MRG8, WOUT, T, DM, DM, DM, DM}; pg8::StaticOrder S; S.init(T, DM, G, bx);
        pg8::EpiX1 E{x, X1B, 1.0f / (S_MRG * S_WOUT)};
        if (MK_DUP == 7 && rep_ == 0) pg8::gemm_phase<pg8::EpiX1, pg8::StaticOrder, true, true, MK_VAR>(ldsl, g, S, E); else
        pg8::gemm_phase<pg8::EpiX1, pg8::StaticOrder, true, true>(ldsl, g, S, E);
#ifdef PROBE_SKIP_ATTN
        VM_WAIT(); __syncthreads();
        for (size_t i = (size_t)gw * 64 + lane; i < (size_t)T * DM / 4; i += (size_t)NGW * 64) ((GAS f32x4*)out)[i] = ((const GAS f32x4*)x)[i];
#endif
    }
    SEAM(7);
    for (int rep_ = 0; rep_ < REPS(8); ++rep_) if (IN(8)) {
        for (int m = gw; m < T; m += NGW) rms_rowbf_to_bf16(X1B + (size_t)m * DM, ffn_norm, RS + 2 * m, (unsigned*)(HHI + (size_t)m * 2048), (unsigned*)(HLO + (size_t)m * 2048), peer::H8ISCALE, lane);
    }
    SEAM(8);
    for (int rep_ = 0; rep_ < REPS(9); ++rep_) if (IN(9)) {
        pg8::Gemm g{X1B, WQ, T, 2048, DM, DM, DM}; pg8::StaticOrder S; S.init(T, 2048, G, bx);
        pg8::EpiF32RS E{RS, QP, 2048};
        pg8::gemm_phase<pg8::EpiF32RS, pg8::StaticOrder>(ldsl, g, S, E);
    }
    SEAM(9);
    for (int rep_ = 0; rep_ < REPS(10); ++rep_) if (IN(10)) {
        LAS int* wl = (LAS int*)(ldsl + wave * peer::SEL_LDS_PER_WAVE);
#pragma unroll 1
        for (int pass = 0; pass < 2; ++pass) {
            if (((pass ^ wave) & 1) == 0) { for (int it = gw; it < (T / 32) * 8; it += NGW) peer::select32((it >> 3) * 32, it & 7, QP, SUBH, SUBL, IDX, GATE, wl, lane); }
            else {
#pragma unroll 1
                for (int r = gw; r < 2 * 16384; r += 2 * NGW) { const int rb = (r + NGW < 2 * 16384) ? r + NGW : r;
                    const bool ua = r < 16384, ub = rb < 16384; const int ea = ua ? r : r - 16384, eb = ub ? rb : rb - 16384;
                    f32x4 ca[16], cb[16];
                    peer::pack_load((ua ? peer_u : peer_v) + (size_t)ea * DM, lane, ca); peer::pack_load((ub ? peer_u : peer_v) + (size_t)eb * DM, lane, cb);
                    __builtin_amdgcn_sched_barrier(0);
                    if (ua) peer::pack_fin_i4w(ca, U8, ea, peer::U4ISCALE, lane); else peer::pack_fin_i4w(ca, V8, ea, peer::V4ISCALE, lane);
                    if (rb != r) { if (ub) peer::pack_fin_i4w(cb, U8, eb, peer::U4ISCALE, lane); else peer::pack_fin_i4w(cb, V8, eb, peer::V4ISCALE, lane); } } }
        }
    }
    SEAM(10);
    for (int rep_ = 0; rep_ < REPS(11); ++rep_) if (IN(11)) {
#ifdef PROBE_SKIP_PEER
        for (int t = gw; t < T; t += NGW) { float* xr = out + (size_t)t * DM; f32x4 v[16]; float ss = 0.f;
            for (int j = 0; j < 16; ++j) { v[j] = ((const GAS f32x4*)xr)[lane + 64 * j]; ss += v[j].x * v[j].x + v[j].y * v[j].y + v[j].z * v[j].z + v[j].w * v[j].w; }
            const float rstd = 1.f / sqrtf(wave_sum(ss) * (1.f / DM) + EPS);
            for (int j = 0; j < 16; ++j) { const f32x4 g = ((const GAS f32x4*)final_norm)[lane + 64 * j]; ((GAS f32x4*)xr)[lane + 64 * j] = v[j] * rstd * g; } }
#else
        if (MK_DUP == 11 && rep_ == 0) peer::expert_tokens4<false, MK_VAR>(gw, NGW, T, H2, U8, V8, IDX, GATE, (const unsigned short*)X1B, out, final_norm, lane);
        else peer::expert_tokens_w(HHI, HLO, U8, V8, IDX, GATE, (const unsigned short*)X1B, (unsigned short*)(ws + WS_R2), out, final_norm, (LAS float*)(ldsl + wave * 8192), lane, wave, T);
#endif
    }

#ifdef MK_CHECK
    {
        xcd_barrier(bar);
        gu32* chk = ctl + 8192;
        const unsigned f0 = __hip_atomic_load(chk, RLX_AGENT), f1 = __hip_atomic_load(chk + 1, RLX_AGENT), f2 = __hip_atomic_load(chk + 2, RLX_AGENT), f3 = __hip_atomic_load(chk + 3, RLX_AGENT);
        const int nz = (f0 ? T / 2 : 0) + (f1 ? T / 4 : 0) + (f2 ? T / 8 : 0) + (f3 ? T / 16 : 0);
        for (int m = gw; m < nz; m += NGW) for (int j = 0; j < 16; ++j) ((GAS f32x4*)(out + (size_t)m * DM))[lane + 64 * j] = (f32x4){0.f, 0.f, 0.f, 0.f};
    }
#endif

#ifdef MK_TSTAT
    {
        xcd_barrier(bar);
        const unsigned a = __hip_atomic_load(ctl + 8200, RLX_AGENT), b = __hip_atomic_load(ctl + 8201, RLX_AGENT), c = __hip_atomic_load(ctl + 8202, RLX_AGENT);
        const float tot = (float)a + (float)b + (float)c + 1.0f;
        const int d1 = (int)(10.0f * (float)(MK_TSTAT == 1 ? a : b) / tot), d2 = (int)(10.0f * (float)c / tot);
        const int nz = (int)((float)T * ((float)d1 * 0.1f + (float)d2 * 0.01f));
        for (int m = gw; m < nz; m += NGW) for (int j = 0; j < 16; ++j) ((GAS f32x4*)(out + (size_t)m * DM))[lane + 64 * j] = (f32x4){0.f, 0.f, 0.f, 0.f};
    }
#endif
#undef IN
#undef SEAM
}

extern "C" void kernel_launch(void* const* d_in, const int* in_sizes, int n_in, void* d_out, int out_size, void* d_ws, size_t ws_size, hipStream_t stream) {
    static int grid = 0;
    if (grid == 0) {
        if (n_in != 19 || out_size != T * DM || ws_size < WS_END) { fprintf(stderr, "kernel_launch: shape mismatch: n_in %d out %d ws %zu (need %zu)\n", n_in, out_size, ws_size, (size_t)WS_END); grid = -1; return; }
        int dev = 0, cus = 0, per_cu = 0;
        if (hipGetDevice(&dev) != hipSuccess || hipDeviceGetAttribute(&cus, hipDeviceAttributeMultiprocessorCount, dev) != hipSuccess) { grid = -1; return; }
        if (hipFuncSetAttribute((const void*)mk_fwd, hipFuncAttributeMaxDynamicSharedMemorySize, LDS_BYTES) != hipSuccess) { fprintf(stderr, "kernel_launch: hipFuncSetAttribute failed\n"); grid = -1; return; }
        if (hipOccupancyMaxActiveBlocksPerMultiprocessor(&per_cu, (const void*)mk_fwd, NWAVES * 64, LDS_BYTES) != hipSuccess || per_cu < 1) { fprintf(stderr, "kernel_launch: occupancy query says %d blocks per CU\n", per_cu); }
        (void)hipGetLastError();
        grid = cus;
    }
    if (grid < 0) return;
    if (hipMemsetAsync((char*)d_ws + WS_CTL, 0, CTL_ZERO_BYTES, stream) != hipSuccess) return;
    Args a{};
    for (int i = 0; i < 19; ++i) a.in[i] = (const float*)d_in[i];
    a.out = (float*)d_out; a.ws = (unsigned char*)d_ws; a.pad = 0;
    constexpr int NL = MK_CUTS;
    for (int li = 0; li < NL; ++li) {
        a.ph_lo = (NL == 1) ? 0 : li; a.ph_hi = (NL == 1) ? NPH : li + 1; a.use_bar = (NL == 1) ? 1 : 0;
        hipLaunchKernelGGL(mk_fwd, dim3(grid), dim3(NWAVES * 64), LDS_BYTES, stream, a);
    }
}
```
